# Optimizing an MI355X kernel written in HIP

```python
import math
import jax, jax.numpy as jnp
from jax import lax
import numpy as np

D_MODEL = 2048
BATCH = 1
SEQ = 8192
DEPTH = 4

CHUNK = 64
A_HEADS = 8
A_KDIM = 128
A_VDIM = 128
A_KWIDTH = A_HEADS * A_KDIM
A_VWIDTH = A_HEADS * A_VDIM
B_GROUPS = 64
B_GROUP_CH = 16
B_STATE = 64
B_WIDTH = B_GROUPS * B_GROUP_CH
S5_DT_MIN = 1e-3
S5_DT_MAX = 1e-1
S5_EIG_CLIP = -1e-4
IN_SIZES = (A_KWIDTH, A_KWIDTH, A_VWIDTH, A_VWIDTH, B_WIDTH, D_MODEL, D_MODEL)
IN_COLS = sum(IN_SIZES)
IN_SPLITS = tuple(int(v) for v in np.cumsum(IN_SIZES)[:-1])
P_HEADS = 8
P_QDIM = 256
P_HALF = P_QDIM // 2
P_NKEYS = 128
P_NEXP = P_NKEYS * P_NKEYS
P_TOPK = 16
P_BLOCK = 128
ALPHA = (2.0 * DEPTH) ** 0.25
BETA = (8.0 * DEPTH) ** -0.25
LN_EPS = 1e-5
RMS_EPS = 1e-6

kernel_name = 'hybrid_hgrn2_s5_peer_deepnorm'


def layer_norm(x, g, b):
    xf = x.astype(jnp.float32)
    mu = jnp.mean(xf, axis=-1, keepdims=True)
    var = jnp.mean(jnp.square(xf - mu), axis=-1, keepdims=True)
    y = (xf - mu) * lax.rsqrt(var + LN_EPS) * g.astype(jnp.float32) + b.astype(jnp.float32)
    return y.astype(x.dtype)


def hgrn2_lower_bounds(lb_logits):
    p = jax.nn.softmax(lb_logits.astype(jnp.float32), axis=0)
    c = jnp.cumsum(p, axis=0)
    return c - c[0:1]


def hgrn2_mixer(q, fz, i, g, lb, norm_g):
    bsz, L, _ = q.shape
    nc = L // CHUNK
    f32 = jnp.float32
    q = q.astype(f32); fz = fz.astype(f32); i = i.astype(f32)
    logf = jnp.logaddexp(jnp.log(lb), jnp.log1p(-lb) + jax.nn.log_sigmoid(fz))
    k = -jnp.expm1(logf)

    def to_chunks(t, d):
        return jnp.moveaxis(t.reshape(bsz, nc, CHUNK, A_HEADS, d), 1, 0)

    qc = to_chunks(q, A_KDIM)
    kc = to_chunks(k, A_KDIM)
    vc = to_chunks(i, A_VDIM)
    bc = jnp.cumsum(to_chunks(logf, A_KDIM), axis=2)
    mask = jnp.tril(jnp.ones((CHUNK, CHUNK), dtype=bool))[None, :, :, None, None]

    def step(S, inp):
        qq, kk, vv, bb = inp
        b_last = bb[:, -1]
        o_inter = jnp.einsum('bthd,bhdv->bthv', qq * jnp.exp(bb), S)
        diff = bb[:, :, None] - bb[:, None, :]
        decay = jnp.exp(jnp.where(mask, diff, -jnp.inf))
        att = jnp.sum(qq[:, :, None] * kk[:, None, :] * decay, axis=-1)
        o_intra = jnp.einsum('btsh,bshv->bthv', att, vv)
        k_tail = kk * jnp.exp(b_last[:, None] - bb)
        S = jnp.exp(b_last)[..., None] * S + jnp.einsum('bshd,bshv->bhdv', k_tail, vv)
        return S, o_inter + o_intra

    S0 = jnp.zeros((bsz, A_HEADS, A_KDIM, A_VDIM), f32)
    _, o = lax.scan(step, S0, (qc, kc, vc, bc))
    o = jnp.moveaxis(o, 0, 1).reshape(bsz, L, A_HEADS, A_VDIM)
    o = o * lax.rsqrt(jnp.mean(jnp.square(o), axis=-1, keepdims=True) + RMS_EPS)
    o = o * norm_g.astype(f32).reshape(A_HEADS, A_VDIM)
    o = o.reshape(bsz, L, A_VWIDTH) * jax.nn.sigmoid(g.astype(f32))
    return o


def _complex_affine_combine(e1, e2):
    a1r, a1i, b1r, b1i = e1
    a2r, a2i, b2r, b2i = e2
    ar = a2r * a1r - a2i * a1i
    ai = a2r * a1i + a2i * a1r
    br = a2r * b1r - a2i * b1i + b2r
    bi = a2r * b1i + a2i * b1r + b2i
    return ar, ai, br, bi


def s5_mixer(u, lam_re, lam_im, log_step, b_re, b_im, c_re, c_im, d, w_glu):
    bsz, L, _ = u.shape
    f32 = jnp.float32
    uf = u.astype(f32).reshape(bsz, L, B_GROUPS, B_GROUP_CH)
    lr = jnp.minimum(lam_re.astype(f32), S5_EIG_CLIP)
    li = lam_im.astype(f32)
    dt = jnp.exp(log_step.astype(f32))[:, None]
    mag = jnp.exp(lr * dt)
    ar = mag * jnp.cos(li * dt)
    ai = mag * jnp.sin(li * dt)
    den = lr * lr + li * li
    nr = ar - 1.0
    zr = (nr * lr + ai * li) / den
    zi = (ai * lr - nr * li) / den
    br_, bi_ = b_re.astype(f32), b_im.astype(f32)
    bbr = zr[..., None] * br_ - zi[..., None] * bi_
    bbi = zr[..., None] * bi_ + zi[..., None] * br_
    bur = jnp.einsum('blgn,gpn->blgp', uf, bbr)
    bui = jnp.einsum('blgn,gpn->blgp', uf, bbi)
    a_r = jnp.broadcast_to(ar, bur.shape)
    a_i = jnp.broadcast_to(ai, bui.shape)
    _, _, xr, xi = lax.associative_scan(_complex_affine_combine, (a_r, a_i, bur, bui), axis=1)
    y = (jnp.einsum('blgp,gnp->blgn', xr, c_re.astype(f32))
         - jnp.einsum('blgp,gnp->blgn', xi, c_im.astype(f32))
         + d.astype(f32) * uf)
    y = jax.nn.gelu(y).reshape(bsz, L, B_WIDTH)
    h = y @ w_glu.astype(f32)
    return h[..., :B_WIDTH] * jax.nn.sigmoid(h[..., B_WIDTH:])


def peer_ffn(x, w_q, keys, u_tab, v_tab):
    bsz, L, _ = x.shape
    f32 = jnp.float32
    q = (x @ w_q).astype(f32).reshape(bsz, L, P_HEADS, P_QDIM)
    kf = keys.astype(f32)
    s1 = jnp.einsum('blhd,hnd->blhn', q[..., :P_HALF], kf[:, 0])
    s2 = jnp.einsum('blhd,hnd->blhn', q[..., P_HALF:], kf[:, 1])
    v1, i1 = lax.top_k(s1, P_TOPK)
    v2, i2 = lax.top_k(s2, P_TOPK)
    cand = (v1[..., :, None] + v2[..., None, :]).reshape(bsz, L, P_HEADS, P_TOPK * P_TOPK)
    cid = (i1[..., :, None] * P_NKEYS + i2[..., None, :]).reshape(bsz, L, P_HEADS, P_TOPK * P_TOPK)
    vals, pos = lax.top_k(cand, P_TOPK)
    eid = jnp.take_along_axis(cid, pos, axis=-1)
    gate = jax.nn.softmax(vals, axis=-1).astype(x.dtype)
    nb = L // P_BLOCK

    def blocks(t):
        return jnp.moveaxis(t.reshape((bsz, nb, P_BLOCK) + t.shape[2:]), 1, 0)

    def block_fn(args):
        xb, eb, gb = args
        ue = jnp.take(u_tab, eb, axis=0)
        ve = jnp.take(v_tab, eb, axis=0)
        act = jax.nn.gelu(jnp.einsum('btd,bthkd->bthk', xb, ue)) * gb
        return jnp.einsum('bthk,bthkd->btd', act, ve).astype(x.dtype)

    y = lax.map(block_fn, (blocks(x), blocks(eid), blocks(gate)))
    return jnp.moveaxis(y, 0, 1).reshape(bsz, L, D_MODEL)


def setup_inputs(seed: int = 0) -> dict:
    key = jax.random.key(seed)
    ks = jax.random.split(key, 24)
    f32 = jnp.float32
    nrm = lambda k, s, sc: jax.random.normal(k, s, f32) * sc
    n_idx = jnp.arange(B_STATE, dtype=f32) * math.pi
    return {
        'x': nrm(ks[0], (BATCH, SEQ, D_MODEL), 1.0),
        'w_in': nrm(ks[1], (DEPTH, D_MODEL, IN_COLS), D_MODEL ** -0.5),
        'hgrn_lb_logits': nrm(ks[2], (DEPTH, A_KWIDTH), 0.1),
        'hgrn_norm_g': 1.0 + nrm(ks[3], (DEPTH, A_VWIDTH), 0.02),
        's5_lambda_re': -0.5 + nrm(ks[4], (DEPTH, B_GROUPS, B_STATE), 0.01),
        's5_lambda_im': n_idx + nrm(ks[5], (DEPTH, B_GROUPS, B_STATE), 0.01),
        's5_log_step': jax.random.uniform(ks[6], (DEPTH, B_GROUPS), f32, math.log(S5_DT_MIN), math.log(S5_DT_MAX)),
        's5_b_re': nrm(ks[7], (DEPTH, B_GROUPS, B_STATE, B_GROUP_CH), (2.0 * B_GROUP_CH) ** -0.5),
        's5_b_im': nrm(ks[8], (DEPTH, B_GROUPS, B_STATE, B_GROUP_CH), (2.0 * B_GROUP_CH) ** -0.5),
        's5_c_re': nrm(ks[9], (DEPTH, B_GROUPS, B_GROUP_CH, B_STATE), (2.0 * B_STATE) ** -0.5),
        's5_c_im': nrm(ks[10], (DEPTH, B_GROUPS, B_GROUP_CH, B_STATE), (2.0 * B_STATE) ** -0.5),
        's5_d': nrm(ks[11], (DEPTH, B_GROUPS, B_GROUP_CH), 1.0),
        's5_w_glu': nrm(ks[12], (DEPTH, B_WIDTH, 2 * B_WIDTH), B_WIDTH ** -0.5),
        'w_up_a': nrm(ks[13], (DEPTH, A_VWIDTH, D_MODEL), BETA * A_VWIDTH ** -0.5),
        'w_up_b': nrm(ks[14], (DEPTH, B_WIDTH, D_MODEL), BETA * B_WIDTH ** -0.5),
        'w_o': nrm(ks[15], (DEPTH, D_MODEL, D_MODEL), BETA * D_MODEL ** -0.5),
        'ln1_g': 1.0 + nrm(ks[16], (DEPTH, D_MODEL), 0.02),
        'ln1_b': nrm(ks[17], (DEPTH, D_MODEL), 0.02),
        'peer_w_q': nrm(ks[18], (DEPTH, D_MODEL, P_HEADS * P_QDIM), D_MODEL ** -0.5),
        'peer_keys': nrm(ks[19], (DEPTH, P_HEADS, 2, P_NKEYS, P_HALF), P_HALF ** -0.5),
        'peer_u': nrm(ks[20], (DEPTH, P_NEXP, D_MODEL), D_MODEL ** -0.5),
        'peer_v': nrm(ks[21], (DEPTH, P_NEXP, D_MODEL), BETA * D_MODEL ** -0.5),
        'ln2_g': 1.0 + nrm(ks[22], (DEPTH, D_MODEL), 0.02),
        'ln2_b': nrm(ks[23], (DEPTH, D_MODEL), 0.02),
    }


def reference(x, w_in, hgrn_lb_logits, hgrn_norm_g, s5_lambda_re, s5_lambda_im, s5_log_step,
              s5_b_re, s5_b_im, s5_c_re, s5_c_im, s5_d, s5_w_glu, w_up_a, w_up_b, w_o,
              ln1_g, ln1_b, peer_w_q, peer_keys, peer_u, peer_v, ln2_g, ln2_b):
    lbs = hgrn2_lower_bounds(hgrn_lb_logits)
    for l in range(DEPTH):
        proj = x @ w_in[l]
        qa, fa, ia, ga, ub, gate_a, gate_b = jnp.split(proj, IN_SPLITS, axis=-1)
        oa = hgrn2_mixer(qa, fa, ia, ga, lbs[l], hgrn_norm_g[l]).astype(x.dtype)
        ob = s5_mixer(ub, s5_lambda_re[l], s5_lambda_im[l], s5_log_step[l], s5_b_re[l], s5_b_im[l],
                      s5_c_re[l], s5_c_im[l], s5_d[l], s5_w_glu[l]).astype(x.dtype)
        merged = (jax.nn.sigmoid(gate_a) * (oa @ w_up_a[l])
                  + jax.nn.sigmoid(gate_b) * (ob @ w_up_b[l]))
        x = layer_norm(ALPHA * x + merged @ w_o[l], ln1_g[l], ln1_b[l])
        y = peer_ffn(x, peer_w_q[l], peer_keys[l], peer_u[l], peer_v[l])
        x = layer_norm(ALPHA * x + y, ln2_g[l], ln2_b[l])
    return x
```

```cpp
#include <hip/hip_runtime.h>
#include <cstdio>
#include <cstdint>

#define LAS __attribute__((address_space(3)))
#define GAS __attribute__((address_space(1)))
typedef unsigned short bf16;
typedef unsigned v4u __attribute__((ext_vector_type(4)));
typedef unsigned v2u __attribute__((ext_vector_type(2)));
typedef float f32x4 __attribute__((ext_vector_type(4)));
typedef float f32x2 __attribute__((ext_vector_type(2)));
typedef short bf16x8 __attribute__((ext_vector_type(8)));
typedef short s16x4 __attribute__((ext_vector_type(4)));

#ifndef ONE_LAUNCH
#define ONE_LAUNCH 1
#endif

constexpr int T = 8192, D = 2048, DEPTH = 4, NIN = 9216;
constexpr int AW = 1024;
constexpr int NCH = 128;
constexpr float ALPHA = 1.6817928305074290f;
constexpr float LN_EPS = 1e-5f, RMS_EPS = 1e-6f;
constexpr int NEXP = 16384;
constexpr int LP = 160;
constexpr int NSLOT = 24;

constexpr size_t MiB = 1u << 20;
constexpr size_t WS_CTL = 0, CTL_ZERO_BYTES = 32768;
constexpr size_t WS_WIN  = 1 * MiB;
constexpr size_t WS_WGLU = WS_WIN + 144 * MiB;
constexpr size_t WS_WUP  = WS_WGLU + 16 * MiB;
constexpr size_t WS_WO   = WS_WUP + 32 * MiB;
constexpr size_t WS_WQB  = WS_WO + 32 * MiB;
constexpr size_t WS_BK   = WS_WQB + 32 * MiB;
constexpr size_t WS_WPQ  = WS_BK + 4 * MiB;
constexpr size_t WS_LB   = WS_WPQ + 32 * MiB;
constexpr size_t WS_APOW = WS_LB + 1 * MiB;
constexpr size_t WS_BB   = WS_APOW + 9 * MiB;
constexpr size_t WS_KMAT = WS_BB + 2 * MiB;
constexpr size_t WS_PM   = WS_KMAT + 9 * MiB;
constexpr size_t WS_E    = WS_PM + 64 * MiB;
constexpr size_t WS_X32  = WS_E + 64 * MiB;
constexpr size_t WS_X1   = WS_X32 + 64 * MiB;
constexpr size_t WS_XB   = WS_X1 + 64 * MiB;
constexpr size_t WS_Q    = WS_XB + 32 * MiB;
constexpr size_t WS_KK   = WS_Q + 16 * MiB;
constexpr size_t WS_V    = WS_KK + 16 * MiB;
constexpr size_t WS_SG   = WS_V + 16 * MiB;
constexpr size_t WS_UB   = WS_SG + 16 * MiB;
constexpr size_t WS_LOGF = WS_UB + 16 * MiB;
constexpr size_t WS_GR   = WS_LOGF + 32 * MiB;
constexpr size_t WS_GB   = WS_GR + 32 * MiB;
constexpr size_t WS_U    = WS_GB + 32 * MiB;
constexpr size_t WS_SP   = WS_U + 64 * MiB;
constexpr size_t WS_BL   = WS_SP + 32 * MiB;
constexpr size_t WS_XLOC = WS_BL + 1 * MiB;
constexpr size_t WS_XS   = WS_XLOC + 4 * MiB;
constexpr size_t WS_OAB  = WS_XS + 4 * MiB;
constexpr size_t WS_YB   = WS_OAB + 32 * MiB;
constexpr size_t WS_MG   = WS_YB + 16 * MiB;
constexpr size_t WS_R    = WS_MG + 32 * MiB;
constexpr size_t WS_SC   = WS_R + 64 * MiB;
constexpr size_t WS_TBU  = WS_SC + 64 * MiB;
constexpr size_t WS_TBV  = WS_TBU + 256 * MiB;
constexpr size_t WS_SEID = WS_TBV + 256 * MiB;
constexpr size_t WS_SGATE= WS_SEID + 6 * MiB;
constexpr size_t WS_PACK = WS_SGATE + 4 * MiB;
constexpr size_t WS_START= WS_PACK + 6 * MiB;
constexpr size_t WS_PACK2= WS_START + 1 * MiB;
constexpr size_t WS_XBS  = WS_PACK2 + 13 * MiB;
constexpr size_t WS_END  = WS_XBS + 32 * MiB;
constexpr size_t WS_XH = WS_XBS;
constexpr size_t WS_RH = WS_R;

constexpr int CW_TMO = 0, CW_CODE = 1;
constexpr int CW_BAR = 4096;

constexpr int RING_BYTES = 131072;
constexpr int LDSCTL_OFF = RING_BYTES, MISC_OFF = LDSCTL_OFF + 320;
constexpr int LDS_BYTES = 147456;

#define LDS_WAIT() asm volatile("s_waitcnt lgkmcnt(0)" ::: "memory")
#define VM_WAIT() asm volatile("s_waitcnt vmcnt(0)" ::: "memory")
__device__ __forceinline__ unsigned cvt_pk_bf16(float lo, float hi) { unsigned r; asm volatile("v_cvt_pk_bf16_f32 %0, %1, %2" : "=v"(r) : "v"(lo), "v"(hi)); return r; }
typedef _Float16 h2_t __attribute__((ext_vector_type(2)));
__device__ __forceinline__ unsigned cvt_pk_f16a(float lo, float hi) { unsigned r; asm volatile("v_cvt_pk_f16_f32 %0, %1, %2" : "=v"(r) : "v"(lo), "v"(hi)); return r; }
__device__ __forceinline__ unsigned cvt_pk_f16(float lo, float hi) { h2_t p; p.x = (_Float16)lo; p.y = (_Float16)hi; return __builtin_bit_cast(unsigned, p); }
__device__ __forceinline__ float dot2h(unsigned a, unsigned b, float c) { return __builtin_amdgcn_fdot2(__builtin_bit_cast(h2_t, a), __builtin_bit_cast(h2_t, b), c, false); }
__device__ __forceinline__ unsigned pkfmah(unsigned a, unsigned b, unsigned c) { return __builtin_bit_cast(unsigned, __builtin_elementwise_fma(__builtin_bit_cast(h2_t, a), __builtin_bit_cast(h2_t, b), __builtin_bit_cast(h2_t, c))); }
__device__ __forceinline__ float bf_lo(unsigned u) { return __uint_as_float(u << 16); }
__device__ __forceinline__ float bf_hi(unsigned u) { return __uint_as_float(u & 0xffff0000u); }
__device__ __forceinline__ float bf2f(bf16 b) { return __uint_as_float(((unsigned)b) << 16); }
__device__ __forceinline__ bf16 f2bf(float f) { return (bf16)(cvt_pk_bf16(f, 0.f) & 0xffffu); }
__device__ __forceinline__ float fexp(float x) { return __builtin_amdgcn_exp2f(x * 1.4426950408889634f); }
__device__ __forceinline__ float flog(float x) { return __builtin_amdgcn_logf(x) * 0.6931471805599453f; }
__device__ __forceinline__ float frcp(float x) { return __builtin_amdgcn_rcpf(x); }
__device__ __forceinline__ float gelu_tanh(float x) {
    const float u = 1.5957691216057308f * (x + 0.044715f * x * x * x);
    const float uc = fminf(fmaxf(u, -60.f), 60.f);
    return x * frcp(1.f + fexp(-uc));
}
__device__ __forceinline__ int lane_id() { int r; asm volatile("v_mbcnt_lo_u32_b32 %0, -1, 0\n\tv_mbcnt_hi_u32_b32 %0, -1, %0" : "=v"(r)); return r; }
__device__ __forceinline__ float wave_sum(float v) {
#pragma unroll
    for (int o = 1; o < 64; o <<= 1) v += __shfl_xor(v, o);
    return v;
}

__device__ __forceinline__ void vlaunder(int& a, int& b) { asm volatile("" : "+v"(a), "+v"(b)); }
template <class P> __device__ __forceinline__ P* opq(P* p) { asm volatile("" : "+s"(p)); return p; }
__device__ __forceinline__ unsigned char* opqg(unsigned char* p) { GAS unsigned char* g = (GAS unsigned char*)p; asm volatile("" : "+s"(g)); return (unsigned char*)g; }
#define GP(T, p) ((T*)(GAS T*)(p))

namespace pg8 {
#define PG8_LAS __attribute__((address_space(3)))
typedef unsigned short bf16_t;
constexpr int BM = 256, BK = 64, HALF = 128, HTB = HALF * BK * 2, STAGE_BYTES = 8 * HTB, NXCD = 8, WGM = 8;

__host__ __device__ __forceinline__ int lds_byte(int r, int c) { const int st = (r >> 4) * 2 + (c >> 5), rr = r & 15, cc = c & 31, ob = rr * 64 + cc * 2; return st * 1024 + (ob ^ (((ob >> 9) & 1) << 5)); }
__host__ __device__ __forceinline__ void stage_rc(int b, int& R, int& C) { const int st = b / 1024, sb = b % 1024, swz = sb ^ (((sb >> 9) & 1) << 5); R = (st >> 1) * 16 + swz / 64; C = (st & 1) * 32 + (swz % 64) / 2; }
__host__ __device__ __forceinline__ int perm32(int rho) { const int n = rho >> 4, i = rho & 15; return 8 * (i >> 2) + 4 * n + (i & 3); }

struct Unit { int pm, pn; };
struct Gemm { const bf16_t* A; const bf16_t* Bt; int M, N, K, lda, ldb, bkoff; long blstride; };

struct StaticOrder {
    int nM, nN, nwg, G, c;
    __host__ __device__ void init(int M, int N, int G_, int c_) { nM = M / BM; nN = N / BM; nwg = nM * nN; G = G_; c = c_; }
    __host__ __device__ bool next(int i, Unit& u) const {
        const long L = (long)i * G + c; if (L >= nwg) return false;
        int wgid = (int)L; { const int q = nwg / NXCD, r = nwg % NXCD, xcd = wgid % NXCD, off = wgid / NXCD; wgid = (xcd < r ? xcd * (q + 1) : r * (q + 1) + (xcd - r) * q) + off; }
        const int nig = WGM * nN, gid = wgid / nig, fm = gid * WGM, gsz = (nM - fm) < WGM ? (nM - fm) : WGM;
        u.pm = fm + ((wgid % nig) % gsz); u.pn = (wgid % nig) / gsz; return true;
    }
    __device__ __forceinline__ void a_ready(const Unit&) const {}
    __device__ __forceinline__ void done(const Unit&) const {}
};

struct OffOrder {
    StaticOrder b; int pn0;
    __device__ void init(int M, int N, int G_, int c_, int pn0_) { b.init(M, N, G_, c_); pn0 = pn0_; }
    __device__ bool next(int i, Unit& u) const { if (!b.next(i, u)) return false; u.pn += pn0; return true; }
    __device__ __forceinline__ void a_ready(const Unit&) const {}
    __device__ __forceinline__ void done(const Unit&) const {}
};
struct PairOrder {
    int c, c0, nN, nwg;
    __device__ bool next(int i, Unit& u) const { if (c < c0 || i >= 2) return false; const int id = (c - c0) * 2 + i; if (id >= nwg) return false; u.pm = id / nN; u.pn = id % nN; return true; }
    __device__ __forceinline__ void a_ready(const Unit&) const {}
    __device__ __forceinline__ void done(const Unit&) const {}
};
typedef f32x4 Acc[2][2][4][2];

typedef _Float16 f16x8 __attribute__((ext_vector_type(8)));
template <class Epi, class Sched, bool ALIGN_EPI = false, bool F16 = false, bool ASL = false>
__device__ __forceinline__ void gemm_phase(PG8_LAS unsigned char* lds, const Gemm g, const Sched& S, const Epi& E, int wv) {
    int tid_ = wv * 64 + lane_id(); asm volatile("" : "+v"(tid_));
    const int tid = tid_, wid = __builtin_amdgcn_readfirstlane(tid >> 6), lane = tid & 63, wr = wid >> 2, wc = wid & 3, fr = lane & 15, fq = lane >> 4;
    const int K = g.K, nt = K / BK;
    unsigned voffA[2], voffB[2];
#pragma unroll
    for (int i = 0; i < 2; ++i) { int R, C; stage_rc(tid * 16 + i * 8192, R, C); const int Rb = Epi::PERM ? ((R & ~31) + perm32(R & 31)) : R;
        voffA[i] = ASL ? (unsigned)(((C >> 5) * g.lda + R) * 64 + (C & 31) * 2) : (unsigned)(R * g.lda + C) * 2u; voffB[i] = (unsigned)(Rb * g.ldb + C) * 2u; }
    const size_t kstep = (size_t)(BK * 2), kstepA = ASL ? (size_t)g.lda * 128 : (size_t)(BK * 2);
    const size_t hstepA = ASL ? (size_t)HALF * 64 : (size_t)HALF * g.lda * 2, hstepB = (size_t)HALF * g.ldb * 2;
    const size_t tstepA = 2 * hstepA, tstepB = 2 * hstepB;
    const unsigned ldsw = (unsigned)wid * 1024u;
    const int aoff = lds_byte(wr * 64 + fr, fq * 8), boff = lds_byte(wc * 32 + fr, fq * 8);
#define PG8_SA(b, h) (((b) * 2 + (h)) * HTB)
#define PG8_SB(b, h) ((4 + (b) * 2 + (h)) * HTB)
#define PG8_STAGE(bufoff, gbase, voff) do { _Pragma("unroll") for (int _i = 0; _i < 2; ++_i) \
        __builtin_amdgcn_global_load_lds((const unsigned*)((const char*)(gbase) + (voff)[_i]), (PG8_LAS unsigned*)(lds + (bufoff) + ldsw + _i * 8192), 16, 0, 0); } while (0)
#define PG8_LDA(dst, b, h) do { _Pragma("unroll") for (int m = 0; m < 4; ++m) _Pragma("unroll") for (int k = 0; k < 2; ++k) dst[m][k] = *(const PG8_LAS bf16x8*)(lds + PG8_SA(b, h) + aoff + m * 2048 + k * 1024); } while (0)
#define PG8_LDB(dst, b, h) do { _Pragma("unroll") for (int n = 0; n < 2; ++n) _Pragma("unroll") for (int k = 0; k < 2; ++k) dst[n][k] = *(const PG8_LAS bf16x8*)(lds + PG8_SB(b, h) + boff + n * 2048 + k * 1024); } while (0)
#define PG8_MMA(ai, bj, At, Bt) do { __builtin_amdgcn_s_setprio(1); _Pragma("unroll") for (int m = 0; m < 4; ++m) _Pragma("unroll") for (int n = 0; n < 2; ++n) _Pragma("unroll") for (int k = 0; k < 2; ++k) \
        { if constexpr (F16) acc[ai][bj][m][n] = __builtin_amdgcn_mfma_f32_16x16x32_f16(__builtin_bit_cast(f16x8, Bt[n][k]), __builtin_bit_cast(f16x8, At[m][k]), acc[ai][bj][m][n], 0, 0, 0); \
          else acc[ai][bj][m][n] = __builtin_amdgcn_mfma_f32_16x16x32_bf16(Bt[n][k], At[m][k], acc[ai][bj][m][n], 0, 0, 0); } __builtin_amdgcn_s_setprio(0); } while (0)
#define PG8_WAIT_V(n) asm volatile("s_waitcnt vmcnt(" #n ")" ::: "memory")
#define PG8_WAIT_L(n) asm volatile("s_waitcnt lgkmcnt(" #n ")" ::: "memory")
#define PG8_BAR __builtin_amdgcn_s_barrier()
#define PG8_SCHED __builtin_amdgcn_sched_barrier(0)
    Unit cur, nxt; int ui = 0;
    if (!S.next(0, cur)) return;
    Acc acc;
#pragma unroll
    for (int a = 0; a < 2; ++a)
#pragma unroll
        for (int b = 0; b < 2; ++b)
#pragma unroll
            for (int m = 0; m < 4; ++m)
#pragma unroll
                for (int n = 0; n < 2; ++n) acc[a][b][m][n] = (f32x4){0.f, 0.f, 0.f, 0.f};
    bf16x8 At[4][2], B0[2][2], B1[2][2];
    const char* cA = (const char*)g.A + (size_t)cur.pm * tstepA;
    const char* cB = (const char*)g.Bt + (size_t)cur.pn * tstepB + ((size_t)(cur.pm & 7) * g.bkoff + (size_t)(cur.pm >> 3) * g.blstride) * 2;
    S.a_ready(cur);
    PG8_STAGE(PG8_SB(0, 0), cB, voffB); PG8_STAGE(PG8_SB(0, 1), cB + hstepB, voffB); PG8_STAGE(PG8_SA(0, 0), cA, voffA); PG8_STAGE(PG8_SA(0, 1), cA + hstepA, voffA);
    if (wr == 1) PG8_BAR;
    PG8_WAIT_V(2); PG8_BAR;
    PG8_STAGE(PG8_SB(1, 0), cB + kstep, voffB); PG8_STAGE(PG8_SA(1, 0), cA + kstepA, voffA); PG8_STAGE(PG8_SB(1, 1), cB + hstepB + kstep, voffB);
    PG8_WAIT_V(6); PG8_BAR;
    for (;;) {
        const bool has_next = S.next(ui + 1, nxt);
        const char* nA = has_next ? (const char*)g.A + (size_t)nxt.pm * tstepA : cA;
        const char* nB = has_next ? (const char*)g.Bt + (size_t)nxt.pn * tstepB + ((size_t)(nxt.pm & 7) * g.bkoff + (size_t)(nxt.pm >> 3) * g.blstride) * 2 : cB;
        for (int t = 0; t < nt; t += 2) {
            const bool last = (t == nt - 2);
            const char* a1 = cA + (size_t)(t + 1) * kstepA;
            const char* a2 = last ? nA : cA + (size_t)(t + 2) * kstepA; const char* b2 = last ? nB : cB + (size_t)(t + 2) * kstep;
            const char* a3 = a2 + kstepA; const char* b3 = b2 + kstep;
            if (last && has_next) S.a_ready(nxt);
            PG8_LDB(B0, 0, 0); PG8_LDB(B1, 0, 1); PG8_SCHED; PG8_LDA(At, 0, 0); PG8_STAGE(PG8_SA(1, 1), a1 + hstepA, voffA);
            PG8_WAIT_V(8); PG8_WAIT_L(0); PG8_BAR; PG8_MMA(0, 0, At, B0); PG8_MMA(0, 1, At, B1); PG8_BAR; PG8_SCHED;
            PG8_LDA(At, 0, 1); PG8_STAGE(PG8_SB(0, 0), b2, voffB); PG8_STAGE(PG8_SB(0, 1), b2 + hstepB, voffB); PG8_STAGE(PG8_SA(0, 0), a2, voffA);
            PG8_WAIT_V(8); PG8_WAIT_L(0); PG8_BAR; PG8_MMA(1, 0, At, B0); PG8_MMA(1, 1, At, B1); PG8_BAR; PG8_SCHED;
            PG8_LDB(B0, 1, 0); PG8_LDB(B1, 1, 1); PG8_SCHED; PG8_LDA(At, 1, 0); PG8_STAGE(PG8_SA(0, 1), a2 + hstepA, voffA);
            PG8_WAIT_V(8); PG8_WAIT_L(0); PG8_BAR; PG8_MMA(0, 0, At, B0); PG8_MMA(0, 1, At, B1); PG8_BAR; PG8_SCHED;
            PG8_LDA(At, 1, 1); PG8_STAGE(PG8_SB(1, 0), b3, voffB); PG8_STAGE(PG8_SB(1, 1), b3 + hstepB, voffB); PG8_STAGE(PG8_SA(1, 0), a3, voffA);
            PG8_WAIT_V(8); PG8_WAIT_L(0); PG8_BAR; PG8_MMA(1, 0, At, B0); PG8_MMA(1, 1, At, B1); PG8_BAR; PG8_SCHED;
            if constexpr (Epi::HAS_MID) { if (t + 2 == (nt >> 1)) E.mid(acc, cur, wr, wc, fr, fq); }
        }
        if constexpr (ALIGN_EPI) { if (wr == 0) PG8_BAR; }
        E(acc, cur, wr, wc, fr, fq); S.done(cur);
        if (!has_next) break;
#pragma unroll
        for (int a = 0; a < 2; ++a)
#pragma unroll
            for (int b = 0; b < 2; ++b)
#pragma unroll
                for (int m = 0; m < 4; ++m)
#pragma unroll
                    for (int n = 0; n < 2; ++n) acc[a][b][m][n] = (f32x4){0.f, 0.f, 0.f, 0.f};
        cur = nxt; cA = nA; cB = nB; ++ui;
        if constexpr (ALIGN_EPI) { if (wr == 1) PG8_BAR; }
    }
    PG8_WAIT_V(0);
    if constexpr (!ALIGN_EPI) { if (wr == 0) PG8_BAR; }
    PG8_BAR;
#undef PG8_SA
#undef PG8_SB
#undef PG8_STAGE
#undef PG8_LDA
#undef PG8_LDB
#undef PG8_MMA
#undef PG8_WAIT_V
#undef PG8_WAIT_L
#undef PG8_BAR
#undef PG8_SCHED
}

struct EpiResH {
    static constexpr bool PERM = true, HAS_MID = false;
    bf16_t* RS; const bf16_t* XS;
    __device__ __forceinline__ void operator()(const Acc& acc, const Unit& u, int wr, int wc, int fr, int fq) const {
        vlaunder(fr, fq);
        const int row0 = u.pm * BM + wr * 64 + fr, sl0 = u.pn * 8 + wc;
#pragma unroll
        for (int ai = 0; ai < 2; ++ai)
#pragma unroll
            for (int m = 0; m < 4; ++m) {
#pragma unroll
                for (int bj = 0; bj < 2; ++bj) { const size_t eo = ((size_t)(sl0 + bj * 4) * T + (row0 + ai * HALF + m * 16)) * 32 + 8 * fq;
                    const v4u xw = *(const v4u*)(XS + eo); const f32x4 v0 = acc[ai][bj][m][0], v1 = acc[ai][bj][m][1];
                    const unsigned a0 = xw.x, a1 = xw.y, a2 = xw.z, a3 = xw.w;
                    const h2_t x0 = __builtin_bit_cast(h2_t, a0), x1 = __builtin_bit_cast(h2_t, a1), x2 = __builtin_bit_cast(h2_t, a2), x3 = __builtin_bit_cast(h2_t, a3);
                    v4u w; w.x = cvt_pk_f16a(v0[0] + ALPHA * (float)x0.x, v0[1] + ALPHA * (float)x0.y); w.y = cvt_pk_f16a(v0[2] + ALPHA * (float)x1.x, v0[3] + ALPHA * (float)x1.y);
                    w.z = cvt_pk_f16a(v1[0] + ALPHA * (float)x2.x, v1[1] + ALPHA * (float)x2.y); w.w = cvt_pk_f16a(v1[2] + ALPHA * (float)x3.x, v1[3] + ALPHA * (float)x3.y);
                    *(v4u*)(RS + eo) = w; } }
    }
};
struct EpiF16 {
    static constexpr bool PERM = true, HAS_MID = false;
    bf16_t* O; int ldc;
    __device__ __forceinline__ void operator()(const Acc& acc, const Unit& u, int wr, int wc, int fr, int fq) const {
        vlaunder(fr, fq);
        const int row0 = u.pm * BM + wr * 64 + fr, col0 = u.pn * BM + wc * 32 + 8 * fq;
#pragma unroll
        for (int ai = 0; ai < 2; ++ai)
#pragma unroll
            for (int m = 0; m < 4; ++m) { bf16_t* rowp = O + (size_t)(row0 + ai * HALF + m * 16) * ldc + col0;
#pragma unroll
                for (int bj = 0; bj < 2; ++bj) { const f32x4 v0 = acc[ai][bj][m][0], v1 = acc[ai][bj][m][1];
                    v4u w; w.x = cvt_pk_f16a(v0[0], v0[1]); w.y = cvt_pk_f16a(v0[2], v0[3]); w.z = cvt_pk_f16a(v1[0], v1[1]); w.w = cvt_pk_f16a(v1[2], v1[3]);
                    *(v4u*)(rowp + bj * HALF) = w; } }
    }
};
struct EpiBf16 {
    static constexpr bool PERM = true, HAS_MID = false;
    bf16_t* O; int ldc;
    __device__ __forceinline__ void operator()(const Acc& acc, const Unit& u, int wr, int wc, int fr, int fq) const {
        vlaunder(fr, fq);
        const int row0 = u.pm * BM + wr * 64 + fr, col0 = u.pn * BM + wc * 32 + 8 * fq;
#pragma unroll
        for (int ai = 0; ai < 2; ++ai)
#pragma unroll
            for (int m = 0; m < 4; ++m) { bf16_t* rowp = O + (size_t)(row0 + ai * HALF + m * 16) * ldc + col0;
#pragma unroll
                for (int bj = 0; bj < 2; ++bj) { const f32x4 v0 = acc[ai][bj][m][0], v1 = acc[ai][bj][m][1];
                    v4u w; w.x = cvt_pk_bf16(v0[0], v0[1]); w.y = cvt_pk_bf16(v0[2], v0[3]); w.z = cvt_pk_bf16(v1[0], v1[1]); w.w = cvt_pk_bf16(v1[2], v1[3]);
                    *(v4u*)(rowp + bj * HALF) = w; } }
    }
};
struct EpiIn {
    static constexpr bool PERM = true, HAS_MID = false;
    bf16_t *Q, *KK, *V, *SG, *UB, *GR, *GB; float* LOGF; const float* lb;
    __device__ __forceinline__ void operator()(const Acc& acc, const Unit& u, int wr, int wc, int fr, int fq) const {
        vlaunder(fr, fq);
        const int row0 = u.pm * BM + wr * 64 + fr;
        const int pn = u.pn;
        if (pn >= 20) {
            const int col0 = (pn - 20) * 128 + wc * 32 + 8 * fq;
#pragma unroll
            for (int ai = 0; ai < 2; ++ai)
#pragma unroll
                for (int m = 0; m < 4; ++m) { const size_t ro = (size_t)(row0 + ai * HALF + m * 16) * 2048 + col0;
                    float rr[8], gg[8];
#pragma unroll
                    for (int n = 0; n < 2; ++n)
#pragma unroll
                        for (int x = 0; x < 4; ++x) { const float za = fminf(fmaxf(acc[ai][0][m][n][x], -30.f), 30.f), zb = fminf(fmaxf(acc[ai][1][m][n][x], -30.f), 30.f);
                            const float ea = fexp(-za), eb = fexp(-zb); gg[n * 4 + x] = frcp(1.f + eb); rr[n * 4 + x] = (1.f + eb) * frcp(1.f + ea); }
                    v4u w; w.x = cvt_pk_bf16(rr[0], rr[1]); w.y = cvt_pk_bf16(rr[2], rr[3]); w.z = cvt_pk_bf16(rr[4], rr[5]); w.w = cvt_pk_bf16(rr[6], rr[7]);
                    *(v4u*)(GR + ro) = w;
                    w.x = cvt_pk_bf16(gg[0], gg[1]); w.y = cvt_pk_bf16(gg[2], gg[3]); w.z = cvt_pk_bf16(gg[4], gg[5]); w.w = cvt_pk_bf16(gg[6], gg[7]);
                    *(v4u*)(GB + ro) = w; }
            return;
        }
        const int sec = pn >> 2, col0 = (pn & 3) * 256 + wc * 32 + 8 * fq;
        if (sec == 1) {
#pragma unroll
            for (int bj = 0; bj < 2; ++bj) {
                const f32x4 l0 = *(const f32x4*)(lb + col0 + bj * HALF), l1 = *(const f32x4*)(lb + col0 + bj * HALF + 4);
#pragma unroll
                for (int ai = 0; ai < 2; ++ai)
#pragma unroll
                    for (int m = 0; m < 4; ++m) { const size_t ro = (size_t)(row0 + ai * HALF + m * 16) * 1024 + col0 + bj * HALF;
                        float lf[8], kk[8];
#pragma unroll
                        for (int n = 0; n < 2; ++n)
#pragma unroll
                            for (int x = 0; x < 4; ++x) { const float z = fminf(fmaxf(acc[ai][bj][m][n][x], -30.f), 30.f); const float lbv = n ? l1[x] : l0[x];
                                const float e = fexp(-z), s = frcp(1.f + e); const float f = lbv + (1.f - lbv) * s;
                                lf[n * 4 + x] = flog(f); kk[n * 4 + x] = (1.f - lbv) * (e * s); }
                        *(f32x4*)(LOGF + ro) = (f32x4){lf[0], lf[1], lf[2], lf[3]}; *(f32x4*)(LOGF + ro + 4) = (f32x4){lf[4], lf[5], lf[6], lf[7]};
                        v4u w; w.x = cvt_pk_bf16(kk[0], kk[1]); w.y = cvt_pk_bf16(kk[2], kk[3]); w.z = cvt_pk_bf16(kk[4], kk[5]); w.w = cvt_pk_bf16(kk[6], kk[7]);
                        *(v4u*)(KK + ro) = w; }
            }
            return;
        }
        bf16_t* dst = sec == 0 ? Q : (sec == 2 ? V : (sec == 3 ? SG : UB));
        const bool sig = (sec == 3);
#pragma unroll
        for (int ai = 0; ai < 2; ++ai)
#pragma unroll
            for (int m = 0; m < 4; ++m) { bf16_t* rowp = dst + (size_t)(row0 + ai * HALF + m * 16) * 1024 + col0;
#pragma unroll
                for (int bj = 0; bj < 2; ++bj) { f32x4 v0 = acc[ai][bj][m][0], v1 = acc[ai][bj][m][1];
                    if (sig) {
#pragma unroll
                        for (int x = 0; x < 4; ++x) { v0[x] = frcp(1.f + fexp(-fminf(fmaxf(v0[x], -30.f), 30.f))); v1[x] = frcp(1.f + fexp(-fminf(fmaxf(v1[x], -30.f), 30.f))); } }
                    v4u w; w.x = cvt_pk_bf16(v0[0], v0[1]); w.y = cvt_pk_bf16(v0[2], v0[3]); w.z = cvt_pk_bf16(v1[0], v1[1]); w.w = cvt_pk_bf16(v1[2], v1[3]);
                    *(v4u*)(rowp + bj * HALF) = w; } }
    }
};
struct EpiGlu {
    static constexpr bool PERM = true, HAS_MID = false;
    bf16_t* O; int ldc;
    __device__ __forceinline__ void operator()(const Acc& acc, const Unit& u, int wr, int wc, int fr, int fq) const {
        vlaunder(fr, fq);
        const int row0 = u.pm * BM + wr * 64 + fr, col0 = u.pn * 128 + wc * 32 + 8 * fq;
#pragma unroll
        for (int ai = 0; ai < 2; ++ai)
#pragma unroll
            for (int m = 0; m < 4; ++m) { float o[8];
#pragma unroll
                for (int n = 0; n < 2; ++n)
#pragma unroll
                    for (int x = 0; x < 4; ++x) { const float h2 = fminf(fmaxf(acc[ai][1][m][n][x], -30.f), 30.f); o[n * 4 + x] = acc[ai][0][m][n][x] * frcp(1.f + fexp(-h2)); }
                v4u w; w.x = cvt_pk_bf16(o[0], o[1]); w.y = cvt_pk_bf16(o[2], o[3]); w.z = cvt_pk_bf16(o[4], o[5]); w.w = cvt_pk_bf16(o[6], o[7]);
                *(v4u*)(O + (size_t)(row0 + ai * HALF + m * 16) * ldc + col0) = w; }
    }
};
struct EpiUp {
    static constexpr bool PERM = true, HAS_MID = true;
    bf16_t* O; const bf16_t *GR, *GB;
    __device__ __forceinline__ void scale(Acc& acc, const bf16_t* G, const Unit& u, int wr, int wc, int fr, int fq) const {
        vlaunder(fr, fq);
        const int row0 = u.pm * BM + wr * 64 + fr, col0 = u.pn * BM + wc * 32 + 8 * fq;
#pragma unroll
        for (int ai = 0; ai < 2; ++ai)
#pragma unroll
            for (int m = 0; m < 4; ++m) {
#pragma unroll
                for (int bj = 0; bj < 2; ++bj) { const v4u w = *(const v4u*)(G + (size_t)(row0 + ai * HALF + m * 16) * 2048 + col0 + bj * HALF);
                    acc[ai][bj][m][0] *= (f32x4){bf_lo(w.x), bf_hi(w.x), bf_lo(w.y), bf_hi(w.y)};
                    acc[ai][bj][m][1] *= (f32x4){bf_lo(w.z), bf_hi(w.z), bf_lo(w.w), bf_hi(w.w)}; }
                if (m & 1) __builtin_amdgcn_sched_barrier(0); }
    }
    __device__ __forceinline__ void mid(Acc& acc, const Unit& u, int wr, int wc, int fr, int fq) const { scale(acc, GR, u, wr, wc, fr, fq); }
    __device__ __forceinline__ void operator()(Acc& acc, const Unit& u, int wr, int wc, int fr, int fq) const {
        scale(acc, GB, u, wr, wc, fr, fq);
        const int row0 = u.pm * BM + wr * 64 + fr, col0 = u.pn * BM + wc * 32 + 8 * fq;
#pragma unroll
        for (int ai = 0; ai < 2; ++ai)
#pragma unroll
            for (int m = 0; m < 4; ++m) { bf16_t* rowp = O + (size_t)(row0 + ai * HALF + m * 16) * 2048 + col0;
#pragma unroll
                for (int bj = 0; bj < 2; ++bj) { const f32x4 v0 = acc[ai][bj][m][0], v1 = acc[ai][bj][m][1];
                    v4u w; w.x = cvt_pk_bf16(v0[0], v0[1]); w.y = cvt_pk_bf16(v0[2], v0[3]); w.z = cvt_pk_bf16(v1[0], v1[1]); w.w = cvt_pk_bf16(v1[2], v1[3]);
                    *(v4u*)(rowp + bj * HALF) = w; } }
    }
};
}

#define XB_TMO      128
#define XB_XCNT(j)  (256  + 64 * (j))
#define XB_XSUB(j)  (1280 + 64 * (j))
#define XB_XGEN(j)  (2304 + 64 * (j))
#define XB_TOP      3328
#define XB_TOPGEN   3392
#define XCD_BAR_WORDS 3456
#define XB_SPIN_CAP (1u << 20)

__device__ __forceinline__ unsigned xb_ld(unsigned* p)              { return __hip_atomic_load(p, __ATOMIC_RELAXED, __HIP_MEMORY_SCOPE_AGENT); }
__device__ __forceinline__ unsigned xb_add(unsigned* p, unsigned v) { return __hip_atomic_fetch_add(p, v, __ATOMIC_RELAXED, __HIP_MEMORY_SCOPE_AGENT); }
__device__ __forceinline__ unsigned xb_xcc_id() { return (unsigned)__builtin_amdgcn_s_getreg((3 << 11) | 20) & 0xFu; }
#define XB_SPIN(cond, bar) do { unsigned _sp = 0; while (cond) { __builtin_amdgcn_s_sleep(1); \
    if ((++_sp & 255u) == 0u) { if (xb_ld(&(bar)[XB_TMO])) break; if (_sp > XB_SPIN_CAP) { atomicAdd(&(bar)[XB_TMO], 1u); break; } } } } while (0)

struct XcdBarrier { unsigned* bar; unsigned x; volatile LAS unsigned* st; };

__device__ __forceinline__ XcdBarrier xcd_barrier_post(unsigned* bar, volatile LAS unsigned* st, bool leader) {
    XcdBarrier b; b.bar = bar; b.x = xb_xcc_id(); b.st = st;
    if (leader) (void)xb_add(&bar[XB_XCNT(b.x)], 1u);
    return b;
}
__device__ __forceinline__ void xcd_barrier_complete(unsigned* bar, unsigned x, unsigned& nloc, unsigned& nx) {
    const unsigned G = gridDim.x * gridDim.y * gridDim.z;
    unsigned sum, cnt, mine, sp = 0u;
    for (;;) {
        sum = 0u; cnt = 0u; mine = 0u;
#pragma unroll
        for (unsigned j = 0; j < 16; ++j) { const unsigned c = xb_ld(&bar[XB_XCNT(j)]); sum += c; cnt += (c > 0u) ? 1u : 0u; mine = (j == x) ? c : mine; }
        if (sum == G) break;
        __builtin_amdgcn_s_sleep(1);
        if ((++sp & 255u) == 0u) { if (xb_ld(&bar[XB_TMO])) break; if (sp > XB_SPIN_CAP) { atomicAdd(&bar[XB_TMO], 1u); break; } }
    }
    nloc = mine > 0u ? mine : 1u; nx = cnt > 0u ? cnt : 1u;
}
__device__ __forceinline__ void xcd_barrier(const XcdBarrier& b, int wv) {
    asm volatile("s_waitcnt vmcnt(0)" ::: "memory");
    __syncthreads();
    if (wv == 0 && lane_id() == 0) {
        unsigned* bar = b.bar;
        __builtin_amdgcn_s_waitcnt(0);
        unsigned nloc = b.st[0], nx = b.st[1];
        if (nloc == 0u) { xcd_barrier_complete(bar, b.x, nloc, nx); b.st[0] = nloc; b.st[1] = nx; }
        const unsigned old = xb_add(&bar[XB_XSUB(b.x)], 1u);
        const unsigned gen = old / nloc;
        if (old + 1u == (gen + 1u) * nloc) {
            __builtin_amdgcn_fence(__ATOMIC_RELEASE, "agent");
            asm volatile("s_waitcnt vmcnt(0)" ::: "memory");
            const unsigned og = xb_add(&bar[XB_TOP], 1u);
            const unsigned tg = og / nx;
            if (og + 1u == (tg + 1u) * nx) xb_add(&bar[XB_TOPGEN], 1u);
            else XB_SPIN(xb_ld(&bar[XB_TOPGEN]) == tg, bar);
            __builtin_amdgcn_fence(__ATOMIC_ACQUIRE, "agent");
            xb_add(&bar[XB_XGEN(b.x)], 1u);
            asm volatile("s_waitcnt vmcnt(0)" ::: "memory");
        } else {
            XB_SPIN(xb_ld(&bar[XB_XGEN(b.x)]) == gen, bar);
            __builtin_amdgcn_fence(__ATOMIC_ACQUIRE, "agent");
            asm volatile("s_waitcnt vmcnt(0)" ::: "memory");
        }
    }
    __syncthreads();
}

struct Args { const float* in[24]; float* out; unsigned char* ws; int ph_lo, ph_hi; };
struct Frame {
    LAS unsigned char* lds;
    int tid, lane, wave, vcu, G;
    unsigned char* ws;
    const __attribute__((address_space(4))) Args* ka;
};
enum { I_X = 0, I_WIN, I_LBL, I_NG, I_LRE, I_LIM, I_LSTEP, I_BRE, I_BIM, I_CRE, I_CIM, I_SD, I_WGLU, I_WUPA, I_WUPB, I_WO, I_LN1G, I_LN1B, I_PWQ, I_PKEYS, I_PU, I_PV, I_LN2G, I_LN2B };

__device__ __forceinline__ void p0_transpose_item(const float* W, int N, bf16* WT, int dpitch, int dst_koff, int dst_row0, LAS float* scr, int k0, int n0, int lane, bool h = false) {
    { const int kr = lane >> 3, c4 = (lane & 7) * 4; f32x4 v[8];
#pragma unroll
      for (int i = 0; i < 8; ++i) v[i] = __builtin_nontemporal_load((const f32x4*)(W + (size_t)(k0 + kr + 8 * i) * N + n0 + c4));
#pragma unroll
      for (int i = 0; i < 8; ++i) { LAS float* d = scr + (kr + 8 * i) * 33 + c4; d[0] = v[i][0]; d[1] = v[i][1]; d[2] = v[i][2]; d[3] = v[i][3]; } }
    LDS_WAIT(); asm volatile("" ::: "memory");
    const int c = lane & 7;
#pragma unroll
    for (int j = 0; j < 4; ++j) { const int n = (lane >> 3) + 8 * j; const LAS float* s = scr + (8 * c) * 33 + n;
        v4u o;
        if (h) { o.x = cvt_pk_f16(s[0 * 33], s[1 * 33]); o.y = cvt_pk_f16(s[2 * 33], s[3 * 33]); o.z = cvt_pk_f16(s[4 * 33], s[5 * 33]); o.w = cvt_pk_f16(s[6 * 33], s[7 * 33]); }
        else { o.x = cvt_pk_bf16(s[0 * 33], s[1 * 33]); o.y = cvt_pk_bf16(s[2 * 33], s[3 * 33]); o.z = cvt_pk_bf16(s[4 * 33], s[5 * 33]); o.w = cvt_pk_bf16(s[6 * 33], s[7 * 33]); }
        *(v4u*)(WT + (size_t)(dst_row0 + n) * dpitch + dst_koff + k0 + 8 * c) = o; }
    LDS_WAIT(); asm volatile("" ::: "memory");
}
__device__ __forceinline__ void sincos_d(double a, double& s, double& c) {
    const double k = __builtin_rint(a * 0.63661977236758134308);
    double r = __builtin_fma(-k, 1.57079632679489655800e+00, a); r = __builtin_fma(-k, 6.12323399573676603587e-17, r);
    const double r2 = r * r;
    double sp = 1.0 / 1307674368000.0; sp = sp * r2 - 1.0 / 6227020800.0; sp = sp * r2 + 1.0 / 39916800.0; sp = sp * r2 - 1.0 / 362880.0; sp = sp * r2 + 1.0 / 5040.0; sp = sp * r2 - 1.0 / 120.0; sp = sp * r2 + 1.0 / 6.0;
    const double sr = r - r * r2 * sp;
    double cp = 1.0 / 20922789888000.0; cp = cp * r2 - 1.0 / 87178291200.0; cp = cp * r2 + 1.0 / 479001600.0; cp = cp * r2 - 1.0 / 3628800.0; cp = cp * r2 + 1.0 / 40320.0; cp = cp * r2 - 1.0 / 720.0; cp = cp * r2 + 1.0 / 24.0;
    const double cr = 1.0 - 0.5 * r2 + r2 * r2 * cp;
    const int q = ((int)k) & 3;
    s = (q == 0) ? sr : (q == 1) ? cr : (q == 2) ? -sr : -cr;
    c = (q == 0) ? cr : (q == 1) ? -sr : (q == 2) ? -cr : sr;
}
__device__ __forceinline__ double exp_d(double x) {
    const double k = __builtin_rint(x * 1.44269504088896340736);
    const double r = __builtin_fma(-k, 6.93147180369123816490e-01, x) - k * 1.90821492927058770002e-10;
    double p = 1.0 / 6227020800.0;
    p = p * r + 1.0 / 479001600.0; p = p * r + 1.0 / 39916800.0; p = p * r + 1.0 / 3628800.0; p = p * r + 1.0 / 362880.0; p = p * r + 1.0 / 40320.0; p = p * r + 1.0 / 5040.0;
    p = p * r + 1.0 / 720.0; p = p * r + 1.0 / 120.0; p = p * r + 1.0 / 24.0; p = p * r + 1.0 / 6.0; p = p * r + 0.5; p = p * r + 1.0; p = p * r + 1.0;
    const long long e = (long long)k + 1023; double sc = __builtin_bit_cast(double, (unsigned long long)(e << 52));
    return p * sc;
}

__device__ __forceinline__ void phase_prologue_a(const Frame& F0) {
    Frame F = F0; F.tid = F.wave * 64 + lane_id(); asm volatile("" : "+v"(F.tid)); F.lane = F.tid & 63;
    unsigned char* ws = opqg(F.ws); const __attribute__((address_space(4))) Args* a = opq(F.ka);
    LAS float* scr = (LAS float*)(F.lds + F.wave * 16384);
    const int gw = F.vcu * 8 + F.wave, NGW = F.G * 8;
    constexpr int I_IN = 32 * 288, I_GLU = 16 * 64, I_UP = 16 * 64, I_O = 32 * 64, I_L = I_IN + I_GLU + 2 * I_UP + I_O;
    for (int it = gw; it < DEPTH * I_L; it += NGW) {
        const int l = it / I_L; int r = it % I_L;
        if (r < I_IN) { const int kb = r / 288, nb = r % 288, n0 = nb * 32; int dr;
            if (n0 < 5120) dr = n0; else if (n0 < 7168) { const int j = n0 - 5120; dr = 5120 + (j >> 7) * 256 + (j & 127); } else { const int j = n0 - 7168; dr = 5120 + (j >> 7) * 256 + 128 + (j & 127); }
            p0_transpose_item(GP(const float, a->in[I_WIN]) + (size_t)l * D * NIN, NIN, (bf16*)(ws + WS_WIN) + (size_t)l * NIN * D, D, 0, dr, scr, kb * 64, n0, F.lane, true); continue; }
        r -= I_IN;
        if (r < I_GLU) { const int kb = r / 64, nb = r % 64, n0 = nb * 32; int dr;
            if (n0 < 1024) dr = (n0 >> 7) * 256 + (n0 & 127); else { const int j = n0 - 1024; dr = (j >> 7) * 256 + 128 + (j & 127); }
            p0_transpose_item(GP(const float, a->in[I_WGLU]) + (size_t)l * 1024 * 2048, 2048, (bf16*)(ws + WS_WGLU) + (size_t)l * 2048 * 1024, 1024, 0, dr, scr, kb * 64, n0, F.lane); continue; }
        r -= I_GLU;
        if (r < I_UP) { const int kb = r / 64, nb = r % 64;
            p0_transpose_item(GP(const float, a->in[I_WUPA]) + (size_t)l * 1024 * 2048, 2048, (bf16*)(ws + WS_WUP) + (size_t)l * 2048 * 2048, 2048, 0, nb * 32, scr, kb * 64, nb * 32, F.lane); continue; }
        r -= I_UP;
        if (r < I_UP) { const int kb = r / 64, nb = r % 64;
            p0_transpose_item(GP(const float, a->in[I_WUPB]) + (size_t)l * 1024 * 2048, 2048, (bf16*)(ws + WS_WUP) + (size_t)l * 2048 * 2048, 2048, 1024, nb * 32, scr, kb * 64, nb * 32, F.lane); continue; }
        r -= I_UP;
        { const int kb = r / 64, nb = r % 64;
            p0_transpose_item(GP(const float, a->in[I_WO]) + (size_t)l * 2048 * 2048, 2048, (bf16*)(ws + WS_WO) + (size_t)l * 2048 * 2048, 2048, 0, nb * 32, scr, kb * 64, nb * 32, F.lane); }
    }
    const size_t gt = (size_t)F.vcu * 512 + F.tid, NT = (size_t)F.G * 512;
    { const float* src = GP(const float, a->in[I_PWQ]); bf16* dst = (bf16*)(ws + WS_WQB);
      for (size_t i = gt; i < (size_t)DEPTH * D * D / 8; i += NT) { const f32x4 v0 = *(const f32x4*)(src + i * 8), v1 = *(const f32x4*)(src + i * 8 + 4);
          v4u w; w.x = cvt_pk_bf16(v0[0], v0[1]); w.y = cvt_pk_bf16(v0[2], v0[3]); w.z = cvt_pk_bf16(v1[0], v1[1]); w.w = cvt_pk_bf16(v1[2], v1[3]); *(v4u*)(dst + i * 8) = w; } }
    { const float* src = GP(const float, a->in[I_X]); bf16* dst = (bf16*)(ws + WS_XH);
      for (size_t i = gt; i < (size_t)T * D / 8; i += NT) { const int j = (int)(i & 3), row = (int)((i >> 2) & (T - 1)), sl = (int)(i >> 15);
          const float* sp = src + (size_t)row * D + sl * 32 + j * 8; const f32x4 v0 = *(const f32x4*)sp, v1 = *(const f32x4*)(sp + 4);
          v4u w; w.x = cvt_pk_f16(v0[0], v0[1]); w.y = cvt_pk_f16(v0[2], v0[3]); w.z = cvt_pk_f16(v1[0], v1[1]); w.w = cvt_pk_f16(v1[2], v1[3]); *(v4u*)(dst + i * 8) = w; } }
    { const float* keys = GP(const float, a->in[I_PKEYS]); bf16* dst = (bf16*)(ws + WS_BK);
      for (size_t i = gt; i < (size_t)DEPTH * 8 * 256 * 256 / 8; i += NT) { const int jj = (int)(i & 31) * 8; const int row = (int)((i >> 5) & 255); const size_t lh = i >> 13; const int half = row >> 7, n = row & 127;
          v4u w = (v4u){0u, 0u, 0u, 0u};
          if ((jj >> 7) == half) { const float* s = keys + ((lh * 2 + half) * 128 + n) * 128 + (jj & 127); const f32x4 v0 = *(const f32x4*)s, v1 = *(const f32x4*)(s + 4);
              w.x = cvt_pk_bf16(v0[0], v0[1]); w.y = cvt_pk_bf16(v0[2], v0[3]); w.z = cvt_pk_bf16(v1[0], v1[1]); w.w = cvt_pk_bf16(v1[2], v1[3]); }
          *(v4u*)(dst + i * 8) = w; } }
    if (gt < 1024) { const float* lg = GP(const float, a->in[I_LBL]); float* lbo = (float*)(ws + WS_LB); const int d = (int)gt;
        const float z0 = lg[d], z1 = lg[1024 + d], z2 = lg[2048 + d], z3 = lg[3072 + d]; const float mx = fmaxf(fmaxf(z0, z1), fmaxf(z2, z3));
        const float e0 = expf(z0 - mx), e1 = expf(z1 - mx), e2 = expf(z2 - mx), e3 = expf(z3 - mx); const float inv = 1.f / (e0 + e1 + e2 + e3);
        lbo[d] = 0.f; lbo[1024 + d] = e1 * inv; lbo[2048 + d] = (e1 + e2) * inv; lbo[3072 + d] = (e1 + e2 + e3) * inv; }
    for (size_t i = gt; i < (size_t)DEPTH * 64 * 64; i += NT) {
        const size_t lg_ = i >> 6;
        const double lr = fmin((double)GP(const float, a->in[I_LRE])[i], -1e-4), li = (double)GP(const float, a->in[I_LIM])[i], dt = exp_d((double)GP(const float, a->in[I_LSTEP])[lg_]);
        const double mag = exp_d(lr * dt); double sn, cs; sincos_d(li * dt, sn, cs);
        const double ar = mag * cs, ai = mag * sn, den = lr * lr + li * li, nr = ar - 1.0;
        const double zr = (nr * lr + ai * li) / den, zi = (ai * lr - nr * li) / den;
        const float* br = GP(const float, a->in[I_BRE]) + i * 16; const float* bi = GP(const float, a->in[I_BIM]) + i * 16; float* bb = (float*)(ws + WS_BB) + i * 32;
#pragma unroll
        for (int m = 0; m < 16; ++m) { const double b_r = br[m], b_i = bi[m]; bb[2 * m] = (float)(zr * b_r - zi * b_i); bb[2 * m + 1] = (float)(zr * b_i + zi * b_r); }
        float* ap = (float*)(ws + WS_APOW) + (lg_ * 65 * 64 + (i & 63)) * 2; double pr = 1.0, pi = 0.0;
        for (int dl = 0; dl < 65; ++dl) { ap[dl * 128] = (float)pr; ap[dl * 128 + 1] = (float)pi; const double t = pr * ar - pi * ai; pi = pr * ai + pi * ar; pr = t; }
    }
    for (int it = gw; it < 2 * DEPTH * 1024; it += NGW) {
        const int tb = it >> 12, l = (it >> 10) & 3, eb = it & 1023;
        const int pe = eb * 16 + (F.lane >> 2), i1 = (pe & 1023) >> 3, i2 = (pe & 7) * 16 + (((pe >> 10) - i1) & 15);
        const float* src = GP(const float, a->in[tb ? I_PV : I_PU]) + ((size_t)l * NEXP + i1 * 128 + i2) * D + (F.lane & 3) * 8;
        bf16* dst = (bf16*)(ws + (tb ? WS_TBV : WS_TBU)) + (size_t)l * 64 * NEXP * 32 + ((size_t)(eb * 16 + (F.lane >> 2)) * 4 + ((F.lane & 3) ^ ((F.lane >> 4) & 3))) * 8;
#pragma unroll 8
        for (int ks = 0; ks < 64; ++ks) { const f32x4 v0 = __builtin_nontemporal_load((const f32x4*)(src + ks * 32)), v1 = __builtin_nontemporal_load((const f32x4*)(src + ks * 32 + 4));
            v4u w; w.x = cvt_pk_f16(v0[0], v0[1]); w.y = cvt_pk_f16(v0[2], v0[3]); w.z = cvt_pk_f16(v1[0], v1[1]); w.w = cvt_pk_f16(v1[2], v1[3]);
            *(v4u*)(dst + (size_t)ks * NEXP * 32) = w; }
    }
}
__device__ __forceinline__ double dummy_unused_(double x) { return x; }

__device__ __forceinline__ void phase_prologue_b(const Frame& F0) {
    Frame F = F0; F.tid = F.wave * 64 + lane_id(); asm volatile("" : "+v"(F.tid)); F.lane = F.tid & 63;
    unsigned char* ws = opqg(F.ws); const __attribute__((address_space(4))) Args* a = opq(F.ka);
    const float* APOW = (const float*)(ws + WS_APOW); const float* BB = (const float*)(ws + WS_BB);
    LAS float* AP = (LAS float*)(F.lds); LAS float* BL = (LAS float*)(F.lds + 33280); LAS float* CR = (LAS float*)(F.lds + 41472); LAS float* CI = (LAS float*)(F.lds + 45568); LAS float* SDL = (LAS float*)(F.lds + 49664);
    bf16* KM = (bf16*)(ws + WS_KMAT); bf16* PM = (bf16*)(ws + WS_PM); bf16* E = (bf16*)(ws + WS_E);
    for (int lg = F.vcu; lg < DEPTH * 64; lg += F.G) {
        for (int i = F.tid; i < 65 * 64 * 2 / 4; i += 512) ((LAS f32x4*)AP)[i] = ((const f32x4*)(APOW + (size_t)lg * 65 * 128))[i];
        ((LAS f32x4*)BL)[F.tid] = ((const f32x4*)(BB + (size_t)lg * 2048))[F.tid];
        if (F.tid < 256) ((LAS f32x4*)CR)[F.tid] = ((const f32x4*)(GP(const float, a->in[I_CRE]) + (size_t)lg * 1024))[F.tid];
        else ((LAS f32x4*)CI)[F.tid - 256] = ((const f32x4*)(GP(const float, a->in[I_CIM]) + (size_t)lg * 1024))[F.tid - 256];
        if (F.tid < 16) SDL[F.tid] = GP(const float, a->in[I_SD])[lg * 16 + F.tid];
        __syncthreads();
        for (int task = F.tid; task < 65 * 16; task += 512) {
            const int n = task & 15, idx = task >> 4;
            float sm[16];
#pragma unroll
            for (int m = 0; m < 16; ++m) sm[m] = 0.f;
            if (idx > 0) { const int dl = idx - 1;
#pragma unroll 4
                for (int p = 0; p < 64; ++p) { const f32x2 av = *(const LAS f32x2*)(AP + (dl * 64 + p) * 2); const float c_r = CR[n * 64 + p], c_i = CI[n * 64 + p];
                    const float car = c_r * av[0] - c_i * av[1], cai = c_r * av[1] + c_i * av[0];
#pragma unroll
                    for (int q = 0; q < 8; ++q) { const f32x4 b4 = *(const LAS f32x4*)(BL + p * 32 + q * 4); sm[2 * q] += car * b4[0] - cai * b4[1]; sm[2 * q + 1] += car * b4[2] - cai * b4[3]; } }
                if (dl == 0) { const float dv = SDL[n];
#pragma unroll
                    for (int m = 0; m < 16; ++m) sm[m] += (m == n) ? dv : 0.f; } }
            v4u w0, w1; w0.x = cvt_pk_bf16(sm[0], sm[1]); w0.y = cvt_pk_bf16(sm[2], sm[3]); w0.z = cvt_pk_bf16(sm[4], sm[5]); w0.w = cvt_pk_bf16(sm[6], sm[7]);
            w1.x = cvt_pk_bf16(sm[8], sm[9]); w1.y = cvt_pk_bf16(sm[10], sm[11]); w1.z = cvt_pk_bf16(sm[12], sm[13]); w1.w = cvt_pk_bf16(sm[14], sm[15]);
            bf16* kp = KM + ((size_t)lg * 65 * 16 + task) * 16; *(v4u*)kp = w0; *(v4u*)(kp + 8) = w1; }
        for (int it = F.tid; it < 128 * 64 * 2; it += 512) {
            const int m0 = (it & 1) * 8, sidx = (it >> 1) & 63, pp = it >> 7, p = pp & 63;
            const f32x2 av = *(const LAS f32x2*)(AP + ((63 - sidx) * 64 + p) * 2); const float pr = av[0], pi = av[1];
            float o[8];
#pragma unroll
            for (int j = 0; j < 4; ++j) { const f32x4 b4 = *(const LAS f32x4*)(BL + p * 32 + m0 * 2 + j * 4);
                o[2 * j] = (pp < 64) ? (pr * b4[0] - pi * b4[1]) : (pr * b4[1] + pi * b4[0]); o[2 * j + 1] = (pp < 64) ? (pr * b4[2] - pi * b4[3]) : (pr * b4[3] + pi * b4[2]); }
            v4u w; w.x = cvt_pk_bf16(o[0], o[1]); w.y = cvt_pk_bf16(o[2], o[3]); w.z = cvt_pk_bf16(o[4], o[5]); w.w = cvt_pk_bf16(o[6], o[7]); *(v4u*)(PM + ((size_t)lg * 16384 + it) * 8) = w; }
        for (int it = F.tid; it < 1024 * 16; it += 512) {
            const int pp0 = (it & 15) * 8, n = (it >> 4) & 15, tau = it >> 8, p0 = pp0 & 63;
            float o[8];
#pragma unroll
            for (int j = 0; j < 8; ++j) { const f32x2 av = *(const LAS f32x2*)(AP + ((tau + 1) * 64 + p0 + j) * 2); const float c_r = CR[n * 64 + p0 + j], c_i = CI[n * 64 + p0 + j];
                o[j] = (pp0 < 64) ? (c_r * av[0] - c_i * av[1]) : -(c_r * av[1] + c_i * av[0]); }
            v4u w; w.x = cvt_pk_bf16(o[0], o[1]); w.y = cvt_pk_bf16(o[2], o[3]); w.z = cvt_pk_bf16(o[4], o[5]); w.w = cvt_pk_bf16(o[6], o[7]); *(v4u*)(E + ((size_t)lg * 16384 + it) * 8) = w; }
        __syncthreads();
    }
}
constexpr int HG_BL = 0, HG_TOT = 33792, HG_VT = 35840, HG_KT = 54272, HG_RED = 72704;
constexpr int KSP = 136, HG_KS = 73728, HG_QT = HG_KS + 64 * KSP * 2, HG_QH = HG_QT + 64 * KSP * 2;
static_assert(HG_QH + 64 * KSP * 2 <= RING_BYTES, "hgrn_out LDS map");
constexpr int BLP = 132, VTP = 72;
__device__ __forceinline__ void hg_cumsum(const Frame& F, const float* LOGF, int c, int h) {
    LAS float* bL = (LAS float*)(F.lds + HG_BL); LAS float* tot = (LAS float*)(F.lds + HG_TOT);
    const int d = F.tid & 127, seg = F.tid >> 7;
    const float* src = LOGF + (size_t)(c * 64 + seg * 16) * AW + h * 128 + d;
    float lf[16];
#pragma unroll
    for (int i = 0; i < 16; ++i) lf[i] = src[(size_t)i * AW];
#pragma unroll
    for (int i = 1; i < 16; ++i) lf[i] += lf[i - 1];
    tot[seg * 128 + d] = lf[15];
    __syncthreads();
    float off = 0.f;
#pragma unroll
    for (int s2 = 0; s2 < 3; ++s2) off += (s2 < seg) ? tot[s2 * 128 + d] : 0.f;
#pragma unroll
    for (int i = 0; i < 16; ++i) bL[(seg * 16 + i) * BLP + d] = lf[i] + off;
}
__device__ __forceinline__ void hg_load_vt(const Frame& F, const bf16* V, int c, int h) {
    LAS bf16* VT = (LAS bf16*)(F.lds + HG_VT);
    const int s = F.lane, vb = F.wave * 16;
    const v4u* src = (const v4u*)(V + (size_t)(c * 64 + s) * AW + h * 128 + vb);
    const v4u w0 = src[0], w1 = src[1];
    const unsigned ww[8] = {w0.x, w0.y, w0.z, w0.w, w1.x, w1.y, w1.z, w1.w};
#pragma unroll
    for (int j = 0; j < 8; ++j) { VT[(vb + 2 * j) * VTP + s] = (bf16)(ww[j] & 0xffffu); VT[(vb + 2 * j + 1) * VTP + s] = (bf16)(ww[j] >> 16); }
}
__device__ __forceinline__ void phase_hgrn_local(const Frame& F0, int l) {
    Frame F = F0; F.tid = F.wave * 64 + lane_id(); asm volatile("" : "+v"(F.tid)); F.lane = F.tid & 63;
    unsigned char* ws = opqg(F.ws);
    const float* LOGF = (const float*)(ws + WS_LOGF); const bf16* KK = (const bf16*)(ws + WS_KK); const bf16* V = (const bf16*)(ws + WS_V);
    _Float16* U = (_Float16*)(ws + WS_U); float* BLo = (float*)(ws + WS_BL);
    LAS float* bL = (LAS float*)(F.lds + HG_BL); LAS bf16* VT = (LAS bf16*)(F.lds + HG_VT); LAS bf16* KT = (LAS bf16*)(F.lds + HG_KT);
    const int fr = F.lane & 15, fq = F.lane >> 4;
    for (int unit = F.vcu; unit < NCH * 8; unit += F.G) {
        const int c = unit >> 3, h = unit & 7;
        hg_cumsum(F, LOGF, c, h);
        hg_load_vt(F, V, c, h);
        __syncthreads();
        { const int s = F.lane, db = F.wave * 16;
          const v4u* src = (const v4u*)(KK + (size_t)(c * 64 + s) * AW + h * 128 + db);
          const v4u w0 = src[0], w1 = src[1];
          const unsigned ww[8] = {w0.x, w0.y, w0.z, w0.w, w1.x, w1.y, w1.z, w1.w};
#pragma unroll
          for (int j = 0; j < 8; ++j) {
              const float b0 = bL[s * BLP + db + 2 * j], b1 = bL[s * BLP + db + 2 * j + 1], l0 = bL[63 * BLP + db + 2 * j], l1 = bL[63 * BLP + db + 2 * j + 1];
              const unsigned pk = cvt_pk_bf16(bf_lo(ww[j]) * fexp(l0 - b0), bf_hi(ww[j]) * fexp(l1 - b1));
              KT[(db + 2 * j) * VTP + s] = (bf16)(pk & 0xffffu); KT[(db + 2 * j + 1) * VTP + s] = (bf16)(pk >> 16); } }
        if (F.tid < 128) BLo[(size_t)c * AW + h * 128 + F.tid] = bL[63 * BLP + F.tid];
        __syncthreads();
        f32x4 acc[8];
#pragma unroll
        for (int i = 0; i < 8; ++i) acc[i] = (f32x4){0.f, 0.f, 0.f, 0.f};
#pragma unroll
        for (int ks = 0; ks < 2; ++ks) {
            const bf16x8 A = *(const LAS bf16x8*)(VT + (F.wave * 16 + fr) * VTP + ks * 32 + fq * 8);
#pragma unroll
            for (int dt = 0; dt < 8; ++dt) { const bf16x8 B = *(const LAS bf16x8*)(KT + (dt * 16 + fr) * VTP + ks * 32 + fq * 8);
                acc[dt] = __builtin_amdgcn_mfma_f32_16x16x32_bf16(B, A, acc[dt], 0, 0, 0); }
        }
        _Float16* up = U + ((size_t)(c * 8 + h) * 128 + F.wave * 16 + fr) * 128 + fq * 4;
#pragma unroll
        for (int dt = 0; dt < 8; ++dt) { v2u w; w.x = cvt_pk_f16(acc[dt][0], acc[dt][1]); w.y = cvt_pk_f16(acc[dt][2], acc[dt][3]); *(v2u*)(up + dt * 16) = w; }
        __syncthreads();
    }
}
__device__ __forceinline__ void phase_scan(const Frame& F0, int l) {
    Frame F = F0; F.tid = F.wave * 64 + lane_id(); asm volatile("" : "+v"(F.tid)); F.lane = F.tid & 63;
    unsigned char* ws = opqg(F.ws);
    const _Float16* U = (const _Float16*)(ws + WS_U); const float* BLo = (const float*)(ws + WS_BL); bf16* SP = (bf16*)(ws + WS_SP);
    for (int e = F.vcu * 512 + F.tid; e < 8 * 128 * 128; e += F.G * 512) {
        const int hd = (e >> 14) * 128 + (e & 127);
        float s = 0.f;
        for (int c0 = 0; c0 < NCH; c0 += 32) {
            float u[32], bl[32];
#pragma unroll
            for (int i = 0; i < 32; ++i) { u[i] = (float)U[(size_t)(c0 + i) * 131072 + e]; bl[i] = BLo[(size_t)(c0 + i) * AW + hd]; }
#pragma unroll
            for (int i = 0; i < 32; ++i) { SP[(size_t)(c0 + i) * 131072 + e] = f2bf(s); s = s * fexp(bl[i]) + u[i]; }
        }
    }
    const float* XLOC = (const float*)(ws + WS_XLOC); float* XS = (float*)(ws + WS_XS); const float* APOW = (const float*)(ws + WS_APOW);
    for (int e = F.vcu * 512 + F.tid; e < 64 * 64; e += F.G * 512) {
        const int g = e >> 6, p = e & 63;
        const float* ap = APOW + (((size_t)(l * 64 + g) * 65 + 64) * 64 + p) * 2; const float ar = ap[0], ai = ap[1];
        float xr = 0.f, xi = 0.f;
        for (int c0 = 0; c0 < NCH; c0 += 32) {
            float lr_[32], li_[32];
#pragma unroll
            for (int i = 0; i < 32; ++i) { lr_[i] = XLOC[((size_t)(c0 + i) * 64 + g) * 128 + p]; li_[i] = XLOC[((size_t)(c0 + i) * 64 + g) * 128 + 64 + p]; }
#pragma unroll
            for (int i = 0; i < 32; ++i) { XS[((size_t)(c0 + i) * 64 + g) * 128 + p] = xr; XS[((size_t)(c0 + i) * 64 + g) * 128 + 64 + p] = xi;
                const float t = ar * xr - ai * xi + lr_[i]; xi = ar * xi + ai * xr + li_[i]; xr = t; }
        }
    }
}
__device__ __forceinline__ void phase_hgrn_out(const Frame& F0, int l) {
    Frame F = F0; F.tid = F.wave * 64 + lane_id(); asm volatile("" : "+v"(F.tid)); F.lane = F.tid & 63;
    unsigned char* ws = opqg(F.ws); const __attribute__((address_space(4))) Args* a = opq(F.ka);
    const float* LOGF = (const float*)(ws + WS_LOGF); const bf16* KK = (const bf16*)(ws + WS_KK); const bf16* V = (const bf16*)(ws + WS_V);
    const bf16* Q = (const bf16*)(ws + WS_Q); const bf16* SG = (const bf16*)(ws + WS_SG); const bf16* SP = (const bf16*)(ws + WS_SP);
    bf16* OAB = (bf16*)(ws + WS_OAB); const float* NG = GP(const float, a->in[I_NG]) + (size_t)l * AW;
    LAS float* bL = (LAS float*)(F.lds + HG_BL); LAS bf16* VT = (LAS bf16*)(F.lds + HG_VT); LAS float* red = (LAS float*)(F.lds + HG_RED);
    const int fr = F.lane & 15, fq = F.lane >> 4, tt = F.wave & 3, vh = F.wave >> 2;
    LAS float* tot = (LAS float*)(F.lds + HG_TOT);
    float lf[16]; v4u vw0, vw1, kg0, kg1, qg0, qg1;
#define HGO_PREF(u_) { const int c_ = (u_) >> 3, h_ = (u_) & 7; \
        const float* src_ = LOGF + (size_t)(c_ * 64 + (F.tid >> 7) * 16) * AW + h_ * 128 + (F.tid & 127); \
        _Pragma("unroll") for (int i = 0; i < 16; ++i) lf[i] = src_[(size_t)i * AW]; \
        const v4u* vp_ = (const v4u*)(V + (size_t)(c_ * 64 + F.lane) * AW + h_ * 128 + F.wave * 16); vw0 = vp_[0]; vw1 = vp_[1]; \
        const size_t ro_ = ((size_t)c_ * 64 + (F.tid >> 3)) * AW + h_ * 128 + (F.tid & 7) * 16; \
        const v4u* kp_ = (const v4u*)(KK + ro_); const v4u* qp_ = (const v4u*)(Q + ro_); kg0 = kp_[0]; kg1 = kp_[1]; qg0 = qp_[0]; qg1 = qp_[1]; }
    if (F.vcu < NCH * 8) HGO_PREF(F.vcu)
    for (int unit = F.vcu; unit < NCH * 8; unit += F.G) {
        const int c = unit >> 3, h = unit & 7;
        { const int d = F.tid & 127, seg = F.tid >> 7;
#pragma unroll
          for (int i = 1; i < 16; ++i) lf[i] += lf[i - 1];
          tot[seg * 128 + d] = lf[15];
          { const int s = F.lane, vb = F.wave * 16; const unsigned ww[8] = {vw0.x, vw0.y, vw0.z, vw0.w, vw1.x, vw1.y, vw1.z, vw1.w};
#pragma unroll
            for (int j = 0; j < 8; ++j) { VT[(vb + 2 * j) * VTP + s] = (bf16)(ww[j] & 0xffffu); VT[(vb + 2 * j + 1) * VTP + s] = (bf16)(ww[j] >> 16); } }
          __syncthreads();
          float off = 0.f;
#pragma unroll
          for (int s2 = 0; s2 < 3; ++s2) off += (s2 < seg) ? tot[s2 * 128 + d] : 0.f;
#pragma unroll
          for (int i = 0; i < 16; ++i) bL[(seg * 16 + i) * BLP + d] = lf[i] + off; }
        __syncthreads();
        const int t = tt * 16 + fr; const size_t tok = (size_t)c * 64 + t;
        bf16x8 sg_[2][4];
#define HG_LOAD(buf, kd_) { const int d0_ = (kd_) * 32 + fq * 8; \
            _Pragma("unroll") for (int vt = 0; vt < 4; ++vt) sg_[buf][vt] = *(const bf16x8*)(SP + ((size_t)(c * 8 + h) * 128 + (vh * 4 + vt) * 16 + fr) * 128 + d0_); }
        HG_LOAD(0, 0) HG_LOAD(1, 1)
        v2u sgw[4];
#pragma unroll
        for (int vt = 0; vt < 4; ++vt) sgw[vt] = *(const v2u*)(SG + tok * AW + h * 128 + (vh * 4 + vt) * 16 + fq * 4);
        f32x4 ngw[4];
#pragma unroll
        for (int vt = 0; vt < 4; ++vt) ngw[vt] = *(const f32x4*)(NG + h * 128 + (vh * 4 + vt) * 16 + fq * 4);
        { const int s = F.tid >> 3, dc = (F.tid & 7) * 16;
          const unsigned kq[8] = {kg0.x, kg0.y, kg0.z, kg0.w, kg1.x, kg1.y, kg1.z, kg1.w}, qq[8] = {qg0.x, qg0.y, qg0.z, qg0.w, qg1.x, qg1.y, qg1.z, qg1.w};
          unsigned ko[8], qto[8], qho[8];
#pragma unroll
          for (int j4 = 0; j4 < 4; ++j4) { const f32x4 bs = *(const LAS f32x4*)(bL + s * BLP + dc + 4 * j4), br = *(const LAS f32x4*)(bL + 31 * BLP + dc + 4 * j4);
#pragma unroll
              for (int hx = 0; hx < 2; ++hx) { const int w = 2 * j4 + hx; const float b0 = bs[2 * hx], b1 = bs[2 * hx + 1], r0 = br[2 * hx], r1 = br[2 * hx + 1];
                  const float k0 = bf_lo(kq[w]), k1 = bf_hi(kq[w]), q0 = bf_lo(qq[w]), q1 = bf_hi(qq[w]);
                  ko[w] = cvt_pk_bf16(k0 * fexp(fminf(r0 - b0, 80.f)), k1 * fexp(fminf(r1 - b1, 80.f)));
                  qto[w] = cvt_pk_bf16(q0 * fexp(fminf(b0 - r0, 80.f)), q1 * fexp(fminf(b1 - r1, 80.f)));
                  qho[w] = cvt_pk_bf16(q0 * fexp(b0), q1 * fexp(b1)); } }
          LAS v4u* kd_ = (LAS v4u*)(F.lds + HG_KS + (s * KSP + dc) * 2); kd_[0] = (v4u){ko[0], ko[1], ko[2], ko[3]}; kd_[1] = (v4u){ko[4], ko[5], ko[6], ko[7]};
          LAS v4u* qt_ = (LAS v4u*)(F.lds + HG_QT + (s * KSP + dc) * 2); qt_[0] = (v4u){qto[0], qto[1], qto[2], qto[3]}; qt_[1] = (v4u){qto[4], qto[5], qto[6], qto[7]};
          LAS v4u* qh_ = (LAS v4u*)(F.lds + HG_QH + (s * KSP + dc) * 2); qh_[0] = (v4u){qho[0], qho[1], qho[2], qho[3]}; qh_[1] = (v4u){qho[4], qho[5], qho[6], qho[7]}; }
        __syncthreads();
        f32x4 att[4], o[4];
#pragma unroll
        for (int i = 0; i < 4; ++i) { att[i] = (f32x4){0.f, 0.f, 0.f, 0.f}; o[i] = (f32x4){0.f, 0.f, 0.f, 0.f}; }
#pragma unroll
        for (int kd = 0; kd < 4; ++kd) {
            const int cb = kd & 1;
            const int fo = (kd * 32 + fq * 8) * 2;
            const bf16x8 Bqt = *(const LAS bf16x8*)(F.lds + HG_QT + (t * KSP) * 2 + fo), Bqh = *(const LAS bf16x8*)(F.lds + HG_QH + (t * KSP) * 2 + fo);
#pragma unroll
            for (int st = 0; st < 4; ++st) { const bf16x8 kt = *(const LAS bf16x8*)(F.lds + HG_KS + ((st * 16 + fr) * KSP) * 2 + fo);
                att[st] = __builtin_amdgcn_mfma_f32_16x16x32_bf16(kt, Bqt, att[st], 0, 0, 0); }
#pragma unroll
            for (int vt = 0; vt < 4; ++vt) o[vt] = __builtin_amdgcn_mfma_f32_16x16x32_bf16(sg_[cb][vt], Bqh, o[vt], 0, 0, 0);
            if (kd < 2) HG_LOAD(cb, kd + 2)
            if (kd == 1) { const int nu = (unit + F.G < NCH * 8) ? unit + F.G : unit; HGO_PREF(nu) }
        }
#undef HG_LOAD
#pragma unroll
        for (int ks = 0; ks < 2; ++ks) {
            float m8[8];
#pragma unroll
            for (int jj = 0; jj < 8; ++jj) { const int st = 2 * ks + (jj >> 2), r = jj & 3, s = st * 16 + fq * 4 + r; m8[jj] = (s <= t) ? att[st][r] : 0.f; }
            v4u pb; pb.x = cvt_pk_bf16(m8[0], m8[1]); pb.y = cvt_pk_bf16(m8[2], m8[3]); pb.z = cvt_pk_bf16(m8[4], m8[5]); pb.w = cvt_pk_bf16(m8[6], m8[7]);
            const bf16x8 B = __builtin_bit_cast(bf16x8, pb);
#pragma unroll
            for (int vt = 0; vt < 4; ++vt) { const int v = (vh * 4 + vt) * 16 + fr;
                const v2u a0 = *(const LAS v2u*)(VT + v * VTP + ks * 32 + fq * 4), a1 = *(const LAS v2u*)(VT + v * VTP + ks * 32 + 16 + fq * 4);
                const v4u pa = (v4u){a0.x, a0.y, a1.x, a1.y};
                o[vt] = __builtin_amdgcn_mfma_f32_16x16x32_bf16(__builtin_bit_cast(bf16x8, pa), B, o[vt], 0, 0, 0); }
        }
        float ss = 0.f;
#pragma unroll
        for (int vt = 0; vt < 4; ++vt)
#pragma unroll
            for (int r = 0; r < 4; ++r) ss += o[vt][r] * o[vt][r];
        ss += __shfl_xor(ss, 16); ss += __shfl_xor(ss, 32);
        if (fq == 0) red[F.wave * 16 + fr] = ss;
        LDS_WAIT(); __builtin_amdgcn_s_barrier(); asm volatile("" ::: "memory");
        const float tot = red[F.wave * 16 + fr] + red[(F.wave ^ 4) * 16 + fr];
        const float rstd = __builtin_amdgcn_rsqf(tot * (1.f / 128.f) + RMS_EPS);
#pragma unroll
        for (int vt = 0; vt < 4; ++vt) { const int v0 = (vh * 4 + vt) * 16 + fq * 4;
            const f32x4 g4 = ngw[vt]; const v2u sg = sgw[vt];
            v2u w; w.x = cvt_pk_bf16(o[vt][0] * rstd * g4[0] * bf_lo(sg.x), o[vt][1] * rstd * g4[1] * bf_hi(sg.x));
            w.y = cvt_pk_bf16(o[vt][2] * rstd * g4[2] * bf_lo(sg.y), o[vt][3] * rstd * g4[3] * bf_hi(sg.y));
            *(v2u*)(OAB + tok * 2048 + h * 128 + v0) = w; }
        LDS_WAIT(); __builtin_amdgcn_s_barrier(); asm volatile("" ::: "memory");
    }
#undef HGO_PREF
}

constexpr int S5_UT = 0, S5_UTP = 2064, S5_XST = 33024, S5_XSP = 272, S5_KM = 37376;
__device__ __forceinline__ void s5_load_ut(const Frame& F, const bf16* UB, int g, int jb) {
#pragma unroll
    for (int i = 0; i < 2; ++i) { const int tl = F.tid + 512 * i; const v4u* src = (const v4u*)(UB + ((size_t)jb * 1024 + tl) * AW + g * 16);
        const v4u w0 = src[0], w1 = src[1]; LAS v4u* dst = (LAS v4u*)(F.lds + S5_UT + (tl >> 6) * S5_UTP + (tl & 63) * 32); dst[0] = w0; dst[1] = w1; }
}
__device__ __forceinline__ void phase_s5_local(const Frame& F0, int l) {
    Frame F = F0; F.tid = F.wave * 64 + lane_id(); asm volatile("" : "+v"(F.tid)); F.lane = F.tid & 63;
    unsigned char* ws = opqg(F.ws);
    const bf16* UB = (const bf16*)(ws + WS_UB); const bf16* PM = (const bf16*)(ws + WS_PM) + (size_t)l * 64 * 128 * 1024; float* XLOC = (float*)(ws + WS_XLOC);
    const int fr = F.lane & 15, fq = F.lane >> 4;
    for (int unit = F.vcu; unit < 64 * 8; unit += F.G) {
        const int g = unit >> 3, jb = unit & 7;
        s5_load_ut(F, UB, g, jb);
        __syncthreads();
        f32x4 acc = (f32x4){0.f, 0.f, 0.f, 0.f};
        const bf16* ap = PM + ((size_t)g * 128 + F.wave * 16 + fr) * 1024 + fq * 8;
        const LAS unsigned char* bp = F.lds + S5_UT + fr * S5_UTP + (fq >> 1) * 32 + (fq & 1) * 16;
#pragma unroll 8
        for (int ks = 0; ks < 32; ++ks) { const bf16x8 A = *(const bf16x8*)(ap + ks * 32); const bf16x8 B = *(const LAS bf16x8*)(bp + ks * 64);
            acc = __builtin_amdgcn_mfma_f32_16x16x32_bf16(A, B, acc, 0, 0, 0); }
        *(f32x4*)(XLOC + ((size_t)(jb * 16 + fr) * 64 + g) * 128 + F.wave * 16 + fq * 4) = acc;
        __syncthreads();
    }
}
__device__ __forceinline__ void phase_s5_out(const Frame& F0, int l) {
    Frame F = F0; F.tid = F.wave * 64 + lane_id(); asm volatile("" : "+v"(F.tid)); F.lane = F.tid & 63;
    unsigned char* ws = opqg(F.ws);
    const bf16* UB = (const bf16*)(ws + WS_UB); const bf16* E = (const bf16*)(ws + WS_E) + (size_t)l * 64 * 1024 * 128; const bf16* KMAT = (const bf16*)(ws + WS_KMAT) + (size_t)l * 64 * 65 * 256;
    const float* XS = (const float*)(ws + WS_XS); bf16* YB = (bf16*)(ws + WS_YB);
    const int fr = F.lane & 15, fq = F.lane >> 4;
    for (int unit = F.vcu; unit < 64 * 8; unit += F.G) {
        const int g = unit >> 3, jb = unit & 7;
        s5_load_ut(F, UB, g, jb);
        { const int cc = F.tid >> 5, p0 = (F.tid & 31) * 4; const f32x4 xv = *(const f32x4*)(XS + ((size_t)(jb * 16 + cc) * 64 + g) * 128 + p0);
          v2u w; w.x = cvt_pk_bf16(xv[0], xv[1]); w.y = cvt_pk_bf16(xv[2], xv[3]); *(LAS v2u*)(F.lds + S5_XST + cc * S5_XSP + p0 * 2) = w; }
        for (int pc = F.tid; pc < 65 * 32; pc += 512) { const int idx = pc >> 5, n = (pc >> 1) & 15, half = pc & 1;
            const v4u w = *(const v4u*)(KMAT + (size_t)g * 65 * 256 + (size_t)pc * 8); *(LAS v4u*)(F.lds + S5_KM + idx * 512 + n * 32 + ((half ^ (n >> 3)) * 16)) = w; }
        __syncthreads();
        for (int ti = 0; ti < 8; ++ti) {
            const int tau = ti * 8 + F.wave;
            const bf16* ep = E + ((size_t)g * 1024 + tau * 16 + fr) * 128 + fq * 8;
            bf16x8 Ae[4];
#pragma unroll
            for (int ke = 0; ke < 4; ++ke) Ae[ke] = *(const bf16x8*)(ep + ke * 32);
            f32x4 acc = (f32x4){0.f, 0.f, 0.f, 0.f}, acc1 = (f32x4){0.f, 0.f, 0.f, 0.f};
            const LAS unsigned char* bp = F.lds + S5_UT + fr * S5_UTP + (fq >> 1) * 32 + (fq & 1) * 16;
            const LAS unsigned char* kp = F.lds + S5_KM + (tau - (fq >> 1) + 1) * 512 + fr * 32 + (((fq & 1) ^ (fr >> 3)) * 16);
            const int nks = (tau >> 1) + 1;
            int ks = 0;
            for (; ks + 4 <= nks; ks += 4) {
                const bf16x8 A0 = *(const LAS bf16x8*)(kp - ks * 1024), A1 = *(const LAS bf16x8*)(kp - (ks + 1) * 1024), A2 = *(const LAS bf16x8*)(kp - (ks + 2) * 1024), A3 = *(const LAS bf16x8*)(kp - (ks + 3) * 1024);
                const bf16x8 B0 = *(const LAS bf16x8*)(bp + ks * 64), B1 = *(const LAS bf16x8*)(bp + (ks + 1) * 64), B2 = *(const LAS bf16x8*)(bp + (ks + 2) * 64), B3 = *(const LAS bf16x8*)(bp + (ks + 3) * 64);
                acc = __builtin_amdgcn_mfma_f32_16x16x32_bf16(A0, B0, acc, 0, 0, 0); acc1 = __builtin_amdgcn_mfma_f32_16x16x32_bf16(A1, B1, acc1, 0, 0, 0);
                acc = __builtin_amdgcn_mfma_f32_16x16x32_bf16(A2, B2, acc, 0, 0, 0); acc1 = __builtin_amdgcn_mfma_f32_16x16x32_bf16(A3, B3, acc1, 0, 0, 0); }
            for (; ks < nks; ++ks) { const bf16x8 A = *(const LAS bf16x8*)(kp - ks * 1024); const bf16x8 B = *(const LAS bf16x8*)(bp + ks * 64);
                acc = __builtin_amdgcn_mfma_f32_16x16x32_bf16(A, B, acc, 0, 0, 0); }
            const LAS unsigned char* xp = F.lds + S5_XST + fr * S5_XSP + fq * 16;
#pragma unroll
            for (int ke = 0; ke < 4; ke += 2) { const bf16x8 B0 = *(const LAS bf16x8*)(xp + ke * 64), B1 = *(const LAS bf16x8*)(xp + (ke + 1) * 64);
                acc = __builtin_amdgcn_mfma_f32_16x16x32_bf16(Ae[ke], B0, acc, 0, 0, 0); acc1 = __builtin_amdgcn_mfma_f32_16x16x32_bf16(Ae[ke + 1], B1, acc1, 0, 0, 0); }
            acc += acc1;
            v2u w; w.x = cvt_pk_bf16(gelu_tanh(acc[0]), gelu_tanh(acc[1])); w.y = cvt_pk_bf16(gelu_tanh(acc[2]), gelu_tanh(acc[3]));
            *(v2u*)(YB + ((size_t)(jb * 16 + fr) * 64 + tau) * AW + g * 16 + fq * 4) = w;
        }
        __syncthreads();
    }
}

__device__ __forceinline__ void phase_ln(const Frame& F0, int l, int which) {
    Frame F = F0; F.tid = F.wave * 64 + lane_id(); asm volatile("" : "+v"(F.tid)); F.lane = F.tid & 63;
    unsigned char* ws = opqg(F.ws); const __attribute__((address_space(4))) Args* a = opq(F.ka);
    const bf16* RS = (const bf16*)(ws + WS_RH); bf16* XS = (bf16*)(ws + WS_XH);
    const bool last = (which == 1 && l == DEPTH - 1); float* OUT = GP(float, a->out);
    const float* gam = GP(const float, a->in[which == 0 ? I_LN1G : I_LN2G]) + (size_t)l * D; const float* bet = GP(const float, a->in[which == 0 ? I_LN1B : I_LN2B]) + (size_t)l * D;
    const int gw = F.vcu * 8 + F.wave, NGW = F.G * 8;
    const int j = F.lane & 3, rr = (F.lane >> 2) & 1, sl = F.lane >> 3;
    for (int rp = gw; rp < T / 2; rp += NGW) {
        const int row = 2 * rp + rr;
        const size_t eo = ((size_t)sl * T + row) * 32 + j * 8;
        v4u w[8];
#pragma unroll
        for (int i = 0; i < 8; ++i) w[i] = *(const v4u*)(RS + eo + (size_t)i * 8 * T * 32);
        float v[64]; float s = 0.f;
#pragma unroll
        for (int i = 0; i < 8; ++i) { const unsigned ww[4] = {w[i].x, w[i].y, w[i].z, w[i].w};
#pragma unroll
            for (int k = 0; k < 4; ++k) { const h2_t hv = __builtin_bit_cast(h2_t, ww[k]); v[8 * i + 2 * k] = (float)hv.x; v[8 * i + 2 * k + 1] = (float)hv.y; s += (float)hv.x + (float)hv.y; } }
        s += __shfl_xor(s, 1); s += __shfl_xor(s, 2); s += __shfl_xor(s, 8); s += __shfl_xor(s, 16); s += __shfl_xor(s, 32);
        const float mean = s * (1.f / D); float s2 = 0.f;
#pragma unroll
        for (int i = 0; i < 64; ++i) { v[i] -= mean; s2 += v[i] * v[i]; }
        s2 += __shfl_xor(s2, 1); s2 += __shfl_xor(s2, 2); s2 += __shfl_xor(s2, 8); s2 += __shfl_xor(s2, 16); s2 += __shfl_xor(s2, 32);
        const float rstd = __builtin_amdgcn_rsqf(s2 * (1.f / D) + LN_EPS);
#pragma unroll
        for (int i = 0; i < 8; ++i) { const int e0 = (8 * i + sl) * 32 + j * 8;
            const f32x4 g0 = *(const f32x4*)(gam + e0), g1 = *(const f32x4*)(gam + e0 + 4), b0 = *(const f32x4*)(bet + e0), b1 = *(const f32x4*)(bet + e0 + 4);
            const f32x4 y0 = (f32x4){v[8 * i], v[8 * i + 1], v[8 * i + 2], v[8 * i + 3]} * rstd * g0 + b0, y1 = (f32x4){v[8 * i + 4], v[8 * i + 5], v[8 * i + 6], v[8 * i + 7]} * rstd * g1 + b1;
            if (last) { *(f32x4*)(OUT + (size_t)row * D + e0) = y0; *(f32x4*)(OUT + (size_t)row * D + e0 + 4) = y1; }
            else { v4u o; o.x = cvt_pk_f16(y0[0], y0[1]); o.y = cvt_pk_f16(y0[2], y0[3]); o.z = cvt_pk_f16(y1[0], y1[1]); o.w = cvt_pk_f16(y1[2], y1[3]); *(v4u*)(XS + eo + (size_t)i * 8 * T * 32) = o; } }
    }
}

constexpr int PK_TV = 0, PK_EID = 65536, PK_GATE = 81920;
__device__ __forceinline__ int f2key(float x) { const int b = __float_as_int(x); return b ^ ((b >> 31) & 0x7fffffff); }
__device__ __forceinline__ float key2f(int k) { return __int_as_float(k ^ ((k >> 31) & 0x7fffffff)); }
__device__ __forceinline__ int imed3(int a, int b, int c) { int r; asm("v_med3_i32 %0, %1, %2, %3" : "=v"(r) : "v"(a), "v"(b), "v"(c)); return r; }
#define INSK(kx) do { const int _x = (kx); _Pragma("unroll") for (int _k = 15; _k > 0; --_k) tk[_k] = imed3(tk[_k - 1], tk[_k], _x); tk[0] = max(tk[0], _x); } while (0)
__device__ __forceinline__ void phase_topk(const Frame& F0, int l) {
    Frame F = F0; F.tid = F.wave * 64 + lane_id(); asm volatile("" : "+v"(F.tid)); F.lane = F.tid & 63;
    unsigned char* ws = opqg(F.ws);
    const float* SC = (const float*)(ws + WS_SC); int* SEID = (int*)(ws + WS_SEID); float* SGATE = (float*)(ws + WS_SGATE); unsigned char* START = ws + WS_START;
    LAS int* TK = (LAS int*)(F.lds + PK_TV); LAS int* EIDL = (LAS int*)(F.lds + PK_EID); LAS float* GATEL = (LAS float*)(F.lds + PK_GATE);
    for (int tb = F.vcu; tb < T / 32; tb += F.G) {
        const int t0 = tb * 32;
        { const int tok = F.tid >> 4, hh = F.tid & 15;
          const v4u* sp = (const v4u*)((const bf16*)SC + (size_t)(t0 + tok) * 2048 + hh * 128);
          int tk[16];
#pragma unroll
          for (int k = 0; k < 16; ++k) tk[k] = (int)0x80000000;
#pragma unroll 2
          for (int i = 0; i < 16; ++i) { const v4u s0 = sp[i]; const unsigned sw[4] = {s0.x, s0.y, s0.z, s0.w};
#pragma unroll
              for (int x = 0; x < 4; ++x) { INSK((f2key(bf_lo(sw[x])) & ~127) | (127 - (8 * i + 2 * x))); INSK((f2key(bf_hi(sw[x])) & ~127) | (127 - (8 * i + 2 * x + 1))); } }
#pragma unroll
          for (int k = 0; k < 16; ++k) TK[F.tid * 16 + k] = tk[k]; }
        __syncthreads();
        if ((F.tid & 1) == 0) {
            float v1[16], v2[16];
#pragma unroll
            for (int k = 0; k < 16; ++k) { v1[k] = key2f(TK[F.tid * 16 + k] & ~127); v2[k] = key2f(TK[(F.tid + 1) * 16 + k] & ~127); }
            int tk[16];
#pragma unroll
            for (int k = 0; k < 16; ++k) tk[k] = (int)0x80000000;
#pragma unroll
            for (int aa = 0; aa < 16; ++aa)
#pragma unroll
                for (int bb = 0; bb < 16; ++bb) if ((aa + 1) * (bb + 1) <= 16) { INSK((f2key(v1[aa] + v2[bb]) & ~255) | (255 - (aa * 16 + bb))); }
            float ex[16], sum = 0.f; const float v0 = key2f(tk[0] & ~255);
#pragma unroll
            for (int k = 0; k < 16; ++k) { ex[k] = expf(key2f(tk[k] & ~255) - v0); sum += ex[k]; }
            const float inv = 1.f / sum;
            const int tok = F.tid >> 4, hd = (F.tid >> 1) & 7;
#pragma unroll
            for (int k = 0; k < 16; ++k) { const int code = 255 - (tk[k] & 255);
                const int i1 = 127 - (TK[F.tid * 16 + (code >> 4)] & 127), i2 = 127 - (TK[(F.tid + 1) * 16 + (code & 15)] & 127);
                EIDL[tok * 128 + hd * 16 + k] = (((i1 + i2) & 15) << 10) + i1 * 8 + (i2 >> 4); GATEL[tok * 128 + hd * 16 + k] = ex[k] * inv; }
        }
        __syncthreads();
        for (int ti = 0; ti < 4; ++ti) {
            const int tok = F.wave * 4 + ti;
            int k0 = (EIDL[tok * 128 + F.lane] << 7) | F.lane, k1 = (EIDL[tok * 128 + 64 + F.lane] << 7) | (64 + F.lane);
#pragma unroll
            for (int k = 2; k <= 128; k <<= 1)
#pragma unroll
                for (int j = k >> 1; j > 0; j >>= 1) {
                    if (j == 64) { const int mn = min(k0, k1), mx = max(k0, k1); k0 = mn; k1 = mx; }
                    else { const int o0 = __shfl_xor(k0, j), o1 = __shfl_xor(k1, j); const bool lower = (F.lane & j) == 0;
                        const bool up0 = (F.lane & k) == 0, up1 = ((64 + F.lane) & k) == 0;
                        k0 = (up0 == lower) ? min(k0, o0) : max(k0, o0); k1 = (up1 == lower) ? min(k1, o1) : max(k1, o1); }
                }
            const size_t t = (size_t)(t0 + tok);
            { const int r0 = k0 >> 17, r1 = k1 >> 17; int mine = 0;
#pragma unroll
              for (int r = 1; r < 16; ++r) { const int c = __builtin_popcountll(__ballot(r0 < r)) + __builtin_popcountll(__ballot(r1 < r)); mine = (F.lane == r) ? c : mine; }
              if (F.lane < 16) START[t * 16 + F.lane] = (unsigned char)mine; }
            SEID[t * LP + F.lane] = k0 >> 7; SEID[t * LP + 64 + F.lane] = k1 >> 7;
            SGATE[t * 128 + F.lane] = GATEL[tok * 128 + (k0 & 127)]; SGATE[t * 128 + 64 + F.lane] = GATEL[tok * 128 + (k1 & 127)];
        }
        __syncthreads();
    }
}
typedef __bf16 bf2_t __attribute__((ext_vector_type(2)));
__device__ __forceinline__ float dot2bf(unsigned a, unsigned b, float c) { return __builtin_amdgcn_fdot2_f32_bf16(__builtin_bit_cast(bf2_t, a), __builtin_bit_cast(bf2_t, b), c, false); }
__device__ __forceinline__ void peer_stage(const Frame& F, const bf16* gsrc, int bo) {
#pragma unroll
    for (int i = 0; i < 8; ++i) { const int p = i * 8 + F.wave;
        __builtin_amdgcn_global_load_lds((const unsigned*)((const char*)gsrc + p * 1024 + F.lane * 16), (LAS unsigned*)(F.lds + bo + p * 1024), 16, 0, 0); }
}
__device__ __forceinline__ void peer_dma(const Frame& F, const void* gsrc, int bo) {
    const unsigned ldsbase = (unsigned)(size_t)(F.lds + bo) + (unsigned)F.wave * 1024u;
#pragma unroll
    for (int i = 0; i < 8; ++i) { const char* g = (const char*)gsrc + (i * 8 + F.wave) * 1024 + F.lane * 16; const unsigned m = ldsbase + i * 8192u;
        asm volatile("s_mov_b32 m0, %0\n\ts_nop 0\n\tglobal_load_lds_dwordx4 %1, off" :: "s"(m), "v"((GAS const char*)g) : "memory"); }
}
__device__ __forceinline__ int wave_max_i(int v) {
#pragma unroll
    for (int o = 1; o < 64; o <<= 1) v = max(v, __shfl_xor(v, o));
    return __builtin_amdgcn_readfirstlane(v);
}
template <int K> __device__ __forceinline__ unsigned dppq(unsigned v) { return (unsigned)__builtin_amdgcn_mov_dpp((int)v, K * 0x55, 0xf, 0xf, true); }
__device__ __forceinline__ float quad_sum(float v) {
    v += __int_as_float(__builtin_amdgcn_mov_dpp(__float_as_int(v), 0xB1, 0xf, 0xf, true));
    v += __int_as_float(__builtin_amdgcn_mov_dpp(__float_as_int(v), 0x4E, 0xf, 0xf, true));
    return v;
}
constexpr int UCAP0 = 24, UCAP1 = 12, UCAP2 = 12, UCAP3 = 8;
__device__ __forceinline__ void phase_peer_u(const Frame& F0, int l) {
    Frame F = F0; F.tid = F.wave * 64 + lane_id(); asm volatile("" : "+v"(F.tid)); F.lane = F.tid & 63;
    unsigned char* ws = opqg(F.ws);
    const bf16* TU = (const bf16*)(ws + WS_TBU) + (size_t)l * 64 * NEXP * 32;
    const int* SEID = (const int*)(ws + WS_SEID); const float* SGATE = (const float*)(ws + WS_SGATE); unsigned* PACK = (unsigned*)(ws + WS_PACK); unsigned char* START = ws + WS_START;
    const bf16* XBS = (const bf16*)(ws + WS_XBS); unsigned* PACK2 = (unsigned*)(ws + WS_PACK2);
    const int qd = F.lane >> 2, jc = F.lane & 3;
    for (int unit = F.vcu; unit < 256; unit += F.G) {
        const int tt = unit & 15, er = unit >> 4; const size_t t = (size_t)tt * 512 + F.tid;
        const int lo = START[t * 16 + er], hi = (er < 15) ? (int)START[t * 16 + er + 1] : 128;
        const int cnt = hi - lo;
        int key = (cnt << 6) | (63 - F.lane);
#pragma unroll
        for (int k = 2; k <= 64; k <<= 1)
#pragma unroll
            for (int j = k >> 1; j > 0; j >>= 1) { const int o = __shfl_xor(key, j); const bool lower = (F.lane & j) == 0, up = (F.lane & k) == 0;
                key = (up == lower) ? max(key, o) : min(key, o); }
        int tl[4], glo[4], gcnt[4], gmax[4];
#pragma unroll
        for (int a = 0; a < 4; ++a) { const int kk = __shfl(key, a * 16 + qd); tl[a] = 63 - (kk & 63); gcnt[a] = kk >> 6; glo[a] = __shfl(lo, tl[a]);
            gmax[a] = __builtin_amdgcn_readfirstlane(__shfl(key, a * 16)) >> 6; }
        const size_t tbase = (size_t)tt * 512 + F.wave * 64;
        unsigned ro0[UCAP0 / 4], ro1[UCAP1 / 4], ro2[UCAP2 / 4], ro3[UCAP3 / 4];
#define LOADRO(arr, a, CAP) _Pragma("unroll") for (int i = 0; i < CAP / 4; ++i) { const int s = 4 * i + jc; const int e = SEID[(tbase + tl[a]) * LP + glo[a] + s]; \
            const int row = (s < gcnt[a]) ? (e & 1023) : 0; arr[i] = (unsigned)((row << 6) + (((row >> 2) & 3) << 4)); }
        LOADRO(ro0, 0, UCAP0) LOADRO(ro1, 1, UCAP1) LOADRO(ro2, 2, UCAP2) LOADRO(ro3, 3, UCAP3)
#undef LOADRO
        float ac0[UCAP0], ac1[UCAP1], ac2[UCAP2], ac3[UCAP3];
#pragma unroll
        for (int s = 0; s < UCAP0; ++s) ac0[s] = 0.f;
#pragma unroll
        for (int s = 0; s < UCAP1; ++s) ac1[s] = 0.f;
#pragma unroll
        for (int s = 0; s < UCAP2; ++s) ac2[s] = 0.f;
#pragma unroll
        for (int s = 0; s < UCAP3; ++s) ac3[s] = 0.f;
        const bf16* gsl0 = TU + (size_t)er * 1024 * 32;
#define XA(a) ((const v4u*)(XBS + (tbase + tl[a]) * 32) + jc)
        v4u xs[4];
#pragma unroll
        for (int a = 0; a < 4; ++a) xs[a] = XA(a)[0];
        peer_dma(F, gsl0, 0);
        VM_WAIT(); __syncthreads();
#pragma unroll 1
        for (int ks = 0; ks < 64; ++ks) {
            const int bo = (ks & 1) * 65536, jx = jc << 4;
            v4u xn[4];
            const int kn = (ks + 1 < 64) ? ks + 1 : ks;
#pragma unroll
            for (int a = 0; a < 4; ++a) xn[a] = XA(a)[(size_t)kn * T * 4];
            if (ks + 1 < 64) peer_dma(F, gsl0 + (size_t)kn * NEXP * 32, bo ^ 65536);
#define URD(B, arr, g) { asm volatile("" : "+v"(arr[g])); B[0] = *(const LAS v4u*)(F.lds + bo + (dppq<0>(arr[g]) ^ jx)); B[1] = *(const LAS v4u*)(F.lds + bo + (dppq<1>(arr[g]) ^ jx)); \
                B[2] = *(const LAS v4u*)(F.lds + bo + (dppq<2>(arr[g]) ^ jx)); B[3] = *(const LAS v4u*)(F.lds + bo + (dppq<3>(arr[g]) ^ jx)); }
#define UCP(B, acc, a, g) { _Pragma("unroll") for (int q = 0; q < 4; ++q) { float p0 = acc[4 * (g) + q]; \
                p0 = dot2h(B[q].x, xs[a].x, p0); p0 = dot2h(B[q].y, xs[a].y, p0); p0 = dot2h(B[q].z, xs[a].z, p0); p0 = dot2h(B[q].w, xs[a].w, p0); acc[4 * (g) + q] = p0; } }
            { v4u BE[4], BO[4];
              URD(BE, ro0, 0) __builtin_amdgcn_sched_barrier(0);
              URD(BO, ro0, 1) UCP(BE, ac0, 0, 0)
              __builtin_amdgcn_sched_barrier(0);
              URD(BE, ro0, 2) UCP(BO, ac0, 0, 1)
              __builtin_amdgcn_sched_barrier(0);
              URD(BO, ro0, 3) UCP(BE, ac0, 0, 2)
              __builtin_amdgcn_sched_barrier(0);
              URD(BE, ro0, 4) UCP(BO, ac0, 0, 3)
              __builtin_amdgcn_sched_barrier(0);
              URD(BO, ro0, 5) UCP(BE, ac0, 0, 4)
              __builtin_amdgcn_sched_barrier(0);
              URD(BE, ro1, 0) UCP(BO, ac0, 0, 5)
              __builtin_amdgcn_sched_barrier(0);
              URD(BO, ro1, 1) UCP(BE, ac1, 1, 0)
              __builtin_amdgcn_sched_barrier(0);
              URD(BE, ro1, 2) UCP(BO, ac1, 1, 1)
              __builtin_amdgcn_sched_barrier(0);
              URD(BO, ro2, 0) UCP(BE, ac1, 1, 2)
              __builtin_amdgcn_sched_barrier(0);
              URD(BE, ro2, 1) UCP(BO, ac2, 2, 0)
              __builtin_amdgcn_sched_barrier(0);
              URD(BO, ro2, 2) UCP(BE, ac2, 2, 1)
              __builtin_amdgcn_sched_barrier(0);
              URD(BE, ro3, 0) UCP(BO, ac2, 2, 2)
              __builtin_amdgcn_sched_barrier(0);
              URD(BO, ro3, 1) UCP(BE, ac3, 3, 0)
              __builtin_amdgcn_sched_barrier(0);
              UCP(BO, ac3, 3, 1) }
#undef URD
#undef UCP
#pragma unroll
            for (int a = 0; a < 4; ++a) xs[a] = xn[a];
            VM_WAIT(); __syncthreads();
        }
#define UOUT(arr, acc, a, CAP) { const size_t tk = tbase + tl[a]; _Pragma("unroll") for (int s = 0; s < CAP; ++s) { const float tot = quad_sum(acc[s]); \
            if ((s & 3) == jc && s < NSLOT) { unsigned wv = 0u; if (s < gcnt[a]) { const float av = gelu_tanh(tot) * SGATE[tk * 128 + glo[a] + s]; wv = (arr[s >> 2] << 16) | (cvt_pk_f16(av, 0.f) & 0xffffu); } \
                PACK2[(tk * 16 + er) * NSLOT + s] = wv; } } \
            _Pragma("unroll") for (int s = CAP; s < NSLOT; ++s) if ((s & 3) == jc && s >= gcnt[a]) PACK2[(tk * 16 + er) * NSLOT + s] = 0u; }
        UOUT(ro0, ac0, 0, UCAP0) UOUT(ro1, ac1, 1, UCAP1) UOUT(ro2, ac2, 2, UCAP2) UOUT(ro3, ac3, 3, UCAP3)
#undef UOUT
#undef XA
        { int myrank = 0; const int mykey = (cnt << 6) | (63 - F.lane);
          for (int p = 0; p < 64; ++p) myrank += (__shfl(key, p) > mykey) ? 1 : 0;
          const int cap = myrank < 16 ? UCAP0 : (myrank < 32 ? UCAP1 : (myrank < 48 ? UCAP2 : UCAP3));
          const v4u* xsp = (const v4u*)(XBS + t * 32);
          for (int s = cap; s < cnt; ++s) {
              const int pos = lo + s, e = SEID[t * LP + pos]; const int f = (e >> 2) & 3; float d = 0.f;
              for (int ks = 0; ks < 64; ++ks)
#pragma unroll
                  for (int j = 0; j < 4; ++j) { const v4u u4 = *(const v4u*)(TU + (((size_t)ks * NEXP + e) * 4 + (j ^ f)) * 8); const v4u x4 = xsp[(size_t)ks * T * 4 + j];
                      d = dot2h(u4.x, x4.x, d); d = dot2h(u4.y, x4.y, d); d = dot2h(u4.z, x4.z, d); d = dot2h(u4.w, x4.w, d); }
              const int row = e & 1023;
              const unsigned wv = ((unsigned)((row << 6) + (((row >> 2) & 3) << 4)) << 16) | (cvt_pk_f16(gelu_tanh(d) * SGATE[t * 128 + pos], 0.f) & 0xffffu);
              if (s < NSLOT) PACK2[(t * 16 + er) * NSLOT + s] = wv; else PACK[t * LP + pos] = wv; }
        }
    }
}
#ifndef VBLK
#define VBLK 2
#endif
#if VBLK == 4
#define VTT(x, j) (4 * ((x) & 3) + ((j) & 3))
#define VDS(x, j, it) (32 * ((x) >> 2) + 8 * (it) + ((j) >> 2))
#elif VBLK == 8
#define VTT(x, j) (8 * ((x) & 1) + ((j) & 7))
#define VDS(x, j, it) (16 * ((x) >> 1) + 4 * (it) + ((j) >> 3))
#elif VBLK == 2
#define VTT(x, j) (2 * (x) + ((j) & 1))
#define VDS(x, j, it) (16 * (it) + ((j) >> 1))
#else
#define VTT(x, j) ((j) & 15)
#define VDS(x, j, it) (((x) * 32 + (j) + 256 * (it)) >> 4)
#endif
__device__ __forceinline__ void phase_peer_v(const Frame& F0, int l) {
    Frame F = F0; F.tid = F.wave * 64 + lane_id(); asm volatile("" : "+v"(F.tid)); F.lane = F.tid & 63;
    unsigned char* ws = opqg(F.ws);
    const bf16* TV = (const bf16*)(ws + WS_TBV) + (size_t)l * 64 * NEXP * 32; const bf16* XS = (const bf16*)(ws + WS_XH); bf16* RS = (bf16*)(ws + WS_RH);
    const unsigned* PACK = (const unsigned*)(ws + WS_PACK); const unsigned char* START = ws + WS_START; const unsigned* PACK2 = (const unsigned*)(ws + WS_PACK2);
    for (int it = 0; it * F.G + F.vcu < 1024; ++it) {
        int tt, ds;
        if (F.G == 256) { const int x = F.vcu >> 5, j = F.vcu & 31; tt = VTT(x, j); ds = VDS(x, j, it); }
        else { const int unit = it * F.G + F.vcu; tt = unit & 15; ds = unit >> 4; }
        const size_t t = (size_t)tt * 512 + F.tid;
        const v4u st4 = *(const v4u*)(START + t * 16);
        const unsigned stw[4] = {st4.x, st4.y, st4.z, st4.w};
        unsigned acc[16];
#pragma unroll
        for (int i = 0; i < 16; ++i) acc[i] = 0u;
        const bf16* gsl0 = TV + (size_t)ds * NEXP * 32;
        unsigned Lc[NSLOT];
        { const v4u* lp = (const v4u*)(PACK2 + t * 16 * NSLOT);
#pragma unroll
          for (int s = 0; s < NSLOT / 4; ++s) { const v4u q = lp[s]; Lc[4 * s] = q.x; Lc[4 * s + 1] = q.y; Lc[4 * s + 2] = q.z; Lc[4 * s + 3] = q.w; } }
        peer_dma(F, gsl0, 0);
        VM_WAIT(); __syncthreads();
#pragma unroll 1
        for (int c = 0; c < 16; ++c) {
            const int bo = (c & 1) * 65536;
            const int q0 = c >> 2, q1 = (c + 1) >> 2;
            const unsigned w0 = q0 == 0 ? stw[0] : (q0 == 1 ? stw[1] : (q0 == 2 ? stw[2] : stw[3])), w1 = q1 == 0 ? stw[0] : (q1 == 1 ? stw[1] : (q1 == 2 ? stw[2] : stw[3]));
            const int s_c = (int)((w0 >> ((c & 3) * 8)) & 255u);
            const int s_n = (c < 15) ? (int)((w1 >> (((c + 1) & 3) * 8)) & 255u) : 128;
            const int n_c = s_n - s_c;
            unsigned Ln[NSLOT];
            const int cn = (c < 15) ? c + 1 : c;
            { const v4u* lp = (const v4u*)(PACK2 + (t * 16 + cn) * NSLOT);
#pragma unroll
              for (int s = 0; s < NSLOT / 4; ++s) { const v4u q = lp[s]; Ln[4 * s] = q.x; Ln[4 * s + 1] = q.y; Ln[4 * s + 2] = q.z; Ln[4 * s + 3] = q.w; } }
            if (c < 15) peer_dma(F, gsl0 + (size_t)cn * 1024 * 32, bo ^ 65536);
            const int wmax = wave_max_i(min(n_c, NSLOT));
#pragma unroll
            for (int g = 0; g < NSLOT / 2; ++g) {
                if (2 * g < wmax) {
                    v4u v4[2][4]; unsigned a2[2];
#pragma unroll
                    for (int q = 0; q < 2; ++q) { const int s = 2 * g + q; const unsigned w = Lc[s];
                        a2[q] = __builtin_amdgcn_perm(w, w, 0x01000100u);
                        const int a0 = bo + (int)((w >> 16) & 0xfff0u);
#pragma unroll
                        for (int j = 0; j < 4; ++j) v4[q][j] = *(const LAS v4u*)(F.lds + (a0 ^ (j << 4))); }
#pragma unroll
                    for (int q = 0; q < 2; ++q)
#pragma unroll
                        for (int j = 0; j < 4; ++j) {
                            acc[4 * j + 0] = pkfmah(v4[q][j].x, a2[q], acc[4 * j + 0]); acc[4 * j + 1] = pkfmah(v4[q][j].y, a2[q], acc[4 * j + 1]);
                            acc[4 * j + 2] = pkfmah(v4[q][j].z, a2[q], acc[4 * j + 2]); acc[4 * j + 3] = pkfmah(v4[q][j].w, a2[q], acc[4 * j + 3]); }
                }
            }
            for (int s = NSLOT; s < n_c; ++s) {
                const unsigned w = PACK[t * LP + s_c + s]; const unsigned a2 = (w & 0xffffu) | (w << 16);
                const int a0 = bo + (int)((w >> 16) & 0xfff0u);
#pragma unroll
                for (int j = 0; j < 4; ++j) { const v4u v4 = *(const LAS v4u*)(F.lds + (a0 ^ (j << 4)));
                    acc[4 * j + 0] = pkfmah(v4.x, a2, acc[4 * j + 0]); acc[4 * j + 1] = pkfmah(v4.y, a2, acc[4 * j + 1]);
                    acc[4 * j + 2] = pkfmah(v4.z, a2, acc[4 * j + 2]); acc[4 * j + 3] = pkfmah(v4.w, a2, acc[4 * j + 3]); }
            }
            VM_WAIT(); __syncthreads();
#pragma unroll
            for (int s = 0; s < NSLOT; ++s) Lc[s] = Ln[s];
        }
        const v4u* xp = (const v4u*)(XS + ((size_t)ds * T + t) * 32); v4u* rp = (v4u*)(RS + ((size_t)ds * T + t) * 32);
#pragma unroll
        for (int j = 0; j < 4; ++j) { const v4u xw = xp[j]; const unsigned xx[4] = {xw.x, xw.y, xw.z, xw.w}; unsigned o[4];
#pragma unroll
            for (int k = 0; k < 4; ++k) { const h2_t xv = __builtin_bit_cast(h2_t, xx[k]), yv = __builtin_bit_cast(h2_t, acc[4 * j + k]);
                o[k] = cvt_pk_f16((float)xv.x * ALPHA + (float)yv.x, (float)xv.y * ALPHA + (float)yv.y); }
            rp[j] = (v4u){o[0], o[1], o[2], o[3]}; }
    }
}

constexpr int PH_PER_LAYER = 13, N_PHASES = 2 + DEPTH * PH_PER_LAYER;
__global__ void __launch_bounds__(512, 2) fwd_kernel(Args args) {
    extern __shared__ __attribute__((aligned(16))) unsigned char lds[];
    Frame F;
    F.lds = (LAS unsigned char*)lds;
    F.wave = __builtin_amdgcn_readfirstlane((int)threadIdx.x >> 6); F.tid = 0; F.lane = 0;
    F.G = gridDim.x; { const int bx = blockIdx.x; F.vcu = (F.G % 8 == 0) ? (bx % 8) * (F.G / 8) + bx / 8 : bx; }
    F.ws = args.ws; F.ka = (const __attribute__((address_space(4))) Args*)__builtin_amdgcn_kernarg_segment_ptr();
    unsigned char* ws = args.ws;
    for (int u = F.wave * 64 + lane_id(); u < (LDS_BYTES - LDSCTL_OFF) / 4; u += 512) ((LAS unsigned*)(F.lds + LDSCTL_OFF))[u] = 0u;
    __syncthreads();
    XcdBarrier bar; bar.bar = (unsigned*)(ws + WS_CTL) + CW_BAR; bar.x = 0; bar.st = nullptr;
    const int lo = args.ph_lo, hi = args.ph_hi;
    if (hi - lo > 1) bar = xcd_barrier_post((unsigned*)(ws + WS_CTL) + CW_BAR, (volatile LAS unsigned*)(F.lds + MISC_OFF) + 8, F.wave == 0 && lane_id() == 0);
#ifndef PHMASK
#define PHMASK 0xFFF
#endif
#define EN(i) ((PHMASK >> (i)) & 1)
#ifndef RPT
#define RPT 0
#endif
#define REP(i) for (int _r = 0; _r <= ((RPT >> (i)) & 1); ++_r)
#define IN(k) (lo <= (k) && (k) < hi)
#define SEAM(k) do { if (IN((k) + 1)) xcd_barrier(bar, F.wave); } while (0)

    if (EN(10) && IN(0)) { REP(13) { phase_prologue_a(F); } SEAM(0); }
    if (EN(11) && IN(1)) REP(14) {
        phase_prologue_b(F);
        unsigned char* ws = opqg(args.ws);
        int kc = 256; asm volatile("" : "+s"(kc));
        pg8::Gemm g{(const bf16*)(ws + WS_BK), (const bf16*)(ws + WS_WQB), DEPTH * 2048, 2048, kc, 256, 2048, 256, (long)2048 * 2048};
        pg8::StaticOrder S; S.init(DEPTH * 2048, 2048, F.G, (int)blockIdx.x);
        pg8::EpiF16 E{(bf16*)(ws + WS_WPQ), 2048};
        pg8::gemm_phase<pg8::EpiF16, pg8::StaticOrder, true>(F.lds, g, S, E, F.wave);
        if (_r == ((RPT >> 14) & 1)) SEAM(1);
    }
    for (int l = 0; l < DEPTH; ++l) {
        const int pb = 2 + l * PH_PER_LAYER;
        if (EN(0) && IN(pb + 0)) REP(0) {
            unsigned char* ws = opqg(args.ws);
            pg8::Gemm g{(const bf16*)(ws + WS_XH), (const bf16*)(ws + WS_WIN) + (size_t)l * NIN * D, T, NIN, D, T, D, 0, 0};
            pg8::StaticOrder S; S.init(T, (F.G == 256) ? 32 * 256 : NIN, F.G, (int)blockIdx.x);
            pg8::EpiIn E{(bf16*)(ws + WS_Q), (bf16*)(ws + WS_KK), (bf16*)(ws + WS_V), (bf16*)(ws + WS_SG), (bf16*)(ws + WS_UB), (bf16*)(ws + WS_GR), (bf16*)(ws + WS_GB),
                         (float*)(ws + WS_LOGF), (const float*)(ws + WS_LB) + l * AW};
            pg8::gemm_phase<pg8::EpiIn, pg8::StaticOrder, true, true, true>(F.lds, g, S, E, F.wave);
            if (_r == ((RPT >> 0) & 1)) SEAM(pb + 0);
        }
        if (EN(1) && IN(pb + 1)) { REP(1) { REP(17) { phase_hgrn_local(F, l); } REP(18) { phase_s5_local(F, l); } } SEAM(pb + 1); }
        if (EN(2) && IN(pb + 2)) { REP(2) { phase_scan(F, l); } SEAM(pb + 2); }
        if (EN(3) && IN(pb + 3)) { REP(3) { REP(15) { phase_hgrn_out(F, l); } REP(16) { phase_s5_out(F, l); } } SEAM(pb + 3); }
        if (EN(4) && IN(pb + 4)) REP(4) {
            unsigned char* ws = opqg(args.ws);
            if (F.G == 256 && blockIdx.x < 128) {
                pg8::Gemm g{(const bf16*)(ws + WS_XH), (const bf16*)(ws + WS_WIN) + (size_t)l * NIN * D, T, NIN, D, T, D, 0, 0};
                pg8::OffOrder S; S.init(T, 4 * 256, F.G, (int)blockIdx.x, 32);
                pg8::EpiIn E{(bf16*)(ws + WS_Q), (bf16*)(ws + WS_KK), (bf16*)(ws + WS_V), (bf16*)(ws + WS_SG), (bf16*)(ws + WS_UB), (bf16*)(ws + WS_GR), (bf16*)(ws + WS_GB),
                             (float*)(ws + WS_LOGF), (const float*)(ws + WS_LB) + l * AW};
                pg8::gemm_phase<pg8::EpiIn, pg8::OffOrder, true, true, true>(F.lds, g, S, E, F.wave);
            } else {
                pg8::Gemm g{(const bf16*)(ws + WS_YB), (const bf16*)(ws + WS_WGLU) + (size_t)l * 2048 * 1024, T, 2048, 1024, 1024, 1024, 0, 0};
                pg8::EpiGlu E{(bf16*)(ws + WS_OAB) + 1024, 2048};
                if (F.G == 256) { pg8::PairOrder S{(int)blockIdx.x, 128, 8, 256}; pg8::gemm_phase<pg8::EpiGlu, pg8::PairOrder, true>(F.lds, g, S, E, F.wave); }
                else { pg8::StaticOrder S; S.init(T, 2048, F.G, (int)blockIdx.x); pg8::gemm_phase<pg8::EpiGlu, pg8::StaticOrder, true>(F.lds, g, S, E, F.wave); }
            }
            if (_r == ((RPT >> 4) & 1)) SEAM(pb + 4);
        }
        if (EN(5) && IN(pb + 5)) REP(5) {
            unsigned char* ws = opqg(args.ws);
            pg8::Gemm g{(const bf16*)(ws + WS_OAB), (const bf16*)(ws + WS_WUP) + (size_t)l * 2048 * 2048, T, 2048, 2048, 2048, 2048, 0, 0};
            pg8::StaticOrder S; S.init(T, 2048, F.G, (int)blockIdx.x);
            pg8::EpiUp E{(bf16*)(ws + WS_MG), (const bf16*)(ws + WS_GR), (const bf16*)(ws + WS_GB)};
            pg8::gemm_phase<pg8::EpiUp, pg8::StaticOrder, true>(F.lds, g, S, E, F.wave);
            if (_r == ((RPT >> 5) & 1)) SEAM(pb + 5);
        }
        if (EN(6) && IN(pb + 6)) REP(6) {
            unsigned char* ws = opqg(args.ws);
            pg8::Gemm g{(const bf16*)(ws + WS_MG), (const bf16*)(ws + WS_WO) + (size_t)l * 2048 * 2048, T, 2048, 2048, 2048, 2048, 0, 0};
            pg8::StaticOrder S; S.init(T, 2048, F.G, (int)blockIdx.x);
            pg8::EpiResH E{(bf16*)(ws + WS_RH), (const bf16*)(ws + WS_XH)};
            pg8::gemm_phase<pg8::EpiResH, pg8::StaticOrder, true>(F.lds, g, S, E, F.wave);
            if (_r == ((RPT >> 6) & 1)) SEAM(pb + 6);
        }
        if (EN(7) && IN(pb + 7)) { REP(7) { phase_ln(F, l, 0); } SEAM(pb + 7); }
        if (EN(8) && IN(pb + 8)) REP(8) {
            unsigned char* ws = opqg(args.ws);
            pg8::Gemm g{(const bf16*)(ws + WS_XH), (const bf16*)(ws + WS_WPQ) + (size_t)l * 2048 * 2048, T, 2048, 2048, T, 2048, 0, 0};
            pg8::StaticOrder S; S.init(T, 2048, F.G, (int)blockIdx.x);
            pg8::EpiBf16 E{(bf16*)(ws + WS_SC), 2048};
            pg8::gemm_phase<pg8::EpiBf16, pg8::StaticOrder, true, true, true>(F.lds, g, S, E, F.wave);
            if (_r == ((RPT >> 8) & 1)) SEAM(pb + 8);
        }
        if (EN(9) && IN(pb + 9)) { REP(9) { phase_topk(F, l); } SEAM(pb + 9); }
        if (EN(9) && IN(pb + 10)) { REP(10) { phase_peer_u(F, l); } SEAM(pb + 10); }
        if (EN(9) && IN(pb + 11)) { REP(11) { phase_peer_v(F, l); } SEAM(pb + 11); }
        if (EN(9) && IN(pb + 12)) { REP(12) { phase_ln(F, l, 1); } SEAM(pb + 12); }
    }
#undef IN
#undef SEAM
}

extern "C" void kernel_launch(void* const* d_in, const int* in_sizes, int n_in, void* d_out, int out_size, void* d_ws, size_t ws_size, hipStream_t stream) {
    static int grid = 0;
    if (grid == 0) {
        if (n_in != 24 || out_size != T * D || ws_size < WS_END) { fprintf(stderr, "kernel_launch: unexpected sizes (n_in %d out %d ws %zu need %zu)\n", n_in, out_size, ws_size, (size_t)WS_END); grid = -1; return; }
        int dev = 0, cus = 0, per_cu = 0;
        if (hipGetDevice(&dev) != hipSuccess || hipDeviceGetAttribute(&cus, hipDeviceAttributeMultiprocessorCount, dev) != hipSuccess) { grid = -1; return; }
        if (hipFuncSetAttribute((const void*)fwd_kernel, hipFuncAttributeMaxDynamicSharedMemorySize, LDS_BYTES) != hipSuccess) { fprintf(stderr, "kernel_launch: hipFuncSetAttribute failed\n"); grid = -1; return; }
        if (hipOccupancyMaxActiveBlocksPerMultiprocessor(&per_cu, (const void*)fwd_kernel, 512, LDS_BYTES) != hipSuccess || per_cu < 1)
            fprintf(stderr, "kernel_launch: occupancy query reports %d\n", per_cu);
        (void)hipGetLastError();
        grid = cus;
    }
    if (grid < 0) return;
    if (hipMemsetAsync((char*)d_ws + WS_CTL, 0, CTL_ZERO_BYTES, stream) != hipSuccess) return;
    Args a{};
    for (int i = 0; i < 24; ++i) a.in[i] = (const float*)d_in[i];
    a.out = (float*)d_out; a.ws = (unsigned char*)d_ws;
#if ONE_LAUNCH
    a.ph_lo = 0; a.ph_hi = N_PHASES;
    hipLaunchKernelGGL(fwd_kernel, dim3(grid), dim3(512), LDS_BYTES, stream, a);
#else
    for (int p = 0; p < N_PHASES; ++p) { a.ph_lo = p; a.ph_hi = p + 1; hipLaunchKernelGGL(fwd_kernel, dim3(grid), dim3(512), LDS_BYTES, stream, a); }
#endif
}
```

```cpp
#include <hip/hip_runtime.h>
#include <cstdio>
#include <cstdint>

#define LAS __attribute__((address_space(3)))
#define GAS __attribute__((address_space(1)))
typedef unsigned short bf16;
typedef unsigned v4u __attribute__((ext_vector_type(4)));
typedef unsigned v2u __attribute__((ext_vector_type(2)));
typedef float f32x4 __attribute__((ext_vector_type(4)));
typedef float f32x2 __attribute__((ext_vector_type(2)));
typedef short bf16x8 __attribute__((ext_vector_type(8)));
typedef short s16x4 __attribute__((ext_vector_type(4)));

#ifndef ONE_LAUNCH
#define ONE_LAUNCH 1
#endif

constexpr int T = 8192, D = 2048, DEPTH = 4, NIN = 9216;
constexpr int AW = 1024;
constexpr int NCH = 128;
constexpr float ALPHA = 1.6817928305074290f;
constexpr float LN_EPS = 1e-5f, RMS_EPS = 1e-6f;
constexpr int NEXP = 16384;
constexpr int LP = 160;
constexpr int NSLOT = 24;

constexpr size_t MiB = 1u << 20;
constexpr size_t WS_CTL = 0, CTL_ZERO_BYTES = 32768;
constexpr size_t WS_WIN  = 1 * MiB;
constexpr size_t WS_WGLU = WS_WIN + 144 * MiB;
constexpr size_t WS_WUP  = WS_WGLU + 16 * MiB;
constexpr size_t WS_WO   = WS_WUP + 32 * MiB;
constexpr size_t WS_WQB  = WS_WO + 32 * MiB;
constexpr size_t WS_BK   = WS_WQB + 32 * MiB;
constexpr size_t WS_WPQ  = WS_BK + 4 * MiB;
constexpr size_t WS_LB   = WS_WPQ + 32 * MiB;
constexpr size_t WS_APOW = WS_LB + 1 * MiB;
constexpr size_t WS_BB   = WS_APOW + 9 * MiB;
constexpr size_t WS_KMAT = WS_BB + 2 * MiB;
constexpr size_t WS_PM   = WS_KMAT + 9 * MiB;
constexpr size_t WS_E    = WS_PM + 64 * MiB;
constexpr size_t WS_X32  = WS_E + 64 * MiB;
constexpr size_t WS_X1   = WS_X32 + 64 * MiB;
constexpr size_t WS_XB   = WS_X1 + 64 * MiB;
constexpr size_t WS_Q    = WS_XB + 32 * MiB;
constexpr size_t WS_KK   = WS_Q + 16 * MiB;
constexpr size_t WS_V    = WS_KK + 16 * MiB;
constexpr size_t WS_SG   = WS_V + 16 * MiB;
constexpr size_t WS_UB   = WS_SG + 16 * MiB;
constexpr size_t WS_LOGF = WS_UB + 16 * MiB;
constexpr size_t WS_GR   = WS_LOGF + 32 * MiB;
constexpr size_t WS_GB   = WS_GR + 32 * MiB;
constexpr size_t WS_U    = WS_GB + 32 * MiB;
constexpr size_t WS_SP   = WS_U + 64 * MiB;
constexpr size_t WS_BL   = WS_SP + 32 * MiB;
constexpr size_t WS_XLOC = WS_BL + 1 * MiB;
constexpr size_t WS_XS   = WS_XLOC + 4 * MiB;
constexpr size_t WS_OAB  = WS_XS + 4 * MiB;
constexpr size_t WS_YB   = WS_OAB + 32 * MiB;
constexpr size_t WS_MG   = WS_YB + 16 * MiB;
constexpr size_t WS_R    = WS_MG + 32 * MiB;
constexpr size_t WS_SC   = WS_R + 64 * MiB;
constexpr size_t WS_TBU  = WS_SC + 64 * MiB;
constexpr size_t WS_TBV  = WS_TBU + 256 * MiB;
constexpr size_t WS_SEID = WS_TBV + 256 * MiB;
constexpr size_t WS_SGATE= WS_SEID + 6 * MiB;
constexpr size_t WS_PACK = WS_SGATE + 4 * MiB;
constexpr size_t WS_START= WS_PACK + 6 * MiB;
constexpr size_t WS_PACK2= WS_START + 1 * MiB;
constexpr size_t WS_XBS  = WS_PACK2 + 13 * MiB;
constexpr size_t WS_END  = WS_XBS + 32 * MiB;
constexpr size_t WS_XH = WS_XBS;
constexpr size_t WS_RH = WS_R;

constexpr int CW_TMO = 0, CW_CODE = 1;
constexpr int CW_BAR = 4096;

constexpr int RING_BYTES = 131072;
constexpr int LDSCTL_OFF = RING_BYTES, MISC_OFF = LDSCTL_OFF + 320;
constexpr int LDS_BYTES = 147456;

#define LDS_WAIT() asm volatile("s_waitcnt lgkmcnt(0)" ::: "memory")
#define VM_WAIT() asm volatile("s_waitcnt vmcnt(0)" ::: "memory")
__device__ __forceinline__ unsigned cvt_pk_bf16(float lo, float hi) { unsigned r; asm volatile("v_cvt_pk_bf16_f32 %0, %1, %2" : "=v"(r) : "v"(lo), "v"(hi)); return r; }
typedef _Float16 h2_t __attribute__((ext_vector_type(2)));
__device__ __forceinline__ unsigned cvt_pk_f16a(float lo, float hi) { unsigned r; asm volatile("v_cvt_pk_f16_f32 %0, %1, %2" : "=v"(r) : "v"(lo), "v"(hi)); return r; }
__device__ __forceinline__ unsigned cvt_pk_f16(float lo, float hi) { h2_t p; p.x = (_Float16)lo; p.y = (_Float16)hi; return __builtin_bit_cast(unsigned, p); }
__device__ __forceinline__ float dot2h(unsigned a, unsigned b, float c) { return __builtin_amdgcn_fdot2(__builtin_bit_cast(h2_t, a), __builtin_bit_cast(h2_t, b), c, false); }
__device__ __forceinline__ unsigned pkfmah(unsigned a, unsigned b, unsigned c) { return __builtin_bit_cast(unsigned, __builtin_elementwise_fma(__builtin_bit_cast(h2_t, a), __builtin_bit_cast(h2_t, b), __builtin_bit_cast(h2_t, c))); }
__device__ __forceinline__ float bf_lo(unsigned u) { return __uint_as_float(u << 16); }
__device__ __forceinline__ float bf_hi(unsigned u) { return __uint_as_float(u & 0xffff0000u); }
__device__ __forceinline__ float bf2f(bf16 b) { return __uint_as_float(((unsigned)b) << 16); }
__device__ __forceinline__ bf16 f2bf(float f) { return (bf16)(cvt_pk_bf16(f, 0.f) & 0xffffu); }
__device__ __forceinline__ float fexp(float x) { return __builtin_amdgcn_exp2f(x * 1.4426950408889634f); }
__device__ __forceinline__ float flog(float x) { return __builtin_amdgcn_logf(x) * 0.6931471805599453f; }
__device__ __forceinline__ float frcp(float x) { return __builtin_amdgcn_rcpf(x); }
__device__ __forceinline__ float gelu_tanh(float x) {
    const float u = 1.5957691216057308f * (x + 0.044715f * x * x * x);
    const float uc = fminf(fmaxf(u, -60.f), 60.f);
    return x * frcp(1.f + fexp(-uc));
}
__device__ __forceinline__ int lane_id() { int r; asm volatile("v_mbcnt_lo_u32_b32 %0, -1, 0\n\tv_mbcnt_hi_u32_b32 %0, -1, %0" : "=v"(r)); return r; }
__device__ __forceinline__ float wave_sum(float v) {
#pragma unroll
    for (int o = 1; o < 64; o <<= 1) v += __shfl_xor(v, o);
    return v;
}

__device__ __forceinline__ void vlaunder(int& a, int& b) { asm volatile("" : "+v"(a), "+v"(b)); }
template <class P> __device__ __forceinline__ P* opq(P* p) { asm volatile("" : "+s"(p)); return p; }
__device__ __forceinline__ unsigned char* opqg(unsigned char* p) { GAS unsigned char* g = (GAS unsigned char*)p; asm volatile("" : "+s"(g)); return (unsigned char*)g; }
#define GP(T, p) ((T*)(GAS T*)(p))

namespace pg8 {
#define PG8_LAS __attribute__((address_space(3)))
typedef unsigned short bf16_t;
constexpr int BM = 256, BK = 64, HALF = 128, HTB = HALF * BK * 2, STAGE_BYTES = 8 * HTB, NXCD = 8, WGM = 8;

__host__ __device__ __forceinline__ int lds_byte(int r, int c) { const int st = (r >> 4) * 2 + (c >> 5), rr = r & 15, cc = c & 31, ob = rr * 64 + cc * 2; return st * 1024 + (ob ^ (((ob >> 9) & 1) << 5)); }
__host__ __device__ __forceinline__ void stage_rc(int b, int& R, int& C) { const int st = b / 1024, sb = b % 1024, swz = sb ^ (((sb >> 9) & 1) << 5); R = (st >> 1) * 16 + swz / 64; C = (st & 1) * 32 + (swz % 64) / 2; }
__host__ __device__ __forceinline__ int perm32(int rho) { const int n = rho >> 4, i = rho & 15; return 8 * (i >> 2) + 4 * n + (i & 3); }

struct Unit { int pm, pn; };
struct Gemm { const bf16_t* A; const bf16_t* Bt; int M, N, K, lda, ldb, bkoff; long blstride; };

struct StaticOrder {
    int nM, nN, nwg, G, c;
    __host__ __device__ void init(int M, int N, int G_, int c_) { nM = M / BM; nN = N / BM; nwg = nM * nN; G = G_; c = c_; }
    __host__ __device__ bool next(int i, Unit& u) const {
        const long L = (long)i * G + c; if (L >= nwg) return false;
        int wgid = (int)L; { const int q = nwg / NXCD, r = nwg % NXCD, xcd = wgid % NXCD, off = wgid / NXCD; wgid = (xcd < r ? xcd * (q + 1) : r * (q + 1) + (xcd - r) * q) + off; }
        const int nig = WGM * nN, gid = wgid / nig, fm = gid * WGM, gsz = (nM - fm) < WGM ? (nM - fm) : WGM;
        u.pm = fm + ((wgid % nig) % gsz); u.pn = (wgid % nig) / gsz; return true;
    }
    __device__ __forceinline__ void a_ready(const Unit&) const {}
    __device__ __forceinline__ void done(const Unit&) const {}
};

struct OffOrder {
    StaticOrder b; int pn0;
    __device__ void init(int M, int N, int G_, int c_, int pn0_) { b.init(M, N, G_, c_); pn0 = pn0_; }
    __device__ bool next(int i, Unit& u) const { if (!b.next(i, u)) return false; u.pn += pn0; return true; }
    __device__ __forceinline__ void a_ready(const Unit&) const {}
    __device__ __forceinline__ void done(const Unit&) const {}
};
struct PairOrder {
    int c, c0, nN, nwg;
    __device__ bool next(int i, Unit& u) const { if (c < c0 || i >= 2) return false; const int id = (c - c0) * 2 + i; if (id >= nwg) return false; u.pm = id / nN; u.pn = id % nN; return true; }
    __device__ __forceinline__ void a_ready(const Unit&) const {}
    __device__ __forceinline__ void done(const Unit&) const {}
};
typedef f32x4 Acc[2][2][4][2];

typedef _Float16 f16x8 __attribute__((ext_vector_type(8)));
template <class Epi, class Sched, bool ALIGN_EPI = false, bool F16 = false, bool ASL = false>
__device__ __forceinline__ void gemm_phase(PG8_LAS unsigned char* lds, const Gemm g, const Sched& S, const Epi& E, int wv) {
    int tid_ = wv * 64 + lane_id(); asm volatile("" : "+v"(tid_));
    const int tid = tid_, wid = __builtin_amdgcn_readfirstlane(tid >> 6), lane = tid & 63, wr = wid >> 2, wc = wid & 3, fr = lane & 15, fq = lane >> 4;
    const int K = g.K, nt = K / BK;
    unsigned voffA[2], voffB[2];
#pragma unroll
    for (int i = 0; i < 2; ++i) { int R, C; stage_rc(tid * 16 + i * 8192, R, C); const int Rb = Epi::PERM ? ((R & ~31) + perm32(R & 31)) : R;
        voffA[i] = ASL ? (unsigned)(((C >> 5) * g.lda + R) * 64 + (C & 31) * 2) : (unsigned)(R * g.lda + C) * 2u; voffB[i] = (unsigned)(Rb * g.ldb + C) * 2u; }
    const size_t kstep = (size_t)(BK * 2), kstepA = ASL ? (size_t)g.lda * 128 : (size_t)(BK * 2);
    const size_t hstepA = ASL ? (size_t)HALF * 64 : (size_t)HALF * g.lda * 2, hstepB = (size_t)HALF * g.ldb * 2;
    const size_t tstepA = 2 * hstepA, tstepB = 2 * hstepB;
    const unsigned ldsw = (unsigned)wid * 1024u;
    const int aoff = lds_byte(wr * 64 + fr, fq * 8), boff = lds_byte(wc * 32 + fr, fq * 8);
#define PG8_SA(b, h) (((b) * 2 + (h)) * HTB)
#define PG8_SB(b, h) ((4 + (b) * 2 + (h)) * HTB)
#define PG8_STAGE(bufoff, gbase, voff) do { _Pragma("unroll") for (int _i = 0; _i < 2; ++_i) \
        __builtin_amdgcn_global_load_lds((const unsigned*)((const char*)(gbase) + (voff)[_i]), (PG8_LAS unsigned*)(lds + (bufoff) + ldsw + _i * 8192), 16, 0, 0); } while (0)
#define PG8_LDA(dst, b, h) do { _Pragma("unroll") for (int m = 0; m < 4; ++m) _Pragma("unroll") for (int k = 0; k < 2; ++k) dst[m][k] = *(const PG8_LAS bf16x8*)(lds + PG8_SA(b, h) + aoff + m * 2048 + k * 1024); } while (0)
#define PG8_LDB(dst, b, h) do { _Pragma("unroll") for (int n = 0; n < 2; ++n) _Pragma("unroll") for (int k = 0; k < 2; ++k) dst[n][k] = *(const PG8_LAS bf16x8*)(lds + PG8_SB(b, h) + boff + n * 2048 + k * 1024); } while (0)
#define PG8_MMA(ai, bj, At, Bt) do { __builtin_amdgcn_s_setprio(1); _Pragma("unroll") for (int m = 0; m < 4; ++m) _Pragma("unroll") for (int n = 0; n < 2; ++n) _Pragma("unroll") for (int k = 0; k < 2; ++k) \
        { if constexpr (F16) acc[ai][bj][m][n] = __builtin_amdgcn_mfma_f32_16x16x32_f16(__builtin_bit_cast(f16x8, Bt[n][k]), __builtin_bit_cast(f16x8, At[m][k]), acc[ai][bj][m][n], 0, 0, 0); \
          else acc[ai][bj][m][n] = __builtin_amdgcn_mfma_f32_16x16x32_bf16(Bt[n][k], At[m][k], acc[ai][bj][m][n], 0, 0, 0); } __builtin_amdgcn_s_setprio(0); } while (0)
#define PG8_WAIT_V(n) asm volatile("s_waitcnt vmcnt(" #n ")" ::: "memory")
#define PG8_WAIT_L(n) asm volatile("s_waitcnt lgkmcnt(" #n ")" ::: "memory")
#define PG8_BAR __builtin_amdgcn_s_barrier()
#define PG8_SCHED __builtin_amdgcn_sched_barrier(0)
    Unit cur, nxt; int ui = 0;
    if (!S.next(0, cur)) return;
    Acc acc;
#pragma unroll
    for (int a = 0; a < 2; ++a)
#pragma unroll
        for (int b = 0; b < 2; ++b)
#pragma unroll
            for (int m = 0; m < 4; ++m)
#pragma unroll
                for (int n = 0; n < 2; ++n) acc[a][b][m][n] = (f32x4){0.f, 0.f, 0.f, 0.f};
    bf16x8 At[4][2], B0[2][2], B1[2][2];
    const char* cA = (const char*)g.A + (size_t)cur.pm * tstepA;
    const char* cB = (const char*)g.Bt + (size_t)cur.pn * tstepB + ((size_t)(cur.pm & 7) * g.bkoff + (size_t)(cur.pm >> 3) * g.blstride) * 2;
    S.a_ready(cur);
    PG8_STAGE(PG8_SB(0, 0), cB, voffB); PG8_STAGE(PG8_SB(0, 1), cB + hstepB, voffB); PG8_STAGE(PG8_SA(0, 0), cA, voffA); PG8_STAGE(PG8_SA(0, 1), cA + hstepA, voffA);
    if (wr == 1) PG8_BAR;
    PG8_WAIT_V(2); PG8_BAR;
    PG8_STAGE(PG8_SB(1, 0), cB + kstep, voffB); PG8_STAGE(PG8_SA(1, 0), cA + kstepA, voffA); PG8_STAGE(PG8_SB(1, 1), cB + hstepB + kstep, voffB);
    PG8_WAIT_V(6); PG8_BAR;
    for (;;) {
        const bool has_next = S.next(ui + 1, nxt);
        const char* nA = has_next ? (const char*)g.A + (size_t)nxt.pm * tstepA : cA;
        const char* nB = has_next ? (const char*)g.Bt + (size_t)nxt.pn * tstepB + ((size_t)(nxt.pm & 7) * g.bkoff + (size_t)(nxt.pm >> 3) * g.blstride) * 2 : cB;
        for (int t = 0; t < nt; t += 2) {
            const bool last = (t == nt - 2);
            const char* a1 = cA + (size_t)(t + 1) * kstepA;
            const char* a2 = last ? nA : cA + (size_t)(t + 2) * kstepA; const char* b2 = last ? nB : cB + (size_t)(t + 2) * kstep;
            const char* a3 = a2 + kstepA; const char* b3 = b2 + kstep;
            if (last && has_next) S.a_ready(nxt);
            PG8_LDB(B0, 0, 0); PG8_LDB(B1, 0, 1); PG8_SCHED; PG8_LDA(At, 0, 0); PG8_STAGE(PG8_SA(1, 1), a1 + hstepA, voffA);
            PG8_WAIT_V(8); PG8_WAIT_L(0); PG8_BAR; PG8_MMA(0, 0, At, B0); PG8_MMA(0, 1, At, B1); PG8_BAR; PG8_SCHED;
            PG8_LDA(At, 0, 1); PG8_STAGE(PG8_SB(0, 0), b2, voffB); PG8_STAGE(PG8_SB(0, 1), b2 + hstepB, voffB); PG8_STAGE(PG8_SA(0, 0), a2, voffA);
            PG8_WAIT_V(8); PG8_WAIT_L(0); PG8_BAR; PG8_MMA(1, 0, At, B0); PG8_MMA(1, 1, At, B1); PG8_BAR; PG8_SCHED;
            PG8_LDB(B0, 1, 0); PG8_LDB(B1, 1, 1); PG8_SCHED; PG8_LDA(At, 1, 0); PG8_STAGE(PG8_SA(0, 1), a2 + hstepA, voffA);
            PG8_WAIT_V(8); PG8_WAIT_L(0); PG8_BAR; PG8_MMA(0, 0, At, B0); PG8_MMA(0, 1, At, B1); PG8_BAR; PG8_SCHED;
            PG8_LDA(At, 1, 1); PG8_STAGE(PG8_SB(1, 0), b3, voffB); PG8_STAGE(PG8_SB(1, 1), b3 + hstepB, voffB); PG8_STAGE(PG8_SA(1, 0), a3, voffA);
            PG8_WAIT_V(8); PG8_WAIT_L(0); PG8_BAR; PG8_MMA(1, 0, At, B0); PG8_MMA(1, 1, At, B1); PG8_BAR; PG8_SCHED;
            if constexpr (Epi::HAS_MID) { if (t + 2 == (nt >> 1)) E.mid(acc, cur, wr, wc, fr, fq); }
        }
        if constexpr (ALIGN_EPI) { if (wr == 0) PG8_BAR; }
        E(acc, cur, wr, wc, fr, fq); S.done(cur);
        if (!has_next) break;
#pragma unroll
        for (int a = 0; a < 2; ++a)
#pragma unroll
            for (int b = 0; b < 2; ++b)
#pragma unroll
                for (int m = 0; m < 4; ++m)
#pragma unroll
                    for (int n = 0; n < 2; ++n) acc[a][b][m][n] = (f32x4){0.f, 0.f, 0.f, 0.f};
        cur = nxt; cA = nA; cB = nB; ++ui;
        if constexpr (ALIGN_EPI) { if (wr == 1) PG8_BAR; }
    }
    PG8_WAIT_V(0);
    if constexpr (!ALIGN_EPI) { if (wr == 0) PG8_BAR; }
    PG8_BAR;
#undef PG8_SA
#undef PG8_SB
#undef PG8_STAGE
#undef PG8_LDA
#undef PG8_LDB
#undef PG8_MMA
#undef PG8_WAIT_V
#undef PG8_WAIT_L
#undef PG8_BAR
#undef PG8_SCHED
}

struct EpiResH {
    static constexpr bool PERM = true, HAS_MID = false;
    bf16_t* RS; const bf16_t* XS;
    __device__ __forceinline__ void operator()(const Acc& acc, const Unit& u, int wr, int wc, int fr, int fq) const {
        vlaunder(fr, fq);
        const int row0 = u.pm * BM + wr * 64 + fr, sl0 = u.pn * 8 + wc;
#pragma unroll
        for (int ai = 0; ai < 2; ++ai) {
            v4u xw[4][2];
#pragma unroll
            for (int m = 0; m < 4; ++m)
#pragma unroll
                for (int bj = 0; bj < 2; ++bj) xw[m][bj] = *(const v4u*)(XS + ((size_t)(sl0 + bj * 4) * T + (row0 + ai * HALF + m * 16)) * 32 + 8 * fq);
#pragma unroll
            for (int m = 0; m < 4; ++m) {
#pragma unroll
                for (int bj = 0; bj < 2; ++bj) { const size_t eo = ((size_t)(sl0 + bj * 4) * T + (row0 + ai * HALF + m * 16)) * 32 + 8 * fq;
                    const f32x4 v0 = acc[ai][bj][m][0], v1 = acc[ai][bj][m][1];
                    const unsigned a0 = xw[m][bj].x, a1 = xw[m][bj].y, a2 = xw[m][bj].z, a3 = xw[m][bj].w;
                    const h2_t x0 = __builtin_bit_cast(h2_t, a0), x1 = __builtin_bit_cast(h2_t, a1), x2 = __builtin_bit_cast(h2_t, a2), x3 = __builtin_bit_cast(h2_t, a3);
                    v4u w; w.x = cvt_pk_f16a(v0[0] + ALPHA * (float)x0.x, v0[1] + ALPHA * (float)x0.y); w.y = cvt_pk_f16a(v0[2] + ALPHA * (float)x1.x, v0[3] + ALPHA * (float)x1.y);
                    w.z = cvt_pk_f16a(v1[0] + ALPHA * (float)x2.x, v1[1] + ALPHA * (float)x2.y); w.w = cvt_pk_f16a(v1[2] + ALPHA * (float)x3.x, v1[3] + ALPHA * (float)x3.y);
                    *(v4u*)(RS + eo) = w; } }
        }
    }
};
struct EpiF16 {
    static constexpr bool PERM = true, HAS_MID = false;
    bf16_t* O; int ldc;
    __device__ __forceinline__ void operator()(const Acc& acc, const Unit& u, int wr, int wc, int fr, int fq) const {
        vlaunder(fr, fq);
        const int row0 = u.pm * BM + wr * 64 + fr, col0 = u.pn * BM + wc * 32 + 8 * fq;
#pragma unroll
        for (int ai = 0; ai < 2; ++ai)
#pragma unroll
            for (int m = 0; m < 4; ++m) { bf16_t* rowp = O + (size_t)(row0 + ai * HALF + m * 16) * ldc + col0;
#pragma unroll
                for (int bj = 0; bj < 2; ++bj) { const f32x4 v0 = acc[ai][bj][m][0], v1 = acc[ai][bj][m][1];
                    v4u w; w.x = cvt_pk_f16a(v0[0], v0[1]); w.y = cvt_pk_f16a(v0[2], v0[3]); w.z = cvt_pk_f16a(v1[0], v1[1]); w.w = cvt_pk_f16a(v1[2], v1[3]);
                    *(v4u*)(rowp + bj * HALF) = w; } }
    }
};
struct EpiBf16 {
    static constexpr bool PERM = true, HAS_MID = false;
    bf16_t* O; int ldc;
    __device__ __forceinline__ void operator()(const Acc& acc, const Unit& u, int wr, int wc, int fr, int fq) const {
        vlaunder(fr, fq);
        const int row0 = u.pm * BM + wr * 64 + fr, col0 = u.pn * BM + wc * 32 + 8 * fq;
#pragma unroll
        for (int ai = 0; ai < 2; ++ai)
#pragma unroll
            for (int m = 0; m < 4; ++m) { bf16_t* rowp = O + (size_t)(row0 + ai * HALF + m * 16) * ldc + col0;
#pragma unroll
                for (int bj = 0; bj < 2; ++bj) { const f32x4 v0 = acc[ai][bj][m][0], v1 = acc[ai][bj][m][1];
                    v4u w; w.x = cvt_pk_bf16(v0[0], v0[1]); w.y = cvt_pk_bf16(v0[2], v0[3]); w.z = cvt_pk_bf16(v1[0], v1[1]); w.w = cvt_pk_bf16(v1[2], v1[3]);
                    *(v4u*)(rowp + bj * HALF) = w; } }
    }
};
struct EpiIn {
    static constexpr bool PERM = true, HAS_MID = false;
    bf16_t *Q, *KK, *V, *SG, *UB, *GR, *GB; float* LOGF; const float* lb;
    __device__ __forceinline__ void operator()(const Acc& acc, const Unit& u, int wr, int wc, int fr, int fq) const {
        vlaunder(fr, fq);
        const int row0 = u.pm * BM + wr * 64 + fr;
        const int pn = u.pn;
        if (pn >= 20) {
            const int col0 = (pn - 20) * 128 + wc * 32 + 8 * fq;
#pragma unroll
            for (int ai = 0; ai < 2; ++ai)
#pragma unroll
                for (int m = 0; m < 4; ++m) { const size_t ro = (size_t)(row0 + ai * HALF + m * 16) * 2048 + col0;
                    float rr[8], gg[8];
#pragma unroll
                    for (int n = 0; n < 2; ++n)
#pragma unroll
                        for (int x = 0; x < 4; ++x) { const float za = fminf(fmaxf(acc[ai][0][m][n][x], -30.f), 30.f), zb = fminf(fmaxf(acc[ai][1][m][n][x], -30.f), 30.f);
                            const float ea = fexp(-za), eb = fexp(-zb); gg[n * 4 + x] = frcp(1.f + eb); rr[n * 4 + x] = (1.f + eb) * frcp(1.f + ea); }
                    v4u w; w.x = cvt_pk_bf16(rr[0], rr[1]); w.y = cvt_pk_bf16(rr[2], rr[3]); w.z = cvt_pk_bf16(rr[4], rr[5]); w.w = cvt_pk_bf16(rr[6], rr[7]);
                    *(v4u*)(GR + ro) = w;
                    w.x = cvt_pk_bf16(gg[0], gg[1]); w.y = cvt_pk_bf16(gg[2], gg[3]); w.z = cvt_pk_bf16(gg[4], gg[5]); w.w = cvt_pk_bf16(gg[6], gg[7]);
                    *(v4u*)(GB + ro) = w; }
            return;
        }
        const int sec = pn >> 2, col0 = (pn & 3) * 256 + wc * 32 + 8 * fq;
        if (sec == 1) {
#pragma unroll
            for (int bj = 0; bj < 2; ++bj) {
                const f32x4 l0 = *(const f32x4*)(lb + col0 + bj * HALF), l1 = *(const f32x4*)(lb + col0 + bj * HALF + 4);
#pragma unroll
                for (int ai = 0; ai < 2; ++ai)
#pragma unroll
                    for (int m = 0; m < 4; ++m) { const size_t ro = (size_t)(row0 + ai * HALF + m * 16) * 1024 + col0 + bj * HALF;
                        float lf[8], kk[8];
#pragma unroll
                        for (int n = 0; n < 2; ++n)
#pragma unroll
                            for (int x = 0; x < 4; ++x) { const float z = fminf(fmaxf(acc[ai][bj][m][n][x], -30.f), 30.f); const float lbv = n ? l1[x] : l0[x];
                                const float e = fexp(-z), s = frcp(1.f + e); const float f = lbv + (1.f - lbv) * s;
                                lf[n * 4 + x] = flog(f); kk[n * 4 + x] = (1.f - lbv) * (e * s); }
                        *(f32x4*)(LOGF + ro) = (f32x4){lf[0], lf[1], lf[2], lf[3]}; *(f32x4*)(LOGF + ro + 4) = (f32x4){lf[4], lf[5], lf[6], lf[7]};
                        v4u w; w.x = cvt_pk_bf16(kk[0], kk[1]); w.y = cvt_pk_bf16(kk[2], kk[3]); w.z = cvt_pk_bf16(kk[4], kk[5]); w.w = cvt_pk_bf16(kk[6], kk[7]);
                        *(v4u*)(KK + ro) = w; }
            }
            return;
        }
        bf16_t* dst = sec == 0 ? Q : (sec == 2 ? V : (sec == 3 ? SG : UB));
        const bool sig = (sec == 3);
#pragma unroll
        for (int ai = 0; ai < 2; ++ai)
#pragma unroll
            for (int m = 0; m < 4; ++m) { bf16_t* rowp = dst + (size_t)(row0 + ai * HALF + m * 16) * 1024 + col0;
#pragma unroll
                for (int bj = 0; bj < 2; ++bj) { f32x4 v0 = acc[ai][bj][m][0], v1 = acc[ai][bj][m][1];
                    if (sig) {
#pragma unroll
                        for (int x = 0; x < 4; ++x) { v0[x] = frcp(1.f + fexp(-fminf(fmaxf(v0[x], -30.f), 30.f))); v1[x] = frcp(1.f + fexp(-fminf(fmaxf(v1[x], -30.f), 30.f))); } }
                    v4u w; w.x = cvt_pk_bf16(v0[0], v0[1]); w.y = cvt_pk_bf16(v0[2], v0[3]); w.z = cvt_pk_bf16(v1[0], v1[1]); w.w = cvt_pk_bf16(v1[2], v1[3]);
                    *(v4u*)(rowp + bj * HALF) = w; } }
    }
};
struct EpiGlu {
    static constexpr bool PERM = true, HAS_MID = false;
    bf16_t* O; int ldc;
    __device__ __forceinline__ void operator()(const Acc& acc, const Unit& u, int wr, int wc, int fr, int fq) const {
        vlaunder(fr, fq);
        const int row0 = u.pm * BM + wr * 64 + fr, col0 = u.pn * 128 + wc * 32 + 8 * fq;
#pragma unroll
        for (int ai = 0; ai < 2; ++ai)
#pragma unroll
            for (int m = 0; m < 4; ++m) { float o[8];
#pragma unroll
                for (int n = 0; n < 2; ++n)
#pragma unroll
                    for (int x = 0; x < 4; ++x) { const float h2 = fminf(fmaxf(acc[ai][1][m][n][x], -30.f), 30.f); o[n * 4 + x] = acc[ai][0][m][n][x] * frcp(1.f + fexp(-h2)); }
                v4u w; w.x = cvt_pk_bf16(o[0], o[1]); w.y = cvt_pk_bf16(o[2], o[3]); w.z = cvt_pk_bf16(o[4], o[5]); w.w = cvt_pk_bf16(o[6], o[7]);
                *(v4u*)(O + (size_t)(row0 + ai * HALF + m * 16) * ldc + col0) = w; }
    }
};
struct EpiUp {
    static constexpr bool PERM = true, HAS_MID = true;
    bf16_t* O; const bf16_t *GR, *GB;
    __device__ __forceinline__ void scale(Acc& acc, const bf16_t* G, const Unit& u, int wr, int wc, int fr, int fq) const {
        vlaunder(fr, fq);
        const int row0 = u.pm * BM + wr * 64 + fr, col0 = u.pn * BM + wc * 32 + 8 * fq;
#pragma unroll
        for (int ai = 0; ai < 2; ++ai)
#pragma unroll
            for (int m = 0; m < 4; ++m) {
#pragma unroll
                for (int bj = 0; bj < 2; ++bj) { const v4u w = *(const v4u*)(G + (size_t)(row0 + ai * HALF + m * 16) * 2048 + col0 + bj * HALF);
                    acc[ai][bj][m][0] *= (f32x4){bf_lo(w.x), bf_hi(w.x), bf_lo(w.y), bf_hi(w.y)};
                    acc[ai][bj][m][1] *= (f32x4){bf_lo(w.z), bf_hi(w.z), bf_lo(w.w), bf_hi(w.w)}; }
                if (m & 1) __builtin_amdgcn_sched_barrier(0); }
    }
    __device__ __forceinline__ void mid(Acc& acc, const Unit& u, int wr, int wc, int fr, int fq) const { scale(acc, GR, u, wr, wc, fr, fq); }
    __device__ __forceinline__ void operator()(Acc& acc, const Unit& u, int wr, int wc, int fr, int fq) const {
        scale(acc, GB, u, wr, wc, fr, fq);
        const int row0 = u.pm * BM + wr * 64 + fr, col0 = u.pn * BM + wc * 32 + 8 * fq;
#pragma unroll
        for (int ai = 0; ai < 2; ++ai)
#pragma unroll
            for (int m = 0; m < 4; ++m) { bf16_t* rowp = O + (size_t)(row0 + ai * HALF + m * 16) * 2048 + col0;
#pragma unroll
                for (int bj = 0; bj < 2; ++bj) { const f32x4 v0 = acc[ai][bj][m][0], v1 = acc[ai][bj][m][1];
                    v4u w; w.x = cvt_pk_bf16(v0[0], v0[1]); w.y = cvt_pk_bf16(v0[2], v0[3]); w.z = cvt_pk_bf16(v1[0], v1[1]); w.w = cvt_pk_bf16(v1[2], v1[3]);
                    *(v4u*)(rowp + bj * HALF) = w; } }
    }
};
}

#define XB_TMO      128
#define XB_XCNT(j)  (256  + 64 * (j))
#define XB_XSUB(j)  (1280 + 64 * (j))
#define XB_XGEN(j)  (2304 + 64 * (j))
#define XB_TOP      3328
#define XB_TOPGEN   3392
#define XCD_BAR_WORDS 3456
#define XB_SPIN_CAP (1u << 20)

__device__ __forceinline__ unsigned xb_ld(unsigned* p)              { return __hip_atomic_load(p, __ATOMIC_RELAXED, __HIP_MEMORY_SCOPE_AGENT); }
__device__ __forceinline__ unsigned xb_add(unsigned* p, unsigned v) { return __hip_atomic_fetch_add(p, v, __ATOMIC_RELAXED, __HIP_MEMORY_SCOPE_AGENT); }
__device__ __forceinline__ unsigned xb_xcc_id() { return (unsigned)__builtin_amdgcn_s_getreg((3 << 11) | 20) & 0xFu; }
#define XB_SPIN(cond, bar) do { unsigned _sp = 0; while (cond) { __builtin_amdgcn_s_sleep(1); \
    if ((++_sp & 255u) == 0u) { if (xb_ld(&(bar)[XB_TMO])) break; if (_sp > XB_SPIN_CAP) { atomicAdd(&(bar)[XB_TMO], 1u); break; } } } } while (0)

struct XcdBarrier { unsigned* bar; unsigned x; volatile LAS unsigned* st; };

__device__ __forceinline__ XcdBarrier xcd_barrier_post(unsigned* bar, volatile LAS unsigned* st, bool leader) {
    XcdBarrier b; b.bar = bar; b.x = xb_xcc_id(); b.st = st;
    if (leader) (void)xb_add(&bar[XB_XCNT(b.x)], 1u);
    return b;
}
__device__ __forceinline__ void xcd_barrier_complete(unsigned* bar, unsigned x, unsigned& nloc, unsigned& nx) {
    const unsigned G = gridDim.x * gridDim.y * gridDim.z;
    unsigned sum, cnt, mine, sp = 0u;
    for (;;) {
        sum = 0u; cnt = 0u; mine = 0u;
#pragma unroll
        for (unsigned j = 0; j < 16; ++j) { const unsigned c = xb_ld(&bar[XB_XCNT(j)]); sum += c; cnt += (c > 0u) ? 1u : 0u; mine = (j == x) ? c : mine; }
        if (sum == G) break;
        __builtin_amdgcn_s_sleep(1);
        if ((++sp & 255u) == 0u) { if (xb_ld(&bar[XB_TMO])) break; if (sp > XB_SPIN_CAP) { atomicAdd(&bar[XB_TMO], 1u); break; } }
    }
    nloc = mine > 0u ? mine : 1u; nx = cnt > 0u ? cnt : 1u;
}
__device__ __forceinline__ void xcd_barrier(const XcdBarrier& b, int wv) {
    asm volatile("s_waitcnt vmcnt(0)" ::: "memory");
    __syncthreads();
    if (wv == 0 && lane_id() == 0) {
        unsigned* bar = b.bar;
        __builtin_amdgcn_s_waitcnt(0);
        unsigned nloc = b.st[0], nx = b.st[1];
        if (nloc == 0u) { xcd_barrier_complete(bar, b.x, nloc, nx); b.st[0] = nloc; b.st[1] = nx; }
        const unsigned old = xb_add(&bar[XB_XSUB(b.x)], 1u);
        const unsigned gen = old / nloc;
        if (old + 1u == (gen + 1u) * nloc) {
            __builtin_amdgcn_fence(__ATOMIC_RELEASE, "agent");
            asm volatile("s_waitcnt vmcnt(0)" ::: "memory");
            const unsigned og = xb_add(&bar[XB_TOP], 1u);
            const unsigned tg = og / nx;
            if (og + 1u == (tg + 1u) * nx) xb_add(&bar[XB_TOPGEN], 1u);
            else XB_SPIN(xb_ld(&bar[XB_TOPGEN]) == tg, bar);
            __builtin_amdgcn_fence(__ATOMIC_ACQUIRE, "agent");
            xb_add(&bar[XB_XGEN(b.x)], 1u);
            asm volatile("s_waitcnt vmcnt(0)" ::: "memory");
        } else {
            XB_SPIN(xb_ld(&bar[XB_XGEN(b.x)]) == gen, bar);
            __builtin_amdgcn_fence(__ATOMIC_ACQUIRE, "agent");
            asm volatile("s_waitcnt vmcnt(0)" ::: "memory");
        }
    }
    __syncthreads();
}

struct Args { const float* in[24]; float* out; unsigned char* ws; int ph_lo, ph_hi; };
struct Frame {
    LAS unsigned char* lds;
    int tid, lane, wave, vcu, G;
    unsigned char* ws;
    const __attribute__((address_space(4))) Args* ka;
};
enum { I_X = 0, I_WIN, I_LBL, I_NG, I_LRE, I_LIM, I_LSTEP, I_BRE, I_BIM, I_CRE, I_CIM, I_SD, I_WGLU, I_WUPA, I_WUPB, I_WO, I_LN1G, I_LN1B, I_PWQ, I_PKEYS, I_PU, I_PV, I_LN2G, I_LN2B };

__device__ __forceinline__ void p0_transpose_item(const float* W, int N, bf16* WT, int dpitch, int dst_koff, int dst_row0, LAS float* scr, int k0, int n0, int lane, bool h = false) {
    { const int kr = lane >> 3, c4 = (lane & 7) * 4; f32x4 v[8];
#pragma unroll
      for (int i = 0; i < 8; ++i) v[i] = __builtin_nontemporal_load((const f32x4*)(W + (size_t)(k0 + kr + 8 * i) * N + n0 + c4));
#pragma unroll
      for (int i = 0; i < 8; ++i) { LAS float* d = scr + (kr + 8 * i) * 33 + c4; d[0] = v[i][0]; d[1] = v[i][1]; d[2] = v[i][2]; d[3] = v[i][3]; } }
    LDS_WAIT(); asm volatile("" ::: "memory");
    const int c = lane & 7;
#pragma unroll
    for (int j = 0; j < 4; ++j) { const int n = (lane >> 3) + 8 * j; const LAS float* s = scr + (8 * c) * 33 + n;
        v4u o;
        if (h) { o.x = cvt_pk_f16(s[0 * 33], s[1 * 33]); o.y = cvt_pk_f16(s[2 * 33], s[3 * 33]); o.z = cvt_pk_f16(s[4 * 33], s[5 * 33]); o.w = cvt_pk_f16(s[6 * 33], s[7 * 33]); }
        else { o.x = cvt_pk_bf16(s[0 * 33], s[1 * 33]); o.y = cvt_pk_bf16(s[2 * 33], s[3 * 33]); o.z = cvt_pk_bf16(s[4 * 33], s[5 * 33]); o.w = cvt_pk_bf16(s[6 * 33], s[7 * 33]); }
        *(v4u*)(WT + (size_t)(dst_row0 + n) * dpitch + dst_koff + k0 + 8 * c) = o; }
    LDS_WAIT(); asm volatile("" ::: "memory");
}
__device__ __forceinline__ void sincos_d(double a, double& s, double& c) {
    const double k = __builtin_rint(a * 0.63661977236758134308);
    double r = __builtin_fma(-k, 1.57079632679489655800e+00, a); r = __builtin_fma(-k, 6.12323399573676603587e-17, r);
    const double r2 = r * r;
    double sp = 1.0 / 1307674368000.0; sp = sp * r2 - 1.0 / 6227020800.0; sp = sp * r2 + 1.0 / 39916800.0; sp = sp * r2 - 1.0 / 362880.0; sp = sp * r2 + 1.0 / 5040.0; sp = sp * r2 - 1.0 / 120.0; sp = sp * r2 + 1.0 / 6.0;
    const double sr = r - r * r2 * sp;
    double cp = 1.0 / 20922789888000.0; cp = cp * r2 - 1.0 / 87178291200.0; cp = cp * r2 + 1.0 / 479001600.0; cp = cp * r2 - 1.0 / 3628800.0; cp = cp * r2 + 1.0 / 40320.0; cp = cp * r2 - 1.0 / 720.0; cp = cp * r2 + 1.0 / 24.0;
    const double cr = 1.0 - 0.5 * r2 + r2 * r2 * cp;
    const int q = ((int)k) & 3;
    s = (q == 0) ? sr : (q == 1) ? cr : (q == 2) ? -sr : -cr;
    c = (q == 0) ? cr : (q == 1) ? -sr : (q == 2) ? -cr : sr;
}
__device__ __forceinline__ double exp_d(double x) {
    const double k = __builtin_rint(x * 1.44269504088896340736);
    const double r = __builtin_fma(-k, 6.93147180369123816490e-01, x) - k * 1.90821492927058770002e-10;
    double p = 1.0 / 6227020800.0;
    p = p * r + 1.0 / 479001600.0; p = p * r + 1.0 / 39916800.0; p = p * r + 1.0 / 3628800.0; p = p * r + 1.0 / 362880.0; p = p * r + 1.0 / 40320.0; p = p * r + 1.0 / 5040.0;
    p = p * r + 1.0 / 720.0; p = p * r + 1.0 / 120.0; p = p * r + 1.0 / 24.0; p = p * r + 1.0 / 6.0; p = p * r + 0.5; p = p * r + 1.0; p = p * r + 1.0;
    const long long e = (long long)k + 1023; double sc = __builtin_bit_cast(double, (unsigned long long)(e << 52));
    return p * sc;
}

__device__ __forceinline__ void phase_prologue_a(const Frame& F0) {
    Frame F = F0; F.tid = F.wave * 64 + lane_id(); asm volatile("" : "+v"(F.tid)); F.lane = F.tid & 63;
    unsigned char* ws = opqg(F.ws); const __attribute__((address_space(4))) Args* a = opq(F.ka);
    LAS float* scr = (LAS float*)(F.lds + F.wave * 16384);
    const int gw = F.vcu * 8 + F.wave, NGW = F.G * 8;
    constexpr int I_IN = 32 * 288, I_GLU = 16 * 64, I_UP = 16 * 64, I_O = 32 * 64, I_L = I_IN + I_GLU + 2 * I_UP + I_O;
    for (int it = gw; it < DEPTH * I_L; it += NGW) {
        const int l = it / I_L; int r = it % I_L;
        if (r < I_IN) { const int kb = r / 288, nb = r % 288, n0 = nb * 32; int dr;
            if (n0 < 5120) dr = n0; else if (n0 < 7168) { const int j = n0 - 5120; dr = 5120 + (j >> 7) * 256 + (j & 127); } else { const int j = n0 - 7168; dr = 5120 + (j >> 7) * 256 + 128 + (j & 127); }
            p0_transpose_item(GP(const float, a->in[I_WIN]) + (size_t)l * D * NIN, NIN, (bf16*)(ws + WS_WIN) + (size_t)l * NIN * D, D, 0, dr, scr, kb * 64, n0, F.lane, true); continue; }
        r -= I_IN;
        if (r < I_GLU) { const int kb = r / 64, nb = r % 64, n0 = nb * 32; int dr;
            if (n0 < 1024) dr = (n0 >> 7) * 256 + (n0 & 127); else { const int j = n0 - 1024; dr = (j >> 7) * 256 + 128 + (j & 127); }
            p0_transpose_item(GP(const float, a->in[I_WGLU]) + (size_t)l * 1024 * 2048, 2048, (bf16*)(ws + WS_WGLU) + (size_t)l * 2048 * 1024, 1024, 0, dr, scr, kb * 64, n0, F.lane); continue; }
        r -= I_GLU;
        if (r < I_UP) { const int kb = r / 64, nb = r % 64;
            p0_transpose_item(GP(const float, a->in[I_WUPA]) + (size_t)l * 1024 * 2048, 2048, (bf16*)(ws + WS_WUP) + (size_t)l * 2048 * 2048, 2048, 0, nb * 32, scr, kb * 64, nb * 32, F.lane); continue; }
        r -= I_UP;
        if (r < I_UP) { const int kb = r / 64, nb = r % 64;
            p0_transpose_item(GP(const float, a->in[I_WUPB]) + (size_t)l * 1024 * 2048, 2048, (bf16*)(ws + WS_WUP) + (size_t)l * 2048 * 2048, 2048, 1024, nb * 32, scr, kb * 64, nb * 32, F.lane); continue; }
        r -= I_UP;
        { const int kb = r / 64, nb = r % 64;
            p0_transpose_item(GP(const float, a->in[I_WO]) + (size_t)l * 2048 * 2048, 2048, (bf16*)(ws + WS_WO) + (size_t)l * 2048 * 2048, 2048, 0, nb * 32, scr, kb * 64, nb * 32, F.lane); }
    }
    const size_t gt = (size_t)F.vcu * 512 + F.tid, NT = (size_t)F.G * 512;
    { const float* src = GP(const float, a->in[I_PWQ]); bf16* dst = (bf16*)(ws + WS_WQB);
      for (size_t i = gt; i < (size_t)DEPTH * D * D / 8; i += NT) { const f32x4 v0 = *(const f32x4*)(src + i * 8), v1 = *(const f32x4*)(src + i * 8 + 4);
          v4u w; w.x = cvt_pk_bf16(v0[0], v0[1]); w.y = cvt_pk_bf16(v0[2], v0[3]); w.z = cvt_pk_bf16(v1[0], v1[1]); w.w = cvt_pk_bf16(v1[2], v1[3]); *(v4u*)(dst + i * 8) = w; } }
    { const float* src = GP(const float, a->in[I_X]); bf16* dst = (bf16*)(ws + WS_XH);
      for (size_t i = gt; i < (size_t)T * D / 8; i += NT) { const int j = (int)(i & 3), row = (int)((i >> 2) & (T - 1)), sl = (int)(i >> 15);
          const float* sp = src + (size_t)row * D + sl * 32 + j * 8; const f32x4 v0 = *(const f32x4*)sp, v1 = *(const f32x4*)(sp + 4);
          v4u w; w.x = cvt_pk_f16(v0[0], v0[1]); w.y = cvt_pk_f16(v0[2], v0[3]); w.z = cvt_pk_f16(v1[0], v1[1]); w.w = cvt_pk_f16(v1[2], v1[3]); *(v4u*)(dst + i * 8) = w; } }
    { const float* keys = GP(const float, a->in[I_PKEYS]); bf16* dst = (bf16*)(ws + WS_BK);
      for (size_t i = gt; i < (size_t)DEPTH * 8 * 256 * 256 / 8; i += NT) { const int jj = (int)(i & 31) * 8; const int row = (int)((i >> 5) & 255); const size_t lh = i >> 13; const int half = row >> 7, n = row & 127;
          v4u w = (v4u){0u, 0u, 0u, 0u};
          if ((jj >> 7) == half) { const float* s = keys + ((lh * 2 + half) * 128 + n) * 128 + (jj & 127); const f32x4 v0 = *(const f32x4*)s, v1 = *(const f32x4*)(s + 4);
              w.x = cvt_pk_bf16(v0[0], v0[1]); w.y = cvt_pk_bf16(v0[2], v0[3]); w.z = cvt_pk_bf16(v1[0], v1[1]); w.w = cvt_pk_bf16(v1[2], v1[3]); }
          *(v4u*)(dst + i * 8) = w; } }
    if (gt < 1024) { const float* lg = GP(const float, a->in[I_LBL]); float* lbo = (float*)(ws + WS_LB); const int d = (int)gt;
        const float z0 = lg[d], z1 = lg[1024 + d], z2 = lg[2048 + d], z3 = lg[3072 + d]; const float mx = fmaxf(fmaxf(z0, z1), fmaxf(z2, z3));
        const float e0 = expf(z0 - mx), e1 = expf(z1 - mx), e2 = expf(z2 - mx), e3 = expf(z3 - mx); const float inv = 1.f / (e0 + e1 + e2 + e3);
        lbo[d] = 0.f; lbo[1024 + d] = e1 * inv; lbo[2048 + d] = (e1 + e2) * inv; lbo[3072 + d] = (e1 + e2 + e3) * inv; }
    for (size_t i = gt; i < (size_t)DEPTH * 64 * 64; i += NT) {
        const size_t lg_ = i >> 6;
        const double lr = fmin((double)GP(const float, a->in[I_LRE])[i], -1e-4), li = (double)GP(const float, a->in[I_LIM])[i], dt = exp_d((double)GP(const float, a->in[I_LSTEP])[lg_]);
        const double mag = exp_d(lr * dt); double sn, cs; sincos_d(li * dt, sn, cs);
        const double ar = mag * cs, ai = mag * sn, den = lr * lr + li * li, nr = ar - 1.0;
        const double zr = (nr * lr + ai * li) / den, zi = (ai * lr - nr * li) / den;
        const float* br = GP(const float, a->in[I_BRE]) + i * 16; const float* bi = GP(const float, a->in[I_BIM]) + i * 16; float* bb = (float*)(ws + WS_BB) + i * 32;
#pragma unroll
        for (int m = 0; m < 16; ++m) { const double b_r = br[m], b_i = bi[m]; bb[2 * m] = (float)(zr * b_r - zi * b_i); bb[2 * m + 1] = (float)(zr * b_i + zi * b_r); }
        float* ap = (float*)(ws + WS_APOW) + (lg_ * 65 * 64 + (i & 63)) * 2; double pr = 1.0, pi = 0.0;
        for (int dl = 0; dl < 65; ++dl) { ap[dl * 128] = (float)pr; ap[dl * 128 + 1] = (float)pi; const double t = pr * ar - pi * ai; pi = pr * ai + pi * ar; pr = t; }
    }
    for (int it = gw; it < 2 * DEPTH * 1024; it += NGW) {
        const int tb = it >> 12, l = (it >> 10) & 3, eb = it & 1023;
        const int pe = eb * 16 + (F.lane >> 2), i1 = (pe & 1023) >> 3, i2 = (pe & 7) * 16 + (((pe >> 10) - i1) & 15);
        const float* src = GP(const float, a->in[tb ? I_PV : I_PU]) + ((size_t)l * NEXP + i1 * 128 + i2) * D + (F.lane & 3) * 8;
        bf16* dst = (bf16*)(ws + (tb ? WS_TBV : WS_TBU)) + (size_t)l * 64 * NEXP * 32 + ((size_t)(eb * 16 + (F.lane >> 2)) * 4 + ((F.lane & 3) ^ ((F.lane >> 4) & 3))) * 8;
#pragma unroll 8
        for (int ks = 0; ks < 64; ++ks) { const f32x4 v0 = __builtin_nontemporal_load((const f32x4*)(src + ks * 32)), v1 = __builtin_nontemporal_load((const f32x4*)(src + ks * 32 + 4));
            v4u w; w.x = cvt_pk_f16(v0[0], v0[1]); w.y = cvt_pk_f16(v0[2], v0[3]); w.z = cvt_pk_f16(v1[0], v1[1]); w.w = cvt_pk_f16(v1[2], v1[3]);
            *(v4u*)(dst + (size_t)ks * NEXP * 32) = w; }
    }
}
__device__ __forceinline__ double dummy_unused_(double x) { return x; }

__device__ __forceinline__ void phase_prologue_b(const Frame& F0) {
    Frame F = F0; F.tid = F.wave * 64 + lane_id(); asm volatile("" : "+v"(F.tid)); F.lane = F.tid & 63;
    unsigned char* ws = opqg(F.ws); const __attribute__((address_space(4))) Args* a = opq(F.ka);
    const float* APOW = (const float*)(ws + WS_APOW); const float* BB = (const float*)(ws + WS_BB);
    LAS float* AP = (LAS float*)(F.lds); LAS float* BL = (LAS float*)(F.lds + 33280); LAS float* CR = (LAS float*)(F.lds + 41472); LAS float* CI = (LAS float*)(F.lds + 45568); LAS float* SDL = (LAS float*)(F.lds + 49664);
    bf16* KM = (bf16*)(ws + WS_KMAT); bf16* PM = (bf16*)(ws + WS_PM); bf16* E = (bf16*)(ws + WS_E);
    for (int lg = F.vcu; lg < DEPTH * 64; lg += F.G) {
        for (int i = F.tid; i < 65 * 64 * 2 / 4; i += 512) ((LAS f32x4*)AP)[i] = ((const f32x4*)(APOW + (size_t)lg * 65 * 128))[i];
        ((LAS f32x4*)BL)[F.tid] = ((const f32x4*)(BB + (size_t)lg * 2048))[F.tid];
        if (F.tid < 256) ((LAS f32x4*)CR)[F.tid] = ((const f32x4*)(GP(const float, a->in[I_CRE]) + (size_t)lg * 1024))[F.tid];
        else ((LAS f32x4*)CI)[F.tid - 256] = ((const f32x4*)(GP(const float, a->in[I_CIM]) + (size_t)lg * 1024))[F.tid - 256];
        if (F.tid < 16) SDL[F.tid] = GP(const float, a->in[I_SD])[lg * 16 + F.tid];
        __syncthreads();
        for (int task = F.tid; task < 65 * 16; task += 512) {
            const int n = task & 15, idx = task >> 4;
            float sm[16];
#pragma unroll
            for (int m = 0; m < 16; ++m) sm[m] = 0.f;
            if (idx > 0) { const int dl = idx - 1;
#pragma unroll 4
                for (int p = 0; p < 64; ++p) { const f32x2 av = *(const LAS f32x2*)(AP + (dl * 64 + p) * 2); const float c_r = CR[n * 64 + p], c_i = CI[n * 64 + p];
                    const float car = c_r * av[0] - c_i * av[1], cai = c_r * av[1] + c_i * av[0];
#pragma unroll
                    for (int q = 0; q < 8; ++q) { const f32x4 b4 = *(const LAS f32x4*)(BL + p * 32 + q * 4); sm[2 * q] += car * b4[0] - cai * b4[1]; sm[2 * q + 1] += car * b4[2] - cai * b4[3]; } }
                if (dl == 0) { const float dv = SDL[n];
#pragma unroll
                    for (int m = 0; m < 16; ++m) sm[m] += (m == n) ? dv : 0.f; } }
            v4u w0, w1; w0.x = cvt_pk_bf16(sm[0], sm[1]); w0.y = cvt_pk_bf16(sm[2], sm[3]); w0.z = cvt_pk_bf16(sm[4], sm[5]); w0.w = cvt_pk_bf16(sm[6], sm[7]);
            w1.x = cvt_pk_bf16(sm[8], sm[9]); w1.y = cvt_pk_bf16(sm[10], sm[11]); w1.z = cvt_pk_bf16(sm[12], sm[13]); w1.w = cvt_pk_bf16(sm[14], sm[15]);
            bf16* kp = KM + ((size_t)lg * 65 * 16 + task) * 16; *(v4u*)kp = w0; *(v4u*)(kp + 8) = w1; }
        for (int it = F.tid; it < 128 * 64 * 2; it += 512) {
            const int m0 = (it & 1) * 8, sidx = (it >> 1) & 63, pp = it >> 7, p = pp & 63;
            const f32x2 av = *(const LAS f32x2*)(AP + ((63 - sidx) * 64 + p) * 2); const float pr = av[0], pi = av[1];
            float o[8];
#pragma unroll
            for (int j = 0; j < 4; ++j) { const f32x4 b4 = *(const LAS f32x4*)(BL + p * 32 + m0 * 2 + j * 4);
                o[2 * j] = (pp < 64) ? (pr * b4[0] - pi * b4[1]) : (pr * b4[1] + pi * b4[0]); o[2 * j + 1] = (pp < 64) ? (pr * b4[2] - pi * b4[3]) : (pr * b4[3] + pi * b4[2]); }
            v4u w; w.x = cvt_pk_bf16(o[0], o[1]); w.y = cvt_pk_bf16(o[2], o[3]); w.z = cvt_pk_bf16(o[4], o[5]); w.w = cvt_pk_bf16(o[6], o[7]); *(v4u*)(PM + ((size_t)lg * 16384 + it) * 8) = w; }
        for (int it = F.tid; it < 1024 * 16; it += 512) {
            const int pp0 = (it & 15) * 8, n = (it >> 4) & 15, tau = it >> 8, p0 = pp0 & 63;
            float o[8];
#pragma unroll
            for (int j = 0; j < 8; ++j) { const f32x2 av = *(const LAS f32x2*)(AP + ((tau + 1) * 64 + p0 + j) * 2); const float c_r = CR[n * 64 + p0 + j], c_i = CI[n * 64 + p0 + j];
                o[j] = (pp0 < 64) ? (c_r * av[0] - c_i * av[1]) : -(c_r * av[1] + c_i * av[0]); }
            v4u w; w.x = cvt_pk_bf16(o[0], o[1]); w.y = cvt_pk_bf16(o[2], o[3]); w.z = cvt_pk_bf16(o[4], o[5]); w.w = cvt_pk_bf16(o[6], o[7]); *(v4u*)(E + ((size_t)lg * 16384 + it) * 8) = w; }
        __syncthreads();
    }
}
constexpr int HG_BL = 0, HG_TOT = 33792, HG_VT = 35840, HG_KT = 54272, HG_RED = 72704;
constexpr int KSP = 136, HG_KS = 73728, HG_QT = HG_KS + 64 * KSP * 2, HG_QH = HG_QT + 64 * KSP * 2;
static_assert(HG_QH + 64 * KSP * 2 <= RING_BYTES, "hgrn_out LDS map");
constexpr int BLP = 132, VTP = 72;
__device__ __forceinline__ void hg_cumsum(const Frame& F, const float* LOGF, int c, int h) {
    LAS float* bL = (LAS float*)(F.lds + HG_BL); LAS float* tot = (LAS float*)(F.lds + HG_TOT);
    const int d = F.tid & 127, seg = F.tid >> 7;
    const float* src = LOGF + (size_t)(c * 64 + seg * 16) * AW + h * 128 + d;
    float lf[16];
#pragma unroll
    for (int i = 0; i < 16; ++i) lf[i] = src[(size_t)i * AW];
#pragma unroll
    for (int i = 1; i < 16; ++i) lf[i] += lf[i - 1];
    tot[seg * 128 + d] = lf[15];
    __syncthreads();
    float off = 0.f;
#pragma unroll
    for (int s2 = 0; s2 < 3; ++s2) off += (s2 < seg) ? tot[s2 * 128 + d] : 0.f;
#pragma unroll
    for (int i = 0; i < 16; ++i) bL[(seg * 16 + i) * BLP + d] = lf[i] + off;
}
__device__ __forceinline__ void hg_load_vt(const Frame& F, const bf16* V, int c, int h) {
    LAS bf16* VT = (LAS bf16*)(F.lds + HG_VT);
    const int s = F.lane, vb = F.wave * 16;
    const v4u* src = (const v4u*)(V + (size_t)(c * 64 + s) * AW + h * 128 + vb);
    const v4u w0 = src[0], w1 = src[1];
    const unsigned ww[8] = {w0.x, w0.y, w0.z, w0.w, w1.x, w1.y, w1.z, w1.w};
#pragma unroll
    for (int j = 0; j < 8; ++j) { VT[(vb + 2 * j) * VTP + s] = (bf16)(ww[j] & 0xffffu); VT[(vb + 2 * j + 1) * VTP + s] = (bf16)(ww[j] >> 16); }
}
__device__ __forceinline__ void phase_hgrn_local(const Frame& F0, int l) {
    Frame F = F0; F.tid = F.wave * 64 + lane_id(); asm volatile("" : "+v"(F.tid)); F.lane = F.tid & 63;
    unsigned char* ws = opqg(F.ws);
    const float* LOGF = (const float*)(ws + WS_LOGF); const bf16* KK = (const bf16*)(ws + WS_KK); const bf16* V = (const bf16*)(ws + WS_V);
    _Float16* U = (_Float16*)(ws + WS_U); float* BLo = (float*)(ws + WS_BL);
    LAS float* bL = (LAS float*)(F.lds + HG_BL); LAS bf16* VT = (LAS bf16*)(F.lds + HG_VT); LAS bf16* KT = (LAS bf16*)(F.lds + HG_KT);
    const int fr = F.lane & 15, fq = F.lane >> 4;
    for (int unit = F.vcu; unit < NCH * 8; unit += F.G) {
        const int c = unit >> 3, h = unit & 7;
        hg_cumsum(F, LOGF, c, h);
        hg_load_vt(F, V, c, h);
        __syncthreads();
        { const int s = F.lane, db = F.wave * 16;
          const v4u* src = (const v4u*)(KK + (size_t)(c * 64 + s) * AW + h * 128 + db);
          const v4u w0 = src[0], w1 = src[1];
          const unsigned ww[8] = {w0.x, w0.y, w0.z, w0.w, w1.x, w1.y, w1.z, w1.w};
#pragma unroll
          for (int j = 0; j < 8; ++j) {
              const float b0 = bL[s * BLP + db + 2 * j], b1 = bL[s * BLP + db + 2 * j + 1], l0 = bL[63 * BLP + db + 2 * j], l1 = bL[63 * BLP + db + 2 * j + 1];
              const unsigned pk = cvt_pk_bf16(bf_lo(ww[j]) * fexp(l0 - b0), bf_hi(ww[j]) * fexp(l1 - b1));
              KT[(db + 2 * j) * VTP + s] = (bf16)(pk & 0xffffu); KT[(db + 2 * j + 1) * VTP + s] = (bf16)(pk >> 16); } }
        if (F.tid < 128) BLo[(size_t)c * AW + h * 128 + F.tid] = bL[63 * BLP + F.tid];
        __syncthreads();
        f32x4 acc[8];
#pragma unroll
        for (int i = 0; i < 8; ++i) acc[i] = (f32x4){0.f, 0.f, 0.f, 0.f};
#pragma unroll
        for (int ks = 0; ks < 2; ++ks) {
            const bf16x8 A = *(const LAS bf16x8*)(VT + (F.wave * 16 + fr) * VTP + ks * 32 + fq * 8);
#pragma unroll
            for (int dt = 0; dt < 8; ++dt) { const bf16x8 B = *(const LAS bf16x8*)(KT + (dt * 16 + fr) * VTP + ks * 32 + fq * 8);
                acc[dt] = __builtin_amdgcn_mfma_f32_16x16x32_bf16(B, A, acc[dt], 0, 0, 0); }
        }
        _Float16* up = U + ((size_t)(c * 8 + h) * 128 + F.wave * 16 + fr) * 128 + fq * 4;
#pragma unroll
        for (int dt = 0; dt < 8; ++dt) { v2u w; w.x = cvt_pk_f16(acc[dt][0], acc[dt][1]); w.y = cvt_pk_f16(acc[dt][2], acc[dt][3]); *(v2u*)(up + dt * 16) = w; }
        __syncthreads();
    }
}
__device__ __forceinline__ void phase_scan(const Frame& F0, int l) {
    Frame F = F0; F.tid = F.wave * 64 + lane_id(); asm volatile("" : "+v"(F.tid)); F.lane = F.tid & 63;
    unsigned char* ws = opqg(F.ws);
    const _Float16* U = (const _Float16*)(ws + WS_U); const float* BLo = (const float*)(ws + WS_BL); bf16* SP = (bf16*)(ws + WS_SP);
    for (int e = F.vcu * 512 + F.tid; e < 8 * 128 * 128; e += F.G * 512) {
        const int hd = (e >> 14) * 128 + (e & 127);
        float s = 0.f;
        for (int c0 = 0; c0 < NCH; c0 += 32) {
            float u[32], bl[32];
#pragma unroll
            for (int i = 0; i < 32; ++i) { u[i] = (float)U[(size_t)(c0 + i) * 131072 + e]; bl[i] = BLo[(size_t)(c0 + i) * AW + hd]; }
#pragma unroll
            for (int i = 0; i < 32; ++i) { SP[(size_t)(c0 + i) * 131072 + e] = f2bf(s); s = s * fexp(bl[i]) + u[i]; }
        }
    }
    const float* XLOC = (const float*)(ws + WS_XLOC); float* XS = (float*)(ws + WS_XS); const float* APOW = (const float*)(ws + WS_APOW);
    for (int e = F.vcu * 512 + F.tid; e < 64 * 64; e += F.G * 512) {
        const int g = e >> 6, p = e & 63;
        const float* ap = APOW + (((size_t)(l * 64 + g) * 65 + 64) * 64 + p) * 2; const float ar = ap[0], ai = ap[1];
        float xr = 0.f, xi = 0.f;
        for (int c0 = 0; c0 < NCH; c0 += 32) {
            float lr_[32], li_[32];
#pragma unroll
            for (int i = 0; i < 32; ++i) { lr_[i] = XLOC[((size_t)(c0 + i) * 64 + g) * 128 + p]; li_[i] = XLOC[((size_t)(c0 + i) * 64 + g) * 128 + 64 + p]; }
#pragma unroll
            for (int i = 0; i < 32; ++i) { XS[((size_t)(c0 + i) * 64 + g) * 128 + p] = xr; XS[((size_t)(c0 + i) * 64 + g) * 128 + 64 + p] = xi;
                const float t = ar * xr - ai * xi + lr_[i]; xi = ar * xi + ai * xr + li_[i]; xr = t; }
        }
    }
}
__device__ __forceinline__ void phase_hgrn_out(const Frame& F0, int l) {
    Frame F = F0; F.tid = F.wave * 64 + lane_id(); asm volatile("" : "+v"(F.tid)); F.lane = F.tid & 63;
    unsigned char* ws = opqg(F.ws); const __attribute__((address_space(4))) Args* a = opq(F.ka);
    const float* LOGF = (const float*)(ws + WS_LOGF); const bf16* KK = (const bf16*)(ws + WS_KK); const bf16* V = (const bf16*)(ws + WS_V);
    const bf16* Q = (const bf16*)(ws + WS_Q); const bf16* SG = (const bf16*)(ws + WS_SG); const bf16* SP = (const bf16*)(ws + WS_SP);
    bf16* OAB = (bf16*)(ws + WS_OAB); const float* NG = GP(const float, a->in[I_NG]) + (size_t)l * AW;
    LAS float* bL = (LAS float*)(F.lds + HG_BL); LAS bf16* VT = (LAS bf16*)(F.lds + HG_VT); LAS float* red = (LAS float*)(F.lds + HG_RED);
    const int fr = F.lane & 15, fq = F.lane >> 4, tt = F.wave & 3, vh = F.wave >> 2;
    LAS float* tot = (LAS float*)(F.lds + HG_TOT);
    float lf[16]; v4u vw0, vw1, kg0, kg1, qg0, qg1;
#define HGO_PREF(u_) { const int c_ = (u_) >> 3, h_ = (u_) & 7; \
        const float* src_ = LOGF + (size_t)(c_ * 64 + (F.tid >> 7) * 16) * AW + h_ * 128 + (F.tid & 127); \
        _Pragma("unroll") for (int i = 0; i < 16; ++i) lf[i] = src_[(size_t)i * AW]; \
        const v4u* vp_ = (const v4u*)(V + (size_t)(c_ * 64 + F.lane) * AW + h_ * 128 + F.wave * 16); vw0 = vp_[0]; vw1 = vp_[1]; \
        const size_t ro_ = ((size_t)c_ * 64 + (F.tid >> 3)) * AW + h_ * 128 + (F.tid & 7) * 16; \
        const v4u* kp_ = (const v4u*)(KK + ro_); const v4u* qp_ = (const v4u*)(Q + ro_); kg0 = kp_[0]; kg1 = kp_[1]; qg0 = qp_[0]; qg1 = qp_[1]; }
    if (F.vcu < NCH * 8) HGO_PREF(F.vcu)
    for (int unit = F.vcu; unit < NCH * 8; unit += F.G) {
        const int c = unit >> 3, h = unit & 7;
        { const int d = F.tid & 127, seg = F.tid >> 7;
#pragma unroll
          for (int i = 1; i < 16; ++i) lf[i] += lf[i - 1];
          tot[seg * 128 + d] = lf[15];
          { const int s = F.lane, vb = F.wave * 16; const unsigned ww[8] = {vw0.x, vw0.y, vw0.z, vw0.w, vw1.x, vw1.y, vw1.z, vw1.w};
#pragma unroll
            for (int j = 0; j < 8; ++j) { VT[(vb + 2 * j) * VTP + s] = (bf16)(ww[j] & 0xffffu); VT[(vb + 2 * j + 1) * VTP + s] = (bf16)(ww[j] >> 16); } }
          __syncthreads();
          float off = 0.f;
#pragma unroll
          for (int s2 = 0; s2 < 3; ++s2) off += (s2 < seg) ? tot[s2 * 128 + d] : 0.f;
#pragma unroll
          for (int i = 0; i < 16; ++i) bL[(seg * 16 + i) * BLP + d] = lf[i] + off; }
        __syncthreads();
        const int t = tt * 16 + fr; const size_t tok = (size_t)c * 64 + t;
        bf16x8 sg_[2][4];
#define HG_LOAD(buf, kd_) { const int d0_ = (kd_) * 32 + fq * 8; \
            _Pragma("unroll") for (int vt = 0; vt < 4; ++vt) sg_[buf][vt] = *(const bf16x8*)(SP + ((size_t)(c * 8 + h) * 128 + (vh * 4 + vt) * 16 + fr) * 128 + d0_); }
        HG_LOAD(0, 0) HG_LOAD(1, 1)
        v2u sgw[4];
#pragma unroll
        for (int vt = 0; vt < 4; ++vt) sgw[vt] = *(const v2u*)(SG + tok * AW + h * 128 + (vh * 4 + vt) * 16 + fq * 4);
        f32x4 ngw[4];
#pragma unroll
        for (int vt = 0; vt < 4; ++vt) ngw[vt] = *(const f32x4*)(NG + h * 128 + (vh * 4 + vt) * 16 + fq * 4);
        { const int s = F.tid >> 3, dc = (F.tid & 7) * 16;
          const unsigned kq[8] = {kg0.x, kg0.y, kg0.z, kg0.w, kg1.x, kg1.y, kg1.z, kg1.w}, qq[8] = {qg0.x, qg0.y, qg0.z, qg0.w, qg1.x, qg1.y, qg1.z, qg1.w};
          unsigned ko[8], qto[8], qho[8];
#pragma unroll
          for (int j4 = 0; j4 < 4; ++j4) { const f32x4 bs = *(const LAS f32x4*)(bL + s * BLP + dc + 4 * j4), br = *(const LAS f32x4*)(bL + 31 * BLP + dc + 4 * j4);
#pragma unroll
              for (int hx = 0; hx < 2; ++hx) { const int w = 2 * j4 + hx; const float b0 = bs[2 * hx], b1 = bs[2 * hx + 1], r0 = br[2 * hx], r1 = br[2 * hx + 1];
                  const float k0 = bf_lo(kq[w]), k1 = bf_hi(kq[w]), q0 = bf_lo(qq[w]), q1 = bf_hi(qq[w]);
                  ko[w] = cvt_pk_bf16(k0 * fexp(fminf(r0 - b0, 80.f)), k1 * fexp(fminf(r1 - b1, 80.f)));
                  qto[w] = cvt_pk_bf16(q0 * fexp(fminf(b0 - r0, 80.f)), q1 * fexp(fminf(b1 - r1, 80.f)));
                  qho[w] = cvt_pk_bf16(q0 * fexp(b0), q1 * fexp(b1)); } }
          LAS v4u* kd_ = (LAS v4u*)(F.lds + HG_KS + (s * KSP + dc) * 2); kd_[0] = (v4u){ko[0], ko[1], ko[2], ko[3]}; kd_[1] = (v4u){ko[4], ko[5], ko[6], ko[7]};
          LAS v4u* qt_ = (LAS v4u*)(F.lds + HG_QT + (s * KSP + dc) * 2); qt_[0] = (v4u){qto[0], qto[1], qto[2], qto[3]}; qt_[1] = (v4u){qto[4], qto[5], qto[6], qto[7]};
          LAS v4u* qh_ = (LAS v4u*)(F.lds + HG_QH + (s * KSP + dc) * 2); qh_[0] = (v4u){qho[0], qho[1], qho[2], qho[3]}; qh_[1] = (v4u){qho[4], qho[5], qho[6], qho[7]}; }
        __syncthreads();
        f32x4 att[4], o[4];
#pragma unroll
        for (int i = 0; i < 4; ++i) { att[i] = (f32x4){0.f, 0.f, 0.f, 0.f}; o[i] = (f32x4){0.f, 0.f, 0.f, 0.f}; }
#pragma unroll
        for (int kd = 0; kd < 4; ++kd) {
            const int cb = kd & 1;
            const int fo = (kd * 32 + fq * 8) * 2;
            const bf16x8 Bqt = *(const LAS bf16x8*)(F.lds + HG_QT + (t * KSP) * 2 + fo), Bqh = *(const LAS bf16x8*)(F.lds + HG_QH + (t * KSP) * 2 + fo);
#pragma unroll
            for (int st = 0; st < 4; ++st) { const bf16x8 kt = *(const LAS bf16x8*)(F.lds + HG_KS + ((st * 16 + fr) * KSP) * 2 + fo);
                att[st] = __builtin_amdgcn_mfma_f32_16x16x32_bf16(kt, Bqt, att[st], 0, 0, 0); }
#pragma unroll
            for (int vt = 0; vt < 4; ++vt) o[vt] = __builtin_amdgcn_mfma_f32_16x16x32_bf16(sg_[cb][vt], Bqh, o[vt], 0, 0, 0);
            if (kd < 2) HG_LOAD(cb, kd + 2)
            if (kd == 1) { const int nu = unit + F.G; if (nu < NCH * 8) HGO_PREF(nu) }
        }
#undef HG_LOAD
#pragma unroll
        for (int ks = 0; ks < 2; ++ks) {
            float m8[8];
#pragma unroll
            for (int jj = 0; jj < 8; ++jj) { const int st = 2 * ks + (jj >> 2), r = jj & 3, s = st * 16 + fq * 4 + r; m8[jj] = (s <= t) ? att[st][r] : 0.f; }
            v4u pb; pb.x = cvt_pk_bf16(m8[0], m8[1]); pb.y = cvt_pk_bf16(m8[2], m8[3]); pb.z = cvt_pk_bf16(m8[4], m8[5]); pb.w = cvt_pk_bf16(m8[6], m8[7]);
            const bf16x8 B = __builtin_bit_cast(bf16x8, pb);
#pragma unroll
            for (int vt = 0; vt < 4; ++vt) { const int v = (vh * 4 + vt) * 16 + fr;
                const v2u a0 = *(const LAS v2u*)(VT + v * VTP + ks * 32 + fq * 4), a1 = *(const LAS v2u*)(VT + v * VTP + ks * 32 + 16 + fq * 4);
                const v4u pa = (v4u){a0.x, a0.y, a1.x, a1.y};
                o[vt] = __builtin_amdgcn_mfma_f32_16x16x32_bf16(__builtin_bit_cast(bf16x8, pa), B, o[vt], 0, 0, 0); }
        }
        float ss = 0.f;
#pragma unroll
        for (int vt = 0; vt < 4; ++vt)
#pragma unroll
            for (int r = 0; r < 4; ++r) ss += o[vt][r] * o[vt][r];
        ss += __shfl_xor(ss, 16); ss += __shfl_xor(ss, 32);
        if (fq == 0) red[F.wave * 16 + fr] = ss;
        LDS_WAIT(); __builtin_amdgcn_s_barrier(); asm volatile("" ::: "memory");
        const float tot = red[F.wave * 16 + fr] + red[(F.wave ^ 4) * 16 + fr];
        const float rstd = __builtin_amdgcn_rsqf(tot * (1.f / 128.f) + RMS_EPS);
#pragma unroll
        for (int vt = 0; vt < 4; ++vt) { const int v0 = (vh * 4 + vt) * 16 + fq * 4;
            const f32x4 g4 = ngw[vt]; const v2u sg = sgw[vt];
            v2u w; w.x = cvt_pk_bf16(o[vt][0] * rstd * g4[0] * bf_lo(sg.x), o[vt][1] * rstd * g4[1] * bf_hi(sg.x));
            w.y = cvt_pk_bf16(o[vt][2] * rstd * g4[2] * bf_lo(sg.y), o[vt][3] * rstd * g4[3] * bf_hi(sg.y));
            *(v2u*)(OAB + tok * 2048 + h * 128 + v0) = w; }
        LDS_WAIT(); __builtin_amdgcn_s_barrier(); asm volatile("" ::: "memory");
    }
#undef HGO_PREF
}

constexpr int S5_UT = 0, S5_UTP = 2064, S5_XST = 33024, S5_XSP = 272, S5_KM = 37376;
__device__ __forceinline__ void s5_load_ut(const Frame& F, const bf16* UB, int g, int jb) {
#pragma unroll
    for (int i = 0; i < 2; ++i) { const int tl = F.tid + 512 * i; const v4u* src = (const v4u*)(UB + ((size_t)jb * 1024 + tl) * AW + g * 16);
        const v4u w0 = src[0], w1 = src[1]; LAS v4u* dst = (LAS v4u*)(F.lds + S5_UT + (tl >> 6) * S5_UTP + (tl & 63) * 32); dst[0] = w0; dst[1] = w1; }
}
__device__ __forceinline__ void phase_s5_local(const Frame& F0, int l) {
    Frame F = F0; F.tid = F.wave * 64 + lane_id(); asm volatile("" : "+v"(F.tid)); F.lane = F.tid & 63;
    unsigned char* ws = opqg(F.ws);
    const bf16* UB = (const bf16*)(ws + WS_UB); const bf16* PM = (const bf16*)(ws + WS_PM) + (size_t)l * 64 * 128 * 1024; float* XLOC = (float*)(ws + WS_XLOC);
    const int fr = F.lane & 15, fq = F.lane >> 4;
    for (int unit = F.vcu; unit < 64 * 8; unit += F.G) {
        const int g = unit >> 3, jb = unit & 7;
        s5_load_ut(F, UB, g, jb);
        __syncthreads();
        f32x4 acc = (f32x4){0.f, 0.f, 0.f, 0.f};
        const bf16* ap = PM + ((size_t)g * 128 + F.wave * 16 + fr) * 1024 + fq * 8;
        const LAS unsigned char* bp = F.lds + S5_UT + fr * S5_UTP + (fq >> 1) * 32 + (fq & 1) * 16;
#pragma unroll 8
        for (int ks = 0; ks < 32; ++ks) { const bf16x8 A = *(const bf16x8*)(ap + ks * 32); const bf16x8 B = *(const LAS bf16x8*)(bp + ks * 64);
            acc = __builtin_amdgcn_mfma_f32_16x16x32_bf16(A, B, acc, 0, 0, 0); }
        *(f32x4*)(XLOC + ((size_t)(jb * 16 + fr) * 64 + g) * 128 + F.wave * 16 + fq * 4) = acc;
        __syncthreads();
    }
}
__device__ __forceinline__ void phase_s5_out(const Frame& F0, int l) {
    Frame F = F0; F.tid = F.wave * 64 + lane_id(); asm volatile("" : "+v"(F.tid)); F.lane = F.tid & 63;
    unsigned char* ws = opqg(F.ws);
    const bf16* UB = (const bf16*)(ws + WS_UB); const bf16* E = (const bf16*)(ws + WS_E) + (size_t)l * 64 * 1024 * 128; const bf16* KMAT = (const bf16*)(ws + WS_KMAT) + (size_t)l * 64 * 65 * 256;
    const float* XS = (const float*)(ws + WS_XS); bf16* YB = (bf16*)(ws + WS_YB);
    const int fr = F.lane & 15, fq = F.lane >> 4;
    for (int unit = F.vcu; unit < 64 * 8; unit += F.G) {
        const int g = unit >> 3, jb = unit & 7;
        s5_load_ut(F, UB, g, jb);
        { const int cc = F.tid >> 5, p0 = (F.tid & 31) * 4; const f32x4 xv = *(const f32x4*)(XS + ((size_t)(jb * 16 + cc) * 64 + g) * 128 + p0);
          v2u w; w.x = cvt_pk_bf16(xv[0], xv[1]); w.y = cvt_pk_bf16(xv[2], xv[3]); *(LAS v2u*)(F.lds + S5_XST + cc * S5_XSP + p0 * 2) = w; }
        for (int pc = F.tid; pc < 65 * 32; pc += 512) { const int idx = pc >> 5, n = (pc >> 1) & 15, half = pc & 1;
            const v4u w = *(const v4u*)(KMAT + (size_t)g * 65 * 256 + (size_t)pc * 8); *(LAS v4u*)(F.lds + S5_KM + idx * 512 + n * 32 + ((half ^ (n >> 3)) * 16)) = w; }
        __syncthreads();
        for (int ti = 0; ti < 8; ++ti) {
            const int tau = ti * 8 + F.wave;
            const bf16* ep = E + ((size_t)g * 1024 + tau * 16 + fr) * 128 + fq * 8;
            bf16x8 Ae[4];
#pragma unroll
            for (int ke = 0; ke < 4; ++ke) Ae[ke] = *(const bf16x8*)(ep + ke * 32);
            f32x4 acc = (f32x4){0.f, 0.f, 0.f, 0.f}, acc1 = (f32x4){0.f, 0.f, 0.f, 0.f};
            const LAS unsigned char* bp = F.lds + S5_UT + fr * S5_UTP + (fq >> 1) * 32 + (fq & 1) * 16;
            const LAS unsigned char* kp = F.lds + S5_KM + (tau - (fq >> 1) + 1) * 512 + fr * 32 + (((fq & 1) ^ (fr >> 3)) * 16);
            const int nks = (tau >> 1) + 1;
            int ks = 0;
            for (; ks + 4 <= nks; ks += 4) {
                const bf16x8 A0 = *(const LAS bf16x8*)(kp - ks * 1024), A1 = *(const LAS bf16x8*)(kp - (ks + 1) * 1024), A2 = *(const LAS bf16x8*)(kp - (ks + 2) * 1024), A3 = *(const LAS bf16x8*)(kp - (ks + 3) * 1024);
                const bf16x8 B0 = *(const LAS bf16x8*)(bp + ks * 64), B1 = *(const LAS bf16x8*)(bp + (ks + 1) * 64), B2 = *(const LAS bf16x8*)(bp + (ks + 2) * 64), B3 = *(const LAS bf16x8*)(bp + (ks + 3) * 64);
                acc = __builtin_amdgcn_mfma_f32_16x16x32_bf16(A0, B0, acc, 0, 0, 0); acc1 = __builtin_amdgcn_mfma_f32_16x16x32_bf16(A1, B1, acc1, 0, 0, 0);
                acc = __builtin_amdgcn_mfma_f32_16x16x32_bf16(A2, B2, acc, 0, 0, 0); acc1 = __builtin_amdgcn_mfma_f32_16x16x32_bf16(A3, B3, acc1, 0, 0, 0); }
            for (; ks < nks; ++ks) { const bf16x8 A = *(const LAS bf16x8*)(kp - ks * 1024); const bf16x8 B = *(const LAS bf16x8*)(bp + ks * 64);
                acc = __builtin_amdgcn_mfma_f32_16x16x32_bf16(A, B, acc, 0, 0, 0); }
            const LAS unsigned char* xp = F.lds + S5_XST + fr * S5_XSP + fq * 16;
#pragma unroll
            for (int ke = 0; ke < 4; ke += 2) { const bf16x8 B0 = *(const LAS bf16x8*)(xp + ke * 64), B1 = *(const LAS bf16x8*)(xp + (ke + 1) * 64);
                acc = __builtin_amdgcn_mfma_f32_16x16x32_bf16(Ae[ke], B0, acc, 0, 0, 0); acc1 = __builtin_amdgcn_mfma_f32_16x16x32_bf16(Ae[ke + 1], B1, acc1, 0, 0, 0); }
            acc += acc1;
            v2u w; w.x = cvt_pk_bf16(gelu_tanh(acc[0]), gelu_tanh(acc[1])); w.y = cvt_pk_bf16(gelu_tanh(acc[2]), gelu_tanh(acc[3]));
            *(v2u*)(YB + ((size_t)(jb * 16 + fr) * 64 + tau) * AW + g * 16 + fq * 4) = w;
        }
        __syncthreads();
    }
}

__device__ __forceinline__ void phase_ln(const Frame& F0, int l, int which) {
    Frame F = F0; F.tid = F.wave * 64 + lane_id(); asm volatile("" : "+v"(F.tid)); F.lane = F.tid & 63;
    unsigned char* ws = opqg(F.ws); const __attribute__((address_space(4))) Args* a = opq(F.ka);
    const bf16* RS = (const bf16*)(ws + WS_RH); bf16* XS = (bf16*)(ws + WS_XH);
    const bool last = (which == 1 && l == DEPTH - 1); float* OUT = GP(float, a->out);
    const float* gam = GP(const float, a->in[which == 0 ? I_LN1G : I_LN2G]) + (size_t)l * D; const float* bet = GP(const float, a->in[which == 0 ? I_LN1B : I_LN2B]) + (size_t)l * D;
    const int gw = F.vcu * 8 + F.wave, NGW = F.G * 8;
    const int j = F.lane & 3, rr = (F.lane >> 2) & 1, sl = F.lane >> 3;
    for (int rp = gw; rp < T / 2; rp += NGW) {
        const int row = 2 * rp + rr;
        const size_t eo = ((size_t)sl * T + row) * 32 + j * 8;
        v4u w[8];
#pragma unroll
        for (int i = 0; i < 8; ++i) w[i] = *(const v4u*)(RS + eo + (size_t)i * 8 * T * 32);
        float v[64]; float s = 0.f;
#pragma unroll
        for (int i = 0; i < 8; ++i) { const unsigned ww[4] = {w[i].x, w[i].y, w[i].z, w[i].w};
#pragma unroll
            for (int k = 0; k < 4; ++k) { const h2_t hv = __builtin_bit_cast(h2_t, ww[k]); v[8 * i + 2 * k] = (float)hv.x; v[8 * i + 2 * k + 1] = (float)hv.y; s += (float)hv.x + (float)hv.y; } }
        s += __shfl_xor(s, 1); s += __shfl_xor(s, 2); s += __shfl_xor(s, 8); s += __shfl_xor(s, 16); s += __shfl_xor(s, 32);
        const float mean = s * (1.f / D); float s2 = 0.f;
#pragma unroll
        for (int i = 0; i < 64; ++i) { v[i] -= mean; s2 += v[i] * v[i]; }
        s2 += __shfl_xor(s2, 1); s2 += __shfl_xor(s2, 2); s2 += __shfl_xor(s2, 8); s2 += __shfl_xor(s2, 16); s2 += __shfl_xor(s2, 32);
        const float rstd = __builtin_amdgcn_rsqf(s2 * (1.f / D) + LN_EPS);
#pragma unroll
        for (int i = 0; i < 8; ++i) { const int e0 = (8 * i + sl) * 32 + j * 8;
            const f32x4 g0 = *(const f32x4*)(gam + e0), g1 = *(const f32x4*)(gam + e0 + 4), b0 = *(const f32x4*)(bet + e0), b1 = *(const f32x4*)(bet + e0 + 4);
            const f32x4 y0 = (f32x4){v[8 * i], v[8 * i + 1], v[8 * i + 2], v[8 * i + 3]} * rstd * g0 + b0, y1 = (f32x4){v[8 * i + 4], v[8 * i + 5], v[8 * i + 6], v[8 * i + 7]} * rstd * g1 + b1;
            if (last) { *(f32x4*)(OUT + (size_t)row * D + e0) = y0; *(f32x4*)(OUT + (size_t)row * D + e0 + 4) = y1; }
            else { v4u o; o.x = cvt_pk_f16(y0[0], y0[1]); o.y = cvt_pk_f16(y0[2], y0[3]); o.z = cvt_pk_f16(y1[0], y1[1]); o.w = cvt_pk_f16(y1[2], y1[3]); *(v4u*)(XS + eo + (size_t)i * 8 * T * 32) = o; } }
    }
}

constexpr int PK_TV = 0, PK_EID = 65536, PK_GATE = 81920;
__device__ __forceinline__ int f2key(float x) { const int b = __float_as_int(x); return b ^ ((b >> 31) & 0x7fffffff); }
__device__ __forceinline__ float key2f(int k) { return __int_as_float(k ^ ((k >> 31) & 0x7fffffff)); }
__device__ __forceinline__ int imed3(int a, int b, int c) { int r; asm("v_med3_i32 %0, %1, %2, %3" : "=v"(r) : "v"(a), "v"(b), "v"(c)); return r; }
#define INSK(kx) do { const int _x = (kx); _Pragma("unroll") for (int _k = 15; _k > 0; --_k) tk[_k] = imed3(tk[_k - 1], tk[_k], _x); tk[0] = max(tk[0], _x); } while (0)
__device__ __forceinline__ void phase_topk(const Frame& F0, int l) {
    Frame F = F0; F.tid = F.wave * 64 + lane_id(); asm volatile("" : "+v"(F.tid)); F.lane = F.tid & 63;
    unsigned char* ws = opqg(F.ws);
    const float* SC = (const float*)(ws + WS_SC); int* SEID = (int*)(ws + WS_SEID); float* SGATE = (float*)(ws + WS_SGATE); unsigned char* START = ws + WS_START;
    LAS int* TK = (LAS int*)(F.lds + PK_TV); LAS int* EIDL = (LAS int*)(F.lds + PK_EID); LAS float* GATEL = (LAS float*)(F.lds + PK_GATE);
    for (int tb = F.vcu; tb < T / 32; tb += F.G) {
        const int t0 = tb * 32;
        { const int tok = F.tid >> 4, hh = F.tid & 15;
          const v4u* sp = (const v4u*)((const bf16*)SC + (size_t)(t0 + tok) * 2048 + hh * 128);
          int tk[16];
#pragma unroll
          for (int k = 0; k < 16; ++k) tk[k] = (int)0x80000000;
#pragma unroll 2
          for (int i = 0; i < 16; ++i) { const v4u s0 = sp[i]; const unsigned sw[4] = {s0.x, s0.y, s0.z, s0.w};
#pragma unroll
              for (int x = 0; x < 4; ++x) { INSK((f2key(bf_lo(sw[x])) & ~127) | (127 - (8 * i + 2 * x))); INSK((f2key(bf_hi(sw[x])) & ~127) | (127 - (8 * i + 2 * x + 1))); } }
#pragma unroll
          for (int k = 0; k < 16; ++k) TK[F.tid * 16 + k] = tk[k]; }
        __syncthreads();
        if ((F.tid & 1) == 0) {
            float v1[16], v2[16];
#pragma unroll
            for (int k = 0; k < 16; ++k) { v1[k] = key2f(TK[F.tid * 16 + k] & ~127); v2[k] = key2f(TK[(F.tid + 1) * 16 + k] & ~127); }
            int tk[16];
#pragma unroll
            for (int k = 0; k < 16; ++k) tk[k] = (int)0x80000000;
#pragma unroll
            for (int aa = 0; aa < 16; ++aa)
#pragma unroll
                for (int bb = 0; bb < 16; ++bb) if ((aa + 1) * (bb + 1) <= 16) { INSK((f2key(v1[aa] + v2[bb]) & ~255) | (255 - (aa * 16 + bb))); }
            float ex[16], sum = 0.f; const float v0 = key2f(tk[0] & ~255);
#pragma unroll
            for (int k = 0; k < 16; ++k) { ex[k] = expf(key2f(tk[k] & ~255) - v0); sum += ex[k]; }
            const float inv = 1.f / sum;
            const int tok = F.tid >> 4, hd = (F.tid >> 1) & 7;
#pragma unroll
            for (int k = 0; k < 16; ++k) { const int code = 255 - (tk[k] & 255);
                const int i1 = 127 - (TK[F.tid * 16 + (code >> 4)] & 127), i2 = 127 - (TK[(F.tid + 1) * 16 + (code & 15)] & 127);
                EIDL[tok * 128 + hd * 16 + k] = (((i1 + i2) & 15) << 10) + i1 * 8 + (i2 >> 4); GATEL[tok * 128 + hd * 16 + k] = ex[k] * inv; }
        }
        __syncthreads();
        for (int ti = 0; ti < 4; ++ti) {
            const int tok = F.wave * 4 + ti;
            int k0 = (EIDL[tok * 128 + F.lane] << 7) | F.lane, k1 = (EIDL[tok * 128 + 64 + F.lane] << 7) | (64 + F.lane);
#pragma unroll
            for (int k = 2; k <= 128; k <<= 1)
#pragma unroll
                for (int j = k >> 1; j > 0; j >>= 1) {
                    if (j == 64) { const int mn = min(k0, k1), mx = max(k0, k1); k0 = mn; k1 = mx; }
                    else { const int o0 = __shfl_xor(k0, j), o1 = __shfl_xor(k1, j); const bool lower = (F.lane & j) == 0;
                        const bool up0 = (F.lane & k) == 0, up1 = ((64 + F.lane) & k) == 0;
                        k0 = (up0 == lower) ? min(k0, o0) : max(k0, o0); k1 = (up1 == lower) ? min(k1, o1) : max(k1, o1); }
                }
            const size_t t = (size_t)(t0 + tok);
            { const int r0 = k0 >> 17, r1 = k1 >> 17; int mine = 0;
#pragma unroll
              for (int r = 1; r < 16; ++r) { const int c = __builtin_popcountll(__ballot(r0 < r)) + __builtin_popcountll(__ballot(r1 < r)); mine = (F.lane == r) ? c : mine; }
              if (F.lane < 16) START[t * 16 + F.lane] = (unsigned char)mine; }
            SEID[t * LP + F.lane] = k0 >> 7; SEID[t * LP + 64 + F.lane] = k1 >> 7;
            SGATE[t * 128 + F.lane] = GATEL[tok * 128 + (k0 & 127)]; SGATE[t * 128 + 64 + F.lane] = GATEL[tok * 128 + (k1 & 127)];
        }
        __syncthreads();
    }
}
typedef __bf16 bf2_t __attribute__((ext_vector_type(2)));
__device__ __forceinline__ float dot2bf(unsigned a, unsigned b, float c) { return __builtin_amdgcn_fdot2_f32_bf16(__builtin_bit_cast(bf2_t, a), __builtin_bit_cast(bf2_t, b), c, false); }
__device__ __forceinline__ void peer_stage(const Frame& F, const bf16* gsrc, int bo) {
#pragma unroll
    for (int i = 0; i < 8; ++i) { const int p = i * 8 + F.wave;
        __builtin_amdgcn_global_load_lds((const unsigned*)((const char*)gsrc + p * 1024 + F.lane * 16), (LAS unsigned*)(F.lds + bo + p * 1024), 16, 0, 0); }
}
__device__ __forceinline__ void peer_dma(const Frame& F, const void* gsrc, int bo) {
    const unsigned ldsbase = (unsigned)(size_t)(F.lds + bo) + (unsigned)F.wave * 1024u;
#pragma unroll
    for (int i = 0; i < 8; ++i) { const char* g = (const char*)gsrc + (i * 8 + F.wave) * 1024 + F.lane * 16; const unsigned m = ldsbase + i * 8192u;
        asm volatile("s_mov_b32 m0, %0\n\ts_nop 0\n\tglobal_load_lds_dwordx4 %1, off" :: "s"(m), "v"((GAS const char*)g) : "memory"); }
}
__device__ __forceinline__ int wave_max_i(int v) {
#pragma unroll
    for (int o = 1; o < 64; o <<= 1) v = max(v, __shfl_xor(v, o));
    return __builtin_amdgcn_readfirstlane(v);
}
template <int K> __device__ __forceinline__ unsigned dppq(unsigned v) { return (unsigned)__builtin_amdgcn_mov_dpp((int)v, K * 0x55, 0xf, 0xf, true); }
__device__ __forceinline__ float quad_sum(float v) {
    v += __int_as_float(__builtin_amdgcn_mov_dpp(__float_as_int(v), 0xB1, 0xf, 0xf, true));
    v += __int_as_float(__builtin_amdgcn_mov_dpp(__float_as_int(v), 0x4E, 0xf, 0xf, true));
    return v;
}
constexpr int UCAP0 = 24, UCAP1 = 12, UCAP2 = 12, UCAP3 = 8;
__device__ __forceinline__ void phase_peer_u(const Frame& F0, int l) {
    Frame F = F0; F.tid = F.wave * 64 + lane_id(); asm volatile("" : "+v"(F.tid)); F.lane = F.tid & 63;
    unsigned char* ws = opqg(F.ws);
    const bf16* TU = (const bf16*)(ws + WS_TBU) + (size_t)l * 64 * NEXP * 32;
    const int* SEID = (const int*)(ws + WS_SEID); const float* SGATE = (const float*)(ws + WS_SGATE); unsigned* PACK = (unsigned*)(ws + WS_PACK); unsigned char* START = ws + WS_START;
    const bf16* XBS = (const bf16*)(ws + WS_XBS); unsigned* PACK2 = (unsigned*)(ws + WS_PACK2);
    const int qd = F.lane >> 2, jc = F.lane & 3;
    for (int unit = F.vcu; unit < 256; unit += F.G) {
        const int tt = unit & 15, er = unit >> 4; const size_t t = (size_t)tt * 512 + F.tid;
        const int lo = START[t * 16 + er], hi = (er < 15) ? (int)START[t * 16 + er + 1] : 128;
        const int cnt = hi - lo;
        int key = (cnt << 6) | (63 - F.lane);
#pragma unroll
        for (int k = 2; k <= 64; k <<= 1)
#pragma unroll
            for (int j = k >> 1; j > 0; j >>= 1) { const int o = __shfl_xor(key, j); const bool lower = (F.lane & j) == 0, up = (F.lane & k) == 0;
                key = (up == lower) ? max(key, o) : min(key, o); }
        int tl[4], glo[4], gcnt[4], gmax[4];
#pragma unroll
        for (int a = 0; a < 4; ++a) { const int kk = __shfl(key, a * 16 + qd); tl[a] = 63 - (kk & 63); gcnt[a] = kk >> 6; glo[a] = __shfl(lo, tl[a]);
            gmax[a] = __builtin_amdgcn_readfirstlane(__shfl(key, a * 16)) >> 6; }
        const size_t tbase = (size_t)tt * 512 + F.wave * 64;
        unsigned ro0[UCAP0 / 4], ro1[UCAP1 / 4], ro2[UCAP2 / 4], ro3[UCAP3 / 4];
#define LOADRO(arr, a, CAP) _Pragma("unroll") for (int i = 0; i < CAP / 4; ++i) { const int s = 4 * i + jc; const int e = SEID[(tbase + tl[a]) * LP + glo[a] + s]; \
            const int row = (s < gcnt[a]) ? (e & 1023) : 0; arr[i] = (unsigned)((row << 6) + (((row >> 2) & 3) << 4)); }
        LOADRO(ro0, 0, UCAP0) LOADRO(ro1, 1, UCAP1) LOADRO(ro2, 2, UCAP2) LOADRO(ro3, 3, UCAP3)
#undef LOADRO
        float ac0[UCAP0], ac1[UCAP1], ac2[UCAP2], ac3[UCAP3];
#pragma unroll
        for (int s = 0; s < UCAP0; ++s) ac0[s] = 0.f;
#pragma unroll
        for (int s = 0; s < UCAP1; ++s) ac1[s] = 0.f;
#pragma unroll
        for (int s = 0; s < UCAP2; ++s) ac2[s] = 0.f;
#pragma unroll
        for (int s = 0; s < UCAP3; ++s) ac3[s] = 0.f;
        const bf16* gsl0 = TU + (size_t)er * 1024 * 32;
#define XA(a) ((const v4u*)(XBS + (tbase + tl[a]) * 32) + jc)
        v4u xs[4];
#pragma unroll
        for (int a = 0; a < 4; ++a) xs[a] = XA(a)[0];
        peer_dma(F, gsl0, 0);
        VM_WAIT(); __syncthreads();
#pragma unroll 1
        for (int ks = 0; ks < 64; ++ks) {
            const int bo = (ks & 1) * 65536, jx = jc << 4;
            v4u xn[4];
            const int kn = (ks + 1 < 64) ? ks + 1 : ks;
#pragma unroll
            for (int a = 0; a < 4; ++a) xn[a] = XA(a)[(size_t)kn * T * 4];
            if (ks + 1 < 64) peer_dma(F, gsl0 + (size_t)kn * NEXP * 32, bo ^ 65536);
#define URD(B, arr, g) { asm volatile("" : "+v"(arr[g])); B[0] = *(const LAS v4u*)(F.lds + bo + (dppq<0>(arr[g]) ^ jx)); B[1] = *(const LAS v4u*)(F.lds + bo + (dppq<1>(arr[g]) ^ jx)); \
                B[2] = *(const LAS v4u*)(F.lds + bo + (dppq<2>(arr[g]) ^ jx)); B[3] = *(const LAS v4u*)(F.lds + bo + (dppq<3>(arr[g]) ^ jx)); }
#define UCP(B, acc, a, g) { _Pragma("unroll") for (int q = 0; q < 4; ++q) { float p0 = acc[4 * (g) + q]; \
                p0 = dot2h(B[q].x, xs[a].x, p0); p0 = dot2h(B[q].y, xs[a].y, p0); p0 = dot2h(B[q].z, xs[a].z, p0); p0 = dot2h(B[q].w, xs[a].w, p0); acc[4 * (g) + q] = p0; } }
            { v4u BE[4], BO[4];
              URD(BE, ro0, 0) __builtin_amdgcn_sched_barrier(0);
              URD(BO, ro0, 1) UCP(BE, ac0, 0, 0)
              __builtin_amdgcn_sched_barrier(0);
              URD(BE, ro0, 2) UCP(BO, ac0, 0, 1)
              __builtin_amdgcn_sched_barrier(0);
              URD(BO, ro0, 3) UCP(BE, ac0, 0, 2)
              __builtin_amdgcn_sched_barrier(0);
              URD(BE, ro0, 4) UCP(BO, ac0, 0, 3)
              __builtin_amdgcn_sched_barrier(0);
              URD(BO, ro0, 5) UCP(BE, ac0, 0, 4)
              __builtin_amdgcn_sched_barrier(0);
              URD(BE, ro1, 0) UCP(BO, ac0, 0, 5)
              __builtin_amdgcn_sched_barrier(0);
              URD(BO, ro1, 1) UCP(BE, ac1, 1, 0)
              __builtin_amdgcn_sched_barrier(0);
              URD(BE, ro1, 2) UCP(BO, ac1, 1, 1)
              __builtin_amdgcn_sched_barrier(0);
              URD(BO, ro2, 0) UCP(BE, ac1, 1, 2)
              __builtin_amdgcn_sched_barrier(0);
              URD(BE, ro2, 1) UCP(BO, ac2, 2, 0)
              __builtin_amdgcn_sched_barrier(0);
              URD(BO, ro2, 2) UCP(BE, ac2, 2, 1)
              __builtin_amdgcn_sched_barrier(0);
              URD(BE, ro3, 0) UCP(BO, ac2, 2, 2)
              __builtin_amdgcn_sched_barrier(0);
              URD(BO, ro3, 1) UCP(BE, ac3, 3, 0)
              __builtin_amdgcn_sched_barrier(0);
              UCP(BO, ac3, 3, 1) }
#undef URD
#undef UCP
#pragma unroll
            for (int a = 0; a < 4; ++a) xs[a] = xn[a];
            VM_WAIT(); __syncthreads();
        }
        float gt0[UCAP0 / 4], gt1[UCAP1 / 4], gt2[UCAP2 / 4], gt3[UCAP3 / 4];
#define UGT(gt, a, CAP) { const float* gp_ = SGATE + (tbase + tl[a]) * 128; _Pragma("unroll") for (int i = 0; i < CAP / 4; ++i) gt[i] = gp_[min(glo[a] + 4 * i + jc, 127)]; }
        UGT(gt0, 0, UCAP0) UGT(gt1, 1, UCAP1) UGT(gt2, 2, UCAP2) UGT(gt3, 3, UCAP3)
#undef UGT
#define UOUT(arr, acc, gt, a, CAP) { const size_t tk = tbase + tl[a]; _Pragma("unroll") for (int s = 0; s < CAP; ++s) { const float tot = quad_sum(acc[s]); \
            if ((s & 3) == jc && s < NSLOT) { unsigned wv = 0u; if (s < gcnt[a]) { const float av = gelu_tanh(tot) * gt[s >> 2]; wv = (arr[s >> 2] << 16) | (cvt_pk_f16(av, 0.f) & 0xffffu); } \
                PACK2[(tk * 16 + er) * NSLOT + s] = wv; } } \
            _Pragma("unroll") for (int s = CAP; s < NSLOT; ++s) if ((s & 3) == jc && s >= gcnt[a]) PACK2[(tk * 16 + er) * NSLOT + s] = 0u; }
        UOUT(ro0, ac0, gt0, 0, UCAP0) UOUT(ro1, ac1, gt1, 1, UCAP1) UOUT(ro2, ac2, gt2, 2, UCAP2) UOUT(ro3, ac3, gt3, 3, UCAP3)
#undef UOUT
#undef XA
        { int myrank = 0; const int mykey = (cnt << 6) | (63 - F.lane);
          for (int p = 0; p < 64; ++p) myrank += (__shfl(key, p) > mykey) ? 1 : 0;
          const int cap = myrank < 16 ? UCAP0 : (myrank < 32 ? UCAP1 : (myrank < 48 ? UCAP2 : UCAP3));
          const v4u* xsp = (const v4u*)(XBS + t * 32);
          for (int s = cap; s < cnt; ++s) {
              const int pos = lo + s, e = SEID[t * LP + pos]; const int f = (e >> 2) & 3; float d = 0.f;
              for (int ks = 0; ks < 64; ++ks)
#pragma unroll
                  for (int j = 0; j < 4; ++j) { const v4u u4 = *(const v4u*)(TU + (((size_t)ks * NEXP + e) * 4 + (j ^ f)) * 8); const v4u x4 = xsp[(size_t)ks * T * 4 + j];
                      d = dot2h(u4.x, x4.x, d); d = dot2h(u4.y, x4.y, d); d = dot2h(u4.z, x4.z, d); d = dot2h(u4.w, x4.w, d); }
              const int row = e & 1023;
              const unsigned wv = ((unsigned)((row << 6) + (((row >> 2) & 3) << 4)) << 16) | (cvt_pk_f16(gelu_tanh(d) * SGATE[t * 128 + pos], 0.f) & 0xffffu);
              if (s < NSLOT) PACK2[(t * 16 + er) * NSLOT + s] = wv; else PACK[t * LP + pos] = wv; }
        }
    }
}
#ifndef VBLK
#define VBLK 2
#endif
#if VBLK == 4
#define VTT(x, j) (4 * ((x) & 3) + ((j) & 3))
#define VDS(x, j, it) (32 * ((x) >> 2) + 8 * (it) + ((j) >> 2))
#elif VBLK == 8
#define VTT(x, j) (8 * ((x) & 1) + ((j) & 7))
#define VDS(x, j, it) (16 * ((x) >> 1) + 4 * (it) + ((j) >> 3))
#elif VBLK == 2
#define VTT(x, j) (2 * (x) + ((j) & 1))
#define VDS(x, j, it) (16 * (it) + ((j) >> 1))
#else
#define VTT(x, j) ((j) & 15)
#define VDS(x, j, it) (((x) * 32 + (j) + 256 * (it)) >> 4)
#endif
__device__ __forceinline__ void phase_peer_v(const Frame& F0, int l) {
    Frame F = F0; F.tid = F.wave * 64 + lane_id(); asm volatile("" : "+v"(F.tid)); F.lane = F.tid & 63;
    unsigned char* ws = opqg(F.ws);
    const bf16* TV = (const bf16*)(ws + WS_TBV) + (size_t)l * 64 * NEXP * 32; const bf16* XS = (const bf16*)(ws + WS_XH); bf16* RS = (bf16*)(ws + WS_RH);
    const unsigned* PACK = (const unsigned*)(ws + WS_PACK); const unsigned char* START = ws + WS_START; const unsigned* PACK2 = (const unsigned*)(ws + WS_PACK2);
    for (int it = 0; it * F.G + F.vcu < 1024; ++it) {
        int tt, ds;
        if (F.G == 256) { const int x = F.vcu >> 5, j = F.vcu & 31; tt = VTT(x, j); ds = VDS(x, j, it); }
        else { const int unit = it * F.G + F.vcu; tt = unit & 15; ds = unit >> 4; }
        const size_t t = (size_t)tt * 512 + F.tid;
        const v4u st4 = *(const v4u*)(START + t * 16);
        const unsigned stw[4] = {st4.x, st4.y, st4.z, st4.w};
        unsigned acc[16];
#pragma unroll
        for (int i = 0; i < 16; ++i) acc[i] = 0u;
        const bf16* gsl0 = TV + (size_t)ds * NEXP * 32;
        unsigned Lc[NSLOT];
        { const v4u* lp = (const v4u*)(PACK2 + t * 16 * NSLOT);
#pragma unroll
          for (int s = 0; s < NSLOT / 4; ++s) { const v4u q = lp[s]; Lc[4 * s] = q.x; Lc[4 * s + 1] = q.y; Lc[4 * s + 2] = q.z; Lc[4 * s + 3] = q.w; } }
        peer_dma(F, gsl0, 0);
        VM_WAIT(); __syncthreads();
#pragma unroll 1
        for (int c = 0; c < 16; ++c) {
            const int bo = (c & 1) * 65536;
            const int q0 = c >> 2, q1 = (c + 1) >> 2;
            const unsigned w0 = q0 == 0 ? stw[0] : (q0 == 1 ? stw[1] : (q0 == 2 ? stw[2] : stw[3])), w1 = q1 == 0 ? stw[0] : (q1 == 1 ? stw[1] : (q1 == 2 ? stw[2] : stw[3]));
            const int s_c = (int)((w0 >> ((c & 3) * 8)) & 255u);
            const int s_n = (c < 15) ? (int)((w1 >> (((c + 1) & 3) * 8)) & 255u) : 128;
            const int n_c = s_n - s_c;
            unsigned Ln[NSLOT];
            const int cn = (c < 15) ? c + 1 : c;
            { const v4u* lp = (const v4u*)(PACK2 + (t * 16 + cn) * NSLOT);
#pragma unroll
              for (int s = 0; s < NSLOT / 4; ++s) { const v4u q = lp[s]; Ln[4 * s] = q.x; Ln[4 * s + 1] = q.y; Ln[4 * s + 2] = q.z; Ln[4 * s + 3] = q.w; } }
            if (c < 15) peer_dma(F, gsl0 + (size_t)cn * 1024 * 32, bo ^ 65536);
            const int wmax = wave_max_i(min(n_c, NSLOT));
#pragma unroll
            for (int g = 0; g < NSLOT / 2; ++g) {
                if (2 * g < wmax) {
                    v4u v4[2][4]; unsigned a2[2];
#pragma unroll
                    for (int q = 0; q < 2; ++q) { const int s = 2 * g + q; const unsigned w = Lc[s];
                        a2[q] = __builtin_amdgcn_perm(w, w, 0x01000100u);
                        const int a0 = bo + (int)((w >> 16) & 0xfff0u);
#pragma unroll
                        for (int j = 0; j < 4; ++j) v4[q][j] = *(const LAS v4u*)(F.lds + (a0 ^ (j << 4))); }
#pragma unroll
                    for (int q = 0; q < 2; ++q)
#pragma unroll
                        for (int j = 0; j < 4; ++j) {
                            acc[4 * j + 0] = pkfmah(v4[q][j].x, a2[q], acc[4 * j + 0]); acc[4 * j + 1] = pkfmah(v4[q][j].y, a2[q], acc[4 * j + 1]);
                            acc[4 * j + 2] = pkfmah(v4[q][j].z, a2[q], acc[4 * j + 2]); acc[4 * j + 3] = pkfmah(v4[q][j].w, a2[q], acc[4 * j + 3]); }
                }
            }
            for (int s = NSLOT; s < n_c; ++s) {
                const unsigned w = PACK[t * LP + s_c + s]; const unsigned a2 = (w & 0xffffu) | (w << 16);
                const int a0 = bo + (int)((w >> 16) & 0xfff0u);
#pragma unroll
                for (int j = 0; j < 4; ++j) { const v4u v4 = *(const LAS v4u*)(F.lds + (a0 ^ (j << 4)));
                    acc[4 * j + 0] = pkfmah(v4.x, a2, acc[4 * j + 0]); acc[4 * j + 1] = pkfmah(v4.y, a2, acc[4 * j + 1]);
                    acc[4 * j + 2] = pkfmah(v4.z, a2, acc[4 * j + 2]); acc[4 * j + 3] = pkfmah(v4.w, a2, acc[4 * j + 3]); }
            }
            VM_WAIT(); __syncthreads();
#pragma unroll
            for (int s = 0; s < NSLOT; ++s) Lc[s] = Ln[s];
        }
        const v4u* xp = (const v4u*)(XS + ((size_t)ds * T + t) * 32); v4u* rp = (v4u*)(RS + ((size_t)ds * T + t) * 32);
        v4u xw4[4];
#pragma unroll
        for (int j = 0; j < 4; ++j) xw4[j] = xp[j];
#pragma unroll
        for (int j = 0; j < 4; ++j) { const v4u xw = xw4[j]; const unsigned xx[4] = {xw.x, xw.y, xw.z, xw.w}; unsigned o[4];
#pragma unroll
            for (int k = 0; k < 4; ++k) { const h2_t xv = __builtin_bit_cast(h2_t, xx[k]), yv = __builtin_bit_cast(h2_t, acc[4 * j + k]);
                o[k] = cvt_pk_f16((float)xv.x * ALPHA + (float)yv.x, (float)xv.y * ALPHA + (float)yv.y); }
            rp[j] = (v4u){o[0], o[1], o[2], o[3]}; }
    }
}

constexpr int PH_PER_LAYER = 13, N_PHASES = 2 + DEPTH * PH_PER_LAYER;
__global__ void __launch_bounds__(512, 2) fwd_kernel(Args args) {
    extern __shared__ __attribute__((aligned(16))) unsigned char lds[];
    Frame F;
    F.lds = (LAS unsigned char*)lds;
    F.wave = __builtin_amdgcn_readfirstlane((int)threadIdx.x >> 6); F.tid = 0; F.lane = 0;
    F.G = gridDim.x; { const int bx = blockIdx.x; F.vcu = (F.G % 8 == 0) ? (bx % 8) * (F.G / 8) + bx / 8 : bx; }
    F.ws = args.ws; F.ka = (const __attribute__((address_space(4))) Args*)__builtin_amdgcn_kernarg_segment_ptr();
    unsigned char* ws = args.ws;
    for (int u = F.wave * 64 + lane_id(); u < (LDS_BYTES - LDSCTL_OFF) / 4; u += 512) ((LAS unsigned*)(F.lds + LDSCTL_OFF))[u] = 0u;
    __syncthreads();
    XcdBarrier bar; bar.bar = (unsigned*)(ws + WS_CTL) + CW_BAR; bar.x = 0; bar.st = nullptr;
    const int lo = args.ph_lo, hi = args.ph_hi;
    if (hi - lo > 1) bar = xcd_barrier_post((unsigned*)(ws + WS_CTL) + CW_BAR, (volatile LAS unsigned*)(F.lds + MISC_OFF) + 8, F.wave == 0 && lane_id() == 0);
#ifndef PHMASK
#define PHMASK 0xFFF
#endif
#define EN(i) ((PHMASK >> (i)) & 1)
#ifndef RPT
#define RPT 0
#endif
#define REP(i) for (int _r = 0; _r <= ((RPT >> (i)) & 1); ++_r)
#define IN(k) (lo <= (k) && (k) < hi)
#define SEAM(k) do { if (IN((k) + 1)) xcd_barrier(bar, F.wave); } while (0)

    if (EN(10) && IN(0)) { REP(13) { phase_prologue_a(F); } SEAM(0); }
    if (EN(11) && IN(1)) REP(14) {
        phase_prologue_b(F);
        unsigned char* ws = opqg(args.ws);
        int kc = 256; asm volatile("" : "+s"(kc));
        pg8::Gemm g{(const bf16*)(ws + WS_BK), (const bf16*)(ws + WS_WQB), DEPTH * 2048, 2048, kc, 256, 2048, 256, (long)2048 * 2048};
        pg8::StaticOrder S; S.init(DEPTH * 2048, 2048, F.G, (int)blockIdx.x);
        pg8::EpiF16 E{(bf16*)(ws + WS_WPQ), 2048};
        pg8::gemm_phase<pg8::EpiF16, pg8::StaticOrder, true>(F.lds, g, S, E, F.wave);
        if (_r == ((RPT >> 14) & 1)) SEAM(1);
    }
    for (int l = 0; l < DEPTH; ++l) {
        const int pb = 2 + l * PH_PER_LAYER;
        if (EN(0) && IN(pb + 0)) REP(0) {
            unsigned char* ws = opqg(args.ws);
            pg8::Gemm g{(const bf16*)(ws + WS_XH), (const bf16*)(ws + WS_WIN) + (size_t)l * NIN * D, T, NIN, D, T, D, 0, 0};
            pg8::StaticOrder S; S.init(T, (F.G == 256) ? 32 * 256 : NIN, F.G, (int)blockIdx.x);
            pg8::EpiIn E{(bf16*)(ws + WS_Q), (bf16*)(ws + WS_KK), (bf16*)(ws + WS_V), (bf16*)(ws + WS_SG), (bf16*)(ws + WS_UB), (bf16*)(ws + WS_GR), (bf16*)(ws + WS_GB),
                         (float*)(ws + WS_LOGF), (const float*)(ws + WS_LB) + l * AW};
            pg8::gemm_phase<pg8::EpiIn, pg8::StaticOrder, true, true, true>(F.lds, g, S, E, F.wave);
            if (_r == ((RPT >> 0) & 1)) SEAM(pb + 0);
        }
        if (EN(1) && IN(pb + 1)) { REP(1) { REP(17) { phase_hgrn_local(F, l); } REP(18) { phase_s5_local(F, l); } } SEAM(pb + 1); }
        if (EN(2) && IN(pb + 2)) { REP(2) { phase_scan(F, l); } SEAM(pb + 2); }
        if (EN(3) && IN(pb + 3)) { REP(3) { REP(15) { phase_hgrn_out(F, l); } REP(16) { phase_s5_out(F, l); } } SEAM(pb + 3); }
        if (EN(4) && IN(pb + 4)) REP(4) {
            unsigned char* ws = opqg(args.ws);
            if (F.G == 256 && blockIdx.x < 128) {
                pg8::Gemm g{(const bf16*)(ws + WS_XH), (const bf16*)(ws + WS_WIN) + (size_t)l * NIN * D, T, NIN, D, T, D, 0, 0};
                pg8::OffOrder S; S.init(T, 4 * 256, F.G, (int)blockIdx.x, 32);
                pg8::EpiIn E{(bf16*)(ws + WS_Q), (bf16*)(ws + WS_KK), (bf16*)(ws + WS_V), (bf16*)(ws + WS_SG), (bf16*)(ws + WS_UB), (bf16*)(ws + WS_GR), (bf16*)(ws + WS_GB),
                             (float*)(ws + WS_LOGF), (const float*)(ws + WS_LB) + l * AW};
                pg8::gemm_phase<pg8::EpiIn, pg8::OffOrder, true, true, true>(F.lds, g, S, E, F.wave);
            } else {
                pg8::Gemm g{(const bf16*)(ws + WS_YB), (const bf16*)(ws + WS_WGLU) + (size_t)l * 2048 * 1024, T, 2048, 1024, 1024, 1024, 0, 0};
                pg8::EpiGlu E{(bf16*)(ws + WS_OAB) + 1024, 2048};
                if (F.G == 256) { pg8::PairOrder S{(int)blockIdx.x, 128, 8, 256}; pg8::gemm_phase<pg8::EpiGlu, pg8::PairOrder, true>(F.lds, g, S, E, F.wave); }
                else { pg8::StaticOrder S; S.init(T, 2048, F.G, (int)blockIdx.x); pg8::gemm_phase<pg8::EpiGlu, pg8::StaticOrder, true>(F.lds, g, S, E, F.wave); }
            }
            if (_r == ((RPT >> 4) & 1)) SEAM(pb + 4);
        }
        if (EN(5) && IN(pb + 5)) REP(5) {
            unsigned char* ws = opqg(args.ws);
            pg8::Gemm g{(const bf16*)(ws + WS_OAB), (const bf16*)(ws + WS_WUP) + (size_t)l * 2048 * 2048, T, 2048, 2048, 2048, 2048, 0, 0};
            pg8::StaticOrder S; S.init(T, 2048, F.G, (int)blockIdx.x);
            pg8::EpiUp E{(bf16*)(ws + WS_MG), (const bf16*)(ws + WS_GR), (const bf16*)(ws + WS_GB)};
            pg8::gemm_phase<pg8::EpiUp, pg8::StaticOrder, true>(F.lds, g, S, E, F.wave);
            if (_r == ((RPT >> 5) & 1)) SEAM(pb + 5);
        }
        if (EN(6) && IN(pb + 6)) REP(6) {
            unsigned char* ws = opqg(args.ws);
            pg8::Gemm g{(const bf16*)(ws + WS_MG), (const bf16*)(ws + WS_WO) + (size_t)l * 2048 * 2048, T, 2048, 2048, 2048, 2048, 0, 0};
            pg8::StaticOrder S; S.init(T, 2048, F.G, (int)blockIdx.x);
            pg8::EpiResH E{(bf16*)(ws + WS_RH), (const bf16*)(ws + WS_XH)};
            pg8::gemm_phase<pg8::EpiResH, pg8::StaticOrder, true>(F.lds, g, S, E, F.wave);
            if (_r == ((RPT >> 6) & 1)) SEAM(pb + 6);
        }
        if (EN(7) && IN(pb + 7)) { REP(7) { phase_ln(F, l, 0); } SEAM(pb + 7); }
        if (EN(8) && IN(pb + 8)) REP(8) {
            unsigned char* ws = opqg(args.ws);
            pg8::Gemm g{(const bf16*)(ws + WS_XH), (const bf16*)(ws + WS_WPQ) + (size_t)l * 2048 * 2048, T, 2048, 2048, T, 2048, 0, 0};
            pg8::StaticOrder S; S.init(T, 2048, F.G, (int)blockIdx.x);
            pg8::EpiBf16 E{(bf16*)(ws + WS_SC), 2048};
            pg8::gemm_phase<pg8::EpiBf16, pg8::StaticOrder, true, true, true>(F.lds, g, S, E, F.wave);
            if (_r == ((RPT >> 8) & 1)) SEAM(pb + 8);
        }
        if (EN(9) && IN(pb + 9)) { REP(9) { phase_topk(F, l); } SEAM(pb + 9); }
        if (EN(9) && IN(pb + 10)) { REP(10) { phase_peer_u(F, l); } SEAM(pb + 10); }
        if (EN(9) && IN(pb + 11)) { REP(11) { phase_peer_v(F, l); } SEAM(pb + 11); }
        if (EN(9) && IN(pb + 12)) { REP(12) { phase_ln(F, l, 1); } SEAM(pb + 12); }
    }
#undef IN
#undef SEAM
}

extern "C" void kernel_launch(void* const* d_in, const int* in_sizes, int n_in, void* d_out, int out_size, void* d_ws, size_t ws_size, hipStream_t stream) {
    static int grid = 0;
    if (grid == 0) {
        if (n_in != 24 || out_size != T * D || ws_size < WS_END) { fprintf(stderr, "kernel_launch: unexpected sizes (n_in %d out %d ws %zu need %zu)\n", n_in, out_size, ws_size, (size_t)WS_END); grid = -1; return; }
        int dev = 0, cus = 0, per_cu = 0;
        if (hipGetDevice(&dev) != hipSuccess || hipDeviceGetAttribute(&cus, hipDeviceAttributeMultiprocessorCount, dev) != hipSuccess) { grid = -1; return; }
        if (hipFuncSetAttribute((const void*)fwd_kernel, hipFuncAttributeMaxDynamicSharedMemorySize, LDS_BYTES) != hipSuccess) { fprintf(stderr, "kernel_launch: hipFuncSetAttribute failed\n"); grid = -1; return; }
        if (hipOccupancyMaxActiveBlocksPerMultiprocessor(&per_cu, (const void*)fwd_kernel, 512, LDS_BYTES) != hipSuccess || per_cu < 1)
            fprintf(stderr, "kernel_launch: occupancy query reports %d\n", per_cu);
        (void)hipGetLastError();
        grid = cus;
    }
    if (grid < 0) return;
    if (hipMemsetAsync((char*)d_ws + WS_CTL, 0, CTL_ZERO_BYTES, stream) != hipSuccess) return;
    Args a{};
    for (int i = 0; i < 24; ++i) a.in[i] = (const float*)d_in[i];
    a.out = (float*)d_out; a.ws = (unsigned char*)d_ws;
#if ONE_LAUNCH
    a.ph_lo = 0; a.ph_hi = N_PHASES;
    hipLaunchKernelGGL(fwd_kernel, dim3(grid), dim3(512), LDS_BYTES, stream, a);
#else
    for (int p = 0; p < N_PHASES; ++p) { a.ph_lo = p; a.ph_hi = p + 1; hipLaunchKernelGGL(fwd_kernel, dim3(grid), dim3(512), LDS_BYTES, stream, a); }
#endif
}
```

```cpp
#include <hip/hip_runtime.h>
#include <cstdio>
#include <cstdint>

#define LAS __attribute__((address_space(3)))
#define GAS __attribute__((address_space(1)))
typedef unsigned short bf16;
typedef unsigned v4u __attribute__((ext_vector_type(4)));
typedef unsigned v2u __attribute__((ext_vector_type(2)));
typedef float f32x4 __attribute__((ext_vector_type(4)));
typedef float f32x2 __attribute__((ext_vector_type(2)));
typedef short bf16x8 __attribute__((ext_vector_type(8)));
typedef short s16x4 __attribute__((ext_vector_type(4)));

#ifndef ONE_LAUNCH
#define ONE_LAUNCH 1
#endif

constexpr int T = 8192, D = 2048, DEPTH = 4, NIN = 9216;
constexpr int AW = 1024;
constexpr int NCH = 128;
constexpr float ALPHA = 1.6817928305074290f;
constexpr float LN_EPS = 1e-5f, RMS_EPS = 1e-6f;
constexpr int NEXP = 16384;
constexpr int LP = 160;
constexpr int NSLOT = 24;

constexpr size_t MiB = 1u << 20;
constexpr size_t WS_CTL = 0, CTL_ZERO_BYTES = 32768;
constexpr size_t WS_WIN  = 1 * MiB;
constexpr size_t WS_WGLU = WS_WIN + 144 * MiB;
constexpr size_t WS_WUP  = WS_WGLU + 16 * MiB;
constexpr size_t WS_WO   = WS_WUP + 32 * MiB;
constexpr size_t WS_WQB  = WS_WO + 32 * MiB;
constexpr size_t WS_BK   = WS_WQB + 32 * MiB;
constexpr size_t WS_WPQ  = WS_BK + 4 * MiB;
constexpr size_t WS_LB   = WS_WPQ + 32 * MiB;
constexpr size_t WS_APOW = WS_LB + 1 * MiB;
constexpr size_t WS_BB   = WS_APOW + 9 * MiB;
constexpr size_t WS_KMAT = WS_BB + 2 * MiB;
constexpr size_t WS_PM   = WS_KMAT + 9 * MiB;
constexpr size_t WS_E    = WS_PM + 64 * MiB;
constexpr size_t WS_X32  = WS_E + 64 * MiB;
constexpr size_t WS_X1   = WS_X32 + 64 * MiB;
constexpr size_t WS_XB   = WS_X1 + 64 * MiB;
constexpr size_t WS_Q    = WS_XB + 32 * MiB;
constexpr size_t WS_KK   = WS_Q + 16 * MiB;
constexpr size_t WS_V    = WS_KK + 16 * MiB;
constexpr size_t WS_SG   = WS_V + 16 * MiB;
constexpr size_t WS_UB   = WS_SG + 16 * MiB;
constexpr size_t WS_LOGF = WS_UB + 16 * MiB;
constexpr size_t WS_GR   = WS_LOGF + 32 * MiB;
constexpr size_t WS_GB   = WS_GR + 32 * MiB;
constexpr size_t WS_U    = WS_GB + 32 * MiB;
constexpr size_t WS_SP   = WS_U + 64 * MiB;
constexpr size_t WS_BL   = WS_SP + 32 * MiB;
constexpr size_t WS_XLOC = WS_BL + 1 * MiB;
constexpr size_t WS_XS   = WS_XLOC + 4 * MiB;
constexpr size_t WS_OAB  = WS_XS + 4 * MiB;
constexpr size_t WS_YB   = WS_OAB + 32 * MiB;
constexpr size_t WS_MG   = WS_YB + 16 * MiB;
constexpr size_t WS_R    = WS_MG + 32 * MiB;
constexpr size_t WS_SC   = WS_R + 64 * MiB;
constexpr size_t WS_TBU  = WS_SC + 64 * MiB;
constexpr size_t WS_TBV  = WS_TBU + 256 * MiB;
constexpr size_t WS_SEID = WS_TBV + 256 * MiB;
constexpr size_t WS_SGATE= WS_SEID + 6 * MiB;
constexpr size_t WS_PACK = WS_SGATE + 4 * MiB;
constexpr size_t WS_START= WS_PACK + 6 * MiB;
constexpr size_t WS_PACK2= WS_START + 1 * MiB;
constexpr size_t WS_XBS  = WS_PACK2 + 13 * MiB;
constexpr size_t WS_END  = WS_XBS + 32 * MiB;
constexpr size_t WS_XH = WS_XBS;
constexpr size_t WS_XQ = WS_X1;
constexpr size_t WS_SX = WS_X1 + 16 * MiB;
constexpr size_t WS_SU = WS_X1 + 17 * MiB;
constexpr size_t WS_RH = WS_R;

constexpr int CW_TMO = 0, CW_CODE = 1;
constexpr int CW_BAR = 4096;

constexpr int RING_BYTES = 131072;
constexpr int LDSCTL_OFF = RING_BYTES, MISC_OFF = LDSCTL_OFF + 320;
constexpr int LDS_BYTES = 147456;

#define LDS_WAIT() asm volatile("s_waitcnt lgkmcnt(0)" ::: "memory")
#define VM_WAIT() asm volatile("s_waitcnt vmcnt(0)" ::: "memory")
__device__ __forceinline__ unsigned cvt_pk_bf16(float lo, float hi) { unsigned r; asm volatile("v_cvt_pk_bf16_f32 %0, %1, %2" : "=v"(r) : "v"(lo), "v"(hi)); return r; }
typedef _Float16 h2_t __attribute__((ext_vector_type(2)));
__device__ __forceinline__ unsigned cvt_pk_f16a(float lo, float hi) { unsigned r; asm volatile("v_cvt_pk_f16_f32 %0, %1, %2" : "=v"(r) : "v"(lo), "v"(hi)); return r; }
__device__ __forceinline__ unsigned cvt_pk_f16(float lo, float hi) { h2_t p; p.x = (_Float16)lo; p.y = (_Float16)hi; return __builtin_bit_cast(unsigned, p); }
__device__ __forceinline__ float dot2h(unsigned a, unsigned b, float c) { return __builtin_amdgcn_fdot2(__builtin_bit_cast(h2_t, a), __builtin_bit_cast(h2_t, b), c, false); }
__device__ __forceinline__ unsigned pkfmah(unsigned a, unsigned b, unsigned c) { return __builtin_bit_cast(unsigned, __builtin_elementwise_fma(__builtin_bit_cast(h2_t, a), __builtin_bit_cast(h2_t, b), __builtin_bit_cast(h2_t, c))); }
__device__ __forceinline__ float bf_lo(unsigned u) { return __uint_as_float(u << 16); }
__device__ __forceinline__ float bf_hi(unsigned u) { return __uint_as_float(u & 0xffff0000u); }
__device__ __forceinline__ float bf2f(bf16 b) { return __uint_as_float(((unsigned)b) << 16); }
__device__ __forceinline__ bf16 f2bf(float f) { return (bf16)(cvt_pk_bf16(f, 0.f) & 0xffffu); }
__device__ __forceinline__ float fexp(float x) { return __builtin_amdgcn_exp2f(x * 1.4426950408889634f); }
__device__ __forceinline__ float flog(float x) { return __builtin_amdgcn_logf(x) * 0.6931471805599453f; }
__device__ __forceinline__ float frcp(float x) { return __builtin_amdgcn_rcpf(x); }
__device__ __forceinline__ float gelu_tanh(float x) {
    const float u = 1.5957691216057308f * (x + 0.044715f * x * x * x);
    const float uc = fminf(fmaxf(u, -60.f), 60.f);
    return x * frcp(1.f + fexp(-uc));
}
__device__ __forceinline__ int lane_id() { int r; asm volatile("v_mbcnt_lo_u32_b32 %0, -1, 0\n\tv_mbcnt_hi_u32_b32 %0, -1, %0" : "=v"(r)); return r; }
__device__ __forceinline__ float wave_sum(float v) {
#pragma unroll
    for (int o = 1; o < 64; o <<= 1) v += __shfl_xor(v, o);
    return v;
}

__device__ __forceinline__ void vlaunder(int& a, int& b) { asm volatile("" : "+v"(a), "+v"(b)); }
template <class P> __device__ __forceinline__ P* opq(P* p) { asm volatile("" : "+s"(p)); return p; }
__device__ __forceinline__ unsigned char* opqg(unsigned char* p) { GAS unsigned char* g = (GAS unsigned char*)p; asm volatile("" : "+s"(g)); return (unsigned char*)g; }
#define GP(T, p) ((T*)(GAS T*)(p))

namespace pg8 {
#define PG8_LAS __attribute__((address_space(3)))
typedef unsigned short bf16_t;
constexpr int BM = 256, BK = 64, HALF = 128, HTB = HALF * BK * 2, STAGE_BYTES = 8 * HTB, NXCD = 8, WGM = 8;

__host__ __device__ __forceinline__ int lds_byte(int r, int c) { const int st = (r >> 4) * 2 + (c >> 5), rr = r & 15, cc = c & 31, ob = rr * 64 + cc * 2; return st * 1024 + (ob ^ (((ob >> 9) & 1) << 5)); }
__host__ __device__ __forceinline__ void stage_rc(int b, int& R, int& C) { const int st = b / 1024, sb = b % 1024, swz = sb ^ (((sb >> 9) & 1) << 5); R = (st >> 1) * 16 + swz / 64; C = (st & 1) * 32 + (swz % 64) / 2; }
__host__ __device__ __forceinline__ int perm32(int rho) { const int n = rho >> 4, i = rho & 15; return 8 * (i >> 2) + 4 * n + (i & 3); }

struct Unit { int pm, pn; };
struct Gemm { const bf16_t* A; const bf16_t* Bt; int M, N, K, lda, ldb, bkoff; long blstride; };

struct StaticOrder {
    int nM, nN, nwg, G, c;
    __host__ __device__ void init(int M, int N, int G_, int c_) { nM = M / BM; nN = N / BM; nwg = nM * nN; G = G_; c = c_; }
    __host__ __device__ bool next(int i, Unit& u) const {
        const long L = (long)i * G + c; if (L >= nwg) return false;
        int wgid = (int)L; { const int q = nwg / NXCD, r = nwg % NXCD, xcd = wgid % NXCD, off = wgid / NXCD; wgid = (xcd < r ? xcd * (q + 1) : r * (q + 1) + (xcd - r) * q) + off; }
        const int nig = WGM * nN, gid = wgid / nig, fm = gid * WGM, gsz = (nM - fm) < WGM ? (nM - fm) : WGM;
        u.pm = fm + ((wgid % nig) % gsz); u.pn = (wgid % nig) / gsz; return true;
    }
    __device__ __forceinline__ void a_ready(const Unit&) const {}
    __device__ __forceinline__ void done(const Unit&) const {}
};

struct OffOrder {
    StaticOrder b; int pn0;
    __device__ void init(int M, int N, int G_, int c_, int pn0_) { b.init(M, N, G_, c_); pn0 = pn0_; }
    __device__ bool next(int i, Unit& u) const { if (!b.next(i, u)) return false; u.pn += pn0; return true; }
    __device__ __forceinline__ void a_ready(const Unit&) const {}
    __device__ __forceinline__ void done(const Unit&) const {}
};
struct PairOrder {
    int c, c0, nN, nwg;
    __device__ bool next(int i, Unit& u) const { if (c < c0 || i >= 2) return false; const int id = (c - c0) * 2 + i; if (id >= nwg) return false; u.pm = id / nN; u.pn = id % nN; return true; }
    __device__ __forceinline__ void a_ready(const Unit&) const {}
    __device__ __forceinline__ void done(const Unit&) const {}
};
typedef f32x4 Acc[2][2][4][2];

typedef _Float16 f16x8 __attribute__((ext_vector_type(8)));
template <class Epi, class Sched, bool ALIGN_EPI = false, bool F16 = false, bool ASL = false>
__device__ __forceinline__ void gemm_phase(PG8_LAS unsigned char* lds, const Gemm g, const Sched& S, const Epi& E, int wv) {
    int tid_ = wv * 64 + lane_id(); asm volatile("" : "+v"(tid_));
    const int tid = tid_, wid = __builtin_amdgcn_readfirstlane(tid >> 6), lane = tid & 63, wr = wid >> 2, wc = wid & 3, fr = lane & 15, fq = lane >> 4;
    const int K = g.K, nt = K / BK;
    unsigned voffA[2], voffB[2];
#pragma unroll
    for (int i = 0; i < 2; ++i) { int R, C; stage_rc(tid * 16 + i * 8192, R, C); const int Rb = Epi::PERM ? ((R & ~31) + perm32(R & 31)) : R;
        voffA[i] = ASL ? (unsigned)(((C >> 5) * g.lda + R) * 64 + (C & 31) * 2) : (unsigned)(R * g.lda + C) * 2u; voffB[i] = (unsigned)(Rb * g.ldb + C) * 2u; }
    const size_t kstep = (size_t)(BK * 2), kstepA = ASL ? (size_t)g.lda * 128 : (size_t)(BK * 2);
    const size_t hstepA = ASL ? (size_t)HALF * 64 : (size_t)HALF * g.lda * 2, hstepB = (size_t)HALF * g.ldb * 2;
    const size_t tstepA = 2 * hstepA, tstepB = 2 * hstepB;
    const unsigned ldsw = (unsigned)wid * 1024u;
    const int aoff = lds_byte(wr * 64 + fr, fq * 8), boff = lds_byte(wc * 32 + fr, fq * 8);
#define PG8_SA(b, h) (((b) * 2 + (h)) * HTB)
#define PG8_SB(b, h) ((4 + (b) * 2 + (h)) * HTB)
#define PG8_STAGE(bufoff, gbase, voff) do { _Pragma("unroll") for (int _i = 0; _i < 2; ++_i) \
        __builtin_amdgcn_global_load_lds((const unsigned*)((const char*)(gbase) + (voff)[_i]), (PG8_LAS unsigned*)(lds + (bufoff) + ldsw + _i * 8192), 16, 0, 0); } while (0)
#define PG8_LDA(dst, b, h) do { _Pragma("unroll") for (int m = 0; m < 4; ++m) _Pragma("unroll") for (int k = 0; k < 2; ++k) dst[m][k] = *(const PG8_LAS bf16x8*)(lds + PG8_SA(b, h) + aoff + m * 2048 + k * 1024); } while (0)
#define PG8_LDB(dst, b, h) do { _Pragma("unroll") for (int n = 0; n < 2; ++n) _Pragma("unroll") for (int k = 0; k < 2; ++k) dst[n][k] = *(const PG8_LAS bf16x8*)(lds + PG8_SB(b, h) + boff + n * 2048 + k * 1024); } while (0)
#define PG8_MMA(ai, bj, At, Bt) do { __builtin_amdgcn_s_setprio(1); _Pragma("unroll") for (int m = 0; m < 4; ++m) _Pragma("unroll") for (int n = 0; n < 2; ++n) _Pragma("unroll") for (int k = 0; k < 2; ++k) \
        { if constexpr (F16) acc[ai][bj][m][n] = __builtin_amdgcn_mfma_f32_16x16x32_f16(__builtin_bit_cast(f16x8, Bt[n][k]), __builtin_bit_cast(f16x8, At[m][k]), acc[ai][bj][m][n], 0, 0, 0); \
          else acc[ai][bj][m][n] = __builtin_amdgcn_mfma_f32_16x16x32_bf16(Bt[n][k], At[m][k], acc[ai][bj][m][n], 0, 0, 0); } __builtin_amdgcn_s_setprio(0); } while (0)
#define PG8_WAIT_V(n) asm volatile("s_waitcnt vmcnt(" #n ")" ::: "memory")
#define PG8_WAIT_L(n) asm volatile("s_waitcnt lgkmcnt(" #n ")" ::: "memory")
#define PG8_BAR __builtin_amdgcn_s_barrier()
#define PG8_SCHED __builtin_amdgcn_sched_barrier(0)
    Unit cur, nxt; int ui = 0;
    if (!S.next(0, cur)) return;
    Acc acc;
#pragma unroll
    for (int a = 0; a < 2; ++a)
#pragma unroll
        for (int b = 0; b < 2; ++b)
#pragma unroll
            for (int m = 0; m < 4; ++m)
#pragma unroll
                for (int n = 0; n < 2; ++n) acc[a][b][m][n] = (f32x4){0.f, 0.f, 0.f, 0.f};
    bf16x8 At[4][2], B0[2][2], B1[2][2];
    const char* cA = (const char*)g.A + (size_t)cur.pm * tstepA;
    const char* cB = (const char*)g.Bt + (size_t)cur.pn * tstepB + ((size_t)(cur.pm & 7) * g.bkoff + (size_t)(cur.pm >> 3) * g.blstride) * 2;
    S.a_ready(cur);
    PG8_STAGE(PG8_SB(0, 0), cB, voffB); PG8_STAGE(PG8_SB(0, 1), cB + hstepB, voffB); PG8_STAGE(PG8_SA(0, 0), cA, voffA); PG8_STAGE(PG8_SA(0, 1), cA + hstepA, voffA);
    if (wr == 1) PG8_BAR;
    PG8_WAIT_V(2); PG8_BAR;
    PG8_STAGE(PG8_SB(1, 0), cB + kstep, voffB); PG8_STAGE(PG8_SA(1, 0), cA + kstepA, voffA); PG8_STAGE(PG8_SB(1, 1), cB + hstepB + kstep, voffB);
    PG8_WAIT_V(6); PG8_BAR;
    for (;;) {
        const bool has_next = S.next(ui + 1, nxt);
        const char* nA = has_next ? (const char*)g.A + (size_t)nxt.pm * tstepA : cA;
        const char* nB = has_next ? (const char*)g.Bt + (size_t)nxt.pn * tstepB + ((size_t)(nxt.pm & 7) * g.bkoff + (size_t)(nxt.pm >> 3) * g.blstride) * 2 : cB;
        for (int t = 0; t < nt; t += 2) {
            const bool last = (t == nt - 2);
            const char* a1 = cA + (size_t)(t + 1) * kstepA;
            const char* a2 = last ? nA : cA + (size_t)(t + 2) * kstepA; const char* b2 = last ? nB : cB + (size_t)(t + 2) * kstep;
            const char* a3 = a2 + kstepA; const char* b3 = b2 + kstep;
            if (last && has_next) S.a_ready(nxt);
            PG8_LDB(B0, 0, 0); PG8_LDB(B1, 0, 1); PG8_SCHED; PG8_LDA(At, 0, 0); PG8_STAGE(PG8_SA(1, 1), a1 + hstepA, voffA);
            PG8_WAIT_V(8); PG8_WAIT_L(0); PG8_BAR; PG8_MMA(0, 0, At, B0); PG8_MMA(0, 1, At, B1); PG8_BAR; PG8_SCHED;
            PG8_LDA(At, 0, 1); PG8_STAGE(PG8_SB(0, 0), b2, voffB); PG8_STAGE(PG8_SB(0, 1), b2 + hstepB, voffB); PG8_STAGE(PG8_SA(0, 0), a2, voffA);
            PG8_WAIT_V(8); PG8_WAIT_L(0); PG8_BAR; PG8_MMA(1, 0, At, B0); PG8_MMA(1, 1, At, B1); PG8_BAR; PG8_SCHED;
            PG8_LDB(B0, 1, 0); PG8_LDB(B1, 1, 1); PG8_SCHED; PG8_LDA(At, 1, 0); PG8_STAGE(PG8_SA(0, 1), a2 + hstepA, voffA);
            PG8_WAIT_V(8); PG8_WAIT_L(0); PG8_BAR; PG8_MMA(0, 0, At, B0); PG8_MMA(0, 1, At, B1); PG8_BAR; PG8_SCHED;
            PG8_LDA(At, 1, 1); PG8_STAGE(PG8_SB(1, 0), b3, voffB); PG8_STAGE(PG8_SB(1, 1), b3 + hstepB, voffB); PG8_STAGE(PG8_SA(1, 0), a3, voffA);
            PG8_WAIT_V(8); PG8_WAIT_L(0); PG8_BAR; PG8_MMA(1, 0, At, B0); PG8_MMA(1, 1, At, B1); PG8_BAR; PG8_SCHED;
            if constexpr (Epi::HAS_MID) { if (t + 2 == (nt >> 1)) E.mid(acc, cur, wr, wc, fr, fq); }
        }
        if constexpr (ALIGN_EPI) { if (wr == 0) PG8_BAR; }
        E(acc, cur, wr, wc, fr, fq); S.done(cur);
        if (!has_next) break;
#pragma unroll
        for (int a = 0; a < 2; ++a)
#pragma unroll
            for (int b = 0; b < 2; ++b)
#pragma unroll
                for (int m = 0; m < 4; ++m)
#pragma unroll
                    for (int n = 0; n < 2; ++n) acc[a][b][m][n] = (f32x4){0.f, 0.f, 0.f, 0.f};
        cur = nxt; cA = nA; cB = nB; ++ui;
        if constexpr (ALIGN_EPI) { if (wr == 1) PG8_BAR; }
    }
    PG8_WAIT_V(0);
    if constexpr (!ALIGN_EPI) { if (wr == 0) PG8_BAR; }
    PG8_BAR;
#undef PG8_SA
#undef PG8_SB
#undef PG8_STAGE
#undef PG8_LDA
#undef PG8_LDB
#undef PG8_MMA
#undef PG8_WAIT_V
#undef PG8_WAIT_L
#undef PG8_BAR
#undef PG8_SCHED
}

struct EpiResH {
    static constexpr bool PERM = true, HAS_MID = false;
    bf16_t* RS; const bf16_t* XS;
    __device__ __forceinline__ void operator()(const Acc& acc, const Unit& u, int wr, int wc, int fr, int fq) const {
        vlaunder(fr, fq);
        const int row0 = u.pm * BM + wr * 64 + fr, sl0 = u.pn * 8 + wc;
#pragma unroll
        for (int ai = 0; ai < 2; ++ai) {
            v4u xw[4][2];
#pragma unroll
            for (int m = 0; m < 4; ++m)
#pragma unroll
                for (int bj = 0; bj < 2; ++bj) xw[m][bj] = *(const v4u*)(XS + ((size_t)(sl0 + bj * 4) * T + (row0 + ai * HALF + m * 16)) * 32 + 8 * fq);
#pragma unroll
            for (int m = 0; m < 4; ++m) {
#pragma unroll
                for (int bj = 0; bj < 2; ++bj) { const size_t eo = ((size_t)(sl0 + bj * 4) * T + (row0 + ai * HALF + m * 16)) * 32 + 8 * fq;
                    const f32x4 v0 = acc[ai][bj][m][0], v1 = acc[ai][bj][m][1];
                    const unsigned a0 = xw[m][bj].x, a1 = xw[m][bj].y, a2 = xw[m][bj].z, a3 = xw[m][bj].w;
                    const h2_t x0 = __builtin_bit_cast(h2_t, a0), x1 = __builtin_bit_cast(h2_t, a1), x2 = __builtin_bit_cast(h2_t, a2), x3 = __builtin_bit_cast(h2_t, a3);
                    v4u w; w.x = cvt_pk_f16a(v0[0] + ALPHA * (float)x0.x, v0[1] + ALPHA * (float)x0.y); w.y = cvt_pk_f16a(v0[2] + ALPHA * (float)x1.x, v0[3] + ALPHA * (float)x1.y);
                    w.z = cvt_pk_f16a(v1[0] + ALPHA * (float)x2.x, v1[1] + ALPHA * (float)x2.y); w.w = cvt_pk_f16a(v1[2] + ALPHA * (float)x3.x, v1[3] + ALPHA * (float)x3.y);
                    *(v4u*)(RS + eo) = w; } }
        }
    }
};
struct EpiF16 {
    static constexpr bool PERM = true, HAS_MID = false;
    bf16_t* O; int ldc;
    __device__ __forceinline__ void operator()(const Acc& acc, const Unit& u, int wr, int wc, int fr, int fq) const {
        vlaunder(fr, fq);
        const int row0 = u.pm * BM + wr * 64 + fr, col0 = u.pn * BM + wc * 32 + 8 * fq;
#pragma unroll
        for (int ai = 0; ai < 2; ++ai)
#pragma unroll
            for (int m = 0; m < 4; ++m) { bf16_t* rowp = O + (size_t)(row0 + ai * HALF + m * 16) * ldc + col0;
#pragma unroll
                for (int bj = 0; bj < 2; ++bj) { const f32x4 v0 = acc[ai][bj][m][0], v1 = acc[ai][bj][m][1];
                    v4u w; w.x = cvt_pk_f16a(v0[0], v0[1]); w.y = cvt_pk_f16a(v0[2], v0[3]); w.z = cvt_pk_f16a(v1[0], v1[1]); w.w = cvt_pk_f16a(v1[2], v1[3]);
                    *(v4u*)(rowp + bj * HALF) = w; } }
    }
};
struct EpiBf16 {
    static constexpr bool PERM = true, HAS_MID = false;
    bf16_t* O; int ldc;
    __device__ __forceinline__ void operator()(const Acc& acc, const Unit& u, int wr, int wc, int fr, int fq) const {
        vlaunder(fr, fq);
        const int row0 = u.pm * BM + wr * 64 + fr, col0 = u.pn * BM + wc * 32 + 8 * fq;
#pragma unroll
        for (int ai = 0; ai < 2; ++ai)
#pragma unroll
            for (int m = 0; m < 4; ++m) { bf16_t* rowp = O + (size_t)(row0 + ai * HALF + m * 16) * ldc + col0;
#pragma unroll
                for (int bj = 0; bj < 2; ++bj) { const f32x4 v0 = acc[ai][bj][m][0], v1 = acc[ai][bj][m][1];
                    v4u w; w.x = cvt_pk_bf16(v0[0], v0[1]); w.y = cvt_pk_bf16(v0[2], v0[3]); w.z = cvt_pk_bf16(v1[0], v1[1]); w.w = cvt_pk_bf16(v1[2], v1[3]);
                    *(v4u*)(rowp + bj * HALF) = w; } }
    }
};
struct EpiIn {
    static constexpr bool PERM = true, HAS_MID = false;
    bf16_t *Q, *KK, *V, *SG, *UB, *GR, *GB; float* LOGF; const float* lb;
    __device__ __forceinline__ void operator()(const Acc& acc, const Unit& u, int wr, int wc, int fr, int fq) const {
        vlaunder(fr, fq);
        const int row0 = u.pm * BM + wr * 64 + fr;
        const int pn = u.pn;
        if (pn >= 20) {
            const int col0 = (pn - 20) * 128 + wc * 32 + 8 * fq;
#pragma unroll
            for (int ai = 0; ai < 2; ++ai)
#pragma unroll
                for (int m = 0; m < 4; ++m) { const size_t ro = (size_t)(row0 + ai * HALF + m * 16) * 2048 + col0;
                    float rr[8], gg[8];
#pragma unroll
                    for (int n = 0; n < 2; ++n)
#pragma unroll
                        for (int x = 0; x < 4; ++x) { const float za = fminf(fmaxf(acc[ai][0][m][n][x], -30.f), 30.f), zb = fminf(fmaxf(acc[ai][1][m][n][x], -30.f), 30.f);
                            const float ea = fexp(-za), eb = fexp(-zb); gg[n * 4 + x] = frcp(1.f + eb); rr[n * 4 + x] = (1.f + eb) * frcp(1.f + ea); }
                    v4u w; w.x = cvt_pk_bf16(rr[0], rr[1]); w.y = cvt_pk_bf16(rr[2], rr[3]); w.z = cvt_pk_bf16(rr[4], rr[5]); w.w = cvt_pk_bf16(rr[6], rr[7]);
                    *(v4u*)(GR + ro) = w;
                    w.x = cvt_pk_bf16(gg[0], gg[1]); w.y = cvt_pk_bf16(gg[2], gg[3]); w.z = cvt_pk_bf16(gg[4], gg[5]); w.w = cvt_pk_bf16(gg[6], gg[7]);
                    *(v4u*)(GB + ro) = w; }
            return;
        }
        const int sec = pn >> 2, col0 = (pn & 3) * 256 + wc * 32 + 8 * fq;
        if (sec == 1) {
#pragma unroll
            for (int bj = 0; bj < 2; ++bj) {
                const f32x4 l0 = *(const f32x4*)(lb + col0 + bj * HALF), l1 = *(const f32x4*)(lb + col0 + bj * HALF + 4);
#pragma unroll
                for (int ai = 0; ai < 2; ++ai)
#pragma unroll
                    for (int m = 0; m < 4; ++m) { const size_t ro = (size_t)(row0 + ai * HALF + m * 16) * 1024 + col0 + bj * HALF;
                        float lf[8], kk[8];
#pragma unroll
                        for (int n = 0; n < 2; ++n)
#pragma unroll
                            for (int x = 0; x < 4; ++x) { const float z = fminf(fmaxf(acc[ai][bj][m][n][x], -30.f), 30.f); const float lbv = n ? l1[x] : l0[x];
                                const float e = fexp(-z), s = frcp(1.f + e); const float f = lbv + (1.f - lbv) * s;
                                lf[n * 4 + x] = flog(f); kk[n * 4 + x] = (1.f - lbv) * (e * s); }
                        *(f32x4*)(LOGF + ro) = (f32x4){lf[0], lf[1], lf[2], lf[3]}; *(f32x4*)(LOGF + ro + 4) = (f32x4){lf[4], lf[5], lf[6], lf[7]};
                        v4u w; w.x = cvt_pk_bf16(kk[0], kk[1]); w.y = cvt_pk_bf16(kk[2], kk[3]); w.z = cvt_pk_bf16(kk[4], kk[5]); w.w = cvt_pk_bf16(kk[6], kk[7]);
                        *(v4u*)(KK + ro) = w; }
            }
            return;
        }
        bf16_t* dst = sec == 0 ? Q : (sec == 2 ? V : (sec == 3 ? SG : UB));
        const bool sig = (sec == 3);
#pragma unroll
        for (int ai = 0; ai < 2; ++ai)
#pragma unroll
            for (int m = 0; m < 4; ++m) { bf16_t* rowp = dst + (size_t)(row0 + ai * HALF + m * 16) * 1024 + col0;
#pragma unroll
                for (int bj = 0; bj < 2; ++bj) { f32x4 v0 = acc[ai][bj][m][0], v1 = acc[ai][bj][m][1];
                    if (sig) {
#pragma unroll
                        for (int x = 0; x < 4; ++x) { v0[x] = frcp(1.f + fexp(-fminf(fmaxf(v0[x], -30.f), 30.f))); v1[x] = frcp(1.f + fexp(-fminf(fmaxf(v1[x], -30.f), 30.f))); } }
                    v4u w; w.x = cvt_pk_bf16(v0[0], v0[1]); w.y = cvt_pk_bf16(v0[2], v0[3]); w.z = cvt_pk_bf16(v1[0], v1[1]); w.w = cvt_pk_bf16(v1[2], v1[3]);
                    *(v4u*)(rowp + bj * HALF) = w; } }
    }
};
struct EpiGlu {
    static constexpr bool PERM = true, HAS_MID = false;
    bf16_t* O; int ldc;
    __device__ __forceinline__ void operator()(const Acc& acc, const Unit& u, int wr, int wc, int fr, int fq) const {
        vlaunder(fr, fq);
        const int row0 = u.pm * BM + wr * 64 + fr, col0 = u.pn * 128 + wc * 32 + 8 * fq;
#pragma unroll
        for (int ai = 0; ai < 2; ++ai)
#pragma unroll
            for (int m = 0; m < 4; ++m) { float o[8];
#pragma unroll
                for (int n = 0; n < 2; ++n)
#pragma unroll
                    for (int x = 0; x < 4; ++x) { const float h2 = fminf(fmaxf(acc[ai][1][m][n][x], -30.f), 30.f); o[n * 4 + x] = acc[ai][0][m][n][x] * frcp(1.f + fexp(-h2)); }
                v4u w; w.x = cvt_pk_bf16(o[0], o[1]); w.y = cvt_pk_bf16(o[2], o[3]); w.z = cvt_pk_bf16(o[4], o[5]); w.w = cvt_pk_bf16(o[6], o[7]);
                *(v4u*)(O + (size_t)(row0 + ai * HALF + m * 16) * ldc + col0) = w; }
    }
};
struct EpiUp {
    static constexpr bool PERM = true, HAS_MID = true;
    bf16_t* O; const bf16_t *GR, *GB;
    __device__ __forceinline__ void scale(Acc& acc, const bf16_t* G, const Unit& u, int wr, int wc, int fr, int fq) const {
        vlaunder(fr, fq);
        const int row0 = u.pm * BM + wr * 64 + fr, col0 = u.pn * BM + wc * 32 + 8 * fq;
#pragma unroll
        for (int ai = 0; ai < 2; ++ai)
#pragma unroll
            for (int m = 0; m < 4; ++m) {
#pragma unroll
                for (int bj = 0; bj < 2; ++bj) { const v4u w = *(const v4u*)(G + (size_t)(row0 + ai * HALF + m * 16) * 2048 + col0 + bj * HALF);
                    acc[ai][bj][m][0] *= (f32x4){bf_lo(w.x), bf_hi(w.x), bf_lo(w.y), bf_hi(w.y)};
                    acc[ai][bj][m][1] *= (f32x4){bf_lo(w.z), bf_hi(w.z), bf_lo(w.w), bf_hi(w.w)}; }
                if (m & 1) __builtin_amdgcn_sched_barrier(0); }
    }
    __device__ __forceinline__ void mid(Acc& acc, const Unit& u, int wr, int wc, int fr, int fq) const { scale(acc, GR, u, wr, wc, fr, fq); }
    __device__ __forceinline__ void operator()(Acc& acc, const Unit& u, int wr, int wc, int fr, int fq) const {
        scale(acc, GB, u, wr, wc, fr, fq);
        const int row0 = u.pm * BM + wr * 64 + fr, col0 = u.pn * BM + wc * 32 + 8 * fq;
#pragma unroll
        for (int ai = 0; ai < 2; ++ai)
#pragma unroll
            for (int m = 0; m < 4; ++m) { bf16_t* rowp = O + (size_t)(row0 + ai * HALF + m * 16) * 2048 + col0;
#pragma unroll
                for (int bj = 0; bj < 2; ++bj) { const f32x4 v0 = acc[ai][bj][m][0], v1 = acc[ai][bj][m][1];
                    v4u w; w.x = cvt_pk_bf16(v0[0], v0[1]); w.y = cvt_pk_bf16(v0[2], v0[3]); w.z = cvt_pk_bf16(v1[0], v1[1]); w.w = cvt_pk_bf16(v1[2], v1[3]);
                    *(v4u*)(rowp + bj * HALF) = w; } }
    }
};
}

#define XB_TMO      128
#define XB_XCNT(j)  (256  + 64 * (j))
#define XB_XSUB(j)  (1280 + 64 * (j))
#define XB_XGEN(j)  (2304 + 64 * (j))
#define XB_TOP      3328
#define XB_TOPGEN   3392
#define XCD_BAR_WORDS 3456
#define XB_SPIN_CAP (1u << 20)

__device__ __forceinline__ unsigned xb_ld(unsigned* p)              { return __hip_atomic_load(p, __ATOMIC_RELAXED, __HIP_MEMORY_SCOPE_AGENT); }
__device__ __forceinline__ unsigned xb_add(unsigned* p, unsigned v) { return __hip_atomic_fetch_add(p, v, __ATOMIC_RELAXED, __HIP_MEMORY_SCOPE_AGENT); }
__device__ __forceinline__ unsigned xb_xcc_id() { return (unsigned)__builtin_amdgcn_s_getreg((3 << 11) | 20) & 0xFu; }
#define XB_SPIN(cond, bar) do { unsigned _sp = 0; while (cond) { __builtin_amdgcn_s_sleep(1); \
    if ((++_sp & 255u) == 0u) { if (xb_ld(&(bar)[XB_TMO])) break; if (_sp > XB_SPIN_CAP) { atomicAdd(&(bar)[XB_TMO], 1u); break; } } } } while (0)

struct XcdBarrier { unsigned* bar; unsigned x; volatile LAS unsigned* st; };

__device__ __forceinline__ XcdBarrier xcd_barrier_post(unsigned* bar, volatile LAS unsigned* st, bool leader) {
    XcdBarrier b; b.bar = bar; b.x = xb_xcc_id(); b.st = st;
    if (leader) (void)xb_add(&bar[XB_XCNT(b.x)], 1u);
    return b;
}
__device__ __forceinline__ void xcd_barrier_complete(unsigned* bar, unsigned x, unsigned& nloc, unsigned& nx) {
    const unsigned G = gridDim.x * gridDim.y * gridDim.z;
    unsigned sum, cnt, mine, sp = 0u;
    for (;;) {
        sum = 0u; cnt = 0u; mine = 0u;
#pragma unroll
        for (unsigned j = 0; j < 16; ++j) { const unsigned c = xb_ld(&bar[XB_XCNT(j)]); sum += c; cnt += (c > 0u) ? 1u : 0u; mine = (j == x) ? c : mine; }
        if (sum == G) break;
        __builtin_amdgcn_s_sleep(1);
        if ((++sp & 255u) == 0u) { if (xb_ld(&bar[XB_TMO])) break; if (sp > XB_SPIN_CAP) { atomicAdd(&bar[XB_TMO], 1u); break; } }
    }
    nloc = mine > 0u ? mine : 1u; nx = cnt > 0u ? cnt : 1u;
}
__device__ __forceinline__ void xcd_barrier(const XcdBarrier& b, int wv) {
    asm volatile("s_waitcnt vmcnt(0)" ::: "memory");
    __syncthreads();
    if (wv == 0 && lane_id() == 0) {
        unsigned* bar = b.bar;
        __builtin_amdgcn_s_waitcnt(0);
        unsigned nloc = b.st[0], nx = b.st[1];
        if (nloc == 0u) { xcd_barrier_complete(bar, b.x, nloc, nx); b.st[0] = nloc; b.st[1] = nx; }
        const unsigned old = xb_add(&bar[XB_XSUB(b.x)], 1u);
        const unsigned gen = old / nloc;
        if (old + 1u == (gen + 1u) * nloc) {
            __builtin_amdgcn_fence(__ATOMIC_RELEASE, "agent");
            asm volatile("s_waitcnt vmcnt(0)" ::: "memory");
            const unsigned og = xb_add(&bar[XB_TOP], 1u);
            const unsigned tg = og / nx;
            if (og + 1u == (tg + 1u) * nx) xb_add(&bar[XB_TOPGEN], 1u);
            else XB_SPIN(xb_ld(&bar[XB_TOPGEN]) == tg, bar);
            __builtin_amdgcn_fence(__ATOMIC_ACQUIRE, "agent");
            xb_add(&bar[XB_XGEN(b.x)], 1u);
            asm volatile("s_waitcnt vmcnt(0)" ::: "memory");
        } else {
            XB_SPIN(xb_ld(&bar[XB_XGEN(b.x)]) == gen, bar);
            __builtin_amdgcn_fence(__ATOMIC_ACQUIRE, "agent");
            asm volatile("s_waitcnt vmcnt(0)" ::: "memory");
        }
    }
    __syncthreads();
}

struct Args { const float* in[24]; float* out; unsigned char* ws; int ph_lo, ph_hi; };
struct Frame {
    LAS unsigned char* lds;
    int tid, lane, wave, vcu, G;
    unsigned char* ws;
    const __attribute__((address_space(4))) Args* ka;
};
enum { I_X = 0, I_WIN, I_LBL, I_NG, I_LRE, I_LIM, I_LSTEP, I_BRE, I_BIM, I_CRE, I_CIM, I_SD, I_WGLU, I_WUPA, I_WUPB, I_WO, I_LN1G, I_LN1B, I_PWQ, I_PKEYS, I_PU, I_PV, I_LN2G, I_LN2B };

__device__ __forceinline__ void p0_transpose_item(const float* W, int N, bf16* WT, int dpitch, int dst_koff, int dst_row0, LAS float* scr, int k0, int n0, int lane, bool h = false) {
    { const int kr = lane >> 3, c4 = (lane & 7) * 4; f32x4 v[8];
#pragma unroll
      for (int i = 0; i < 8; ++i) v[i] = __builtin_nontemporal_load((const f32x4*)(W + (size_t)(k0 + kr + 8 * i) * N + n0 + c4));
#pragma unroll
      for (int i = 0; i < 8; ++i) { LAS float* d = scr + (kr + 8 * i) * 33 + c4; d[0] = v[i][0]; d[1] = v[i][1]; d[2] = v[i][2]; d[3] = v[i][3]; } }
    LDS_WAIT(); asm volatile("" ::: "memory");
    const int c = lane & 7;
#pragma unroll
    for (int j = 0; j < 4; ++j) { const int n = (lane >> 3) + 8 * j; const LAS float* s = scr + (8 * c) * 33 + n;
        v4u o;
        if (h) { o.x = cvt_pk_f16(s[0 * 33], s[1 * 33]); o.y = cvt_pk_f16(s[2 * 33], s[3 * 33]); o.z = cvt_pk_f16(s[4 * 33], s[5 * 33]); o.w = cvt_pk_f16(s[6 * 33], s[7 * 33]); }
        else { o.x = cvt_pk_bf16(s[0 * 33], s[1 * 33]); o.y = cvt_pk_bf16(s[2 * 33], s[3 * 33]); o.z = cvt_pk_bf16(s[4 * 33], s[5 * 33]); o.w = cvt_pk_bf16(s[6 * 33], s[7 * 33]); }
        *(v4u*)(WT + (size_t)(dst_row0 + n) * dpitch + dst_koff + k0 + 8 * c) = o; }
    LDS_WAIT(); asm volatile("" ::: "memory");
}
__device__ __forceinline__ void sincos_d(double a, double& s, double& c) {
    const double k = __builtin_rint(a * 0.63661977236758134308);
    double r = __builtin_fma(-k, 1.57079632679489655800e+00, a); r = __builtin_fma(-k, 6.12323399573676603587e-17, r);
    const double r2 = r * r;
    double sp = 1.0 / 1307674368000.0; sp = sp * r2 - 1.0 / 6227020800.0; sp = sp * r2 + 1.0 / 39916800.0; sp = sp * r2 - 1.0 / 362880.0; sp = sp * r2 + 1.0 / 5040.0; sp = sp * r2 - 1.0 / 120.0; sp = sp * r2 + 1.0 / 6.0;
    const double sr = r - r * r2 * sp;
    double cp = 1.0 / 20922789888000.0; cp = cp * r2 - 1.0 / 87178291200.0; cp = cp * r2 + 1.0 / 479001600.0; cp = cp * r2 - 1.0 / 3628800.0; cp = cp * r2 + 1.0 / 40320.0; cp = cp * r2 - 1.0 / 720.0; cp = cp * r2 + 1.0 / 24.0;
    const double cr = 1.0 - 0.5 * r2 + r2 * r2 * cp;
    const int q = ((int)k) & 3;
    s = (q == 0) ? sr : (q == 1) ? cr : (q == 2) ? -sr : -cr;
    c = (q == 0) ? cr : (q == 1) ? -sr : (q == 2) ? -cr : sr;
}
__device__ __forceinline__ double exp_d(double x) {
    const double k = __builtin_rint(x * 1.44269504088896340736);
    const double r = __builtin_fma(-k, 6.93147180369123816490e-01, x) - k * 1.90821492927058770002e-10;
    double p = 1.0 / 6227020800.0;
    p = p * r + 1.0 / 479001600.0; p = p * r + 1.0 / 39916800.0; p = p * r + 1.0 / 3628800.0; p = p * r + 1.0 / 362880.0; p = p * r + 1.0 / 40320.0; p = p * r + 1.0 / 5040.0;
    p = p * r + 1.0 / 720.0; p = p * r + 1.0 / 120.0; p = p * r + 1.0 / 24.0; p = p * r + 1.0 / 6.0; p = p * r + 0.5; p = p * r + 1.0; p = p * r + 1.0;
    const long long e = (long long)k + 1023; double sc = __builtin_bit_cast(double, (unsigned long long)(e << 52));
    return p * sc;
}

__device__ __forceinline__ void phase_prologue_a(const Frame& F0) {
    Frame F = F0; F.tid = F.wave * 64 + lane_id(); asm volatile("" : "+v"(F.tid)); F.lane = F.tid & 63;
    unsigned char* ws = opqg(F.ws); const __attribute__((address_space(4))) Args* a = opq(F.ka);
    LAS float* scr = (LAS float*)(F.lds + F.wave * 16384);
    const int gw = F.vcu * 8 + F.wave, NGW = F.G * 8;
    constexpr int I_IN = 32 * 288, I_GLU = 16 * 64, I_UP = 16 * 64, I_O = 32 * 64, I_L = I_IN + I_GLU + 2 * I_UP + I_O;
    for (int it = gw; it < DEPTH * I_L; it += NGW) {
        const int l = it / I_L; int r = it % I_L;
        if (r < I_IN) { const int kb = r / 288, nb = r % 288, n0 = nb * 32; int dr;
            if (n0 < 5120) dr = n0; else if (n0 < 7168) { const int j = n0 - 5120; dr = 5120 + (j >> 7) * 256 + (j & 127); } else { const int j = n0 - 7168; dr = 5120 + (j >> 7) * 256 + 128 + (j & 127); }
            p0_transpose_item(GP(const float, a->in[I_WIN]) + (size_t)l * D * NIN, NIN, (bf16*)(ws + WS_WIN) + (size_t)l * NIN * D, D, 0, dr, scr, kb * 64, n0, F.lane, true); continue; }
        r -= I_IN;
        if (r < I_GLU) { const int kb = r / 64, nb = r % 64, n0 = nb * 32; int dr;
            if (n0 < 1024) dr = (n0 >> 7) * 256 + (n0 & 127); else { const int j = n0 - 1024; dr = (j >> 7) * 256 + 128 + (j & 127); }
            p0_transpose_item(GP(const float, a->in[I_WGLU]) + (size_t)l * 1024 * 2048, 2048, (bf16*)(ws + WS_WGLU) + (size_t)l * 2048 * 1024, 1024, 0, dr, scr, kb * 64, n0, F.lane); continue; }
        r -= I_GLU;
        if (r < I_UP) { const int kb = r / 64, nb = r % 64;
            p0_transpose_item(GP(const float, a->in[I_WUPA]) + (size_t)l * 1024 * 2048, 2048, (bf16*)(ws + WS_WUP) + (size_t)l * 2048 * 2048, 2048, 0, nb * 32, scr, kb * 64, nb * 32, F.lane); continue; }
        r -= I_UP;
        if (r < I_UP) { const int kb = r / 64, nb = r % 64;
            p0_transpose_item(GP(const float, a->in[I_WUPB]) + (size_t)l * 1024 * 2048, 2048, (bf16*)(ws + WS_WUP) + (size_t)l * 2048 * 2048, 2048, 1024, nb * 32, scr, kb * 64, nb * 32, F.lane); continue; }
        r -= I_UP;
        { const int kb = r / 64, nb = r % 64;
            p0_transpose_item(GP(const float, a->in[I_WO]) + (size_t)l * 2048 * 2048, 2048, (bf16*)(ws + WS_WO) + (size_t)l * 2048 * 2048, 2048, 0, nb * 32, scr, kb * 64, nb * 32, F.lane); }
    }
    const size_t gt = (size_t)F.vcu * 512 + F.tid, NT = (size_t)F.G * 512;
    { const float* src = GP(const float, a->in[I_PWQ]); bf16* dst = (bf16*)(ws + WS_WQB);
      for (size_t i = gt; i < (size_t)DEPTH * D * D / 8; i += NT) { const f32x4 v0 = *(const f32x4*)(src + i * 8), v1 = *(const f32x4*)(src + i * 8 + 4);
          v4u w; w.x = cvt_pk_bf16(v0[0], v0[1]); w.y = cvt_pk_bf16(v0[2], v0[3]); w.z = cvt_pk_bf16(v1[0], v1[1]); w.w = cvt_pk_bf16(v1[2], v1[3]); *(v4u*)(dst + i * 8) = w; } }
    { const float* src = GP(const float, a->in[I_X]); bf16* dst = (bf16*)(ws + WS_XH);
      for (size_t i = gt; i < (size_t)T * D / 8; i += NT) { const int j = (int)(i & 3), row = (int)((i >> 2) & (T - 1)), sl = (int)(i >> 15);
          const float* sp = src + (size_t)row * D + sl * 32 + j * 8; const f32x4 v0 = *(const f32x4*)sp, v1 = *(const f32x4*)(sp + 4);
          v4u w; w.x = cvt_pk_f16(v0[0], v0[1]); w.y = cvt_pk_f16(v0[2], v0[3]); w.z = cvt_pk_f16(v1[0], v1[1]); w.w = cvt_pk_f16(v1[2], v1[3]); *(v4u*)(dst + i * 8) = w; } }
    { const float* keys = GP(const float, a->in[I_PKEYS]); bf16* dst = (bf16*)(ws + WS_BK);
      for (size_t i = gt; i < (size_t)DEPTH * 8 * 256 * 256 / 8; i += NT) { const int jj = (int)(i & 31) * 8; const int row = (int)((i >> 5) & 255); const size_t lh = i >> 13; const int half = row >> 7, n = row & 127;
          v4u w = (v4u){0u, 0u, 0u, 0u};
          if ((jj >> 7) == half) { const float* s = keys + ((lh * 2 + half) * 128 + n) * 128 + (jj & 127); const f32x4 v0 = *(const f32x4*)s, v1 = *(const f32x4*)(s + 4);
              w.x = cvt_pk_bf16(v0[0], v0[1]); w.y = cvt_pk_bf16(v0[2], v0[3]); w.z = cvt_pk_bf16(v1[0], v1[1]); w.w = cvt_pk_bf16(v1[2], v1[3]); }
          *(v4u*)(dst + i * 8) = w; } }
    if (gt < 1024) { const float* lg = GP(const float, a->in[I_LBL]); float* lbo = (float*)(ws + WS_LB); const int d = (int)gt;
        const float z0 = lg[d], z1 = lg[1024 + d], z2 = lg[2048 + d], z3 = lg[3072 + d]; const float mx = fmaxf(fmaxf(z0, z1), fmaxf(z2, z3));
        const float e0 = expf(z0 - mx), e1 = expf(z1 - mx), e2 = expf(z2 - mx), e3 = expf(z3 - mx); const float inv = 1.f / (e0 + e1 + e2 + e3);
        lbo[d] = 0.f; lbo[1024 + d] = e1 * inv; lbo[2048 + d] = (e1 + e2) * inv; lbo[3072 + d] = (e1 + e2 + e3) * inv; }
    for (size_t i = gt; i < (size_t)DEPTH * 64 * 64; i += NT) {
        const size_t lg_ = i >> 6;
        const double lr = fmin((double)GP(const float, a->in[I_LRE])[i], -1e-4), li = (double)GP(const float, a->in[I_LIM])[i], dt = exp_d((double)GP(const float, a->in[I_LSTEP])[lg_]);
        const double mag = exp_d(lr * dt); double sn, cs; sincos_d(li * dt, sn, cs);
        const double ar = mag * cs, ai = mag * sn, den = lr * lr + li * li, nr = ar - 1.0;
        const double zr = (nr * lr + ai * li) / den, zi = (ai * lr - nr * li) / den;
        const float* br = GP(const float, a->in[I_BRE]) + i * 16; const float* bi = GP(const float, a->in[I_BIM]) + i * 16; float* bb = (float*)(ws + WS_BB) + i * 32;
#pragma unroll
        for (int m = 0; m < 16; ++m) { const double b_r = br[m], b_i = bi[m]; bb[2 * m] = (float)(zr * b_r - zi * b_i); bb[2 * m + 1] = (float)(zr * b_i + zi * b_r); }
        float* ap = (float*)(ws + WS_APOW) + (lg_ * 65 * 64 + (i & 63)) * 2; double pr = 1.0, pi = 0.0;
        for (int dl = 0; dl < 65; ++dl) { ap[dl * 128] = (float)pr; ap[dl * 128 + 1] = (float)pi; const double t = pr * ar - pi * ai; pi = pr * ai + pi * ar; pr = t; }
    }
    for (int it = gw; it < DEPTH * 1024; it += NGW) {
        const int l = it >> 10, eb = it & 1023;
        const int pe = eb * 16 + (F.lane >> 2), i1 = (pe & 1023) >> 3, i2 = (pe & 7) * 16 + (((pe >> 10) - i1) & 15);
        const float* src = GP(const float, a->in[I_PV]) + ((size_t)l * NEXP + i1 * 128 + i2) * D + (F.lane & 3) * 8;
        bf16* dst = (bf16*)(ws + WS_TBV) + (size_t)l * 64 * NEXP * 32 + ((size_t)(eb * 16 + (F.lane >> 2)) * 4 + ((F.lane & 3) ^ ((F.lane >> 4) & 3))) * 8;
#pragma unroll 8
        for (int ks = 0; ks < 64; ++ks) { const f32x4 v0 = __builtin_nontemporal_load((const f32x4*)(src + ks * 32)), v1 = __builtin_nontemporal_load((const f32x4*)(src + ks * 32 + 4));
            v4u w; w.x = cvt_pk_f16(v0[0], v0[1]); w.y = cvt_pk_f16(v0[2], v0[3]); w.z = cvt_pk_f16(v1[0], v1[1]); w.w = cvt_pk_f16(v1[2], v1[3]);
            *(v4u*)(dst + (size_t)ks * NEXP * 32) = w; }
    }
    for (int it = gw; it < DEPTH * 4096; it += NGW) {
        const int l = it >> 12, q4 = it & 4095, c = F.lane & 15;
        const int pe = q4 * 4 + (F.lane >> 4), i1 = (pe & 1023) >> 3, i2 = (pe & 7) * 16 + (((pe >> 10) - i1) & 15);
        const float* src = GP(const float, a->in[I_PU]) + ((size_t)l * NEXP + i1 * 128 + i2) * D + c * 4;
        unsigned hv[64]; float m = 0.f;
#pragma unroll
        for (int i = 0; i < 32; ++i) { const f32x4 v = __builtin_nontemporal_load((const f32x4*)(src + i * 64));
            m = fmaxf(fmaxf(m, fmaxf(fabsf(v[0]), fabsf(v[1]))), fmaxf(fabsf(v[2]), fabsf(v[3])));
            hv[2 * i] = cvt_pk_f16(v[0], v[1]); hv[2 * i + 1] = cvt_pk_f16(v[2], v[3]); }
        m = fmaxf(m, __shfl_xor(m, 1)); m = fmaxf(m, __shfl_xor(m, 2)); m = fmaxf(m, __shfl_xor(m, 4)); m = fmaxf(m, __shfl_xor(m, 8));
        const float sc = (m > 0.f) ? m * (1.f / 127.f) : 1.f, inv = (m > 0.f) ? 127.f / m : 0.f;
        if (c == 0) ((float*)(ws + WS_SU))[(size_t)l * NEXP + pe] = sc;
        unsigned char* dst = ws + WS_TBU + (size_t)l * 32 * NEXP * 64 + (size_t)pe * 64 + (((c >> 2) ^ ((pe >> 2) & 3)) * 16 + (c & 3) * 4);
#pragma unroll
        for (int i = 0; i < 32; ++i) { const h2_t p0 = __builtin_bit_cast(h2_t, hv[2 * i]), p1 = __builtin_bit_cast(h2_t, hv[2 * i + 1]);
            const int q0 = (int)__builtin_rintf((float)p0.x * inv), q1 = (int)__builtin_rintf((float)p0.y * inv), q2 = (int)__builtin_rintf((float)p1.x * inv), q3 = (int)__builtin_rintf((float)p1.y * inv);
            *(unsigned*)(dst + (size_t)i * NEXP * 64) = (unsigned)(q0 & 255) | ((unsigned)(q1 & 255) << 8) | ((unsigned)(q2 & 255) << 16) | ((unsigned)q3 << 24); }
    }
}
__device__ __forceinline__ double dummy_unused_(double x) { return x; }

__device__ __forceinline__ void phase_prologue_b(const Frame& F0) {
    Frame F = F0; F.tid = F.wave * 64 + lane_id(); asm volatile("" : "+v"(F.tid)); F.lane = F.tid & 63;
    unsigned char* ws = opqg(F.ws); const __attribute__((address_space(4))) Args* a = opq(F.ka);
    const float* APOW = (const float*)(ws + WS_APOW); const float* BB = (const float*)(ws + WS_BB);
    LAS float* AP = (LAS float*)(F.lds); LAS float* BL = (LAS float*)(F.lds + 33280); LAS float* CR = (LAS float*)(F.lds + 41472); LAS float* CI = (LAS float*)(F.lds + 45568); LAS float* SDL = (LAS float*)(F.lds + 49664);
    bf16* KM = (bf16*)(ws + WS_KMAT); bf16* PM = (bf16*)(ws + WS_PM); bf16* E = (bf16*)(ws + WS_E);
    for (int lg = F.vcu; lg < DEPTH * 64; lg += F.G) {
        for (int i = F.tid; i < 65 * 64 * 2 / 4; i += 512) ((LAS f32x4*)AP)[i] = ((const f32x4*)(APOW + (size_t)lg * 65 * 128))[i];
        ((LAS f32x4*)BL)[F.tid] = ((const f32x4*)(BB + (size_t)lg * 2048))[F.tid];
        if (F.tid < 256) ((LAS f32x4*)CR)[F.tid] = ((const f32x4*)(GP(const float, a->in[I_CRE]) + (size_t)lg * 1024))[F.tid];
        else ((LAS f32x4*)CI)[F.tid - 256] = ((const f32x4*)(GP(const float, a->in[I_CIM]) + (size_t)lg * 1024))[F.tid - 256];
        if (F.tid < 16) SDL[F.tid] = GP(const float, a->in[I_SD])[lg * 16 + F.tid];
        __syncthreads();
        for (int task = F.tid; task < 65 * 16; task += 512) {
            const int n = task & 15, idx = task >> 4;
            float sm[16];
#pragma unroll
            for (int m = 0; m < 16; ++m) sm[m] = 0.f;
            if (idx > 0) { const int dl = idx - 1;
#pragma unroll 4
                for (int p = 0; p < 64; ++p) { const f32x2 av = *(const LAS f32x2*)(AP + (dl * 64 + p) * 2); const float c_r = CR[n * 64 + p], c_i = CI[n * 64 + p];
                    const float car = c_r * av[0] - c_i * av[1], cai = c_r * av[1] + c_i * av[0];
#pragma unroll
                    for (int q = 0; q < 8; ++q) { const f32x4 b4 = *(const LAS f32x4*)(BL + p * 32 + q * 4); sm[2 * q] += car * b4[0] - cai * b4[1]; sm[2 * q + 1] += car * b4[2] - cai * b4[3]; } }
                if (dl == 0) { const float dv = SDL[n];
#pragma unroll
                    for (int m = 0; m < 16; ++m) sm[m] += (m == n) ? dv : 0.f; } }
            v4u w0, w1; w0.x = cvt_pk_bf16(sm[0], sm[1]); w0.y = cvt_pk_bf16(sm[2], sm[3]); w0.z = cvt_pk_bf16(sm[4], sm[5]); w0.w = cvt_pk_bf16(sm[6], sm[7]);
            w1.x = cvt_pk_bf16(sm[8], sm[9]); w1.y = cvt_pk_bf16(sm[10], sm[11]); w1.z = cvt_pk_bf16(sm[12], sm[13]); w1.w = cvt_pk_bf16(sm[14], sm[15]);
            bf16* kp = KM + ((size_t)lg * 65 * 16 + task) * 16; *(v4u*)kp = w0; *(v4u*)(kp + 8) = w1; }
        for (int it = F.tid; it < 128 * 64 * 2; it += 512) {
            const int m0 = (it & 1) * 8, sidx = (it >> 1) & 63, pp = it >> 7, p = pp & 63;
            const f32x2 av = *(const LAS f32x2*)(AP + ((63 - sidx) * 64 + p) * 2); const float pr = av[0], pi = av[1];
            float o[8];
#pragma unroll
            for (int j = 0; j < 4; ++j) { const f32x4 b4 = *(const LAS f32x4*)(BL + p * 32 + m0 * 2 + j * 4);
                o[2 * j] = (pp < 64) ? (pr * b4[0] - pi * b4[1]) : (pr * b4[1] + pi * b4[0]); o[2 * j + 1] = (pp < 64) ? (pr * b4[2] - pi * b4[3]) : (pr * b4[3] + pi * b4[2]); }
            v4u w; w.x = cvt_pk_bf16(o[0], o[1]); w.y = cvt_pk_bf16(o[2], o[3]); w.z = cvt_pk_bf16(o[4], o[5]); w.w = cvt_pk_bf16(o[6], o[7]); *(v4u*)(PM + ((size_t)lg * 16384 + it) * 8) = w; }
        for (int it = F.tid; it < 1024 * 16; it += 512) {
            const int pp0 = (it & 15) * 8, n = (it >> 4) & 15, tau = it >> 8, p0 = pp0 & 63;
            float o[8];
#pragma unroll
            for (int j = 0; j < 8; ++j) { const f32x2 av = *(const LAS f32x2*)(AP + ((tau + 1) * 64 + p0 + j) * 2); const float c_r = CR[n * 64 + p0 + j], c_i = CI[n * 64 + p0 + j];
                o[j] = (pp0 < 64) ? (c_r * av[0] - c_i * av[1]) : -(c_r * av[1] + c_i * av[0]); }
            v4u w; w.x = cvt_pk_bf16(o[0], o[1]); w.y = cvt_pk_bf16(o[2], o[3]); w.z = cvt_pk_bf16(o[4], o[5]); w.w = cvt_pk_bf16(o[6], o[7]); *(v4u*)(E + ((size_t)lg * 16384 + it) * 8) = w; }
        __syncthreads();
    }
}
constexpr int HG_BL = 0, HG_TOT = 33792, HG_VT = 35840, HG_KT = 54272, HG_RED = 72704;
constexpr int KSP = 136, HG_KS = 73728, HG_QT = HG_KS + 64 * KSP * 2, HG_QH = HG_QT + 64 * KSP * 2;
static_assert(HG_QH + 64 * KSP * 2 <= RING_BYTES, "hgrn_out LDS map");
constexpr int BLP = 132, VTP = 72;
__device__ __forceinline__ void hg_cumsum(const Frame& F, const float* LOGF, int c, int h) {
    LAS float* bL = (LAS float*)(F.lds + HG_BL); LAS float* tot = (LAS float*)(F.lds + HG_TOT);
    const int d = F.tid & 127, seg = F.tid >> 7;
    const float* src = LOGF + (size_t)(c * 64 + seg * 16) * AW + h * 128 + d;
    float lf[16];
#pragma unroll
    for (int i = 0; i < 16; ++i) lf[i] = src[(size_t)i * AW];
#pragma unroll
    for (int i = 1; i < 16; ++i) lf[i] += lf[i - 1];
    tot[seg * 128 + d] = lf[15];
    __syncthreads();
    float off = 0.f;
#pragma unroll
    for (int s2 = 0; s2 < 3; ++s2) off += (s2 < seg) ? tot[s2 * 128 + d] : 0.f;
#pragma unroll
    for (int i = 0; i < 16; ++i) bL[(seg * 16 + i) * BLP + d] = lf[i] + off;
}
__device__ __forceinline__ void hg_load_vt(const Frame& F, const bf16* V, int c, int h) {
    LAS bf16* VT = (LAS bf16*)(F.lds + HG_VT);
    const int s = F.lane, vb = F.wave * 16;
    const v4u* src = (const v4u*)(V + (size_t)(c * 64 + s) * AW + h * 128 + vb);
    const v4u w0 = src[0], w1 = src[1];
    const unsigned ww[8] = {w0.x, w0.y, w0.z, w0.w, w1.x, w1.y, w1.z, w1.w};
#pragma unroll
    for (int j = 0; j < 8; ++j) { VT[(vb + 2 * j) * VTP + s] = (bf16)(ww[j] & 0xffffu); VT[(vb + 2 * j + 1) * VTP + s] = (bf16)(ww[j] >> 16); }
}
__device__ __forceinline__ void phase_hgrn_local(const Frame& F0, int l) {
    Frame F = F0; F.tid = F.wave * 64 + lane_id(); asm volatile("" : "+v"(F.tid)); F.lane = F.tid & 63;
    unsigned char* ws = opqg(F.ws);
    const float* LOGF = (const float*)(ws + WS_LOGF); const bf16* KK = (const bf16*)(ws + WS_KK); const bf16* V = (const bf16*)(ws + WS_V);
    _Float16* U = (_Float16*)(ws + WS_U); float* BLo = (float*)(ws + WS_BL);
    LAS float* bL = (LAS float*)(F.lds + HG_BL); LAS bf16* VT = (LAS bf16*)(F.lds + HG_VT); LAS bf16* KT = (LAS bf16*)(F.lds + HG_KT);
    const int fr = F.lane & 15, fq = F.lane >> 4;
    for (int unit = F.vcu; unit < NCH * 8; unit += F.G) {
        const int c = unit >> 3, h = unit & 7;
        hg_cumsum(F, LOGF, c, h);
        hg_load_vt(F, V, c, h);
        __syncthreads();
        { const int s = F.lane, db = F.wave * 16;
          const v4u* src = (const v4u*)(KK + (size_t)(c * 64 + s) * AW + h * 128 + db);
          const v4u w0 = src[0], w1 = src[1];
          const unsigned ww[8] = {w0.x, w0.y, w0.z, w0.w, w1.x, w1.y, w1.z, w1.w};
#pragma unroll
          for (int j = 0; j < 8; ++j) {
              const float b0 = bL[s * BLP + db + 2 * j], b1 = bL[s * BLP + db + 2 * j + 1], l0 = bL[63 * BLP + db + 2 * j], l1 = bL[63 * BLP + db + 2 * j + 1];
              const unsigned pk = cvt_pk_bf16(bf_lo(ww[j]) * fexp(l0 - b0), bf_hi(ww[j]) * fexp(l1 - b1));
              KT[(db + 2 * j) * VTP + s] = (bf16)(pk & 0xffffu); KT[(db + 2 * j + 1) * VTP + s] = (bf16)(pk >> 16); } }
        if (F.tid < 128) BLo[(size_t)c * AW + h * 128 + F.tid] = bL[63 * BLP + F.tid];
        __syncthreads();
        f32x4 acc[8];
#pragma unroll
        for (int i = 0; i < 8; ++i) acc[i] = (f32x4){0.f, 0.f, 0.f, 0.f};
#pragma unroll
        for (int ks = 0; ks < 2; ++ks) {
            const bf16x8 A = *(const LAS bf16x8*)(VT + (F.wave * 16 + fr) * VTP + ks * 32 + fq * 8);
#pragma unroll
            for (int dt = 0; dt < 8; ++dt) { const bf16x8 B = *(const LAS bf16x8*)(KT + (dt * 16 + fr) * VTP + ks * 32 + fq * 8);
                acc[dt] = __builtin_amdgcn_mfma_f32_16x16x32_bf16(B, A, acc[dt], 0, 0, 0); }
        }
        _Float16* up = U + ((size_t)(c * 8 + h) * 128 + F.wave * 16 + fr) * 128 + fq * 4;
#pragma unroll
        for (int dt = 0; dt < 8; ++dt) { v2u w; w.x = cvt_pk_f16(acc[dt][0], acc[dt][1]); w.y = cvt_pk_f16(acc[dt][2], acc[dt][3]); *(v2u*)(up + dt * 16) = w; }
        __syncthreads();
    }
}
__device__ __forceinline__ void phase_scan(const Frame& F0, int l) {
    Frame F = F0; F.tid = F.wave * 64 + lane_id(); asm volatile("" : "+v"(F.tid)); F.lane = F.tid & 63;
    unsigned char* ws = opqg(F.ws);
    const _Float16* U = (const _Float16*)(ws + WS_U); const float* BLo = (const float*)(ws + WS_BL); bf16* SP = (bf16*)(ws + WS_SP);
    for (int e = F.vcu * 512 + F.tid; e < 8 * 128 * 128; e += F.G * 512) {
        const int hd = (e >> 14) * 128 + (e & 127);
        float s = 0.f;
        for (int c0 = 0; c0 < NCH; c0 += 32) {
            float u[32], bl[32];
#pragma unroll
            for (int i = 0; i < 32; ++i) { u[i] = (float)U[(size_t)(c0 + i) * 131072 + e]; bl[i] = BLo[(size_t)(c0 + i) * AW + hd]; }
#pragma unroll
            for (int i = 0; i < 32; ++i) { SP[(size_t)(c0 + i) * 131072 + e] = f2bf(s); s = s * fexp(bl[i]) + u[i]; }
        }
    }
    const float* XLOC = (const float*)(ws + WS_XLOC); float* XS = (float*)(ws + WS_XS); const float* APOW = (const float*)(ws + WS_APOW);
    for (int e = F.vcu * 512 + F.tid; e < 64 * 64; e += F.G * 512) {
        const int g = e >> 6, p = e & 63;
        const float* ap = APOW + (((size_t)(l * 64 + g) * 65 + 64) * 64 + p) * 2; const float ar = ap[0], ai = ap[1];
        float xr = 0.f, xi = 0.f;
        for (int c0 = 0; c0 < NCH; c0 += 32) {
            float lr_[32], li_[32];
#pragma unroll
            for (int i = 0; i < 32; ++i) { lr_[i] = XLOC[((size_t)(c0 + i) * 64 + g) * 128 + p]; li_[i] = XLOC[((size_t)(c0 + i) * 64 + g) * 128 + 64 + p]; }
#pragma unroll
            for (int i = 0; i < 32; ++i) { XS[((size_t)(c0 + i) * 64 + g) * 128 + p] = xr; XS[((size_t)(c0 + i) * 64 + g) * 128 + 64 + p] = xi;
                const float t = ar * xr - ai * xi + lr_[i]; xi = ar * xi + ai * xr + li_[i]; xr = t; }
        }
    }
}
__device__ __forceinline__ void phase_hgrn_out(const Frame& F0, int l) {
    Frame F = F0; F.tid = F.wave * 64 + lane_id(); asm volatile("" : "+v"(F.tid)); F.lane = F.tid & 63;
    unsigned char* ws = opqg(F.ws); const __attribute__((address_space(4))) Args* a = opq(F.ka);
    const float* LOGF = (const float*)(ws + WS_LOGF); const bf16* KK = (const bf16*)(ws + WS_KK); const bf16* V = (const bf16*)(ws + WS_V);
    const bf16* Q = (const bf16*)(ws + WS_Q); const bf16* SG = (const bf16*)(ws + WS_SG); const bf16* SP = (const bf16*)(ws + WS_SP);
    bf16* OAB = (bf16*)(ws + WS_OAB); const float* NG = GP(const float, a->in[I_NG]) + (size_t)l * AW;
    LAS float* bL = (LAS float*)(F.lds + HG_BL); LAS bf16* VT = (LAS bf16*)(F.lds + HG_VT); LAS float* red = (LAS float*)(F.lds + HG_RED);
    const int fr = F.lane & 15, fq = F.lane >> 4, tt = F.wave & 3, vh = F.wave >> 2;
    LAS float* tot = (LAS float*)(F.lds + HG_TOT);
    float lf[16]; v4u vw0, vw1, kg0, kg1, qg0, qg1;
#define HGO_PREF(u_) { const int c_ = (u_) >> 3, h_ = (u_) & 7; \
        const float* src_ = LOGF + (size_t)(c_ * 64 + (F.tid >> 7) * 16) * AW + h_ * 128 + (F.tid & 127); \
        _Pragma("unroll") for (int i = 0; i < 16; ++i) lf[i] = src_[(size_t)i * AW]; \
        const v4u* vp_ = (const v4u*)(V + (size_t)(c_ * 64 + F.lane) * AW + h_ * 128 + F.wave * 16); vw0 = vp_[0]; vw1 = vp_[1]; \
        const size_t ro_ = ((size_t)c_ * 64 + (F.tid >> 3)) * AW + h_ * 128 + (F.tid & 7) * 16; \
        const v4u* kp_ = (const v4u*)(KK + ro_); const v4u* qp_ = (const v4u*)(Q + ro_); kg0 = kp_[0]; kg1 = kp_[1]; qg0 = qp_[0]; qg1 = qp_[1]; }
    if (F.vcu < NCH * 8) HGO_PREF(F.vcu)
    for (int unit = F.vcu; unit < NCH * 8; unit += F.G) {
        const int c = unit >> 3, h = unit & 7;
        { const int d = F.tid & 127, seg = F.tid >> 7;
#pragma unroll
          for (int i = 1; i < 16; ++i) lf[i] += lf[i - 1];
          tot[seg * 128 + d] = lf[15];
          { const int s = F.lane, vb = F.wave * 16; const unsigned ww[8] = {vw0.x, vw0.y, vw0.z, vw0.w, vw1.x, vw1.y, vw1.z, vw1.w};
#pragma unroll
            for (int j = 0; j < 8; ++j) { VT[(vb + 2 * j) * VTP + s] = (bf16)(ww[j] & 0xffffu); VT[(vb + 2 * j + 1) * VTP + s] = (bf16)(ww[j] >> 16); } }
          __syncthreads();
          float off = 0.f;
#pragma unroll
          for (int s2 = 0; s2 < 3; ++s2) off += (s2 < seg) ? tot[s2 * 128 + d] : 0.f;
#pragma unroll
          for (int i = 0; i < 16; ++i) bL[(seg * 16 + i) * BLP + d] = lf[i] + off; }
        __syncthreads();
        const int t = tt * 16 + fr; const size_t tok = (size_t)c * 64 + t;
        bf16x8 sg_[2][4];
#define HG_LOAD(buf, kd_) { const int d0_ = (kd_) * 32 + fq * 8; \
            _Pragma("unroll") for (int vt = 0; vt < 4; ++vt) sg_[buf][vt] = *(const bf16x8*)(SP + ((size_t)(c * 8 + h) * 128 + (vh * 4 + vt) * 16 + fr) * 128 + d0_); }
        HG_LOAD(0, 0) HG_LOAD(1, 1)
        v2u sgw[4];
#pragma unroll
        for (int vt = 0; vt < 4; ++vt) sgw[vt] = *(const v2u*)(SG + tok * AW + h * 128 + (vh * 4 + vt) * 16 + fq * 4);
        f32x4 ngw[4];
#pragma unroll
        for (int vt = 0; vt < 4; ++vt) ngw[vt] = *(const f32x4*)(NG + h * 128 + (vh * 4 + vt) * 16 + fq * 4);
        { const int s = F.tid >> 3, dc = (F.tid & 7) * 16;
          const unsigned kq[8] = {kg0.x, kg0.y, kg0.z, kg0.w, kg1.x, kg1.y, kg1.z, kg1.w}, qq[8] = {qg0.x, qg0.y, qg0.z, qg0.w, qg1.x, qg1.y, qg1.z, qg1.w};
          unsigned ko[8], qto[8], qho[8];
#pragma unroll
          for (int j4 = 0; j4 < 4; ++j4) { const f32x4 bs = *(const LAS f32x4*)(bL + s * BLP + dc + 4 * j4), br = *(const LAS f32x4*)(bL + 31 * BLP + dc + 4 * j4);
#pragma unroll
              for (int hx = 0; hx < 2; ++hx) { const int w = 2 * j4 + hx; const float b0 = bs[2 * hx], b1 = bs[2 * hx + 1], r0 = br[2 * hx], r1 = br[2 * hx + 1];
                  const float k0 = bf_lo(kq[w]), k1 = bf_hi(kq[w]), q0 = bf_lo(qq[w]), q1 = bf_hi(qq[w]);
                  ko[w] = cvt_pk_bf16(k0 * fexp(fminf(r0 - b0, 80.f)), k1 * fexp(fminf(r1 - b1, 80.f)));
                  qto[w] = cvt_pk_bf16(q0 * fexp(fminf(b0 - r0, 80.f)), q1 * fexp(fminf(b1 - r1, 80.f)));
                  qho[w] = cvt_pk_bf16(q0 * fexp(b0), q1 * fexp(b1)); } }
          LAS v4u* kd_ = (LAS v4u*)(F.lds + HG_KS + (s * KSP + dc) * 2); kd_[0] = (v4u){ko[0], ko[1], ko[2], ko[3]}; kd_[1] = (v4u){ko[4], ko[5], ko[6], ko[7]};
          LAS v4u* qt_ = (LAS v4u*)(F.lds + HG_QT + (s * KSP + dc) * 2); qt_[0] = (v4u){qto[0], qto[1], qto[2], qto[3]}; qt_[1] = (v4u){qto[4], qto[5], qto[6], qto[7]};
          LAS v4u* qh_ = (LAS v4u*)(F.lds + HG_QH + (s * KSP + dc) * 2); qh_[0] = (v4u){qho[0], qho[1], qho[2], qho[3]}; qh_[1] = (v4u){qho[4], qho[5], qho[6], qho[7]}; }
        __syncthreads();
        f32x4 att[4], o[4];
#pragma unroll
        for (int i = 0; i < 4; ++i) { att[i] = (f32x4){0.f, 0.f, 0.f, 0.f}; o[i] = (f32x4){0.f, 0.f, 0.f, 0.f}; }
#pragma unroll
        for (int kd = 0; kd < 4; ++kd) {
            const int cb = kd & 1;
            const int fo = (kd * 32 + fq * 8) * 2;
            const bf16x8 Bqt = *(const LAS bf16x8*)(F.lds + HG_QT + (t * KSP) * 2 + fo), Bqh = *(const LAS bf16x8*)(F.lds + HG_QH + (t * KSP) * 2 + fo);
#pragma unroll
            for (int st = 0; st < 4; ++st) { const bf16x8 kt = *(const LAS bf16x8*)(F.lds + HG_KS + ((st * 16 + fr) * KSP) * 2 + fo);
                att[st] = __builtin_amdgcn_mfma_f32_16x16x32_bf16(kt, Bqt, att[st], 0, 0, 0); }
#pragma unroll
            for (int vt = 0; vt < 4; ++vt) o[vt] = __builtin_amdgcn_mfma_f32_16x16x32_bf16(sg_[cb][vt], Bqh, o[vt], 0, 0, 0);
            if (kd < 2) HG_LOAD(cb, kd + 2)
            if (kd == 1) { const int nu = unit + F.G; if (nu < NCH * 8) HGO_PREF(nu) }
        }
#undef HG_LOAD
#pragma unroll
        for (int ks = 0; ks < 2; ++ks) {
            float m8[8];
#pragma unroll
            for (int jj = 0; jj < 8; ++jj) { const int st = 2 * ks + (jj >> 2), r = jj & 3, s = st * 16 + fq * 4 + r; m8[jj] = (s <= t) ? att[st][r] : 0.f; }
            v4u pb; pb.x = cvt_pk_bf16(m8[0], m8[1]); pb.y = cvt_pk_bf16(m8[2], m8[3]); pb.z = cvt_pk_bf16(m8[4], m8[5]); pb.w = cvt_pk_bf16(m8[6], m8[7]);
            const bf16x8 B = __builtin_bit_cast(bf16x8, pb);
#pragma unroll
            for (int vt = 0; vt < 4; ++vt) { const int v = (vh * 4 + vt) * 16 + fr;
                const v2u a0 = *(const LAS v2u*)(VT + v * VTP + ks * 32 + fq * 4), a1 = *(const LAS v2u*)(VT + v * VTP + ks * 32 + 16 + fq * 4);
                const v4u pa = (v4u){a0.x, a0.y, a1.x, a1.y};
                o[vt] = __builtin_amdgcn_mfma_f32_16x16x32_bf16(__builtin_bit_cast(bf16x8, pa), B, o[vt], 0, 0, 0); }
        }
        float ss = 0.f;
#pragma unroll
        for (int vt = 0; vt < 4; ++vt)
#pragma unroll
            for (int r = 0; r < 4; ++r) ss += o[vt][r] * o[vt][r];
        ss += __shfl_xor(ss, 16); ss += __shfl_xor(ss, 32);
        if (fq == 0) red[F.wave * 16 + fr] = ss;
        LDS_WAIT(); __builtin_amdgcn_s_barrier(); asm volatile("" ::: "memory");
        const float tot = red[F.wave * 16 + fr] + red[(F.wave ^ 4) * 16 + fr];
        const float rstd = __builtin_amdgcn_rsqf(tot * (1.f / 128.f) + RMS_EPS);
#pragma unroll
        for (int vt = 0; vt < 4; ++vt) { const int v0 = (vh * 4 + vt) * 16 + fq * 4;
            const f32x4 g4 = ngw[vt]; const v2u sg = sgw[vt];
            v2u w; w.x = cvt_pk_bf16(o[vt][0] * rstd * g4[0] * bf_lo(sg.x), o[vt][1] * rstd * g4[1] * bf_hi(sg.x));
            w.y = cvt_pk_bf16(o[vt][2] * rstd * g4[2] * bf_lo(sg.y), o[vt][3] * rstd * g4[3] * bf_hi(sg.y));
            *(v2u*)(OAB + tok * 2048 + h * 128 + v0) = w; }
        LDS_WAIT(); __builtin_amdgcn_s_barrier(); asm volatile("" ::: "memory");
    }
#undef HGO_PREF
}

constexpr int S5_UT = 0, S5_UTP = 2064, S5_XST = 33024, S5_XSP = 272, S5_KM = 37376;
__device__ __forceinline__ void s5_load_ut(const Frame& F, const bf16* UB, int g, int jb) {
#pragma unroll
    for (int i = 0; i < 2; ++i) { const int tl = F.tid + 512 * i; const v4u* src = (const v4u*)(UB + ((size_t)jb * 1024 + tl) * AW + g * 16);
        const v4u w0 = src[0], w1 = src[1]; LAS v4u* dst = (LAS v4u*)(F.lds + S5_UT + (tl >> 6) * S5_UTP + (tl & 63) * 32); dst[0] = w0; dst[1] = w1; }
}
__device__ __forceinline__ void phase_s5_local(const Frame& F0, int l) {
    Frame F = F0; F.tid = F.wave * 64 + lane_id(); asm volatile("" : "+v"(F.tid)); F.lane = F.tid & 63;
    unsigned char* ws = opqg(F.ws);
    const bf16* UB = (const bf16*)(ws + WS_UB); const bf16* PM = (const bf16*)(ws + WS_PM) + (size_t)l * 64 * 128 * 1024; float* XLOC = (float*)(ws + WS_XLOC);
    const int fr = F.lane & 15, fq = F.lane >> 4;
    for (int unit = F.vcu; unit < 64 * 8; unit += F.G) {
        const int g = unit >> 3, jb = unit & 7;
        s5_load_ut(F, UB, g, jb);
        __syncthreads();
        f32x4 acc = (f32x4){0.f, 0.f, 0.f, 0.f};
        const bf16* ap = PM + ((size_t)g * 128 + F.wave * 16 + fr) * 1024 + fq * 8;
        const LAS unsigned char* bp = F.lds + S5_UT + fr * S5_UTP + (fq >> 1) * 32 + (fq & 1) * 16;
#pragma unroll 8
        for (int ks = 0; ks < 32; ++ks) { const bf16x8 A = *(const bf16x8*)(ap + ks * 32); const bf16x8 B = *(const LAS bf16x8*)(bp + ks * 64);
            acc = __builtin_amdgcn_mfma_f32_16x16x32_bf16(A, B, acc, 0, 0, 0); }
        *(f32x4*)(XLOC + ((size_t)(jb * 16 + fr) * 64 + g) * 128 + F.wave * 16 + fq * 4) = acc;
        __syncthreads();
    }
}
__device__ __forceinline__ void phase_s5_out(const Frame& F0, int l) {
    Frame F = F0; F.tid = F.wave * 64 + lane_id(); asm volatile("" : "+v"(F.tid)); F.lane = F.tid & 63;
    unsigned char* ws = opqg(F.ws);
    const bf16* UB = (const bf16*)(ws + WS_UB); const bf16* E = (const bf16*)(ws + WS_E) + (size_t)l * 64 * 1024 * 128; const bf16* KMAT = (const bf16*)(ws + WS_KMAT) + (size_t)l * 64 * 65 * 256;
    const float* XS = (const float*)(ws + WS_XS); bf16* YB = (bf16*)(ws + WS_YB);
    const int fr = F.lane & 15, fq = F.lane >> 4;
    for (int unit = F.vcu; unit < 64 * 8; unit += F.G) {
        const int g = unit >> 3, jb = unit & 7;
        s5_load_ut(F, UB, g, jb);
        { const int cc = F.tid >> 5, p0 = (F.tid & 31) * 4; const f32x4 xv = *(const f32x4*)(XS + ((size_t)(jb * 16 + cc) * 64 + g) * 128 + p0);
          v2u w; w.x = cvt_pk_bf16(xv[0], xv[1]); w.y = cvt_pk_bf16(xv[2], xv[3]); *(LAS v2u*)(F.lds + S5_XST + cc * S5_XSP + p0 * 2) = w; }
        for (int pc = F.tid; pc < 65 * 32; pc += 512) { const int idx = pc >> 5, n = (pc >> 1) & 15, half = pc & 1;
            const v4u w = *(const v4u*)(KMAT + (size_t)g * 65 * 256 + (size_t)pc * 8); *(LAS v4u*)(F.lds + S5_KM + idx * 512 + n * 32 + ((half ^ (n >> 3)) * 16)) = w; }
        __syncthreads();
        for (int ti = 0; ti < 8; ++ti) {
            const int tau = ti * 8 + F.wave;
            const bf16* ep = E + ((size_t)g * 1024 + tau * 16 + fr) * 128 + fq * 8;
            bf16x8 Ae[4];
#pragma unroll
            for (int ke = 0; ke < 4; ++ke) Ae[ke] = *(const bf16x8*)(ep + ke * 32);
            f32x4 acc = (f32x4){0.f, 0.f, 0.f, 0.f}, acc1 = (f32x4){0.f, 0.f, 0.f, 0.f};
            const LAS unsigned char* bp = F.lds + S5_UT + fr * S5_UTP + (fq >> 1) * 32 + (fq & 1) * 16;
            const LAS unsigned char* kp = F.lds + S5_KM + (tau - (fq >> 1) + 1) * 512 + fr * 32 + (((fq & 1) ^ (fr >> 3)) * 16);
            const int nks = (tau >> 1) + 1;
            int ks = 0;
            for (; ks + 4 <= nks; ks += 4) {
                const bf16x8 A0 = *(const LAS bf16x8*)(kp - ks * 1024), A1 = *(const LAS bf16x8*)(kp - (ks + 1) * 1024), A2 = *(const LAS bf16x8*)(kp - (ks + 2) * 1024), A3 = *(const LAS bf16x8*)(kp - (ks + 3) * 1024);
                const bf16x8 B0 = *(const LAS bf16x8*)(bp + ks * 64), B1 = *(const LAS bf16x8*)(bp + (ks + 1) * 64), B2 = *(const LAS bf16x8*)(bp + (ks + 2) * 64), B3 = *(const LAS bf16x8*)(bp + (ks + 3) * 64);
                acc = __builtin_amdgcn_mfma_f32_16x16x32_bf16(A0, B0, acc, 0, 0, 0); acc1 = __builtin_amdgcn_mfma_f32_16x16x32_bf16(A1, B1, acc1, 0, 0, 0);
                acc = __builtin_amdgcn_mfma_f32_16x16x32_bf16(A2, B2, acc, 0, 0, 0); acc1 = __builtin_amdgcn_mfma_f32_16x16x32_bf16(A3, B3, acc1, 0, 0, 0); }
            for (; ks < nks; ++ks) { const bf16x8 A = *(const LAS bf16x8*)(kp - ks * 1024); const bf16x8 B = *(const LAS bf16x8*)(bp + ks * 64);
                acc = __builtin_amdgcn_mfma_f32_16x16x32_bf16(A, B, acc, 0, 0, 0); }
            const LAS unsigned char* xp = F.lds + S5_XST + fr * S5_XSP + fq * 16;
#pragma unroll
            for (int ke = 0; ke < 4; ke += 2) { const bf16x8 B0 = *(const LAS bf16x8*)(xp + ke * 64), B1 = *(const LAS bf16x8*)(xp + (ke + 1) * 64);
                acc = __builtin_amdgcn_mfma_f32_16x16x32_bf16(Ae[ke], B0, acc, 0, 0, 0); acc1 = __builtin_amdgcn_mfma_f32_16x16x32_bf16(Ae[ke + 1], B1, acc1, 0, 0, 0); }
            acc += acc1;
            v2u w; w.x = cvt_pk_bf16(gelu_tanh(acc[0]), gelu_tanh(acc[1])); w.y = cvt_pk_bf16(gelu_tanh(acc[2]), gelu_tanh(acc[3]));
            *(v2u*)(YB + ((size_t)(jb * 16 + fr) * 64 + tau) * AW + g * 16 + fq * 4) = w;
        }
        __syncthreads();
    }
}

__device__ __forceinline__ void phase_ln(const Frame& F0, int l, int which) {
    Frame F = F0; F.tid = F.wave * 64 + lane_id(); asm volatile("" : "+v"(F.tid)); F.lane = F.tid & 63;
    unsigned char* ws = opqg(F.ws); const __attribute__((address_space(4))) Args* a = opq(F.ka);
    const bf16* RS = (const bf16*)(ws + WS_RH); bf16* XS = (bf16*)(ws + WS_XH);
    const bool last = (which == 1 && l == DEPTH - 1); float* OUT = GP(float, a->out);
    const float* gam = GP(const float, a->in[which == 0 ? I_LN1G : I_LN2G]) + (size_t)l * D; const float* bet = GP(const float, a->in[which == 0 ? I_LN1B : I_LN2B]) + (size_t)l * D;
    const int gw = F.vcu * 8 + F.wave, NGW = F.G * 8;
    const int j = F.lane & 3, rr = (F.lane >> 2) & 1, sl = F.lane >> 3;
    for (int rp = gw; rp < T / 2; rp += NGW) {
        const int row = 2 * rp + rr;
        const size_t eo = ((size_t)sl * T + row) * 32 + j * 8;
        v4u w[8];
#pragma unroll
        for (int i = 0; i < 8; ++i) w[i] = *(const v4u*)(RS + eo + (size_t)i * 8 * T * 32);
        float v[64]; float s = 0.f;
#pragma unroll
        for (int i = 0; i < 8; ++i) { const unsigned ww[4] = {w[i].x, w[i].y, w[i].z, w[i].w};
#pragma unroll
            for (int k = 0; k < 4; ++k) { const h2_t hv = __builtin_bit_cast(h2_t, ww[k]); v[8 * i + 2 * k] = (float)hv.x; v[8 * i + 2 * k + 1] = (float)hv.y; s += (float)hv.x + (float)hv.y; } }
        s += __shfl_xor(s, 1); s += __shfl_xor(s, 2); s += __shfl_xor(s, 8); s += __shfl_xor(s, 16); s += __shfl_xor(s, 32);
        const float mean = s * (1.f / D); float s2 = 0.f;
#pragma unroll
        for (int i = 0; i < 64; ++i) { v[i] -= mean; s2 += v[i] * v[i]; }
        s2 += __shfl_xor(s2, 1); s2 += __shfl_xor(s2, 2); s2 += __shfl_xor(s2, 8); s2 += __shfl_xor(s2, 16); s2 += __shfl_xor(s2, 32);
        const float rstd = __builtin_amdgcn_rsqf(s2 * (1.f / D) + LN_EPS);
        float amax = 0.f;
#pragma unroll
        for (int i = 0; i < 8; ++i) { const int e0 = (8 * i + sl) * 32 + j * 8;
            const f32x4 g0 = *(const f32x4*)(gam + e0), g1 = *(const f32x4*)(gam + e0 + 4), b0 = *(const f32x4*)(bet + e0), b1 = *(const f32x4*)(bet + e0 + 4);
            const f32x4 y0 = (f32x4){v[8 * i], v[8 * i + 1], v[8 * i + 2], v[8 * i + 3]} * rstd * g0 + b0, y1 = (f32x4){v[8 * i + 4], v[8 * i + 5], v[8 * i + 6], v[8 * i + 7]} * rstd * g1 + b1;
            if (last) { *(f32x4*)(OUT + (size_t)row * D + e0) = y0; *(f32x4*)(OUT + (size_t)row * D + e0 + 4) = y1; }
            else { v4u o; o.x = cvt_pk_f16(y0[0], y0[1]); o.y = cvt_pk_f16(y0[2], y0[3]); o.z = cvt_pk_f16(y1[0], y1[1]); o.w = cvt_pk_f16(y1[2], y1[3]); *(v4u*)(XS + eo + (size_t)i * 8 * T * 32) = o; }
            if (which == 0) {
#pragma unroll
                for (int k = 0; k < 4; ++k) { v[8 * i + k] = y0[k]; v[8 * i + 4 + k] = y1[k]; amax = fmaxf(amax, fmaxf(fabsf(y0[k]), fabsf(y1[k]))); } } }
        if (which == 0) {
            amax = fmaxf(amax, __shfl_xor(amax, 1)); amax = fmaxf(amax, __shfl_xor(amax, 2)); amax = fmaxf(amax, __shfl_xor(amax, 8)); amax = fmaxf(amax, __shfl_xor(amax, 16)); amax = fmaxf(amax, __shfl_xor(amax, 32));
            const float inv = (amax > 0.f) ? 127.f / amax : 0.f;
            if (j == 0 && sl == 0) ((float*)(ws + WS_SX))[row] = (amax > 0.f) ? amax * (1.f / 127.f) : 1.f;
            unsigned char* xq = ws + WS_XQ + (size_t)row * 64 + (sl & 1) * 32 + j * 8;
#pragma unroll
            for (int i = 0; i < 8; ++i) { int q[8];
#pragma unroll
                for (int k = 0; k < 8; ++k) q[k] = (int)__builtin_rintf(v[8 * i + k] * inv);
                v2u o; o.x = (unsigned)(q[0] & 255) | ((unsigned)(q[1] & 255) << 8) | ((unsigned)(q[2] & 255) << 16) | ((unsigned)q[3] << 24);
                o.y = (unsigned)(q[4] & 255) | ((unsigned)(q[5] & 255) << 8) | ((unsigned)(q[6] & 255) << 16) | ((unsigned)q[7] << 24);
                *(v2u*)(xq + (size_t)(4 * i + (sl >> 1)) * T * 64) = o; } }
    }
}

constexpr int PK_TV = 0, PK_EID = 65536, PK_GATE = 81920;
__device__ __forceinline__ int f2key(float x) { const int b = __float_as_int(x); return b ^ ((b >> 31) & 0x7fffffff); }
__device__ __forceinline__ float key2f(int k) { return __int_as_float(k ^ ((k >> 31) & 0x7fffffff)); }
__device__ __forceinline__ int imed3(int a, int b, int c) { int r; asm("v_med3_i32 %0, %1, %2, %3" : "=v"(r) : "v"(a), "v"(b), "v"(c)); return r; }
#define INSK(kx) do { const int _x = (kx); _Pragma("unroll") for (int _k = 15; _k > 0; --_k) tk[_k] = imed3(tk[_k - 1], tk[_k], _x); tk[0] = max(tk[0], _x); } while (0)
__device__ __forceinline__ void phase_topk(const Frame& F0, int l) {
    Frame F = F0; F.tid = F.wave * 64 + lane_id(); asm volatile("" : "+v"(F.tid)); F.lane = F.tid & 63;
    unsigned char* ws = opqg(F.ws);
    const float* SC = (const float*)(ws + WS_SC); int* SEID = (int*)(ws + WS_SEID); float* SGATE = (float*)(ws + WS_SGATE); unsigned char* START = ws + WS_START;
    LAS int* TK = (LAS int*)(F.lds + PK_TV); LAS int* EIDL = (LAS int*)(F.lds + PK_EID); LAS float* GATEL = (LAS float*)(F.lds + PK_GATE);
    for (int tb = F.vcu; tb < T / 32; tb += F.G) {
        const int t0 = tb * 32;
        { const int tok = F.tid >> 4, hh = F.tid & 15;
          const v4u* sp = (const v4u*)((const bf16*)SC + (size_t)(t0 + tok) * 2048 + hh * 128);
          int tk[16];
#pragma unroll
          for (int k = 0; k < 16; ++k) tk[k] = (int)0x80000000;
#pragma unroll 2
          for (int i = 0; i < 16; ++i) { const v4u s0 = sp[i]; const unsigned sw[4] = {s0.x, s0.y, s0.z, s0.w};
#pragma unroll
              for (int x = 0; x < 4; ++x) { INSK((f2key(bf_lo(sw[x])) & ~127) | (127 - (8 * i + 2 * x))); INSK((f2key(bf_hi(sw[x])) & ~127) | (127 - (8 * i + 2 * x + 1))); } }
#pragma unroll
          for (int k = 0; k < 16; ++k) TK[F.tid * 16 + k] = tk[k]; }
        __syncthreads();
        if ((F.tid & 1) == 0) {
            float v1[16], v2[16];
#pragma unroll
            for (int k = 0; k < 16; ++k) { v1[k] = key2f(TK[F.tid * 16 + k] & ~127); v2[k] = key2f(TK[(F.tid + 1) * 16 + k] & ~127); }
            int tk[16];
#pragma unroll
            for (int k = 0; k < 16; ++k) tk[k] = (int)0x80000000;
#pragma unroll
            for (int aa = 0; aa < 16; ++aa)
#pragma unroll
                for (int bb = 0; bb < 16; ++bb) if ((aa + 1) * (bb + 1) <= 16) { INSK((f2key(v1[aa] + v2[bb]) & ~255) | (255 - (aa * 16 + bb))); }
            float ex[16], sum = 0.f; const float v0 = key2f(tk[0] & ~255);
#pragma unroll
            for (int k = 0; k < 16; ++k) { ex[k] = expf(key2f(tk[k] & ~255) - v0); sum += ex[k]; }
            const float inv = 1.f / sum;
            const int tok = F.tid >> 4, hd = (F.tid >> 1) & 7;
#pragma unroll
            for (int k = 0; k < 16; ++k) { const int code = 255 - (tk[k] & 255);
                const int i1 = 127 - (TK[F.tid * 16 + (code >> 4)] & 127), i2 = 127 - (TK[(F.tid + 1) * 16 + (code & 15)] & 127);
                EIDL[tok * 128 + hd * 16 + k] = (((i1 + i2) & 15) << 10) + i1 * 8 + (i2 >> 4); GATEL[tok * 128 + hd * 16 + k] = ex[k] * inv; }
        }
        __syncthreads();
        for (int ti = 0; ti < 4; ++ti) {
            const int tok = F.wave * 4 + ti;
            int k0 = (EIDL[tok * 128 + F.lane] << 7) | F.lane, k1 = (EIDL[tok * 128 + 64 + F.lane] << 7) | (64 + F.lane);
#pragma unroll
            for (int k = 2; k <= 128; k <<= 1)
#pragma unroll
                for (int j = k >> 1; j > 0; j >>= 1) {
                    if (j == 64) { const int mn = min(k0, k1), mx = max(k0, k1); k0 = mn; k1 = mx; }
                    else { const int o0 = __shfl_xor(k0, j), o1 = __shfl_xor(k1, j); const bool lower = (F.lane & j) == 0;
                        const bool up0 = (F.lane & k) == 0, up1 = ((64 + F.lane) & k) == 0;
                        k0 = (up0 == lower) ? min(k0, o0) : max(k0, o0); k1 = (up1 == lower) ? min(k1, o1) : max(k1, o1); }
                }
            const size_t t = (size_t)(t0 + tok);
            { const int r0 = k0 >> 17, r1 = k1 >> 17; int mine = 0;
#pragma unroll
              for (int r = 1; r < 16; ++r) { const int c = __builtin_popcountll(__ballot(r0 < r)) + __builtin_popcountll(__ballot(r1 < r)); mine = (F.lane == r) ? c : mine; }
              if (F.lane < 16) START[t * 16 + F.lane] = (unsigned char)mine; }
            SEID[t * LP + F.lane] = k0 >> 7; SEID[t * LP + 64 + F.lane] = k1 >> 7;
            SGATE[t * 128 + F.lane] = GATEL[tok * 128 + (k0 & 127)]; SGATE[t * 128 + 64 + F.lane] = GATEL[tok * 128 + (k1 & 127)];
        }
        __syncthreads();
    }
}
typedef __bf16 bf2_t __attribute__((ext_vector_type(2)));
__device__ __forceinline__ float dot2bf(unsigned a, unsigned b, float c) { return __builtin_amdgcn_fdot2_f32_bf16(__builtin_bit_cast(bf2_t, a), __builtin_bit_cast(bf2_t, b), c, false); }
__device__ __forceinline__ void peer_stage(const Frame& F, const bf16* gsrc, int bo) {
#pragma unroll
    for (int i = 0; i < 8; ++i) { const int p = i * 8 + F.wave;
        __builtin_amdgcn_global_load_lds((const unsigned*)((const char*)gsrc + p * 1024 + F.lane * 16), (LAS unsigned*)(F.lds + bo + p * 1024), 16, 0, 0); }
}
__device__ __forceinline__ void peer_dma(const Frame& F, const void* gsrc, int bo) {
    const unsigned ldsbase = (unsigned)(size_t)(F.lds + bo) + (unsigned)F.wave * 1024u;
#pragma unroll
    for (int i = 0; i < 8; ++i) { const char* g = (const char*)gsrc + (i * 8 + F.wave) * 1024 + F.lane * 16; const unsigned m = ldsbase + i * 8192u;
        asm volatile("s_mov_b32 m0, %0\n\ts_nop 0\n\tglobal_load_lds_dwordx4 %1, off" :: "s"(m), "v"((GAS const char*)g) : "memory"); }
}
__device__ __forceinline__ int wave_max_i(int v) {
#pragma unroll
    for (int o = 1; o < 64; o <<= 1) v = max(v, __shfl_xor(v, o));
    return __builtin_amdgcn_readfirstlane(v);
}
template <int K> __device__ __forceinline__ unsigned dppq(unsigned v) { return (unsigned)__builtin_amdgcn_mov_dpp((int)v, K * 0x55, 0xf, 0xf, true); }
__device__ __forceinline__ int sdot4(unsigned a, unsigned b, int c) { return __builtin_amdgcn_sdot4((int)a, (int)b, c, false); }
__device__ __forceinline__ int quad_sum_i(int v) {
    v += __builtin_amdgcn_mov_dpp(v, 0xB1, 0xf, 0xf, true);
    v += __builtin_amdgcn_mov_dpp(v, 0x4E, 0xf, 0xf, true);
    return v;
}
__device__ __forceinline__ float quad_sum(float v) {
    v += __int_as_float(__builtin_amdgcn_mov_dpp(__float_as_int(v), 0xB1, 0xf, 0xf, true));
    v += __int_as_float(__builtin_amdgcn_mov_dpp(__float_as_int(v), 0x4E, 0xf, 0xf, true));
    return v;
}
constexpr int UCAP0 = 24, UCAP1 = 12, UCAP2 = 12, UCAP3 = 8;
__device__ __forceinline__ void phase_peer_u(const Frame& F0, int l) {
    Frame F = F0; F.tid = F.wave * 64 + lane_id(); asm volatile("" : "+v"(F.tid)); F.lane = F.tid & 63;
    unsigned char* ws = opqg(F.ws);
    const bf16* TU = (const bf16*)(ws + WS_TBU) + (size_t)l * 32 * NEXP * 32;
    const int* SEID = (const int*)(ws + WS_SEID); const float* SGATE = (const float*)(ws + WS_SGATE); unsigned* PACK = (unsigned*)(ws + WS_PACK); unsigned char* START = ws + WS_START;
    const bf16* XBS = (const bf16*)(ws + WS_XQ); unsigned* PACK2 = (unsigned*)(ws + WS_PACK2);
    const float* SX = (const float*)(ws + WS_SX); const float* SU = (const float*)(ws + WS_SU) + (size_t)l * NEXP;
    const int qd = F.lane >> 2, jc = F.lane & 3;
    for (int unit = F.vcu; unit < 256; unit += F.G) {
        const int tt = unit & 15, er = unit >> 4; const size_t t = (size_t)tt * 512 + F.tid;
        const int lo = START[t * 16 + er], hi = (er < 15) ? (int)START[t * 16 + er + 1] : 128;
        const int cnt = hi - lo;
        int key = (cnt << 6) | (63 - F.lane);
#pragma unroll
        for (int k = 2; k <= 64; k <<= 1)
#pragma unroll
            for (int j = k >> 1; j > 0; j >>= 1) { const int o = __shfl_xor(key, j); const bool lower = (F.lane & j) == 0, up = (F.lane & k) == 0;
                key = (up == lower) ? max(key, o) : min(key, o); }
        int tl[4], glo[4], gcnt[4], gmax[4];
#pragma unroll
        for (int a = 0; a < 4; ++a) { const int kk = __shfl(key, a * 16 + qd); tl[a] = 63 - (kk & 63); gcnt[a] = kk >> 6; glo[a] = __shfl(lo, tl[a]);
            gmax[a] = __builtin_amdgcn_readfirstlane(__shfl(key, a * 16)) >> 6; }
        const size_t tbase = (size_t)tt * 512 + F.wave * 64;
        unsigned ro0[UCAP0 / 4], ro1[UCAP1 / 4], ro2[UCAP2 / 4], ro3[UCAP3 / 4];
#define LOADRO(arr, a, CAP) _Pragma("unroll") for (int i = 0; i < CAP / 4; ++i) { const int s = 4 * i + jc; const int e = SEID[(tbase + tl[a]) * LP + glo[a] + s]; \
            const int row = (s < gcnt[a]) ? (e & 1023) : 0; arr[i] = (unsigned)((row << 6) + (((row >> 2) & 3) << 4)); }
        LOADRO(ro0, 0, UCAP0) LOADRO(ro1, 1, UCAP1) LOADRO(ro2, 2, UCAP2) LOADRO(ro3, 3, UCAP3)
#undef LOADRO
        int ac0[UCAP0], ac1[UCAP1], ac2[UCAP2], ac3[UCAP3];
#pragma unroll
        for (int s = 0; s < UCAP0; ++s) ac0[s] = 0;
#pragma unroll
        for (int s = 0; s < UCAP1; ++s) ac1[s] = 0;
#pragma unroll
        for (int s = 0; s < UCAP2; ++s) ac2[s] = 0;
#pragma unroll
        for (int s = 0; s < UCAP3; ++s) ac3[s] = 0;
        const bf16* gsl0 = TU + (size_t)er * 1024 * 32;
#define XA(a) ((const v4u*)(XBS + (tbase + tl[a]) * 32) + jc)
        v4u xs[4];
#pragma unroll
        for (int a = 0; a < 4; ++a) xs[a] = XA(a)[0];
        peer_dma(F, gsl0, 0);
        VM_WAIT(); __syncthreads();
#pragma unroll 1
        for (int ks = 0; ks < 32; ++ks) {
            const int bo = (ks & 1) * 65536, jx = jc << 4;
            v4u xn[4];
            const int kn = (ks + 1 < 32) ? ks + 1 : ks;
#pragma unroll
            for (int a = 0; a < 4; ++a) xn[a] = XA(a)[(size_t)kn * T * 4];
            if (ks + 1 < 32) peer_dma(F, gsl0 + (size_t)kn * NEXP * 32, bo ^ 65536);
#define URD(B, arr, g) { asm volatile("" : "+v"(arr[g])); B[0] = *(const LAS v4u*)(F.lds + bo + (dppq<0>(arr[g]) ^ jx)); B[1] = *(const LAS v4u*)(F.lds + bo + (dppq<1>(arr[g]) ^ jx)); \
                B[2] = *(const LAS v4u*)(F.lds + bo + (dppq<2>(arr[g]) ^ jx)); B[3] = *(const LAS v4u*)(F.lds + bo + (dppq<3>(arr[g]) ^ jx)); }
#define UCP(B, acc, a, g) { _Pragma("unroll") for (int q = 0; q < 4; ++q) { int p0 = acc[4 * (g) + q]; \
                p0 = sdot4(B[q].x, xs[a].x, p0); p0 = sdot4(B[q].y, xs[a].y, p0); p0 = sdot4(B[q].z, xs[a].z, p0); p0 = sdot4(B[q].w, xs[a].w, p0); acc[4 * (g) + q] = p0; } }
            { v4u BE[4], BO[4];
              URD(BE, ro0, 0) __builtin_amdgcn_sched_barrier(0);
              URD(BO, ro0, 1) UCP(BE, ac0, 0, 0)
              __builtin_amdgcn_sched_barrier(0);
              URD(BE, ro0, 2) UCP(BO, ac0, 0, 1)
              __builtin_amdgcn_sched_barrier(0);
              URD(BO, ro0, 3) UCP(BE, ac0, 0, 2)
              __builtin_amdgcn_sched_barrier(0);
              URD(BE, ro0, 4) UCP(BO, ac0, 0, 3)
              __builtin_amdgcn_sched_barrier(0);
              URD(BO, ro0, 5) UCP(BE, ac0, 0, 4)
              __builtin_amdgcn_sched_barrier(0);
              URD(BE, ro1, 0) UCP(BO, ac0, 0, 5)
              __builtin_amdgcn_sched_barrier(0);
              URD(BO, ro1, 1) UCP(BE, ac1, 1, 0)
              __builtin_amdgcn_sched_barrier(0);
              URD(BE, ro1, 2) UCP(BO, ac1, 1, 1)
              __builtin_amdgcn_sched_barrier(0);
              URD(BO, ro2, 0) UCP(BE, ac1, 1, 2)
              __builtin_amdgcn_sched_barrier(0);
              URD(BE, ro2, 1) UCP(BO, ac2, 2, 0)
              __builtin_amdgcn_sched_barrier(0);
              URD(BO, ro2, 2) UCP(BE, ac2, 2, 1)
              __builtin_amdgcn_sched_barrier(0);
              URD(BE, ro3, 0) UCP(BO, ac2, 2, 2)
              __builtin_amdgcn_sched_barrier(0);
              URD(BO, ro3, 1) UCP(BE, ac3, 3, 0)
              __builtin_amdgcn_sched_barrier(0);
              UCP(BO, ac3, 3, 1) }
#undef URD
#undef UCP
#pragma unroll
            for (int a = 0; a < 4; ++a) xs[a] = xn[a];
            VM_WAIT(); __syncthreads();
        }
        float gt0[UCAP0 / 4], gt1[UCAP1 / 4], gt2[UCAP2 / 4], gt3[UCAP3 / 4];
        float sq0[UCAP0 / 4], sq1[UCAP1 / 4], sq2[UCAP2 / 4], sq3[UCAP3 / 4];
#define UGT(gt, sq, arr, a, CAP) { const float* gp_ = SGATE + (tbase + tl[a]) * 128; const float sx_ = SX[tbase + tl[a]]; _Pragma("unroll") for (int i = 0; i < CAP / 4; ++i) { gt[i] = gp_[min(glo[a] + 4 * i + jc, 127)]; sq[i] = sx_ * SU[er * 1024 + (int)(arr[i] >> 6)]; } }
        UGT(gt0, sq0, ro0, 0, UCAP0) UGT(gt1, sq1, ro1, 1, UCAP1) UGT(gt2, sq2, ro2, 2, UCAP2) UGT(gt3, sq3, ro3, 3, UCAP3)
#undef UGT
#define UOUT(arr, acc, gt, sq, a, CAP) { const size_t tk = tbase + tl[a]; _Pragma("unroll") for (int s = 0; s < CAP; ++s) { const int toti = quad_sum_i(acc[s]); \
            if ((s & 3) == jc && s < NSLOT) { unsigned wv = 0u; if (s < gcnt[a]) { const float av = gelu_tanh((float)toti * sq[s >> 2]) * gt[s >> 2]; wv = (arr[s >> 2] << 16) | (cvt_pk_f16(av, 0.f) & 0xffffu); } \
                PACK2[(tk * 16 + er) * NSLOT + s] = wv; } } \
            _Pragma("unroll") for (int s = CAP; s < NSLOT; ++s) if ((s & 3) == jc && s >= gcnt[a]) PACK2[(tk * 16 + er) * NSLOT + s] = 0u; }
        UOUT(ro0, ac0, gt0, sq0, 0, UCAP0) UOUT(ro1, ac1, gt1, sq1, 1, UCAP1) UOUT(ro2, ac2, gt2, sq2, 2, UCAP2) UOUT(ro3, ac3, gt3, sq3, 3, UCAP3)
#undef UOUT
#undef XA
        { int myrank = 0; const int mykey = (cnt << 6) | (63 - F.lane);
          for (int p = 0; p < 64; ++p) myrank += (__shfl(key, p) > mykey) ? 1 : 0;
          const int cap = myrank < 16 ? UCAP0 : (myrank < 32 ? UCAP1 : (myrank < 48 ? UCAP2 : UCAP3));
          const v4u* xsp = (const v4u*)(XBS + t * 32);
          for (int s = cap; s < cnt; ++s) {
              const int pos = lo + s, e = SEID[t * LP + pos]; const int f = (e >> 2) & 3; int di = 0;
              for (int ks = 0; ks < 32; ++ks)
#pragma unroll
                  for (int j = 0; j < 4; ++j) { const v4u u4 = *(const v4u*)(TU + (((size_t)ks * NEXP + e) * 4 + (j ^ f)) * 8); const v4u x4 = xsp[(size_t)ks * T * 4 + j];
                      di = sdot4(u4.x, x4.x, di); di = sdot4(u4.y, x4.y, di); di = sdot4(u4.z, x4.z, di); di = sdot4(u4.w, x4.w, di); }
              const float d = (float)di * SX[t] * SU[e];
              const int row = e & 1023;
              const unsigned wv = ((unsigned)((row << 6) + (((row >> 2) & 3) << 4)) << 16) | (cvt_pk_f16(gelu_tanh(d) * SGATE[t * 128 + pos], 0.f) & 0xffffu);
              if (s < NSLOT) PACK2[(t * 16 + er) * NSLOT + s] = wv; else PACK[t * LP + pos] = wv; }
        }
    }
}
#ifndef VBLK
#define VBLK 2
#endif
#if VBLK == 4
#define VTT(x, j) (4 * ((x) & 3) + ((j) & 3))
#define VDS(x, j, it) (32 * ((x) >> 2) + 8 * (it) + ((j) >> 2))
#elif VBLK == 8
#define VTT(x, j) (8 * ((x) & 1) + ((j) & 7))
#define VDS(x, j, it) (16 * ((x) >> 1) + 4 * (it) + ((j) >> 3))
#elif VBLK == 2
#define VTT(x, j) (2 * (x) + ((j) & 1))
#define VDS(x, j, it) (16 * (it) + ((j) >> 1))
#else
#define VTT(x, j) ((j) & 15)
#define VDS(x, j, it) (((x) * 32 + (j) + 256 * (it)) >> 4)
#endif
__device__ __forceinline__ void phase_peer_v(const Frame& F0, int l) {
    Frame F = F0; F.tid = F.wave * 64 + lane_id(); asm volatile("" : "+v"(F.tid)); F.lane = F.tid & 63;
    unsigned char* ws = opqg(F.ws);
    const bf16* TV = (const bf16*)(ws + WS_TBV) + (size_t)l * 64 * NEXP * 32; const bf16* XS = (const bf16*)(ws + WS_XH); bf16* RS = (bf16*)(ws + WS_RH);
    const unsigned* PACK = (const unsigned*)(ws + WS_PACK); const unsigned char* START = ws + WS_START; const unsigned* PACK2 = (const unsigned*)(ws + WS_PACK2);
    for (int it = 0; it * F.G + F.vcu < 1024; ++it) {
        int tt, ds;
        if (F.G == 256) { const int x = F.vcu >> 5, j = F.vcu & 31; tt = VTT(x, j); ds = VDS(x, j, it); }
        else { const int unit = it * F.G + F.vcu; tt = unit & 15; ds = unit >> 4; }
        const size_t t = (size_t)tt * 512 + F.tid;
        const v4u st4 = *(const v4u*)(START + t * 16);
        const unsigned stw[4] = {st4.x, st4.y, st4.z, st4.w};
        unsigned acc[16];
#pragma unroll
        for (int i = 0; i < 16; ++i) acc[i] = 0u;
        const bf16* gsl0 = TV + (size_t)ds * NEXP * 32;
        unsigned Lc[NSLOT];
        { const v4u* lp = (const v4u*)(PACK2 + t * 16 * NSLOT);
#pragma unroll
          for (int s = 0; s < NSLOT / 4; ++s) { const v4u q = lp[s]; Lc[4 * s] = q.x; Lc[4 * s + 1] = q.y; Lc[4 * s + 2] = q.z; Lc[4 * s + 3] = q.w; } }
        peer_dma(F, gsl0, 0);
        VM_WAIT(); __syncthreads();
#pragma unroll 1
        for (int c = 0; c < 16; ++c) {
            const int bo = (c & 1) * 65536;
            const int q0 = c >> 2, q1 = (c + 1) >> 2;
            const unsigned w0 = q0 == 0 ? stw[0] : (q0 == 1 ? stw[1] : (q0 == 2 ? stw[2] : stw[3])), w1 = q1 == 0 ? stw[0] : (q1 == 1 ? stw[1] : (q1 == 2 ? stw[2] : stw[3]));
            const int s_c = (int)((w0 >> ((c & 3) * 8)) & 255u);
            const int s_n = (c < 15) ? (int)((w1 >> (((c + 1) & 3) * 8)) & 255u) : 128;
            const int n_c = s_n - s_c;
            unsigned Ln[NSLOT];
            const int cn = (c < 15) ? c + 1 : c;
            { const v4u* lp = (const v4u*)(PACK2 + (t * 16 + cn) * NSLOT);
#pragma unroll
              for (int s = 0; s < NSLOT / 4; ++s) { const v4u q = lp[s]; Ln[4 * s] = q.x; Ln[4 * s + 1] = q.y; Ln[4 * s + 2] = q.z; Ln[4 * s + 3] = q.w; } }
            if (c < 15) peer_dma(F, gsl0 + (size_t)cn * 1024 * 32, bo ^ 65536);
            const int wmax = wave_max_i(min(n_c, NSLOT));
#pragma unroll
            for (int g = 0; g < NSLOT / 2; ++g) {
                if (2 * g < wmax) {
                    v4u v4[2][4]; unsigned a2[2];
#pragma unroll
                    for (int q = 0; q < 2; ++q) { const int s = 2 * g + q; const unsigned w = Lc[s];
                        a2[q] = __builtin_amdgcn_perm(w, w, 0x01000100u);
                        const int a0 = bo + (int)((w >> 16) & 0xfff0u);
#pragma unroll
                        for (int j = 0; j < 4; ++j) v4[q][j] = *(const LAS v4u*)(F.lds + (a0 ^ (j << 4))); }
#pragma unroll
                    for (int q = 0; q < 2; ++q)
#pragma unroll
                        for (int j = 0; j < 4; ++j) {
                            acc[4 * j + 0] = pkfmah(v4[q][j].x, a2[q], acc[4 * j + 0]); acc[4 * j + 1] = pkfmah(v4[q][j].y, a2[q], acc[4 * j + 1]);
                            acc[4 * j + 2] = pkfmah(v4[q][j].z, a2[q], acc[4 * j + 2]); acc[4 * j + 3] = pkfmah(v4[q][j].w, a2[q], acc[4 * j + 3]); }
                }
            }
            for (int s = NSLOT; s < n_c; ++s) {
                const unsigned w = PACK[t * LP + s_c + s]; const unsigned a2 = (w & 0xffffu) | (w << 16);
                const int a0 = bo + (int)((w >> 16) & 0xfff0u);
#pragma unroll
                for (int j = 0; j < 4; ++j) { const v4u v4 = *(const LAS v4u*)(F.lds + (a0 ^ (j << 4)));
                    acc[4 * j + 0] = pkfmah(v4.x, a2, acc[4 * j + 0]); acc[4 * j + 1] = pkfmah(v4.y, a2, acc[4 * j + 1]);
                    acc[4 * j + 2] = pkfmah(v4.z, a2, acc[4 * j + 2]); acc[4 * j + 3] = pkfmah(v4.w, a2, acc[4 * j + 3]); }
            }
            VM_WAIT(); __syncthreads();
#pragma unroll
            for (int s = 0; s < NSLOT; ++s) Lc[s] = Ln[s];
        }
        const v4u* xp = (const v4u*)(XS + ((size_t)ds * T + t) * 32); v4u* rp = (v4u*)(RS + ((size_t)ds * T + t) * 32);
        v4u xw4[4];
#pragma unroll
        for (int j = 0; j < 4; ++j) xw4[j] = xp[j];
#pragma unroll
        for (int j = 0; j < 4; ++j) { const v4u xw = xw4[j]; const unsigned xx[4] = {xw.x, xw.y, xw.z, xw.w}; unsigned o[4];
#pragma unroll
            for (int k = 0; k < 4; ++k) { const h2_t xv = __builtin_bit_cast(h2_t, xx[k]), yv = __builtin_bit_cast(h2_t, acc[4 * j + k]);
                o[k] = cvt_pk_f16((float)xv.x * ALPHA + (float)yv.x, (float)xv.y * ALPHA + (float)yv.y); }
            rp[j] = (v4u){o[0], o[1], o[2], o[3]}; }
    }
}

constexpr int PH_PER_LAYER = 13, N_PHASES = 2 + DEPTH * PH_PER_LAYER;
__global__ void __launch_bounds__(512, 2) fwd_kernel(Args args) {
    extern __shared__ __attribute__((aligned(16))) unsigned char lds[];
    Frame F;
    F.lds = (LAS unsigned char*)lds;
    F.wave = __builtin_amdgcn_readfirstlane((int)threadIdx.x >> 6); F.tid = 0; F.lane = 0;
    F.G = gridDim.x; { const int bx = blockIdx.x; F.vcu = (F.G % 8 == 0) ? (bx % 8) * (F.G / 8) + bx / 8 : bx; }
    F.ws = args.ws; F.ka = (const __attribute__((address_space(4))) Args*)__builtin_amdgcn_kernarg_segment_ptr();
    unsigned char* ws = args.ws;
    for (int u = F.wave * 64 + lane_id(); u < (LDS_BYTES - LDSCTL_OFF) / 4; u += 512) ((LAS unsigned*)(F.lds + LDSCTL_OFF))[u] = 0u;
    __syncthreads();
    XcdBarrier bar; bar.bar = (unsigned*)(ws + WS_CTL) + CW_BAR; bar.x = 0; bar.st = nullptr;
    const int lo = args.ph_lo, hi = args.ph_hi;
    if (hi - lo > 1) bar = xcd_barrier_post((unsigned*)(ws + WS_CTL) + CW_BAR, (volatile LAS unsigned*)(F.lds + MISC_OFF) + 8, F.wave == 0 && lane_id() == 0);
#ifndef PHMASK
#define PHMASK 0xFFF
#endif
#define EN(i) ((PHMASK >> (i)) & 1)
#ifndef RPT
#define RPT 0
#endif
#define REP(i) for (int _r = 0; _r <= ((RPT >> (i)) & 1); ++_r)
#define IN(k) (lo <= (k) && (k) < hi)
#define SEAM(k) do { if (IN((k) + 1)) xcd_barrier(bar, F.wave); } while (0)

    if (EN(10) && IN(0)) { REP(13) { phase_prologue_a(F); } SEAM(0); }
    if (EN(11) && IN(1)) REP(14) {
        phase_prologue_b(F);
        unsigned char* ws = opqg(args.ws);
        int kc = 256; asm volatile("" : "+s"(kc));
        pg8::Gemm g{(const bf16*)(ws + WS_BK), (const bf16*)(ws + WS_WQB), DEPTH * 2048, 2048, kc, 256, 2048, 256, (long)2048 * 2048};
        pg8::StaticOrder S; S.init(DEPTH * 2048, 2048, F.G, (int)blockIdx.x);
        pg8::EpiF16 E{(bf16*)(ws + WS_WPQ), 2048};
        pg8::gemm_phase<pg8::EpiF16, pg8::StaticOrder, true>(F.lds, g, S, E, F.wave);
        if (_r == ((RPT >> 14) & 1)) SEAM(1);
    }
    for (int l = 0; l < DEPTH; ++l) {
        const int pb = 2 + l * PH_PER_LAYER;
        if (EN(0) && IN(pb + 0)) REP(0) {
            unsigned char* ws = opqg(args.ws);
            pg8::Gemm g{(const bf16*)(ws + WS_XH), (const bf16*)(ws + WS_WIN) + (size_t)l * NIN * D, T, NIN, D, T, D, 0, 0};
            pg8::StaticOrder S; S.init(T, (F.G == 256) ? 32 * 256 : NIN, F.G, (int)blockIdx.x);
            pg8::EpiIn E{(bf16*)(ws + WS_Q), (bf16*)(ws + WS_KK), (bf16*)(ws + WS_V), (bf16*)(ws + WS_SG), (bf16*)(ws + WS_UB), (bf16*)(ws + WS_GR), (bf16*)(ws + WS_GB),
                         (float*)(ws + WS_LOGF), (const float*)(ws + WS_LB) + l * AW};
            pg8::gemm_phase<pg8::EpiIn, pg8::StaticOrder, true, true, true>(F.lds, g, S, E, F.wave);
            if (_r == ((RPT >> 0) & 1)) SEAM(pb + 0);
        }
        if (EN(1) && IN(pb + 1)) { REP(1) { REP(17) { phase_hgrn_local(F, l); } REP(18) { phase_s5_local(F, l); } } SEAM(pb + 1); }
        if (EN(2) && IN(pb + 2)) { REP(2) { phase_scan(F, l); } SEAM(pb + 2); }
        if (EN(3) && IN(pb + 3)) { REP(3) { REP(15) { phase_hgrn_out(F, l); } REP(16) { phase_s5_out(F, l); } } SEAM(pb + 3); }
        if (EN(4) && IN(pb + 4)) REP(4) {
            unsigned char* ws = opqg(args.ws);
            if (F.G == 256 && blockIdx.x < 128) {
                pg8::Gemm g{(const bf16*)(ws + WS_XH), (const bf16*)(ws + WS_WIN) + (size_t)l * NIN * D, T, NIN, D, T, D, 0, 0};
                pg8::OffOrder S; S.init(T, 4 * 256, F.G, (int)blockIdx.x, 32);
                pg8::EpiIn E{(bf16*)(ws + WS_Q), (bf16*)(ws + WS_KK), (bf16*)(ws + WS_V), (bf16*)(ws + WS_SG), (bf16*)(ws + WS_UB), (bf16*)(ws + WS_GR), (bf16*)(ws + WS_GB),
                             (float*)(ws + WS_LOGF), (const float*)(ws + WS_LB) + l * AW};
                pg8::gemm_phase<pg8::EpiIn, pg8::OffOrder, true, true, true>(F.lds, g, S, E, F.wave);
            } else {
                pg8::Gemm g{(const bf16*)(ws + WS_YB), (const bf16*)(ws + WS_WGLU) + (size_t)l * 2048 * 1024, T, 2048, 1024, 1024, 1024, 0, 0};
                pg8::EpiGlu E{(bf16*)(ws + WS_OAB) + 1024, 2048};
                if (F.G == 256) { pg8::PairOrder S{(int)blockIdx.x, 128, 8, 256}; pg8::gemm_phase<pg8::EpiGlu, pg8::PairOrder, true>(F.lds, g, S, E, F.wave); }
                else { pg8::StaticOrder S; S.init(T, 2048, F.G, (int)blockIdx.x); pg8::gemm_phase<pg8::EpiGlu, pg8::StaticOrder, true>(F.lds, g, S, E, F.wave); }
            }
            if (_r == ((RPT >> 4) & 1)) SEAM(pb + 4);
        }
        if (EN(5) && IN(pb + 5)) REP(5) {
            unsigned char* ws = opqg(args.ws);
            pg8::Gemm g{(const bf16*)(ws + WS_OAB), (const bf16*)(ws + WS_WUP) + (size_t)l * 2048 * 2048, T, 2048, 2048, 2048, 2048, 0, 0};
            pg8::StaticOrder S; S.init(T, 2048, F.G, (int)blockIdx.x);
            pg8::EpiUp E{(bf16*)(ws + WS_MG), (const bf16*)(ws + WS_GR), (const bf16*)(ws + WS_GB)};
            pg8::gemm_phase<pg8::EpiUp, pg8::StaticOrder, true>(F.lds, g, S, E, F.wave);
            if (_r == ((RPT >> 5) & 1)) SEAM(pb + 5);
        }
        if (EN(6) && IN(pb + 6)) REP(6) {
            unsigned char* ws = opqg(args.ws);
            pg8::Gemm g{(const bf16*)(ws + WS_MG), (const bf16*)(ws + WS_WO) + (size_t)l * 2048 * 2048, T, 2048, 2048, 2048, 2048, 0, 0};
            pg8::StaticOrder S; S.init(T, 2048, F.G, (int)blockIdx.x);
            pg8::EpiResH E{(bf16*)(ws + WS_RH), (const bf16*)(ws + WS_XH)};
            pg8::gemm_phase<pg8::EpiResH, pg8::StaticOrder, true>(F.lds, g, S, E, F.wave);
            if (_r == ((RPT >> 6) & 1)) SEAM(pb + 6);
        }
        if (EN(7) && IN(pb + 7)) { REP(7) { phase_ln(F, l, 0); } SEAM(pb + 7); }
        if (EN(8) && IN(pb + 8)) REP(8) {
            unsigned char* ws = opqg(args.ws);
            pg8::Gemm g{(const bf16*)(ws + WS_XH), (const bf16*)(ws + WS_WPQ) + (size_t)l * 2048 * 2048, T, 2048, 2048, T, 2048, 0, 0};
            pg8::StaticOrder S; S.init(T, 2048, F.G, (int)blockIdx.x);
            pg8::EpiBf16 E{(bf16*)(ws + WS_SC), 2048};
            pg8::gemm_phase<pg8::EpiBf16, pg8::StaticOrder, true, true, true>(F.lds, g, S, E, F.wave);
            if (_r == ((RPT >> 8) & 1)) SEAM(pb + 8);
        }
        if (EN(9) && IN(pb + 9)) { REP(9) { phase_topk(F, l); } SEAM(pb + 9); }
        if (EN(9) && IN(pb + 10)) { REP(10) { phase_peer_u(F, l); } SEAM(pb + 10); }
        if (EN(9) && IN(pb + 11)) { REP(11) { phase_peer_v(F, l); } SEAM(pb + 11); }
        if (EN(9) && IN(pb + 12)) { REP(12) { phase_ln(F, l, 1); } SEAM(pb + 12); }
    }
#undef IN
#undef SEAM
}

extern "C" void kernel_launch(void* const* d_in, const int* in_sizes, int n_in, void* d_out, int out_size, void* d_ws, size_t ws_size, hipStream_t stream) {
    static int grid = 0;
    if (grid == 0) {
        if (n_in != 24 || out_size != T * D || ws_size < WS_END) { fprintf(stderr, "kernel_launch: unexpected sizes (n_in %d out %d ws %zu need %zu)\n", n_in, out_size, ws_size, (size_t)WS_END); grid = -1; return; }
        int dev = 0, cus = 0, per_cu = 0;
        if (hipGetDevice(&dev) != hipSuccess || hipDeviceGetAttribute(&cus, hipDeviceAttributeMultiprocessorCount, dev) != hipSuccess) { grid = -1; return; }
        if (hipFuncSetAttribute((const void*)fwd_kernel, hipFuncAttributeMaxDynamicSharedMemorySize, LDS_BYTES) != hipSuccess) { fprintf(stderr, "kernel_launch: hipFuncSetAttribute failed\n"); grid = -1; return; }
        if (hipOccupancyMaxActiveBlocksPerMultiprocessor(&per_cu, (const void*)fwd_kernel, 512, LDS_BYTES) != hipSuccess || per_cu < 1)
            fprintf(stderr, "kernel_launch: occupancy query reports %d\n", per_cu);
        (void)hipGetLastError();
        grid = cus;
    }
    if (grid < 0) return;
    if (hipMemsetAsync((char*)d_ws + WS_CTL, 0, CTL_ZERO_BYTES, stream) != hipSuccess) return;
    Args a{};
    for (int i = 0; i < 24; ++i) a.in[i] = (const float*)d_in[i];
    a.out = (float*)d_out; a.ws = (unsigned char*)d_ws;
#if ONE_LAUNCH
    a.ph_lo = 0; a.ph_hi = N_PHASES;
    hipLaunchKernelGGL(fwd_kernel, dim3(grid), dim3(512), LDS_BYTES, stream, a);
#else
    for (int p = 0; p < N_PHASES; ++p) { a.ph_lo = p; a.ph_hi = p + 1; hipLaunchKernelGGL(fwd_kernel, dim3(grid), dim3(512), LDS_BYTES, stream, a); }
#endif
}
```

```cpp
#include <hip/hip_runtime.h>
#include <cstdio>
#include <cstdint>

#define LAS __attribute__((address_space(3)))
#define GAS __attribute__((address_space(1)))
typedef unsigned short bf16;
typedef unsigned v4u __attribute__((ext_vector_type(4)));
typedef unsigned v2u __attribute__((ext_vector_type(2)));
typedef float f32x4 __attribute__((ext_vector_type(4)));
typedef float f32x2 __attribute__((ext_vector_type(2)));
typedef short bf16x8 __attribute__((ext_vector_type(8)));
typedef short s16x4 __attribute__((ext_vector_type(4)));

#ifndef ONE_LAUNCH
#define ONE_LAUNCH 1
#endif

constexpr int T = 8192, D = 2048, DEPTH = 4, NIN = 9216;
constexpr int AW = 1024;
constexpr int NCH = 128;
constexpr float ALPHA = 1.6817928305074290f;
constexpr float LN_EPS = 1e-5f, RMS_EPS = 1e-6f;
constexpr int NEXP = 16384;
constexpr int LP = 160;
constexpr int NSLOT = 24;

constexpr size_t MiB = 1u << 20;
constexpr size_t WS_CTL = 0, CTL_ZERO_BYTES = 32768;
constexpr size_t WS_WIN  = 1 * MiB;
constexpr size_t WS_WGLU = WS_WIN + 144 * MiB;
constexpr size_t WS_WUP  = WS_WGLU + 16 * MiB;
constexpr size_t WS_WO   = WS_WUP + 32 * MiB;
constexpr size_t WS_WQB  = WS_WO + 32 * MiB;
constexpr size_t WS_BK   = WS_WQB + 32 * MiB;
constexpr size_t WS_WPQ  = WS_BK + 4 * MiB;
constexpr size_t WS_LB   = WS_WPQ + 32 * MiB;
constexpr size_t WS_APOW = WS_LB + 1 * MiB;
constexpr size_t WS_BB   = WS_APOW + 9 * MiB;
constexpr size_t WS_KMAT = WS_BB + 2 * MiB;
constexpr size_t WS_PM   = WS_KMAT + 9 * MiB;
constexpr size_t WS_E    = WS_PM + 64 * MiB;
constexpr size_t WS_X32  = WS_E + 64 * MiB;
constexpr size_t WS_X1   = WS_X32 + 64 * MiB;
constexpr size_t WS_XB   = WS_X1 + 64 * MiB;
constexpr size_t WS_Q    = WS_XB + 32 * MiB;
constexpr size_t WS_KK   = WS_Q + 16 * MiB;
constexpr size_t WS_V    = WS_KK + 16 * MiB;
constexpr size_t WS_SG   = WS_V + 16 * MiB;
constexpr size_t WS_UB   = WS_SG + 16 * MiB;
constexpr size_t WS_LOGF = WS_UB + 16 * MiB;
constexpr size_t WS_GR   = WS_LOGF + 32 * MiB;
constexpr size_t WS_GB   = WS_GR + 32 * MiB;
constexpr size_t WS_U    = WS_GB + 32 * MiB;
constexpr size_t WS_SP   = WS_U + 64 * MiB;
constexpr size_t WS_BL   = WS_SP + 32 * MiB;
constexpr size_t WS_XLOC = WS_BL + 1 * MiB;
constexpr size_t WS_XS   = WS_XLOC + 4 * MiB;
constexpr size_t WS_OAB  = WS_XS + 4 * MiB;
constexpr size_t WS_YB   = WS_OAB + 32 * MiB;
constexpr size_t WS_MG   = WS_YB + 16 * MiB;
constexpr size_t WS_R    = WS_MG + 32 * MiB;
constexpr size_t WS_SC   = WS_R + 64 * MiB;
constexpr size_t WS_TBU  = WS_SC + 64 * MiB;
constexpr size_t WS_TBV  = WS_TBU + 256 * MiB;
constexpr size_t WS_SEID = WS_TBV + 256 * MiB;
constexpr size_t WS_SGATE= WS_SEID + 6 * MiB;
constexpr size_t WS_PACK = WS_SGATE + 4 * MiB;
constexpr size_t WS_START= WS_PACK + 6 * MiB;
constexpr size_t WS_PACK2= WS_START + 1 * MiB;
constexpr size_t WS_XBS  = WS_PACK2 + 13 * MiB;
constexpr size_t WS_END  = WS_XBS + 32 * MiB;
constexpr size_t WS_XH = WS_XBS;
constexpr size_t WS_XQ = WS_X1;
constexpr size_t WS_SX = WS_X1 + 16 * MiB;
constexpr size_t WS_SU = WS_X1 + 17 * MiB;
constexpr size_t WS_RH = WS_R;

constexpr int CW_TMO = 0, CW_CODE = 1;
constexpr int CW_BAR = 4096;

constexpr int RING_BYTES = 131072;
constexpr int LDSCTL_OFF = RING_BYTES, MISC_OFF = LDSCTL_OFF + 320;
constexpr int LDS_BYTES = 147456;

#define LDS_WAIT() asm volatile("s_waitcnt lgkmcnt(0)" ::: "memory")
#define VM_WAIT() asm volatile("s_waitcnt vmcnt(0)" ::: "memory")
__device__ __forceinline__ unsigned cvt_pk_bf16(float lo, float hi) { unsigned r; asm volatile("v_cvt_pk_bf16_f32 %0, %1, %2" : "=v"(r) : "v"(lo), "v"(hi)); return r; }
typedef _Float16 h2_t __attribute__((ext_vector_type(2)));
__device__ __forceinline__ unsigned cvt_pk_f16a(float lo, float hi) { unsigned r; asm volatile("v_cvt_pk_f16_f32 %0, %1, %2" : "=v"(r) : "v"(lo), "v"(hi)); return r; }
__device__ __forceinline__ unsigned cvt_pk_f16(float lo, float hi) { h2_t p; p.x = (_Float16)lo; p.y = (_Float16)hi; return __builtin_bit_cast(unsigned, p); }
__device__ __forceinline__ float dot2h(unsigned a, unsigned b, float c) { return __builtin_amdgcn_fdot2(__builtin_bit_cast(h2_t, a), __builtin_bit_cast(h2_t, b), c, false); }
__device__ __forceinline__ unsigned pkfmah(unsigned a, unsigned b, unsigned c) { return __builtin_bit_cast(unsigned, __builtin_elementwise_fma(__builtin_bit_cast(h2_t, a), __builtin_bit_cast(h2_t, b), __builtin_bit_cast(h2_t, c))); }
__device__ __forceinline__ float bf_lo(unsigned u) { return __uint_as_float(u << 16); }
__device__ __forceinline__ float bf_hi(unsigned u) { return __uint_as_float(u & 0xffff0000u); }
__device__ __forceinline__ float bf2f(bf16 b) { return __uint_as_float(((unsigned)b) << 16); }
__device__ __forceinline__ bf16 f2bf(float f) { return (bf16)(cvt_pk_bf16(f, 0.f) & 0xffffu); }
__device__ __forceinline__ float fexp(float x) { return __builtin_amdgcn_exp2f(x * 1.4426950408889634f); }
__device__ __forceinline__ float flog(float x) { return __builtin_amdgcn_logf(x) * 0.6931471805599453f; }
__device__ __forceinline__ float frcp(float x) { return __builtin_amdgcn_rcpf(x); }
__device__ __forceinline__ float gelu_tanh(float x) {
    const float u = 1.5957691216057308f * (x + 0.044715f * x * x * x);
    const float uc = fminf(fmaxf(u, -60.f), 60.f);
    return x * frcp(1.f + fexp(-uc));
}
__device__ __forceinline__ int lane_id() { int r; asm volatile("v_mbcnt_lo_u32_b32 %0, -1, 0\n\tv_mbcnt_hi_u32_b32 %0, -1, %0" : "=v"(r)); return r; }
__device__ __forceinline__ float wave_sum(float v) {
#pragma unroll
    for (int o = 1; o < 64; o <<= 1) v += __shfl_xor(v, o);
    return v;
}

__device__ __forceinline__ void vlaunder(int& a, int& b) { asm volatile("" : "+v"(a), "+v"(b)); }
template <class P> __device__ __forceinline__ P* opq(P* p) { asm volatile("" : "+s"(p)); return p; }
__device__ __forceinline__ unsigned char* opqg(unsigned char* p) { GAS unsigned char* g = (GAS unsigned char*)p; asm volatile("" : "+s"(g)); return (unsigned char*)g; }
#define GP(T, p) ((T*)(GAS T*)(p))

namespace pg8 {
#define PG8_LAS __attribute__((address_space(3)))
typedef unsigned short bf16_t;
constexpr int BM = 256, BK = 64, HALF = 128, HTB = HALF * BK * 2, STAGE_BYTES = 8 * HTB, NXCD = 8, WGM = 8;

__host__ __device__ __forceinline__ int lds_byte(int r, int c) { const int st = (r >> 4) * 2 + (c >> 5), rr = r & 15, cc = c & 31, ob = rr * 64 + cc * 2; return st * 1024 + (ob ^ (((ob >> 9) & 1) << 5)); }
__host__ __device__ __forceinline__ void stage_rc(int b, int& R, int& C) { const int st = b / 1024, sb = b % 1024, swz = sb ^ (((sb >> 9) & 1) << 5); R = (st >> 1) * 16 + swz / 64; C = (st & 1) * 32 + (swz % 64) / 2; }
__host__ __device__ __forceinline__ int perm32(int rho) { const int n = rho >> 4, i = rho & 15; return 8 * (i >> 2) + 4 * n + (i & 3); }

struct Unit { int pm, pn; };
struct Gemm { const bf16_t* A; const bf16_t* Bt; int M, N, K, lda, ldb, bkoff; long blstride; };

struct StaticOrder {
    int nM, nN, nwg, G, c;
    __host__ __device__ void init(int M, int N, int G_, int c_) { nM = M / BM; nN = N / BM; nwg = nM * nN; G = G_; c = c_; }
    __host__ __device__ bool next(int i, Unit& u) const {
        const long L = (long)i * G + c; if (L >= nwg) return false;
        int wgid = (int)L; { const int q = nwg / NXCD, r = nwg % NXCD, xcd = wgid % NXCD, off = wgid / NXCD; wgid = (xcd < r ? xcd * (q + 1) : r * (q + 1) + (xcd - r) * q) + off; }
        const int nig = WGM * nN, gid = wgid / nig, fm = gid * WGM, gsz = (nM - fm) < WGM ? (nM - fm) : WGM;
        u.pm = fm + ((wgid % nig) % gsz); u.pn = (wgid % nig) / gsz; return true;
    }
    __device__ __forceinline__ void a_ready(const Unit&) const {}
    __device__ __forceinline__ void done(const Unit&) const {}
};

struct OffOrder {
    StaticOrder b; int pn0;
    __device__ void init(int M, int N, int G_, int c_, int pn0_) { b.init(M, N, G_, c_); pn0 = pn0_; }
    __device__ bool next(int i, Unit& u) const { if (!b.next(i, u)) return false; u.pn += pn0; return true; }
    __device__ __forceinline__ void a_ready(const Unit&) const {}
    __device__ __forceinline__ void done(const Unit&) const {}
};
struct PairOrder {
    int c, c0, nN, nwg;
    __device__ bool next(int i, Unit& u) const { if (c < c0 || i >= 2) return false; const int id = (c - c0) * 2 + i; if (id >= nwg) return false; u.pm = id / nN; u.pn = id % nN; return true; }
    __device__ __forceinline__ void a_ready(const Unit&) const {}
    __device__ __forceinline__ void done(const Unit&) const {}
};
typedef f32x4 Acc[2][2][4][2];

typedef _Float16 f16x8 __attribute__((ext_vector_type(8)));
template <class Epi, class Sched, bool ALIGN_EPI = false, bool F16 = false, bool ASL = false>
__device__ __forceinline__ void gemm_phase(PG8_LAS unsigned char* lds, const Gemm g, const Sched& S, const Epi& E, int wv) {
    int tid_ = wv * 64 + lane_id(); asm volatile("" : "+v"(tid_));
    const int tid = tid_, wid = __builtin_amdgcn_readfirstlane(tid >> 6), lane = tid & 63, wr = wid >> 2, wc = wid & 3, fr = lane & 15, fq = lane >> 4;
    const int K = g.K, nt = K / BK;
    unsigned voffA[2], voffB[2];
#pragma unroll
    for (int i = 0; i < 2; ++i) { int R, C; stage_rc(tid * 16 + i * 8192, R, C); const int Rb = Epi::PERM ? ((R & ~31) + perm32(R & 31)) : R;
        voffA[i] = ASL ? (unsigned)(((C >> 5) * g.lda + R) * 64 + (C & 31) * 2) : (unsigned)(R * g.lda + C) * 2u; voffB[i] = (unsigned)(Rb * g.ldb + C) * 2u; }
    const size_t kstep = (size_t)(BK * 2), kstepA = ASL ? (size_t)g.lda * 128 : (size_t)(BK * 2);
    const size_t hstepA = ASL ? (size_t)HALF * 64 : (size_t)HALF * g.lda * 2, hstepB = (size_t)HALF * g.ldb * 2;
    const size_t tstepA = 2 * hstepA, tstepB = 2 * hstepB;
    const unsigned ldsw = (unsigned)wid * 1024u;
    const int aoff = lds_byte(wr * 64 + fr, fq * 8), boff = lds_byte(wc * 32 + fr, fq * 8);
#define PG8_SA(b, h) (((b) * 2 + (h)) * HTB)
#define PG8_SB(b, h) ((4 + (b) * 2 + (h)) * HTB)
#define PG8_STAGE(bufoff, gbase, voff) do { _Pragma("unroll") for (int _i = 0; _i < 2; ++_i) \
        __builtin_amdgcn_global_load_lds((const unsigned*)((const char*)(gbase) + (voff)[_i]), (PG8_LAS unsigned*)(lds + (bufoff) + ldsw + _i * 8192), 16, 0, 0); } while (0)
#define PG8_LDA(dst, b, h) do { _Pragma("unroll") for (int m = 0; m < 4; ++m) _Pragma("unroll") for (int k = 0; k < 2; ++k) dst[m][k] = *(const PG8_LAS bf16x8*)(lds + PG8_SA(b, h) + aoff + m * 2048 + k * 1024); } while (0)
#define PG8_LDB(dst, b, h) do { _Pragma("unroll") for (int n = 0; n < 2; ++n) _Pragma("unroll") for (int k = 0; k < 2; ++k) dst[n][k] = *(const PG8_LAS bf16x8*)(lds + PG8_SB(b, h) + boff + n * 2048 + k * 1024); } while (0)
#define PG8_MMA(ai, bj, At, Bt) do { __builtin_amdgcn_s_setprio(1); _Pragma("unroll") for (int m = 0; m < 4; ++m) _Pragma("unroll") for (int n = 0; n < 2; ++n) _Pragma("unroll") for (int k = 0; k < 2; ++k) \
        { if constexpr (F16) acc[ai][bj][m][n] = __builtin_amdgcn_mfma_f32_16x16x32_f16(__builtin_bit_cast(f16x8, Bt[n][k]), __builtin_bit_cast(f16x8, At[m][k]), acc[ai][bj][m][n], 0, 0, 0); \
          else acc[ai][bj][m][n] = __builtin_amdgcn_mfma_f32_16x16x32_bf16(Bt[n][k], At[m][k], acc[ai][bj][m][n], 0, 0, 0); } __builtin_amdgcn_s_setprio(0); } while (0)
#define PG8_WAIT_V(n) asm volatile("s_waitcnt vmcnt(" #n ")" ::: "memory")
#define PG8_WAIT_L(n) asm volatile("s_waitcnt lgkmcnt(" #n ")" ::: "memory")
#define PG8_BAR __builtin_amdgcn_s_barrier()
#define PG8_SCHED __builtin_amdgcn_sched_barrier(0)
    Unit cur, nxt; int ui = 0;
    if (!S.next(0, cur)) return;
    Acc acc;
#pragma unroll
    for (int a = 0; a < 2; ++a)
#pragma unroll
        for (int b = 0; b < 2; ++b)
#pragma unroll
            for (int m = 0; m < 4; ++m)
#pragma unroll
                for (int n = 0; n < 2; ++n) acc[a][b][m][n] = (f32x4){0.f, 0.f, 0.f, 0.f};
    bf16x8 At[4][2], B0[2][2], B1[2][2];
    const char* cA = (const char*)g.A + (size_t)cur.pm * tstepA;
    const char* cB = (const char*)g.Bt + (size_t)cur.pn * tstepB + ((size_t)(cur.pm & 7) * g.bkoff + (size_t)(cur.pm >> 3) * g.blstride) * 2;
    S.a_ready(cur);
    PG8_STAGE(PG8_SB(0, 0), cB, voffB); PG8_STAGE(PG8_SB(0, 1), cB + hstepB, voffB); PG8_STAGE(PG8_SA(0, 0), cA, voffA); PG8_STAGE(PG8_SA(0, 1), cA + hstepA, voffA);
    if (wr == 1) PG8_BAR;
    PG8_WAIT_V(2); PG8_BAR;
    PG8_STAGE(PG8_SB(1, 0), cB + kstep, voffB); PG8_STAGE(PG8_SA(1, 0), cA + kstepA, voffA); PG8_STAGE(PG8_SB(1, 1), cB + hstepB + kstep, voffB);
    PG8_WAIT_V(6); PG8_BAR;
    for (;;) {
        const bool has_next = S.next(ui + 1, nxt);
        const char* nA = has_next ? (const char*)g.A + (size_t)nxt.pm * tstepA : cA;
        const char* nB = has_next ? (const char*)g.Bt + (size_t)nxt.pn * tstepB + ((size_t)(nxt.pm & 7) * g.bkoff + (size_t)(nxt.pm >> 3) * g.blstride) * 2 : cB;
        for (int t = 0; t < nt; t += 2) {
            const bool last = (t == nt - 2);
            const char* a1 = cA + (size_t)(t + 1) * kstepA;
            const char* a2 = last ? nA : cA + (size_t)(t + 2) * kstepA; const char* b2 = last ? nB : cB + (size_t)(t + 2) * kstep;
            const char* a3 = a2 + kstepA; const char* b3 = b2 + kstep;
            if (last && has_next) S.a_ready(nxt);
            PG8_LDB(B0, 0, 0); PG8_LDB(B1, 0, 1); PG8_SCHED; PG8_LDA(At, 0, 0); PG8_STAGE(PG8_SA(1, 1), a1 + hstepA, voffA);
            PG8_WAIT_V(8); PG8_WAIT_L(0); PG8_BAR; PG8_MMA(0, 0, At, B0); PG8_MMA(0, 1, At, B1); PG8_BAR; PG8_SCHED;
            PG8_LDA(At, 0, 1); PG8_STAGE(PG8_SB(0, 0), b2, voffB); PG8_STAGE(PG8_SB(0, 1), b2 + hstepB, voffB); PG8_STAGE(PG8_SA(0, 0), a2, voffA);
            PG8_WAIT_V(8); PG8_WAIT_L(0); PG8_BAR; PG8_MMA(1, 0, At, B0); PG8_MMA(1, 1, At, B1); PG8_BAR; PG8_SCHED;
            PG8_LDB(B0, 1, 0); PG8_LDB(B1, 1, 1); PG8_SCHED; PG8_LDA(At, 1, 0); PG8_STAGE(PG8_SA(0, 1), a2 + hstepA, voffA);
            PG8_WAIT_V(8); PG8_WAIT_L(0); PG8_BAR; PG8_MMA(0, 0, At, B0); PG8_MMA(0, 1, At, B1); PG8_BAR; PG8_SCHED;
            PG8_LDA(At, 1, 1); PG8_STAGE(PG8_SB(1, 0), b3, voffB); PG8_STAGE(PG8_SB(1, 1), b3 + hstepB, voffB); PG8_STAGE(PG8_SA(1, 0), a3, voffA);
            PG8_WAIT_V(8); PG8_WAIT_L(0); PG8_BAR; PG8_MMA(1, 0, At, B0); PG8_MMA(1, 1, At, B1); PG8_BAR; PG8_SCHED;
            if constexpr (Epi::HAS_MID) { if (t + 2 == (nt >> 1)) E.mid(acc, cur, wr, wc, fr, fq); }
        }
        if constexpr (ALIGN_EPI) { if (wr == 0) PG8_BAR; }
        E(acc, cur, wr, wc, fr, fq); S.done(cur);
        if (!has_next) break;
#pragma unroll
        for (int a = 0; a < 2; ++a)
#pragma unroll
            for (int b = 0; b < 2; ++b)
#pragma unroll
                for (int m = 0; m < 4; ++m)
#pragma unroll
                    for (int n = 0; n < 2; ++n) acc[a][b][m][n] = (f32x4){0.f, 0.f, 0.f, 0.f};
        cur = nxt; cA = nA; cB = nB; ++ui;
        if constexpr (ALIGN_EPI) { if (wr == 1) PG8_BAR; }
    }
    PG8_WAIT_V(0);
    if constexpr (!ALIGN_EPI) { if (wr == 0) PG8_BAR; }
    PG8_BAR;
#undef PG8_SA
#undef PG8_SB
#undef PG8_STAGE
#undef PG8_LDA
#undef PG8_LDB
#undef PG8_MMA
#undef PG8_WAIT_V
#undef PG8_WAIT_L
#undef PG8_BAR
#undef PG8_SCHED
}

struct EpiResH {
    static constexpr bool PERM = true, HAS_MID = false;
    bf16_t* RS; const bf16_t* XS;
    __device__ __forceinline__ void operator()(const Acc& acc, const Unit& u, int wr, int wc, int fr, int fq) const {
        vlaunder(fr, fq);
        const int row0 = u.pm * BM + wr * 64 + fr, sl0 = u.pn * 8 + wc;
#pragma unroll
        for (int ai = 0; ai < 2; ++ai) {
            v4u xw[4][2];
#pragma unroll
            for (int m = 0; m < 4; ++m)
#pragma unroll
                for (int bj = 0; bj < 2; ++bj) xw[m][bj] = *(const v4u*)(XS + ((size_t)(sl0 + bj * 4) * T + (row0 + ai * HALF + m * 16)) * 32 + 8 * fq);
#pragma unroll
            for (int m = 0; m < 4; ++m) {
#pragma unroll
                for (int bj = 0; bj < 2; ++bj) { const size_t eo = ((size_t)(sl0 + bj * 4) * T + (row0 + ai * HALF + m * 16)) * 32 + 8 * fq;
                    const f32x4 v0 = acc[ai][bj][m][0], v1 = acc[ai][bj][m][1];
                    const unsigned a0 = xw[m][bj].x, a1 = xw[m][bj].y, a2 = xw[m][bj].z, a3 = xw[m][bj].w;
                    const h2_t x0 = __builtin_bit_cast(h2_t, a0), x1 = __builtin_bit_cast(h2_t, a1), x2 = __builtin_bit_cast(h2_t, a2), x3 = __builtin_bit_cast(h2_t, a3);
                    v4u w; w.x = cvt_pk_f16a(v0[0] + ALPHA * (float)x0.x, v0[1] + ALPHA * (float)x0.y); w.y = cvt_pk_f16a(v0[2] + ALPHA * (float)x1.x, v0[3] + ALPHA * (float)x1.y);
                    w.z = cvt_pk_f16a(v1[0] + ALPHA * (float)x2.x, v1[1] + ALPHA * (float)x2.y); w.w = cvt_pk_f16a(v1[2] + ALPHA * (float)x3.x, v1[3] + ALPHA * (float)x3.y);
                    *(v4u*)(RS + eo) = w; } }
        }
    }
};
struct EpiF16 {
    static constexpr bool PERM = true, HAS_MID = false;
    bf16_t* O; int ldc;
    __device__ __forceinline__ void operator()(const Acc& acc, const Unit& u, int wr, int wc, int fr, int fq) const {
        vlaunder(fr, fq);
        const int row0 = u.pm * BM + wr * 64 + fr, col0 = u.pn * BM + wc * 32 + 8 * fq;
#pragma unroll
        for (int ai = 0; ai < 2; ++ai)
#pragma unroll
            for (int m = 0; m < 4; ++m) { bf16_t* rowp = O + (size_t)(row0 + ai * HALF + m * 16) * ldc + col0;
#pragma unroll
                for (int bj = 0; bj < 2; ++bj) { const f32x4 v0 = acc[ai][bj][m][0], v1 = acc[ai][bj][m][1];
                    v4u w; w.x = cvt_pk_f16a(v0[0], v0[1]); w.y = cvt_pk_f16a(v0[2], v0[3]); w.z = cvt_pk_f16a(v1[0], v1[1]); w.w = cvt_pk_f16a(v1[2], v1[3]);
                    *(v4u*)(rowp + bj * HALF) = w; } }
    }
};
struct EpiBf16 {
    static constexpr bool PERM = true, HAS_MID = false;
    bf16_t* O; int ldc;
    __device__ __forceinline__ void operator()(const Acc& acc, const Unit& u, int wr, int wc, int fr, int fq) const {
        vlaunder(fr, fq);
        const int row0 = u.pm * BM + wr * 64 + fr, col0 = u.pn * BM + wc * 32 + 8 * fq;
#pragma unroll
        for (int ai = 0; ai < 2; ++ai)
#pragma unroll
            for (int m = 0; m < 4; ++m) { bf16_t* rowp = O + (size_t)(row0 + ai * HALF + m * 16) * ldc + col0;
#pragma unroll
                for (int bj = 0; bj < 2; ++bj) { const f32x4 v0 = acc[ai][bj][m][0], v1 = acc[ai][bj][m][1];
                    v4u w; w.x = cvt_pk_bf16(v0[0], v0[1]); w.y = cvt_pk_bf16(v0[2], v0[3]); w.z = cvt_pk_bf16(v1[0], v1[1]); w.w = cvt_pk_bf16(v1[2], v1[3]);
                    *(v4u*)(rowp + bj * HALF) = w; } }
    }
};
struct EpiIn {
    static constexpr bool PERM = true, HAS_MID = false;
    bf16_t *Q, *KK, *V, *SG, *UB, *GR, *GB; float* LOGF; const float* lb;
    __device__ __forceinline__ void operator()(const Acc& acc, const Unit& u, int wr, int wc, int fr, int fq) const {
        vlaunder(fr, fq);
        const int row0 = u.pm * BM + wr * 64 + fr;
        const int pn = u.pn;
        if (pn >= 20) {
            const int col0 = (pn - 20) * 128 + wc * 32 + 8 * fq;
#pragma unroll
            for (int ai = 0; ai < 2; ++ai)
#pragma unroll
                for (int m = 0; m < 4; ++m) { const size_t ro = (size_t)(row0 + ai * HALF + m * 16) * 2048 + col0;
                    float rr[8], gg[8];
#pragma unroll
                    for (int n = 0; n < 2; ++n)
#pragma unroll
                        for (int x = 0; x < 4; ++x) { const float za = fminf(fmaxf(acc[ai][0][m][n][x], -30.f), 30.f), zb = fminf(fmaxf(acc[ai][1][m][n][x], -30.f), 30.f);
                            const float ea = fexp(-za), eb = fexp(-zb); gg[n * 4 + x] = frcp(1.f + eb); rr[n * 4 + x] = (1.f + eb) * frcp(1.f + ea); }
                    v4u w; w.x = cvt_pk_bf16(rr[0], rr[1]); w.y = cvt_pk_bf16(rr[2], rr[3]); w.z = cvt_pk_bf16(rr[4], rr[5]); w.w = cvt_pk_bf16(rr[6], rr[7]);
                    *(v4u*)(GR + ro) = w;
                    w.x = cvt_pk_bf16(gg[0], gg[1]); w.y = cvt_pk_bf16(gg[2], gg[3]); w.z = cvt_pk_bf16(gg[4], gg[5]); w.w = cvt_pk_bf16(gg[6], gg[7]);
                    *(v4u*)(GB + ro) = w; }
            return;
        }
        const int sec = pn >> 2, col0 = (pn & 3) * 256 + wc * 32 + 8 * fq;
        if (sec == 1) {
#pragma unroll
            for (int bj = 0; bj < 2; ++bj) {
                const f32x4 l0 = *(const f32x4*)(lb + col0 + bj * HALF), l1 = *(const f32x4*)(lb + col0 + bj * HALF + 4);
#pragma unroll
                for (int ai = 0; ai < 2; ++ai)
#pragma unroll
                    for (int m = 0; m < 4; ++m) { const size_t ro = (size_t)(row0 + ai * HALF + m * 16) * 1024 + col0 + bj * HALF;
                        float lf[8], kk[8];
#pragma unroll
                        for (int n = 0; n < 2; ++n)
#pragma unroll
                            for (int x = 0; x < 4; ++x) { const float z = fminf(fmaxf(acc[ai][bj][m][n][x], -30.f), 30.f); const float lbv = n ? l1[x] : l0[x];
                                const float e = fexp(-z), s = frcp(1.f + e); const float f = lbv + (1.f - lbv) * s;
                                lf[n * 4 + x] = flog(f); kk[n * 4 + x] = (1.f - lbv) * (e * s); }
                        *(f32x4*)(LOGF + ro) = (f32x4){lf[0], lf[1], lf[2], lf[3]}; *(f32x4*)(LOGF + ro + 4) = (f32x4){lf[4], lf[5], lf[6], lf[7]};
                        v4u w; w.x = cvt_pk_bf16(kk[0], kk[1]); w.y = cvt_pk_bf16(kk[2], kk[3]); w.z = cvt_pk_bf16(kk[4], kk[5]); w.w = cvt_pk_bf16(kk[6], kk[7]);
                        *(v4u*)(KK + ro) = w; }
            }
            return;
        }
        bf16_t* dst = sec == 0 ? Q : (sec == 2 ? V : (sec == 3 ? SG : UB));
        const bool sig = (sec == 3);
#pragma unroll
        for (int ai = 0; ai < 2; ++ai)
#pragma unroll
            for (int m = 0; m < 4; ++m) { bf16_t* rowp = dst + (size_t)(row0 + ai * HALF + m * 16) * 1024 + col0;
#pragma unroll
                for (int bj = 0; bj < 2; ++bj) { f32x4 v0 = acc[ai][bj][m][0], v1 = acc[ai][bj][m][1];
                    if (sig) {
#pragma unroll
                        for (int x = 0; x < 4; ++x) { v0[x] = frcp(1.f + fexp(-fminf(fmaxf(v0[x], -30.f), 30.f))); v1[x] = frcp(1.f + fexp(-fminf(fmaxf(v1[x], -30.f), 30.f))); } }
                    v4u w; w.x = cvt_pk_bf16(v0[0], v0[1]); w.y = cvt_pk_bf16(v0[2], v0[3]); w.z = cvt_pk_bf16(v1[0], v1[1]); w.w = cvt_pk_bf16(v1[2], v1[3]);
                    *(v4u*)(rowp + bj * HALF) = w; } }
    }
};
struct EpiGlu {
    static constexpr bool PERM = true, HAS_MID = false;
    bf16_t* O; int ldc;
    __device__ __forceinline__ void operator()(const Acc& acc, const Unit& u, int wr, int wc, int fr, int fq) const {
        vlaunder(fr, fq);
        const int row0 = u.pm * BM + wr * 64 + fr, col0 = u.pn * 128 + wc * 32 + 8 * fq;
#pragma unroll
        for (int ai = 0; ai < 2; ++ai)
#pragma unroll
            for (int m = 0; m < 4; ++m) { float o[8];
#pragma unroll
                for (int n = 0; n < 2; ++n)
#pragma unroll
                    for (int x = 0; x < 4; ++x) { const float h2 = fminf(fmaxf(acc[ai][1][m][n][x], -30.f), 30.f); o[n * 4 + x] = acc[ai][0][m][n][x] * frcp(1.f + fexp(-h2)); }
                v4u w; w.x = cvt_pk_bf16(o[0], o[1]); w.y = cvt_pk_bf16(o[2], o[3]); w.z = cvt_pk_bf16(o[4], o[5]); w.w = cvt_pk_bf16(o[6], o[7]);
                *(v4u*)(O + (size_t)(row0 + ai * HALF + m * 16) * ldc + col0) = w; }
    }
};
struct EpiUp {
    static constexpr bool PERM = true, HAS_MID = true;
    bf16_t* O; const bf16_t *GR, *GB;
    __device__ __forceinline__ void scale(Acc& acc, const bf16_t* G, const Unit& u, int wr, int wc, int fr, int fq) const {
        vlaunder(fr, fq);
        const int row0 = u.pm * BM + wr * 64 + fr, col0 = u.pn * BM + wc * 32 + 8 * fq;
#pragma unroll
        for (int ai = 0; ai < 2; ++ai) {
            v4u gw[4][2];
#pragma unroll
            for (int m = 0; m < 4; ++m)
#pragma unroll
                for (int bj = 0; bj < 2; ++bj) gw[m][bj] = *(const v4u*)(G + (size_t)(row0 + ai * HALF + m * 16) * 2048 + col0 + bj * HALF);
            __builtin_amdgcn_sched_barrier(0);
#pragma unroll
            for (int m = 0; m < 4; ++m) {
#pragma unroll
                for (int bj = 0; bj < 2; ++bj) { const v4u w = gw[m][bj];
                    acc[ai][bj][m][0] *= (f32x4){bf_lo(w.x), bf_hi(w.x), bf_lo(w.y), bf_hi(w.y)};
                    acc[ai][bj][m][1] *= (f32x4){bf_lo(w.z), bf_hi(w.z), bf_lo(w.w), bf_hi(w.w)}; } }
            __builtin_amdgcn_sched_barrier(0); }
    }
    __device__ __forceinline__ void mid(Acc& acc, const Unit& u, int wr, int wc, int fr, int fq) const { scale(acc, GR, u, wr, wc, fr, fq); }
    __device__ __forceinline__ void operator()(Acc& acc, const Unit& u, int wr, int wc, int fr, int fq) const {
        scale(acc, GB, u, wr, wc, fr, fq);
        const int row0 = u.pm * BM + wr * 64 + fr, col0 = u.pn * BM + wc * 32 + 8 * fq;
#pragma unroll
        for (int ai = 0; ai < 2; ++ai)
#pragma unroll
            for (int m = 0; m < 4; ++m) { bf16_t* rowp = O + (size_t)(row0 + ai * HALF + m * 16) * 2048 + col0;
#pragma unroll
                for (int bj = 0; bj < 2; ++bj) { const f32x4 v0 = acc[ai][bj][m][0], v1 = acc[ai][bj][m][1];
                    v4u w; w.x = cvt_pk_bf16(v0[0], v0[1]); w.y = cvt_pk_bf16(v0[2], v0[3]); w.z = cvt_pk_bf16(v1[0], v1[1]); w.w = cvt_pk_bf16(v1[2], v1[3]);
                    *(v4u*)(rowp + bj * HALF) = w; } }
    }
};
}

#define XB_TMO      128
#define XB_XCNT(j)  (256  + 64 * (j))
#define XB_XSUB(j)  (1280 + 64 * (j))
#define XB_XGEN(j)  (2304 + 64 * (j))
#define XB_TOP      3328
#define XB_TOPGEN   3392
#define XCD_BAR_WORDS 3456
#define XB_SPIN_CAP (1u << 20)

__device__ __forceinline__ unsigned xb_ld(unsigned* p)              { return __hip_atomic_load(p, __ATOMIC_RELAXED, __HIP_MEMORY_SCOPE_AGENT); }
__device__ __forceinline__ unsigned xb_add(unsigned* p, unsigned v) { return __hip_atomic_fetch_add(p, v, __ATOMIC_RELAXED, __HIP_MEMORY_SCOPE_AGENT); }
__device__ __forceinline__ unsigned xb_xcc_id() { return (unsigned)__builtin_amdgcn_s_getreg((3 << 11) | 20) & 0xFu; }
#define XB_SPIN(cond, bar) do { unsigned _sp = 0; while (cond) { __builtin_amdgcn_s_sleep(1); \
    if ((++_sp & 255u) == 0u) { if (xb_ld(&(bar)[XB_TMO])) break; if (_sp > XB_SPIN_CAP) { atomicAdd(&(bar)[XB_TMO], 1u); break; } } } } while (0)

struct XcdBarrier { unsigned* bar; unsigned x; volatile LAS unsigned* st; };

__device__ __forceinline__ XcdBarrier xcd_barrier_post(unsigned* bar, volatile LAS unsigned* st, bool leader) {
    XcdBarrier b; b.bar = bar; b.x = xb_xcc_id(); b.st = st;
    if (leader) (void)xb_add(&bar[XB_XCNT(b.x)], 1u);
    return b;
}
__device__ __forceinline__ void xcd_barrier_complete(unsigned* bar, unsigned x, unsigned& nloc, unsigned& nx) {
    const unsigned G = gridDim.x * gridDim.y * gridDim.z;
    unsigned sum, cnt, mine, sp = 0u;
    for (;;) {
        sum = 0u; cnt = 0u; mine = 0u;
#pragma unroll
        for (unsigned j = 0; j < 16; ++j) { const unsigned c = xb_ld(&bar[XB_XCNT(j)]); sum += c; cnt += (c > 0u) ? 1u : 0u; mine = (j == x) ? c : mine; }
        if (sum == G) break;
        __builtin_amdgcn_s_sleep(1);
        if ((++sp & 255u) == 0u) { if (xb_ld(&bar[XB_TMO])) break; if (sp > XB_SPIN_CAP) { atomicAdd(&bar[XB_TMO], 1u); break; } }
    }
    nloc = mine > 0u ? mine : 1u; nx = cnt > 0u ? cnt : 1u;
}
__device__ __forceinline__ void xcd_barrier(const XcdBarrier& b, int wv) {
    asm volatile("s_waitcnt vmcnt(0)" ::: "memory");
    __syncthreads();
    if (wv == 0 && lane_id() == 0) {
        unsigned* bar = b.bar;
        __builtin_amdgcn_s_waitcnt(0);
        unsigned nloc = b.st[0], nx = b.st[1];
        if (nloc == 0u) { xcd_barrier_complete(bar, b.x, nloc, nx); b.st[0] = nloc; b.st[1] = nx; }
        const unsigned old = xb_add(&bar[XB_XSUB(b.x)], 1u);
        const unsigned gen = old / nloc;
        if (old + 1u == (gen + 1u) * nloc) {
            __builtin_amdgcn_fence(__ATOMIC_RELEASE, "agent");
            asm volatile("s_waitcnt vmcnt(0)" ::: "memory");
            const unsigned og = xb_add(&bar[XB_TOP], 1u);
            const unsigned tg = og / nx;
            if (og + 1u == (tg + 1u) * nx) xb_add(&bar[XB_TOPGEN], 1u);
            else XB_SPIN(xb_ld(&bar[XB_TOPGEN]) == tg, bar);
            __builtin_amdgcn_fence(__ATOMIC_ACQUIRE, "agent");
            xb_add(&bar[XB_XGEN(b.x)], 1u);
            asm volatile("s_waitcnt vmcnt(0)" ::: "memory");
        } else {
            XB_SPIN(xb_ld(&bar[XB_XGEN(b.x)]) == gen, bar);
            __builtin_amdgcn_fence(__ATOMIC_ACQUIRE, "agent");
            asm volatile("s_waitcnt vmcnt(0)" ::: "memory");
        }
    }
    __syncthreads();
}

struct Args { const float* in[24]; float* out; unsigned char* ws; int ph_lo, ph_hi; };
struct Frame {
    LAS unsigned char* lds;
    int tid, lane, wave, vcu, G;
    unsigned char* ws;
    const __attribute__((address_space(4))) Args* ka;
};
enum { I_X = 0, I_WIN, I_LBL, I_NG, I_LRE, I_LIM, I_LSTEP, I_BRE, I_BIM, I_CRE, I_CIM, I_SD, I_WGLU, I_WUPA, I_WUPB, I_WO, I_LN1G, I_LN1B, I_PWQ, I_PKEYS, I_PU, I_PV, I_LN2G, I_LN2B };

__device__ __forceinline__ void p0_transpose_item(const float* W, int N, bf16* WT, int dpitch, int dst_koff, int dst_row0, LAS float* scr, int k0, int n0, int lane, bool h = false) {
    { const int kr = lane >> 3, c4 = (lane & 7) * 4; f32x4 v[8];
#pragma unroll
      for (int i = 0; i < 8; ++i) v[i] = __builtin_nontemporal_load((const f32x4*)(W + (size_t)(k0 + kr + 8 * i) * N + n0 + c4));
#pragma unroll
      for (int i = 0; i < 8; ++i) { LAS float* d = scr + (kr + 8 * i) * 33 + c4; d[0] = v[i][0]; d[1] = v[i][1]; d[2] = v[i][2]; d[3] = v[i][3]; } }
    LDS_WAIT(); asm volatile("" ::: "memory");
    const int c = lane & 7;
#pragma unroll
    for (int j = 0; j < 4; ++j) { const int n = (lane >> 3) + 8 * j; const LAS float* s = scr + (8 * c) * 33 + n;
        v4u o;
        if (h) { o.x = cvt_pk_f16(s[0 * 33], s[1 * 33]); o.y = cvt_pk_f16(s[2 * 33], s[3 * 33]); o.z = cvt_pk_f16(s[4 * 33], s[5 * 33]); o.w = cvt_pk_f16(s[6 * 33], s[7 * 33]); }
        else { o.x = cvt_pk_bf16(s[0 * 33], s[1 * 33]); o.y = cvt_pk_bf16(s[2 * 33], s[3 * 33]); o.z = cvt_pk_bf16(s[4 * 33], s[5 * 33]); o.w = cvt_pk_bf16(s[6 * 33], s[7 * 33]); }
        *(v4u*)(WT + (size_t)(dst_row0 + n) * dpitch + dst_koff + k0 + 8 * c) = o; }
    LDS_WAIT(); asm volatile("" ::: "memory");
}
__device__ __forceinline__ void sincos_d(double a, double& s, double& c) {
    const double k = __builtin_rint(a * 0.63661977236758134308);
    double r = __builtin_fma(-k, 1.57079632679489655800e+00, a); r = __builtin_fma(-k, 6.12323399573676603587e-17, r);
    const double r2 = r * r;
    double sp = 1.0 / 1307674368000.0; sp = sp * r2 - 1.0 / 6227020800.0; sp = sp * r2 + 1.0 / 39916800.0; sp = sp * r2 - 1.0 / 362880.0; sp = sp * r2 + 1.0 / 5040.0; sp = sp * r2 - 1.0 / 120.0; sp = sp * r2 + 1.0 / 6.0;
    const double sr = r - r * r2 * sp;
    double cp = 1.0 / 20922789888000.0; cp = cp * r2 - 1.0 / 87178291200.0; cp = cp * r2 + 1.0 / 479001600.0; cp = cp * r2 - 1.0 / 3628800.0; cp = cp * r2 + 1.0 / 40320.0; cp = cp * r2 - 1.0 / 720.0; cp = cp * r2 + 1.0 / 24.0;
    const double cr = 1.0 - 0.5 * r2 + r2 * r2 * cp;
    const int q = ((int)k) & 3;
    s = (q == 0) ? sr : (q == 1) ? cr : (q == 2) ? -sr : -cr;
    c = (q == 0) ? cr : (q == 1) ? -sr : (q == 2) ? -cr : sr;
}
__device__ __forceinline__ double exp_d(double x) {
    const double k = __builtin_rint(x * 1.44269504088896340736);
    const double r = __builtin_fma(-k, 6.93147180369123816490e-01, x) - k * 1.90821492927058770002e-10;
    double p = 1.0 / 6227020800.0;
    p = p * r + 1.0 / 479001600.0; p = p * r + 1.0 / 39916800.0; p = p * r + 1.0 / 3628800.0; p = p * r + 1.0 / 362880.0; p = p * r + 1.0 / 40320.0; p = p * r + 1.0 / 5040.0;
    p = p * r + 1.0 / 720.0; p = p * r + 1.0 / 120.0; p = p * r + 1.0 / 24.0; p = p * r + 1.0 / 6.0; p = p * r + 0.5; p = p * r + 1.0; p = p * r + 1.0;
    const long long e = (long long)k + 1023; double sc = __builtin_bit_cast(double, (unsigned long long)(e << 52));
    return p * sc;
}

__device__ __forceinline__ void phase_prologue_a(const Frame& F0) {
    Frame F = F0; F.tid = F.wave * 64 + lane_id(); asm volatile("" : "+v"(F.tid)); F.lane = F.tid & 63;
    unsigned char* ws = opqg(F.ws); const __attribute__((address_space(4))) Args* a = opq(F.ka);
    LAS float* scr = (LAS float*)(F.lds + F.wave * 16384);
    const int gw = F.vcu * 8 + F.wave, NGW = F.G * 8;
    constexpr int I_IN = 32 * 288, I_GLU = 16 * 64, I_UP = 16 * 64, I_O = 32 * 64, I_L = I_IN + I_GLU + 2 * I_UP + I_O;
    for (int it = gw; it < DEPTH * I_L; it += NGW) {
        const int l = it / I_L; int r = it % I_L;
        if (r < I_IN) { const int kb = r / 288, nb = r % 288, n0 = nb * 32; int dr;
            if (n0 < 5120) dr = n0; else if (n0 < 7168) { const int j = n0 - 5120; dr = 5120 + (j >> 7) * 256 + (j & 127); } else { const int j = n0 - 7168; dr = 5120 + (j >> 7) * 256 + 128 + (j & 127); }
            p0_transpose_item(GP(const float, a->in[I_WIN]) + (size_t)l * D * NIN, NIN, (bf16*)(ws + WS_WIN) + (size_t)l * NIN * D, D, 0, dr, scr, kb * 64, n0, F.lane, true); continue; }
        r -= I_IN;
        if (r < I_GLU) { const int kb = r / 64, nb = r % 64, n0 = nb * 32; int dr;
            if (n0 < 1024) dr = (n0 >> 7) * 256 + (n0 & 127); else { const int j = n0 - 1024; dr = (j >> 7) * 256 + 128 + (j & 127); }
            p0_transpose_item(GP(const float, a->in[I_WGLU]) + (size_t)l * 1024 * 2048, 2048, (bf16*)(ws + WS_WGLU) + (size_t)l * 2048 * 1024, 1024, 0, dr, scr, kb * 64, n0, F.lane); continue; }
        r -= I_GLU;
        if (r < I_UP) { const int kb = r / 64, nb = r % 64;
            p0_transpose_item(GP(const float, a->in[I_WUPA]) + (size_t)l * 1024 * 2048, 2048, (bf16*)(ws + WS_WUP) + (size_t)l * 2048 * 2048, 2048, 0, nb * 32, scr, kb * 64, nb * 32, F.lane); continue; }
        r -= I_UP;
        if (r < I_UP) { const int kb = r / 64, nb = r % 64;
            p0_transpose_item(GP(const float, a->in[I_WUPB]) + (size_t)l * 1024 * 2048, 2048, (bf16*)(ws + WS_WUP) + (size_t)l * 2048 * 2048, 2048, 1024, nb * 32, scr, kb * 64, nb * 32, F.lane); continue; }
        r -= I_UP;
        { const int kb = r / 64, nb = r % 64;
            p0_transpose_item(GP(const float, a->in[I_WO]) + (size_t)l * 2048 * 2048, 2048, (bf16*)(ws + WS_WO) + (size_t)l * 2048 * 2048, 2048, 0, nb * 32, scr, kb * 64, nb * 32, F.lane); }
    }
    const size_t gt = (size_t)F.vcu * 512 + F.tid, NT = (size_t)F.G * 512;
    { const float* src = GP(const float, a->in[I_PWQ]); bf16* dst = (bf16*)(ws + WS_WQB);
      for (size_t i = gt; i < (size_t)DEPTH * D * D / 8; i += NT) { const f32x4 v0 = *(const f32x4*)(src + i * 8), v1 = *(const f32x4*)(src + i * 8 + 4);
          v4u w; w.x = cvt_pk_bf16(v0[0], v0[1]); w.y = cvt_pk_bf16(v0[2], v0[3]); w.z = cvt_pk_bf16(v1[0], v1[1]); w.w = cvt_pk_bf16(v1[2], v1[3]); *(v4u*)(dst + i * 8) = w; } }
    { const float* src = GP(const float, a->in[I_X]); bf16* dst = (bf16*)(ws + WS_XH);
      for (size_t i = gt; i < (size_t)T * D / 8; i += NT) { const int j = (int)(i & 3), row = (int)((i >> 2) & (T - 1)), sl = (int)(i >> 15);
          const float* sp = src + (size_t)row * D + sl * 32 + j * 8; const f32x4 v0 = *(const f32x4*)sp, v1 = *(const f32x4*)(sp + 4);
          v4u w; w.x = cvt_pk_f16(v0[0], v0[1]); w.y = cvt_pk_f16(v0[2], v0[3]); w.z = cvt_pk_f16(v1[0], v1[1]); w.w = cvt_pk_f16(v1[2], v1[3]); *(v4u*)(dst + i * 8) = w; } }
    { const float* keys = GP(const float, a->in[I_PKEYS]); bf16* dst = (bf16*)(ws + WS_BK);
      for (size_t i = gt; i < (size_t)DEPTH * 8 * 256 * 256 / 8; i += NT) { const int jj = (int)(i & 31) * 8; const int row = (int)((i >> 5) & 255); const size_t lh = i >> 13; const int half = row >> 7, n = row & 127;
          v4u w = (v4u){0u, 0u, 0u, 0u};
          if ((jj >> 7) == half) { const float* s = keys + ((lh * 2 + half) * 128 + n) * 128 + (jj & 127); const f32x4 v0 = *(const f32x4*)s, v1 = *(const f32x4*)(s + 4);
              w.x = cvt_pk_bf16(v0[0], v0[1]); w.y = cvt_pk_bf16(v0[2], v0[3]); w.z = cvt_pk_bf16(v1[0], v1[1]); w.w = cvt_pk_bf16(v1[2], v1[3]); }
          *(v4u*)(dst + i * 8) = w; } }
    if (gt < 1024) { const float* lg = GP(const float, a->in[I_LBL]); float* lbo = (float*)(ws + WS_LB); const int d = (int)gt;
        const float z0 = lg[d], z1 = lg[1024 + d], z2 = lg[2048 + d], z3 = lg[3072 + d]; const float mx = fmaxf(fmaxf(z0, z1), fmaxf(z2, z3));
        const float e0 = expf(z0 - mx), e1 = expf(z1 - mx), e2 = expf(z2 - mx), e3 = expf(z3 - mx); const float inv = 1.f / (e0 + e1 + e2 + e3);
        lbo[d] = 0.f; lbo[1024 + d] = e1 * inv; lbo[2048 + d] = (e1 + e2) * inv; lbo[3072 + d] = (e1 + e2 + e3) * inv; }
    for (size_t i = gt; i < (size_t)DEPTH * 64 * 64; i += NT) {
        const size_t lg_ = i >> 6;
        const double lr = fmin((double)GP(const float, a->in[I_LRE])[i], -1e-4), li = (double)GP(const float, a->in[I_LIM])[i], dt = exp_d((double)GP(const float, a->in[I_LSTEP])[lg_]);
        const double mag = exp_d(lr * dt); double sn, cs; sincos_d(li * dt, sn, cs);
        const double ar = mag * cs, ai = mag * sn, den = lr * lr + li * li, nr = ar - 1.0;
        const double zr = (nr * lr + ai * li) / den, zi = (ai * lr - nr * li) / den;
        const float* br = GP(const float, a->in[I_BRE]) + i * 16; const float* bi = GP(const float, a->in[I_BIM]) + i * 16; float* bb = (float*)(ws + WS_BB) + i * 32;
        f32x4 brv[4], biv[4];
#pragma unroll
        for (int m4 = 0; m4 < 4; ++m4) { brv[m4] = ((const f32x4*)br)[m4]; biv[m4] = ((const f32x4*)bi)[m4]; }
#pragma unroll
        for (int m4 = 0; m4 < 4; ++m4) { float o8[8];
#pragma unroll
            for (int x = 0; x < 4; ++x) { const double b_r = brv[m4][x], b_i = biv[m4][x]; o8[2 * x] = (float)(zr * b_r - zi * b_i); o8[2 * x + 1] = (float)(zr * b_i + zi * b_r); }
            ((f32x4*)bb)[2 * m4] = (f32x4){o8[0], o8[1], o8[2], o8[3]}; ((f32x4*)bb)[2 * m4 + 1] = (f32x4){o8[4], o8[5], o8[6], o8[7]}; }
        float* ap = (float*)(ws + WS_APOW) + (lg_ * 65 * 64 + (i & 63)) * 2; double pr = 1.0, pi = 0.0;
        for (int dl = 0; dl < 65; ++dl) { ap[dl * 128] = (float)pr; ap[dl * 128 + 1] = (float)pi; const double t = pr * ar - pi * ai; pi = pr * ai + pi * ar; pr = t; }
    }
    for (int it = gw; it < DEPTH * 1024; it += NGW) {
        const int l = it >> 10, eb = it & 1023;
        const int pe = eb * 16 + (F.lane >> 2), i1 = (pe & 1023) >> 3, i2 = (pe & 7) * 16 + (((pe >> 10) - i1) & 15);
        const float* src = GP(const float, a->in[I_PV]) + ((size_t)l * NEXP + i1 * 128 + i2) * D + (F.lane & 3) * 8;
        bf16* dst = (bf16*)(ws + WS_TBV) + (size_t)l * 64 * NEXP * 32 + ((size_t)(eb * 16 + (F.lane >> 2)) * 4 + ((F.lane & 3) ^ ((F.lane >> 4) & 3))) * 8;
#pragma unroll 8
        for (int ks = 0; ks < 64; ++ks) { const f32x4 v0 = __builtin_nontemporal_load((const f32x4*)(src + ks * 32)), v1 = __builtin_nontemporal_load((const f32x4*)(src + ks * 32 + 4));
            v4u w; w.x = cvt_pk_f16(v0[0], v0[1]); w.y = cvt_pk_f16(v0[2], v0[3]); w.z = cvt_pk_f16(v1[0], v1[1]); w.w = cvt_pk_f16(v1[2], v1[3]);
            *(v4u*)(dst + (size_t)ks * NEXP * 32) = w; }
    }
    for (int it = gw; it < DEPTH * 4096; it += NGW) {
        const int l = it >> 12, q4 = it & 4095, c = F.lane & 15;
        const int pe = q4 * 4 + (F.lane >> 4), i1 = (pe & 1023) >> 3, i2 = (pe & 7) * 16 + (((pe >> 10) - i1) & 15);
        const float* src = GP(const float, a->in[I_PU]) + ((size_t)l * NEXP + i1 * 128 + i2) * D + c * 4;
        unsigned hv[64]; float m = 0.f;
#pragma unroll
        for (int i = 0; i < 32; ++i) { const f32x4 v = __builtin_nontemporal_load((const f32x4*)(src + i * 64));
            m = fmaxf(fmaxf(m, fmaxf(fabsf(v[0]), fabsf(v[1]))), fmaxf(fabsf(v[2]), fabsf(v[3])));
            hv[2 * i] = cvt_pk_f16(v[0], v[1]); hv[2 * i + 1] = cvt_pk_f16(v[2], v[3]); }
        m = fmaxf(m, __shfl_xor(m, 1)); m = fmaxf(m, __shfl_xor(m, 2)); m = fmaxf(m, __shfl_xor(m, 4)); m = fmaxf(m, __shfl_xor(m, 8));
        const float sc = (m > 0.f) ? m * (1.f / 127.f) : 1.f, inv = (m > 0.f) ? 127.f / m : 0.f;
        if (c == 0) ((float*)(ws + WS_SU))[(size_t)l * NEXP + pe] = sc;
        unsigned char* dst = ws + WS_TBU + (size_t)l * 32 * NEXP * 64 + (size_t)pe * 64 + (((c >> 2) ^ ((pe >> 2) & 3)) * 16 + (c & 3) * 4);
#pragma unroll
        for (int i = 0; i < 32; ++i) { const h2_t p0 = __builtin_bit_cast(h2_t, hv[2 * i]), p1 = __builtin_bit_cast(h2_t, hv[2 * i + 1]);
            const int q0 = (int)__builtin_rintf((float)p0.x * inv), q1 = (int)__builtin_rintf((float)p0.y * inv), q2 = (int)__builtin_rintf((float)p1.x * inv), q3 = (int)__builtin_rintf((float)p1.y * inv);
            *(unsigned*)(dst + (size_t)i * NEXP * 64) = (unsigned)(q0 & 255) | ((unsigned)(q1 & 255) << 8) | ((unsigned)(q2 & 255) << 16) | ((unsigned)q3 << 24); }
    }
}
__device__ __forceinline__ double dummy_unused_(double x) { return x; }

__device__ __forceinline__ void phase_prologue_b(const Frame& F0) {
    Frame F = F0; F.tid = F.wave * 64 + lane_id(); asm volatile("" : "+v"(F.tid)); F.lane = F.tid & 63;
    unsigned char* ws = opqg(F.ws); const __attribute__((address_space(4))) Args* a = opq(F.ka);
    const float* APOW = (const float*)(ws + WS_APOW); const float* BB = (const float*)(ws + WS_BB);
    LAS float* AP = (LAS float*)(F.lds); LAS float* BL = (LAS float*)(F.lds + 33280); LAS float* CR = (LAS float*)(F.lds + 41472); LAS float* CI = (LAS float*)(F.lds + 45568); LAS float* SDL = (LAS float*)(F.lds + 49664);
    bf16* KM = (bf16*)(ws + WS_KMAT); bf16* PM = (bf16*)(ws + WS_PM); bf16* E = (bf16*)(ws + WS_E);
    for (int lg = F.vcu; lg < DEPTH * 64; lg += F.G) {
        for (int i = F.tid; i < 65 * 64 * 2 / 4; i += 512) ((LAS f32x4*)AP)[i] = ((const f32x4*)(APOW + (size_t)lg * 65 * 128))[i];
        ((LAS f32x4*)BL)[F.tid] = ((const f32x4*)(BB + (size_t)lg * 2048))[F.tid];
        if (F.tid < 256) ((LAS f32x4*)CR)[F.tid] = ((const f32x4*)(GP(const float, a->in[I_CRE]) + (size_t)lg * 1024))[F.tid];
        else ((LAS f32x4*)CI)[F.tid - 256] = ((const f32x4*)(GP(const float, a->in[I_CIM]) + (size_t)lg * 1024))[F.tid - 256];
        if (F.tid < 16) SDL[F.tid] = GP(const float, a->in[I_SD])[lg * 16 + F.tid];
        __syncthreads();
        for (int task = F.tid; task < 65 * 16; task += 512) {
            const int n = task & 15, idx = task >> 4;
            float sm[16];
#pragma unroll
            for (int m = 0; m < 16; ++m) sm[m] = 0.f;
            if (idx > 0) { const int dl = idx - 1;
#pragma unroll 4
                for (int p = 0; p < 64; ++p) { const f32x2 av = *(const LAS f32x2*)(AP + (dl * 64 + p) * 2); const float c_r = CR[n * 64 + p], c_i = CI[n * 64 + p];
                    const float car = c_r * av[0] - c_i * av[1], cai = c_r * av[1] + c_i * av[0];
#pragma unroll
                    for (int q = 0; q < 8; ++q) { const f32x4 b4 = *(const LAS f32x4*)(BL + p * 32 + q * 4); sm[2 * q] += car * b4[0] - cai * b4[1]; sm[2 * q + 1] += car * b4[2] - cai * b4[3]; } }
                if (dl == 0) { const float dv = SDL[n];
#pragma unroll
                    for (int m = 0; m < 16; ++m) sm[m] += (m == n) ? dv : 0.f; } }
            v4u w0, w1; w0.x = cvt_pk_bf16(sm[0], sm[1]); w0.y = cvt_pk_bf16(sm[2], sm[3]); w0.z = cvt_pk_bf16(sm[4], sm[5]); w0.w = cvt_pk_bf16(sm[6], sm[7]);
            w1.x = cvt_pk_bf16(sm[8], sm[9]); w1.y = cvt_pk_bf16(sm[10], sm[11]); w1.z = cvt_pk_bf16(sm[12], sm[13]); w1.w = cvt_pk_bf16(sm[14], sm[15]);
            bf16* kp = KM + ((size_t)lg * 65 * 16 + task) * 16; *(v4u*)kp = w0; *(v4u*)(kp + 8) = w1; }
        for (int it = F.tid; it < 128 * 64 * 2; it += 512) {
            const int m0 = (it & 1) * 8, sidx = (it >> 1) & 63, pp = it >> 7, p = pp & 63;
            const f32x2 av = *(const LAS f32x2*)(AP + ((63 - sidx) * 64 + p) * 2); const float pr = av[0], pi = av[1];
            float o[8];
#pragma unroll
            for (int j = 0; j < 4; ++j) { const f32x4 b4 = *(const LAS f32x4*)(BL + p * 32 + m0 * 2 + j * 4);
                o[2 * j] = (pp < 64) ? (pr * b4[0] - pi * b4[1]) : (pr * b4[1] + pi * b4[0]); o[2 * j + 1] = (pp < 64) ? (pr * b4[2] - pi * b4[3]) : (pr * b4[3] + pi * b4[2]); }
            v4u w; w.x = cvt_pk_bf16(o[0], o[1]); w.y = cvt_pk_bf16(o[2], o[3]); w.z = cvt_pk_bf16(o[4], o[5]); w.w = cvt_pk_bf16(o[6], o[7]); *(v4u*)(PM + ((size_t)lg * 16384 + it) * 8) = w; }
        for (int it = F.tid; it < 1024 * 16; it += 512) {
            const int pp0 = (it & 15) * 8, n = (it >> 4) & 15, tau = it >> 8, p0 = pp0 & 63;
            float o[8];
#pragma unroll
            for (int j = 0; j < 8; ++j) { const f32x2 av = *(const LAS f32x2*)(AP + ((tau + 1) * 64 + p0 + j) * 2); const float c_r = CR[n * 64 + p0 + j], c_i = CI[n * 64 + p0 + j];
                o[j] = (pp0 < 64) ? (c_r * av[0] - c_i * av[1]) : -(c_r * av[1] + c_i * av[0]); }
            v4u w; w.x = cvt_pk_bf16(o[0], o[1]); w.y = cvt_pk_bf16(o[2], o[3]); w.z = cvt_pk_bf16(o[4], o[5]); w.w = cvt_pk_bf16(o[6], o[7]); *(v4u*)(E + ((size_t)lg * 16384 + it) * 8) = w; }
        __syncthreads();
    }
}
constexpr int HG_BL = 0, HG_TOT = 33792, HG_VT = 35840, HG_KT = 54272, HG_RED = 72704;
constexpr int KSP = 136, HG_KS = 73728, HG_QT = HG_KS + 64 * KSP * 2, HG_QH = HG_QT + 64 * KSP * 2;
static_assert(HG_QH + 64 * KSP * 2 <= RING_BYTES, "hgrn_out LDS map");
constexpr int BLP = 132, VTP = 72;
__device__ __forceinline__ void hg_cumsum(const Frame& F, const float* LOGF, int c, int h) {
    LAS float* bL = (LAS float*)(F.lds + HG_BL); LAS float* tot = (LAS float*)(F.lds + HG_TOT);
    const int d = F.tid & 127, seg = F.tid >> 7;
    const float* src = LOGF + (size_t)(c * 64 + seg * 16) * AW + h * 128 + d;
    float lf[16];
#pragma unroll
    for (int i = 0; i < 16; ++i) lf[i] = src[(size_t)i * AW];
#pragma unroll
    for (int i = 1; i < 16; ++i) lf[i] += lf[i - 1];
    tot[seg * 128 + d] = lf[15];
    __syncthreads();
    float off = 0.f;
#pragma unroll
    for (int s2 = 0; s2 < 3; ++s2) off += (s2 < seg) ? tot[s2 * 128 + d] : 0.f;
#pragma unroll
    for (int i = 0; i < 16; ++i) bL[(seg * 16 + i) * BLP + d] = lf[i] + off;
}
__device__ __forceinline__ void hg_load_vt(const Frame& F, const bf16* V, int c, int h) {
    LAS bf16* VT = (LAS bf16*)(F.lds + HG_VT);
    const int s = F.lane, vb = F.wave * 16;
    const v4u* src = (const v4u*)(V + (size_t)(c * 64 + s) * AW + h * 128 + vb);
    const v4u w0 = src[0], w1 = src[1];
    const unsigned ww[8] = {w0.x, w0.y, w0.z, w0.w, w1.x, w1.y, w1.z, w1.w};
#pragma unroll
    for (int j = 0; j < 8; ++j) { VT[(vb + 2 * j) * VTP + s] = (bf16)(ww[j] & 0xffffu); VT[(vb + 2 * j + 1) * VTP + s] = (bf16)(ww[j] >> 16); }
}
__device__ __forceinline__ void phase_hgrn_local(const Frame& F0, int l) {
    Frame F = F0; F.tid = F.wave * 64 + lane_id(); asm volatile("" : "+v"(F.tid)); F.lane = F.tid & 63;
    unsigned char* ws = opqg(F.ws);
    const float* LOGF = (const float*)(ws + WS_LOGF); const bf16* KK = (const bf16*)(ws + WS_KK); const bf16* V = (const bf16*)(ws + WS_V);
    _Float16* U = (_Float16*)(ws + WS_U); float* BLo = (float*)(ws + WS_BL);
    LAS float* bL = (LAS float*)(F.lds + HG_BL); LAS bf16* VT = (LAS bf16*)(F.lds + HG_VT); LAS bf16* KT = (LAS bf16*)(F.lds + HG_KT);
    const int fr = F.lane & 15, fq = F.lane >> 4;
    for (int unit = F.vcu; unit < NCH * 8; unit += F.G) {
        const int c = unit >> 3, h = unit & 7;
        hg_cumsum(F, LOGF, c, h);
        hg_load_vt(F, V, c, h);
        __syncthreads();
        { const int s = F.lane, db = F.wave * 16;
          const v4u* src = (const v4u*)(KK + (size_t)(c * 64 + s) * AW + h * 128 + db);
          const v4u w0 = src[0], w1 = src[1];
          const unsigned ww[8] = {w0.x, w0.y, w0.z, w0.w, w1.x, w1.y, w1.z, w1.w};
#pragma unroll
          for (int j = 0; j < 8; ++j) {
              const float b0 = bL[s * BLP + db + 2 * j], b1 = bL[s * BLP + db + 2 * j + 1], l0 = bL[63 * BLP + db + 2 * j], l1 = bL[63 * BLP + db + 2 * j + 1];
              const unsigned pk = cvt_pk_bf16(bf_lo(ww[j]) * fexp(l0 - b0), bf_hi(ww[j]) * fexp(l1 - b1));
              KT[(db + 2 * j) * VTP + s] = (bf16)(pk & 0xffffu); KT[(db + 2 * j + 1) * VTP + s] = (bf16)(pk >> 16); } }
        if (F.tid < 128) BLo[(size_t)c * AW + h * 128 + F.tid] = bL[63 * BLP + F.tid];
        __syncthreads();
        f32x4 acc[8];
#pragma unroll
        for (int i = 0; i < 8; ++i) acc[i] = (f32x4){0.f, 0.f, 0.f, 0.f};
#pragma unroll
        for (int ks = 0; ks < 2; ++ks) {
            const bf16x8 A = *(const LAS bf16x8*)(VT + (F.wave * 16 + fr) * VTP + ks * 32 + fq * 8);
#pragma unroll
            for (int dt = 0; dt < 8; ++dt) { const bf16x8 B = *(const LAS bf16x8*)(KT + (dt * 16 + fr) * VTP + ks * 32 + fq * 8);
                acc[dt] = __builtin_amdgcn_mfma_f32_16x16x32_bf16(B, A, acc[dt], 0, 0, 0); }
        }
        _Float16* up = U + ((size_t)(c * 8 + h) * 128 + F.wave * 16 + fr) * 128 + fq * 4;
#pragma unroll
        for (int dt = 0; dt < 8; ++dt) { v2u w; w.x = cvt_pk_f16(acc[dt][0], acc[dt][1]); w.y = cvt_pk_f16(acc[dt][2], acc[dt][3]); *(v2u*)(up + dt * 16) = w; }
        __syncthreads();
    }
}
__device__ __forceinline__ void phase_scan(const Frame& F0, int l) {
    Frame F = F0; F.tid = F.wave * 64 + lane_id(); asm volatile("" : "+v"(F.tid)); F.lane = F.tid & 63;
    unsigned char* ws = opqg(F.ws);
    const _Float16* U = (const _Float16*)(ws + WS_U); const float* BLo = (const float*)(ws + WS_BL); bf16* SP = (bf16*)(ws + WS_SP);
    for (int e = F.vcu * 512 + F.tid; e < 8 * 128 * 128; e += F.G * 512) {
        const int hd = (e >> 14) * 128 + (e & 127);
        float s = 0.f;
        for (int c0 = 0; c0 < NCH; c0 += 32) {
            float u[32], bl[32];
#pragma unroll
            for (int i = 0; i < 32; ++i) { u[i] = (float)U[(size_t)(c0 + i) * 131072 + e]; bl[i] = BLo[(size_t)(c0 + i) * AW + hd]; }
#pragma unroll
            for (int i = 0; i < 32; ++i) { SP[(size_t)(c0 + i) * 131072 + e] = f2bf(s); s = s * fexp(bl[i]) + u[i]; }
        }
    }
    const float* XLOC = (const float*)(ws + WS_XLOC); float* XS = (float*)(ws + WS_XS); const float* APOW = (const float*)(ws + WS_APOW);
    for (int e = F.vcu * 512 + F.tid; e < 64 * 64; e += F.G * 512) {
        const int g = e >> 6, p = e & 63;
        const float* ap = APOW + (((size_t)(l * 64 + g) * 65 + 64) * 64 + p) * 2; const float ar = ap[0], ai = ap[1];
        float xr = 0.f, xi = 0.f;
        for (int c0 = 0; c0 < NCH; c0 += 32) {
            float lr_[32], li_[32];
#pragma unroll
            for (int i = 0; i < 32; ++i) { lr_[i] = XLOC[((size_t)(c0 + i) * 64 + g) * 128 + p]; li_[i] = XLOC[((size_t)(c0 + i) * 64 + g) * 128 + 64 + p]; }
#pragma unroll
            for (int i = 0; i < 32; ++i) { XS[((size_t)(c0 + i) * 64 + g) * 128 + p] = xr; XS[((size_t)(c0 + i) * 64 + g) * 128 + 64 + p] = xi;
                const float t = ar * xr - ai * xi + lr_[i]; xi = ar * xi + ai * xr + li_[i]; xr = t; }
        }
    }
}
__device__ __forceinline__ void phase_hgrn_out(const Frame& F0, int l) {
    Frame F = F0; F.tid = F.wave * 64 + lane_id(); asm volatile("" : "+v"(F.tid)); F.lane = F.tid & 63;
    unsigned char* ws = opqg(F.ws); const __attribute__((address_space(4))) Args* a = opq(F.ka);
    const float* LOGF = (const float*)(ws + WS_LOGF); const bf16* KK = (const bf16*)(ws + WS_KK); const bf16* V = (const bf16*)(ws + WS_V);
    const bf16* Q = (const bf16*)(ws + WS_Q); const bf16* SG = (const bf16*)(ws + WS_SG); const bf16* SP = (const bf16*)(ws + WS_SP);
    bf16* OAB = (bf16*)(ws + WS_OAB); const float* NG = GP(const float, a->in[I_NG]) + (size_t)l * AW;
    LAS float* bL = (LAS float*)(F.lds + HG_BL); LAS bf16* VT = (LAS bf16*)(F.lds + HG_VT); LAS float* red = (LAS float*)(F.lds + HG_RED);
    const int fr = F.lane & 15, fq = F.lane >> 4, tt = F.wave & 3, vh = F.wave >> 2;
    LAS float* tot = (LAS float*)(F.lds + HG_TOT);
    float lf[16]; v4u vw0, vw1, kg0, kg1, qg0, qg1;
#define HGO_PREF(u_) { const int c_ = (u_) >> 3, h_ = (u_) & 7; \
        const float* src_ = LOGF + (size_t)(c_ * 64 + (F.tid >> 7) * 16) * AW + h_ * 128 + (F.tid & 127); \
        _Pragma("unroll") for (int i = 0; i < 16; ++i) lf[i] = src_[(size_t)i * AW]; \
        const v4u* vp_ = (const v4u*)(V + (size_t)(c_ * 64 + F.lane) * AW + h_ * 128 + F.wave * 16); vw0 = vp_[0]; vw1 = vp_[1]; \
        const size_t ro_ = ((size_t)c_ * 64 + (F.tid >> 3)) * AW + h_ * 128 + (F.tid & 7) * 16; \
        const v4u* kp_ = (const v4u*)(KK + ro_); const v4u* qp_ = (const v4u*)(Q + ro_); kg0 = kp_[0]; kg1 = kp_[1]; qg0 = qp_[0]; qg1 = qp_[1]; }
    if (F.vcu < NCH * 8) HGO_PREF(F.vcu)
    for (int unit = F.vcu; unit < NCH * 8; unit += F.G) {
        const int c = unit >> 3, h = unit & 7;
        { const int d = F.tid & 127, seg = F.tid >> 7;
#pragma unroll
          for (int i = 1; i < 16; ++i) lf[i] += lf[i - 1];
          tot[seg * 128 + d] = lf[15];
          { const int s = F.lane, vb = F.wave * 16; const unsigned ww[8] = {vw0.x, vw0.y, vw0.z, vw0.w, vw1.x, vw1.y, vw1.z, vw1.w};
#pragma unroll
            for (int j = 0; j < 8; ++j) { VT[(vb + 2 * j) * VTP + s] = (bf16)(ww[j] & 0xffffu); VT[(vb + 2 * j + 1) * VTP + s] = (bf16)(ww[j] >> 16); } }
          __syncthreads();
          float off = 0.f;
#pragma unroll
          for (int s2 = 0; s2 < 3; ++s2) off += (s2 < seg) ? tot[s2 * 128 + d] : 0.f;
#pragma unroll
          for (int i = 0; i < 16; ++i) bL[(seg * 16 + i) * BLP + d] = lf[i] + off; }
        __syncthreads();
        const int t = tt * 16 + fr; const size_t tok = (size_t)c * 64 + t;
        bf16x8 sg_[2][4];
#define HG_LOAD(buf, kd_) { const int d0_ = (kd_) * 32 + fq * 8; \
            _Pragma("unroll") for (int vt = 0; vt < 4; ++vt) sg_[buf][vt] = *(const bf16x8*)(SP + ((size_t)(c * 8 + h) * 128 + (vh * 4 + vt) * 16 + fr) * 128 + d0_); }
        HG_LOAD(0, 0) HG_LOAD(1, 1)
        v2u sgw[4];
#pragma unroll
        for (int vt = 0; vt < 4; ++vt) sgw[vt] = *(const v2u*)(SG + tok * AW + h * 128 + (vh * 4 + vt) * 16 + fq * 4);
        f32x4 ngw[4];
#pragma unroll
        for (int vt = 0; vt < 4; ++vt) ngw[vt] = *(const f32x4*)(NG + h * 128 + (vh * 4 + vt) * 16 + fq * 4);
        { const int s = F.tid >> 3, dc = (F.tid & 7) * 16;
          const unsigned kq[8] = {kg0.x, kg0.y, kg0.z, kg0.w, kg1.x, kg1.y, kg1.z, kg1.w}, qq[8] = {qg0.x, qg0.y, qg0.z, qg0.w, qg1.x, qg1.y, qg1.z, qg1.w};
          unsigned ko[8], qto[8], qho[8];
#pragma unroll
          for (int j4 = 0; j4 < 4; ++j4) { const f32x4 bs = *(const LAS f32x4*)(bL + s * BLP + dc + 4 * j4), br = *(const LAS f32x4*)(bL + 31 * BLP + dc + 4 * j4);
#pragma unroll
              for (int hx = 0; hx < 2; ++hx) { const int w = 2 * j4 + hx; const float b0 = bs[2 * hx], b1 = bs[2 * hx + 1], r0 = br[2 * hx], r1 = br[2 * hx + 1];
                  const float k0 = bf_lo(kq[w]), k1 = bf_hi(kq[w]), q0 = bf_lo(qq[w]), q1 = bf_hi(qq[w]);
                  ko[w] = cvt_pk_bf16(k0 * fexp(fminf(r0 - b0, 80.f)), k1 * fexp(fminf(r1 - b1, 80.f)));
                  qto[w] = cvt_pk_bf16(q0 * fexp(fminf(b0 - r0, 80.f)), q1 * fexp(fminf(b1 - r1, 80.f)));
                  qho[w] = cvt_pk_bf16(q0 * fexp(b0), q1 * fexp(b1)); } }
          LAS v4u* kd_ = (LAS v4u*)(F.lds + HG_KS + (s * KSP + dc) * 2); kd_[0] = (v4u){ko[0], ko[1], ko[2], ko[3]}; kd_[1] = (v4u){ko[4], ko[5], ko[6], ko[7]};
          LAS v4u* qt_ = (LAS v4u*)(F.lds + HG_QT + (s * KSP + dc) * 2); qt_[0] = (v4u){qto[0], qto[1], qto[2], qto[3]}; qt_[1] = (v4u){qto[4], qto[5], qto[6], qto[7]};
          LAS v4u* qh_ = (LAS v4u*)(F.lds + HG_QH + (s * KSP + dc) * 2); qh_[0] = (v4u){qho[0], qho[1], qho[2], qho[3]}; qh_[1] = (v4u){qho[4], qho[5], qho[6], qho[7]}; }
        __syncthreads();
        f32x4 att[4], o[4];
#pragma unroll
        for (int i = 0; i < 4; ++i) { att[i] = (f32x4){0.f, 0.f, 0.f, 0.f}; o[i] = (f32x4){0.f, 0.f, 0.f, 0.f}; }
#pragma unroll
        for (int kd = 0; kd < 4; ++kd) {
            const int cb = kd & 1;
            const int fo = (kd * 32 + fq * 8) * 2;
            const bf16x8 Bqt = *(const LAS bf16x8*)(F.lds + HG_QT + (t * KSP) * 2 + fo), Bqh = *(const LAS bf16x8*)(F.lds + HG_QH + (t * KSP) * 2 + fo);
#pragma unroll
            for (int st = 0; st < 4; ++st) { const bf16x8 kt = *(const LAS bf16x8*)(F.lds + HG_KS + ((st * 16 + fr) * KSP) * 2 + fo);
                att[st] = __builtin_amdgcn_mfma_f32_16x16x32_bf16(kt, Bqt, att[st], 0, 0, 0); }
#pragma unroll
            for (int vt = 0; vt < 4; ++vt) o[vt] = __builtin_amdgcn_mfma_f32_16x16x32_bf16(sg_[cb][vt], Bqh, o[vt], 0, 0, 0);
            if (kd < 2) HG_LOAD(cb, kd + 2)
            if (kd == 1) { const int nu = unit + F.G; if (nu < NCH * 8) HGO_PREF(nu) }
        }
#undef HG_LOAD
#pragma unroll
        for (int ks = 0; ks < 2; ++ks) {
            float m8[8];
#pragma unroll
            for (int jj = 0; jj < 8; ++jj) { const int st = 2 * ks + (jj >> 2), r = jj & 3, s = st * 16 + fq * 4 + r; m8[jj] = (s <= t) ? att[st][r] : 0.f; }
            v4u pb; pb.x = cvt_pk_bf16(m8[0], m8[1]); pb.y = cvt_pk_bf16(m8[2], m8[3]); pb.z = cvt_pk_bf16(m8[4], m8[5]); pb.w = cvt_pk_bf16(m8[6], m8[7]);
            const bf16x8 B = __builtin_bit_cast(bf16x8, pb);
#pragma unroll
            for (int vt = 0; vt < 4; ++vt) { const int v = (vh * 4 + vt) * 16 + fr;
                const v2u a0 = *(const LAS v2u*)(VT + v * VTP + ks * 32 + fq * 4), a1 = *(const LAS v2u*)(VT + v * VTP + ks * 32 + 16 + fq * 4);
                const v4u pa = (v4u){a0.x, a0.y, a1.x, a1.y};
                o[vt] = __builtin_amdgcn_mfma_f32_16x16x32_bf16(__builtin_bit_cast(bf16x8, pa), B, o[vt], 0, 0, 0); }
        }
        float ss = 0.f;
#pragma unroll
        for (int vt = 0; vt < 4; ++vt)
#pragma unroll
            for (int r = 0; r < 4; ++r) ss += o[vt][r] * o[vt][r];
        ss += __shfl_xor(ss, 16); ss += __shfl_xor(ss, 32);
        if (fq == 0) red[F.wave * 16 + fr] = ss;
        LDS_WAIT(); __builtin_amdgcn_s_barrier(); asm volatile("" ::: "memory");
        const float tot = red[F.wave * 16 + fr] + red[(F.wave ^ 4) * 16 + fr];
        const float rstd = __builtin_amdgcn_rsqf(tot * (1.f / 128.f) + RMS_EPS);
#pragma unroll
        for (int vt = 0; vt < 4; ++vt) { const int v0 = (vh * 4 + vt) * 16 + fq * 4;
            const f32x4 g4 = ngw[vt]; const v2u sg = sgw[vt];
            v2u w; w.x = cvt_pk_bf16(o[vt][0] * rstd * g4[0] * bf_lo(sg.x), o[vt][1] * rstd * g4[1] * bf_hi(sg.x));
            w.y = cvt_pk_bf16(o[vt][2] * rstd * g4[2] * bf_lo(sg.y), o[vt][3] * rstd * g4[3] * bf_hi(sg.y));
            *(v2u*)(OAB + tok * 2048 + h * 128 + v0) = w; }
        LDS_WAIT(); __builtin_amdgcn_s_barrier(); asm volatile("" ::: "memory");
    }
#undef HGO_PREF
}

constexpr int S5_UT = 0, S5_UTP = 2064, S5_XST = 33024, S5_XSP = 272, S5_KM = 37376;
__device__ __forceinline__ void s5_load_ut(const Frame& F, const bf16* UB, int g, int jb) {
#pragma unroll
    for (int i = 0; i < 2; ++i) { const int tl = F.tid + 512 * i; const v4u* src = (const v4u*)(UB + ((size_t)jb * 1024 + tl) * AW + g * 16);
        const v4u w0 = src[0], w1 = src[1]; LAS v4u* dst = (LAS v4u*)(F.lds + S5_UT + (tl >> 6) * S5_UTP + (tl & 63) * 32); dst[0] = w0; dst[1] = w1; }
}
__device__ __forceinline__ void phase_s5_local(const Frame& F0, int l) {
    Frame F = F0; F.tid = F.wave * 64 + lane_id(); asm volatile("" : "+v"(F.tid)); F.lane = F.tid & 63;
    unsigned char* ws = opqg(F.ws);
    const bf16* UB = (const bf16*)(ws + WS_UB); const bf16* PM = (const bf16*)(ws + WS_PM) + (size_t)l * 64 * 128 * 1024; float* XLOC = (float*)(ws + WS_XLOC);
    const int fr = F.lane & 15, fq = F.lane >> 4;
    for (int unit = F.vcu; unit < 64 * 8; unit += F.G) {
        const int g = unit >> 3, jb = unit & 7;
        const bf16* ap = PM + ((size_t)g * 128 + F.wave * 16 + fr) * 1024 + fq * 8;
        bf16x8 Af[32];
#pragma unroll
        for (int ks = 0; ks < 32; ++ks) Af[ks] = *(const bf16x8*)(ap + ks * 32);
        s5_load_ut(F, UB, g, jb);
        __syncthreads();
        f32x4 acc = (f32x4){0.f, 0.f, 0.f, 0.f};
        const LAS unsigned char* bp = F.lds + S5_UT + fr * S5_UTP + (fq >> 1) * 32 + (fq & 1) * 16;
#pragma unroll
        for (int ks = 0; ks < 32; ++ks) { const bf16x8 B = *(const LAS bf16x8*)(bp + ks * 64);
            acc = __builtin_amdgcn_mfma_f32_16x16x32_bf16(Af[ks], B, acc, 0, 0, 0); }
        *(f32x4*)(XLOC + ((size_t)(jb * 16 + fr) * 64 + g) * 128 + F.wave * 16 + fq * 4) = acc;
        __syncthreads();
    }
}
__device__ __forceinline__ void phase_s5_out(const Frame& F0, int l) {
    Frame F = F0; F.tid = F.wave * 64 + lane_id(); asm volatile("" : "+v"(F.tid)); F.lane = F.tid & 63;
    unsigned char* ws = opqg(F.ws);
    const bf16* UB = (const bf16*)(ws + WS_UB); const bf16* E = (const bf16*)(ws + WS_E) + (size_t)l * 64 * 1024 * 128; const bf16* KMAT = (const bf16*)(ws + WS_KMAT) + (size_t)l * 64 * 65 * 256;
    const float* XS = (const float*)(ws + WS_XS); bf16* YB = (bf16*)(ws + WS_YB);
    const int fr = F.lane & 15, fq = F.lane >> 4;
    for (int unit = F.vcu; unit < 64 * 8; unit += F.G) {
        const int g = unit >> 3, jb = unit & 7;
        s5_load_ut(F, UB, g, jb);
        { const int cc = F.tid >> 5, p0 = (F.tid & 31) * 4; const f32x4 xv = *(const f32x4*)(XS + ((size_t)(jb * 16 + cc) * 64 + g) * 128 + p0);
          v2u w; w.x = cvt_pk_bf16(xv[0], xv[1]); w.y = cvt_pk_bf16(xv[2], xv[3]); *(LAS v2u*)(F.lds + S5_XST + cc * S5_XSP + p0 * 2) = w; }
        for (int pc = F.tid; pc < 65 * 32; pc += 512) { const int idx = pc >> 5, n = (pc >> 1) & 15, half = pc & 1;
            const v4u w = *(const v4u*)(KMAT + (size_t)g * 65 * 256 + (size_t)pc * 8); *(LAS v4u*)(F.lds + S5_KM + idx * 512 + n * 32 + ((half ^ (n >> 3)) * 16)) = w; }
        __syncthreads();
        for (int ti = 0; ti < 8; ++ti) {
            const int tau = ti * 8 + F.wave;
            const bf16* ep = E + ((size_t)g * 1024 + tau * 16 + fr) * 128 + fq * 8;
            bf16x8 Ae[4];
#pragma unroll
            for (int ke = 0; ke < 4; ++ke) Ae[ke] = *(const bf16x8*)(ep + ke * 32);
            f32x4 acc = (f32x4){0.f, 0.f, 0.f, 0.f}, acc1 = (f32x4){0.f, 0.f, 0.f, 0.f};
            const LAS unsigned char* bp = F.lds + S5_UT + fr * S5_UTP + (fq >> 1) * 32 + (fq & 1) * 16;
            const LAS unsigned char* kp = F.lds + S5_KM + (tau - (fq >> 1) + 1) * 512 + fr * 32 + (((fq & 1) ^ (fr >> 3)) * 16);
            const int nks = (tau >> 1) + 1;
            int ks = 0;
            for (; ks + 4 <= nks; ks += 4) {
                const bf16x8 A0 = *(const LAS bf16x8*)(kp - ks * 1024), A1 = *(const LAS bf16x8*)(kp - (ks + 1) * 1024), A2 = *(const LAS bf16x8*)(kp - (ks + 2) * 1024), A3 = *(const LAS bf16x8*)(kp - (ks + 3) * 1024);
                const bf16x8 B0 = *(const LAS bf16x8*)(bp + ks * 64), B1 = *(const LAS bf16x8*)(bp + (ks + 1) * 64), B2 = *(const LAS bf16x8*)(bp + (ks + 2) * 64), B3 = *(const LAS bf16x8*)(bp + (ks + 3) * 64);
                acc = __builtin_amdgcn_mfma_f32_16x16x32_bf16(A0, B0, acc, 0, 0, 0); acc1 = __builtin_amdgcn_mfma_f32_16x16x32_bf16(A1, B1, acc1, 0, 0, 0);
                acc = __builtin_amdgcn_mfma_f32_16x16x32_bf16(A2, B2, acc, 0, 0, 0); acc1 = __builtin_amdgcn_mfma_f32_16x16x32_bf16(A3, B3, acc1, 0, 0, 0); }
            for (; ks < nks; ++ks) { const bf16x8 A = *(const LAS bf16x8*)(kp - ks * 1024); const bf16x8 B = *(const LAS bf16x8*)(bp + ks * 64);
                acc = __builtin_amdgcn_mfma_f32_16x16x32_bf16(A, B, acc, 0, 0, 0); }
            const LAS unsigned char* xp = F.lds + S5_XST + fr * S5_XSP + fq * 16;
#pragma unroll
            for (int ke = 0; ke < 4; ke += 2) { const bf16x8 B0 = *(const LAS bf16x8*)(xp + ke * 64), B1 = *(const LAS bf16x8*)(xp + (ke + 1) * 64);
                acc = __builtin_amdgcn_mfma_f32_16x16x32_bf16(Ae[ke], B0, acc, 0, 0, 0); acc1 = __builtin_amdgcn_mfma_f32_16x16x32_bf16(Ae[ke + 1], B1, acc1, 0, 0, 0); }
            acc += acc1;
            v2u w; w.x = cvt_pk_bf16(gelu_tanh(acc[0]), gelu_tanh(acc[1])); w.y = cvt_pk_bf16(gelu_tanh(acc[2]), gelu_tanh(acc[3]));
            *(v2u*)(YB + ((size_t)(jb * 16 + fr) * 64 + tau) * AW + g * 16 + fq * 4) = w;
        }
        __syncthreads();
    }
}

__device__ __forceinline__ void phase_ln(const Frame& F0, int l, int which) {
    Frame F = F0; F.tid = F.wave * 64 + lane_id(); asm volatile("" : "+v"(F.tid)); F.lane = F.tid & 63;
    unsigned char* ws = opqg(F.ws); const __attribute__((address_space(4))) Args* a = opq(F.ka);
    const bf16* RS = (const bf16*)(ws + WS_RH); bf16* XS = (bf16*)(ws + WS_XH);
    const bool last = (which == 1 && l == DEPTH - 1); float* OUT = GP(float, a->out);
    const float* gam = GP(const float, a->in[which == 0 ? I_LN1G : I_LN2G]) + (size_t)l * D; const float* bet = GP(const float, a->in[which == 0 ? I_LN1B : I_LN2B]) + (size_t)l * D;
    const int gw = F.vcu * 8 + F.wave, NGW = F.G * 8;
    const int j = F.lane & 3, rr = (F.lane >> 2) & 1, sl = F.lane >> 3;
    for (int rp = gw; rp < T / 2; rp += NGW) {
        const int row = 2 * rp + rr;
        const size_t eo = ((size_t)sl * T + row) * 32 + j * 8;
        v4u w[8];
#pragma unroll
        for (int i = 0; i < 8; ++i) w[i] = *(const v4u*)(RS + eo + (size_t)i * 8 * T * 32);
        float v[64]; float s = 0.f;
#pragma unroll
        for (int i = 0; i < 8; ++i) { const unsigned ww[4] = {w[i].x, w[i].y, w[i].z, w[i].w};
#pragma unroll
            for (int k = 0; k < 4; ++k) { const h2_t hv = __builtin_bit_cast(h2_t, ww[k]); v[8 * i + 2 * k] = (float)hv.x; v[8 * i + 2 * k + 1] = (float)hv.y; s += (float)hv.x + (float)hv.y; } }
        s += __shfl_xor(s, 1); s += __shfl_xor(s, 2); s += __shfl_xor(s, 8); s += __shfl_xor(s, 16); s += __shfl_xor(s, 32);
        const float mean = s * (1.f / D); float s2 = 0.f;
#pragma unroll
        for (int i = 0; i < 64; ++i) { v[i] -= mean; s2 += v[i] * v[i]; }
        s2 += __shfl_xor(s2, 1); s2 += __shfl_xor(s2, 2); s2 += __shfl_xor(s2, 8); s2 += __shfl_xor(s2, 16); s2 += __shfl_xor(s2, 32);
        const float rstd = __builtin_amdgcn_rsqf(s2 * (1.f / D) + LN_EPS);
        float amax = 0.f;
#pragma unroll
        for (int i = 0; i < 8; ++i) { const int e0 = (8 * i + sl) * 32 + j * 8;
            const f32x4 g0 = *(const f32x4*)(gam + e0), g1 = *(const f32x4*)(gam + e0 + 4), b0 = *(const f32x4*)(bet + e0), b1 = *(const f32x4*)(bet + e0 + 4);
            const f32x4 y0 = (f32x4){v[8 * i], v[8 * i + 1], v[8 * i + 2], v[8 * i + 3]} * rstd * g0 + b0, y1 = (f32x4){v[8 * i + 4], v[8 * i + 5], v[8 * i + 6], v[8 * i + 7]} * rstd * g1 + b1;
            if (last) { *(f32x4*)(OUT + (size_t)row * D + e0) = y0; *(f32x4*)(OUT + (size_t)row * D + e0 + 4) = y1; }
            else { v4u o; o.x = cvt_pk_f16(y0[0], y0[1]); o.y = cvt_pk_f16(y0[2], y0[3]); o.z = cvt_pk_f16(y1[0], y1[1]); o.w = cvt_pk_f16(y1[2], y1[3]); *(v4u*)(XS + eo + (size_t)i * 8 * T * 32) = o; }
            if (which == 0) {
#pragma unroll
                for (int k = 0; k < 4; ++k) { v[8 * i + k] = y0[k]; v[8 * i + 4 + k] = y1[k]; amax = fmaxf(amax, fmaxf(fabsf(y0[k]), fabsf(y1[k]))); } } }
        if (which == 0) {
            amax = fmaxf(amax, __shfl_xor(amax, 1)); amax = fmaxf(amax, __shfl_xor(amax, 2)); amax = fmaxf(amax, __shfl_xor(amax, 8)); amax = fmaxf(amax, __shfl_xor(amax, 16)); amax = fmaxf(amax, __shfl_xor(amax, 32));
            const float inv = (amax > 0.f) ? 127.f / amax : 0.f;
            if (j == 0 && sl == 0) ((float*)(ws + WS_SX))[row] = (amax > 0.f) ? amax * (1.f / 127.f) : 1.f;
            unsigned char* xq = ws + WS_XQ + (size_t)row * 64 + (sl & 1) * 32 + j * 8;
#pragma unroll
            for (int i = 0; i < 8; ++i) { int q[8];
#pragma unroll
                for (int k = 0; k < 8; ++k) q[k] = (int)__builtin_rintf(v[8 * i + k] * inv);
                v2u o; o.x = (unsigned)(q[0] & 255) | ((unsigned)(q[1] & 255) << 8) | ((unsigned)(q[2] & 255) << 16) | ((unsigned)q[3] << 24);
                o.y = (unsigned)(q[4] & 255) | ((unsigned)(q[5] & 255) << 8) | ((unsigned)(q[6] & 255) << 16) | ((unsigned)q[7] << 24);
                *(v2u*)(xq + (size_t)(4 * i + (sl >> 1)) * T * 64) = o; } }
    }
}

constexpr int PK_TV = 0, PK_EID = 65536, PK_GATE = 81920;
__device__ __forceinline__ int f2key(float x) { const int b = __float_as_int(x); return b ^ ((b >> 31) & 0x7fffffff); }
__device__ __forceinline__ float key2f(int k) { return __int_as_float(k ^ ((k >> 31) & 0x7fffffff)); }
__device__ __forceinline__ int imed3(int a, int b, int c) { int r; asm("v_med3_i32 %0, %1, %2, %3" : "=v"(r) : "v"(a), "v"(b), "v"(c)); return r; }
#define INSK(kx) do { const int _x = (kx); _Pragma("unroll") for (int _k = 15; _k > 0; --_k) tk[_k] = imed3(tk[_k - 1], tk[_k], _x); tk[0] = max(tk[0], _x); } while (0)
__device__ __forceinline__ void phase_topk(const Frame& F0, int l) {
    Frame F = F0; F.tid = F.wave * 64 + lane_id(); asm volatile("" : "+v"(F.tid)); F.lane = F.tid & 63;
    unsigned char* ws = opqg(F.ws);
    const float* SC = (const float*)(ws + WS_SC); int* SEID = (int*)(ws + WS_SEID); float* SGATE = (float*)(ws + WS_SGATE); unsigned char* START = ws + WS_START;
    LAS int* TK = (LAS int*)(F.lds + PK_TV); LAS int* EIDL = (LAS int*)(F.lds + PK_EID); LAS float* GATEL = (LAS float*)(F.lds + PK_GATE);
    for (int tb = F.vcu; tb < T / 32; tb += F.G) {
        const int t0 = tb * 32;
        { const int tok = F.tid >> 4, hh = F.tid & 15;
          const v4u* sp = (const v4u*)((const bf16*)SC + (size_t)(t0 + tok) * 2048 + hh * 128);
          int tk[16];
#pragma unroll
          for (int k = 0; k < 16; ++k) tk[k] = (int)0x80000000;
#pragma unroll 2
          for (int i = 0; i < 16; ++i) { const v4u s0 = sp[i]; const unsigned sw[4] = {s0.x, s0.y, s0.z, s0.w};
#pragma unroll
              for (int x = 0; x < 4; ++x) { INSK((f2key(bf_lo(sw[x])) & ~127) | (127 - (8 * i + 2 * x))); INSK((f2key(bf_hi(sw[x])) & ~127) | (127 - (8 * i + 2 * x + 1))); } }
#pragma unroll
          for (int k = 0; k < 16; ++k) TK[F.tid * 16 + k] = tk[k]; }
        __syncthreads();
        if ((F.tid & 1) == 0) {
            float v1[16], v2[16];
#pragma unroll
            for (int k = 0; k < 16; ++k) { v1[k] = key2f(TK[F.tid * 16 + k] & ~127); v2[k] = key2f(TK[(F.tid + 1) * 16 + k] & ~127); }
            int tk[16];
#pragma unroll
            for (int k = 0; k < 16; ++k) tk[k] = (int)0x80000000;
#pragma unroll
            for (int aa = 0; aa < 16; ++aa)
#pragma unroll
                for (int bb = 0; bb < 16; ++bb) if ((aa + 1) * (bb + 1) <= 16) { INSK((f2key(v1[aa] + v2[bb]) & ~255) | (255 - (aa * 16 + bb))); }
            float ex[16], sum = 0.f; const float v0 = key2f(tk[0] & ~255);
#pragma unroll
            for (int k = 0; k < 16; ++k) { ex[k] = expf(key2f(tk[k] & ~255) - v0); sum += ex[k]; }
            const float inv = 1.f / sum;
            const int tok = F.tid >> 4, hd = (F.tid >> 1) & 7;
#pragma unroll
            for (int k = 0; k < 16; ++k) { const int code = 255 - (tk[k] & 255);
                const int i1 = 127 - (TK[F.tid * 16 + (code >> 4)] & 127), i2 = 127 - (TK[(F.tid + 1) * 16 + (code & 15)] & 127);
                EIDL[tok * 128 + hd * 16 + k] = (((i1 + i2) & 15) << 10) + i1 * 8 + (i2 >> 4); GATEL[tok * 128 + hd * 16 + k] = ex[k] * inv; }
        }
        __syncthreads();
        for (int ti = 0; ti < 4; ++ti) {
            const int tok = F.wave * 4 + ti;
            int k0 = (EIDL[tok * 128 + F.lane] << 7) | F.lane, k1 = (EIDL[tok * 128 + 64 + F.lane] << 7) | (64 + F.lane);
#pragma unroll
            for (int k = 2; k <= 128; k <<= 1)
#pragma unroll
                for (int j = k >> 1; j > 0; j >>= 1) {
                    if (j == 64) { const int mn = min(k0, k1), mx = max(k0, k1); k0 = mn; k1 = mx; }
                    else { const int o0 = __shfl_xor(k0, j), o1 = __shfl_xor(k1, j); const bool lower = (F.lane & j) == 0;
                        const bool up0 = (F.lane & k) == 0, up1 = ((64 + F.lane) & k) == 0;
                        k0 = (up0 == lower) ? min(k0, o0) : max(k0, o0); k1 = (up1 == lower) ? min(k1, o1) : max(k1, o1); }
                }
            const size_t t = (size_t)(t0 + tok);
            { const int r0 = k0 >> 17, r1 = k1 >> 17; int mine = 0;
#pragma unroll
              for (int r = 1; r < 16; ++r) { const int c = __builtin_popcountll(__ballot(r0 < r)) + __builtin_popcountll(__ballot(r1 < r)); mine = (F.lane == r) ? c : mine; }
              if (F.lane < 16) START[t * 16 + F.lane] = (unsigned char)mine; }
            SEID[t * LP + F.lane] = k0 >> 7; SEID[t * LP + 64 + F.lane] = k1 >> 7;
            SGATE[t * 128 + F.lane] = GATEL[tok * 128 + (k0 & 127)]; SGATE[t * 128 + 64 + F.lane] = GATEL[tok * 128 + (k1 & 127)];
        }
        __syncthreads();
    }
}
typedef __bf16 bf2_t __attribute__((ext_vector_type(2)));
__device__ __forceinline__ float dot2bf(unsigned a, unsigned b, float c) { return __builtin_amdgcn_fdot2_f32_bf16(__builtin_bit_cast(bf2_t, a), __builtin_bit_cast(bf2_t, b), c, false); }
__device__ __forceinline__ void peer_stage(const Frame& F, const bf16* gsrc, int bo) {
#pragma unroll
    for (int i = 0; i < 8; ++i) { const int p = i * 8 + F.wave;
        __builtin_amdgcn_global_load_lds((const unsigned*)((const char*)gsrc + p * 1024 + F.lane * 16), (LAS unsigned*)(F.lds + bo + p * 1024), 16, 0, 0); }
}
__device__ __forceinline__ void peer_dma(const Frame& F, const void* gsrc, int bo) {
    const unsigned ldsbase = (unsigned)(size_t)(F.lds + bo) + (unsigned)F.wave * 1024u;
#pragma unroll
    for (int i = 0; i < 8; ++i) { const char* g = (const char*)gsrc + (i * 8 + F.wave) * 1024 + F.lane * 16; const unsigned m = ldsbase + i * 8192u;
        asm volatile("s_mov_b32 m0, %0\n\ts_nop 0\n\tglobal_load_lds_dwordx4 %1, off" :: "s"(m), "v"((GAS const char*)g) : "memory"); }
}
__device__ __forceinline__ int wave_max_i(int v) {
#pragma unroll
    for (int o = 1; o < 64; o <<= 1) v = max(v, __shfl_xor(v, o));
    return __builtin_amdgcn_readfirstlane(v);
}
template <int K> __device__ __forceinline__ unsigned dppq(unsigned v) { return (unsigned)__builtin_amdgcn_mov_dpp((int)v, K * 0x55, 0xf, 0xf, true); }
__device__ __forceinline__ int sdot4(unsigned a, unsigned b, int c) { return __builtin_amdgcn_sdot4((int)a, (int)b, c, false); }
__device__ __forceinline__ int quad_sum_i(int v) {
    v += __builtin_amdgcn_mov_dpp(v, 0xB1, 0xf, 0xf, true);
    v += __builtin_amdgcn_mov_dpp(v, 0x4E, 0xf, 0xf, true);
    return v;
}
__device__ __forceinline__ float quad_sum(float v) {
    v += __int_as_float(__builtin_amdgcn_mov_dpp(__float_as_int(v), 0xB1, 0xf, 0xf, true));
    v += __int_as_float(__builtin_amdgcn_mov_dpp(__float_as_int(v), 0x4E, 0xf, 0xf, true));
    return v;
}
constexpr int UCAP0 = 24, UCAP1 = 12, UCAP2 = 12, UCAP3 = 8;
__device__ __forceinline__ void phase_peer_u(const Frame& F0, int l) {
    Frame F = F0; F.tid = F.wave * 64 + lane_id(); asm volatile("" : "+v"(F.tid)); F.lane = F.tid & 63;
    unsigned char* ws = opqg(F.ws);
    const bf16* TU = (const bf16*)(ws + WS_TBU) + (size_t)l * 32 * NEXP * 32;
    const int* SEID = (const int*)(ws + WS_SEID); const float* SGATE = (const float*)(ws + WS_SGATE); unsigned* PACK = (unsigned*)(ws + WS_PACK); unsigned char* START = ws + WS_START;
    const bf16* XBS = (const bf16*)(ws + WS_XQ); unsigned* PACK2 = (unsigned*)(ws + WS_PACK2);
    const float* SX = (const float*)(ws + WS_SX); const float* SU = (const float*)(ws + WS_SU) + (size_t)l * NEXP;
    const int qd = F.lane >> 2, jc = F.lane & 3;
    for (int unit = F.vcu; unit < 256; unit += F.G) {
        const int tt = unit & 15, er = unit >> 4; const size_t t = (size_t)tt * 512 + F.tid;
        const int lo = START[t * 16 + er], hi = (er < 15) ? (int)START[t * 16 + er + 1] : 128;
        const int cnt = hi - lo;
        int key = (cnt << 6) | (63 - F.lane);
#pragma unroll
        for (int k = 2; k <= 64; k <<= 1)
#pragma unroll
            for (int j = k >> 1; j > 0; j >>= 1) { const int o = __shfl_xor(key, j); const bool lower = (F.lane & j) == 0, up = (F.lane & k) == 0;
                key = (up == lower) ? max(key, o) : min(key, o); }
        int tl[4], glo[4], gcnt[4], gmax[4];
#pragma unroll
        for (int a = 0; a < 4; ++a) { const int kk = __shfl(key, a * 16 + qd); tl[a] = 63 - (kk & 63); gcnt[a] = kk >> 6; glo[a] = __shfl(lo, tl[a]);
            gmax[a] = __builtin_amdgcn_readfirstlane(__shfl(key, a * 16)) >> 6; }
        const size_t tbase = (size_t)tt * 512 + F.wave * 64;
        unsigned ro0[UCAP0 / 4], ro1[UCAP1 / 4], ro2[UCAP2 / 4], ro3[UCAP3 / 4];
#define LOADRO(arr, a, CAP) _Pragma("unroll") for (int i = 0; i < CAP / 4; ++i) { const int s = 4 * i + jc; const int e = SEID[(tbase + tl[a]) * LP + glo[a] + s]; \
            const int row = (s < gcnt[a]) ? (e & 1023) : 0; arr[i] = (unsigned)((row << 6) + (((row >> 2) & 3) << 4)); }
        LOADRO(ro0, 0, UCAP0) LOADRO(ro1, 1, UCAP1) LOADRO(ro2, 2, UCAP2) LOADRO(ro3, 3, UCAP3)
#undef LOADRO
        int ac0[UCAP0], ac1[UCAP1], ac2[UCAP2], ac3[UCAP3];
#pragma unroll
        for (int s = 0; s < UCAP0; ++s) ac0[s] = 0;
#pragma unroll
        for (int s = 0; s < UCAP1; ++s) ac1[s] = 0;
#pragma unroll
        for (int s = 0; s < UCAP2; ++s) ac2[s] = 0;
#pragma unroll
        for (int s = 0; s < UCAP3; ++s) ac3[s] = 0;
        const bf16* gsl0 = TU + (size_t)er * 1024 * 32;
#define XA(a) ((const v4u*)(XBS + (tbase + tl[a]) * 32) + jc)
        v4u xs[4];
#pragma unroll
        for (int a = 0; a < 4; ++a) xs[a] = XA(a)[0];
        peer_dma(F, gsl0, 0);
        VM_WAIT(); __syncthreads();
#pragma unroll 1
        for (int ks = 0; ks < 32; ++ks) {
            const int bo = (ks & 1) * 65536, jx = jc << 4;
            v4u xn[4];
            const int kn = (ks + 1 < 32) ? ks + 1 : ks;
#pragma unroll
            for (int a = 0; a < 4; ++a) xn[a] = XA(a)[(size_t)kn * T * 4];
            if (ks + 1 < 32) peer_dma(F, gsl0 + (size_t)kn * NEXP * 32, bo ^ 65536);
#define URD(B, arr, g) { asm volatile("" : "+v"(arr[g])); B[0] = *(const LAS v4u*)(F.lds + bo + (dppq<0>(arr[g]) ^ jx)); B[1] = *(const LAS v4u*)(F.lds + bo + (dppq<1>(arr[g]) ^ jx)); \
                B[2] = *(const LAS v4u*)(F.lds + bo + (dppq<2>(arr[g]) ^ jx)); B[3] = *(const LAS v4u*)(F.lds + bo + (dppq<3>(arr[g]) ^ jx)); }
#define UCP(B, acc, a, g) { _Pragma("unroll") for (int q = 0; q < 4; ++q) { int p0 = acc[4 * (g) + q]; \
                p0 = sdot4(B[q].x, xs[a].x, p0); p0 = sdot4(B[q].y, xs[a].y, p0); p0 = sdot4(B[q].z, xs[a].z, p0); p0 = sdot4(B[q].w, xs[a].w, p0); acc[4 * (g) + q] = p0; } }
            { v4u BE[4], BO[4];
              URD(BE, ro0, 0) __builtin_amdgcn_sched_barrier(0);
              URD(BO, ro0, 1) UCP(BE, ac0, 0, 0)
              __builtin_amdgcn_sched_barrier(0);
              URD(BE, ro0, 2) UCP(BO, ac0, 0, 1)
              __builtin_amdgcn_sched_barrier(0);
              URD(BO, ro0, 3) UCP(BE, ac0, 0, 2)
              __builtin_amdgcn_sched_barrier(0);
              URD(BE, ro0, 4) UCP(BO, ac0, 0, 3)
              __builtin_amdgcn_sched_barrier(0);
              URD(BO, ro0, 5) UCP(BE, ac0, 0, 4)
              __builtin_amdgcn_sched_barrier(0);
              URD(BE, ro1, 0) UCP(BO, ac0, 0, 5)
              __builtin_amdgcn_sched_barrier(0);
              URD(BO, ro1, 1) UCP(BE, ac1, 1, 0)
              __builtin_amdgcn_sched_barrier(0);
              URD(BE, ro1, 2) UCP(BO, ac1, 1, 1)
              __builtin_amdgcn_sched_barrier(0);
              URD(BO, ro2, 0) UCP(BE, ac1, 1, 2)
              __builtin_amdgcn_sched_barrier(0);
              URD(BE, ro2, 1) UCP(BO, ac2, 2, 0)
              __builtin_amdgcn_sched_barrier(0);
              URD(BO, ro2, 2) UCP(BE, ac2, 2, 1)
              __builtin_amdgcn_sched_barrier(0);
              URD(BE, ro3, 0) UCP(BO, ac2, 2, 2)
              __builtin_amdgcn_sched_barrier(0);
              URD(BO, ro3, 1) UCP(BE, ac3, 3, 0)
              __builtin_amdgcn_sched_barrier(0);
              UCP(BO, ac3, 3, 1) }
#undef URD
#undef UCP
#pragma unroll
            for (int a = 0; a < 4; ++a) xs[a] = xn[a];
            VM_WAIT(); __syncthreads();
        }
        float gt0[UCAP0 / 4], gt1[UCAP1 / 4], gt2[UCAP2 / 4], gt3[UCAP3 / 4];
        float sq0[UCAP0 / 4], sq1[UCAP1 / 4], sq2[UCAP2 / 4], sq3[UCAP3 / 4];
#define UGT(gt, sq, arr, a, CAP) { const float* gp_ = SGATE + (tbase + tl[a]) * 128; const float sx_ = SX[tbase + tl[a]]; _Pragma("unroll") for (int i = 0; i < CAP / 4; ++i) { gt[i] = gp_[min(glo[a] + 4 * i + jc, 127)]; sq[i] = sx_ * SU[er * 1024 + (int)(arr[i] >> 6)]; } }
        UGT(gt0, sq0, ro0, 0, UCAP0) UGT(gt1, sq1, ro1, 1, UCAP1) UGT(gt2, sq2, ro2, 2, UCAP2) UGT(gt3, sq3, ro3, 3, UCAP3)
#undef UGT
#define UOUT(arr, acc, gt, sq, a, CAP) { const size_t tk = tbase + tl[a]; _Pragma("unroll") for (int s = 0; s < CAP; ++s) { const int toti = quad_sum_i(acc[s]); \
            if ((s & 3) == jc && s < NSLOT) { unsigned wv = 0u; if (s < gcnt[a]) { const float av = gelu_tanh((float)toti * sq[s >> 2]) * gt[s >> 2]; wv = (arr[s >> 2] << 16) | (cvt_pk_f16(av, 0.f) & 0xffffu); } \
                PACK2[(tk * 16 + er) * NSLOT + s] = wv; } } \
            _Pragma("unroll") for (int s = CAP; s < NSLOT; ++s) if ((s & 3) == jc && s >= gcnt[a]) PACK2[(tk * 16 + er) * NSLOT + s] = 0u; }
        UOUT(ro0, ac0, gt0, sq0, 0, UCAP0) UOUT(ro1, ac1, gt1, sq1, 1, UCAP1) UOUT(ro2, ac2, gt2, sq2, 2, UCAP2) UOUT(ro3, ac3, gt3, sq3, 3, UCAP3)
#undef UOUT
#undef XA
        { int myrank = 0; const int mykey = (cnt << 6) | (63 - F.lane);
          for (int p = 0; p < 64; ++p) myrank += (__shfl(key, p) > mykey) ? 1 : 0;
          const int cap = myrank < 16 ? UCAP0 : (myrank < 32 ? UCAP1 : (myrank < 48 ? UCAP2 : UCAP3));
          const v4u* xsp = (const v4u*)(XBS + t * 32);
          for (int s = cap; s < cnt; ++s) {
              const int pos = lo + s, e = SEID[t * LP + pos]; const int f = (e >> 2) & 3; int di = 0;
              for (int ks = 0; ks < 32; ++ks)
#pragma unroll
                  for (int j = 0; j < 4; ++j) { const v4u u4 = *(const v4u*)(TU + (((size_t)ks * NEXP + e) * 4 + (j ^ f)) * 8); const v4u x4 = xsp[(size_t)ks * T * 4 + j];
                      di = sdot4(u4.x, x4.x, di); di = sdot4(u4.y, x4.y, di); di = sdot4(u4.z, x4.z, di); di = sdot4(u4.w, x4.w, di); }
              const float d = (float)di * SX[t] * SU[e];
              const int row = e & 1023;
              const unsigned wv = ((unsigned)((row << 6) + (((row >> 2) & 3) << 4)) << 16) | (cvt_pk_f16(gelu_tanh(d) * SGATE[t * 128 + pos], 0.f) & 0xffffu);
              if (s < NSLOT) PACK2[(t * 16 + er) * NSLOT + s] = wv; else PACK[t * LP + pos] = wv; }
        }
    }
}
#ifndef VBLK
#define VBLK 2
#endif
#if VBLK == 4
#define VTT(x, j) (4 * ((x) & 3) + ((j) & 3))
#define VDS(x, j, it) (32 * ((x) >> 2) + 8 * (it) + ((j) >> 2))
#elif VBLK == 8
#define VTT(x, j) (8 * ((x) & 1) + ((j) & 7))
#define VDS(x, j, it) (16 * ((x) >> 1) + 4 * (it) + ((j) >> 3))
#elif VBLK == 2
#define VTT(x, j) (2 * (x) + ((j) & 1))
#define VDS(x, j, it) (16 * (it) + ((j) >> 1))
#else
#define VTT(x, j) ((j) & 15)
#define VDS(x, j, it) (((x) * 32 + (j) + 256 * (it)) >> 4)
#endif
__device__ __forceinline__ void phase_peer_v(const Frame& F0, int l) {
    Frame F = F0; F.tid = F.wave * 64 + lane_id(); asm volatile("" : "+v"(F.tid)); F.lane = F.tid & 63;
    unsigned char* ws = opqg(F.ws);
    const bf16* TV = (const bf16*)(ws + WS_TBV) + (size_t)l * 64 * NEXP * 32; const bf16* XS = (const bf16*)(ws + WS_XH); bf16* RS = (bf16*)(ws + WS_RH);
    const unsigned* PACK = (const unsigned*)(ws + WS_PACK); const unsigned char* START = ws + WS_START; const unsigned* PACK2 = (const unsigned*)(ws + WS_PACK2);
    for (int it = 0; it * F.G + F.vcu < 1024; ++it) {
        int tt, ds;
        if (F.G == 256) { const int x = F.vcu >> 5, j = F.vcu & 31; tt = VTT(x, j); ds = VDS(x, j, it); }
        else { const int unit = it * F.G + F.vcu; tt = unit & 15; ds = unit >> 4; }
        const size_t t = (size_t)tt * 512 + F.tid;
        const v4u st4 = *(const v4u*)(START + t * 16);
        const unsigned stw[4] = {st4.x, st4.y, st4.z, st4.w};
        unsigned acc[16];
#pragma unroll
        for (int i = 0; i < 16; ++i) acc[i] = 0u;
        const bf16* gsl0 = TV + (size_t)ds * NEXP * 32;
        unsigned Lc[NSLOT];
        { const v4u* lp = (const v4u*)(PACK2 + t * 16 * NSLOT);
#pragma unroll
          for (int s = 0; s < NSLOT / 4; ++s) { const v4u q = lp[s]; Lc[4 * s] = q.x; Lc[4 * s + 1] = q.y; Lc[4 * s + 2] = q.z; Lc[4 * s + 3] = q.w; } }
        peer_dma(F, gsl0, 0);
        VM_WAIT(); __syncthreads();
#pragma unroll 1
        for (int c = 0; c < 16; ++c) {
            const int bo = (c & 1) * 65536;
            const int q0 = c >> 2, q1 = (c + 1) >> 2;
            const unsigned w0 = q0 == 0 ? stw[0] : (q0 == 1 ? stw[1] : (q0 == 2 ? stw[2] : stw[3])), w1 = q1 == 0 ? stw[0] : (q1 == 1 ? stw[1] : (q1 == 2 ? stw[2] : stw[3]));
            const int s_c = (int)((w0 >> ((c & 3) * 8)) & 255u);
            const int s_n = (c < 15) ? (int)((w1 >> (((c + 1) & 3) * 8)) & 255u) : 128;
            const int n_c = s_n - s_c;
            unsigned Ln[NSLOT];
            const int cn = (c < 15) ? c + 1 : c;
            { const v4u* lp = (const v4u*)(PACK2 + (t * 16 + cn) * NSLOT);
#pragma unroll
              for (int s = 0; s < NSLOT / 4; ++s) { const v4u q = lp[s]; Ln[4 * s] = q.x; Ln[4 * s + 1] = q.y; Ln[4 * s + 2] = q.z; Ln[4 * s + 3] = q.w; } }
            if (c < 15) peer_dma(F, gsl0 + (size_t)cn * 1024 * 32, bo ^ 65536);
            const int wmax = wave_max_i(min(n_c, NSLOT));
#pragma unroll
            for (int g = 0; g < NSLOT / 2; ++g) {
                if (2 * g < wmax) {
                    v4u v4[2][4]; unsigned a2[2];
#pragma unroll
                    for (int q = 0; q < 2; ++q) { const int s = 2 * g + q; const unsigned w = Lc[s];
                        a2[q] = __builtin_amdgcn_perm(w, w, 0x01000100u);
                        const int a0 = bo + (int)((w >> 16) & 0xfff0u);
#pragma unroll
                        for (int j = 0; j < 4; ++j) v4[q][j] = *(const LAS v4u*)(F.lds + (a0 ^ (j << 4))); }
#pragma unroll
                    for (int q = 0; q < 2; ++q)
#pragma unroll
                        for (int j = 0; j < 4; ++j) {
                            acc[4 * j + 0] = pkfmah(v4[q][j].x, a2[q], acc[4 * j + 0]); acc[4 * j + 1] = pkfmah(v4[q][j].y, a2[q], acc[4 * j + 1]);
                            acc[4 * j + 2] = pkfmah(v4[q][j].z, a2[q], acc[4 * j + 2]); acc[4 * j + 3] = pkfmah(v4[q][j].w, a2[q], acc[4 * j + 3]); }
                }
            }
            for (int s = NSLOT; s < n_c; ++s) {
                const unsigned w = PACK[t * LP + s_c + s]; const unsigned a2 = (w & 0xffffu) | (w << 16);
                const int a0 = bo + (int)((w >> 16) & 0xfff0u);
#pragma unroll
                for (int j = 0; j < 4; ++j) { const v4u v4 = *(const LAS v4u*)(F.lds + (a0 ^ (j << 4)));
                    acc[4 * j + 0] = pkfmah(v4.x, a2, acc[4 * j + 0]); acc[4 * j + 1] = pkfmah(v4.y, a2, acc[4 * j + 1]);
                    acc[4 * j + 2] = pkfmah(v4.z, a2, acc[4 * j + 2]); acc[4 * j + 3] = pkfmah(v4.w, a2, acc[4 * j + 3]); }
            }
            VM_WAIT(); __syncthreads();
#pragma unroll
            for (int s = 0; s < NSLOT; ++s) Lc[s] = Ln[s];
        }
        const v4u* xp = (const v4u*)(XS + ((size_t)ds * T + t) * 32); v4u* rp = (v4u*)(RS + ((size_t)ds * T + t) * 32);
        v4u xw4[4];
#pragma unroll
        for (int j = 0; j < 4; ++j) xw4[j] = xp[j];
#pragma unroll
        for (int j = 0; j < 4; ++j) { const v4u xw = xw4[j]; const unsigned xx[4] = {xw.x, xw.y, xw.z, xw.w}; unsigned o[4];
#pragma unroll
            for (int k = 0; k < 4; ++k) { const h2_t xv = __builtin_bit_cast(h2_t, xx[k]), yv = __builtin_bit_cast(h2_t, acc[4 * j + k]);
                o[k] = cvt_pk_f16((float)xv.x * ALPHA + (float)yv.x, (float)xv.y * ALPHA + (float)yv.y); }
            rp[j] = (v4u){o[0], o[1], o[2], o[3]}; }
    }
}

constexpr int PH_PER_LAYER = 13, N_PHASES = 2 + DEPTH * PH_PER_LAYER;
__global__ void __launch_bounds__(512, 2) fwd_kernel(Args args) {
    extern __shared__ __attribute__((aligned(16))) unsigned char lds[];
    Frame F;
    F.lds = (LAS unsigned char*)lds;
    F.wave = __builtin_amdgcn_readfirstlane((int)threadIdx.x >> 6); F.tid = 0; F.lane = 0;
    F.G = gridDim.x; { const int bx = blockIdx.x; F.vcu = (F.G % 8 == 0) ? (bx % 8) * (F.G / 8) + bx / 8 : bx; }
    F.ws = args.ws; F.ka = (const __attribute__((address_space(4))) Args*)__builtin_amdgcn_kernarg_segment_ptr();
    unsigned char* ws = args.ws;
    for (int u = F.wave * 64 + lane_id(); u < (LDS_BYTES - LDSCTL_OFF) / 4; u += 512) ((LAS unsigned*)(F.lds + LDSCTL_OFF))[u] = 0u;
    __syncthreads();
    XcdBarrier bar; bar.bar = (unsigned*)(ws + WS_CTL) + CW_BAR; bar.x = 0; bar.st = nullptr;
    const int lo = args.ph_lo, hi = args.ph_hi;
    if (hi - lo > 1) bar = xcd_barrier_post((unsigned*)(ws + WS_CTL) + CW_BAR, (volatile LAS unsigned*)(F.lds + MISC_OFF) + 8, F.wave == 0 && lane_id() == 0);
#ifndef PHMASK
#define PHMASK 0xFFF
#endif
#define EN(i) ((PHMASK >> (i)) & 1)
#ifndef RPT
#define RPT 0
#endif
#define REP(i) for (int _r = 0; _r <= ((RPT >> (i)) & 1); ++_r)
#define IN(k) (lo <= (k) && (k) < hi)
#define SEAM(k) do { if (IN((k) + 1)) xcd_barrier(bar, F.wave); } while (0)

    if (EN(10) && IN(0)) { REP(13) { phase_prologue_a(F); } SEAM(0); }
    if (EN(11) && IN(1)) REP(14) {
        phase_prologue_b(F);
        unsigned char* ws = opqg(args.ws);
        int kc = 256; asm volatile("" : "+s"(kc));
        pg8::Gemm g{(const bf16*)(ws + WS_BK), (const bf16*)(ws + WS_WQB), DEPTH * 2048, 2048, kc, 256, 2048, 256, (long)2048 * 2048};
        pg8::StaticOrder S; S.init(DEPTH * 2048, 2048, F.G, (int)blockIdx.x);
        pg8::EpiF16 E{(bf16*)(ws + WS_WPQ), 2048};
        pg8::gemm_phase<pg8::EpiF16, pg8::StaticOrder, true>(F.lds, g, S, E, F.wave);
        if (_r == ((RPT >> 14) & 1)) SEAM(1);
    }
    for (int l = 0; l < DEPTH; ++l) {
        const int pb = 2 + l * PH_PER_LAYER;
        if (EN(0) && IN(pb + 0)) REP(0) {
            unsigned char* ws = opqg(args.ws);
            pg8::Gemm g{(const bf16*)(ws + WS_XH), (const bf16*)(ws + WS_WIN) + (size_t)l * NIN * D, T, NIN, D, T, D, 0, 0};
            pg8::StaticOrder S; S.init(T, (F.G == 256) ? 32 * 256 : NIN, F.G, (int)blockIdx.x);
            pg8::EpiIn E{(bf16*)(ws + WS_Q), (bf16*)(ws + WS_KK), (bf16*)(ws + WS_V), (bf16*)(ws + WS_SG), (bf16*)(ws + WS_UB), (bf16*)(ws + WS_GR), (bf16*)(ws + WS_GB),
                         (float*)(ws + WS_LOGF), (const float*)(ws + WS_LB) + l * AW};
            pg8::gemm_phase<pg8::EpiIn, pg8::StaticOrder, true, true, true>(F.lds, g, S, E, F.wave);
            if (_r == ((RPT >> 0) & 1)) SEAM(pb + 0);
        }
        if (EN(1) && IN(pb + 1)) { REP(1) { REP(17) { phase_hgrn_local(F, l); } REP(18) { phase_s5_local(F, l); } } SEAM(pb + 1); }
        if (EN(2) && IN(pb + 2)) { REP(2) { phase_scan(F, l); } SEAM(pb + 2); }
        if (EN(3) && IN(pb + 3)) { REP(3) { REP(15) { phase_hgrn_out(F, l); } REP(16) { phase_s5_out(F, l); } } SEAM(pb + 3); }
        if (EN(4) && IN(pb + 4)) REP(4) {
            unsigned char* ws = opqg(args.ws);
            if (F.G == 256 && blockIdx.x < 128) {
                pg8::Gemm g{(const bf16*)(ws + WS_XH), (const bf16*)(ws + WS_WIN) + (size_t)l * NIN * D, T, NIN, D, T, D, 0, 0};
                pg8::OffOrder S; S.init(T, 4 * 256, F.G, (int)blockIdx.x, 32);
                pg8::EpiIn E{(bf16*)(ws + WS_Q), (bf16*)(ws + WS_KK), (bf16*)(ws + WS_V), (bf16*)(ws + WS_SG), (bf16*)(ws + WS_UB), (bf16*)(ws + WS_GR), (bf16*)(ws + WS_GB),
                             (float*)(ws + WS_LOGF), (const float*)(ws + WS_LB) + l * AW};
                pg8::gemm_phase<pg8::EpiIn, pg8::OffOrder, true, true, true>(F.lds, g, S, E, F.wave);
            } else {
                pg8::Gemm g{(const bf16*)(ws + WS_YB), (const bf16*)(ws + WS_WGLU) + (size_t)l * 2048 * 1024, T, 2048, 1024, 1024, 1024, 0, 0};
                pg8::EpiGlu E{(bf16*)(ws + WS_OAB) + 1024, 2048};
                if (F.G == 256) { pg8::PairOrder S{(int)blockIdx.x, 128, 8, 256}; pg8::gemm_phase<pg8::EpiGlu, pg8::PairOrder, true>(F.lds, g, S, E, F.wave); }
                else { pg8::StaticOrder S; S.init(T, 2048, F.G, (int)blockIdx.x); pg8::gemm_phase<pg8::EpiGlu, pg8::StaticOrder, true>(F.lds, g, S, E, F.wave); }
            }
            if (_r == ((RPT >> 4) & 1)) SEAM(pb + 4);
        }
        if (EN(5) && IN(pb + 5)) REP(5) {
            unsigned char* ws = opqg(args.ws);
            pg8::Gemm g{(const bf16*)(ws + WS_OAB), (const bf16*)(ws + WS_WUP) + (size_t)l * 2048 * 2048, T, 2048, 2048, 2048, 2048, 0, 0};
            pg8::StaticOrder S; S.init(T, 2048, F.G, (int)blockIdx.x);
            pg8::EpiUp E{(bf16*)(ws + WS_MG), (const bf16*)(ws + WS_GR), (const bf16*)(ws + WS_GB)};
            pg8::gemm_phase<pg8::EpiUp, pg8::StaticOrder, true>(F.lds, g, S, E, F.wave);
            if (_r == ((RPT >> 5) & 1)) SEAM(pb + 5);
        }
        if (EN(6) && IN(pb + 6)) REP(6) {
            unsigned char* ws = opqg(args.ws);
            pg8::Gemm g{(const bf16*)(ws + WS_MG), (const bf16*)(ws + WS_WO) + (size_t)l * 2048 * 2048, T, 2048, 2048, 2048, 2048, 0, 0};
            pg8::StaticOrder S; S.init(T, 2048, F.G, (int)blockIdx.x);
            pg8::EpiResH E{(bf16*)(ws + WS_RH), (const bf16*)(ws + WS_XH)};
            pg8::gemm_phase<pg8::EpiResH, pg8::StaticOrder, true>(F.lds, g, S, E, F.wave);
            if (_r == ((RPT >> 6) & 1)) SEAM(pb + 6);
        }
        if (EN(7) && IN(pb + 7)) { REP(7) { phase_ln(F, l, 0); } SEAM(pb + 7); }
        if (EN(8) && IN(pb + 8)) REP(8) {
            unsigned char* ws = opqg(args.ws);
            pg8::Gemm g{(const bf16*)(ws + WS_XH), (const bf16*)(ws + WS_WPQ) + (size_t)l * 2048 * 2048, T, 2048, 2048, T, 2048, 0, 0};
            pg8::StaticOrder S; S.init(T, 2048, F.G, (int)blockIdx.x);
            pg8::EpiBf16 E{(bf16*)(ws + WS_SC), 2048};
            pg8::gemm_phase<pg8::EpiBf16, pg8::StaticOrder, true, true, true>(F.lds, g, S, E, F.wave);
            if (_r == ((RPT >> 8) & 1)) SEAM(pb + 8);
        }
        if (EN(9) && IN(pb + 9)) { REP(9) { phase_topk(F, l); } SEAM(pb + 9); }
        if (EN(9) && IN(pb + 10)) { REP(10) { phase_peer_u(F, l); } SEAM(pb + 10); }
        if (EN(9) && IN(pb + 11)) { REP(11) { phase_peer_v(F, l); } SEAM(pb + 11); }
        if (EN(9) && IN(pb + 12)) { REP(12) { phase_ln(F, l, 1); } SEAM(pb + 12); }
    }
#undef IN
#undef SEAM
}

extern "C" void kernel_launch(void* const* d_in, const int* in_sizes, int n_in, void* d_out, int out_size, void* d_ws, size_t ws_size, hipStream_t stream) {
    static int grid = 0;
    if (grid == 0) {
        if (n_in != 24 || out_size != T * D || ws_size < WS_END) { fprintf(stderr, "kernel_launch: unexpected sizes (n_in %d out %d ws %zu need %zu)\n", n_in, out_size, ws_size, (size_t)WS_END); grid = -1; return; }
        int dev = 0, cus = 0, per_cu = 0;
        if (hipGetDevice(&dev) != hipSuccess || hipDeviceGetAttribute(&cus, hipDeviceAttributeMultiprocessorCount, dev) != hipSuccess) { grid = -1; return; }
        if (hipFuncSetAttribute((const void*)fwd_kernel, hipFuncAttributeMaxDynamicSharedMemorySize, LDS_BYTES) != hipSuccess) { fprintf(stderr, "kernel_launch: hipFuncSetAttribute failed\n"); grid = -1; return; }
        if (hipOccupancyMaxActiveBlocksPerMultiprocessor(&per_cu, (const void*)fwd_kernel, 512, LDS_BYTES) != hipSuccess || per_cu < 1)
            fprintf(stderr, "kernel_launch: occupancy query reports %d\n", per_cu);
        (void)hipGetLastError();
        grid = cus;
    }
    if (grid < 0) return;
    if (hipMemsetAsync((char*)d_ws + WS_CTL, 0, CTL_ZERO_BYTES, stream) != hipSuccess) return;
    Args a{};
    for (int i = 0; i < 24; ++i) a.in[i] = (const float*)d_in[i];
    a.out = (float*)d_out; a.ws = (unsigned char*)d_ws;
#if ONE_LAUNCH
    a.ph_lo = 0; a.ph_hi = N_PHASES;
    hipLaunchKernelGGL(fwd_kernel, dim3(grid), dim3(512), LDS_BYTES, stream, a);
#else
    for (int p = 0; p < N_PHASES; ++p) { a.ph_lo = p; a.ph_hi = p + 1; hipLaunchKernelGGL(fwd_kernel, dim3(grid), dim3(512), LDS_BYTES, stream, a); }
#endif
}
```

```cpp
#include <hip/hip_runtime.h>
#include <cstdio>
#include <cstdint>

#define LAS __attribute__((address_space(3)))
#define GAS __attribute__((address_space(1)))
typedef unsigned short bf16;
typedef unsigned v4u __attribute__((ext_vector_type(4)));
typedef unsigned v2u __attribute__((ext_vector_type(2)));
typedef float f32x4 __attribute__((ext_vector_type(4)));
typedef float f32x2 __attribute__((ext_vector_type(2)));
typedef short bf16x8 __attribute__((ext_vector_type(8)));
typedef short s16x4 __attribute__((ext_vector_type(4)));

#ifndef ONE_LAUNCH
#define ONE_LAUNCH 1
#endif

constexpr int T = 8192, D = 2048, DEPTH = 4, NIN = 9216;
constexpr int AW = 1024;
constexpr int NCH = 128;
constexpr float ALPHA = 1.6817928305074290f;
constexpr float LN_EPS = 1e-5f, RMS_EPS = 1e-6f;
constexpr int NEXP = 16384;
constexpr int LP = 160;
constexpr int NSLOT = 24;

constexpr size_t MiB = 1u << 20;
constexpr size_t WS_CTL = 0, CTL_ZERO_BYTES = 32768;
constexpr size_t WS_WIN  = 1 * MiB;
constexpr size_t WS_WGLU = WS_WIN + 144 * MiB;
constexpr size_t WS_WUP  = WS_WGLU + 16 * MiB;
constexpr size_t WS_WO   = WS_WUP + 32 * MiB;
constexpr size_t WS_WQB  = WS_WO + 32 * MiB;
constexpr size_t WS_BK   = WS_WQB + 32 * MiB;
constexpr size_t WS_WPQ  = WS_BK + 4 * MiB;
constexpr size_t WS_LB   = WS_WPQ + 32 * MiB;
constexpr size_t WS_APOW = WS_LB + 1 * MiB;
constexpr size_t WS_BB   = WS_APOW + 9 * MiB;
constexpr size_t WS_KMAT = WS_BB + 2 * MiB;
constexpr size_t WS_PM   = WS_KMAT + 9 * MiB;
constexpr size_t WS_E    = WS_PM + 64 * MiB;
constexpr size_t WS_X32  = WS_E + 64 * MiB;
constexpr size_t WS_X1   = WS_X32 + 64 * MiB;
constexpr size_t WS_XB   = WS_X1 + 64 * MiB;
constexpr size_t WS_Q    = WS_XB + 32 * MiB;
constexpr size_t WS_KK   = WS_Q + 16 * MiB;
constexpr size_t WS_V    = WS_KK + 16 * MiB;
constexpr size_t WS_SG   = WS_V + 16 * MiB;
constexpr size_t WS_UB   = WS_SG + 16 * MiB;
constexpr size_t WS_LOGF = WS_UB + 16 * MiB;
constexpr size_t WS_GR   = WS_LOGF + 32 * MiB;
constexpr size_t WS_GB   = WS_GR + 32 * MiB;
constexpr size_t WS_U    = WS_GB + 32 * MiB;
constexpr size_t WS_SP   = WS_U + 64 * MiB;
constexpr size_t WS_BL   = WS_SP + 32 * MiB;
constexpr size_t WS_XLOC = WS_BL + 1 * MiB;
constexpr size_t WS_XS   = WS_XLOC + 4 * MiB;
constexpr size_t WS_OAB  = WS_XS + 4 * MiB;
constexpr size_t WS_YB   = WS_OAB + 32 * MiB;
constexpr size_t WS_MG   = WS_YB + 16 * MiB;
constexpr size_t WS_R    = WS_MG + 32 * MiB;
constexpr size_t WS_SC   = WS_R + 64 * MiB;
constexpr size_t WS_TBU  = WS_SC + 64 * MiB;
constexpr size_t WS_TBV  = WS_TBU + 256 * MiB;
constexpr size_t WS_SEID = WS_TBV + 256 * MiB;
constexpr size_t WS_SGATE= WS_SEID + 6 * MiB;
constexpr size_t WS_PACK = WS_SGATE + 4 * MiB;
constexpr size_t WS_START= WS_PACK + 6 * MiB;
constexpr size_t WS_PACK2= WS_START + 1 * MiB;
constexpr size_t WS_XBS  = WS_PACK2 + 13 * MiB;
constexpr size_t WS_END  = WS_XBS + 32 * MiB;
constexpr size_t WS_XH = WS_XBS;
constexpr size_t WS_XQ = WS_X1;
constexpr size_t WS_SX = WS_X1 + 16 * MiB;
constexpr size_t WS_SU = WS_X1 + 17 * MiB;
constexpr size_t WS_RH = WS_R;

constexpr int CW_TMO = 0, CW_CODE = 1;
constexpr int CW_BAR = 4096;

constexpr int RING_BYTES = 131072;
constexpr int LDSCTL_OFF = RING_BYTES, MISC_OFF = LDSCTL_OFF + 320;
constexpr int LDS_BYTES = 147456;

#define LDS_WAIT() asm volatile("s_waitcnt lgkmcnt(0)" ::: "memory")
#define VM_WAIT() asm volatile("s_waitcnt vmcnt(0)" ::: "memory")
__device__ __forceinline__ unsigned cvt_pk_bf16(float lo, float hi) { unsigned r; asm volatile("v_cvt_pk_bf16_f32 %0, %1, %2" : "=v"(r) : "v"(lo), "v"(hi)); return r; }
typedef _Float16 h2_t __attribute__((ext_vector_type(2)));
__device__ __forceinline__ unsigned cvt_pk_f16a(float lo, float hi) { unsigned r; asm volatile("v_cvt_pk_f16_f32 %0, %1, %2" : "=v"(r) : "v"(lo), "v"(hi)); return r; }
__device__ __forceinline__ unsigned cvt_pk_f16(float lo, float hi) { h2_t p; p.x = (_Float16)lo; p.y = (_Float16)hi; return __builtin_bit_cast(unsigned, p); }
__device__ __forceinline__ float dot2h(unsigned a, unsigned b, float c) { return __builtin_amdgcn_fdot2(__builtin_bit_cast(h2_t, a), __builtin_bit_cast(h2_t, b), c, false); }
__device__ __forceinline__ unsigned pkfmah(unsigned a, unsigned b, unsigned c) { return __builtin_bit_cast(unsigned, __builtin_elementwise_fma(__builtin_bit_cast(h2_t, a), __builtin_bit_cast(h2_t, b), __builtin_bit_cast(h2_t, c))); }
__device__ __forceinline__ float bf_lo(unsigned u) { return __uint_as_float(u << 16); }
__device__ __forceinline__ float bf_hi(unsigned u) { return __uint_as_float(u & 0xffff0000u); }
__device__ __forceinline__ float bf2f(bf16 b) { return __uint_as_float(((unsigned)b) << 16); }
__device__ __forceinline__ bf16 f2bf(float f) { return (bf16)(cvt_pk_bf16(f, 0.f) & 0xffffu); }
__device__ __forceinline__ float fexp(float x) { return __builtin_amdgcn_exp2f(x * 1.4426950408889634f); }
__device__ __forceinline__ float flog(float x) { return __builtin_amdgcn_logf(x) * 0.6931471805599453f; }
__device__ __forceinline__ float frcp(float x) { return __builtin_amdgcn_rcpf(x); }
__device__ __forceinline__ float gelu_tanh(float x) {
    const float u = 1.5957691216057308f * (x + 0.044715f * x * x * x);
    const float uc = fminf(fmaxf(u, -60.f), 60.f);
    return x * frcp(1.f + fexp(-uc));
}
__device__ __forceinline__ int lane_id() { int r; asm volatile("v_mbcnt_lo_u32_b32 %0, -1, 0\n\tv_mbcnt_hi_u32_b32 %0, -1, %0" : "=v"(r)); return r; }
__device__ __forceinline__ float wave_sum(float v) {
#pragma unroll
    for (int o = 1; o < 64; o <<= 1) v += __shfl_xor(v, o);
    return v;
}

__device__ __forceinline__ void vlaunder(int& a, int& b) { asm volatile("" : "+v"(a), "+v"(b)); }
template <class P> __device__ __forceinline__ P* opq(P* p) { asm volatile("" : "+s"(p)); return p; }
__device__ __forceinline__ unsigned char* opqg(unsigned char* p) { GAS unsigned char* g = (GAS unsigned char*)p; asm volatile("" : "+s"(g)); return (unsigned char*)g; }
#define GP(T, p) ((T*)(GAS T*)(p))

namespace pg8 {
#define PG8_LAS __attribute__((address_space(3)))
typedef unsigned short bf16_t;
constexpr int BM = 256, BK = 64, HALF = 128, HTB = HALF * BK * 2, STAGE_BYTES = 8 * HTB, NXCD = 8, WGM = 8;

__host__ __device__ __forceinline__ int lds_byte(int r, int c) { const int st = (r >> 4) * 2 + (c >> 5), rr = r & 15, cc = c & 31, ob = rr * 64 + cc * 2; return st * 1024 + (ob ^ (((ob >> 9) & 1) << 5)); }
__host__ __device__ __forceinline__ void stage_rc(int b, int& R, int& C) { const int st = b / 1024, sb = b % 1024, swz = sb ^ (((sb >> 9) & 1) << 5); R = (st >> 1) * 16 + swz / 64; C = (st & 1) * 32 + (swz % 64) / 2; }
__host__ __device__ __forceinline__ int perm32(int rho) { const int n = rho >> 4, i = rho & 15; return 8 * (i >> 2) + 4 * n + (i & 3); }

struct Unit { int pm, pn; };
struct Gemm { const bf16_t* A; const bf16_t* Bt; int M, N, K, lda, ldb, bkoff; long blstride; };

struct StaticOrder {
    int nM, nN, nwg, G, c;
    __host__ __device__ void init(int M, int N, int G_, int c_) { nM = M / BM; nN = N / BM; nwg = nM * nN; G = G_; c = c_; }
    __host__ __device__ bool next(int i, Unit& u) const {
        const long L = (long)i * G + c; if (L >= nwg) return false;
        int wgid = (int)L; { const int q = nwg / NXCD, r = nwg % NXCD, xcd = wgid % NXCD, off = wgid / NXCD; wgid = (xcd < r ? xcd * (q + 1) : r * (q + 1) + (xcd - r) * q) + off; }
        const int nig = WGM * nN, gid = wgid / nig, fm = gid * WGM, gsz = (nM - fm) < WGM ? (nM - fm) : WGM;
        u.pm = fm + ((wgid % nig) % gsz); u.pn = (wgid % nig) / gsz; return true;
    }
    __device__ __forceinline__ void a_ready(const Unit&) const {}
    __device__ __forceinline__ void done(const Unit&) const {}
};

struct OffOrder {
    StaticOrder b; int pn0;
    __device__ void init(int M, int N, int G_, int c_, int pn0_) { b.init(M, N, G_, c_); pn0 = pn0_; }
    __device__ bool next(int i, Unit& u) const { if (!b.next(i, u)) return false; u.pn += pn0; return true; }
    __device__ __forceinline__ void a_ready(const Unit&) const {}
    __device__ __forceinline__ void done(const Unit&) const {}
};
struct PairOrder {
    int c, c0, nN, nwg;
    __device__ bool next(int i, Unit& u) const { if (c < c0 || i >= 2) return false; const int id = (c - c0) * 2 + i; if (id >= nwg) return false; u.pm = id / nN; u.pn = id % nN; return true; }
    __device__ __forceinline__ void a_ready(const Unit&) const {}
    __device__ __forceinline__ void done(const Unit&) const {}
};
typedef f32x4 Acc[2][2][4][2];

typedef _Float16 f16x8 __attribute__((ext_vector_type(8)));
template <class Epi, class Sched, bool ALIGN_EPI = false, bool F16 = false, bool ASL = false>
__device__ __forceinline__ void gemm_phase(PG8_LAS unsigned char* lds, const Gemm g, const Sched& S, const Epi& E, int wv) {
    int tid_ = wv * 64 + lane_id(); asm volatile("" : "+v"(tid_));
    const int tid = tid_, wid = __builtin_amdgcn_readfirstlane(tid >> 6), lane = tid & 63, wr = wid >> 2, wc = wid & 3, fr = lane & 15, fq = lane >> 4;
    const int K = g.K, nt = K / BK;
    unsigned voffA[2], voffB[2];
#pragma unroll
    for (int i = 0; i < 2; ++i) { int R, C; stage_rc(tid * 16 + i * 8192, R, C); const int Rb = Epi::PERM ? ((R & ~31) + perm32(R & 31)) : R;
        voffA[i] = ASL ? (unsigned)(((C >> 5) * g.lda + R) * 64 + (C & 31) * 2) : (unsigned)(R * g.lda + C) * 2u; voffB[i] = (unsigned)(Rb * g.ldb + C) * 2u; }
    const size_t kstep = (size_t)(BK * 2), kstepA = ASL ? (size_t)g.lda * 128 : (size_t)(BK * 2);
    const size_t hstepA = ASL ? (size_t)HALF * 64 : (size_t)HALF * g.lda * 2, hstepB = (size_t)HALF * g.ldb * 2;
    const size_t tstepA = 2 * hstepA, tstepB = 2 * hstepB;
    const unsigned ldsw = (unsigned)wid * 1024u;
    const int aoff = lds_byte(wr * 64 + fr, fq * 8), boff = lds_byte(wc * 32 + fr, fq * 8);
#define PG8_SA(b, h) (((b) * 2 + (h)) * HTB)
#define PG8_SB(b, h) ((4 + (b) * 2 + (h)) * HTB)
#define PG8_STAGE(bufoff, gbase, voff) do { _Pragma("unroll") for (int _i = 0; _i < 2; ++_i) \
        __builtin_amdgcn_global_load_lds((const unsigned*)((const char*)(gbase) + (voff)[_i]), (PG8_LAS unsigned*)(lds + (bufoff) + ldsw + _i * 8192), 16, 0, 0); } while (0)
#define PG8_LDA(dst, b, h) do { _Pragma("unroll") for (int m = 0; m < 4; ++m) _Pragma("unroll") for (int k = 0; k < 2; ++k) dst[m][k] = *(const PG8_LAS bf16x8*)(lds + PG8_SA(b, h) + aoff + m * 2048 + k * 1024); } while (0)
#define PG8_LDB(dst, b, h) do { _Pragma("unroll") for (int n = 0; n < 2; ++n) _Pragma("unroll") for (int k = 0; k < 2; ++k) dst[n][k] = *(const PG8_LAS bf16x8*)(lds + PG8_SB(b, h) + boff + n * 2048 + k * 1024); } while (0)
#define PG8_MMA(ai, bj, At, Bt) do { __builtin_amdgcn_s_setprio(1); _Pragma("unroll") for (int m = 0; m < 4; ++m) _Pragma("unroll") for (int n = 0; n < 2; ++n) _Pragma("unroll") for (int k = 0; k < 2; ++k) \
        { if constexpr (F16) acc[ai][bj][m][n] = __builtin_amdgcn_mfma_f32_16x16x32_f16(__builtin_bit_cast(f16x8, Bt[n][k]), __builtin_bit_cast(f16x8, At[m][k]), acc[ai][bj][m][n], 0, 0, 0); \
          else acc[ai][bj][m][n] = __builtin_amdgcn_mfma_f32_16x16x32_bf16(Bt[n][k], At[m][k], acc[ai][bj][m][n], 0, 0, 0); } __builtin_amdgcn_s_setprio(0); } while (0)
#define PG8_WAIT_V(n) asm volatile("s_waitcnt vmcnt(" #n ")" ::: "memory")
#define PG8_WAIT_L(n) asm volatile("s_waitcnt lgkmcnt(" #n ")" ::: "memory")
#define PG8_BAR __builtin_amdgcn_s_barrier()
#define PG8_SCHED __builtin_amdgcn_sched_barrier(0)
    Unit cur, nxt; int ui = 0;
    if (!S.next(0, cur)) return;
    Acc acc;
#pragma unroll
    for (int a = 0; a < 2; ++a)
#pragma unroll
        for (int b = 0; b < 2; ++b)
#pragma unroll
            for (int m = 0; m < 4; ++m)
#pragma unroll
                for (int n = 0; n < 2; ++n) acc[a][b][m][n] = (f32x4){0.f, 0.f, 0.f, 0.f};
    bf16x8 At[4][2], B0[2][2], B1[2][2];
    const char* cA = (const char*)g.A + (size_t)cur.pm * tstepA;
    const char* cB = (const char*)g.Bt + (size_t)cur.pn * tstepB + ((size_t)(cur.pm & 7) * g.bkoff + (size_t)(cur.pm >> 3) * g.blstride) * 2;
    S.a_ready(cur);
    PG8_STAGE(PG8_SB(0, 0), cB, voffB); PG8_STAGE(PG8_SB(0, 1), cB + hstepB, voffB); PG8_STAGE(PG8_SA(0, 0), cA, voffA); PG8_STAGE(PG8_SA(0, 1), cA + hstepA, voffA);
    if (wr == 1) PG8_BAR;
    PG8_WAIT_V(2); PG8_BAR;
    PG8_STAGE(PG8_SB(1, 0), cB + kstep, voffB); PG8_STAGE(PG8_SA(1, 0), cA + kstepA, voffA); PG8_STAGE(PG8_SB(1, 1), cB + hstepB + kstep, voffB);
    PG8_WAIT_V(6); PG8_BAR;
    for (;;) {
        const bool has_next = S.next(ui + 1, nxt);
        const char* nA = has_next ? (const char*)g.A + (size_t)nxt.pm * tstepA : cA;
        const char* nB = has_next ? (const char*)g.Bt + (size_t)nxt.pn * tstepB + ((size_t)(nxt.pm & 7) * g.bkoff + (size_t)(nxt.pm >> 3) * g.blstride) * 2 : cB;
        for (int t = 0; t < nt; t += 2) {
            const bool last = (t == nt - 2);
            const char* a1 = cA + (size_t)(t + 1) * kstepA;
            const char* a2 = last ? nA : cA + (size_t)(t + 2) * kstepA; const char* b2 = last ? nB : cB + (size_t)(t + 2) * kstep;
            const char* a3 = a2 + kstepA; const char* b3 = b2 + kstep;
            if (last && has_next) S.a_ready(nxt);
            PG8_LDB(B0, 0, 0); PG8_LDB(B1, 0, 1); PG8_SCHED; PG8_LDA(At, 0, 0); PG8_STAGE(PG8_SA(1, 1), a1 + hstepA, voffA);
            PG8_WAIT_V(8); PG8_WAIT_L(0); PG8_BAR; PG8_MMA(0, 0, At, B0); PG8_MMA(0, 1, At, B1); PG8_BAR; PG8_SCHED;
            PG8_LDA(At, 0, 1); PG8_STAGE(PG8_SB(0, 0), b2, voffB); PG8_STAGE(PG8_SB(0, 1), b2 + hstepB, voffB); PG8_STAGE(PG8_SA(0, 0), a2, voffA);
            PG8_WAIT_V(8); PG8_WAIT_L(0); PG8_BAR; PG8_MMA(1, 0, At, B0); PG8_MMA(1, 1, At, B1); PG8_BAR; PG8_SCHED;
            PG8_LDB(B0, 1, 0); PG8_LDB(B1, 1, 1); PG8_SCHED; PG8_LDA(At, 1, 0); PG8_STAGE(PG8_SA(0, 1), a2 + hstepA, voffA);
            PG8_WAIT_V(8); PG8_WAIT_L(0); PG8_BAR; PG8_MMA(0, 0, At, B0); PG8_MMA(0, 1, At, B1); PG8_BAR; PG8_SCHED;
            PG8_LDA(At, 1, 1); PG8_STAGE(PG8_SB(1, 0), b3, voffB); PG8_STAGE(PG8_SB(1, 1), b3 + hstepB, voffB); PG8_STAGE(PG8_SA(1, 0), a3, voffA);
            PG8_WAIT_V(8); PG8_WAIT_L(0); PG8_BAR; PG8_MMA(1, 0, At, B0); PG8_MMA(1, 1, At, B1); PG8_BAR; PG8_SCHED;
            if constexpr (Epi::HAS_MID) { if (t + 2 == (nt >> 1)) E.mid(acc, cur, wr, wc, fr, fq); }
        }
        if constexpr (ALIGN_EPI) { if (wr == 0) PG8_BAR; }
        E(acc, cur, wr, wc, fr, fq); S.done(cur);
        if (!has_next) break;
#pragma unroll
        for (int a = 0; a < 2; ++a)
#pragma unroll
            for (int b = 0; b < 2; ++b)
#pragma unroll
                for (int m = 0; m < 4; ++m)
#pragma unroll
                    for (int n = 0; n < 2; ++n) acc[a][b][m][n] = (f32x4){0.f, 0.f, 0.f, 0.f};
        cur = nxt; cA = nA; cB = nB; ++ui;
        if constexpr (ALIGN_EPI) { if (wr == 1) PG8_BAR; }
    }
    PG8_WAIT_V(0);
    if constexpr (!ALIGN_EPI) { if (wr == 0) PG8_BAR; }
    PG8_BAR;
#undef PG8_SA
#undef PG8_SB
#undef PG8_STAGE
#undef PG8_LDA
#undef PG8_LDB
#undef PG8_MMA
#undef PG8_WAIT_V
#undef PG8_WAIT_L
#undef PG8_BAR
#undef PG8_SCHED
}

struct EpiResH {
    static constexpr bool PERM = true, HAS_MID = false;
    bf16_t* RS; const bf16_t* XS;
    __device__ __forceinline__ void operator()(const Acc& acc, const Unit& u, int wr, int wc, int fr, int fq) const {
        vlaunder(fr, fq);
        const int row0 = u.pm * BM + wr * 64 + fr, sl0 = u.pn * 8 + wc;
#pragma unroll
        for (int ai = 0; ai < 2; ++ai) {
            v4u xw[4][2];
#pragma unroll
            for (int m = 0; m < 4; ++m)
#pragma unroll
                for (int bj = 0; bj < 2; ++bj) xw[m][bj] = *(const v4u*)(XS + ((size_t)(sl0 + bj * 4) * T + (row0 + ai * HALF + m * 16)) * 32 + 8 * fq);
#pragma unroll
            for (int m = 0; m < 4; ++m) {
#pragma unroll
                for (int bj = 0; bj < 2; ++bj) { const size_t eo = ((size_t)(sl0 + bj * 4) * T + (row0 + ai * HALF + m * 16)) * 32 + 8 * fq;
                    const f32x4 v0 = acc[ai][bj][m][0], v1 = acc[ai][bj][m][1];
                    const unsigned a0 = xw[m][bj].x, a1 = xw[m][bj].y, a2 = xw[m][bj].z, a3 = xw[m][bj].w;
                    const h2_t x0 = __builtin_bit_cast(h2_t, a0), x1 = __builtin_bit_cast(h2_t, a1), x2 = __builtin_bit_cast(h2_t, a2), x3 = __builtin_bit_cast(h2_t, a3);
                    v4u w; w.x = cvt_pk_f16a(v0[0] + ALPHA * (float)x0.x, v0[1] + ALPHA * (float)x0.y); w.y = cvt_pk_f16a(v0[2] + ALPHA * (float)x1.x, v0[3] + ALPHA * (float)x1.y);
                    w.z = cvt_pk_f16a(v1[0] + ALPHA * (float)x2.x, v1[1] + ALPHA * (float)x2.y); w.w = cvt_pk_f16a(v1[2] + ALPHA * (float)x3.x, v1[3] + ALPHA * (float)x3.y);
                    *(v4u*)(RS + eo) = w; } }
        }
    }
};
struct EpiF16 {
    static constexpr bool PERM = true, HAS_MID = false;
    bf16_t* O; int ldc;
    __device__ __forceinline__ void operator()(const Acc& acc, const Unit& u, int wr, int wc, int fr, int fq) const {
        vlaunder(fr, fq);
        const int row0 = u.pm * BM + wr * 64 + fr, col0 = u.pn * BM + wc * 32 + 8 * fq;
#pragma unroll
        for (int ai = 0; ai < 2; ++ai)
#pragma unroll
            for (int m = 0; m < 4; ++m) { bf16_t* rowp = O + (size_t)(row0 + ai * HALF + m * 16) * ldc + col0;
#pragma unroll
                for (int bj = 0; bj < 2; ++bj) { const f32x4 v0 = acc[ai][bj][m][0], v1 = acc[ai][bj][m][1];
                    v4u w; w.x = cvt_pk_f16a(v0[0], v0[1]); w.y = cvt_pk_f16a(v0[2], v0[3]); w.z = cvt_pk_f16a(v1[0], v1[1]); w.w = cvt_pk_f16a(v1[2], v1[3]);
                    *(v4u*)(rowp + bj * HALF) = w; } }
    }
};
struct EpiBf16 {
    static constexpr bool PERM = true, HAS_MID = false;
    bf16_t* O; int ldc;
    __device__ __forceinline__ void operator()(const Acc& acc, const Unit& u, int wr, int wc, int fr, int fq) const {
        vlaunder(fr, fq);
        const int row0 = u.pm * BM + wr * 64 + fr, col0 = u.pn * BM + wc * 32 + 8 * fq;
#pragma unroll
        for (int ai = 0; ai < 2; ++ai)
#pragma unroll
            for (int m = 0; m < 4; ++m) { bf16_t* rowp = O + (size_t)(row0 + ai * HALF + m * 16) * ldc + col0;
#pragma unroll
                for (int bj = 0; bj < 2; ++bj) { const f32x4 v0 = acc[ai][bj][m][0], v1 = acc[ai][bj][m][1];
                    v4u w; w.x = cvt_pk_bf16(v0[0], v0[1]); w.y = cvt_pk_bf16(v0[2], v0[3]); w.z = cvt_pk_bf16(v1[0], v1[1]); w.w = cvt_pk_bf16(v1[2], v1[3]);
                    *(v4u*)(rowp + bj * HALF) = w; } }
    }
};
struct EpiIn {
    static constexpr bool PERM = true, HAS_MID = false;
    bf16_t *Q, *KK, *V, *SG, *UB, *GR, *GB; float* LOGF; const float* lb;
    __device__ __forceinline__ void operator()(const Acc& acc, const Unit& u, int wr, int wc, int fr, int fq) const {
        vlaunder(fr, fq);
        const int row0 = u.pm * BM + wr * 64 + fr;
        const int pn = u.pn;
        if (pn >= 20) {
            const int col0 = (pn - 20) * 128 + wc * 32 + 8 * fq;
#pragma unroll
            for (int ai = 0; ai < 2; ++ai)
#pragma unroll
                for (int m = 0; m < 4; ++m) { const size_t ro = (size_t)(row0 + ai * HALF + m * 16) * 2048 + col0;
                    float rr[8], gg[8];
#pragma unroll
                    for (int n = 0; n < 2; ++n)
#pragma unroll
                        for (int x = 0; x < 4; ++x) { const float za = fminf(fmaxf(acc[ai][0][m][n][x], -30.f), 30.f), zb = fminf(fmaxf(acc[ai][1][m][n][x], -30.f), 30.f);
                            const float ea = fexp(-za), eb = fexp(-zb); gg[n * 4 + x] = frcp(1.f + eb); rr[n * 4 + x] = (1.f + eb) * frcp(1.f + ea); }
                    v4u w; w.x = cvt_pk_bf16(rr[0], rr[1]); w.y = cvt_pk_bf16(rr[2], rr[3]); w.z = cvt_pk_bf16(rr[4], rr[5]); w.w = cvt_pk_bf16(rr[6], rr[7]);
                    *(v4u*)(GR + ro) = w;
                    w.x = cvt_pk_bf16(gg[0], gg[1]); w.y = cvt_pk_bf16(gg[2], gg[3]); w.z = cvt_pk_bf16(gg[4], gg[5]); w.w = cvt_pk_bf16(gg[6], gg[7]);
                    *(v4u*)(GB + ro) = w; }
            return;
        }
        const int sec = pn >> 2, col0 = (pn & 3) * 256 + wc * 32 + 8 * fq;
        if (sec == 1) {
#pragma unroll
            for (int bj = 0; bj < 2; ++bj) {
                const f32x4 l0 = *(const f32x4*)(lb + col0 + bj * HALF), l1 = *(const f32x4*)(lb + col0 + bj * HALF + 4);
#pragma unroll
                for (int ai = 0; ai < 2; ++ai)
#pragma unroll
                    for (int m = 0; m < 4; ++m) { const size_t ro = (size_t)(row0 + ai * HALF + m * 16) * 1024 + col0 + bj * HALF;
                        float lf[8], kk[8];
#pragma unroll
                        for (int n = 0; n < 2; ++n)
#pragma unroll
                            for (int x = 0; x < 4; ++x) { const float z = fminf(fmaxf(acc[ai][bj][m][n][x], -30.f), 30.f); const float lbv = n ? l1[x] : l0[x];
                                const float e = fexp(-z), s = frcp(1.f + e); const float f = lbv + (1.f - lbv) * s;
                                lf[n * 4 + x] = flog(f); kk[n * 4 + x] = (1.f - lbv) * (e * s); }
                        *(f32x4*)(LOGF + ro) = (f32x4){lf[0], lf[1], lf[2], lf[3]}; *(f32x4*)(LOGF + ro + 4) = (f32x4){lf[4], lf[5], lf[6], lf[7]};
                        v4u w; w.x = cvt_pk_bf16(kk[0], kk[1]); w.y = cvt_pk_bf16(kk[2], kk[3]); w.z = cvt_pk_bf16(kk[4], kk[5]); w.w = cvt_pk_bf16(kk[6], kk[7]);
                        *(v4u*)(KK + ro) = w; }
            }
            return;
        }
        bf16_t* dst = sec == 0 ? Q : (sec == 2 ? V : (sec == 3 ? SG : UB));
        const bool sig = (sec == 3);
#pragma unroll
        for (int ai = 0; ai < 2; ++ai)
#pragma unroll
            for (int m = 0; m < 4; ++m) { bf16_t* rowp = dst + (size_t)(row0 + ai * HALF + m * 16) * 1024 + col0;
#pragma unroll
                for (int bj = 0; bj < 2; ++bj) { f32x4 v0 = acc[ai][bj][m][0], v1 = acc[ai][bj][m][1];
                    if (sig) {
#pragma unroll
                        for (int x = 0; x < 4; ++x) { v0[x] = frcp(1.f + fexp(-fminf(fmaxf(v0[x], -30.f), 30.f))); v1[x] = frcp(1.f + fexp(-fminf(fmaxf(v1[x], -30.f), 30.f))); } }
                    v4u w; w.x = cvt_pk_bf16(v0[0], v0[1]); w.y = cvt_pk_bf16(v0[2], v0[3]); w.z = cvt_pk_bf16(v1[0], v1[1]); w.w = cvt_pk_bf16(v1[2], v1[3]);
                    *(v4u*)(rowp + bj * HALF) = w; } }
    }
};
struct EpiGlu {
    static constexpr bool PERM = true, HAS_MID = false;
    bf16_t* O; int ldc;
    __device__ __forceinline__ void operator()(const Acc& acc, const Unit& u, int wr, int wc, int fr, int fq) const {
        vlaunder(fr, fq);
        const int row0 = u.pm * BM + wr * 64 + fr, col0 = u.pn * 128 + wc * 32 + 8 * fq;
#pragma unroll
        for (int ai = 0; ai < 2; ++ai)
#pragma unroll
            for (int m = 0; m < 4; ++m) { float o[8];
#pragma unroll
                for (int n = 0; n < 2; ++n)
#pragma unroll
                    for (int x = 0; x < 4; ++x) { const float h2 = fminf(fmaxf(acc[ai][1][m][n][x], -30.f), 30.f); o[n * 4 + x] = acc[ai][0][m][n][x] * frcp(1.f + fexp(-h2)); }
                v4u w; w.x = cvt_pk_bf16(o[0], o[1]); w.y = cvt_pk_bf16(o[2], o[3]); w.z = cvt_pk_bf16(o[4], o[5]); w.w = cvt_pk_bf16(o[6], o[7]);
                *(v4u*)(O + (size_t)(row0 + ai * HALF + m * 16) * ldc + col0) = w; }
    }
};
struct EpiUp {
    static constexpr bool PERM = true, HAS_MID = true;
    bf16_t* O; const bf16_t *GR, *GB;
    __device__ __forceinline__ void scale(Acc& acc, const bf16_t* G, const Unit& u, int wr, int wc, int fr, int fq) const {
        vlaunder(fr, fq);
        const int row0 = u.pm * BM + wr * 64 + fr, col0 = u.pn * BM + wc * 32 + 8 * fq;
#pragma unroll
        for (int ai = 0; ai < 2; ++ai) {
            v4u gw[4][2];
#pragma unroll
            for (int m = 0; m < 4; ++m)
#pragma unroll
                for (int bj = 0; bj < 2; ++bj) gw[m][bj] = *(const v4u*)(G + (size_t)(row0 + ai * HALF + m * 16) * 2048 + col0 + bj * HALF);
            __builtin_amdgcn_sched_barrier(0);
#pragma unroll
            for (int m = 0; m < 4; ++m) {
#pragma unroll
                for (int bj = 0; bj < 2; ++bj) { const v4u w = gw[m][bj];
                    acc[ai][bj][m][0] *= (f32x4){bf_lo(w.x), bf_hi(w.x), bf_lo(w.y), bf_hi(w.y)};
                    acc[ai][bj][m][1] *= (f32x4){bf_lo(w.z), bf_hi(w.z), bf_lo(w.w), bf_hi(w.w)}; } }
            __builtin_amdgcn_sched_barrier(0); }
    }
    __device__ __forceinline__ void mid(Acc& acc, const Unit& u, int wr, int wc, int fr, int fq) const { scale(acc, GR, u, wr, wc, fr, fq); }
    __device__ __forceinline__ void operator()(Acc& acc, const Unit& u, int wr, int wc, int fr, int fq) const {
        scale(acc, GB, u, wr, wc, fr, fq);
        const int row0 = u.pm * BM + wr * 64 + fr, col0 = u.pn * BM + wc * 32 + 8 * fq;
#pragma unroll
        for (int ai = 0; ai < 2; ++ai)
#pragma unroll
            for (int m = 0; m < 4; ++m) { bf16_t* rowp = O + (size_t)(row0 + ai * HALF + m * 16) * 2048 + col0;
#pragma unroll
                for (int bj = 0; bj < 2; ++bj) { const f32x4 v0 = acc[ai][bj][m][0], v1 = acc[ai][bj][m][1];
                    v4u w; w.x = cvt_pk_bf16(v0[0], v0[1]); w.y = cvt_pk_bf16(v0[2], v0[3]); w.z = cvt_pk_bf16(v1[0], v1[1]); w.w = cvt_pk_bf16(v1[2], v1[3]);
                    *(v4u*)(rowp + bj * HALF) = w; } }
    }
};
}

#define XB_TMO      128
#define XB_XCNT(j)  (256  + 64 * (j))
#define XB_XSUB(j)  (1280 + 64 * (j))
#define XB_XGEN(j)  (2304 + 64 * (j))
#define XB_TOP      3328
#define XB_TOPGEN   3392
#define XCD_BAR_WORDS 3456
#define XB_SPIN_CAP (1u << 20)

__device__ __forceinline__ unsigned xb_ld(unsigned* p)              { return __hip_atomic_load(p, __ATOMIC_RELAXED, __HIP_MEMORY_SCOPE_AGENT); }
__device__ __forceinline__ unsigned xb_add(unsigned* p, unsigned v) { return __hip_atomic_fetch_add(p, v, __ATOMIC_RELAXED, __HIP_MEMORY_SCOPE_AGENT); }
__device__ __forceinline__ unsigned xb_xcc_id() { return (unsigned)__builtin_amdgcn_s_getreg((3 << 11) | 20) & 0xFu; }
#define XB_SPIN(cond, bar) do { unsigned _sp = 0; while (cond) { __builtin_amdgcn_s_sleep(1); \
    if ((++_sp & 255u) == 0u) { if (xb_ld(&(bar)[XB_TMO])) break; if (_sp > XB_SPIN_CAP) { atomicAdd(&(bar)[XB_TMO], 1u); break; } } } } while (0)

struct XcdBarrier { unsigned* bar; unsigned x; volatile LAS unsigned* st; };

__device__ __forceinline__ XcdBarrier xcd_barrier_post(unsigned* bar, volatile LAS unsigned* st, bool leader) {
    XcdBarrier b; b.bar = bar; b.x = xb_xcc_id(); b.st = st;
    if (leader) (void)xb_add(&bar[XB_XCNT(b.x)], 1u);
    return b;
}
__device__ __forceinline__ void xcd_barrier_complete(unsigned* bar, unsigned x, unsigned& nloc, unsigned& nx) {
    const unsigned G = gridDim.x * gridDim.y * gridDim.z;
    unsigned sum, cnt, mine, sp = 0u;
    for (;;) {
        sum = 0u; cnt = 0u; mine = 0u;
#pragma unroll
        for (unsigned j = 0; j < 16; ++j) { const unsigned c = xb_ld(&bar[XB_XCNT(j)]); sum += c; cnt += (c > 0u) ? 1u : 0u; mine = (j == x) ? c : mine; }
        if (sum == G) break;
        __builtin_amdgcn_s_sleep(1);
        if ((++sp & 255u) == 0u) { if (xb_ld(&bar[XB_TMO])) break; if (sp > XB_SPIN_CAP) { atomicAdd(&bar[XB_TMO], 1u); break; } }
    }
    nloc = mine > 0u ? mine : 1u; nx = cnt > 0u ? cnt : 1u;
}
__device__ __forceinline__ void xcd_barrier(const XcdBarrier& b, int wv) {
    asm volatile("s_waitcnt vmcnt(0)" ::: "memory");
    __syncthreads();
    if (wv == 0 && lane_id() == 0) {
        unsigned* bar = b.bar;
        __builtin_amdgcn_s_waitcnt(0);
        unsigned nloc = b.st[0], nx = b.st[1];
        if (nloc == 0u) { xcd_barrier_complete(bar, b.x, nloc, nx); b.st[0] = nloc; b.st[1] = nx; }
        const unsigned old = xb_add(&bar[XB_XSUB(b.x)], 1u);
        const unsigned gen = old / nloc;
        if (old + 1u == (gen + 1u) * nloc) {
            __builtin_amdgcn_fence(__ATOMIC_RELEASE, "agent");
            asm volatile("s_waitcnt vmcnt(0)" ::: "memory");
            const unsigned og = xb_add(&bar[XB_TOP], 1u);
            const unsigned tg = og / nx;
            if (og + 1u == (tg + 1u) * nx) xb_add(&bar[XB_TOPGEN], 1u);
            else XB_SPIN(xb_ld(&bar[XB_TOPGEN]) == tg, bar);
            __builtin_amdgcn_fence(__ATOMIC_ACQUIRE, "agent");
            xb_add(&bar[XB_XGEN(b.x)], 1u);
            asm volatile("s_waitcnt vmcnt(0)" ::: "memory");
        } else {
            XB_SPIN(xb_ld(&bar[XB_XGEN(b.x)]) == gen, bar);
            __builtin_amdgcn_fence(__ATOMIC_ACQUIRE, "agent");
            asm volatile("s_waitcnt vmcnt(0)" ::: "memory");
        }
    }
    __syncthreads();
}

struct Args { const float* in[24]; float* out; unsigned char* ws; int ph_lo, ph_hi; };
struct Frame {
    LAS unsigned char* lds;
    int tid, lane, wave, vcu, G;
    unsigned char* ws;
    const __attribute__((address_space(4))) Args* ka;
};
enum { I_X = 0, I_WIN, I_LBL, I_NG, I_LRE, I_LIM, I_LSTEP, I_BRE, I_BIM, I_CRE, I_CIM, I_SD, I_WGLU, I_WUPA, I_WUPB, I_WO, I_LN1G, I_LN1B, I_PWQ, I_PKEYS, I_PU, I_PV, I_LN2G, I_LN2B };

__device__ __forceinline__ void p0_transpose_item(const float* W, int N, bf16* WT, int dpitch, int dst_koff, int dst_row0, LAS float* scr, int k0, int n0, int lane, bool h = false) {
    { const int kr = lane >> 3, c4 = (lane & 7) * 4; f32x4 v[8];
#pragma unroll
      for (int i = 0; i < 8; ++i) v[i] = __builtin_nontemporal_load((const f32x4*)(W + (size_t)(k0 + kr + 8 * i) * N + n0 + c4));
#pragma unroll
      for (int i = 0; i < 8; ++i) { LAS float* d = scr + (kr + 8 * i) * 33 + c4; d[0] = v[i][0]; d[1] = v[i][1]; d[2] = v[i][2]; d[3] = v[i][3]; } }
    LDS_WAIT(); asm volatile("" ::: "memory");
    const int c = lane & 7;
#pragma unroll
    for (int j = 0; j < 4; ++j) { const int n = (lane >> 3) + 8 * j; const LAS float* s = scr + (8 * c) * 33 + n;
        v4u o;
        if (h) { o.x = cvt_pk_f16(s[0 * 33], s[1 * 33]); o.y = cvt_pk_f16(s[2 * 33], s[3 * 33]); o.z = cvt_pk_f16(s[4 * 33], s[5 * 33]); o.w = cvt_pk_f16(s[6 * 33], s[7 * 33]); }
        else { o.x = cvt_pk_bf16(s[0 * 33], s[1 * 33]); o.y = cvt_pk_bf16(s[2 * 33], s[3 * 33]); o.z = cvt_pk_bf16(s[4 * 33], s[5 * 33]); o.w = cvt_pk_bf16(s[6 * 33], s[7 * 33]); }
        *(v4u*)(WT + (size_t)(dst_row0 + n) * dpitch + dst_koff + k0 + 8 * c) = o; }
    LDS_WAIT(); asm volatile("" ::: "memory");
}
__device__ __forceinline__ void sincos_d(double a, double& s, double& c) {
    const double k = __builtin_rint(a * 0.63661977236758134308);
    double r = __builtin_fma(-k, 1.57079632679489655800e+00, a); r = __builtin_fma(-k, 6.12323399573676603587e-17, r);
    const double r2 = r * r;
    double sp = 1.0 / 1307674368000.0; sp = sp * r2 - 1.0 / 6227020800.0; sp = sp * r2 + 1.0 / 39916800.0; sp = sp * r2 - 1.0 / 362880.0; sp = sp * r2 + 1.0 / 5040.0; sp = sp * r2 - 1.0 / 120.0; sp = sp * r2 + 1.0 / 6.0;
    const double sr = r - r * r2 * sp;
    double cp = 1.0 / 20922789888000.0; cp = cp * r2 - 1.0 / 87178291200.0; cp = cp * r2 + 1.0 / 479001600.0; cp = cp * r2 - 1.0 / 3628800.0; cp = cp * r2 + 1.0 / 40320.0; cp = cp * r2 - 1.0 / 720.0; cp = cp * r2 + 1.0 / 24.0;
    const double cr = 1.0 - 0.5 * r2 + r2 * r2 * cp;
    const int q = ((int)k) & 3;
    s = (q == 0) ? sr : (q == 1) ? cr : (q == 2) ? -sr : -cr;
    c = (q == 0) ? cr : (q == 1) ? -sr : (q == 2) ? -cr : sr;
}
__device__ __forceinline__ double exp_d(double x) {
    const double k = __builtin_rint(x * 1.44269504088896340736);
    const double r = __builtin_fma(-k, 6.93147180369123816490e-01, x) - k * 1.90821492927058770002e-10;
    double p = 1.0 / 6227020800.0;
    p = p * r + 1.0 / 479001600.0; p = p * r + 1.0 / 39916800.0; p = p * r + 1.0 / 3628800.0; p = p * r + 1.0 / 362880.0; p = p * r + 1.0 / 40320.0; p = p * r + 1.0 / 5040.0;
    p = p * r + 1.0 / 720.0; p = p * r + 1.0 / 120.0; p = p * r + 1.0 / 24.0; p = p * r + 1.0 / 6.0; p = p * r + 0.5; p = p * r + 1.0; p = p * r + 1.0;
    const long long e = (long long)k + 1023; double sc = __builtin_bit_cast(double, (unsigned long long)(e << 52));
    return p * sc;
}

__device__ __forceinline__ void phase_prologue_a(const Frame& F0) {
    Frame F = F0; F.tid = F.wave * 64 + lane_id(); asm volatile("" : "+v"(F.tid)); F.lane = F.tid & 63;
    unsigned char* ws = opqg(F.ws); const __attribute__((address_space(4))) Args* a = opq(F.ka);
    LAS float* scr = (LAS float*)(F.lds + F.wave * 16384);
    const int gw = F.vcu * 8 + F.wave, NGW = F.G * 8;
    constexpr int I_IN = 32 * 288, I_GLU = 16 * 64, I_UP = 16 * 64, I_O = 32 * 64, I_L = I_IN + I_GLU + 2 * I_UP + I_O;
    for (int it = gw; it < DEPTH * I_L; it += NGW) {
        const int l = it / I_L; int r = it % I_L;
        if (r < I_IN) { const int kb = r / 288, nb = r % 288, n0 = nb * 32; int dr;
            if (n0 < 5120) dr = n0; else if (n0 < 7168) { const int j = n0 - 5120; dr = 5120 + (j >> 7) * 256 + (j & 127); } else { const int j = n0 - 7168; dr = 5120 + (j >> 7) * 256 + 128 + (j & 127); }
            p0_transpose_item(GP(const float, a->in[I_WIN]) + (size_t)l * D * NIN, NIN, (bf16*)(ws + WS_WIN) + (size_t)l * NIN * D, D, 0, dr, scr, kb * 64, n0, F.lane, true); continue; }
        r -= I_IN;
        if (r < I_GLU) { const int kb = r / 64, nb = r % 64, n0 = nb * 32; int dr;
            if (n0 < 1024) dr = (n0 >> 7) * 256 + (n0 & 127); else { const int j = n0 - 1024; dr = (j >> 7) * 256 + 128 + (j & 127); }
            p0_transpose_item(GP(const float, a->in[I_WGLU]) + (size_t)l * 1024 * 2048, 2048, (bf16*)(ws + WS_WGLU) + (size_t)l * 2048 * 1024, 1024, 0, dr, scr, kb * 64, n0, F.lane); continue; }
        r -= I_GLU;
        if (r < I_UP) { const int kb = r / 64, nb = r % 64;
            p0_transpose_item(GP(const float, a->in[I_WUPA]) + (size_t)l * 1024 * 2048, 2048, (bf16*)(ws + WS_WUP) + (size_t)l * 2048 * 2048, 2048, 0, nb * 32, scr, kb * 64, nb * 32, F.lane); continue; }
        r -= I_UP;
        if (r < I_UP) { const int kb = r / 64, nb = r % 64;
            p0_transpose_item(GP(const float, a->in[I_WUPB]) + (size_t)l * 1024 * 2048, 2048, (bf16*)(ws + WS_WUP) + (size_t)l * 2048 * 2048, 2048, 1024, nb * 32, scr, kb * 64, nb * 32, F.lane); continue; }
        r -= I_UP;
        { const int kb = r / 64, nb = r % 64;
            p0_transpose_item(GP(const float, a->in[I_WO]) + (size_t)l * 2048 * 2048, 2048, (bf16*)(ws + WS_WO) + (size_t)l * 2048 * 2048, 2048, 0, nb * 32, scr, kb * 64, nb * 32, F.lane); }
    }
    const size_t gt = (size_t)F.vcu * 512 + F.tid, NT = (size_t)F.G * 512;
    { const float* src = GP(const float, a->in[I_PWQ]); bf16* dst = (bf16*)(ws + WS_WQB);
      const size_t N_ = (size_t)DEPTH * D * D / 8; size_t i = gt;
      for (; i + 3 * NT < N_; i += 4 * NT) { f32x4 va[4], vb[4];
#pragma unroll
          for (int k = 0; k < 4; ++k) { va[k] = *(const f32x4*)(src + (i + k * NT) * 8); vb[k] = *(const f32x4*)(src + (i + k * NT) * 8 + 4); }
#pragma unroll
          for (int k = 0; k < 4; ++k) { v4u w; w.x = cvt_pk_bf16(va[k][0], va[k][1]); w.y = cvt_pk_bf16(va[k][2], va[k][3]); w.z = cvt_pk_bf16(vb[k][0], vb[k][1]); w.w = cvt_pk_bf16(vb[k][2], vb[k][3]); *(v4u*)(dst + (i + k * NT) * 8) = w; } }
      for (; i < N_; i += NT) { const f32x4 v0 = *(const f32x4*)(src + i * 8), v1 = *(const f32x4*)(src + i * 8 + 4);
          v4u w; w.x = cvt_pk_bf16(v0[0], v0[1]); w.y = cvt_pk_bf16(v0[2], v0[3]); w.z = cvt_pk_bf16(v1[0], v1[1]); w.w = cvt_pk_bf16(v1[2], v1[3]); *(v4u*)(dst + i * 8) = w; } }
    { const float* src = GP(const float, a->in[I_X]); bf16* dst = (bf16*)(ws + WS_XH);
      const size_t N_ = (size_t)T * D / 8; size_t i = gt;
#define XSRC(ii) (src + (size_t)(int)(((ii) >> 2) & (T - 1)) * D + (int)((ii) >> 15) * 32 + (int)((ii) & 3) * 8)
      for (; i + 3 * NT < N_; i += 4 * NT) { f32x4 va[4], vb[4];
#pragma unroll
          for (int k = 0; k < 4; ++k) { const float* sp = XSRC(i + k * NT); va[k] = *(const f32x4*)sp; vb[k] = *(const f32x4*)(sp + 4); }
#pragma unroll
          for (int k = 0; k < 4; ++k) { v4u w; w.x = cvt_pk_f16(va[k][0], va[k][1]); w.y = cvt_pk_f16(va[k][2], va[k][3]); w.z = cvt_pk_f16(vb[k][0], vb[k][1]); w.w = cvt_pk_f16(vb[k][2], vb[k][3]); *(v4u*)(dst + (i + k * NT) * 8) = w; } }
      for (; i < N_; i += NT) { const float* sp = XSRC(i); const f32x4 v0 = *(const f32x4*)sp, v1 = *(const f32x4*)(sp + 4);
          v4u w; w.x = cvt_pk_f16(v0[0], v0[1]); w.y = cvt_pk_f16(v0[2], v0[3]); w.z = cvt_pk_f16(v1[0], v1[1]); w.w = cvt_pk_f16(v1[2], v1[3]); *(v4u*)(dst + i * 8) = w; }
#undef XSRC
    }
    { const float* keys = GP(const float, a->in[I_PKEYS]); bf16* dst = (bf16*)(ws + WS_BK);
      for (size_t i = gt; i < (size_t)DEPTH * 8 * 256 * 256 / 8; i += NT) { const int jj = (int)(i & 31) * 8; const int row = (int)((i >> 5) & 255); const size_t lh = i >> 13; const int half = row >> 7, n = row & 127;
          v4u w = (v4u){0u, 0u, 0u, 0u};
          if ((jj >> 7) == half) { const float* s = keys + ((lh * 2 + half) * 128 + n) * 128 + (jj & 127); const f32x4 v0 = *(const f32x4*)s, v1 = *(const f32x4*)(s + 4);
              w.x = cvt_pk_bf16(v0[0], v0[1]); w.y = cvt_pk_bf16(v0[2], v0[3]); w.z = cvt_pk_bf16(v1[0], v1[1]); w.w = cvt_pk_bf16(v1[2], v1[3]); }
          *(v4u*)(dst + i * 8) = w; } }
    if (gt < 1024) { const float* lg = GP(const float, a->in[I_LBL]); float* lbo = (float*)(ws + WS_LB); const int d = (int)gt;
        const float z0 = lg[d], z1 = lg[1024 + d], z2 = lg[2048 + d], z3 = lg[3072 + d]; const float mx = fmaxf(fmaxf(z0, z1), fmaxf(z2, z3));
        const float e0 = expf(z0 - mx), e1 = expf(z1 - mx), e2 = expf(z2 - mx), e3 = expf(z3 - mx); const float inv = 1.f / (e0 + e1 + e2 + e3);
        lbo[d] = 0.f; lbo[1024 + d] = e1 * inv; lbo[2048 + d] = (e1 + e2) * inv; lbo[3072 + d] = (e1 + e2 + e3) * inv; }
    for (size_t i = gt; i < (size_t)DEPTH * 64 * 64; i += NT) {
        const size_t lg_ = i >> 6;
        const double lr = fmin((double)GP(const float, a->in[I_LRE])[i], -1e-4), li = (double)GP(const float, a->in[I_LIM])[i], dt = exp_d((double)GP(const float, a->in[I_LSTEP])[lg_]);
        const double mag = exp_d(lr * dt); double sn, cs; sincos_d(li * dt, sn, cs);
        const double ar = mag * cs, ai = mag * sn, den = lr * lr + li * li, nr = ar - 1.0;
        const double zr = (nr * lr + ai * li) / den, zi = (ai * lr - nr * li) / den;
        const float* br = GP(const float, a->in[I_BRE]) + i * 16; const float* bi = GP(const float, a->in[I_BIM]) + i * 16; float* bb = (float*)(ws + WS_BB) + i * 32;
        f32x4 brv[4], biv[4];
#pragma unroll
        for (int m4 = 0; m4 < 4; ++m4) { brv[m4] = ((const f32x4*)br)[m4]; biv[m4] = ((const f32x4*)bi)[m4]; }
#pragma unroll
        for (int m4 = 0; m4 < 4; ++m4) { float o8[8];
#pragma unroll
            for (int x = 0; x < 4; ++x) { const double b_r = brv[m4][x], b_i = biv[m4][x]; o8[2 * x] = (float)(zr * b_r - zi * b_i); o8[2 * x + 1] = (float)(zr * b_i + zi * b_r); }
            ((f32x4*)bb)[2 * m4] = (f32x4){o8[0], o8[1], o8[2], o8[3]}; ((f32x4*)bb)[2 * m4 + 1] = (f32x4){o8[4], o8[5], o8[6], o8[7]}; }
        float* ap = (float*)(ws + WS_APOW) + (lg_ * 65 * 64 + (i & 63)) * 2; double pr = 1.0, pi = 0.0;
        for (int dl = 0; dl < 65; ++dl) { ap[dl * 128] = (float)pr; ap[dl * 128 + 1] = (float)pi; const double t = pr * ar - pi * ai; pi = pr * ai + pi * ar; pr = t; }
    }
    for (int it = gw; it < DEPTH * 1024; it += NGW) {
        const int l = it >> 10, eb = it & 1023;
        const int pe = eb * 16 + (F.lane >> 2), i1 = (pe & 1023) >> 3, i2 = (pe & 7) * 16 + (((pe >> 10) - i1) & 15);
        const float* src = GP(const float, a->in[I_PV]) + ((size_t)l * NEXP + i1 * 128 + i2) * D + (F.lane & 3) * 8;
        bf16* dst = (bf16*)(ws + WS_TBV) + (size_t)l * 64 * NEXP * 32 + ((size_t)(eb * 16 + (F.lane >> 2)) * 4 + ((F.lane & 3) ^ ((F.lane >> 4) & 3))) * 8;
#pragma unroll 1
        for (int k8 = 0; k8 < 64; k8 += 8) { f32x4 va[8], vb[8];
#pragma unroll
            for (int k = 0; k < 8; ++k) { va[k] = __builtin_nontemporal_load((const f32x4*)(src + (k8 + k) * 32)); vb[k] = __builtin_nontemporal_load((const f32x4*)(src + (k8 + k) * 32 + 4)); }
#pragma unroll
            for (int k = 0; k < 8; ++k) { v4u w; w.x = cvt_pk_f16(va[k][0], va[k][1]); w.y = cvt_pk_f16(va[k][2], va[k][3]); w.z = cvt_pk_f16(vb[k][0], vb[k][1]); w.w = cvt_pk_f16(vb[k][2], vb[k][3]);
                *(v4u*)(dst + (size_t)(k8 + k) * NEXP * 32) = w; } }
    }
    for (int it = gw; it < DEPTH * 4096; it += NGW) {
        const int l = it >> 12, q4 = it & 4095, c = F.lane & 15;
        const int pe = q4 * 4 + (F.lane >> 4), i1 = (pe & 1023) >> 3, i2 = (pe & 7) * 16 + (((pe >> 10) - i1) & 15);
        const float* src = GP(const float, a->in[I_PU]) + ((size_t)l * NEXP + i1 * 128 + i2) * D + c * 4;
        unsigned hv[64]; float m = 0.f;
#pragma unroll
        for (int i = 0; i < 32; ++i) { const f32x4 v = __builtin_nontemporal_load((const f32x4*)(src + i * 64));
            m = fmaxf(fmaxf(m, fmaxf(fabsf(v[0]), fabsf(v[1]))), fmaxf(fabsf(v[2]), fabsf(v[3])));
            hv[2 * i] = cvt_pk_f16(v[0], v[1]); hv[2 * i + 1] = cvt_pk_f16(v[2], v[3]); }
        m = fmaxf(m, __shfl_xor(m, 1)); m = fmaxf(m, __shfl_xor(m, 2)); m = fmaxf(m, __shfl_xor(m, 4)); m = fmaxf(m, __shfl_xor(m, 8));
        const float sc = (m > 0.f) ? m * (1.f / 127.f) : 1.f, inv = (m > 0.f) ? 127.f / m : 0.f;
        if (c == 0) ((float*)(ws + WS_SU))[(size_t)l * NEXP + pe] = sc;
        unsigned char* dst = ws + WS_TBU + (size_t)l * 32 * NEXP * 64 + (size_t)pe * 64 + (((c >> 2) ^ ((pe >> 2) & 3)) * 16 + (c & 3) * 4);
#pragma unroll
        for (int i = 0; i < 32; ++i) { const h2_t p0 = __builtin_bit_cast(h2_t, hv[2 * i]), p1 = __builtin_bit_cast(h2_t, hv[2 * i + 1]);
            const int q0 = (int)__builtin_rintf((float)p0.x * inv), q1 = (int)__builtin_rintf((float)p0.y * inv), q2 = (int)__builtin_rintf((float)p1.x * inv), q3 = (int)__builtin_rintf((float)p1.y * inv);
            *(unsigned*)(dst + (size_t)i * NEXP * 64) = (unsigned)(q0 & 255) | ((unsigned)(q1 & 255) << 8) | ((unsigned)(q2 & 255) << 16) | ((unsigned)q3 << 24); }
    }
}
__device__ __forceinline__ double dummy_unused_(double x) { return x; }

__device__ __forceinline__ void phase_prologue_b(const Frame& F0) {
    Frame F = F0; F.tid = F.wave * 64 + lane_id(); asm volatile("" : "+v"(F.tid)); F.lane = F.tid & 63;
    unsigned char* ws = opqg(F.ws); const __attribute__((address_space(4))) Args* a = opq(F.ka);
    const float* APOW = (const float*)(ws + WS_APOW); const float* BB = (const float*)(ws + WS_BB);
    LAS float* AP = (LAS float*)(F.lds); LAS float* BL = (LAS float*)(F.lds + 33280); LAS float* CR = (LAS float*)(F.lds + 41472); LAS float* CI = (LAS float*)(F.lds + 45568); LAS float* SDL = (LAS float*)(F.lds + 49664);
    bf16* KM = (bf16*)(ws + WS_KMAT); bf16* PM = (bf16*)(ws + WS_PM); bf16* E = (bf16*)(ws + WS_E);
    for (int lg = F.vcu; lg < DEPTH * 64; lg += F.G) {
        for (int i = F.tid; i < 65 * 64 * 2 / 4; i += 512) ((LAS f32x4*)AP)[i] = ((const f32x4*)(APOW + (size_t)lg * 65 * 128))[i];
        ((LAS f32x4*)BL)[F.tid] = ((const f32x4*)(BB + (size_t)lg * 2048))[F.tid];
        if (F.tid < 256) ((LAS f32x4*)CR)[F.tid] = ((const f32x4*)(GP(const float, a->in[I_CRE]) + (size_t)lg * 1024))[F.tid];
        else ((LAS f32x4*)CI)[F.tid - 256] = ((const f32x4*)(GP(const float, a->in[I_CIM]) + (size_t)lg * 1024))[F.tid - 256];
        if (F.tid < 16) SDL[F.tid] = GP(const float, a->in[I_SD])[lg * 16 + F.tid];
        __syncthreads();
        for (int task = F.tid; task < 65 * 16; task += 512) {
            const int n = task & 15, idx = task >> 4;
            float sm[16];
#pragma unroll
            for (int m = 0; m < 16; ++m) sm[m] = 0.f;
            if (idx > 0) { const int dl = idx - 1;
#pragma unroll 4
                for (int p = 0; p < 64; ++p) { const f32x2 av = *(const LAS f32x2*)(AP + (dl * 64 + p) * 2); const float c_r = CR[n * 64 + p], c_i = CI[n * 64 + p];
                    const float car = c_r * av[0] - c_i * av[1], cai = c_r * av[1] + c_i * av[0];
#pragma unroll
                    for (int q = 0; q < 8; ++q) { const f32x4 b4 = *(const LAS f32x4*)(BL + p * 32 + q * 4); sm[2 * q] += car * b4[0] - cai * b4[1]; sm[2 * q + 1] += car * b4[2] - cai * b4[3]; } }
                if (dl == 0) { const float dv = SDL[n];
#pragma unroll
                    for (int m = 0; m < 16; ++m) sm[m] += (m == n) ? dv : 0.f; } }
            v4u w0, w1; w0.x = cvt_pk_bf16(sm[0], sm[1]); w0.y = cvt_pk_bf16(sm[2], sm[3]); w0.z = cvt_pk_bf16(sm[4], sm[5]); w0.w = cvt_pk_bf16(sm[6], sm[7]);
            w1.x = cvt_pk_bf16(sm[8], sm[9]); w1.y = cvt_pk_bf16(sm[10], sm[11]); w1.z = cvt_pk_bf16(sm[12], sm[13]); w1.w = cvt_pk_bf16(sm[14], sm[15]);
            bf16* kp = KM + ((size_t)lg * 65 * 16 + task) * 16; *(v4u*)kp = w0; *(v4u*)(kp + 8) = w1; }
        for (int it = F.tid; it < 128 * 64 * 2; it += 512) {
            const int m0 = (it & 1) * 8, sidx = (it >> 1) & 63, pp = it >> 7, p = pp & 63;
            const f32x2 av = *(const LAS f32x2*)(AP + ((63 - sidx) * 64 + p) * 2); const float pr = av[0], pi = av[1];
            float o[8];
#pragma unroll
            for (int j = 0; j < 4; ++j) { const f32x4 b4 = *(const LAS f32x4*)(BL + p * 32 + m0 * 2 + j * 4);
                o[2 * j] = (pp < 64) ? (pr * b4[0] - pi * b4[1]) : (pr * b4[1] + pi * b4[0]); o[2 * j + 1] = (pp < 64) ? (pr * b4[2] - pi * b4[3]) : (pr * b4[3] + pi * b4[2]); }
            v4u w; w.x = cvt_pk_bf16(o[0], o[1]); w.y = cvt_pk_bf16(o[2], o[3]); w.z = cvt_pk_bf16(o[4], o[5]); w.w = cvt_pk_bf16(o[6], o[7]); *(v4u*)(PM + ((size_t)lg * 16384 + it) * 8) = w; }
        for (int it = F.tid; it < 1024 * 16; it += 512) {
            const int pp0 = (it & 15) * 8, n = (it >> 4) & 15, tau = it >> 8, p0 = pp0 & 63;
            float o[8];
#pragma unroll
            for (int j = 0; j < 8; ++j) { const f32x2 av = *(const LAS f32x2*)(AP + ((tau + 1) * 64 + p0 + j) * 2); const float c_r = CR[n * 64 + p0 + j], c_i = CI[n * 64 + p0 + j];
                o[j] = (pp0 < 64) ? (c_r * av[0] - c_i * av[1]) : -(c_r * av[1] + c_i * av[0]); }
            v4u w; w.x = cvt_pk_bf16(o[0], o[1]); w.y = cvt_pk_bf16(o[2], o[3]); w.z = cvt_pk_bf16(o[4], o[5]); w.w = cvt_pk_bf16(o[6], o[7]); *(v4u*)(E + ((size_t)lg * 16384 + it) * 8) = w; }
        __syncthreads();
    }
}
constexpr int HG_BL = 0, HG_TOT = 33792, HG_VT = 35840, HG_KT = 54272, HG_RED = 72704;
constexpr int KSP = 136, HG_KS = 73728, HG_QT = HG_KS + 64 * KSP * 2, HG_QH = HG_QT + 64 * KSP * 2;
static_assert(HG_QH + 64 * KSP * 2 <= RING_BYTES, "hgrn_out LDS map");
constexpr int BLP = 132, VTP = 72;
__device__ __forceinline__ void hg_cumsum(const Frame& F, const float* LOGF, int c, int h) {
    LAS float* bL = (LAS float*)(F.lds + HG_BL); LAS float* tot = (LAS float*)(F.lds + HG_TOT);
    const int d = F.tid & 127, seg = F.tid >> 7;
    const float* src = LOGF + (size_t)(c * 64 + seg * 16) * AW + h * 128 + d;
    float lf[16];
#pragma unroll
    for (int i = 0; i < 16; ++i) lf[i] = src[(size_t)i * AW];
#pragma unroll
    for (int i = 1; i < 16; ++i) lf[i] += lf[i - 1];
    tot[seg * 128 + d] = lf[15];
    __syncthreads();
    float off = 0.f;
#pragma unroll
    for (int s2 = 0; s2 < 3; ++s2) off += (s2 < seg) ? tot[s2 * 128 + d] : 0.f;
#pragma unroll
    for (int i = 0; i < 16; ++i) bL[(seg * 16 + i) * BLP + d] = lf[i] + off;
}
__device__ __forceinline__ void hg_load_vt(const Frame& F, const bf16* V, int c, int h) {
    LAS bf16* VT = (LAS bf16*)(F.lds + HG_VT);
    const int s = F.lane, vb = F.wave * 16;
    const v4u* src = (const v4u*)(V + (size_t)(c * 64 + s) * AW + h * 128 + vb);
    const v4u w0 = src[0], w1 = src[1];
    const unsigned ww[8] = {w0.x, w0.y, w0.z, w0.w, w1.x, w1.y, w1.z, w1.w};
#pragma unroll
    for (int j = 0; j < 8; ++j) { VT[(vb + 2 * j) * VTP + s] = (bf16)(ww[j] & 0xffffu); VT[(vb + 2 * j + 1) * VTP + s] = (bf16)(ww[j] >> 16); }
}
__device__ __forceinline__ void phase_hgrn_local(const Frame& F0, int l) {
    Frame F = F0; F.tid = F.wave * 64 + lane_id(); asm volatile("" : "+v"(F.tid)); F.lane = F.tid & 63;
    unsigned char* ws = opqg(F.ws);
    const float* LOGF = (const float*)(ws + WS_LOGF); const bf16* KK = (const bf16*)(ws + WS_KK); const bf16* V = (const bf16*)(ws + WS_V);
    _Float16* U = (_Float16*)(ws + WS_U); float* BLo = (float*)(ws + WS_BL);
    LAS float* bL = (LAS float*)(F.lds + HG_BL); LAS bf16* VT = (LAS bf16*)(F.lds + HG_VT); LAS bf16* KT = (LAS bf16*)(F.lds + HG_KT);
    const int fr = F.lane & 15, fq = F.lane >> 4;
    for (int unit = F.vcu; unit < NCH * 8; unit += F.G) {
        const int c = unit >> 3, h = unit & 7;
        hg_cumsum(F, LOGF, c, h);
        hg_load_vt(F, V, c, h);
        __syncthreads();
        { const int s = F.lane, db = F.wave * 16;
          const v4u* src = (const v4u*)(KK + (size_t)(c * 64 + s) * AW + h * 128 + db);
          const v4u w0 = src[0], w1 = src[1];
          const unsigned ww[8] = {w0.x, w0.y, w0.z, w0.w, w1.x, w1.y, w1.z, w1.w};
#pragma unroll
          for (int j = 0; j < 8; ++j) {
              const float b0 = bL[s * BLP + db + 2 * j], b1 = bL[s * BLP + db + 2 * j + 1], l0 = bL[63 * BLP + db + 2 * j], l1 = bL[63 * BLP + db + 2 * j + 1];
              const unsigned pk = cvt_pk_bf16(bf_lo(ww[j]) * fexp(l0 - b0), bf_hi(ww[j]) * fexp(l1 - b1));
              KT[(db + 2 * j) * VTP + s] = (bf16)(pk & 0xffffu); KT[(db + 2 * j + 1) * VTP + s] = (bf16)(pk >> 16); } }
        if (F.tid < 128) BLo[(size_t)c * AW + h * 128 + F.tid] = bL[63 * BLP + F.tid];
        __syncthreads();
        f32x4 acc[8];
#pragma unroll
        for (int i = 0; i < 8; ++i) acc[i] = (f32x4){0.f, 0.f, 0.f, 0.f};
#pragma unroll
        for (int ks = 0; ks < 2; ++ks) {
            const bf16x8 A = *(const LAS bf16x8*)(VT + (F.wave * 16 + fr) * VTP + ks * 32 + fq * 8);
#pragma unroll
            for (int dt = 0; dt < 8; ++dt) { const bf16x8 B = *(const LAS bf16x8*)(KT + (dt * 16 + fr) * VTP + ks * 32 + fq * 8);
                acc[dt] = __builtin_amdgcn_mfma_f32_16x16x32_bf16(B, A, acc[dt], 0, 0, 0); }
        }
        _Float16* up = U + ((size_t)(c * 8 + h) * 128 + F.wave * 16 + fr) * 128 + fq * 4;
#pragma unroll
        for (int dt = 0; dt < 8; ++dt) { v2u w; w.x = cvt_pk_f16(acc[dt][0], acc[dt][1]); w.y = cvt_pk_f16(acc[dt][2], acc[dt][3]); *(v2u*)(up + dt * 16) = w; }
        __syncthreads();
    }
}
__device__ __forceinline__ void phase_scan(const Frame& F0, int l) {
    Frame F = F0; F.tid = F.wave * 64 + lane_id(); asm volatile("" : "+v"(F.tid)); F.lane = F.tid & 63;
    unsigned char* ws = opqg(F.ws);
    const _Float16* U = (const _Float16*)(ws + WS_U); const float* BLo = (const float*)(ws + WS_BL); bf16* SP = (bf16*)(ws + WS_SP);
    for (int e = F.vcu * 512 + F.tid; e < 8 * 128 * 128; e += F.G * 512) {
        const int hd = (e >> 14) * 128 + (e & 127);
        float s = 0.f;
        for (int c0 = 0; c0 < NCH; c0 += 32) {
            float u[32], bl[32];
#pragma unroll
            for (int i = 0; i < 32; ++i) { u[i] = (float)U[(size_t)(c0 + i) * 131072 + e]; bl[i] = BLo[(size_t)(c0 + i) * AW + hd]; }
#pragma unroll
            for (int i = 0; i < 32; ++i) { SP[(size_t)(c0 + i) * 131072 + e] = f2bf(s); s = s * fexp(bl[i]) + u[i]; }
        }
    }
    const float* XLOC = (const float*)(ws + WS_XLOC); float* XS = (float*)(ws + WS_XS); const float* APOW = (const float*)(ws + WS_APOW);
    for (int e = F.vcu * 512 + F.tid; e < 64 * 64; e += F.G * 512) {
        const int g = e >> 6, p = e & 63;
        const float* ap = APOW + (((size_t)(l * 64 + g) * 65 + 64) * 64 + p) * 2; const float ar = ap[0], ai = ap[1];
        float xr = 0.f, xi = 0.f;
        for (int c0 = 0; c0 < NCH; c0 += 32) {
            float lr_[32], li_[32];
#pragma unroll
            for (int i = 0; i < 32; ++i) { lr_[i] = XLOC[((size_t)(c0 + i) * 64 + g) * 128 + p]; li_[i] = XLOC[((size_t)(c0 + i) * 64 + g) * 128 + 64 + p]; }
#pragma unroll
            for (int i = 0; i < 32; ++i) { XS[((size_t)(c0 + i) * 64 + g) * 128 + p] = xr; XS[((size_t)(c0 + i) * 64 + g) * 128 + 64 + p] = xi;
                const float t = ar * xr - ai * xi + lr_[i]; xi = ar * xi + ai * xr + li_[i]; xr = t; }
        }
    }
}
__device__ __forceinline__ void phase_hgrn_out(const Frame& F0, int l) {
    Frame F = F0; F.tid = F.wave * 64 + lane_id(); asm volatile("" : "+v"(F.tid)); F.lane = F.tid & 63;
    unsigned char* ws = opqg(F.ws); const __attribute__((address_space(4))) Args* a = opq(F.ka);
    const float* LOGF = (const float*)(ws + WS_LOGF); const bf16* KK = (const bf16*)(ws + WS_KK); const bf16* V = (const bf16*)(ws + WS_V);
    const bf16* Q = (const bf16*)(ws + WS_Q); const bf16* SG = (const bf16*)(ws + WS_SG); const bf16* SP = (const bf16*)(ws + WS_SP);
    bf16* OAB = (bf16*)(ws + WS_OAB); const float* NG = GP(const float, a->in[I_NG]) + (size_t)l * AW;
    LAS float* bL = (LAS float*)(F.lds + HG_BL); LAS bf16* VT = (LAS bf16*)(F.lds + HG_VT); LAS float* red = (LAS float*)(F.lds + HG_RED);
    const int fr = F.lane & 15, fq = F.lane >> 4, tt = F.wave & 3, vh = F.wave >> 2;
    LAS float* tot = (LAS float*)(F.lds + HG_TOT);
    float lf[16]; v4u vw0, vw1, kg0, kg1, qg0, qg1;
#define HGO_PREF(u_) { const int c_ = (u_) >> 3, h_ = (u_) & 7; \
        const float* src_ = LOGF + (size_t)(c_ * 64 + (F.tid >> 7) * 16) * AW + h_ * 128 + (F.tid & 127); \
        _Pragma("unroll") for (int i = 0; i < 16; ++i) lf[i] = src_[(size_t)i * AW]; \
        const v4u* vp_ = (const v4u*)(V + (size_t)(c_ * 64 + F.lane) * AW + h_ * 128 + F.wave * 16); vw0 = vp_[0]; vw1 = vp_[1]; \
        const size_t ro_ = ((size_t)c_ * 64 + (F.tid >> 3)) * AW + h_ * 128 + (F.tid & 7) * 16; \
        const v4u* kp_ = (const v4u*)(KK + ro_); const v4u* qp_ = (const v4u*)(Q + ro_); kg0 = kp_[0]; kg1 = kp_[1]; qg0 = qp_[0]; qg1 = qp_[1]; }
    if (F.vcu < NCH * 8) HGO_PREF(F.vcu)
    for (int unit = F.vcu; unit < NCH * 8; unit += F.G) {
        const int c = unit >> 3, h = unit & 7;
        { const int d = F.tid & 127, seg = F.tid >> 7;
#pragma unroll
          for (int i = 1; i < 16; ++i) lf[i] += lf[i - 1];
          tot[seg * 128 + d] = lf[15];
          { const int s = F.lane, vb = F.wave * 16; const unsigned ww[8] = {vw0.x, vw0.y, vw0.z, vw0.w, vw1.x, vw1.y, vw1.z, vw1.w};
#pragma unroll
            for (int j = 0; j < 8; ++j) { VT[(vb + 2 * j) * VTP + s] = (bf16)(ww[j] & 0xffffu); VT[(vb + 2 * j + 1) * VTP + s] = (bf16)(ww[j] >> 16); } }
          __syncthreads();
          float off = 0.f;
#pragma unroll
          for (int s2 = 0; s2 < 3; ++s2) off += (s2 < seg) ? tot[s2 * 128 + d] : 0.f;
#pragma unroll
          for (int i = 0; i < 16; ++i) bL[(seg * 16 + i) * BLP + d] = lf[i] + off; }
        __syncthreads();
        const int t = tt * 16 + fr; const size_t tok = (size_t)c * 64 + t;
        bf16x8 sg_[2][4];
#define HG_LOAD(buf, kd_) { const int d0_ = (kd_) * 32 + fq * 8; \
            _Pragma("unroll") for (int vt = 0; vt < 4; ++vt) sg_[buf][vt] = *(const bf16x8*)(SP + ((size_t)(c * 8 + h) * 128 + (vh * 4 + vt) * 16 + fr) * 128 + d0_); }
        HG_LOAD(0, 0) HG_LOAD(1, 1)
        v2u sgw[4];
#pragma unroll
        for (int vt = 0; vt < 4; ++vt) sgw[vt] = *(const v2u*)(SG + tok * AW + h * 128 + (vh * 4 + vt) * 16 + fq * 4);
        f32x4 ngw[4];
#pragma unroll
        for (int vt = 0; vt < 4; ++vt) ngw[vt] = *(const f32x4*)(NG + h * 128 + (vh * 4 + vt) * 16 + fq * 4);
        { const int s = F.tid >> 3, dc = (F.tid & 7) * 16;
          const unsigned kq[8] = {kg0.x, kg0.y, kg0.z, kg0.w, kg1.x, kg1.y, kg1.z, kg1.w}, qq[8] = {qg0.x, qg0.y, qg0.z, qg0.w, qg1.x, qg1.y, qg1.z, qg1.w};
          unsigned ko[8], qto[8], qho[8];
#pragma unroll
          for (int j4 = 0; j4 < 4; ++j4) { const f32x4 bs = *(const LAS f32x4*)(bL + s * BLP + dc + 4 * j4), br = *(const LAS f32x4*)(bL + 31 * BLP + dc + 4 * j4);
#pragma unroll
              for (int hx = 0; hx < 2; ++hx) { const int w = 2 * j4 + hx; const float b0 = bs[2 * hx], b1 = bs[2 * hx + 1], r0 = br[2 * hx], r1 = br[2 * hx + 1];
                  const float k0 = bf_lo(kq[w]), k1 = bf_hi(kq[w]), q0 = bf_lo(qq[w]), q1 = bf_hi(qq[w]);
                  ko[w] = cvt_pk_bf16(k0 * fexp(fminf(r0 - b0, 80.f)), k1 * fexp(fminf(r1 - b1, 80.f)));
                  qto[w] = cvt_pk_bf16(q0 * fexp(fminf(b0 - r0, 80.f)), q1 * fexp(fminf(b1 - r1, 80.f)));
                  qho[w] = cvt_pk_bf16(q0 * fexp(b0), q1 * fexp(b1)); } }
          LAS v4u* kd_ = (LAS v4u*)(F.lds + HG_KS + (s * KSP + dc) * 2); kd_[0] = (v4u){ko[0], ko[1], ko[2], ko[3]}; kd_[1] = (v4u){ko[4], ko[5], ko[6], ko[7]};
          LAS v4u* qt_ = (LAS v4u*)(F.lds + HG_QT + (s * KSP + dc) * 2); qt_[0] = (v4u){qto[0], qto[1], qto[2], qto[3]}; qt_[1] = (v4u){qto[4], qto[5], qto[6], qto[7]};
          LAS v4u* qh_ = (LAS v4u*)(F.lds + HG_QH + (s * KSP + dc) * 2); qh_[0] = (v4u){qho[0], qho[1], qho[2], qho[3]}; qh_[1] = (v4u){qho[4], qho[5], qho[6], qho[7]}; }
        __syncthreads();
        f32x4 att[4], o[4];
#pragma unroll
        for (int i = 0; i < 4; ++i) { att[i] = (f32x4){0.f, 0.f, 0.f, 0.f}; o[i] = (f32x4){0.f, 0.f, 0.f, 0.f}; }
#pragma unroll
        for (int kd = 0; kd < 4; ++kd) {
            const int cb = kd & 1;
            const int fo = (kd * 32 + fq * 8) * 2;
            const bf16x8 Bqt = *(const LAS bf16x8*)(F.lds + HG_QT + (t * KSP) * 2 + fo), Bqh = *(const LAS bf16x8*)(F.lds + HG_QH + (t * KSP) * 2 + fo);
#pragma unroll
            for (int st = 0; st < 4; ++st) { const bf16x8 kt = *(const LAS bf16x8*)(F.lds + HG_KS + ((st * 16 + fr) * KSP) * 2 + fo);
                att[st] = __builtin_amdgcn_mfma_f32_16x16x32_bf16(kt, Bqt, att[st], 0, 0, 0); }
#pragma unroll
            for (int vt = 0; vt < 4; ++vt) o[vt] = __builtin_amdgcn_mfma_f32_16x16x32_bf16(sg_[cb][vt], Bqh, o[vt], 0, 0, 0);
            if (kd < 2) HG_LOAD(cb, kd + 2)
            if (kd == 1) { const int nu = unit + F.G; if (nu < NCH * 8) HGO_PREF(nu) }
        }
#undef HG_LOAD
#pragma unroll
        for (int ks = 0; ks < 2; ++ks) {
            float m8[8];
#pragma unroll
            for (int jj = 0; jj < 8; ++jj) { const int st = 2 * ks + (jj >> 2), r = jj & 3, s = st * 16 + fq * 4 + r; m8[jj] = (s <= t) ? att[st][r] : 0.f; }
            v4u pb; pb.x = cvt_pk_bf16(m8[0], m8[1]); pb.y = cvt_pk_bf16(m8[2], m8[3]); pb.z = cvt_pk_bf16(m8[4], m8[5]); pb.w = cvt_pk_bf16(m8[6], m8[7]);
            const bf16x8 B = __builtin_bit_cast(bf16x8, pb);
#pragma unroll
            for (int vt = 0; vt < 4; ++vt) { const int v = (vh * 4 + vt) * 16 + fr;
                const v2u a0 = *(const LAS v2u*)(VT + v * VTP + ks * 32 + fq * 4), a1 = *(const LAS v2u*)(VT + v * VTP + ks * 32 + 16 + fq * 4);
                const v4u pa = (v4u){a0.x, a0.y, a1.x, a1.y};
                o[vt] = __builtin_amdgcn_mfma_f32_16x16x32_bf16(__builtin_bit_cast(bf16x8, pa), B, o[vt], 0, 0, 0); }
        }
        float ss = 0.f;
#pragma unroll
        for (int vt = 0; vt < 4; ++vt)
#pragma unroll
            for (int r = 0; r < 4; ++r) ss += o[vt][r] * o[vt][r];
        ss += __shfl_xor(ss, 16); ss += __shfl_xor(ss, 32);
        if (fq == 0) red[F.wave * 16 + fr] = ss;
        LDS_WAIT(); __builtin_amdgcn_s_barrier(); asm volatile("" ::: "memory");
        const float tot = red[F.wave * 16 + fr] + red[(F.wave ^ 4) * 16 + fr];
        const float rstd = __builtin_amdgcn_rsqf(tot * (1.f / 128.f) + RMS_EPS);
#pragma unroll
        for (int vt = 0; vt < 4; ++vt) { const int v0 = (vh * 4 + vt) * 16 + fq * 4;
            const f32x4 g4 = ngw[vt]; const v2u sg = sgw[vt];
            v2u w; w.x = cvt_pk_bf16(o[vt][0] * rstd * g4[0] * bf_lo(sg.x), o[vt][1] * rstd * g4[1] * bf_hi(sg.x));
            w.y = cvt_pk_bf16(o[vt][2] * rstd * g4[2] * bf_lo(sg.y), o[vt][3] * rstd * g4[3] * bf_hi(sg.y));
            *(v2u*)(OAB + tok * 2048 + h * 128 + v0) = w; }
        LDS_WAIT(); __builtin_amdgcn_s_barrier(); asm volatile("" ::: "memory");
    }
#undef HGO_PREF
}

constexpr int S5_UT = 0, S5_UTP = 2064, S5_XST = 33024, S5_XSP = 272, S5_KM = 37376;
__device__ __forceinline__ void s5_load_ut(const Frame& F, const bf16* UB, int g, int jb) {
    v4u w0[2], w1[2];
#pragma unroll
    for (int i = 0; i < 2; ++i) { const int tl = F.tid + 512 * i; const v4u* src = (const v4u*)(UB + ((size_t)jb * 1024 + tl) * AW + g * 16); w0[i] = src[0]; w1[i] = src[1]; }
#pragma unroll
    for (int i = 0; i < 2; ++i) { const int tl = F.tid + 512 * i; LAS v4u* dst = (LAS v4u*)(F.lds + S5_UT + (tl >> 6) * S5_UTP + (tl & 63) * 32); dst[0] = w0[i]; dst[1] = w1[i]; }
}
__device__ __forceinline__ void phase_s5_local(const Frame& F0, int l) {
    Frame F = F0; F.tid = F.wave * 64 + lane_id(); asm volatile("" : "+v"(F.tid)); F.lane = F.tid & 63;
    unsigned char* ws = opqg(F.ws);
    const bf16* UB = (const bf16*)(ws + WS_UB); const bf16* PM = (const bf16*)(ws + WS_PM) + (size_t)l * 64 * 128 * 1024; float* XLOC = (float*)(ws + WS_XLOC);
    const int fr = F.lane & 15, fq = F.lane >> 4;
    for (int unit = F.vcu; unit < 64 * 8; unit += F.G) {
        const int g = unit >> 3, jb = unit & 7;
        const bf16* ap = PM + ((size_t)g * 128 + F.wave * 16 + fr) * 1024 + fq * 8;
        bf16x8 Af[32];
#pragma unroll
        for (int ks = 0; ks < 32; ++ks) Af[ks] = *(const bf16x8*)(ap + ks * 32);
        s5_load_ut(F, UB, g, jb);
        __syncthreads();
        f32x4 acc = (f32x4){0.f, 0.f, 0.f, 0.f};
        const LAS unsigned char* bp = F.lds + S5_UT + fr * S5_UTP + (fq >> 1) * 32 + (fq & 1) * 16;
#pragma unroll
        for (int ks = 0; ks < 32; ++ks) { const bf16x8 B = *(const LAS bf16x8*)(bp + ks * 64);
            acc = __builtin_amdgcn_mfma_f32_16x16x32_bf16(Af[ks], B, acc, 0, 0, 0); }
        *(f32x4*)(XLOC + ((size_t)(jb * 16 + fr) * 64 + g) * 128 + F.wave * 16 + fq * 4) = acc;
        __syncthreads();
    }
}
__device__ __forceinline__ void phase_s5_out(const Frame& F0, int l) {
    Frame F = F0; F.tid = F.wave * 64 + lane_id(); asm volatile("" : "+v"(F.tid)); F.lane = F.tid & 63;
    unsigned char* ws = opqg(F.ws);
    const bf16* UB = (const bf16*)(ws + WS_UB); const bf16* E = (const bf16*)(ws + WS_E) + (size_t)l * 64 * 1024 * 128; const bf16* KMAT = (const bf16*)(ws + WS_KMAT) + (size_t)l * 64 * 65 * 256;
    const float* XS = (const float*)(ws + WS_XS); bf16* YB = (bf16*)(ws + WS_YB);
    const int fr = F.lane & 15, fq = F.lane >> 4;
    for (int unit = F.vcu; unit < 64 * 8; unit += F.G) {
        const int g = unit >> 3, jb = unit & 7;
        { const int cc = F.tid >> 5, p0 = (F.tid & 31) * 4;
          const f32x4 xv = *(const f32x4*)(XS + ((size_t)(jb * 16 + cc) * 64 + g) * 128 + p0);
          v4u km[5];
#pragma unroll
          for (int k = 0; k < 5; ++k) { const int pc = F.tid + 512 * k; km[k] = (pc < 65 * 32) ? *(const v4u*)(KMAT + (size_t)g * 65 * 256 + (size_t)pc * 8) : (v4u){0u, 0u, 0u, 0u}; }
          s5_load_ut(F, UB, g, jb);
          v2u w; w.x = cvt_pk_bf16(xv[0], xv[1]); w.y = cvt_pk_bf16(xv[2], xv[3]); *(LAS v2u*)(F.lds + S5_XST + cc * S5_XSP + p0 * 2) = w;
#pragma unroll
          for (int k = 0; k < 5; ++k) { const int pc = F.tid + 512 * k; const int idx = pc >> 5, n = (pc >> 1) & 15, half = pc & 1;
              if (pc < 65 * 32) *(LAS v4u*)(F.lds + S5_KM + idx * 512 + n * 32 + ((half ^ (n >> 3)) * 16)) = km[k]; } }
        __syncthreads();
        for (int ti = 0; ti < 8; ++ti) {
            const int tau = ti * 8 + F.wave;
            const bf16* ep = E + ((size_t)g * 1024 + tau * 16 + fr) * 128 + fq * 8;
            bf16x8 Ae[4];
#pragma unroll
            for (int ke = 0; ke < 4; ++ke) Ae[ke] = *(const bf16x8*)(ep + ke * 32);
            f32x4 acc = (f32x4){0.f, 0.f, 0.f, 0.f}, acc1 = (f32x4){0.f, 0.f, 0.f, 0.f};
            const LAS unsigned char* bp = F.lds + S5_UT + fr * S5_UTP + (fq >> 1) * 32 + (fq & 1) * 16;
            const LAS unsigned char* kp = F.lds + S5_KM + (tau - (fq >> 1) + 1) * 512 + fr * 32 + (((fq & 1) ^ (fr >> 3)) * 16);
            const int nks = (tau >> 1) + 1;
            int ks = 0;
            for (; ks + 4 <= nks; ks += 4) {
                const bf16x8 A0 = *(const LAS bf16x8*)(kp - ks * 1024), A1 = *(const LAS bf16x8*)(kp - (ks + 1) * 1024), A2 = *(const LAS bf16x8*)(kp - (ks + 2) * 1024), A3 = *(const LAS bf16x8*)(kp - (ks + 3) * 1024);
                const bf16x8 B0 = *(const LAS bf16x8*)(bp + ks * 64), B1 = *(const LAS bf16x8*)(bp + (ks + 1) * 64), B2 = *(const LAS bf16x8*)(bp + (ks + 2) * 64), B3 = *(const LAS bf16x8*)(bp + (ks + 3) * 64);
                acc = __builtin_amdgcn_mfma_f32_16x16x32_bf16(A0, B0, acc, 0, 0, 0); acc1 = __builtin_amdgcn_mfma_f32_16x16x32_bf16(A1, B1, acc1, 0, 0, 0);
                acc = __builtin_amdgcn_mfma_f32_16x16x32_bf16(A2, B2, acc, 0, 0, 0); acc1 = __builtin_amdgcn_mfma_f32_16x16x32_bf16(A3, B3, acc1, 0, 0, 0); }
            for (; ks < nks; ++ks) { const bf16x8 A = *(const LAS bf16x8*)(kp - ks * 1024); const bf16x8 B = *(const LAS bf16x8*)(bp + ks * 64);
                acc = __builtin_amdgcn_mfma_f32_16x16x32_bf16(A, B, acc, 0, 0, 0); }
            const LAS unsigned char* xp = F.lds + S5_XST + fr * S5_XSP + fq * 16;
#pragma unroll
            for (int ke = 0; ke < 4; ke += 2) { const bf16x8 B0 = *(const LAS bf16x8*)(xp + ke * 64), B1 = *(const LAS bf16x8*)(xp + (ke + 1) * 64);
                acc = __builtin_amdgcn_mfma_f32_16x16x32_bf16(Ae[ke], B0, acc, 0, 0, 0); acc1 = __builtin_amdgcn_mfma_f32_16x16x32_bf16(Ae[ke + 1], B1, acc1, 0, 0, 0); }
            acc += acc1;
            v2u w; w.x = cvt_pk_bf16(gelu_tanh(acc[0]), gelu_tanh(acc[1])); w.y = cvt_pk_bf16(gelu_tanh(acc[2]), gelu_tanh(acc[3]));
            *(v2u*)(YB + ((size_t)(jb * 16 + fr) * 64 + tau) * AW + g * 16 + fq * 4) = w;
        }
        __syncthreads();
    }
}

__device__ __forceinline__ void phase_ln(const Frame& F0, int l, int which) {
    Frame F = F0; F.tid = F.wave * 64 + lane_id(); asm volatile("" : "+v"(F.tid)); F.lane = F.tid & 63;
    unsigned char* ws = opqg(F.ws); const __attribute__((address_space(4))) Args* a = opq(F.ka);
    const bf16* RS = (const bf16*)(ws + WS_RH); bf16* XS = (bf16*)(ws + WS_XH);
    const bool last = (which == 1 && l == DEPTH - 1); float* OUT = GP(float, a->out);
    const float* gam = GP(const float, a->in[which == 0 ? I_LN1G : I_LN2G]) + (size_t)l * D; const float* bet = GP(const float, a->in[which == 0 ? I_LN1B : I_LN2B]) + (size_t)l * D;
    const int gw = F.vcu * 8 + F.wave, NGW = F.G * 8;
    const int j = F.lane & 3, rr = (F.lane >> 2) & 1, sl = F.lane >> 3;
    for (int rp = gw; rp < T / 2; rp += NGW) {
        const int row = 2 * rp + rr;
        const size_t eo = ((size_t)sl * T + row) * 32 + j * 8;
        v4u w[8];
#pragma unroll
        for (int i = 0; i < 8; ++i) w[i] = *(const v4u*)(RS + eo + (size_t)i * 8 * T * 32);
        float v[64]; float s = 0.f;
#pragma unroll
        for (int i = 0; i < 8; ++i) { const unsigned ww[4] = {w[i].x, w[i].y, w[i].z, w[i].w};
#pragma unroll
            for (int k = 0; k < 4; ++k) { const h2_t hv = __builtin_bit_cast(h2_t, ww[k]); v[8 * i + 2 * k] = (float)hv.x; v[8 * i + 2 * k + 1] = (float)hv.y; s += (float)hv.x + (float)hv.y; } }
        s += __shfl_xor(s, 1); s += __shfl_xor(s, 2); s += __shfl_xor(s, 8); s += __shfl_xor(s, 16); s += __shfl_xor(s, 32);
        const float mean = s * (1.f / D); float s2 = 0.f;
#pragma unroll
        for (int i = 0; i < 64; ++i) { v[i] -= mean; s2 += v[i] * v[i]; }
        s2 += __shfl_xor(s2, 1); s2 += __shfl_xor(s2, 2); s2 += __shfl_xor(s2, 8); s2 += __shfl_xor(s2, 16); s2 += __shfl_xor(s2, 32);
        const float rstd = __builtin_amdgcn_rsqf(s2 * (1.f / D) + LN_EPS);
        float amax = 0.f;
#pragma unroll
        for (int i = 0; i < 8; ++i) { const int e0 = (8 * i + sl) * 32 + j * 8;
            const f32x4 g0 = *(const f32x4*)(gam + e0), g1 = *(const f32x4*)(gam + e0 + 4), b0 = *(const f32x4*)(bet + e0), b1 = *(const f32x4*)(bet + e0 + 4);
            const f32x4 y0 = (f32x4){v[8 * i], v[8 * i + 1], v[8 * i + 2], v[8 * i + 3]} * rstd * g0 + b0, y1 = (f32x4){v[8 * i + 4], v[8 * i + 5], v[8 * i + 6], v[8 * i + 7]} * rstd * g1 + b1;
            if (last) { *(f32x4*)(OUT + (size_t)row * D + e0) = y0; *(f32x4*)(OUT + (size_t)row * D + e0 + 4) = y1; }
            else { v4u o; o.x = cvt_pk_f16(y0[0], y0[1]); o.y = cvt_pk_f16(y0[2], y0[3]); o.z = cvt_pk_f16(y1[0], y1[1]); o.w = cvt_pk_f16(y1[2], y1[3]); *(v4u*)(XS + eo + (size_t)i * 8 * T * 32) = o; }
            if (which == 0) {
#pragma unroll
                for (int k = 0; k < 4; ++k) { v[8 * i + k] = y0[k]; v[8 * i + 4 + k] = y1[k]; amax = fmaxf(amax, fmaxf(fabsf(y0[k]), fabsf(y1[k]))); } } }
        if (which == 0) {
            amax = fmaxf(amax, __shfl_xor(amax, 1)); amax = fmaxf(amax, __shfl_xor(amax, 2)); amax = fmaxf(amax, __shfl_xor(amax, 8)); amax = fmaxf(amax, __shfl_xor(amax, 16)); amax = fmaxf(amax, __shfl_xor(amax, 32));
            const float inv = (amax > 0.f) ? 127.f / amax : 0.f;
            if (j == 0 && sl == 0) ((float*)(ws + WS_SX))[row] = (amax > 0.f) ? amax * (1.f / 127.f) : 1.f;
            unsigned char* xq = ws + WS_XQ + (size_t)row * 64 + (sl & 1) * 32 + j * 8;
#pragma unroll
            for (int i = 0; i < 8; ++i) { int q[8];
#pragma unroll
                for (int k = 0; k < 8; ++k) q[k] = (int)__builtin_rintf(v[8 * i + k] * inv);
                v2u o; o.x = (unsigned)(q[0] & 255) | ((unsigned)(q[1] & 255) << 8) | ((unsigned)(q[2] & 255) << 16) | ((unsigned)q[3] << 24);
                o.y = (unsigned)(q[4] & 255) | ((unsigned)(q[5] & 255) << 8) | ((unsigned)(q[6] & 255) << 16) | ((unsigned)q[7] << 24);
                *(v2u*)(xq + (size_t)(4 * i + (sl >> 1)) * T * 64) = o; } }
    }
}

constexpr int PK_TV = 0, PK_EID = 65536, PK_GATE = 81920;
__device__ __forceinline__ int f2key(float x) { const int b = __float_as_int(x); return b ^ ((b >> 31) & 0x7fffffff); }
__device__ __forceinline__ float key2f(int k) { return __int_as_float(k ^ ((k >> 31) & 0x7fffffff)); }
__device__ __forceinline__ int imed3(int a, int b, int c) { int r; asm("v_med3_i32 %0, %1, %2, %3" : "=v"(r) : "v"(a), "v"(b), "v"(c)); return r; }
#define INSK(kx) do { const int _x = (kx); _Pragma("unroll") for (int _k = 15; _k > 0; --_k) tk[_k] = imed3(tk[_k - 1], tk[_k], _x); tk[0] = max(tk[0], _x); } while (0)
__device__ __forceinline__ void phase_topk(const Frame& F0, int l) {
    Frame F = F0; F.tid = F.wave * 64 + lane_id(); asm volatile("" : "+v"(F.tid)); F.lane = F.tid & 63;
    unsigned char* ws = opqg(F.ws);
    const float* SC = (const float*)(ws + WS_SC); int* SEID = (int*)(ws + WS_SEID); float* SGATE = (float*)(ws + WS_SGATE); unsigned char* START = ws + WS_START;
    LAS int* TK = (LAS int*)(F.lds + PK_TV); LAS int* EIDL = (LAS int*)(F.lds + PK_EID); LAS float* GATEL = (LAS float*)(F.lds + PK_GATE);
    for (int tb = F.vcu; tb < T / 32; tb += F.G) {
        const int t0 = tb * 32;
        { const int tok = F.tid >> 4, hh = F.tid & 15;
          const v4u* sp = (const v4u*)((const bf16*)SC + (size_t)(t0 + tok) * 2048 + hh * 128);
          int tk[16];
#pragma unroll
          for (int k = 0; k < 16; ++k) tk[k] = (int)0x80000000;
#pragma unroll 2
          for (int i = 0; i < 16; ++i) { const v4u s0 = sp[i]; const unsigned sw[4] = {s0.x, s0.y, s0.z, s0.w};
#pragma unroll
              for (int x = 0; x < 4; ++x) { INSK((f2key(bf_lo(sw[x])) & ~127) | (127 - (8 * i + 2 * x))); INSK((f2key(bf_hi(sw[x])) & ~127) | (127 - (8 * i + 2 * x + 1))); } }
#pragma unroll
          for (int k = 0; k < 16; ++k) TK[F.tid * 16 + k] = tk[k]; }
        __syncthreads();
        if ((F.tid & 1) == 0) {
            float v1[16], v2[16];
#pragma unroll
            for (int k = 0; k < 16; ++k) { v1[k] = key2f(TK[F.tid * 16 + k] & ~127); v2[k] = key2f(TK[(F.tid + 1) * 16 + k] & ~127); }
            int tk[16];
#pragma unroll
            for (int k = 0; k < 16; ++k) tk[k] = (int)0x80000000;
#pragma unroll
            for (int aa = 0; aa < 16; ++aa)
#pragma unroll
                for (int bb = 0; bb < 16; ++bb) if ((aa + 1) * (bb + 1) <= 16) { INSK((f2key(v1[aa] + v2[bb]) & ~255) | (255 - (aa * 16 + bb))); }
            float ex[16], sum = 0.f; const float v0 = key2f(tk[0] & ~255);
#pragma unroll
            for (int k = 0; k < 16; ++k) { ex[k] = expf(key2f(tk[k] & ~255) - v0); sum += ex[k]; }
            const float inv = 1.f / sum;
            const int tok = F.tid >> 4, hd = (F.tid >> 1) & 7;
#pragma unroll
            for (int k = 0; k < 16; ++k) { const int code = 255 - (tk[k] & 255);
                const int i1 = 127 - (TK[F.tid * 16 + (code >> 4)] & 127), i2 = 127 - (TK[(F.tid + 1) * 16 + (code & 15)] & 127);
                EIDL[tok * 128 + hd * 16 + k] = (((i1 + i2) & 15) << 10) + i1 * 8 + (i2 >> 4); GATEL[tok * 128 + hd * 16 + k] = ex[k] * inv; }
        }
        __syncthreads();
        for (int ti = 0; ti < 4; ++ti) {
            const int tok = F.wave * 4 + ti;
            int k0 = (EIDL[tok * 128 + F.lane] << 7) | F.lane, k1 = (EIDL[tok * 128 + 64 + F.lane] << 7) | (64 + F.lane);
#pragma unroll
            for (int k = 2; k <= 128; k <<= 1)
#pragma unroll
                for (int j = k >> 1; j > 0; j >>= 1) {
                    if (j == 64) { const int mn = min(k0, k1), mx = max(k0, k1); k0 = mn; k1 = mx; }
                    else { const int o0 = __shfl_xor(k0, j), o1 = __shfl_xor(k1, j); const bool lower = (F.lane & j) == 0;
                        const bool up0 = (F.lane & k) == 0, up1 = ((64 + F.lane) & k) == 0;
                        k0 = (up0 == lower) ? min(k0, o0) : max(k0, o0); k1 = (up1 == lower) ? min(k1, o1) : max(k1, o1); }
                }
            const size_t t = (size_t)(t0 + tok);
            { const int r0 = k0 >> 17, r1 = k1 >> 17; int mine = 0;
#pragma unroll
              for (int r = 1; r < 16; ++r) { const int c = __builtin_popcountll(__ballot(r0 < r)) + __builtin_popcountll(__ballot(r1 < r)); mine = (F.lane == r) ? c : mine; }
              if (F.lane < 16) START[t * 16 + F.lane] = (unsigned char)mine; }
            SEID[t * LP + F.lane] = k0 >> 7; SEID[t * LP + 64 + F.lane] = k1 >> 7;
            SGATE[t * 128 + F.lane] = GATEL[tok * 128 + (k0 & 127)]; SGATE[t * 128 + 64 + F.lane] = GATEL[tok * 128 + (k1 & 127)];
        }
        __syncthreads();
    }
}
typedef __bf16 bf2_t __attribute__((ext_vector_type(2)));
__device__ __forceinline__ float dot2bf(unsigned a, unsigned b, float c) { return __builtin_amdgcn_fdot2_f32_bf16(__builtin_bit_cast(bf2_t, a), __builtin_bit_cast(bf2_t, b), c, false); }
__device__ __forceinline__ void peer_stage(const Frame& F, const bf16* gsrc, int bo) {
#pragma unroll
    for (int i = 0; i < 8; ++i) { const int p = i * 8 + F.wave;
        __builtin_amdgcn_global_load_lds((const unsigned*)((const char*)gsrc + p * 1024 + F.lane * 16), (LAS unsigned*)(F.lds + bo + p * 1024), 16, 0, 0); }
}
__device__ __forceinline__ void peer_dma(const Frame& F, const void* gsrc, int bo) {
    const unsigned ldsbase = (unsigned)(size_t)(F.lds + bo) + (unsigned)F.wave * 1024u;
#pragma unroll
    for (int i = 0; i < 8; ++i) { const char* g = (const char*)gsrc + (i * 8 + F.wave) * 1024 + F.lane * 16; const unsigned m = ldsbase + i * 8192u;
        asm volatile("s_mov_b32 m0, %0\n\ts_nop 0\n\tglobal_load_lds_dwordx4 %1, off" :: "s"(m), "v"((GAS const char*)g) : "memory"); }
}
__device__ __forceinline__ int wave_max_i(int v) {
#pragma unroll
    for (int o = 1; o < 64; o <<= 1) v = max(v, __shfl_xor(v, o));
    return __builtin_amdgcn_readfirstlane(v);
}
template <int K> __device__ __forceinline__ unsigned dppq(unsigned v) { return (unsigned)__builtin_amdgcn_mov_dpp((int)v, K * 0x55, 0xf, 0xf, true); }
__device__ __forceinline__ int sdot4(unsigned a, unsigned b, int c) { return __builtin_amdgcn_sdot4((int)a, (int)b, c, false); }
__device__ __forceinline__ int quad_sum_i(int v) {
    v += __builtin_amdgcn_mov_dpp(v, 0xB1, 0xf, 0xf, true);
    v += __builtin_amdgcn_mov_dpp(v, 0x4E, 0xf, 0xf, true);
    return v;
}
__device__ __forceinline__ float quad_sum(float v) {
    v += __int_as_float(__builtin_amdgcn_mov_dpp(__float_as_int(v), 0xB1, 0xf, 0xf, true));
    v += __int_as_float(__builtin_amdgcn_mov_dpp(__float_as_int(v), 0x4E, 0xf, 0xf, true));
    return v;
}
constexpr int UCAP0 = 24, UCAP1 = 12, UCAP2 = 12, UCAP3 = 8;
__device__ __forceinline__ void phase_peer_u(const Frame& F0, int l) {
    Frame F = F0; F.tid = F.wave * 64 + lane_id(); asm volatile("" : "+v"(F.tid)); F.lane = F.tid & 63;
    unsigned char* ws = opqg(F.ws);
    const bf16* TU = (const bf16*)(ws + WS_TBU) + (size_t)l * 32 * NEXP * 32;
    const int* SEID = (const int*)(ws + WS_SEID); const float* SGATE = (const float*)(ws + WS_SGATE); unsigned* PACK = (unsigned*)(ws + WS_PACK); unsigned char* START = ws + WS_START;
    const bf16* XBS = (const bf16*)(ws + WS_XQ); unsigned* PACK2 = (unsigned*)(ws + WS_PACK2);
    const float* SX = (const float*)(ws + WS_SX); const float* SU = (const float*)(ws + WS_SU) + (size_t)l * NEXP;
    const int qd = F.lane >> 2, jc = F.lane & 3;
    for (int unit = F.vcu; unit < 256; unit += F.G) {
        const int tt = unit & 15, er = unit >> 4; const size_t t = (size_t)tt * 512 + F.tid;
        const int lo = START[t * 16 + er], hi = (er < 15) ? (int)START[t * 16 + er + 1] : 128;
        const int cnt = hi - lo;
        int key = (cnt << 6) | (63 - F.lane);
#pragma unroll
        for (int k = 2; k <= 64; k <<= 1)
#pragma unroll
            for (int j = k >> 1; j > 0; j >>= 1) { const int o = __shfl_xor(key, j); const bool lower = (F.lane & j) == 0, up = (F.lane & k) == 0;
                key = (up == lower) ? max(key, o) : min(key, o); }
        int tl[4], glo[4], gcnt[4], gmax[4];
#pragma unroll
        for (int a = 0; a < 4; ++a) { const int kk = __shfl(key, a * 16 + qd); tl[a] = 63 - (kk & 63); gcnt[a] = kk >> 6; glo[a] = __shfl(lo, tl[a]);
            gmax[a] = __builtin_amdgcn_readfirstlane(__shfl(key, a * 16)) >> 6; }
        const size_t tbase = (size_t)tt * 512 + F.wave * 64;
        unsigned ro0[UCAP0 / 4], ro1[UCAP1 / 4], ro2[UCAP2 / 4], ro3[UCAP3 / 4];
#define LOADRO(arr, a, CAP) _Pragma("unroll") for (int i = 0; i < CAP / 4; ++i) { const int s = 4 * i + jc; const int e = SEID[(tbase + tl[a]) * LP + glo[a] + s]; \
            const int row = (s < gcnt[a]) ? (e & 1023) : 0; arr[i] = (unsigned)((row << 6) + (((row >> 2) & 3) << 4)); }
        LOADRO(ro0, 0, UCAP0) LOADRO(ro1, 1, UCAP1) LOADRO(ro2, 2, UCAP2) LOADRO(ro3, 3, UCAP3)
#undef LOADRO
        int ac0[UCAP0], ac1[UCAP1], ac2[UCAP2], ac3[UCAP3];
#pragma unroll
        for (int s = 0; s < UCAP0; ++s) ac0[s] = 0;
#pragma unroll
        for (int s = 0; s < UCAP1; ++s) ac1[s] = 0;
#pragma unroll
        for (int s = 0; s < UCAP2; ++s) ac2[s] = 0;
#pragma unroll
        for (int s = 0; s < UCAP3; ++s) ac3[s] = 0;
        const bf16* gsl0 = TU + (size_t)er * 1024 * 32;
#define XA(a) ((const v4u*)(XBS + (tbase + tl[a]) * 32) + jc)
        v4u xs[4];
#pragma unroll
        for (int a = 0; a < 4; ++a) xs[a] = XA(a)[0];
        peer_dma(F, gsl0, 0);
        VM_WAIT(); __syncthreads();
#pragma unroll 1
        for (int ks = 0; ks < 32; ++ks) {
            const int bo = (ks & 1) * 65536, jx = jc << 4;
            v4u xn[4];
            const int kn = (ks + 1 < 32) ? ks + 1 : ks;
#pragma unroll
            for (int a = 0; a < 4; ++a) xn[a] = XA(a)[(size_t)kn * T * 4];
            if (ks + 1 < 32) peer_dma(F, gsl0 + (size_t)kn * NEXP * 32, bo ^ 65536);
#define URD(B, arr, g) { asm volatile("" : "+v"(arr[g])); B[0] = *(const LAS v4u*)(F.lds + bo + (dppq<0>(arr[g]) ^ jx)); B[1] = *(const LAS v4u*)(F.lds + bo + (dppq<1>(arr[g]) ^ jx)); \
                B[2] = *(const LAS v4u*)(F.lds + bo + (dppq<2>(arr[g]) ^ jx)); B[3] = *(const LAS v4u*)(F.lds + bo + (dppq<3>(arr[g]) ^ jx)); }
#define UCP(B, acc, a, g) { _Pragma("unroll") for (int q = 0; q < 4; ++q) { int p0 = acc[4 * (g) + q]; \
                p0 = sdot4(B[q].x, xs[a].x, p0); p0 = sdot4(B[q].y, xs[a].y, p0); p0 = sdot4(B[q].z, xs[a].z, p0); p0 = sdot4(B[q].w, xs[a].w, p0); acc[4 * (g) + q] = p0; } }
            { v4u BE[4], BO[4];
              URD(BE, ro0, 0) __builtin_amdgcn_sched_barrier(0);
              URD(BO, ro0, 1) UCP(BE, ac0, 0, 0)
              __builtin_amdgcn_sched_barrier(0);
              URD(BE, ro0, 2) UCP(BO, ac0, 0, 1)
              __builtin_amdgcn_sched_barrier(0);
              URD(BO, ro0, 3) UCP(BE, ac0, 0, 2)
              __builtin_amdgcn_sched_barrier(0);
              URD(BE, ro0, 4) UCP(BO, ac0, 0, 3)
              __builtin_amdgcn_sched_barrier(0);
              URD(BO, ro0, 5) UCP(BE, ac0, 0, 4)
              __builtin_amdgcn_sched_barrier(0);
              URD(BE, ro1, 0) UCP(BO, ac0, 0, 5)
              __builtin_amdgcn_sched_barrier(0);
              URD(BO, ro1, 1) UCP(BE, ac1, 1, 0)
              __builtin_amdgcn_sched_barrier(0);
              URD(BE, ro1, 2) UCP(BO, ac1, 1, 1)
              __builtin_amdgcn_sched_barrier(0);
              URD(BO, ro2, 0) UCP(BE, ac1, 1, 2)
              __builtin_amdgcn_sched_barrier(0);
              URD(BE, ro2, 1) UCP(BO, ac2, 2, 0)
              __builtin_amdgcn_sched_barrier(0);
              URD(BO, ro2, 2) UCP(BE, ac2, 2, 1)
              __builtin_amdgcn_sched_barrier(0);
              URD(BE, ro3, 0) UCP(BO, ac2, 2, 2)
              __builtin_amdgcn_sched_barrier(0);
              URD(BO, ro3, 1) UCP(BE, ac3, 3, 0)
              __builtin_amdgcn_sched_barrier(0);
              UCP(BO, ac3, 3, 1) }
#undef URD
#undef UCP
#pragma unroll
            for (int a = 0; a < 4; ++a) xs[a] = xn[a];
            VM_WAIT(); __syncthreads();
        }
        float gt0[UCAP0 / 4], gt1[UCAP1 / 4], gt2[UCAP2 / 4], gt3[UCAP3 / 4];
        float sq0[UCAP0 / 4], sq1[UCAP1 / 4], sq2[UCAP2 / 4], sq3[UCAP3 / 4];
#define UGT(gt, sq, arr, a, CAP) { const float* gp_ = SGATE + (tbase + tl[a]) * 128; const float sx_ = SX[tbase + tl[a]]; _Pragma("unroll") for (int i = 0; i < CAP / 4; ++i) { gt[i] = gp_[min(glo[a] + 4 * i + jc, 127)]; sq[i] = sx_ * SU[er * 1024 + (int)(arr[i] >> 6)]; } }
        UGT(gt0, sq0, ro0, 0, UCAP0) UGT(gt1, sq1, ro1, 1, UCAP1) UGT(gt2, sq2, ro2, 2, UCAP2) UGT(gt3, sq3, ro3, 3, UCAP3)
#undef UGT
#define UOUT(arr, acc, gt, sq, a, CAP) { const size_t tk = tbase + tl[a]; _Pragma("unroll") for (int s = 0; s < CAP; ++s) { const int toti = quad_sum_i(acc[s]); \
            if ((s & 3) == jc && s < NSLOT) { unsigned wv = 0u; if (s < gcnt[a]) { const float av = gelu_tanh((float)toti * sq[s >> 2]) * gt[s >> 2]; wv = (arr[s >> 2] << 16) | (cvt_pk_f16(av, 0.f) & 0xffffu); } \
                PACK2[(tk * 16 + er) * NSLOT + s] = wv; } } \
            _Pragma("unroll") for (int s = CAP; s < NSLOT; ++s) if ((s & 3) == jc && s >= gcnt[a]) PACK2[(tk * 16 + er) * NSLOT + s] = 0u; }
        UOUT(ro0, ac0, gt0, sq0, 0, UCAP0) UOUT(ro1, ac1, gt1, sq1, 1, UCAP1) UOUT(ro2, ac2, gt2, sq2, 2, UCAP2) UOUT(ro3, ac3, gt3, sq3, 3, UCAP3)
#undef UOUT
#undef XA
        { int myrank = 0; const int mykey = (cnt << 6) | (63 - F.lane);
          for (int p = 0; p < 64; ++p) myrank += (__shfl(key, p) > mykey) ? 1 : 0;
          const int cap = myrank < 16 ? UCAP0 : (myrank < 32 ? UCAP1 : (myrank < 48 ? UCAP2 : UCAP3));
          const v4u* xsp = (const v4u*)(XBS + t * 32);
          for (int s = cap; s < cnt; ++s) {
              const int pos = lo + s, e = SEID[t * LP + pos]; const int f = (e >> 2) & 3; int di = 0;
              for (int ks = 0; ks < 32; ++ks)
#pragma unroll
                  for (int j = 0; j < 4; ++j) { const v4u u4 = *(const v4u*)(TU + (((size_t)ks * NEXP + e) * 4 + (j ^ f)) * 8); const v4u x4 = xsp[(size_t)ks * T * 4 + j];
                      di = sdot4(u4.x, x4.x, di); di = sdot4(u4.y, x4.y, di); di = sdot4(u4.z, x4.z, di); di = sdot4(u4.w, x4.w, di); }
              const float d = (float)di * SX[t] * SU[e];
              const int row = e & 1023;
              const unsigned wv = ((unsigned)((row << 6) + (((row >> 2) & 3) << 4)) << 16) | (cvt_pk_f16(gelu_tanh(d) * SGATE[t * 128 + pos], 0.f) & 0xffffu);
              if (s < NSLOT) PACK2[(t * 16 + er) * NSLOT + s] = wv; else PACK[t * LP + pos] = wv; }
        }
    }
}
#ifndef VBLK
#define VBLK 2
#endif
#if VBLK == 4
#define VTT(x, j) (4 * ((x) & 3) + ((j) & 3))
#define VDS(x, j, it) (32 * ((x) >> 2) + 8 * (it) + ((j) >> 2))
#elif VBLK == 8
#define VTT(x, j) (8 * ((x) & 1) + ((j) & 7))
#define VDS(x, j, it) (16 * ((x) >> 1) + 4 * (it) + ((j) >> 3))
#elif VBLK == 2
#define VTT(x, j) (2 * (x) + ((j) & 1))
#define VDS(x, j, it) (16 * (it) + ((j) >> 1))
#else
#define VTT(x, j) ((j) & 15)
#define VDS(x, j, it) (((x) * 32 + (j) + 256 * (it)) >> 4)
#endif
__device__ __forceinline__ void phase_peer_v(const Frame& F0, int l) {
    Frame F = F0; F.tid = F.wave * 64 + lane_id(); asm volatile("" : "+v"(F.tid)); F.lane = F.tid & 63;
    unsigned char* ws = opqg(F.ws);
    const bf16* TV = (const bf16*)(ws + WS_TBV) + (size_t)l * 64 * NEXP * 32; const bf16* XS = (const bf16*)(ws + WS_XH); bf16* RS = (bf16*)(ws + WS_RH);
    const unsigned* PACK = (const unsigned*)(ws + WS_PACK); const unsigned char* START = ws + WS_START; const unsigned* PACK2 = (const unsigned*)(ws + WS_PACK2);
    for (int it = 0; it * F.G + F.vcu < 1024; ++it) {
        int tt, ds;
        if (F.G == 256) { const int x = F.vcu >> 5, j = F.vcu & 31; tt = VTT(x, j); ds = VDS(x, j, it); }
        else { const int unit = it * F.G + F.vcu; tt = unit & 15; ds = unit >> 4; }
        const size_t t = (size_t)tt * 512 + F.tid;
        const v4u st4 = *(const v4u*)(START + t * 16);
        const unsigned stw[4] = {st4.x, st4.y, st4.z, st4.w};
        unsigned acc[16];
#pragma unroll
        for (int i = 0; i < 16; ++i) acc[i] = 0u;
        const bf16* gsl0 = TV + (size_t)ds * NEXP * 32;
        unsigned Lc[NSLOT];
        { const v4u* lp = (const v4u*)(PACK2 + t * 16 * NSLOT);
#pragma unroll
          for (int s = 0; s < NSLOT / 4; ++s) { const v4u q = lp[s]; Lc[4 * s] = q.x; Lc[4 * s + 1] = q.y; Lc[4 * s + 2] = q.z; Lc[4 * s + 3] = q.w; } }
        peer_dma(F, gsl0, 0);
        VM_WAIT(); __syncthreads();
#pragma unroll 1
        for (int c = 0; c < 16; ++c) {
            const int bo = (c & 1) * 65536;
            const int q0 = c >> 2, q1 = (c + 1) >> 2;
            const unsigned w0 = q0 == 0 ? stw[0] : (q0 == 1 ? stw[1] : (q0 == 2 ? stw[2] : stw[3])), w1 = q1 == 0 ? stw[0] : (q1 == 1 ? stw[1] : (q1 == 2 ? stw[2] : stw[3]));
            const int s_c = (int)((w0 >> ((c & 3) * 8)) & 255u);
            const int s_n = (c < 15) ? (int)((w1 >> (((c + 1) & 3) * 8)) & 255u) : 128;
            const int n_c = s_n - s_c;
            unsigned Ln[NSLOT];
            const int cn = (c < 15) ? c + 1 : c;
            { const v4u* lp = (const v4u*)(PACK2 + (t * 16 + cn) * NSLOT);
#pragma unroll
              for (int s = 0; s < NSLOT / 4; ++s) { const v4u q = lp[s]; Ln[4 * s] = q.x; Ln[4 * s + 1] = q.y; Ln[4 * s + 2] = q.z; Ln[4 * s + 3] = q.w; } }
            if (c < 15) peer_dma(F, gsl0 + (size_t)cn * 1024 * 32, bo ^ 65536);
            const int wmax = wave_max_i(min(n_c, NSLOT));
#pragma unroll
            for (int g = 0; g < NSLOT / 2; ++g) {
                if (2 * g < wmax) {
                    v4u v4[2][4]; unsigned a2[2];
#pragma unroll
                    for (int q = 0; q < 2; ++q) { const int s = 2 * g + q; const unsigned w = Lc[s];
                        a2[q] = __builtin_amdgcn_perm(w, w, 0x01000100u);
                        const int a0 = bo + (int)((w >> 16) & 0xfff0u);
#pragma unroll
                        for (int j = 0; j < 4; ++j) v4[q][j] = *(const LAS v4u*)(F.lds + (a0 ^ (j << 4))); }
#pragma unroll
                    for (int q = 0; q < 2; ++q)
#pragma unroll
                        for (int j = 0; j < 4; ++j) {
                            acc[4 * j + 0] = pkfmah(v4[q][j].x, a2[q], acc[4 * j + 0]); acc[4 * j + 1] = pkfmah(v4[q][j].y, a2[q], acc[4 * j + 1]);
                            acc[4 * j + 2] = pkfmah(v4[q][j].z, a2[q], acc[4 * j + 2]); acc[4 * j + 3] = pkfmah(v4[q][j].w, a2[q], acc[4 * j + 3]); }
                }
            }
            for (int s = NSLOT; s < n_c; ++s) {
                const unsigned w = PACK[t * LP + s_c + s]; const unsigned a2 = (w & 0xffffu) | (w << 16);
                const int a0 = bo + (int)((w >> 16) & 0xfff0u);
#pragma unroll
                for (int j = 0; j < 4; ++j) { const v4u v4 = *(const LAS v4u*)(F.lds + (a0 ^ (j << 4)));
                    acc[4 * j + 0] = pkfmah(v4.x, a2, acc[4 * j + 0]); acc[4 * j + 1] = pkfmah(v4.y, a2, acc[4 * j + 1]);
                    acc[4 * j + 2] = pkfmah(v4.z, a2, acc[4 * j + 2]); acc[4 * j + 3] = pkfmah(v4.w, a2, acc[4 * j + 3]); }
            }
            VM_WAIT(); __syncthreads();
#pragma unroll
            for (int s = 0; s < NSLOT; ++s) Lc[s] = Ln[s];
        }
        const v4u* xp = (const v4u*)(XS + ((size_t)ds * T + t) * 32); v4u* rp = (v4u*)(RS + ((size_t)ds * T + t) * 32);
        v4u xw4[4];
#pragma unroll
        for (int j = 0; j < 4; ++j) xw4[j] = xp[j];
#pragma unroll
        for (int j = 0; j < 4; ++j) { const v4u xw = xw4[j]; const unsigned xx[4] = {xw.x, xw.y, xw.z, xw.w}; unsigned o[4];
#pragma unroll
            for (int k = 0; k < 4; ++k) { const h2_t xv = __builtin_bit_cast(h2_t, xx[k]), yv = __builtin_bit_cast(h2_t, acc[4 * j + k]);
                o[k] = cvt_pk_f16((float)xv.x * ALPHA + (float)yv.x, (float)xv.y * ALPHA + (float)yv.y); }
            rp[j] = (v4u){o[0], o[1], o[2], o[3]}; }
    }
}

constexpr int PH_PER_LAYER = 13, N_PHASES = 2 + DEPTH * PH_PER_LAYER;
__global__ void __launch_bounds__(512, 2) fwd_kernel(Args args) {
    extern __shared__ __attribute__((aligned(16))) unsigned char lds[];
    Frame F;
    F.lds = (LAS unsigned char*)lds;
    F.wave = __builtin_amdgcn_readfirstlane((int)threadIdx.x >> 6); F.tid = 0; F.lane = 0;
    F.G = gridDim.x; { const int bx = blockIdx.x; F.vcu = (F.G % 8 == 0) ? (bx % 8) * (F.G / 8) + bx / 8 : bx; }
    F.ws = args.ws; F.ka = (const __attribute__((address_space(4))) Args*)__builtin_amdgcn_kernarg_segment_ptr();
    unsigned char* ws = args.ws;
    for (int u = F.wave * 64 + lane_id(); u < (LDS_BYTES - LDSCTL_OFF) / 4; u += 512) ((LAS unsigned*)(F.lds + LDSCTL_OFF))[u] = 0u;
    __syncthreads();
    XcdBarrier bar; bar.bar = (unsigned*)(ws + WS_CTL) + CW_BAR; bar.x = 0; bar.st = nullptr;
    const int lo = args.ph_lo, hi = args.ph_hi;
    if (hi - lo > 1) bar = xcd_barrier_post((unsigned*)(ws + WS_CTL) + CW_BAR, (volatile LAS unsigned*)(F.lds + MISC_OFF) + 8, F.wave == 0 && lane_id() == 0);
#ifndef PHMASK
#define PHMASK 0xFFF
#endif
#define EN(i) ((PHMASK >> (i)) & 1)
#ifndef RPT
#define RPT 0
#endif
#define REP(i) for (int _r = 0; _r <= ((RPT >> (i)) & 1); ++_r)
#define IN(k) (lo <= (k) && (k) < hi)
#define SEAM(k) do { if (IN((k) + 1)) xcd_barrier(bar, F.wave); } while (0)

    if (EN(10) && IN(0)) { REP(13) { phase_prologue_a(F); } SEAM(0); }
    if (EN(11) && IN(1)) REP(14) {
        phase_prologue_b(F);
        unsigned char* ws = opqg(args.ws);
        int kc = 256; asm volatile("" : "+s"(kc));
        pg8::Gemm g{(const bf16*)(ws + WS_BK), (const bf16*)(ws + WS_WQB), DEPTH * 2048, 2048, kc, 256, 2048, 256, (long)2048 * 2048};
        pg8::StaticOrder S; S.init(DEPTH * 2048, 2048, F.G, (int)blockIdx.x);
        pg8::EpiF16 E{(bf16*)(ws + WS_WPQ), 2048};
        pg8::gemm_phase<pg8::EpiF16, pg8::StaticOrder, true>(F.lds, g, S, E, F.wave);
        if (_r == ((RPT >> 14) & 1)) SEAM(1);
    }
    for (int l = 0; l < DEPTH; ++l) {
        const int pb = 2 + l * PH_PER_LAYER;
        if (EN(0) && IN(pb + 0)) REP(0) {
            unsigned char* ws = opqg(args.ws);
            pg8::Gemm g{(const bf16*)(ws + WS_XH), (const bf16*)(ws + WS_WIN) + (size_t)l * NIN * D, T, NIN, D, T, D, 0, 0};
            pg8::StaticOrder S; S.init(T, (F.G == 256) ? 32 * 256 : NIN, F.G, (int)blockIdx.x);
            pg8::EpiIn E{(bf16*)(ws + WS_Q), (bf16*)(ws + WS_KK), (bf16*)(ws + WS_V), (bf16*)(ws + WS_SG), (bf16*)(ws + WS_UB), (bf16*)(ws + WS_GR), (bf16*)(ws + WS_GB),
                         (float*)(ws + WS_LOGF), (const float*)(ws + WS_LB) + l * AW};
            pg8::gemm_phase<pg8::EpiIn, pg8::StaticOrder, true, true, true>(F.lds, g, S, E, F.wave);
            if (_r == ((RPT >> 0) & 1)) SEAM(pb + 0);
        }
        if (EN(1) && IN(pb + 1)) { REP(1) { REP(17) { phase_hgrn_local(F, l); } REP(18) { phase_s5_local(F, l); } } SEAM(pb + 1); }
        if (EN(2) && IN(pb + 2)) { REP(2) { phase_scan(F, l); } SEAM(pb + 2); }
        if (EN(3) && IN(pb + 3)) { REP(3) { REP(15) { phase_hgrn_out(F, l); } REP(16) { phase_s5_out(F, l); } } SEAM(pb + 3); }
        if (EN(4) && IN(pb + 4)) REP(4) {
            unsigned char* ws = opqg(args.ws);
            if (F.G == 256 && blockIdx.x < 128) {
                pg8::Gemm g{(const bf16*)(ws + WS_XH), (const bf16*)(ws + WS_WIN) + (size_t)l * NIN * D, T, NIN, D, T, D, 0, 0};
                pg8::OffOrder S; S.init(T, 4 * 256, F.G, (int)blockIdx.x, 32);
                pg8::EpiIn E{(bf16*)(ws + WS_Q), (bf16*)(ws + WS_KK), (bf16*)(ws + WS_V), (bf16*)(ws + WS_SG), (bf16*)(ws + WS_UB), (bf16*)(ws + WS_GR), (bf16*)(ws + WS_GB),
                             (float*)(ws + WS_LOGF), (const float*)(ws + WS_LB) + l * AW};
                pg8::gemm_phase<pg8::EpiIn, pg8::OffOrder, true, true, true>(F.lds, g, S, E, F.wave);
            } else {
                pg8::Gemm g{(const bf16*)(ws + WS_YB), (const bf16*)(ws + WS_WGLU) + (size_t)l * 2048 * 1024, T, 2048, 1024, 1024, 1024, 0, 0};
                pg8::EpiGlu E{(bf16*)(ws + WS_OAB) + 1024, 2048};
                if (F.G == 256) { pg8::PairOrder S{(int)blockIdx.x, 128, 8, 256}; pg8::gemm_phase<pg8::EpiGlu, pg8::PairOrder, true>(F.lds, g, S, E, F.wave); }
                else { pg8::StaticOrder S; S.init(T, 2048, F.G, (int)blockIdx.x); pg8::gemm_phase<pg8::EpiGlu, pg8::StaticOrder, true>(F.lds, g, S, E, F.wave); }
            }
            if (_r == ((RPT >> 4) & 1)) SEAM(pb + 4);
        }
        if (EN(5) && IN(pb + 5)) REP(5) {
            unsigned char* ws = opqg(args.ws);
            pg8::Gemm g{(const bf16*)(ws + WS_OAB), (const bf16*)(ws + WS_WUP) + (size_t)l * 2048 * 2048, T, 2048, 2048, 2048, 2048, 0, 0};
            pg8::StaticOrder S; S.init(T, 2048, F.G, (int)blockIdx.x);
            pg8::EpiUp E{(bf16*)(ws + WS_MG), (const bf16*)(ws + WS_GR), (const bf16*)(ws + WS_GB)};
            pg8::gemm_phase<pg8::EpiUp, pg8::StaticOrder, true>(F.lds, g, S, E, F.wave);
            if (_r == ((RPT >> 5) & 1)) SEAM(pb + 5);
        }
        if (EN(6) && IN(pb + 6)) REP(6) {
            unsigned char* ws = opqg(args.ws);
            pg8::Gemm g{(const bf16*)(ws + WS_MG), (const bf16*)(ws + WS_WO) + (size_t)l * 2048 * 2048, T, 2048, 2048, 2048, 2048, 0, 0};
            pg8::StaticOrder S; S.init(T, 2048, F.G, (int)blockIdx.x);
            pg8::EpiResH E{(bf16*)(ws + WS_RH), (const bf16*)(ws + WS_XH)};
            pg8::gemm_phase<pg8::EpiResH, pg8::StaticOrder, true>(F.lds, g, S, E, F.wave);
            if (_r == ((RPT >> 6) & 1)) SEAM(pb + 6);
        }
        if (EN(7) && IN(pb + 7)) { REP(7) { phase_ln(F, l, 0); } SEAM(pb + 7); }
        if (EN(8) && IN(pb + 8)) REP(8) {
            unsigned char* ws = opqg(args.ws);
            pg8::Gemm g{(const bf16*)(ws + WS_XH), (const bf16*)(ws + WS_WPQ) + (size_t)l * 2048 * 2048, T, 2048, 2048, T, 2048, 0, 0};
            pg8::StaticOrder S; S.init(T, 2048, F.G, (int)blockIdx.x);
            pg8::EpiBf16 E{(bf16*)(ws + WS_SC), 2048};
            pg8::gemm_phase<pg8::EpiBf16, pg8::StaticOrder, true, true, true>(F.lds, g, S, E, F.wave);
            if (_r == ((RPT >> 8) & 1)) SEAM(pb + 8);
        }
        if (EN(9) && IN(pb + 9)) { REP(9) { phase_topk(F, l); } SEAM(pb + 9); }
        if (EN(9) && IN(pb + 10)) { REP(10) { phase_peer_u(F, l); } SEAM(pb + 10); }
        if (EN(9) && IN(pb + 11)) { REP(11) { phase_peer_v(F, l); } SEAM(pb + 11); }
        if (EN(9) && IN(pb + 12)) { REP(12) { phase_ln(F, l, 1); } SEAM(pb + 12); }
    }
#undef IN
#undef SEAM
}

extern "C" void kernel_launch(void* const* d_in, const int* in_sizes, int n_in, void* d_out, int out_size, void* d_ws, size_t ws_size, hipStream_t stream) {
    static int grid = 0;
    if (grid == 0) {
        if (n_in != 24 || out_size != T * D || ws_size < WS_END) { fprintf(stderr, "kernel_launch: unexpected sizes (n_in %d out %d ws %zu need %zu)\n", n_in, out_size, ws_size, (size_t)WS_END); grid = -1; return; }
        int dev = 0, cus = 0, per_cu = 0;
        if (hipGetDevice(&dev) != hipSuccess || hipDeviceGetAttribute(&cus, hipDeviceAttributeMultiprocessorCount, dev) != hipSuccess) { grid = -1; return; }
        if (hipFuncSetAttribute((const void*)fwd_kernel, hipFuncAttributeMaxDynamicSharedMemorySize, LDS_BYTES) != hipSuccess) { fprintf(stderr, "kernel_launch: hipFuncSetAttribute failed\n"); grid = -1; return; }
        if (hipOccupancyMaxActiveBlocksPerMultiprocessor(&per_cu, (const void*)fwd_kernel, 512, LDS_BYTES) != hipSuccess || per_cu < 1)
            fprintf(stderr, "kernel_launch: occupancy query reports %d\n", per_cu);
        (void)hipGetLastError();
        grid = cus;
    }
    if (grid < 0) return;
    if (hipMemsetAsync((char*)d_ws + WS_CTL, 0, CTL_ZERO_BYTES, stream) != hipSuccess) return;
    Args a{};
    for (int i = 0; i < 24; ++i) a.in[i] = (const float*)d_in[i];
    a.out = (float*)d_out; a.ws = (unsigned char*)d_ws;
#if ONE_LAUNCH
    a.ph_lo = 0; a.ph_hi = N_PHASES;
    hipLaunchKernelGGL(fwd_kernel, dim3(grid), dim3(512), LDS_BYTES, stream, a);
#else
    for (int p = 0; p < N_PHASES; ++p) { a.ph_lo = p; a.ph_hi = p + 1; hipLaunchKernelGGL(fwd_kernel, dim3(grid), dim3(512), LDS_BYTES, stream, a); }
#endif
}
```

```cpp
#include <hip/hip_runtime.h>
#include <cstdio>
#include <cstdint>

#define LAS __attribute__((address_space(3)))
#define GAS __attribute__((address_space(1)))
typedef unsigned short bf16;
typedef unsigned v4u __attribute__((ext_vector_type(4)));
typedef unsigned v2u __attribute__((ext_vector_type(2)));
typedef float f32x4 __attribute__((ext_vector_type(4)));
typedef float f32x2 __attribute__((ext_vector_type(2)));
typedef short bf16x8 __attribute__((ext_vector_type(8)));
typedef short s16x4 __attribute__((ext_vector_type(4)));

#ifndef ONE_LAUNCH
#define ONE_LAUNCH 1
#endif

constexpr int T = 8192, D = 2048, DEPTH = 4, NIN = 9216;
constexpr int AW = 1024;
constexpr int NCH = 128;
constexpr float ALPHA = 1.6817928305074290f;
constexpr float LN_EPS = 1e-5f, RMS_EPS = 1e-6f;
constexpr int NEXP = 16384;
constexpr int LP = 160;
constexpr int NSLOT = 24;

constexpr size_t MiB = 1u << 20;
constexpr size_t WS_CTL = 0, CTL_ZERO_BYTES = 32768;
constexpr size_t WS_WIN  = 1 * MiB;
constexpr size_t WS_WGLU = WS_WIN + 144 * MiB;
constexpr size_t WS_WUP  = WS_WGLU + 16 * MiB;
constexpr size_t WS_WO   = WS_WUP + 32 * MiB;
constexpr size_t WS_WQB  = WS_WO + 32 * MiB;
constexpr size_t WS_BK   = WS_WQB + 32 * MiB;
constexpr size_t WS_WPQ  = WS_BK + 4 * MiB;
constexpr size_t WS_LB   = WS_WPQ + 32 * MiB;
constexpr size_t WS_APOW = WS_LB + 1 * MiB;
constexpr size_t WS_BB   = WS_APOW + 9 * MiB;
constexpr size_t WS_KMAT = WS_BB + 2 * MiB;
constexpr size_t WS_PM   = WS_KMAT + 9 * MiB;
constexpr size_t WS_E    = WS_PM + 64 * MiB;
constexpr size_t WS_X32  = WS_E + 64 * MiB;
constexpr size_t WS_X1   = WS_X32 + 64 * MiB;
constexpr size_t WS_XB   = WS_X1 + 64 * MiB;
constexpr size_t WS_Q    = WS_XB + 32 * MiB;
constexpr size_t WS_KK   = WS_Q + 16 * MiB;
constexpr size_t WS_V    = WS_KK + 16 * MiB;
constexpr size_t WS_SG   = WS_V + 16 * MiB;
constexpr size_t WS_UB   = WS_SG + 16 * MiB;
constexpr size_t WS_LOGF = WS_UB + 16 * MiB;
constexpr size_t WS_GR   = WS_LOGF + 32 * MiB;
constexpr size_t WS_GB   = WS_GR + 32 * MiB;
constexpr size_t WS_U    = WS_GB + 32 * MiB;
constexpr size_t WS_SP   = WS_U + 64 * MiB;
constexpr size_t WS_BL   = WS_SP + 32 * MiB;
constexpr size_t WS_XLOC = WS_BL + 1 * MiB;
constexpr size_t WS_XS   = WS_XLOC + 4 * MiB;
constexpr size_t WS_OAB  = WS_XS + 4 * MiB;
constexpr size_t WS_YB   = WS_OAB + 32 * MiB;
constexpr size_t WS_MG   = WS_YB + 16 * MiB;
constexpr size_t WS_R    = WS_MG + 32 * MiB;
constexpr size_t WS_SC   = WS_R + 64 * MiB;
constexpr size_t WS_TBU  = WS_SC + 64 * MiB;
constexpr size_t WS_TBV  = WS_TBU + 256 * MiB;
constexpr size_t WS_SEID = WS_TBV + 256 * MiB;
constexpr size_t WS_SGATE= WS_SEID + 6 * MiB;
constexpr size_t WS_PACK = WS_SGATE + 4 * MiB;
constexpr size_t WS_START= WS_PACK + 6 * MiB;
constexpr size_t WS_PACK2= WS_START + 1 * MiB;
constexpr size_t WS_XBS  = WS_PACK2 + 13 * MiB;
constexpr size_t WS_END  = WS_XBS + 32 * MiB;
constexpr size_t WS_XH = WS_XBS;
constexpr size_t WS_XQ = WS_X1;
constexpr size_t WS_SX = WS_X1 + 16 * MiB;
constexpr size_t WS_SU = WS_X1 + 17 * MiB;
constexpr size_t WS_RH = WS_R;

constexpr int CW_TMO = 0, CW_CODE = 1;
constexpr int CW_BAR = 4096;

constexpr int RING_BYTES = 131072;
constexpr int LDSCTL_OFF = RING_BYTES, MISC_OFF = LDSCTL_OFF + 320;
constexpr int LDS_BYTES = 147456;

#define LDS_WAIT() asm volatile("s_waitcnt lgkmcnt(0)" ::: "memory")
#define VM_WAIT() asm volatile("s_waitcnt vmcnt(0)" ::: "memory")
__device__ __forceinline__ unsigned cvt_pk_bf16(float lo, float hi) { unsigned r; asm volatile("v_cvt_pk_bf16_f32 %0, %1, %2" : "=v"(r) : "v"(lo), "v"(hi)); return r; }
typedef _Float16 h2_t __attribute__((ext_vector_type(2)));
__device__ __forceinline__ unsigned cvt_pk_f16a(float lo, float hi) { unsigned r; asm volatile("v_cvt_pk_f16_f32 %0, %1, %2" : "=v"(r) : "v"(lo), "v"(hi)); return r; }
__device__ __forceinline__ unsigned cvt_pk_f16(float lo, float hi) { h2_t p; p.x = (_Float16)lo; p.y = (_Float16)hi; return __builtin_bit_cast(unsigned, p); }
__device__ __forceinline__ float dot2h(unsigned a, unsigned b, float c) { return __builtin_amdgcn_fdot2(__builtin_bit_cast(h2_t, a), __builtin_bit_cast(h2_t, b), c, false); }
__device__ __forceinline__ unsigned pkfmah(unsigned a, unsigned b, unsigned c) { return __builtin_bit_cast(unsigned, __builtin_elementwise_fma(__builtin_bit_cast(h2_t, a), __builtin_bit_cast(h2_t, b), __builtin_bit_cast(h2_t, c))); }
__device__ __forceinline__ float bf_lo(unsigned u) { return __uint_as_float(u << 16); }
__device__ __forceinline__ float bf_hi(unsigned u) { return __uint_as_float(u & 0xffff0000u); }
__device__ __forceinline__ float bf2f(bf16 b) { return __uint_as_float(((unsigned)b) << 16); }
__device__ __forceinline__ bf16 f2bf(float f) { return (bf16)(cvt_pk_bf16(f, 0.f) & 0xffffu); }
__device__ __forceinline__ float fexp(float x) { return __builtin_amdgcn_exp2f(x * 1.4426950408889634f); }
__device__ __forceinline__ float flog(float x) { return __builtin_amdgcn_logf(x) * 0.6931471805599453f; }
__device__ __forceinline__ float frcp(float x) { return __builtin_amdgcn_rcpf(x); }
__device__ __forceinline__ float gelu_tanh(float x) {
    const float u = 1.5957691216057308f * (x + 0.044715f * x * x * x);
    const float uc = fminf(fmaxf(u, -60.f), 60.f);
    return x * frcp(1.f + fexp(-uc));
}
__device__ __forceinline__ int lane_id() { int r; asm volatile("v_mbcnt_lo_u32_b32 %0, -1, 0\n\tv_mbcnt_hi_u32_b32 %0, -1, %0" : "=v"(r)); return r; }
__device__ __forceinline__ float wave_sum(float v) {
#pragma unroll
    for (int o = 1; o < 64; o <<= 1) v += __shfl_xor(v, o);
    return v;
}

__device__ __forceinline__ void vlaunder(int& a, int& b) { asm volatile("" : "+v"(a), "+v"(b)); }
template <class P> __device__ __forceinline__ P* opq(P* p) { asm volatile("" : "+s"(p)); return p; }
__device__ __forceinline__ unsigned char* opqg(unsigned char* p) { GAS unsigned char* g = (GAS unsigned char*)p; asm volatile("" : "+s"(g)); return (unsigned char*)g; }
#define GP(T, p) ((T*)(GAS T*)(p))

namespace pg8 {
#define PG8_LAS __attribute__((address_space(3)))
typedef unsigned short bf16_t;
constexpr int BM = 256, BK = 64, HALF = 128, HTB = HALF * BK * 2, STAGE_BYTES = 8 * HTB, NXCD = 8, WGM = 8;

__host__ __device__ __forceinline__ int lds_byte(int r, int c) { const int st = (r >> 4) * 2 + (c >> 5), rr = r & 15, cc = c & 31, ob = rr * 64 + cc * 2; return st * 1024 + (ob ^ (((ob >> 9) & 1) << 5)); }
__host__ __device__ __forceinline__ void stage_rc(int b, int& R, int& C) { const int st = b / 1024, sb = b % 1024, swz = sb ^ (((sb >> 9) & 1) << 5); R = (st >> 1) * 16 + swz / 64; C = (st & 1) * 32 + (swz % 64) / 2; }
__host__ __device__ __forceinline__ int perm32(int rho) { const int n = rho >> 4, i = rho & 15; return 8 * (i >> 2) + 4 * n + (i & 3); }

struct Unit { int pm, pn; };
struct Gemm { const bf16_t* A; const bf16_t* Bt; int M, N, K, lda, ldb, bkoff; long blstride; };

struct StaticOrder {
    int nM, nN, nwg, G, c;
    __host__ __device__ void init(int M, int N, int G_, int c_) { nM = M / BM; nN = N / BM; nwg = nM * nN; G = G_; c = c_; }
    __host__ __device__ bool next(int i, Unit& u) const {
        const long L = (long)i * G + c; if (L >= nwg) return false;
        int wgid = (int)L; { const int q = nwg / NXCD, r = nwg % NXCD, xcd = wgid % NXCD, off = wgid / NXCD; wgid = (xcd < r ? xcd * (q + 1) : r * (q + 1) + (xcd - r) * q) + off; }
        const int nig = WGM * nN, gid = wgid / nig, fm = gid * WGM, gsz = (nM - fm) < WGM ? (nM - fm) : WGM;
        u.pm = fm + ((wgid % nig) % gsz); u.pn = (wgid % nig) / gsz; return true;
    }
    __device__ __forceinline__ void a_ready(const Unit&) const {}
    __device__ __forceinline__ void done(const Unit&) const {}
};

struct OffOrder {
    StaticOrder b; int pn0;
    __device__ void init(int M, int N, int G_, int c_, int pn0_) { b.init(M, N, G_, c_); pn0 = pn0_; }
    __device__ bool next(int i, Unit& u) const { if (!b.next(i, u)) return false; u.pn += pn0; return true; }
    __device__ __forceinline__ void a_ready(const Unit&) const {}
    __device__ __forceinline__ void done(const Unit&) const {}
};
struct PairOrder {
    int c, c0, nN, nwg;
    __device__ bool next(int i, Unit& u) const { if (c < c0 || i >= 2) return false; const int id = (c - c0) * 2 + i; if (id >= nwg) return false; u.pm = id / nN; u.pn = id % nN; return true; }
    __device__ __forceinline__ void a_ready(const Unit&) const {}
    __device__ __forceinline__ void done(const Unit&) const {}
};
typedef f32x4 Acc[2][2][4][2];

typedef _Float16 f16x8 __attribute__((ext_vector_type(8)));
template <class Epi, class Sched, bool ALIGN_EPI = false, bool F16 = false, bool ASL = false>
__device__ __forceinline__ void gemm_phase(PG8_LAS unsigned char* lds, const Gemm g, const Sched& S, const Epi& E, int wv) {
    int tid_ = wv * 64 + lane_id(); asm volatile("" : "+v"(tid_));
    const int tid = tid_, wid = __builtin_amdgcn_readfirstlane(tid >> 6), lane = tid & 63, wr = wid >> 2, wc = wid & 3, fr = lane & 15, fq = lane >> 4;
    const int K = g.K, nt = K / BK;
    unsigned voffA[2], voffB[2];
#pragma unroll
    for (int i = 0; i < 2; ++i) { int R, C; stage_rc(tid * 16 + i * 8192, R, C); const int Rb = Epi::PERM ? ((R & ~31) + perm32(R & 31)) : R;
        voffA[i] = ASL ? (unsigned)(((C >> 5) * g.lda + R) * 64 + (C & 31) * 2) : (unsigned)(R * g.lda + C) * 2u; voffB[i] = (unsigned)(Rb * g.ldb + C) * 2u; }
    const size_t kstep = (size_t)(BK * 2), kstepA = ASL ? (size_t)g.lda * 128 : (size_t)(BK * 2);
    const size_t hstepA = ASL ? (size_t)HALF * 64 : (size_t)HALF * g.lda * 2, hstepB = (size_t)HALF * g.ldb * 2;
    const size_t tstepA = 2 * hstepA, tstepB = 2 * hstepB;
    const unsigned ldsw = (unsigned)wid * 1024u;
    const int aoff = lds_byte(wr * 64 + fr, fq * 8), boff = lds_byte(wc * 32 + fr, fq * 8);
#define PG8_SA(b, h) (((b) * 2 + (h)) * HTB)
#define PG8_SB(b, h) ((4 + (b) * 2 + (h)) * HTB)
#define PG8_STAGE(bufoff, gbase, voff) do { _Pragma("unroll") for (int _i = 0; _i < 2; ++_i) \
        __builtin_amdgcn_global_load_lds((const unsigned*)((const char*)(gbase) + (voff)[_i]), (PG8_LAS unsigned*)(lds + (bufoff) + ldsw + _i * 8192), 16, 0, 0); } while (0)
#define PG8_LDA(dst, b, h) do { _Pragma("unroll") for (int m = 0; m < 4; ++m) _Pragma("unroll") for (int k = 0; k < 2; ++k) dst[m][k] = *(const PG8_LAS bf16x8*)(lds + PG8_SA(b, h) + aoff + m * 2048 + k * 1024); } while (0)
#define PG8_LDB(dst, b, h) do { _Pragma("unroll") for (int n = 0; n < 2; ++n) _Pragma("unroll") for (int k = 0; k < 2; ++k) dst[n][k] = *(const PG8_LAS bf16x8*)(lds + PG8_SB(b, h) + boff + n * 2048 + k * 1024); } while (0)
#define PG8_MMA(ai, bj, At, Bt) do { __builtin_amdgcn_s_setprio(1); _Pragma("unroll") for (int m = 0; m < 4; ++m) _Pragma("unroll") for (int n = 0; n < 2; ++n) _Pragma("unroll") for (int k = 0; k < 2; ++k) \
        { if constexpr (F16) acc[ai][bj][m][n] = __builtin_amdgcn_mfma_f32_16x16x32_f16(__builtin_bit_cast(f16x8, Bt[n][k]), __builtin_bit_cast(f16x8, At[m][k]), acc[ai][bj][m][n], 0, 0, 0); \
          else acc[ai][bj][m][n] = __builtin_amdgcn_mfma_f32_16x16x32_bf16(Bt[n][k], At[m][k], acc[ai][bj][m][n], 0, 0, 0); } __builtin_amdgcn_s_setprio(0); } while (0)
#define PG8_WAIT_V(n) asm volatile("s_waitcnt vmcnt(" #n ")" ::: "memory")
#define PG8_WAIT_L(n) asm volatile("s_waitcnt lgkmcnt(" #n ")" ::: "memory")
#define PG8_BAR __builtin_amdgcn_s_barrier()
#define PG8_SCHED __builtin_amdgcn_sched_barrier(0)
    Unit cur, nxt; int ui = 0;
    if (!S.next(0, cur)) return;
    Acc acc;
#pragma unroll
    for (int a = 0; a < 2; ++a)
#pragma unroll
        for (int b = 0; b < 2; ++b)
#pragma unroll
            for (int m = 0; m < 4; ++m)
#pragma unroll
                for (int n = 0; n < 2; ++n) acc[a][b][m][n] = (f32x4){0.f, 0.f, 0.f, 0.f};
    bf16x8 At[4][2], B0[2][2], B1[2][2];
    const char* cA = (const char*)g.A + (size_t)cur.pm * tstepA;
    const char* cB = (const char*)g.Bt + (size_t)cur.pn * tstepB + ((size_t)(cur.pm & 7) * g.bkoff + (size_t)(cur.pm >> 3) * g.blstride) * 2;
    S.a_ready(cur);
    PG8_STAGE(PG8_SB(0, 0), cB, voffB); PG8_STAGE(PG8_SB(0, 1), cB + hstepB, voffB); PG8_STAGE(PG8_SA(0, 0), cA, voffA); PG8_STAGE(PG8_SA(0, 1), cA + hstepA, voffA);
    if (wr == 1) PG8_BAR;
    PG8_WAIT_V(2); PG8_BAR;
    PG8_STAGE(PG8_SB(1, 0), cB + kstep, voffB); PG8_STAGE(PG8_SA(1, 0), cA + kstepA, voffA); PG8_STAGE(PG8_SB(1, 1), cB + hstepB + kstep, voffB);
    PG8_WAIT_V(6); PG8_BAR;
    for (;;) {
        const bool has_next = S.next(ui + 1, nxt);
        const char* nA = has_next ? (const char*)g.A + (size_t)nxt.pm * tstepA : cA;
        const char* nB = has_next ? (const char*)g.Bt + (size_t)nxt.pn * tstepB + ((size_t)(nxt.pm & 7) * g.bkoff + (size_t)(nxt.pm >> 3) * g.blstride) * 2 : cB;
        for (int t = 0; t < nt; t += 2) {
            const bool last = (t == nt - 2);
            const char* a1 = cA + (size_t)(t + 1) * kstepA;
            const char* a2 = last ? nA : cA + (size_t)(t + 2) * kstepA; const char* b2 = last ? nB : cB + (size_t)(t + 2) * kstep;
            const char* a3 = a2 + kstepA; const char* b3 = b2 + kstep;
            if (last && has_next) S.a_ready(nxt);
            PG8_LDB(B0, 0, 0); PG8_LDB(B1, 0, 1); PG8_SCHED; PG8_LDA(At, 0, 0); PG8_STAGE(PG8_SA(1, 1), a1 + hstepA, voffA);
            PG8_WAIT_V(8); PG8_WAIT_L(0); PG8_BAR; PG8_MMA(0, 0, At, B0); PG8_MMA(0, 1, At, B1); PG8_BAR; PG8_SCHED;
            PG8_LDA(At, 0, 1); PG8_STAGE(PG8_SB(0, 0), b2, voffB); PG8_STAGE(PG8_SB(0, 1), b2 + hstepB, voffB); PG8_STAGE(PG8_SA(0, 0), a2, voffA);
            PG8_WAIT_V(8); PG8_WAIT_L(0); PG8_BAR; PG8_MMA(1, 0, At, B0); PG8_MMA(1, 1, At, B1); PG8_BAR; PG8_SCHED;
            PG8_LDB(B0, 1, 0); PG8_LDB(B1, 1, 1); PG8_SCHED; PG8_LDA(At, 1, 0); PG8_STAGE(PG8_SA(0, 1), a2 + hstepA, voffA);
            PG8_WAIT_V(8); PG8_WAIT_L(0); PG8_BAR; PG8_MMA(0, 0, At, B0); PG8_MMA(0, 1, At, B1); PG8_BAR; PG8_SCHED;
            PG8_LDA(At, 1, 1); PG8_STAGE(PG8_SB(1, 0), b3, voffB); PG8_STAGE(PG8_SB(1, 1), b3 + hstepB, voffB); PG8_STAGE(PG8_SA(1, 0), a3, voffA);
            PG8_WAIT_V(8); PG8_WAIT_L(0); PG8_BAR; PG8_MMA(1, 0, At, B0); PG8_MMA(1, 1, At, B1); PG8_BAR; PG8_SCHED;
            if constexpr (Epi::HAS_MID) { if (t + 2 == (nt >> 1)) E.mid(acc, cur, wr, wc, fr, fq); }
        }
        if constexpr (ALIGN_EPI) { if (wr == 0) PG8_BAR; }
        E(acc, cur, wr, wc, fr, fq); S.done(cur);
        if (!has_next) break;
#pragma unroll
        for (int a = 0; a < 2; ++a)
#pragma unroll
            for (int b = 0; b < 2; ++b)
#pragma unroll
                for (int m = 0; m < 4; ++m)
#pragma unroll
                    for (int n = 0; n < 2; ++n) acc[a][b][m][n] = (f32x4){0.f, 0.f, 0.f, 0.f};
        cur = nxt; cA = nA; cB = nB; ++ui;
        if constexpr (ALIGN_EPI) { if (wr == 1) PG8_BAR; }
    }
    PG8_WAIT_V(0);
    if constexpr (!ALIGN_EPI) { if (wr == 0) PG8_BAR; }
    PG8_BAR;
#undef PG8_SA
#undef PG8_SB
#undef PG8_STAGE
#undef PG8_LDA
#undef PG8_LDB
#undef PG8_MMA
#undef PG8_WAIT_V
#undef PG8_WAIT_L
#undef PG8_BAR
#undef PG8_SCHED
}

struct EpiResH {
    static constexpr bool PERM = true, HAS_MID = false;
    bf16_t* RS; const bf16_t* XS;
    __device__ __forceinline__ void operator()(const Acc& acc, const Unit& u, int wr, int wc, int fr, int fq) const {
        vlaunder(fr, fq);
        const int row0 = u.pm * BM + wr * 64 + fr, sl0 = u.pn * 8 + wc;
#pragma unroll
        for (int ai = 0; ai < 2; ++ai) {
            v4u xw[4][2];
#pragma unroll
            for (int m = 0; m < 4; ++m)
#pragma unroll
                for (int bj = 0; bj < 2; ++bj) xw[m][bj] = *(const v4u*)(XS + ((size_t)(sl0 + bj * 4) * T + (row0 + ai * HALF + m * 16)) * 32 + 8 * fq);
#pragma unroll
            for (int m = 0; m < 4; ++m) {
#pragma unroll
                for (int bj = 0; bj < 2; ++bj) { const size_t eo = ((size_t)(sl0 + bj * 4) * T + (row0 + ai * HALF + m * 16)) * 32 + 8 * fq;
                    const f32x4 v0 = acc[ai][bj][m][0], v1 = acc[ai][bj][m][1];
                    const unsigned a0 = xw[m][bj].x, a1 = xw[m][bj].y, a2 = xw[m][bj].z, a3 = xw[m][bj].w;
                    const h2_t x0 = __builtin_bit_cast(h2_t, a0), x1 = __builtin_bit_cast(h2_t, a1), x2 = __builtin_bit_cast(h2_t, a2), x3 = __builtin_bit_cast(h2_t, a3);
                    v4u w; w.x = cvt_pk_f16a(v0[0] + ALPHA * (float)x0.x, v0[1] + ALPHA * (float)x0.y); w.y = cvt_pk_f16a(v0[2] + ALPHA * (float)x1.x, v0[3] + ALPHA * (float)x1.y);
                    w.z = cvt_pk_f16a(v1[0] + ALPHA * (float)x2.x, v1[1] + ALPHA * (float)x2.y); w.w = cvt_pk_f16a(v1[2] + ALPHA * (float)x3.x, v1[3] + ALPHA * (float)x3.y);
                    *(v4u*)(RS + eo) = w; } }
        }
    }
};
struct EpiF16 {
    static constexpr bool PERM = true, HAS_MID = false;
    bf16_t* O; int ldc;
    __device__ __forceinline__ void operator()(const Acc& acc, const Unit& u, int wr, int wc, int fr, int fq) const {
        vlaunder(fr, fq);
        const int row0 = u.pm * BM + wr * 64 + fr, col0 = u.pn * BM + wc * 32 + 8 * fq;
#pragma unroll
        for (int ai = 0; ai < 2; ++ai)
#pragma unroll
            for (int m = 0; m < 4; ++m) { bf16_t* rowp = O + (size_t)(row0 + ai * HALF + m * 16) * ldc + col0;
#pragma unroll
                for (int bj = 0; bj < 2; ++bj) { const f32x4 v0 = acc[ai][bj][m][0], v1 = acc[ai][bj][m][1];
                    v4u w; w.x = cvt_pk_f16a(v0[0], v0[1]); w.y = cvt_pk_f16a(v0[2], v0[3]); w.z = cvt_pk_f16a(v1[0], v1[1]); w.w = cvt_pk_f16a(v1[2], v1[3]);
                    *(v4u*)(rowp + bj * HALF) = w; } }
    }
};
struct EpiBf16 {
    static constexpr bool PERM = true, HAS_MID = false;
    bf16_t* O; int ldc;
    __device__ __forceinline__ void operator()(const Acc& acc, const Unit& u, int wr, int wc, int fr, int fq) const {
        vlaunder(fr, fq);
        const int row0 = u.pm * BM + wr * 64 + fr, col0 = u.pn * BM + wc * 32 + 8 * fq;
#pragma unroll
        for (int ai = 0; ai < 2; ++ai)
#pragma unroll
            for (int m = 0; m < 4; ++m) { bf16_t* rowp = O + (size_t)(row0 + ai * HALF + m * 16) * ldc + col0;
#pragma unroll
                for (int bj = 0; bj < 2; ++bj) { const f32x4 v0 = acc[ai][bj][m][0], v1 = acc[ai][bj][m][1];
                    v4u w; w.x = cvt_pk_bf16(v0[0], v0[1]); w.y = cvt_pk_bf16(v0[2], v0[3]); w.z = cvt_pk_bf16(v1[0], v1[1]); w.w = cvt_pk_bf16(v1[2], v1[3]);
                    *(v4u*)(rowp + bj * HALF) = w; } }
    }
};
struct EpiIn {
    static constexpr bool PERM = true, HAS_MID = false;
    bf16_t *Q, *KK, *V, *SG, *UB, *GR, *GB; float* LOGF; const float* lb;
    __device__ __forceinline__ void operator()(const Acc& acc, const Unit& u, int wr, int wc, int fr, int fq) const {
        vlaunder(fr, fq);
        const int row0 = u.pm * BM + wr * 64 + fr;
        const int pn = u.pn;
        if (pn >= 20) {
            const int col0 = (pn - 20) * 128 + wc * 32 + 8 * fq;
#pragma unroll
            for (int ai = 0; ai < 2; ++ai)
#pragma unroll
                for (int m = 0; m < 4; ++m) { const size_t ro = (size_t)(row0 + ai * HALF + m * 16) * 2048 + col0;
                    float rr[8], gg[8];
#pragma unroll
                    for (int n = 0; n < 2; ++n)
#pragma unroll
                        for (int x = 0; x < 4; ++x) { const float za = fminf(fmaxf(acc[ai][0][m][n][x], -30.f), 30.f), zb = fminf(fmaxf(acc[ai][1][m][n][x], -30.f), 30.f);
                            const float ea = fexp(-za), eb = fexp(-zb); gg[n * 4 + x] = frcp(1.f + eb); rr[n * 4 + x] = (1.f + eb) * frcp(1.f + ea); }
                    v4u w; w.x = cvt_pk_bf16(rr[0], rr[1]); w.y = cvt_pk_bf16(rr[2], rr[3]); w.z = cvt_pk_bf16(rr[4], rr[5]); w.w = cvt_pk_bf16(rr[6], rr[7]);
                    *(v4u*)(GR + ro) = w;
                    w.x = cvt_pk_bf16(gg[0], gg[1]); w.y = cvt_pk_bf16(gg[2], gg[3]); w.z = cvt_pk_bf16(gg[4], gg[5]); w.w = cvt_pk_bf16(gg[6], gg[7]);
                    *(v4u*)(GB + ro) = w; }
            return;
        }
        const int sec = pn >> 2, col0 = (pn & 3) * 256 + wc * 32 + 8 * fq;
        if (sec == 1) {
#pragma unroll
            for (int bj = 0; bj < 2; ++bj) {
                const f32x4 l0 = *(const f32x4*)(lb + col0 + bj * HALF), l1 = *(const f32x4*)(lb + col0 + bj * HALF + 4);
#pragma unroll
                for (int ai = 0; ai < 2; ++ai)
#pragma unroll
                    for (int m = 0; m < 4; ++m) { const size_t ro = (size_t)(row0 + ai * HALF + m * 16) * 1024 + col0 + bj * HALF;
                        float lf[8], kk[8];
#pragma unroll
                        for (int n = 0; n < 2; ++n)
#pragma unroll
                            for (int x = 0; x < 4; ++x) { const float z = fminf(fmaxf(acc[ai][bj][m][n][x], -30.f), 30.f); const float lbv = n ? l1[x] : l0[x];
                                const float e = fexp(-z), s = frcp(1.f + e); const float f = lbv + (1.f - lbv) * s;
                                lf[n * 4 + x] = flog(f); kk[n * 4 + x] = (1.f - lbv) * (e * s); }
                        *(f32x4*)(LOGF + ro) = (f32x4){lf[0], lf[1], lf[2], lf[3]}; *(f32x4*)(LOGF + ro + 4) = (f32x4){lf[4], lf[5], lf[6], lf[7]};
                        v4u w; w.x = cvt_pk_bf16(kk[0], kk[1]); w.y = cvt_pk_bf16(kk[2], kk[3]); w.z = cvt_pk_bf16(kk[4], kk[5]); w.w = cvt_pk_bf16(kk[6], kk[7]);
                        *(v4u*)(KK + ro) = w; }
            }
            return;
        }
        bf16_t* dst = sec == 0 ? Q : (sec == 2 ? V : (sec == 3 ? SG : UB));
        const bool sig = (sec == 3);
#pragma unroll
        for (int ai = 0; ai < 2; ++ai)
#pragma unroll
            for (int m = 0; m < 4; ++m) { bf16_t* rowp = dst + (size_t)(row0 + ai * HALF + m * 16) * 1024 + col0;
#pragma unroll
                for (int bj = 0; bj < 2; ++bj) { f32x4 v0 = acc[ai][bj][m][0], v1 = acc[ai][bj][m][1];
                    if (sig) {
#pragma unroll
                        for (int x = 0; x < 4; ++x) { v0[x] = frcp(1.f + fexp(-fminf(fmaxf(v0[x], -30.f), 30.f))); v1[x] = frcp(1.f + fexp(-fminf(fmaxf(v1[x], -30.f), 30.f))); } }
                    v4u w; w.x = cvt_pk_bf16(v0[0], v0[1]); w.y = cvt_pk_bf16(v0[2], v0[3]); w.z = cvt_pk_bf16(v1[0], v1[1]); w.w = cvt_pk_bf16(v1[2], v1[3]);
                    *(v4u*)(rowp + bj * HALF) = w; } }
    }
};
struct EpiGlu {
    static constexpr bool PERM = true, HAS_MID = false;
    bf16_t* O; int ldc;
    __device__ __forceinline__ void operator()(const Acc& acc, const Unit& u, int wr, int wc, int fr, int fq) const {
        vlaunder(fr, fq);
        const int row0 = u.pm * BM + wr * 64 + fr, col0 = u.pn * 128 + wc * 32 + 8 * fq;
#pragma unroll
        for (int ai = 0; ai < 2; ++ai)
#pragma unroll
            for (int m = 0; m < 4; ++m) { float o[8];
#pragma unroll
                for (int n = 0; n < 2; ++n)
#pragma unroll
                    for (int x = 0; x < 4; ++x) { const float h2 = fminf(fmaxf(acc[ai][1][m][n][x], -30.f), 30.f); o[n * 4 + x] = acc[ai][0][m][n][x] * frcp(1.f + fexp(-h2)); }
                v4u w; w.x = cvt_pk_bf16(o[0], o[1]); w.y = cvt_pk_bf16(o[2], o[3]); w.z = cvt_pk_bf16(o[4], o[5]); w.w = cvt_pk_bf16(o[6], o[7]);
                *(v4u*)(O + (size_t)(row0 + ai * HALF + m * 16) * ldc + col0) = w; }
    }
};
struct EpiUp {
    static constexpr bool PERM = true, HAS_MID = true;
    bf16_t* O; const bf16_t *GR, *GB;
    __device__ __forceinline__ void scale(Acc& acc, const bf16_t* G, const Unit& u, int wr, int wc, int fr, int fq) const {
        vlaunder(fr, fq);
        const int row0 = u.pm * BM + wr * 64 + fr, col0 = u.pn * BM + wc * 32 + 8 * fq;
#pragma unroll
        for (int ai = 0; ai < 2; ++ai) {
            v4u gw[4][2];
#pragma unroll
            for (int m = 0; m < 4; ++m)
#pragma unroll
                for (int bj = 0; bj < 2; ++bj) gw[m][bj] = *(const v4u*)(G + (size_t)(row0 + ai * HALF + m * 16) * 2048 + col0 + bj * HALF);
            __builtin_amdgcn_sched_barrier(0);
#pragma unroll
            for (int m = 0; m < 4; ++m) {
#pragma unroll
                for (int bj = 0; bj < 2; ++bj) { const v4u w = gw[m][bj];
                    acc[ai][bj][m][0] *= (f32x4){bf_lo(w.x), bf_hi(w.x), bf_lo(w.y), bf_hi(w.y)};
                    acc[ai][bj][m][1] *= (f32x4){bf_lo(w.z), bf_hi(w.z), bf_lo(w.w), bf_hi(w.w)}; } }
            __builtin_amdgcn_sched_barrier(0); }
    }
    __device__ __forceinline__ void mid(Acc& acc, const Unit& u, int wr, int wc, int fr, int fq) const { scale(acc, GR, u, wr, wc, fr, fq); }
    __device__ __forceinline__ void operator()(Acc& acc, const Unit& u, int wr, int wc, int fr, int fq) const {
        scale(acc, GB, u, wr, wc, fr, fq);
        const int row0 = u.pm * BM + wr * 64 + fr, col0 = u.pn * BM + wc * 32 + 8 * fq;
#pragma unroll
        for (int ai = 0; ai < 2; ++ai)
#pragma unroll
            for (int m = 0; m < 4; ++m) { bf16_t* rowp = O + (size_t)(row0 + ai * HALF + m * 16) * 2048 + col0;
#pragma unroll
                for (int bj = 0; bj < 2; ++bj) { const f32x4 v0 = acc[ai][bj][m][0], v1 = acc[ai][bj][m][1];
                    v4u w; w.x = cvt_pk_bf16(v0[0], v0[1]); w.y = cvt_pk_bf16(v0[2], v0[3]); w.z = cvt_pk_bf16(v1[0], v1[1]); w.w = cvt_pk_bf16(v1[2], v1[3]);
                    *(v4u*)(rowp + bj * HALF) = w; } }
    }
};
}

#define XB_TMO      128
#define XB_XCNT(j)  (256  + 64 * (j))
#define XB_XSUB(j)  (1280 + 64 * (j))
#define XB_XGEN(j)  (2304 + 64 * (j))
#define XB_TOP      3328
#define XB_TOPGEN   3392
#define XCD_BAR_WORDS 3456
#define XB_SPIN_CAP (1u << 20)

__device__ __forceinline__ unsigned xb_ld(unsigned* p)              { return __hip_atomic_load(p, __ATOMIC_RELAXED, __HIP_MEMORY_SCOPE_AGENT); }
__device__ __forceinline__ unsigned xb_add(unsigned* p, unsigned v) { return __hip_atomic_fetch_add(p, v, __ATOMIC_RELAXED, __HIP_MEMORY_SCOPE_AGENT); }
__device__ __forceinline__ unsigned xb_xcc_id() { return (unsigned)__builtin_amdgcn_s_getreg((3 << 11) | 20) & 0xFu; }
#define XB_SPIN(cond, bar) do { unsigned _sp = 0; while (cond) { __builtin_amdgcn_s_sleep(1); \
    if ((++_sp & 255u) == 0u) { if (xb_ld(&(bar)[XB_TMO])) break; if (_sp > XB_SPIN_CAP) { atomicAdd(&(bar)[XB_TMO], 1u); break; } } } } while (0)

struct XcdBarrier { unsigned* bar; unsigned x; volatile LAS unsigned* st; };

__device__ __forceinline__ XcdBarrier xcd_barrier_post(unsigned* bar, volatile LAS unsigned* st, bool leader) {
    XcdBarrier b; b.bar = bar; b.x = xb_xcc_id(); b.st = st;
    if (leader) (void)xb_add(&bar[XB_XCNT(b.x)], 1u);
    return b;
}
__device__ __forceinline__ void xcd_barrier_complete(unsigned* bar, unsigned x, unsigned& nloc, unsigned& nx) {
    const unsigned G = gridDim.x * gridDim.y * gridDim.z;
    unsigned sum, cnt, mine, sp = 0u;
    for (;;) {
        sum = 0u; cnt = 0u; mine = 0u;
#pragma unroll
        for (unsigned j = 0; j < 16; ++j) { const unsigned c = xb_ld(&bar[XB_XCNT(j)]); sum += c; cnt += (c > 0u) ? 1u : 0u; mine = (j == x) ? c : mine; }
        if (sum == G) break;
        __builtin_amdgcn_s_sleep(1);
        if ((++sp & 255u) == 0u) { if (xb_ld(&bar[XB_TMO])) break; if (sp > XB_SPIN_CAP) { atomicAdd(&bar[XB_TMO], 1u); break; } }
    }
    nloc = mine > 0u ? mine : 1u; nx = cnt > 0u ? cnt : 1u;
}
__device__ __forceinline__ void xcd_barrier(const XcdBarrier& b, int wv) {
    asm volatile("s_waitcnt vmcnt(0)" ::: "memory");
    __syncthreads();
    if (wv == 0 && lane_id() == 0) {
        unsigned* bar = b.bar;
        __builtin_amdgcn_s_waitcnt(0);
        unsigned nloc = b.st[0], nx = b.st[1];
        if (nloc == 0u) { xcd_barrier_complete(bar, b.x, nloc, nx); b.st[0] = nloc; b.st[1] = nx; }
        const unsigned old = xb_add(&bar[XB_XSUB(b.x)], 1u);
        const unsigned gen = old / nloc;
        if (old + 1u == (gen + 1u) * nloc) {
            __builtin_amdgcn_fence(__ATOMIC_RELEASE, "agent");
            asm volatile("s_waitcnt vmcnt(0)" ::: "memory");
            const unsigned og = xb_add(&bar[XB_TOP], 1u);
            const unsigned tg = og / nx;
            if (og + 1u == (tg + 1u) * nx) xb_add(&bar[XB_TOPGEN], 1u);
            else XB_SPIN(xb_ld(&bar[XB_TOPGEN]) == tg, bar);
            __builtin_amdgcn_fence(__ATOMIC_ACQUIRE, "agent");
            xb_add(&bar[XB_XGEN(b.x)], 1u);
            asm volatile("s_waitcnt vmcnt(0)" ::: "memory");
        } else {
            XB_SPIN(xb_ld(&bar[XB_XGEN(b.x)]) == gen, bar);
            __builtin_amdgcn_fence(__ATOMIC_ACQUIRE, "agent");
            asm volatile("s_waitcnt vmcnt(0)" ::: "memory");
        }
    }
    __syncthreads();
}

struct Args { const float* in[24]; float* out; unsigned char* ws; int ph_lo, ph_hi; };
struct Frame {
    LAS unsigned char* lds;
    int tid, lane, wave, vcu, G;
    unsigned char* ws;
    const __attribute__((address_space(4))) Args* ka;
};
enum { I_X = 0, I_WIN, I_LBL, I_NG, I_LRE, I_LIM, I_LSTEP, I_BRE, I_BIM, I_CRE, I_CIM, I_SD, I_WGLU, I_WUPA, I_WUPB, I_WO, I_LN1G, I_LN1B, I_PWQ, I_PKEYS, I_PU, I_PV, I_LN2G, I_LN2B };

__device__ __forceinline__ void p0_transpose_item(const float* W, int N, bf16* WT, int dpitch, int dst_koff, int dst_row0, LAS float* scr, int k0, int n0, int lane, bool h = false) {
    { const int kr = lane >> 3, c4 = (lane & 7) * 4; f32x4 v[8];
#pragma unroll
      for (int i = 0; i < 8; ++i) v[i] = __builtin_nontemporal_load((const f32x4*)(W + (size_t)(k0 + kr + 8 * i) * N + n0 + c4));
#pragma unroll
      for (int i = 0; i < 8; ++i) { LAS float* d = scr + (kr + 8 * i) * 33 + c4; d[0] = v[i][0]; d[1] = v[i][1]; d[2] = v[i][2]; d[3] = v[i][3]; } }
    LDS_WAIT(); asm volatile("" ::: "memory");
    const int c = lane & 7;
#pragma unroll
    for (int j = 0; j < 4; ++j) { const int n = (lane >> 3) + 8 * j; const LAS float* s = scr + (8 * c) * 33 + n;
        v4u o;
        if (h) { o.x = cvt_pk_f16(s[0 * 33], s[1 * 33]); o.y = cvt_pk_f16(s[2 * 33], s[3 * 33]); o.z = cvt_pk_f16(s[4 * 33], s[5 * 33]); o.w = cvt_pk_f16(s[6 * 33], s[7 * 33]); }
        else { o.x = cvt_pk_bf16(s[0 * 33], s[1 * 33]); o.y = cvt_pk_bf16(s[2 * 33], s[3 * 33]); o.z = cvt_pk_bf16(s[4 * 33], s[5 * 33]); o.w = cvt_pk_bf16(s[6 * 33], s[7 * 33]); }
        *(v4u*)(WT + (size_t)(dst_row0 + n) * dpitch + dst_koff + k0 + 8 * c) = o; }
    LDS_WAIT(); asm volatile("" ::: "memory");
}
__device__ __forceinline__ void sincos_d(double a, double& s, double& c) {
    const double k = __builtin_rint(a * 0.63661977236758134308);
    double r = __builtin_fma(-k, 1.57079632679489655800e+00, a); r = __builtin_fma(-k, 6.12323399573676603587e-17, r);
    const double r2 = r * r;
    double sp = 1.0 / 1307674368000.0; sp = sp * r2 - 1.0 / 6227020800.0; sp = sp * r2 + 1.0 / 39916800.0; sp = sp * r2 - 1.0 / 362880.0; sp = sp * r2 + 1.0 / 5040.0; sp = sp * r2 - 1.0 / 120.0; sp = sp * r2 + 1.0 / 6.0;
    const double sr = r - r * r2 * sp;
    double cp = 1.0 / 20922789888000.0; cp = cp * r2 - 1.0 / 87178291200.0; cp = cp * r2 + 1.0 / 479001600.0; cp = cp * r2 - 1.0 / 3628800.0; cp = cp * r2 + 1.0 / 40320.0; cp = cp * r2 - 1.0 / 720.0; cp = cp * r2 + 1.0 / 24.0;
    const double cr = 1.0 - 0.5 * r2 + r2 * r2 * cp;
    const int q = ((int)k) & 3;
    s = (q == 0) ? sr : (q == 1) ? cr : (q == 2) ? -sr : -cr;
    c = (q == 0) ? cr : (q == 1) ? -sr : (q == 2) ? -cr : sr;
}
__device__ __forceinline__ double exp_d(double x) {
    const double k = __builtin_rint(x * 1.44269504088896340736);
    const double r = __builtin_fma(-k, 6.93147180369123816490e-01, x) - k * 1.90821492927058770002e-10;
    double p = 1.0 / 6227020800.0;
    p = p * r + 1.0 / 479001600.0; p = p * r + 1.0 / 39916800.0; p = p * r + 1.0 / 3628800.0; p = p * r + 1.0 / 362880.0; p = p * r + 1.0 / 40320.0; p = p * r + 1.0 / 5040.0;
    p = p * r + 1.0 / 720.0; p = p * r + 1.0 / 120.0; p = p * r + 1.0 / 24.0; p = p * r + 1.0 / 6.0; p = p * r + 0.5; p = p * r + 1.0; p = p * r + 1.0;
    const long long e = (long long)k + 1023; double sc = __builtin_bit_cast(double, (unsigned long long)(e << 52));
    return p * sc;
}

__device__ __forceinline__ void phase_prologue_a(const Frame& F0) {
    Frame F = F0; F.tid = F.wave * 64 + lane_id(); asm volatile("" : "+v"(F.tid)); F.lane = F.tid & 63;
    unsigned char* ws = opqg(F.ws); const __attribute__((address_space(4))) Args* a = opq(F.ka);
    LAS float* scr = (LAS float*)(F.lds + F.wave * 16384);
    const int gw = F.vcu * 8 + F.wave, NGW = F.G * 8;
    constexpr int I_IN = 32 * 288, I_GLU = 16 * 64, I_UP = 16 * 64, I_O = 32 * 64, I_L = I_IN + I_GLU + 2 * I_UP + I_O;
    for (int it = gw; it < DEPTH * I_L; it += NGW) {
        const int l = it / I_L; int r = it % I_L;
        if (r < I_IN) { const int kb = r / 288, nb = r % 288, n0 = nb * 32; int dr;
            if (n0 < 5120) dr = n0; else if (n0 < 7168) { const int j = n0 - 5120; dr = 5120 + (j >> 7) * 256 + (j & 127); } else { const int j = n0 - 7168; dr = 5120 + (j >> 7) * 256 + 128 + (j & 127); }
            p0_transpose_item(GP(const float, a->in[I_WIN]) + (size_t)l * D * NIN, NIN, (bf16*)(ws + WS_WIN) + (size_t)l * NIN * D, D, 0, dr, scr, kb * 64, n0, F.lane, true); continue; }
        r -= I_IN;
        if (r < I_GLU) { const int kb = r / 64, nb = r % 64, n0 = nb * 32; int dr;
            if (n0 < 1024) dr = (n0 >> 7) * 256 + (n0 & 127); else { const int j = n0 - 1024; dr = (j >> 7) * 256 + 128 + (j & 127); }
            p0_transpose_item(GP(const float, a->in[I_WGLU]) + (size_t)l * 1024 * 2048, 2048, (bf16*)(ws + WS_WGLU) + (size_t)l * 2048 * 1024, 1024, 0, dr, scr, kb * 64, n0, F.lane); continue; }
        r -= I_GLU;
        if (r < I_UP) { const int kb = r / 64, nb = r % 64;
            p0_transpose_item(GP(const float, a->in[I_WUPA]) + (size_t)l * 1024 * 2048, 2048, (bf16*)(ws + WS_WUP) + (size_t)l * 2048 * 2048, 2048, 0, nb * 32, scr, kb * 64, nb * 32, F.lane); continue; }
        r -= I_UP;
        if (r < I_UP) { const int kb = r / 64, nb = r % 64;
            p0_transpose_item(GP(const float, a->in[I_WUPB]) + (size_t)l * 1024 * 2048, 2048, (bf16*)(ws + WS_WUP) + (size_t)l * 2048 * 2048, 2048, 1024, nb * 32, scr, kb * 64, nb * 32, F.lane); continue; }
        r -= I_UP;
        { const int kb = r / 64, nb = r % 64;
            p0_transpose_item(GP(const float, a->in[I_WO]) + (size_t)l * 2048 * 2048, 2048, (bf16*)(ws + WS_WO) + (size_t)l * 2048 * 2048, 2048, 0, nb * 32, scr, kb * 64, nb * 32, F.lane); }
    }
    const size_t gt = (size_t)F.vcu * 512 + F.tid, NT = (size_t)F.G * 512;
    { const float* src = GP(const float, a->in[I_PWQ]); bf16* dst = (bf16*)(ws + WS_WQB);
      const size_t N_ = (size_t)DEPTH * D * D / 8; size_t i = gt;
      for (; i + 3 * NT < N_; i += 4 * NT) { f32x4 va[4], vb[4];
#pragma unroll
          for (int k = 0; k < 4; ++k) { va[k] = *(const f32x4*)(src + (i + k * NT) * 8); vb[k] = *(const f32x4*)(src + (i + k * NT) * 8 + 4); }
#pragma unroll
          for (int k = 0; k < 4; ++k) { v4u w; w.x = cvt_pk_bf16(va[k][0], va[k][1]); w.y = cvt_pk_bf16(va[k][2], va[k][3]); w.z = cvt_pk_bf16(vb[k][0], vb[k][1]); w.w = cvt_pk_bf16(vb[k][2], vb[k][3]); *(v4u*)(dst + (i + k * NT) * 8) = w; } }
      for (; i < N_; i += NT) { const f32x4 v0 = *(const f32x4*)(src + i * 8), v1 = *(const f32x4*)(src + i * 8 + 4);
          v4u w; w.x = cvt_pk_bf16(v0[0], v0[1]); w.y = cvt_pk_bf16(v0[2], v0[3]); w.z = cvt_pk_bf16(v1[0], v1[1]); w.w = cvt_pk_bf16(v1[2], v1[3]); *(v4u*)(dst + i * 8) = w; } }
    { const float* src = GP(const float, a->in[I_X]); bf16* dst = (bf16*)(ws + WS_XH);
      const size_t N_ = (size_t)T * D / 8; size_t i = gt;
#define XSRC(ii) (src + (size_t)(int)(((ii) >> 2) & (T - 1)) * D + (int)((ii) >> 15) * 32 + (int)((ii) & 3) * 8)
      for (; i + 3 * NT < N_; i += 4 * NT) { f32x4 va[4], vb[4];
#pragma unroll
          for (int k = 0; k < 4; ++k) { const float* sp = XSRC(i + k * NT); va[k] = *(const f32x4*)sp; vb[k] = *(const f32x4*)(sp + 4); }
#pragma unroll
          for (int k = 0; k < 4; ++k) { v4u w; w.x = cvt_pk_f16(va[k][0], va[k][1]); w.y = cvt_pk_f16(va[k][2], va[k][3]); w.z = cvt_pk_f16(vb[k][0], vb[k][1]); w.w = cvt_pk_f16(vb[k][2], vb[k][3]); *(v4u*)(dst + (i + k * NT) * 8) = w; } }
      for (; i < N_; i += NT) { const float* sp = XSRC(i); const f32x4 v0 = *(const f32x4*)sp, v1 = *(const f32x4*)(sp + 4);
          v4u w; w.x = cvt_pk_f16(v0[0], v0[1]); w.y = cvt_pk_f16(v0[2], v0[3]); w.z = cvt_pk_f16(v1[0], v1[1]); w.w = cvt_pk_f16(v1[2], v1[3]); *(v4u*)(dst + i * 8) = w; }
#undef XSRC
    }
    { const float* keys = GP(const float, a->in[I_PKEYS]); bf16* dst = (bf16*)(ws + WS_BK);
      for (size_t i = gt; i < (size_t)DEPTH * 8 * 256 * 256 / 8; i += NT) { const int jj = (int)(i & 31) * 8; const int row = (int)((i >> 5) & 255); const size_t lh = i >> 13; const int half = row >> 7, n = row & 127;
          v4u w = (v4u){0u, 0u, 0u, 0u};
          if ((jj >> 7) == half) { const float* s = keys + ((lh * 2 + half) * 128 + n) * 128 + (jj & 127); const f32x4 v0 = *(const f32x4*)s, v1 = *(const f32x4*)(s + 4);
              w.x = cvt_pk_bf16(v0[0], v0[1]); w.y = cvt_pk_bf16(v0[2], v0[3]); w.z = cvt_pk_bf16(v1[0], v1[1]); w.w = cvt_pk_bf16(v1[2], v1[3]); }
          *(v4u*)(dst + i * 8) = w; } }
    if (gt < 1024) { const float* lg = GP(const float, a->in[I_LBL]); float* lbo = (float*)(ws + WS_LB); const int d = (int)gt;
        const float z0 = lg[d], z1 = lg[1024 + d], z2 = lg[2048 + d], z3 = lg[3072 + d]; const float mx = fmaxf(fmaxf(z0, z1), fmaxf(z2, z3));
        const float e0 = expf(z0 - mx), e1 = expf(z1 - mx), e2 = expf(z2 - mx), e3 = expf(z3 - mx); const float inv = 1.f / (e0 + e1 + e2 + e3);
        lbo[d] = 0.f; lbo[1024 + d] = e1 * inv; lbo[2048 + d] = (e1 + e2) * inv; lbo[3072 + d] = (e1 + e2 + e3) * inv; }
    for (size_t i = gt; i < (size_t)DEPTH * 64 * 64; i += NT) {
        const size_t lg_ = i >> 6;
        const double lr = fmin((double)GP(const float, a->in[I_LRE])[i], -1e-4), li = (double)GP(const float, a->in[I_LIM])[i], dt = exp_d((double)GP(const float, a->in[I_LSTEP])[lg_]);
        const double mag = exp_d(lr * dt); double sn, cs; sincos_d(li * dt, sn, cs);
        const double ar = mag * cs, ai = mag * sn, den = lr * lr + li * li, nr = ar - 1.0;
        const double zr = (nr * lr + ai * li) / den, zi = (ai * lr - nr * li) / den;
        const float* br = GP(const float, a->in[I_BRE]) + i * 16; const float* bi = GP(const float, a->in[I_BIM]) + i * 16; float* bb = (float*)(ws + WS_BB) + i * 32;
        f32x4 brv[4], biv[4];
#pragma unroll
        for (int m4 = 0; m4 < 4; ++m4) { brv[m4] = ((const f32x4*)br)[m4]; biv[m4] = ((const f32x4*)bi)[m4]; }
#pragma unroll
        for (int m4 = 0; m4 < 4; ++m4) { float o8[8];
#pragma unroll
            for (int x = 0; x < 4; ++x) { const double b_r = brv[m4][x], b_i = biv[m4][x]; o8[2 * x] = (float)(zr * b_r - zi * b_i); o8[2 * x + 1] = (float)(zr * b_i + zi * b_r); }
            ((f32x4*)bb)[2 * m4] = (f32x4){o8[0], o8[1], o8[2], o8[3]}; ((f32x4*)bb)[2 * m4 + 1] = (f32x4){o8[4], o8[5], o8[6], o8[7]}; }
        float* ap = (float*)(ws + WS_APOW) + (lg_ * 65 * 64 + (i & 63)) * 2; double pr = 1.0, pi = 0.0;
        for (int dl = 0; dl < 65; ++dl) { ap[dl * 128] = (float)pr; ap[dl * 128 + 1] = (float)pi; const double t = pr * ar - pi * ai; pi = pr * ai + pi * ar; pr = t; }
    }
    for (int it = gw; it < DEPTH * 1024; it += NGW) {
        const int l = it >> 10, eb = it & 1023;
        const int pe = eb * 16 + (F.lane >> 2), i1 = (pe & 1023) >> 3, i2 = (pe & 7) * 16 + (((pe >> 10) - i1) & 15);
        const float* src = GP(const float, a->in[I_PV]) + ((size_t)l * NEXP + i1 * 128 + i2) * D + (F.lane & 3) * 8;
        bf16* dst = (bf16*)(ws + WS_TBV) + (size_t)l * 64 * NEXP * 32 + ((size_t)(eb * 16 + (F.lane >> 2)) * 4 + ((F.lane & 3) ^ ((F.lane >> 4) & 3))) * 8;
#pragma unroll 1
        for (int k8 = 0; k8 < 64; k8 += 8) { f32x4 va[8], vb[8];
#pragma unroll
            for (int k = 0; k < 8; ++k) { va[k] = __builtin_nontemporal_load((const f32x4*)(src + (k8 + k) * 32)); vb[k] = __builtin_nontemporal_load((const f32x4*)(src + (k8 + k) * 32 + 4)); }
#pragma unroll
            for (int k = 0; k < 8; ++k) { v4u w; w.x = cvt_pk_f16(va[k][0], va[k][1]); w.y = cvt_pk_f16(va[k][2], va[k][3]); w.z = cvt_pk_f16(vb[k][0], vb[k][1]); w.w = cvt_pk_f16(vb[k][2], vb[k][3]);
                *(v4u*)(dst + (size_t)(k8 + k) * NEXP * 32) = w; } }
    }
    for (int it = gw; it < DEPTH * 4096; it += NGW) {
        const int l = it >> 12, q4 = it & 4095, c = F.lane & 15;
        const int pe = q4 * 4 + (F.lane >> 4), i1 = (pe & 1023) >> 3, i2 = (pe & 7) * 16 + (((pe >> 10) - i1) & 15);
        const float* src = GP(const float, a->in[I_PU]) + ((size_t)l * NEXP + i1 * 128 + i2) * D + c * 4;
        unsigned hv[64]; float m = 0.f;
#pragma unroll
        for (int i = 0; i < 32; ++i) { const f32x4 v = __builtin_nontemporal_load((const f32x4*)(src + i * 64));
            m = fmaxf(fmaxf(m, fmaxf(fabsf(v[0]), fabsf(v[1]))), fmaxf(fabsf(v[2]), fabsf(v[3])));
            hv[2 * i] = cvt_pk_f16(v[0], v[1]); hv[2 * i + 1] = cvt_pk_f16(v[2], v[3]); }
        m = fmaxf(m, __shfl_xor(m, 1)); m = fmaxf(m, __shfl_xor(m, 2)); m = fmaxf(m, __shfl_xor(m, 4)); m = fmaxf(m, __shfl_xor(m, 8));
        const float sc = (m > 0.f) ? m * (1.f / 127.f) : 1.f, inv = (m > 0.f) ? 127.f / m : 0.f;
        if (c == 0) ((float*)(ws + WS_SU))[(size_t)l * NEXP + pe] = sc;
        unsigned char* dst = ws + WS_TBU + (size_t)l * 32 * NEXP * 64 + (size_t)pe * 64 + (((c >> 2) ^ ((pe >> 2) & 3)) * 16 + (c & 3) * 4);
#pragma unroll
        for (int i = 0; i < 32; ++i) { const h2_t p0 = __builtin_bit_cast(h2_t, hv[2 * i]), p1 = __builtin_bit_cast(h2_t, hv[2 * i + 1]);
            const int q0 = (int)__builtin_rintf((float)p0.x * inv), q1 = (int)__builtin_rintf((float)p0.y * inv), q2 = (int)__builtin_rintf((float)p1.x * inv), q3 = (int)__builtin_rintf((float)p1.y * inv);
            *(unsigned*)(dst + (size_t)i * NEXP * 64) = (unsigned)(q0 & 255) | ((unsigned)(q1 & 255) << 8) | ((unsigned)(q2 & 255) << 16) | ((unsigned)q3 << 24); }
    }
}
__device__ __forceinline__ double dummy_unused_(double x) { return x; }

__device__ __forceinline__ void phase_prologue_b(const Frame& F0) {
    Frame F = F0; F.tid = F.wave * 64 + lane_id(); asm volatile("" : "+v"(F.tid)); F.lane = F.tid & 63;
    unsigned char* ws = opqg(F.ws); const __attribute__((address_space(4))) Args* a = opq(F.ka);
    const float* APOW = (const float*)(ws + WS_APOW); const float* BB = (const float*)(ws + WS_BB);
    LAS float* AP = (LAS float*)(F.lds); LAS float* BL = (LAS float*)(F.lds + 33280); LAS float* CR = (LAS float*)(F.lds + 41472); LAS float* CI = (LAS float*)(F.lds + 45568); LAS float* SDL = (LAS float*)(F.lds + 49664);
    bf16* KM = (bf16*)(ws + WS_KMAT); bf16* PM = (bf16*)(ws + WS_PM); bf16* E = (bf16*)(ws + WS_E);
    for (int lg = F.vcu; lg < DEPTH * 64; lg += F.G) {
        for (int i = F.tid; i < 65 * 64 * 2 / 4; i += 512) ((LAS f32x4*)AP)[i] = ((const f32x4*)(APOW + (size_t)lg * 65 * 128))[i];
        ((LAS f32x4*)BL)[F.tid] = ((const f32x4*)(BB + (size_t)lg * 2048))[F.tid];
        if (F.tid < 256) ((LAS f32x4*)CR)[F.tid] = ((const f32x4*)(GP(const float, a->in[I_CRE]) + (size_t)lg * 1024))[F.tid];
        else ((LAS f32x4*)CI)[F.tid - 256] = ((const f32x4*)(GP(const float, a->in[I_CIM]) + (size_t)lg * 1024))[F.tid - 256];
        if (F.tid < 16) SDL[F.tid] = GP(const float, a->in[I_SD])[lg * 16 + F.tid];
        __syncthreads();
        for (int task = F.tid; task < 65 * 16; task += 512) {
            const int n = task & 15, idx = task >> 4;
            float sm[16];
#pragma unroll
            for (int m = 0; m < 16; ++m) sm[m] = 0.f;
            if (idx > 0) { const int dl = idx - 1;
#pragma unroll 4
                for (int p = 0; p < 64; ++p) { const f32x2 av = *(const LAS f32x2*)(AP + (dl * 64 + p) * 2); const float c_r = CR[n * 64 + p], c_i = CI[n * 64 + p];
                    const float car = c_r * av[0] - c_i * av[1], cai = c_r * av[1] + c_i * av[0];
#pragma unroll
                    for (int q = 0; q < 8; ++q) { const f32x4 b4 = *(const LAS f32x4*)(BL + p * 32 + q * 4); sm[2 * q] += car * b4[0] - cai * b4[1]; sm[2 * q + 1] += car * b4[2] - cai * b4[3]; } }
                if (dl == 0) { const float dv = SDL[n];
#pragma unroll
                    for (int m = 0; m < 16; ++m) sm[m] += (m == n) ? dv : 0.f; } }
            v4u w0, w1; w0.x = cvt_pk_bf16(sm[0], sm[1]); w0.y = cvt_pk_bf16(sm[2], sm[3]); w0.z = cvt_pk_bf16(sm[4], sm[5]); w0.w = cvt_pk_bf16(sm[6], sm[7]);
            w1.x = cvt_pk_bf16(sm[8], sm[9]); w1.y = cvt_pk_bf16(sm[10], sm[11]); w1.z = cvt_pk_bf16(sm[12], sm[13]); w1.w = cvt_pk_bf16(sm[14], sm[15]);
            bf16* kp = KM + ((size_t)lg * 65 * 16 + task) * 16; *(v4u*)kp = w0; *(v4u*)(kp + 8) = w1; }
        for (int it = F.tid; it < 128 * 64 * 2; it += 512) {
            const int m0 = (it & 1) * 8, sidx = (it >> 1) & 63, pp = it >> 7, p = pp & 63;
            const f32x2 av = *(const LAS f32x2*)(AP + ((63 - sidx) * 64 + p) * 2); const float pr = av[0], pi = av[1];
            float o[8];
#pragma unroll
            for (int j = 0; j < 4; ++j) { const f32x4 b4 = *(const LAS f32x4*)(BL + p * 32 + m0 * 2 + j * 4);
                o[2 * j] = (pp < 64) ? (pr * b4[0] - pi * b4[1]) : (pr * b4[1] + pi * b4[0]); o[2 * j + 1] = (pp < 64) ? (pr * b4[2] - pi * b4[3]) : (pr * b4[3] + pi * b4[2]); }
            v4u w; w.x = cvt_pk_bf16(o[0], o[1]); w.y = cvt_pk_bf16(o[2], o[3]); w.z = cvt_pk_bf16(o[4], o[5]); w.w = cvt_pk_bf16(o[6], o[7]); *(v4u*)(PM + ((size_t)lg * 16384 + it) * 8) = w; }
        for (int it = F.tid; it < 1024 * 16; it += 512) {
            const int pp0 = (it & 15) * 8, n = (it >> 4) & 15, tau = it >> 8, p0 = pp0 & 63;
            float o[8];
#pragma unroll
            for (int j = 0; j < 8; ++j) { const f32x2 av = *(const LAS f32x2*)(AP + ((tau + 1) * 64 + p0 + j) * 2); const float c_r = CR[n * 64 + p0 + j], c_i = CI[n * 64 + p0 + j];
                o[j] = (pp0 < 64) ? (c_r * av[0] - c_i * av[1]) : -(c_r * av[1] + c_i * av[0]); }
            v4u w; w.x = cvt_pk_bf16(o[0], o[1]); w.y = cvt_pk_bf16(o[2], o[3]); w.z = cvt_pk_bf16(o[4], o[5]); w.w = cvt_pk_bf16(o[6], o[7]); *(v4u*)(E + ((size_t)lg * 16384 + it) * 8) = w; }
        __syncthreads();
    }
}
constexpr int HG_BL = 0, HG_TOT = 33792, HG_VT = 35840, HG_KT = 54272, HG_RED = 72704;
constexpr int KSP = 136, HG_KS = 73728, HG_QT = HG_KS + 64 * KSP * 2, HG_QH = HG_QT + 64 * KSP * 2;
static_assert(HG_QH + 64 * KSP * 2 <= RING_BYTES, "hgrn_out LDS map");
constexpr int BLP = 132, VTP = 72;
__device__ __forceinline__ void hg_cumsum(const Frame& F, const float* LOGF, int c, int h) {
    LAS float* bL = (LAS float*)(F.lds + HG_BL); LAS float* tot = (LAS float*)(F.lds + HG_TOT);
    const int d = F.tid & 127, seg = F.tid >> 7;
    const float* src = LOGF + (size_t)(c * 64 + seg * 16) * AW + h * 128 + d;
    float lf[16];
#pragma unroll
    for (int i = 0; i < 16; ++i) lf[i] = src[(size_t)i * AW];
#pragma unroll
    for (int i = 1; i < 16; ++i) lf[i] += lf[i - 1];
    tot[seg * 128 + d] = lf[15];
    __syncthreads();
    float off = 0.f;
#pragma unroll
    for (int s2 = 0; s2 < 3; ++s2) off += (s2 < seg) ? tot[s2 * 128 + d] : 0.f;
#pragma unroll
    for (int i = 0; i < 16; ++i) bL[(seg * 16 + i) * BLP + d] = lf[i] + off;
}
__device__ __forceinline__ void hg_load_vt(const Frame& F, const bf16* V, int c, int h) {
    LAS bf16* VT = (LAS bf16*)(F.lds + HG_VT);
    const int s = F.lane, vb = F.wave * 16;
    const v4u* src = (const v4u*)(V + (size_t)(c * 64 + s) * AW + h * 128 + vb);
    const v4u w0 = src[0], w1 = src[1];
    const unsigned ww[8] = {w0.x, w0.y, w0.z, w0.w, w1.x, w1.y, w1.z, w1.w};
#pragma unroll
    for (int j = 0; j < 8; ++j) { VT[(vb + 2 * j) * VTP + s] = (bf16)(ww[j] & 0xffffu); VT[(vb + 2 * j + 1) * VTP + s] = (bf16)(ww[j] >> 16); }
}
__device__ __forceinline__ void phase_hgrn_local(const Frame& F0, int l) {
    Frame F = F0; F.tid = F.wave * 64 + lane_id(); asm volatile("" : "+v"(F.tid)); F.lane = F.tid & 63;
    unsigned char* ws = opqg(F.ws);
    const float* LOGF = (const float*)(ws + WS_LOGF); const bf16* KK = (const bf16*)(ws + WS_KK); const bf16* V = (const bf16*)(ws + WS_V);
    _Float16* U = (_Float16*)(ws + WS_U); float* BLo = (float*)(ws + WS_BL);
    LAS float* bL = (LAS float*)(F.lds + HG_BL); LAS bf16* VT = (LAS bf16*)(F.lds + HG_VT); LAS bf16* KT = (LAS bf16*)(F.lds + HG_KT);
    const int fr = F.lane & 15, fq = F.lane >> 4;
    for (int unit = F.vcu; unit < NCH * 8; unit += F.G) {
        const int c = unit >> 3, h = unit & 7;
        hg_cumsum(F, LOGF, c, h);
        hg_load_vt(F, V, c, h);
        __syncthreads();
        { const int s = F.lane, db = F.wave * 16;
          const v4u* src = (const v4u*)(KK + (size_t)(c * 64 + s) * AW + h * 128 + db);
          const v4u w0 = src[0], w1 = src[1];
          const unsigned ww[8] = {w0.x, w0.y, w0.z, w0.w, w1.x, w1.y, w1.z, w1.w};
#pragma unroll
          for (int j = 0; j < 8; ++j) {
              const float b0 = bL[s * BLP + db + 2 * j], b1 = bL[s * BLP + db + 2 * j + 1], l0 = bL[63 * BLP + db + 2 * j], l1 = bL[63 * BLP + db + 2 * j + 1];
              const unsigned pk = cvt_pk_bf16(bf_lo(ww[j]) * fexp(l0 - b0), bf_hi(ww[j]) * fexp(l1 - b1));
              KT[(db + 2 * j) * VTP + s] = (bf16)(pk & 0xffffu); KT[(db + 2 * j + 1) * VTP + s] = (bf16)(pk >> 16); } }
        if (F.tid < 128) BLo[(size_t)c * AW + h * 128 + F.tid] = bL[63 * BLP + F.tid];
        __syncthreads();
        f32x4 acc[8];
#pragma unroll
        for (int i = 0; i < 8; ++i) acc[i] = (f32x4){0.f, 0.f, 0.f, 0.f};
#pragma unroll
        for (int ks = 0; ks < 2; ++ks) {
            const bf16x8 A = *(const LAS bf16x8*)(VT + (F.wave * 16 + fr) * VTP + ks * 32 + fq * 8);
#pragma unroll
            for (int dt = 0; dt < 8; ++dt) { const bf16x8 B = *(const LAS bf16x8*)(KT + (dt * 16 + fr) * VTP + ks * 32 + fq * 8);
                acc[dt] = __builtin_amdgcn_mfma_f32_16x16x32_bf16(B, A, acc[dt], 0, 0, 0); }
        }
        _Float16* up = U + ((size_t)(c * 8 + h) * 128 + F.wave * 16 + fr) * 128 + fq * 4;
#pragma unroll
        for (int dt = 0; dt < 8; ++dt) { v2u w; w.x = cvt_pk_f16(acc[dt][0], acc[dt][1]); w.y = cvt_pk_f16(acc[dt][2], acc[dt][3]); *(v2u*)(up + dt * 16) = w; }
        __syncthreads();
    }
}
__device__ __forceinline__ void phase_scan(const Frame& F0, int l) {
    Frame F = F0; F.tid = F.wave * 64 + lane_id(); asm volatile("" : "+v"(F.tid)); F.lane = F.tid & 63;
    unsigned char* ws = opqg(F.ws);
    const _Float16* U = (const _Float16*)(ws + WS_U); const float* BLo = (const float*)(ws + WS_BL); bf16* SP = (bf16*)(ws + WS_SP);
    for (int e = F.vcu * 512 + F.tid; e < 8 * 128 * 128; e += F.G * 512) {
        const int hd = (e >> 14) * 128 + (e & 127);
        float s = 0.f;
        for (int c0 = 0; c0 < NCH; c0 += 32) {
            float u[32], bl[32];
#pragma unroll
            for (int i = 0; i < 32; ++i) { u[i] = (float)U[(size_t)(c0 + i) * 131072 + e]; bl[i] = BLo[(size_t)(c0 + i) * AW + hd]; }
#pragma unroll
            for (int i = 0; i < 32; ++i) { SP[(size_t)(c0 + i) * 131072 + e] = f2bf(s); s = s * fexp(bl[i]) + u[i]; }
        }
    }
    const float* XLOC = (const float*)(ws + WS_XLOC); float* XS = (float*)(ws + WS_XS); const float* APOW = (const float*)(ws + WS_APOW);
    for (int e = F.vcu * 512 + F.tid; e < 64 * 64; e += F.G * 512) {
        const int g = e >> 6, p = e & 63;
        const float* ap = APOW + (((size_t)(l * 64 + g) * 65 + 64) * 64 + p) * 2; const float ar = ap[0], ai = ap[1];
        float xr = 0.f, xi = 0.f;
        for (int c0 = 0; c0 < NCH; c0 += 32) {
            float lr_[32], li_[32];
#pragma unroll
            for (int i = 0; i < 32; ++i) { lr_[i] = XLOC[((size_t)(c0 + i) * 64 + g) * 128 + p]; li_[i] = XLOC[((size_t)(c0 + i) * 64 + g) * 128 + 64 + p]; }
#pragma unroll
            for (int i = 0; i < 32; ++i) { XS[((size_t)(c0 + i) * 64 + g) * 128 + p] = xr; XS[((size_t)(c0 + i) * 64 + g) * 128 + 64 + p] = xi;
                const float t = ar * xr - ai * xi + lr_[i]; xi = ar * xi + ai * xr + li_[i]; xr = t; }
        }
    }
}
__device__ __forceinline__ void phase_hgrn_out(const Frame& F0, int l) {
    Frame F = F0; F.tid = F.wave * 64 + lane_id(); asm volatile("" : "+v"(F.tid)); F.lane = F.tid & 63;
    unsigned char* ws = opqg(F.ws); const __attribute__((address_space(4))) Args* a = opq(F.ka);
    const float* LOGF = (const float*)(ws + WS_LOGF); const bf16* KK = (const bf16*)(ws + WS_KK); const bf16* V = (const bf16*)(ws + WS_V);
    const bf16* Q = (const bf16*)(ws + WS_Q); const bf16* SG = (const bf16*)(ws + WS_SG); const bf16* SP = (const bf16*)(ws + WS_SP);
    bf16* OAB = (bf16*)(ws + WS_OAB); const float* NG = GP(const float, a->in[I_NG]) + (size_t)l * AW;
    LAS float* bL = (LAS float*)(F.lds + HG_BL); LAS bf16* VT = (LAS bf16*)(F.lds + HG_VT); LAS float* red = (LAS float*)(F.lds + HG_RED);
    const int fr = F.lane & 15, fq = F.lane >> 4, tt = F.wave & 3, vh = F.wave >> 2;
    LAS float* tot = (LAS float*)(F.lds + HG_TOT);
    float lf[16]; v4u vw0, vw1, kg0, kg1, qg0, qg1;
#define HGO_PREF(u_) { const int c_ = (u_) >> 3, h_ = (u_) & 7; \
        const float* src_ = LOGF + (size_t)(c_ * 64 + (F.tid >> 7) * 16) * AW + h_ * 128 + (F.tid & 127); \
        _Pragma("unroll") for (int i = 0; i < 16; ++i) lf[i] = src_[(size_t)i * AW]; \
        const v4u* vp_ = (const v4u*)(V + (size_t)(c_ * 64 + F.lane) * AW + h_ * 128 + F.wave * 16); vw0 = vp_[0]; vw1 = vp_[1]; \
        const size_t ro_ = ((size_t)c_ * 64 + (F.tid >> 3)) * AW + h_ * 128 + (F.tid & 7) * 16; \
        const v4u* kp_ = (const v4u*)(KK + ro_); const v4u* qp_ = (const v4u*)(Q + ro_); kg0 = kp_[0]; kg1 = kp_[1]; qg0 = qp_[0]; qg1 = qp_[1]; }
    if (F.vcu < NCH * 8) HGO_PREF(F.vcu)
    for (int unit = F.vcu; unit < NCH * 8; unit += F.G) {
        const int c = unit >> 3, h = unit & 7;
        { const int d = F.tid & 127, seg = F.tid >> 7;
#pragma unroll
          for (int i = 1; i < 16; ++i) lf[i] += lf[i - 1];
          tot[seg * 128 + d] = lf[15];
          { const int s = F.lane, vb = F.wave * 16; const unsigned ww[8] = {vw0.x, vw0.y, vw0.z, vw0.w, vw1.x, vw1.y, vw1.z, vw1.w};
#pragma unroll
            for (int j = 0; j < 8; ++j) { VT[(vb + 2 * j) * VTP + s] = (bf16)(ww[j] & 0xffffu); VT[(vb + 2 * j + 1) * VTP + s] = (bf16)(ww[j] >> 16); } }
          __syncthreads();
          float off = 0.f;
#pragma unroll
          for (int s2 = 0; s2 < 3; ++s2) off += (s2 < seg) ? tot[s2 * 128 + d] : 0.f;
#pragma unroll
          for (int i = 0; i < 16; ++i) bL[(seg * 16 + i) * BLP + d] = lf[i] + off; }
        __syncthreads();
        const int t = tt * 16 + fr; const size_t tok = (size_t)c * 64 + t;
        bf16x8 sg_[2][4];
#define HG_LOAD(buf, kd_) { const int d0_ = (kd_) * 32 + fq * 8; \
            _Pragma("unroll") for (int vt = 0; vt < 4; ++vt) sg_[buf][vt] = *(const bf16x8*)(SP + ((size_t)(c * 8 + h) * 128 + (vh * 4 + vt) * 16 + fr) * 128 + d0_); }
        HG_LOAD(0, 0) HG_LOAD(1, 1)
        v2u sgw[4];
#pragma unroll
        for (int vt = 0; vt < 4; ++vt) sgw[vt] = *(const v2u*)(SG + tok * AW + h * 128 + (vh * 4 + vt) * 16 + fq * 4);
        f32x4 ngw[4];
#pragma unroll
        for (int vt = 0; vt < 4; ++vt) ngw[vt] = *(const f32x4*)(NG + h * 128 + (vh * 4 + vt) * 16 + fq * 4);
        { const int s = F.tid >> 3, dc = (F.tid & 7) * 16;
          const unsigned kq[8] = {kg0.x, kg0.y, kg0.z, kg0.w, kg1.x, kg1.y, kg1.z, kg1.w}, qq[8] = {qg0.x, qg0.y, qg0.z, qg0.w, qg1.x, qg1.y, qg1.z, qg1.w};
          unsigned ko[8], qto[8], qho[8];
#pragma unroll
          for (int j4 = 0; j4 < 4; ++j4) { const f32x4 bs = *(const LAS f32x4*)(bL + s * BLP + dc + 4 * j4), br = *(const LAS f32x4*)(bL + 31 * BLP + dc + 4 * j4);
#pragma unroll
              for (int hx = 0; hx < 2; ++hx) { const int w = 2 * j4 + hx; const float b0 = bs[2 * hx], b1 = bs[2 * hx + 1], r0 = br[2 * hx], r1 = br[2 * hx + 1];
                  const float k0 = bf_lo(kq[w]), k1 = bf_hi(kq[w]), q0 = bf_lo(qq[w]), q1 = bf_hi(qq[w]);
                  ko[w] = cvt_pk_bf16(k0 * fexp(fminf(r0 - b0, 80.f)), k1 * fexp(fminf(r1 - b1, 80.f)));
                  qto[w] = cvt_pk_bf16(q0 * fexp(fminf(b0 - r0, 80.f)), q1 * fexp(fminf(b1 - r1, 80.f)));
                  qho[w] = cvt_pk_bf16(q0 * fexp(b0), q1 * fexp(b1)); } }
          LAS v4u* kd_ = (LAS v4u*)(F.lds + HG_KS + (s * KSP + dc) * 2); kd_[0] = (v4u){ko[0], ko[1], ko[2], ko[3]}; kd_[1] = (v4u){ko[4], ko[5], ko[6], ko[7]};
          LAS v4u* qt_ = (LAS v4u*)(F.lds + HG_QT + (s * KSP + dc) * 2); qt_[0] = (v4u){qto[0], qto[1], qto[2], qto[3]}; qt_[1] = (v4u){qto[4], qto[5], qto[6], qto[7]};
          LAS v4u* qh_ = (LAS v4u*)(F.lds + HG_QH + (s * KSP + dc) * 2); qh_[0] = (v4u){qho[0], qho[1], qho[2], qho[3]}; qh_[1] = (v4u){qho[4], qho[5], qho[6], qho[7]}; }
        __syncthreads();
        f32x4 att[4], o[4];
#pragma unroll
        for (int i = 0; i < 4; ++i) { att[i] = (f32x4){0.f, 0.f, 0.f, 0.f}; o[i] = (f32x4){0.f, 0.f, 0.f, 0.f}; }
#pragma unroll
        for (int kd = 0; kd < 4; ++kd) {
            const int cb = kd & 1;
            const int fo = (kd * 32 + fq * 8) * 2;
            const bf16x8 Bqt = *(const LAS bf16x8*)(F.lds + HG_QT + (t * KSP) * 2 + fo), Bqh = *(const LAS bf16x8*)(F.lds + HG_QH + (t * KSP) * 2 + fo);
#pragma unroll
            for (int st = 0; st < 4; ++st) { const bf16x8 kt = *(const LAS bf16x8*)(F.lds + HG_KS + ((st * 16 + fr) * KSP) * 2 + fo);
                att[st] = __builtin_amdgcn_mfma_f32_16x16x32_bf16(kt, Bqt, att[st], 0, 0, 0); }
#pragma unroll
            for (int vt = 0; vt < 4; ++vt) o[vt] = __builtin_amdgcn_mfma_f32_16x16x32_bf16(sg_[cb][vt], Bqh, o[vt], 0, 0, 0);
            if (kd < 2) HG_LOAD(cb, kd + 2)
            if (kd == 1) { const int nu = unit + F.G; if (nu < NCH * 8) HGO_PREF(nu) }
        }
#undef HG_LOAD
#pragma unroll
        for (int ks = 0; ks < 2; ++ks) {
            float m8[8];
#pragma unroll
            for (int jj = 0; jj < 8; ++jj) { const int st = 2 * ks + (jj >> 2), r = jj & 3, s = st * 16 + fq * 4 + r; m8[jj] = (s <= t) ? att[st][r] : 0.f; }
            v4u pb; pb.x = cvt_pk_bf16(m8[0], m8[1]); pb.y = cvt_pk_bf16(m8[2], m8[3]); pb.z = cvt_pk_bf16(m8[4], m8[5]); pb.w = cvt_pk_bf16(m8[6], m8[7]);
            const bf16x8 B = __builtin_bit_cast(bf16x8, pb);
#pragma unroll
            for (int vt = 0; vt < 4; ++vt) { const int v = (vh * 4 + vt) * 16 + fr;
                const v2u a0 = *(const LAS v2u*)(VT + v * VTP + ks * 32 + fq * 4), a1 = *(const LAS v2u*)(VT + v * VTP + ks * 32 + 16 + fq * 4);
                const v4u pa = (v4u){a0.x, a0.y, a1.x, a1.y};
                o[vt] = __builtin_amdgcn_mfma_f32_16x16x32_bf16(__builtin_bit_cast(bf16x8, pa), B, o[vt], 0, 0, 0); }
        }
        float ss = 0.f;
#pragma unroll
        for (int vt = 0; vt < 4; ++vt)
#pragma unroll
            for (int r = 0; r < 4; ++r) ss += o[vt][r] * o[vt][r];
        ss += __shfl_xor(ss, 16); ss += __shfl_xor(ss, 32);
        if (fq == 0) red[F.wave * 16 + fr] = ss;
        LDS_WAIT(); __builtin_amdgcn_s_barrier(); asm volatile("" ::: "memory");
        const float tot = red[F.wave * 16 + fr] + red[(F.wave ^ 4) * 16 + fr];
        const float rstd = __builtin_amdgcn_rsqf(tot * (1.f / 128.f) + RMS_EPS);
#pragma unroll
        for (int vt = 0; vt < 4; ++vt) { const int v0 = (vh * 4 + vt) * 16 + fq * 4;
            const f32x4 g4 = ngw[vt]; const v2u sg = sgw[vt];
            v2u w; w.x = cvt_pk_bf16(o[vt][0] * rstd * g4[0] * bf_lo(sg.x), o[vt][1] * rstd * g4[1] * bf_hi(sg.x));
            w.y = cvt_pk_bf16(o[vt][2] * rstd * g4[2] * bf_lo(sg.y), o[vt][3] * rstd * g4[3] * bf_hi(sg.y));
            *(v2u*)(OAB + tok * 2048 + h * 128 + v0) = w; }
        LDS_WAIT(); __builtin_amdgcn_s_barrier(); asm volatile("" ::: "memory");
    }
#undef HGO_PREF
}

constexpr int S5_UT = 0, S5_UTP = 2064, S5_XST = 33024, S5_XSP = 272, S5_KM = 37376;
__device__ __forceinline__ void s5_load_ut(const Frame& F, const bf16* UB, int g, int jb) {
    v4u w0[2], w1[2];
#pragma unroll
    for (int i = 0; i < 2; ++i) { const int tl = F.tid + 512 * i; const v4u* src = (const v4u*)(UB + ((size_t)jb * 1024 + tl) * AW + g * 16); w0[i] = src[0]; w1[i] = src[1]; }
#pragma unroll
    for (int i = 0; i < 2; ++i) { const int tl = F.tid + 512 * i; LAS v4u* dst = (LAS v4u*)(F.lds + S5_UT + (tl >> 6) * S5_UTP + (tl & 63) * 32); dst[0] = w0[i]; dst[1] = w1[i]; }
}
__device__ __forceinline__ void phase_s5_local(const Frame& F0, int l) {
    Frame F = F0; F.tid = F.wave * 64 + lane_id(); asm volatile("" : "+v"(F.tid)); F.lane = F.tid & 63;
    unsigned char* ws = opqg(F.ws);
    const bf16* UB = (const bf16*)(ws + WS_UB); const bf16* PM = (const bf16*)(ws + WS_PM) + (size_t)l * 64 * 128 * 1024; float* XLOC = (float*)(ws + WS_XLOC);
    const int fr = F.lane & 15, fq = F.lane >> 4;
    for (int unit = F.vcu; unit < 64 * 8; unit += F.G) {
        const int g = unit >> 3, jb = unit & 7;
        const bf16* ap = PM + ((size_t)g * 128 + F.wave * 16 + fr) * 1024 + fq * 8;
        bf16x8 Af[32];
#pragma unroll
        for (int ks = 0; ks < 32; ++ks) Af[ks] = *(const bf16x8*)(ap + ks * 32);
        s5_load_ut(F, UB, g, jb);
        __syncthreads();
        f32x4 acc = (f32x4){0.f, 0.f, 0.f, 0.f};
        const LAS unsigned char* bp = F.lds + S5_UT + fr * S5_UTP + (fq >> 1) * 32 + (fq & 1) * 16;
#pragma unroll
        for (int ks = 0; ks < 32; ++ks) { const bf16x8 B = *(const LAS bf16x8*)(bp + ks * 64);
            acc = __builtin_amdgcn_mfma_f32_16x16x32_bf16(Af[ks], B, acc, 0, 0, 0); }
        *(f32x4*)(XLOC + ((size_t)(jb * 16 + fr) * 64 + g) * 128 + F.wave * 16 + fq * 4) = acc;
        __syncthreads();
    }
}
__device__ __forceinline__ void phase_s5_out(const Frame& F0, int l) {
    Frame F = F0; F.tid = F.wave * 64 + lane_id(); asm volatile("" : "+v"(F.tid)); F.lane = F.tid & 63;
    unsigned char* ws = opqg(F.ws);
    const bf16* UB = (const bf16*)(ws + WS_UB); const bf16* E = (const bf16*)(ws + WS_E) + (size_t)l * 64 * 1024 * 128; const bf16* KMAT = (const bf16*)(ws + WS_KMAT) + (size_t)l * 64 * 65 * 256;
    const float* XS = (const float*)(ws + WS_XS); bf16* YB = (bf16*)(ws + WS_YB);
    const int fr = F.lane & 15, fq = F.lane >> 4;
    for (int unit = F.vcu; unit < 64 * 8; unit += F.G) {
        const int g = unit >> 3, jb = unit & 7;
        { const int cc = F.tid >> 5, p0 = (F.tid & 31) * 4;
          const f32x4 xv = *(const f32x4*)(XS + ((size_t)(jb * 16 + cc) * 64 + g) * 128 + p0);
          v4u km[5];
#pragma unroll
          for (int k = 0; k < 5; ++k) { const int pc = F.tid + 512 * k; km[k] = (pc < 65 * 32) ? *(const v4u*)(KMAT + (size_t)g * 65 * 256 + (size_t)pc * 8) : (v4u){0u, 0u, 0u, 0u}; }
          s5_load_ut(F, UB, g, jb);
          v2u w; w.x = cvt_pk_bf16(xv[0], xv[1]); w.y = cvt_pk_bf16(xv[2], xv[3]); *(LAS v2u*)(F.lds + S5_XST + cc * S5_XSP + p0 * 2) = w;
#pragma unroll
          for (int k = 0; k < 5; ++k) { const int pc = F.tid + 512 * k; const int idx = pc >> 5, n = (pc >> 1) & 15, half = pc & 1;
              if (pc < 65 * 32) *(LAS v4u*)(F.lds + S5_KM + idx * 512 + n * 32 + ((half ^ (n >> 3)) * 16)) = km[k]; } }
        __syncthreads();
        for (int ti = 0; ti < 8; ++ti) {
            const int tau = ti * 8 + F.wave;
            const bf16* ep = E + ((size_t)g * 1024 + tau * 16 + fr) * 128 + fq * 8;
            bf16x8 Ae[4];
#pragma unroll
            for (int ke = 0; ke < 4; ++ke) Ae[ke] = *(const bf16x8*)(ep + ke * 32);
            f32x4 acc = (f32x4){0.f, 0.f, 0.f, 0.f}, acc1 = (f32x4){0.f, 0.f, 0.f, 0.f};
            const LAS unsigned char* bp = F.lds + S5_UT + fr * S5_UTP + (fq >> 1) * 32 + (fq & 1) * 16;
            const LAS unsigned char* kp = F.lds + S5_KM + (tau - (fq >> 1) + 1) * 512 + fr * 32 + (((fq & 1) ^ (fr >> 3)) * 16);
            const int nks = (tau >> 1) + 1;
            int ks = 0;
            for (; ks + 4 <= nks; ks += 4) {
                const bf16x8 A0 = *(const LAS bf16x8*)(kp - ks * 1024), A1 = *(const LAS bf16x8*)(kp - (ks + 1) * 1024), A2 = *(const LAS bf16x8*)(kp - (ks + 2) * 1024), A3 = *(const LAS bf16x8*)(kp - (ks + 3) * 1024);
                const bf16x8 B0 = *(const LAS bf16x8*)(bp + ks * 64), B1 = *(const LAS bf16x8*)(bp + (ks + 1) * 64), B2 = *(const LAS bf16x8*)(bp + (ks + 2) * 64), B3 = *(const LAS bf16x8*)(bp + (ks + 3) * 64);
                acc = __builtin_amdgcn_mfma_f32_16x16x32_bf16(A0, B0, acc, 0, 0, 0); acc1 = __builtin_amdgcn_mfma_f32_16x16x32_bf16(A1, B1, acc1, 0, 0, 0);
                acc = __builtin_amdgcn_mfma_f32_16x16x32_bf16(A2, B2, acc, 0, 0, 0); acc1 = __builtin_amdgcn_mfma_f32_16x16x32_bf16(A3, B3, acc1, 0, 0, 0); }
            for (; ks < nks; ++ks) { const bf16x8 A = *(const LAS bf16x8*)(kp - ks * 1024); const bf16x8 B = *(const LAS bf16x8*)(bp + ks * 64);
                acc = __builtin_amdgcn_mfma_f32_16x16x32_bf16(A, B, acc, 0, 0, 0); }
            const LAS unsigned char* xp = F.lds + S5_XST + fr * S5_XSP + fq * 16;
#pragma unroll
            for (int ke = 0; ke < 4; ke += 2) { const bf16x8 B0 = *(const LAS bf16x8*)(xp + ke * 64), B1 = *(const LAS bf16x8*)(xp + (ke + 1) * 64);
                acc = __builtin_amdgcn_mfma_f32_16x16x32_bf16(Ae[ke], B0, acc, 0, 0, 0); acc1 = __builtin_amdgcn_mfma_f32_16x16x32_bf16(Ae[ke + 1], B1, acc1, 0, 0, 0); }
            acc += acc1;
            v2u w; w.x = cvt_pk_bf16(gelu_tanh(acc[0]), gelu_tanh(acc[1])); w.y = cvt_pk_bf16(gelu_tanh(acc[2]), gelu_tanh(acc[3]));
            *(v2u*)(YB + ((size_t)(jb * 16 + fr) * 64 + tau) * AW + g * 16 + fq * 4) = w;
        }
        __syncthreads();
    }
}

__device__ __forceinline__ void phase_ln(const Frame& F0, int l, int which) {
    Frame F = F0; F.tid = F.wave * 64 + lane_id(); asm volatile("" : "+v"(F.tid)); F.lane = F.tid & 63;
    unsigned char* ws = opqg(F.ws); const __attribute__((address_space(4))) Args* a = opq(F.ka);
    const bf16* RS = (const bf16*)(ws + WS_RH); bf16* XS = (bf16*)(ws + WS_XH);
    const bool last = (which == 1 && l == DEPTH - 1); float* OUT = GP(float, a->out);
    const float* gam = GP(const float, a->in[which == 0 ? I_LN1G : I_LN2G]) + (size_t)l * D; const float* bet = GP(const float, a->in[which == 0 ? I_LN1B : I_LN2B]) + (size_t)l * D;
    const int gw = F.vcu * 8 + F.wave, NGW = F.G * 8;
    const int j = F.lane & 3, rr = (F.lane >> 2) & 1, sl = F.lane >> 3;
    LAS float* gamL = (LAS float*)(F.lds); LAS float* betL = gamL + D;
    ((LAS f32x4*)gamL)[F.tid] = ((const f32x4*)gam)[F.tid]; ((LAS f32x4*)betL)[F.tid] = ((const f32x4*)bet)[F.tid];
    __syncthreads();
    for (int rp = gw; rp < T / 2; rp += NGW) {
        const int row = 2 * rp + rr;
        const size_t eo = ((size_t)sl * T + row) * 32 + j * 8;
        v4u w[8];
#pragma unroll
        for (int i = 0; i < 8; ++i) w[i] = *(const v4u*)(RS + eo + (size_t)i * 8 * T * 32);
        float v[64]; float s = 0.f;
#pragma unroll
        for (int i = 0; i < 8; ++i) { const unsigned ww[4] = {w[i].x, w[i].y, w[i].z, w[i].w};
#pragma unroll
            for (int k = 0; k < 4; ++k) { const h2_t hv = __builtin_bit_cast(h2_t, ww[k]); v[8 * i + 2 * k] = (float)hv.x; v[8 * i + 2 * k + 1] = (float)hv.y; s += (float)hv.x + (float)hv.y; } }
        s += __shfl_xor(s, 1); s += __shfl_xor(s, 2); s += __shfl_xor(s, 8); s += __shfl_xor(s, 16); s += __shfl_xor(s, 32);
        const float mean = s * (1.f / D); float s2 = 0.f;
#pragma unroll
        for (int i = 0; i < 64; ++i) { v[i] -= mean; s2 += v[i] * v[i]; }
        s2 += __shfl_xor(s2, 1); s2 += __shfl_xor(s2, 2); s2 += __shfl_xor(s2, 8); s2 += __shfl_xor(s2, 16); s2 += __shfl_xor(s2, 32);
        const float rstd = __builtin_amdgcn_rsqf(s2 * (1.f / D) + LN_EPS);
        float amax = 0.f; int slv = sl; asm volatile("" : "+v"(slv));
#pragma unroll
        for (int i = 0; i < 8; ++i) { const int e0 = (8 * i + slv) * 32 + j * 8;
            const f32x4 g0 = *(const LAS f32x4*)(gamL + e0), g1 = *(const LAS f32x4*)(gamL + e0 + 4), b0 = *(const LAS f32x4*)(betL + e0), b1 = *(const LAS f32x4*)(betL + e0 + 4);
            const f32x4 y0 = (f32x4){v[8 * i], v[8 * i + 1], v[8 * i + 2], v[8 * i + 3]} * rstd * g0 + b0, y1 = (f32x4){v[8 * i + 4], v[8 * i + 5], v[8 * i + 6], v[8 * i + 7]} * rstd * g1 + b1;
            if (last) { *(f32x4*)(OUT + (size_t)row * D + e0) = y0; *(f32x4*)(OUT + (size_t)row * D + e0 + 4) = y1; }
            else { v4u o; o.x = cvt_pk_f16(y0[0], y0[1]); o.y = cvt_pk_f16(y0[2], y0[3]); o.z = cvt_pk_f16(y1[0], y1[1]); o.w = cvt_pk_f16(y1[2], y1[3]); *(v4u*)(XS + eo + (size_t)i * 8 * T * 32) = o; }
            if (which == 0) {
#pragma unroll
                for (int k = 0; k < 4; ++k) { v[8 * i + k] = y0[k]; v[8 * i + 4 + k] = y1[k]; amax = fmaxf(amax, fmaxf(fabsf(y0[k]), fabsf(y1[k]))); } } }
        if (which == 0) {
            amax = fmaxf(amax, __shfl_xor(amax, 1)); amax = fmaxf(amax, __shfl_xor(amax, 2)); amax = fmaxf(amax, __shfl_xor(amax, 8)); amax = fmaxf(amax, __shfl_xor(amax, 16)); amax = fmaxf(amax, __shfl_xor(amax, 32));
            const float inv = (amax > 0.f) ? 127.f / amax : 0.f;
            if (j == 0 && sl == 0) ((float*)(ws + WS_SX))[row] = (amax > 0.f) ? amax * (1.f / 127.f) : 1.f;
            unsigned char* xq = ws + WS_XQ + (size_t)row * 64 + (sl & 1) * 32 + j * 8;
#pragma unroll
            for (int i = 0; i < 8; ++i) { int q[8];
#pragma unroll
                for (int k = 0; k < 8; ++k) q[k] = (int)__builtin_rintf(v[8 * i + k] * inv);
                v2u o; o.x = (unsigned)(q[0] & 255) | ((unsigned)(q[1] & 255) << 8) | ((unsigned)(q[2] & 255) << 16) | ((unsigned)q[3] << 24);
                o.y = (unsigned)(q[4] & 255) | ((unsigned)(q[5] & 255) << 8) | ((unsigned)(q[6] & 255) << 16) | ((unsigned)q[7] << 24);
                *(v2u*)(xq + (size_t)(4 * i + (sl >> 1)) * T * 64) = o; } }
    }
    __syncthreads();
}

constexpr int PK_TV = 0, PK_EID = 65536, PK_GATE = 81920;
__device__ __forceinline__ int f2key(float x) { const int b = __float_as_int(x); return b ^ ((b >> 31) & 0x7fffffff); }
__device__ __forceinline__ float key2f(int k) { return __int_as_float(k ^ ((k >> 31) & 0x7fffffff)); }
__device__ __forceinline__ int imed3(int a, int b, int c) { int r; asm("v_med3_i32 %0, %1, %2, %3" : "=v"(r) : "v"(a), "v"(b), "v"(c)); return r; }
#define INSK(kx) do { const int _x = (kx); _Pragma("unroll") for (int _k = 15; _k > 0; --_k) tk[_k] = imed3(tk[_k - 1], tk[_k], _x); tk[0] = max(tk[0], _x); } while (0)
__device__ __forceinline__ void phase_topk(const Frame& F0, int l) {
    Frame F = F0; F.tid = F.wave * 64 + lane_id(); asm volatile("" : "+v"(F.tid)); F.lane = F.tid & 63;
    unsigned char* ws = opqg(F.ws);
    const float* SC = (const float*)(ws + WS_SC); int* SEID = (int*)(ws + WS_SEID); float* SGATE = (float*)(ws + WS_SGATE); unsigned char* START = ws + WS_START;
    LAS int* TK = (LAS int*)(F.lds + PK_TV); LAS int* EIDL = (LAS int*)(F.lds + PK_EID); LAS float* GATEL = (LAS float*)(F.lds + PK_GATE);
    for (int tb = F.vcu; tb < T / 32; tb += F.G) {
        const int t0 = tb * 32;
        { const int tok = F.tid >> 4, hh = F.tid & 15;
          const v4u* sp = (const v4u*)((const bf16*)SC + (size_t)(t0 + tok) * 2048 + hh * 128);
          int tk[16];
#pragma unroll
          for (int k = 0; k < 16; ++k) tk[k] = (int)0x80000000;
#pragma unroll 1
          for (int i4 = 0; i4 < 16; i4 += 4) { v4u sa[4];
#pragma unroll
              for (int i = 0; i < 4; ++i) sa[i] = sp[i4 + i];
#pragma unroll
              for (int i = 0; i < 4; ++i) { const v4u s0 = sa[i]; const unsigned sw[4] = {s0.x, s0.y, s0.z, s0.w}; const int ib = 127 - 8 * (i4 + i);
#pragma unroll
                  for (int x = 0; x < 4; ++x) { INSK((f2key(bf_lo(sw[x])) & ~127) | (ib - 2 * x)); INSK((f2key(bf_hi(sw[x])) & ~127) | (ib - 2 * x - 1)); } } }
#pragma unroll
          for (int k = 0; k < 16; ++k) TK[F.tid * 16 + k] = tk[k]; }
        __syncthreads();
        if ((F.tid & 1) == 0) {
            float v1[16], v2[16];
#pragma unroll
            for (int k = 0; k < 16; ++k) { v1[k] = key2f(TK[F.tid * 16 + k] & ~127); v2[k] = key2f(TK[(F.tid + 1) * 16 + k] & ~127); }
            int tk[16];
#pragma unroll
            for (int k = 0; k < 16; ++k) tk[k] = (int)0x80000000;
#pragma unroll
            for (int aa = 0; aa < 16; ++aa)
#pragma unroll
                for (int bb = 0; bb < 16; ++bb) if ((aa + 1) * (bb + 1) <= 16) { INSK((f2key(v1[aa] + v2[bb]) & ~255) | (255 - (aa * 16 + bb))); }
            float ex[16], sum = 0.f; const float v0 = key2f(tk[0] & ~255);
#pragma unroll
            for (int k = 0; k < 16; ++k) { ex[k] = expf(key2f(tk[k] & ~255) - v0); sum += ex[k]; }
            const float inv = 1.f / sum;
            const int tok = F.tid >> 4, hd = (F.tid >> 1) & 7;
#pragma unroll
            for (int k = 0; k < 16; ++k) { const int code = 255 - (tk[k] & 255);
                const int i1 = 127 - (TK[F.tid * 16 + (code >> 4)] & 127), i2 = 127 - (TK[(F.tid + 1) * 16 + (code & 15)] & 127);
                EIDL[tok * 128 + hd * 16 + k] = (((i1 + i2) & 15) << 10) + i1 * 8 + (i2 >> 4); GATEL[tok * 128 + hd * 16 + k] = ex[k] * inv; }
        }
        __syncthreads();
        for (int ti = 0; ti < 4; ++ti) {
            const int tok = F.wave * 4 + ti;
            int k0 = (EIDL[tok * 128 + F.lane] << 7) | F.lane, k1 = (EIDL[tok * 128 + 64 + F.lane] << 7) | (64 + F.lane);
#pragma unroll
            for (int k = 2; k <= 128; k <<= 1)
#pragma unroll
                for (int j = k >> 1; j > 0; j >>= 1) {
                    if (j == 64) { const int mn = min(k0, k1), mx = max(k0, k1); k0 = mn; k1 = mx; }
                    else { const int o0 = __shfl_xor(k0, j), o1 = __shfl_xor(k1, j); const bool lower = (F.lane & j) == 0;
                        const bool up0 = (F.lane & k) == 0, up1 = ((64 + F.lane) & k) == 0;
                        k0 = (up0 == lower) ? min(k0, o0) : max(k0, o0); k1 = (up1 == lower) ? min(k1, o1) : max(k1, o1); }
                }
            const size_t t = (size_t)(t0 + tok);
            { const int r0 = k0 >> 17, r1 = k1 >> 17; int mine = 0;
#pragma unroll
              for (int r = 1; r < 16; ++r) { const int c = __builtin_popcountll(__ballot(r0 < r)) + __builtin_popcountll(__ballot(r1 < r)); mine = (F.lane == r) ? c : mine; }
              if (F.lane < 16) START[t * 16 + F.lane] = (unsigned char)mine; }
            SEID[t * LP + F.lane] = k0 >> 7; SEID[t * LP + 64 + F.lane] = k1 >> 7;
            SGATE[t * 128 + F.lane] = GATEL[tok * 128 + (k0 & 127)]; SGATE[t * 128 + 64 + F.lane] = GATEL[tok * 128 + (k1 & 127)];
        }
        __syncthreads();
    }
}
typedef __bf16 bf2_t __attribute__((ext_vector_type(2)));
__device__ __forceinline__ float dot2bf(unsigned a, unsigned b, float c) { return __builtin_amdgcn_fdot2_f32_bf16(__builtin_bit_cast(bf2_t, a), __builtin_bit_cast(bf2_t, b), c, false); }
__device__ __forceinline__ void peer_stage(const Frame& F, const bf16* gsrc, int bo) {
#pragma unroll
    for (int i = 0; i < 8; ++i) { const int p = i * 8 + F.wave;
        __builtin_amdgcn_global_load_lds((const unsigned*)((const char*)gsrc + p * 1024 + F.lane * 16), (LAS unsigned*)(F.lds + bo + p * 1024), 16, 0, 0); }
}
__device__ __forceinline__ void peer_dma(const Frame& F, const void* gsrc, int bo) {
    const unsigned ldsbase = (unsigned)(size_t)(F.lds + bo) + (unsigned)F.wave * 1024u;
#pragma unroll
    for (int i = 0; i < 8; ++i) { const char* g = (const char*)gsrc + (i * 8 + F.wave) * 1024 + F.lane * 16; const unsigned m = ldsbase + i * 8192u;
        asm volatile("s_mov_b32 m0, %0\n\ts_nop 0\n\tglobal_load_lds_dwordx4 %1, off" :: "s"(m), "v"((GAS const char*)g) : "memory"); }
}
__device__ __forceinline__ int wave_max_i(int v) {
#pragma unroll
    for (int o = 1; o < 64; o <<= 1) v = max(v, __shfl_xor(v, o));
    return __builtin_amdgcn_readfirstlane(v);
}
template <int K> __device__ __forceinline__ unsigned dppq(unsigned v) { return (unsigned)__builtin_amdgcn_mov_dpp((int)v, K * 0x55, 0xf, 0xf, true); }
__device__ __forceinline__ int sdot4(unsigned a, unsigned b, int c) { return __builtin_amdgcn_sdot4((int)a, (int)b, c, false); }
__device__ __forceinline__ int quad_sum_i(int v) {
    v += __builtin_amdgcn_mov_dpp(v, 0xB1, 0xf, 0xf, true);
    v += __builtin_amdgcn_mov_dpp(v, 0x4E, 0xf, 0xf, true);
    return v;
}
__device__ __forceinline__ float quad_sum(float v) {
    v += __int_as_float(__builtin_amdgcn_mov_dpp(__float_as_int(v), 0xB1, 0xf, 0xf, true));
    v += __int_as_float(__builtin_amdgcn_mov_dpp(__float_as_int(v), 0x4E, 0xf, 0xf, true));
    return v;
}
constexpr int UCAP0 = 24, UCAP1 = 12, UCAP2 = 12, UCAP3 = 8;
__device__ __forceinline__ void phase_peer_u(const Frame& F0, int l) {
    Frame F = F0; F.tid = F.wave * 64 + lane_id(); asm volatile("" : "+v"(F.tid)); F.lane = F.tid & 63;
    unsigned char* ws = opqg(F.ws);
    const bf16* TU = (const bf16*)(ws + WS_TBU) + (size_t)l * 32 * NEXP * 32;
    const int* SEID = (const int*)(ws + WS_SEID); const float* SGATE = (const float*)(ws + WS_SGATE); unsigned* PACK = (unsigned*)(ws + WS_PACK); unsigned char* START = ws + WS_START;
    const bf16* XBS = (const bf16*)(ws + WS_XQ); unsigned* PACK2 = (unsigned*)(ws + WS_PACK2);
    const float* SX = (const float*)(ws + WS_SX); const float* SU = (const float*)(ws + WS_SU) + (size_t)l * NEXP;
    const int qd = F.lane >> 2, jc = F.lane & 3;
    for (int unit = F.vcu; unit < 256; unit += F.G) {
        const int tt = unit & 15, er = unit >> 4; const size_t t = (size_t)tt * 512 + F.tid;
        const int lo = START[t * 16 + er], hi = (er < 15) ? (int)START[t * 16 + er + 1] : 128;
        const int cnt = hi - lo;
        int key = (cnt << 6) | (63 - F.lane);
#pragma unroll
        for (int k = 2; k <= 64; k <<= 1)
#pragma unroll
            for (int j = k >> 1; j > 0; j >>= 1) { const int o = __shfl_xor(key, j); const bool lower = (F.lane & j) == 0, up = (F.lane & k) == 0;
                key = (up == lower) ? max(key, o) : min(key, o); }
        int tl[4], glo[4], gcnt[4], gmax[4];
#pragma unroll
        for (int a = 0; a < 4; ++a) { const int kk = __shfl(key, a * 16 + qd); tl[a] = 63 - (kk & 63); gcnt[a] = kk >> 6; glo[a] = __shfl(lo, tl[a]);
            gmax[a] = __builtin_amdgcn_readfirstlane(__shfl(key, a * 16)) >> 6; }
        const size_t tbase = (size_t)tt * 512 + F.wave * 64;
        unsigned ro0[UCAP0 / 4], ro1[UCAP1 / 4], ro2[UCAP2 / 4], ro3[UCAP3 / 4];
#define LOADRO(arr, a, CAP) _Pragma("unroll") for (int i = 0; i < CAP / 4; ++i) { const int s = 4 * i + jc; const int e = SEID[(tbase + tl[a]) * LP + glo[a] + s]; \
            const int row = (s < gcnt[a]) ? (e & 1023) : 0; arr[i] = (unsigned)((row << 6) + (((row >> 2) & 3) << 4)); }
        LOADRO(ro0, 0, UCAP0) LOADRO(ro1, 1, UCAP1) LOADRO(ro2, 2, UCAP2) LOADRO(ro3, 3, UCAP3)
#undef LOADRO
        int ac0[UCAP0], ac1[UCAP1], ac2[UCAP2], ac3[UCAP3];
#pragma unroll
        for (int s = 0; s < UCAP0; ++s) ac0[s] = 0;
#pragma unroll
        for (int s = 0; s < UCAP1; ++s) ac1[s] = 0;
#pragma unroll
        for (int s = 0; s < UCAP2; ++s) ac2[s] = 0;
#pragma unroll
        for (int s = 0; s < UCAP3; ++s) ac3[s] = 0;
        const bf16* gsl0 = TU + (size_t)er * 1024 * 32;
#define XA(a) ((const v4u*)(XBS + (tbase + tl[a]) * 32) + jc)
        v4u xs[4];
#pragma unroll
        for (int a = 0; a < 4; ++a) xs[a] = XA(a)[0];
        peer_dma(F, gsl0, 0);
        VM_WAIT(); __syncthreads();
#pragma unroll 1
        for (int ks = 0; ks < 32; ++ks) {
            const int bo = (ks & 1) * 65536, jx = jc << 4;
            v4u xn[4];
            const int kn = (ks + 1 < 32) ? ks + 1 : ks;
#pragma unroll
            for (int a = 0; a < 4; ++a) xn[a] = XA(a)[(size_t)kn * T * 4];
            if (ks + 1 < 32) peer_dma(F, gsl0 + (size_t)kn * NEXP * 32, bo ^ 65536);
#define URD(B, arr, g) { asm volatile("" : "+v"(arr[g])); B[0] = *(const LAS v4u*)(F.lds + bo + (dppq<0>(arr[g]) ^ jx)); B[1] = *(const LAS v4u*)(F.lds + bo + (dppq<1>(arr[g]) ^ jx)); \
                B[2] = *(const LAS v4u*)(F.lds + bo + (dppq<2>(arr[g]) ^ jx)); B[3] = *(const LAS v4u*)(F.lds + bo + (dppq<3>(arr[g]) ^ jx)); }
#define UCP(B, acc, a, g) { _Pragma("unroll") for (int q = 0; q < 4; ++q) { int p0 = acc[4 * (g) + q]; \
                p0 = sdot4(B[q].x, xs[a].x, p0); p0 = sdot4(B[q].y, xs[a].y, p0); p0 = sdot4(B[q].z, xs[a].z, p0); p0 = sdot4(B[q].w, xs[a].w, p0); acc[4 * (g) + q] = p0; } }
            { v4u BE[4], BO[4];
              URD(BE, ro0, 0) __builtin_amdgcn_sched_barrier(0);
              URD(BO, ro0, 1) UCP(BE, ac0, 0, 0)
              __builtin_amdgcn_sched_barrier(0);
              URD(BE, ro0, 2) UCP(BO, ac0, 0, 1)
              __builtin_amdgcn_sched_barrier(0);
              URD(BO, ro0, 3) UCP(BE, ac0, 0, 2)
              __builtin_amdgcn_sched_barrier(0);
              URD(BE, ro0, 4) UCP(BO, ac0, 0, 3)
              __builtin_amdgcn_sched_barrier(0);
              URD(BO, ro0, 5) UCP(BE, ac0, 0, 4)
              __builtin_amdgcn_sched_barrier(0);
              URD(BE, ro1, 0) UCP(BO, ac0, 0, 5)
              __builtin_amdgcn_sched_barrier(0);
              URD(BO, ro1, 1) UCP(BE, ac1, 1, 0)
              __builtin_amdgcn_sched_barrier(0);
              URD(BE, ro1, 2) UCP(BO, ac1, 1, 1)
              __builtin_amdgcn_sched_barrier(0);
              URD(BO, ro2, 0) UCP(BE, ac1, 1, 2)
              __builtin_amdgcn_sched_barrier(0);
              URD(BE, ro2, 1) UCP(BO, ac2, 2, 0)
              __builtin_amdgcn_sched_barrier(0);
              URD(BO, ro2, 2) UCP(BE, ac2, 2, 1)
              __builtin_amdgcn_sched_barrier(0);
              URD(BE, ro3, 0) UCP(BO, ac2, 2, 2)
              __builtin_amdgcn_sched_barrier(0);
              URD(BO, ro3, 1) UCP(BE, ac3, 3, 0)
              __builtin_amdgcn_sched_barrier(0);
              UCP(BO, ac3, 3, 1) }
#undef URD
#undef UCP
#pragma unroll
            for (int a = 0; a < 4; ++a) xs[a] = xn[a];
            VM_WAIT(); __syncthreads();
        }
        float gt0[UCAP0 / 4], gt1[UCAP1 / 4], gt2[UCAP2 / 4], gt3[UCAP3 / 4];
        float sq0[UCAP0 / 4], sq1[UCAP1 / 4], sq2[UCAP2 / 4], sq3[UCAP3 / 4];
#define UGT(gt, sq, arr, a, CAP) { const float* gp_ = SGATE + (tbase + tl[a]) * 128; const float sx_ = SX[tbase + tl[a]]; _Pragma("unroll") for (int i = 0; i < CAP / 4; ++i) { gt[i] = gp_[min(glo[a] + 4 * i + jc, 127)]; sq[i] = sx_ * SU[er * 1024 + (int)(arr[i] >> 6)]; } }
        UGT(gt0, sq0, ro0, 0, UCAP0) UGT(gt1, sq1, ro1, 1, UCAP1) UGT(gt2, sq2, ro2, 2, UCAP2) UGT(gt3, sq3, ro3, 3, UCAP3)
#undef UGT
#define UOUT(arr, acc, gt, sq, a, CAP) { const size_t tk = tbase + tl[a]; _Pragma("unroll") for (int s = 0; s < CAP; ++s) { const int toti = quad_sum_i(acc[s]); \
            if ((s & 3) == jc && s < NSLOT) { unsigned wv = 0u; if (s < gcnt[a]) { const float av = gelu_tanh((float)toti * sq[s >> 2]) * gt[s >> 2]; wv = (arr[s >> 2] << 16) | (cvt_pk_f16(av, 0.f) & 0xffffu); } \
                PACK2[(tk * 16 + er) * NSLOT + s] = wv; } } \
            _Pragma("unroll") for (int s = CAP; s < NSLOT; ++s) if ((s & 3) == jc && s >= gcnt[a]) PACK2[(tk * 16 + er) * NSLOT + s] = 0u; }
        UOUT(ro0, ac0, gt0, sq0, 0, UCAP0) UOUT(ro1, ac1, gt1, sq1, 1, UCAP1) UOUT(ro2, ac2, gt2, sq2, 2, UCAP2) UOUT(ro3, ac3, gt3, sq3, 3, UCAP3)
#undef UOUT
#undef XA
        { int myrank = 0; const int mykey = (cnt << 6) | (63 - F.lane);
          for (int p = 0; p < 64; ++p) myrank += (__shfl(key, p) > mykey) ? 1 : 0;
          const int cap = myrank < 16 ? UCAP0 : (myrank < 32 ? UCAP1 : (myrank < 48 ? UCAP2 : UCAP3));
          const v4u* xsp = (const v4u*)(XBS + t * 32);
          for (int s = cap; s < cnt; ++s) {
              const int pos = lo + s, e = SEID[t * LP + pos]; const int f = (e >> 2) & 3; int di = 0;
              for (int ks = 0; ks < 32; ++ks)
#pragma unroll
                  for (int j = 0; j < 4; ++j) { const v4u u4 = *(const v4u*)(TU + (((size_t)ks * NEXP + e) * 4 + (j ^ f)) * 8); const v4u x4 = xsp[(size_t)ks * T * 4 + j];
                      di = sdot4(u4.x, x4.x, di); di = sdot4(u4.y, x4.y, di); di = sdot4(u4.z, x4.z, di); di = sdot4(u4.w, x4.w, di); }
              const float d = (float)di * SX[t] * SU[e];
              const int row = e & 1023;
              const unsigned wv = ((unsigned)((row << 6) + (((row >> 2) & 3) << 4)) << 16) | (cvt_pk_f16(gelu_tanh(d) * SGATE[t * 128 + pos], 0.f) & 0xffffu);
              if (s < NSLOT) PACK2[(t * 16 + er) * NSLOT + s] = wv; else PACK[t * LP + pos] = wv; }
        }
    }
}
#ifndef VBLK
#define VBLK 2
#endif
#if VBLK == 4
#define VTT(x, j) (4 * ((x) & 3) + ((j) & 3))
#define VDS(x, j, it) (32 * ((x) >> 2) + 8 * (it) + ((j) >> 2))
#elif VBLK == 8
#define VTT(x, j) (8 * ((x) & 1) + ((j) & 7))
#define VDS(x, j, it) (16 * ((x) >> 1) + 4 * (it) + ((j) >> 3))
#elif VBLK == 2
#define VTT(x, j) (2 * (x) + ((j) & 1))
#define VDS(x, j, it) (16 * (it) + ((j) >> 1))
#else
#define VTT(x, j) ((j) & 15)
#define VDS(x, j, it) (((x) * 32 + (j) + 256 * (it)) >> 4)
#endif
__device__ __forceinline__ void phase_peer_v(const Frame& F0, int l) {
    Frame F = F0; F.tid = F.wave * 64 + lane_id(); asm volatile("" : "+v"(F.tid)); F.lane = F.tid & 63;
    unsigned char* ws = opqg(F.ws);
    const bf16* TV = (const bf16*)(ws + WS_TBV) + (size_t)l * 64 * NEXP * 32; const bf16* XS = (const bf16*)(ws + WS_XH); bf16* RS = (bf16*)(ws + WS_RH);
    const unsigned* PACK = (const unsigned*)(ws + WS_PACK); const unsigned char* START = ws + WS_START; const unsigned* PACK2 = (const unsigned*)(ws + WS_PACK2);
    for (int it = 0; it * F.G + F.vcu < 1024; ++it) {
        int tt, ds;
        if (F.G == 256) { const int x = F.vcu >> 5, j = F.vcu & 31; tt = VTT(x, j); ds = VDS(x, j, it); }
        else { const int unit = it * F.G + F.vcu; tt = unit & 15; ds = unit >> 4; }
        const size_t t = (size_t)tt * 512 + F.tid;
        const v4u st4 = *(const v4u*)(START + t * 16);
        const unsigned stw[4] = {st4.x, st4.y, st4.z, st4.w};
        unsigned acc[16];
#pragma unroll
        for (int i = 0; i < 16; ++i) acc[i] = 0u;
        const bf16* gsl0 = TV + (size_t)ds * NEXP * 32;
        unsigned Lc[NSLOT];
        { const v4u* lp = (const v4u*)(PACK2 + t * 16 * NSLOT);
#pragma unroll
          for (int s = 0; s < NSLOT / 4; ++s) { const v4u q = lp[s]; Lc[4 * s] = q.x; Lc[4 * s + 1] = q.y; Lc[4 * s + 2] = q.z; Lc[4 * s + 3] = q.w; } }
        peer_dma(F, gsl0, 0);
        VM_WAIT(); __syncthreads();
#pragma unroll 1
        for (int c = 0; c < 16; ++c) {
            const int bo = (c & 1) * 65536;
            const int q0 = c >> 2, q1 = (c + 1) >> 2;
            const unsigned w0 = q0 == 0 ? stw[0] : (q0 == 1 ? stw[1] : (q0 == 2 ? stw[2] : stw[3])), w1 = q1 == 0 ? stw[0] : (q1 == 1 ? stw[1] : (q1 == 2 ? stw[2] : stw[3]));
            const int s_c = (int)((w0 >> ((c & 3) * 8)) & 255u);
            const int s_n = (c < 15) ? (int)((w1 >> (((c + 1) & 3) * 8)) & 255u) : 128;
            const int n_c = s_n - s_c;
            unsigned Ln[NSLOT];
            const int cn = (c < 15) ? c + 1 : c;
            { const v4u* lp = (const v4u*)(PACK2 + (t * 16 + cn) * NSLOT);
#pragma unroll
              for (int s = 0; s < NSLOT / 4; ++s) { const v4u q = lp[s]; Ln[4 * s] = q.x; Ln[4 * s + 1] = q.y; Ln[4 * s + 2] = q.z; Ln[4 * s + 3] = q.w; } }
            if (c < 15) peer_dma(F, gsl0 + (size_t)cn * 1024 * 32, bo ^ 65536);
            const int wmax = wave_max_i(min(n_c, NSLOT));
#pragma unroll
            for (int g = 0; g < NSLOT / 2; ++g) {
                if (2 * g < wmax) {
                    v4u v4[2][4]; unsigned a2[2];
#pragma unroll
                    for (int q = 0; q < 2; ++q) { const int s = 2 * g + q; const unsigned w = Lc[s];
                        a2[q] = __builtin_amdgcn_perm(w, w, 0x01000100u);
                        const int a0 = bo + (int)((w >> 16) & 0xfff0u);
#pragma unroll
                        for (int j = 0; j < 4; ++j) v4[q][j] = *(const LAS v4u*)(F.lds + (a0 ^ (j << 4))); }
#pragma unroll
                    for (int q = 0; q < 2; ++q)
#pragma unroll
                        for (int j = 0; j < 4; ++j) {
                            acc[4 * j + 0] = pkfmah(v4[q][j].x, a2[q], acc[4 * j + 0]); acc[4 * j + 1] = pkfmah(v4[q][j].y, a2[q], acc[4 * j + 1]);
                            acc[4 * j + 2] = pkfmah(v4[q][j].z, a2[q], acc[4 * j + 2]); acc[4 * j + 3] = pkfmah(v4[q][j].w, a2[q], acc[4 * j + 3]); }
                }
            }
            for (int s = NSLOT; s < n_c; ++s) {
                const unsigned w = PACK[t * LP + s_c + s]; const unsigned a2 = (w & 0xffffu) | (w << 16);
                const int a0 = bo + (int)((w >> 16) & 0xfff0u);
#pragma unroll
                for (int j = 0; j < 4; ++j) { const v4u v4 = *(const LAS v4u*)(F.lds + (a0 ^ (j << 4)));
                    acc[4 * j + 0] = pkfmah(v4.x, a2, acc[4 * j + 0]); acc[4 * j + 1] = pkfmah(v4.y, a2, acc[4 * j + 1]);
                    acc[4 * j + 2] = pkfmah(v4.z, a2, acc[4 * j + 2]); acc[4 * j + 3] = pkfmah(v4.w, a2, acc[4 * j + 3]); }
            }
            VM_WAIT(); __syncthreads();
#pragma unroll
            for (int s = 0; s < NSLOT; ++s) Lc[s] = Ln[s];
        }
        const v4u* xp = (const v4u*)(XS + ((size_t)ds * T + t) * 32); v4u* rp = (v4u*)(RS + ((size_t)ds * T + t) * 32);
        v4u xw4[4];
#pragma unroll
        for (int j = 0; j < 4; ++j) xw4[j] = xp[j];
#pragma unroll
        for (int j = 0; j < 4; ++j) { const v4u xw = xw4[j]; const unsigned xx[4] = {xw.x, xw.y, xw.z, xw.w}; unsigned o[4];
#pragma unroll
            for (int k = 0; k < 4; ++k) { const h2_t xv = __builtin_bit_cast(h2_t, xx[k]), yv = __builtin_bit_cast(h2_t, acc[4 * j + k]);
                o[k] = cvt_pk_f16((float)xv.x * ALPHA + (float)yv.x, (float)xv.y * ALPHA + (float)yv.y); }
            rp[j] = (v4u){o[0], o[1], o[2], o[3]}; }
    }
}

constexpr int PH_PER_LAYER = 13, N_PHASES = 2 + DEPTH * PH_PER_LAYER;
__global__ void __launch_bounds__(512, 2) fwd_kernel(Args args) {
    extern __shared__ __attribute__((aligned(16))) unsigned char lds[];
    Frame F;
    F.lds = (LAS unsigned char*)lds;
    F.wave = __builtin_amdgcn_readfirstlane((int)threadIdx.x >> 6); F.tid = 0; F.lane = 0;
    F.G = gridDim.x; { const int bx = blockIdx.x; F.vcu = (F.G % 8 == 0) ? (bx % 8) * (F.G / 8) + bx / 8 : bx; }
    F.ws = args.ws; F.ka = (const __attribute__((address_space(4))) Args*)__builtin_amdgcn_kernarg_segment_ptr();
    unsigned char* ws = args.ws;
    for (int u = F.wave * 64 + lane_id(); u < (LDS_BYTES - LDSCTL_OFF) / 4; u += 512) ((LAS unsigned*)(F.lds + LDSCTL_OFF))[u] = 0u;
    __syncthreads();
    XcdBarrier bar; bar.bar = (unsigned*)(ws + WS_CTL) + CW_BAR; bar.x = 0; bar.st = nullptr;
    const int lo = args.ph_lo, hi = args.ph_hi;
    if (hi - lo > 1) bar = xcd_barrier_post((unsigned*)(ws + WS_CTL) + CW_BAR, (volatile LAS unsigned*)(F.lds + MISC_OFF) + 8, F.wave == 0 && lane_id() == 0);
#ifndef PHMASK
#define PHMASK 0xFFF
#endif
#define EN(i) ((PHMASK >> (i)) & 1)
#ifndef RPT
#define RPT 0
#endif
#define REP(i) for (int _r = 0; _r <= ((RPT >> (i)) & 1); ++_r)
#define IN(k) (lo <= (k) && (k) < hi)
#define SEAM(k) do { if (IN((k) + 1)) xcd_barrier(bar, F.wave); } while (0)

    if (EN(10) && IN(0)) { REP(13) { phase_prologue_a(F); } SEAM(0); }
    if (EN(11) && IN(1)) REP(14) {
        phase_prologue_b(F);
        unsigned char* ws = opqg(args.ws);
        int kc = 256; asm volatile("" : "+s"(kc));
        pg8::Gemm g{(const bf16*)(ws + WS_BK), (const bf16*)(ws + WS_WQB), DEPTH * 2048, 2048, kc, 256, 2048, 256, (long)2048 * 2048};
        pg8::StaticOrder S; S.init(DEPTH * 2048, 2048, F.G, (int)blockIdx.x);
        pg8::EpiF16 E{(bf16*)(ws + WS_WPQ), 2048};
        pg8::gemm_phase<pg8::EpiF16, pg8::StaticOrder, true>(F.lds, g, S, E, F.wave);
        if (_r == ((RPT >> 14) & 1)) SEAM(1);
    }
    for (int l = 0; l < DEPTH; ++l) {
        const int pb = 2 + l * PH_PER_LAYER;
        if (EN(0) && IN(pb + 0)) REP(0) {
            unsigned char* ws = opqg(args.ws);
            pg8::Gemm g{(const bf16*)(ws + WS_XH), (const bf16*)(ws + WS_WIN) + (size_t)l * NIN * D, T, NIN, D, T, D, 0, 0};
            pg8::StaticOrder S; S.init(T, (F.G == 256) ? 32 * 256 : NIN, F.G, (int)blockIdx.x);
            pg8::EpiIn E{(bf16*)(ws + WS_Q), (bf16*)(ws + WS_KK), (bf16*)(ws + WS_V), (bf16*)(ws + WS_SG), (bf16*)(ws + WS_UB), (bf16*)(ws + WS_GR), (bf16*)(ws + WS_GB),
                         (float*)(ws + WS_LOGF), (const float*)(ws + WS_LB) + l * AW};
            pg8::gemm_phase<pg8::EpiIn, pg8::StaticOrder, true, true, true>(F.lds, g, S, E, F.wave);
            if (_r == ((RPT >> 0) & 1)) SEAM(pb + 0);
        }
        if (EN(1) && IN(pb + 1)) { REP(1) { REP(17) { phase_hgrn_local(F, l); } REP(18) { phase_s5_local(F, l); } } SEAM(pb + 1); }
        if (EN(2) && IN(pb + 2)) { REP(2) { phase_scan(F, l); } SEAM(pb + 2); }
        if (EN(3) && IN(pb + 3)) { REP(3) { REP(15) { phase_hgrn_out(F, l); } REP(16) { phase_s5_out(F, l); } } SEAM(pb + 3); }
        if (EN(4) && IN(pb + 4)) REP(4) {
            unsigned char* ws = opqg(args.ws);
            if (F.G == 256 && blockIdx.x < 128) {
                pg8::Gemm g{(const bf16*)(ws + WS_XH), (const bf16*)(ws + WS_WIN) + (size_t)l * NIN * D, T, NIN, D, T, D, 0, 0};
                pg8::OffOrder S; S.init(T, 4 * 256, F.G, (int)blockIdx.x, 32);
                pg8::EpiIn E{(bf16*)(ws + WS_Q), (bf16*)(ws + WS_KK), (bf16*)(ws + WS_V), (bf16*)(ws + WS_SG), (bf16*)(ws + WS_UB), (bf16*)(ws + WS_GR), (bf16*)(ws + WS_GB),
                             (float*)(ws + WS_LOGF), (const float*)(ws + WS_LB) + l * AW};
                pg8::gemm_phase<pg8::EpiIn, pg8::OffOrder, true, true, true>(F.lds, g, S, E, F.wave);
            } else {
                pg8::Gemm g{(const bf16*)(ws + WS_YB), (const bf16*)(ws + WS_WGLU) + (size_t)l * 2048 * 1024, T, 2048, 1024, 1024, 1024, 0, 0};
                pg8::EpiGlu E{(bf16*)(ws + WS_OAB) + 1024, 2048};
                if (F.G == 256) { pg8::PairOrder S{(int)blockIdx.x, 128, 8, 256}; pg8::gemm_phase<pg8::EpiGlu, pg8::PairOrder, true>(F.lds, g, S, E, F.wave); }
                else { pg8::StaticOrder S; S.init(T, 2048, F.G, (int)blockIdx.x); pg8::gemm_phase<pg8::EpiGlu, pg8::StaticOrder, true>(F.lds, g, S, E, F.wave); }
            }
            if (_r == ((RPT >> 4) & 1)) SEAM(pb + 4);
        }
        if (EN(5) && IN(pb + 5)) REP(5) {
            unsigned char* ws = opqg(args.ws);
            pg8::Gemm g{(const bf16*)(ws + WS_OAB), (const bf16*)(ws + WS_WUP) + (size_t)l * 2048 * 2048, T, 2048, 2048, 2048, 2048, 0, 0};
            pg8::StaticOrder S; S.init(T, 2048, F.G, (int)blockIdx.x);
            pg8::EpiUp E{(bf16*)(ws + WS_MG), (const bf16*)(ws + WS_GR), (const bf16*)(ws + WS_GB)};
            pg8::gemm_phase<pg8::EpiUp, pg8::StaticOrder, true>(F.lds, g, S, E, F.wave);
            if (_r == ((RPT >> 5) & 1)) SEAM(pb + 5);
        }
        if (EN(6) && IN(pb + 6)) REP(6) {
            unsigned char* ws = opqg(args.ws);
            pg8::Gemm g{(const bf16*)(ws + WS_MG), (const bf16*)(ws + WS_WO) + (size_t)l * 2048 * 2048, T, 2048, 2048, 2048, 2048, 0, 0};
            pg8::StaticOrder S; S.init(T, 2048, F.G, (int)blockIdx.x);
            pg8::EpiResH E{(bf16*)(ws + WS_RH), (const bf16*)(ws + WS_XH)};
            pg8::gemm_phase<pg8::EpiResH, pg8::StaticOrder, true>(F.lds, g, S, E, F.wave);
            if (_r == ((RPT >> 6) & 1)) SEAM(pb + 6);
        }
        if (EN(7) && IN(pb + 7)) { REP(7) { phase_ln(F, l, 0); } SEAM(pb + 7); }
        if (EN(8) && IN(pb + 8)) REP(8) {
            unsigned char* ws = opqg(args.ws);
            pg8::Gemm g{(const bf16*)(ws + WS_XH), (const bf16*)(ws + WS_WPQ) + (size_t)l * 2048 * 2048, T, 2048, 2048, T, 2048, 0, 0};
            pg8::StaticOrder S; S.init(T, 2048, F.G, (int)blockIdx.x);
            pg8::EpiBf16 E{(bf16*)(ws + WS_SC), 2048};
            pg8::gemm_phase<pg8::EpiBf16, pg8::StaticOrder, true, true, true>(F.lds, g, S, E, F.wave);
            if (_r == ((RPT >> 8) & 1)) SEAM(pb + 8);
        }
        if (EN(9) && IN(pb + 9)) { REP(9) { phase_topk(F, l); } SEAM(pb + 9); }
        if (EN(9) && IN(pb + 10)) { REP(10) { phase_peer_u(F, l); } SEAM(pb + 10); }
        if (EN(9) && IN(pb + 11)) { REP(11) { phase_peer_v(F, l); } SEAM(pb + 11); }
        if (EN(9) && IN(pb + 12)) { REP(12) { phase_ln(F, l, 1); } SEAM(pb + 12); }
    }
#undef IN
#undef SEAM
}

extern "C" void kernel_launch(void* const* d_in, const int* in_sizes, int n_in, void* d_out, int out_size, void* d_ws, size_t ws_size, hipStream_t stream) {
    static int grid = 0;
    if (grid == 0) {
        if (n_in != 24 || out_size != T * D || ws_size < WS_END) { fprintf(stderr, "kernel_launch: unexpected sizes (n_in %d out %d ws %zu need %zu)\n", n_in, out_size, ws_size, (size_t)WS_END); grid = -1; return; }
        int dev = 0, cus = 0, per_cu = 0;
        if (hipGetDevice(&dev) != hipSuccess || hipDeviceGetAttribute(&cus, hipDeviceAttributeMultiprocessorCount, dev) != hipSuccess) { grid = -1; return; }
        if (hipFuncSetAttribute((const void*)fwd_kernel, hipFuncAttributeMaxDynamicSharedMemorySize, LDS_BYTES) != hipSuccess) { fprintf(stderr, "kernel_launch: hipFuncSetAttribute failed\n"); grid = -1; return; }
        if (hipOccupancyMaxActiveBlocksPerMultiprocessor(&per_cu, (const void*)fwd_kernel, 512, LDS_BYTES) != hipSuccess || per_cu < 1)
            fprintf(stderr, "kernel_launch: occupancy query reports %d\n", per_cu);
        (void)hipGetLastError();
        grid = cus;
    }
    if (grid < 0) return;
    if (hipMemsetAsync((char*)d_ws + WS_CTL, 0, CTL_ZERO_BYTES, stream) != hipSuccess) return;
    Args a{};
    for (int i = 0; i < 24; ++i) a.in[i] = (const float*)d_in[i];
    a.out = (float*)d_out; a.ws = (unsigned char*)d_ws;
#if ONE_LAUNCH
    a.ph_lo = 0; a.ph_hi = N_PHASES;
    hipLaunchKernelGGL(fwd_kernel, dim3(grid), dim3(512), LDS_BYTES, stream, a);
#else
    for (int p = 0; p < N_PHASES; ++p) { a.ph_lo = p; a.ph_hi = p + 1; hipLaunchKernelGGL(fwd_kernel, dim3(grid), dim3(512), LDS_BYTES, stream, a); }
#endif
}
```

```cpp
#include <hip/hip_runtime.h>
#include <cstdio>
#include <cstdint>

#define LAS __attribute__((address_space(3)))
#define GAS __attribute__((address_space(1)))
typedef unsigned short bf16;
typedef unsigned v4u __attribute__((ext_vector_type(4)));
typedef unsigned v2u __attribute__((ext_vector_type(2)));
typedef float f32x4 __attribute__((ext_vector_type(4)));
typedef float f32x2 __attribute__((ext_vector_type(2)));
typedef short bf16x8 __attribute__((ext_vector_type(8)));
typedef short s16x4 __attribute__((ext_vector_type(4)));

#ifndef ONE_LAUNCH
#define ONE_LAUNCH 1
#endif

constexpr int T = 8192, D = 2048, DEPTH = 4, NIN = 9216;
constexpr int AW = 1024;
constexpr int NCH = 128;
constexpr float ALPHA = 1.6817928305074290f;
constexpr float LN_EPS = 1e-5f, RMS_EPS = 1e-6f;
constexpr int NEXP = 16384;
constexpr int LP = 160;
constexpr int NSLOT = 24;

constexpr size_t MiB = 1u << 20;
constexpr size_t WS_CTL = 0, CTL_ZERO_BYTES = 32768;
constexpr size_t WS_WIN  = 1 * MiB;
constexpr size_t WS_WGLU = WS_WIN + 144 * MiB;
constexpr size_t WS_WUP  = WS_WGLU + 16 * MiB;
constexpr size_t WS_WO   = WS_WUP + 32 * MiB;
constexpr size_t WS_WQB  = WS_WO + 32 * MiB;
constexpr size_t WS_BK   = WS_WQB + 32 * MiB;
constexpr size_t WS_WPQ  = WS_BK + 4 * MiB;
constexpr size_t WS_LB   = WS_WPQ + 32 * MiB;
constexpr size_t WS_APOW = WS_LB + 1 * MiB;
constexpr size_t WS_BB   = WS_APOW + 9 * MiB;
constexpr size_t WS_KMAT = WS_BB + 2 * MiB;
constexpr size_t WS_PM   = WS_KMAT + 9 * MiB;
constexpr size_t WS_E    = WS_PM + 64 * MiB;
constexpr size_t WS_X32  = WS_E + 64 * MiB;
constexpr size_t WS_X1   = WS_X32 + 64 * MiB;
constexpr size_t WS_XB   = WS_X1 + 64 * MiB;
constexpr size_t WS_Q    = WS_XB + 32 * MiB;
constexpr size_t WS_KK   = WS_Q + 16 * MiB;
constexpr size_t WS_V    = WS_KK + 16 * MiB;
constexpr size_t WS_SG   = WS_V + 16 * MiB;
constexpr size_t WS_UB   = WS_SG + 16 * MiB;
constexpr size_t WS_LOGF = WS_UB + 16 * MiB;
constexpr size_t WS_GR   = WS_LOGF + 32 * MiB;
constexpr size_t WS_GB   = WS_GR + 32 * MiB;
constexpr size_t WS_U    = WS_GB + 32 * MiB;
constexpr size_t WS_SP   = WS_U + 64 * MiB;
constexpr size_t WS_BL   = WS_SP + 32 * MiB;
constexpr size_t WS_XLOC = WS_BL + 1 * MiB;
constexpr size_t WS_XS   = WS_XLOC + 4 * MiB;
constexpr size_t WS_OAB  = WS_XS + 4 * MiB;
constexpr size_t WS_YB   = WS_OAB + 32 * MiB;
constexpr size_t WS_MG   = WS_YB + 16 * MiB;
constexpr size_t WS_R    = WS_MG + 32 * MiB;
constexpr size_t WS_SC   = WS_R + 64 * MiB;
constexpr size_t WS_TBU  = WS_SC + 64 * MiB;
constexpr size_t WS_TBV  = WS_TBU + 256 * MiB;
constexpr size_t WS_SEID = WS_TBV + 256 * MiB;
constexpr size_t WS_SGATE= WS_SEID + 6 * MiB;
constexpr size_t WS_PACK = WS_SGATE + 4 * MiB;
constexpr size_t WS_START= WS_PACK + 6 * MiB;
constexpr size_t WS_PACK2= WS_START + 1 * MiB;
constexpr size_t WS_XBS  = WS_PACK2 + 13 * MiB;
constexpr size_t WS_END  = WS_XBS + 32 * MiB;
constexpr size_t WS_XH = WS_XBS;
constexpr size_t WS_XQ = WS_X1;
constexpr size_t WS_SX = WS_X1 + 16 * MiB;
constexpr size_t WS_SU = WS_X1 + 17 * MiB;
constexpr size_t WS_SW = WS_X1 + 18 * MiB;
constexpr size_t WS_WP8 = WS_WQB;
constexpr size_t WS_RH = WS_R;

constexpr int CW_TMO = 0, CW_CODE = 1;
constexpr int CW_BAR = 4096;

constexpr int RING_BYTES = 131072;
constexpr int LDSCTL_OFF = RING_BYTES, MISC_OFF = LDSCTL_OFF + 320;
constexpr int LDS_BYTES = 147456;

#define LDS_WAIT() asm volatile("s_waitcnt lgkmcnt(0)" ::: "memory")
#define VM_WAIT() asm volatile("s_waitcnt vmcnt(0)" ::: "memory")
__device__ __forceinline__ unsigned cvt_pk_bf16(float lo, float hi) { unsigned r; asm volatile("v_cvt_pk_bf16_f32 %0, %1, %2" : "=v"(r) : "v"(lo), "v"(hi)); return r; }
typedef _Float16 h2_t __attribute__((ext_vector_type(2)));
__device__ __forceinline__ unsigned cvt_pk_f16a(float lo, float hi) { unsigned r; asm volatile("v_cvt_pk_f16_f32 %0, %1, %2" : "=v"(r) : "v"(lo), "v"(hi)); return r; }
__device__ __forceinline__ unsigned cvt_pk_f16(float lo, float hi) { h2_t p; p.x = (_Float16)lo; p.y = (_Float16)hi; return __builtin_bit_cast(unsigned, p); }
__device__ __forceinline__ float dot2h(unsigned a, unsigned b, float c) { return __builtin_amdgcn_fdot2(__builtin_bit_cast(h2_t, a), __builtin_bit_cast(h2_t, b), c, false); }
__device__ __forceinline__ unsigned pkfmah(unsigned a, unsigned b, unsigned c) { return __builtin_bit_cast(unsigned, __builtin_elementwise_fma(__builtin_bit_cast(h2_t, a), __builtin_bit_cast(h2_t, b), __builtin_bit_cast(h2_t, c))); }
__device__ __forceinline__ float bf_lo(unsigned u) { return __uint_as_float(u << 16); }
__device__ __forceinline__ float bf_hi(unsigned u) { return __uint_as_float(u & 0xffff0000u); }
__device__ __forceinline__ float bf2f(bf16 b) { return __uint_as_float(((unsigned)b) << 16); }
__device__ __forceinline__ bf16 f2bf(float f) { return (bf16)(cvt_pk_bf16(f, 0.f) & 0xffffu); }
__device__ __forceinline__ float fexp(float x) { return __builtin_amdgcn_exp2f(x * 1.4426950408889634f); }
__device__ __forceinline__ float flog(float x) { return __builtin_amdgcn_logf(x) * 0.6931471805599453f; }
__device__ __forceinline__ float frcp(float x) { return __builtin_amdgcn_rcpf(x); }
__device__ __forceinline__ float gelu_tanh(float x) {
    const float u = 1.5957691216057308f * (x + 0.044715f * x * x * x);
    const float uc = fminf(fmaxf(u, -60.f), 60.f);
    return x * frcp(1.f + fexp(-uc));
}
__device__ __forceinline__ int lane_id() { int r; asm volatile("v_mbcnt_lo_u32_b32 %0, -1, 0\n\tv_mbcnt_hi_u32_b32 %0, -1, %0" : "=v"(r)); return r; }
__device__ __forceinline__ float wave_sum(float v) {
#pragma unroll
    for (int o = 1; o < 64; o <<= 1) v += __shfl_xor(v, o);
    return v;
}

__device__ __forceinline__ void vlaunder(int& a, int& b) { asm volatile("" : "+v"(a), "+v"(b)); }
template <class P> __device__ __forceinline__ P* opq(P* p) { asm volatile("" : "+s"(p)); return p; }
__device__ __forceinline__ unsigned char* opqg(unsigned char* p) { GAS unsigned char* g = (GAS unsigned char*)p; asm volatile("" : "+s"(g)); return (unsigned char*)g; }
#define GP(T, p) ((T*)(GAS T*)(p))

namespace pg8 {
#define PG8_LAS __attribute__((address_space(3)))
typedef unsigned short bf16_t;
constexpr int BM = 256, BK = 64, HALF = 128, HTB = HALF * BK * 2, STAGE_BYTES = 8 * HTB, NXCD = 8, WGM = 8;

__host__ __device__ __forceinline__ int lds_byte(int r, int c) { const int st = (r >> 4) * 2 + (c >> 5), rr = r & 15, cc = c & 31, ob = rr * 64 + cc * 2; return st * 1024 + (ob ^ (((ob >> 9) & 1) << 5)); }
__host__ __device__ __forceinline__ void stage_rc(int b, int& R, int& C) { const int st = b / 1024, sb = b % 1024, swz = sb ^ (((sb >> 9) & 1) << 5); R = (st >> 1) * 16 + swz / 64; C = (st & 1) * 32 + (swz % 64) / 2; }
__host__ __device__ __forceinline__ int perm32(int rho) { const int n = rho >> 4, i = rho & 15; return 8 * (i >> 2) + 4 * n + (i & 3); }

struct Unit { int pm, pn; };
struct Gemm { const bf16_t* A; const bf16_t* Bt; int M, N, K, lda, ldb, bkoff; long blstride; };

struct StaticOrder {
    int nM, nN, nwg, G, c;
    __host__ __device__ void init(int M, int N, int G_, int c_) { nM = M / BM; nN = N / BM; nwg = nM * nN; G = G_; c = c_; }
    __host__ __device__ bool next(int i, Unit& u) const {
        const long L = (long)i * G + c; if (L >= nwg) return false;
        int wgid = (int)L; { const int q = nwg / NXCD, r = nwg % NXCD, xcd = wgid % NXCD, off = wgid / NXCD; wgid = (xcd < r ? xcd * (q + 1) : r * (q + 1) + (xcd - r) * q) + off; }
        const int nig = WGM * nN, gid = wgid / nig, fm = gid * WGM, gsz = (nM - fm) < WGM ? (nM - fm) : WGM;
        u.pm = fm + ((wgid % nig) % gsz); u.pn = (wgid % nig) / gsz; return true;
    }
    __device__ __forceinline__ void a_ready(const Unit&) const {}
    __device__ __forceinline__ void done(const Unit&) const {}
};

struct OffOrder {
    StaticOrder b; int pn0;
    __device__ void init(int M, int N, int G_, int c_, int pn0_) { b.init(M, N, G_, c_); pn0 = pn0_; }
    __device__ bool next(int i, Unit& u) const { if (!b.next(i, u)) return false; u.pn += pn0; return true; }
    __device__ __forceinline__ void a_ready(const Unit&) const {}
    __device__ __forceinline__ void done(const Unit&) const {}
};
struct PairOrder {
    int c, c0, nN, nwg;
    __device__ bool next(int i, Unit& u) const { if (c < c0 || i >= 2) return false; const int id = (c - c0) * 2 + i; if (id >= nwg) return false; u.pm = id / nN; u.pn = id % nN; return true; }
    __device__ __forceinline__ void a_ready(const Unit&) const {}
    __device__ __forceinline__ void done(const Unit&) const {}
};
typedef f32x4 Acc[2][2][4][2];

typedef _Float16 f16x8 __attribute__((ext_vector_type(8)));
typedef int i32x4 __attribute__((ext_vector_type(4)));
template <class Epi, class Sched, bool ALIGN_EPI = false, bool F16 = false, bool ASL = false, bool I8 = false>
__device__ __forceinline__ void gemm_phase(PG8_LAS unsigned char* lds, const Gemm g, const Sched& S, const Epi& E, int wv) {
    int tid_ = wv * 64 + lane_id(); asm volatile("" : "+v"(tid_));
    const int tid = tid_, wid = __builtin_amdgcn_readfirstlane(tid >> 6), lane = tid & 63, wr = wid >> 2, wc = wid & 3, fr = lane & 15, fq = lane >> 4;
    const int K = g.K, nt = K / BK;
    unsigned voffA[2], voffB[2];
#pragma unroll
    for (int i = 0; i < 2; ++i) { int R, C; stage_rc(tid * 16 + i * 8192, R, C); const int Rb = Epi::PERM ? ((R & ~31) + perm32(R & 31)) : R;
        voffA[i] = ASL ? (unsigned)(((C >> 5) * g.lda + R) * 64 + (C & 31) * 2) : (unsigned)(R * g.lda + C) * 2u; voffB[i] = (unsigned)(Rb * g.ldb + C) * 2u; }
    const size_t kstep = (size_t)(BK * 2), kstepA = ASL ? (size_t)g.lda * 128 : (size_t)(BK * 2);
    const size_t hstepA = ASL ? (size_t)HALF * 64 : (size_t)HALF * g.lda * 2, hstepB = (size_t)HALF * g.ldb * 2;
    const size_t tstepA = 2 * hstepA, tstepB = 2 * hstepB;
    const unsigned ldsw = (unsigned)wid * 1024u;
    const int aoff = lds_byte(wr * 64 + fr, fq * 8), boff = lds_byte(wc * 32 + fr, fq * 8);
#define PG8_SA(b, h) (((b) * 2 + (h)) * HTB)
#define PG8_SB(b, h) ((4 + (b) * 2 + (h)) * HTB)
#define PG8_STAGE(bufoff, gbase, voff) do { _Pragma("unroll") for (int _i = 0; _i < 2; ++_i) \
        __builtin_amdgcn_global_load_lds((const unsigned*)((const char*)(gbase) + (voff)[_i]), (PG8_LAS unsigned*)(lds + (bufoff) + ldsw + _i * 8192), 16, 0, 0); } while (0)
#define PG8_LDA(dst, b, h) do { _Pragma("unroll") for (int m = 0; m < 4; ++m) _Pragma("unroll") for (int k = 0; k < 2; ++k) dst[m][k] = *(const PG8_LAS bf16x8*)(lds + PG8_SA(b, h) + aoff + m * 2048 + k * 1024); } while (0)
#define PG8_LDB(dst, b, h) do { _Pragma("unroll") for (int n = 0; n < 2; ++n) _Pragma("unroll") for (int k = 0; k < 2; ++k) dst[n][k] = *(const PG8_LAS bf16x8*)(lds + PG8_SB(b, h) + boff + n * 2048 + k * 1024); } while (0)
#define PG8_MMA(ai, bj, At, Bt) do { __builtin_amdgcn_s_setprio(1); _Pragma("unroll") for (int m = 0; m < 4; ++m) _Pragma("unroll") for (int n = 0; n < 2; ++n) _Pragma("unroll") for (int k = 0; k < 2; ++k) \
        { if constexpr (I8) acc[ai][bj][m][n] = __builtin_bit_cast(f32x4, __builtin_amdgcn_mfma_i32_16x16x64_i8(__builtin_bit_cast(i32x4, Bt[n][k]), __builtin_bit_cast(i32x4, At[m][k]), __builtin_bit_cast(i32x4, acc[ai][bj][m][n]), 0, 0, 0)); \
          else if constexpr (F16) acc[ai][bj][m][n] = __builtin_amdgcn_mfma_f32_16x16x32_f16(__builtin_bit_cast(f16x8, Bt[n][k]), __builtin_bit_cast(f16x8, At[m][k]), acc[ai][bj][m][n], 0, 0, 0); \
          else acc[ai][bj][m][n] = __builtin_amdgcn_mfma_f32_16x16x32_bf16(Bt[n][k], At[m][k], acc[ai][bj][m][n], 0, 0, 0); } __builtin_amdgcn_s_setprio(0); } while (0)
#define PG8_WAIT_V(n) asm volatile("s_waitcnt vmcnt(" #n ")" ::: "memory")
#define PG8_WAIT_L(n) asm volatile("s_waitcnt lgkmcnt(" #n ")" ::: "memory")
#define PG8_BAR __builtin_amdgcn_s_barrier()
#define PG8_SCHED __builtin_amdgcn_sched_barrier(0)
    Unit cur, nxt; int ui = 0;
    if (!S.next(0, cur)) return;
    Acc acc;
#pragma unroll
    for (int a = 0; a < 2; ++a)
#pragma unroll
        for (int b = 0; b < 2; ++b)
#pragma unroll
            for (int m = 0; m < 4; ++m)
#pragma unroll
                for (int n = 0; n < 2; ++n) acc[a][b][m][n] = (f32x4){0.f, 0.f, 0.f, 0.f};
    bf16x8 At[4][2], B0[2][2], B1[2][2];
    const char* cA = (const char*)g.A + (size_t)cur.pm * tstepA;
    const char* cB = (const char*)g.Bt + (size_t)cur.pn * tstepB + ((size_t)(cur.pm & 7) * g.bkoff + (size_t)(cur.pm >> 3) * g.blstride) * 2;
    S.a_ready(cur);
    PG8_STAGE(PG8_SB(0, 0), cB, voffB); PG8_STAGE(PG8_SB(0, 1), cB + hstepB, voffB); PG8_STAGE(PG8_SA(0, 0), cA, voffA); PG8_STAGE(PG8_SA(0, 1), cA + hstepA, voffA);
    if (wr == 1) PG8_BAR;
    PG8_WAIT_V(2); PG8_BAR;
    PG8_STAGE(PG8_SB(1, 0), cB + kstep, voffB); PG8_STAGE(PG8_SA(1, 0), cA + kstepA, voffA); PG8_STAGE(PG8_SB(1, 1), cB + hstepB + kstep, voffB);
    PG8_WAIT_V(6); PG8_BAR;
    for (;;) {
        const bool has_next = S.next(ui + 1, nxt);
        const char* nA = has_next ? (const char*)g.A + (size_t)nxt.pm * tstepA : cA;
        const char* nB = has_next ? (const char*)g.Bt + (size_t)nxt.pn * tstepB + ((size_t)(nxt.pm & 7) * g.bkoff + (size_t)(nxt.pm >> 3) * g.blstride) * 2 : cB;
        for (int t = 0; t < nt; t += 2) {
            const bool last = (t == nt - 2);
            const char* a1 = cA + (size_t)(t + 1) * kstepA;
            const char* a2 = last ? nA : cA + (size_t)(t + 2) * kstepA; const char* b2 = last ? nB : cB + (size_t)(t + 2) * kstep;
            const char* a3 = a2 + kstepA; const char* b3 = b2 + kstep;
            if (last && has_next) S.a_ready(nxt);
            PG8_LDB(B0, 0, 0); PG8_LDB(B1, 0, 1); PG8_SCHED; PG8_LDA(At, 0, 0); PG8_STAGE(PG8_SA(1, 1), a1 + hstepA, voffA);
            PG8_WAIT_V(8); PG8_WAIT_L(0); PG8_BAR; PG8_MMA(0, 0, At, B0); PG8_MMA(0, 1, At, B1); PG8_BAR; PG8_SCHED;
            PG8_LDA(At, 0, 1); PG8_STAGE(PG8_SB(0, 0), b2, voffB); PG8_STAGE(PG8_SB(0, 1), b2 + hstepB, voffB); PG8_STAGE(PG8_SA(0, 0), a2, voffA);
            PG8_WAIT_V(8); PG8_WAIT_L(0); PG8_BAR; PG8_MMA(1, 0, At, B0); PG8_MMA(1, 1, At, B1); PG8_BAR; PG8_SCHED;
            PG8_LDB(B0, 1, 0); PG8_LDB(B1, 1, 1); PG8_SCHED; PG8_LDA(At, 1, 0); PG8_STAGE(PG8_SA(0, 1), a2 + hstepA, voffA);
            PG8_WAIT_V(8); PG8_WAIT_L(0); PG8_BAR; PG8_MMA(0, 0, At, B0); PG8_MMA(0, 1, At, B1); PG8_BAR; PG8_SCHED;
            PG8_LDA(At, 1, 1); PG8_STAGE(PG8_SB(1, 0), b3, voffB); PG8_STAGE(PG8_SB(1, 1), b3 + hstepB, voffB); PG8_STAGE(PG8_SA(1, 0), a3, voffA);
            PG8_WAIT_V(8); PG8_WAIT_L(0); PG8_BAR; PG8_MMA(1, 0, At, B0); PG8_MMA(1, 1, At, B1); PG8_BAR; PG8_SCHED;
            if constexpr (Epi::HAS_MID) { if (t + 2 == (nt >> 1)) E.mid(acc, cur, wr, wc, fr, fq); }
        }
        if constexpr (ALIGN_EPI) { if (wr == 0) PG8_BAR; }
        E(acc, cur, wr, wc, fr, fq); S.done(cur);
        if (!has_next) break;
#pragma unroll
        for (int a = 0; a < 2; ++a)
#pragma unroll
            for (int b = 0; b < 2; ++b)
#pragma unroll
                for (int m = 0; m < 4; ++m)
#pragma unroll
                    for (int n = 0; n < 2; ++n) acc[a][b][m][n] = (f32x4){0.f, 0.f, 0.f, 0.f};
        cur = nxt; cA = nA; cB = nB; ++ui;
        if constexpr (ALIGN_EPI) { if (wr == 1) PG8_BAR; }
    }
    PG8_WAIT_V(0);
    if constexpr (!ALIGN_EPI) { if (wr == 0) PG8_BAR; }
    PG8_BAR;
#undef PG8_SA
#undef PG8_SB
#undef PG8_STAGE
#undef PG8_LDA
#undef PG8_LDB
#undef PG8_MMA
#undef PG8_WAIT_V
#undef PG8_WAIT_L
#undef PG8_BAR
#undef PG8_SCHED
}

struct EpiResH {
    static constexpr bool PERM = true, HAS_MID = false;
    bf16_t* RS; const bf16_t* XS;
    __device__ __forceinline__ void operator()(const Acc& acc, const Unit& u, int wr, int wc, int fr, int fq) const {
        vlaunder(fr, fq);
        const int row0 = u.pm * BM + wr * 64 + fr, sl0 = u.pn * 8 + wc;
#pragma unroll
        for (int ai = 0; ai < 2; ++ai) {
            v4u xw[4][2];
#pragma unroll
            for (int m = 0; m < 4; ++m)
#pragma unroll
                for (int bj = 0; bj < 2; ++bj) xw[m][bj] = *(const v4u*)(XS + ((size_t)(sl0 + bj * 4) * T + (row0 + ai * HALF + m * 16)) * 32 + 8 * fq);
#pragma unroll
            for (int m = 0; m < 4; ++m) {
#pragma unroll
                for (int bj = 0; bj < 2; ++bj) { const size_t eo = ((size_t)(sl0 + bj * 4) * T + (row0 + ai * HALF + m * 16)) * 32 + 8 * fq;
                    const f32x4 v0 = acc[ai][bj][m][0], v1 = acc[ai][bj][m][1];
                    const unsigned a0 = xw[m][bj].x, a1 = xw[m][bj].y, a2 = xw[m][bj].z, a3 = xw[m][bj].w;
                    const h2_t x0 = __builtin_bit_cast(h2_t, a0), x1 = __builtin_bit_cast(h2_t, a1), x2 = __builtin_bit_cast(h2_t, a2), x3 = __builtin_bit_cast(h2_t, a3);
                    v4u w; w.x = cvt_pk_f16a(v0[0] + ALPHA * (float)x0.x, v0[1] + ALPHA * (float)x0.y); w.y = cvt_pk_f16a(v0[2] + ALPHA * (float)x1.x, v0[3] + ALPHA * (float)x1.y);
                    w.z = cvt_pk_f16a(v1[0] + ALPHA * (float)x2.x, v1[1] + ALPHA * (float)x2.y); w.w = cvt_pk_f16a(v1[2] + ALPHA * (float)x3.x, v1[3] + ALPHA * (float)x3.y);
                    *(v4u*)(RS + eo) = w; } }
        }
    }
};
struct EpiF16 {
    static constexpr bool PERM = true, HAS_MID = false;
    bf16_t* O; int ldc;
    __device__ __forceinline__ void operator()(const Acc& acc, const Unit& u, int wr, int wc, int fr, int fq) const {
        vlaunder(fr, fq);
        const int row0 = u.pm * BM + wr * 64 + fr, col0 = u.pn * BM + wc * 32 + 8 * fq;
#pragma unroll
        for (int ai = 0; ai < 2; ++ai)
#pragma unroll
            for (int m = 0; m < 4; ++m) { bf16_t* rowp = O + (size_t)(row0 + ai * HALF + m * 16) * ldc + col0;
#pragma unroll
                for (int bj = 0; bj < 2; ++bj) { const f32x4 v0 = acc[ai][bj][m][0], v1 = acc[ai][bj][m][1];
                    v4u w; w.x = cvt_pk_f16a(v0[0], v0[1]); w.y = cvt_pk_f16a(v0[2], v0[3]); w.z = cvt_pk_f16a(v1[0], v1[1]); w.w = cvt_pk_f16a(v1[2], v1[3]);
                    *(v4u*)(rowp + bj * HALF) = w; } }
    }
};
struct EpiSc8 {
    static constexpr bool PERM = true, HAS_MID = false;
    bf16_t* O; const float* SXp; const float* SWp;
    __device__ __forceinline__ void operator()(const Acc& acc, const Unit& u, int wr, int wc, int fr, int fq) const {
        vlaunder(fr, fq);
        const int row0 = u.pm * BM + wr * 64 + fr, col0 = u.pn * BM + wc * 32 + 8 * fq;
        f32x4 sw[2][2]; float sx[2][4];
#pragma unroll
        for (int bj = 0; bj < 2; ++bj) { sw[bj][0] = *(const f32x4*)(SWp + col0 + bj * HALF); sw[bj][1] = *(const f32x4*)(SWp + col0 + bj * HALF + 4); }
#pragma unroll
        for (int ai = 0; ai < 2; ++ai)
#pragma unroll
            for (int m = 0; m < 4; ++m) sx[ai][m] = SXp[row0 + ai * HALF + m * 16];
#pragma unroll
        for (int ai = 0; ai < 2; ++ai)
#pragma unroll
            for (int m = 0; m < 4; ++m) { bf16_t* rowp = O + (size_t)(row0 + ai * HALF + m * 16) * 2048 + col0;
#pragma unroll
                for (int bj = 0; bj < 2; ++bj) { const i32x4 i0 = __builtin_bit_cast(i32x4, acc[ai][bj][m][0]), i1 = __builtin_bit_cast(i32x4, acc[ai][bj][m][1]);
                    const f32x4 v0 = (f32x4){(float)i0[0], (float)i0[1], (float)i0[2], (float)i0[3]} * sx[ai][m] * sw[bj][0], v1 = (f32x4){(float)i1[0], (float)i1[1], (float)i1[2], (float)i1[3]} * sx[ai][m] * sw[bj][1];
                    v4u w; w.x = cvt_pk_bf16(v0[0], v0[1]); w.y = cvt_pk_bf16(v0[2], v0[3]); w.z = cvt_pk_bf16(v1[0], v1[1]); w.w = cvt_pk_bf16(v1[2], v1[3]);
                    *(v4u*)(rowp + bj * HALF) = w; } }
    }
};
struct EpiBf16 {
    static constexpr bool PERM = true, HAS_MID = false;
    bf16_t* O; int ldc;
    __device__ __forceinline__ void operator()(const Acc& acc, const Unit& u, int wr, int wc, int fr, int fq) const {
        vlaunder(fr, fq);
        const int row0 = u.pm * BM + wr * 64 + fr, col0 = u.pn * BM + wc * 32 + 8 * fq;
#pragma unroll
        for (int ai = 0; ai < 2; ++ai)
#pragma unroll
            for (int m = 0; m < 4; ++m) { bf16_t* rowp = O + (size_t)(row0 + ai * HALF + m * 16) * ldc + col0;
#pragma unroll
                for (int bj = 0; bj < 2; ++bj) { const f32x4 v0 = acc[ai][bj][m][0], v1 = acc[ai][bj][m][1];
                    v4u w; w.x = cvt_pk_bf16(v0[0], v0[1]); w.y = cvt_pk_bf16(v0[2], v0[3]); w.z = cvt_pk_bf16(v1[0], v1[1]); w.w = cvt_pk_bf16(v1[2], v1[3]);
                    *(v4u*)(rowp + bj * HALF) = w; } }
    }
};
struct EpiIn {
    static constexpr bool PERM = true, HAS_MID = false;
    bf16_t *Q, *KK, *V, *SG, *UB, *GR, *GB; float* LOGF; const float* lb;
    __device__ __forceinline__ void operator()(const Acc& acc, const Unit& u, int wr, int wc, int fr, int fq) const {
        vlaunder(fr, fq);
        const int row0 = u.pm * BM + wr * 64 + fr;
        const int pn = u.pn;
        if (pn >= 20) {
            const int col0 = (pn - 20) * 128 + wc * 32 + 8 * fq;
#pragma unroll
            for (int ai = 0; ai < 2; ++ai)
#pragma unroll
                for (int m = 0; m < 4; ++m) { const size_t ro = (size_t)(row0 + ai * HALF + m * 16) * 2048 + col0;
                    float rr[8], gg[8];
#pragma unroll
                    for (int n = 0; n < 2; ++n)
#pragma unroll
                        for (int x = 0; x < 4; ++x) { const float za = fminf(fmaxf(acc[ai][0][m][n][x], -30.f), 30.f), zb = fminf(fmaxf(acc[ai][1][m][n][x], -30.f), 30.f);
                            const float ea = fexp(-za), eb = fexp(-zb); gg[n * 4 + x] = frcp(1.f + eb); rr[n * 4 + x] = (1.f + eb) * frcp(1.f + ea); }
                    v4u w; w.x = cvt_pk_bf16(rr[0], rr[1]); w.y = cvt_pk_bf16(rr[2], rr[3]); w.z = cvt_pk_bf16(rr[4], rr[5]); w.w = cvt_pk_bf16(rr[6], rr[7]);
                    *(v4u*)(GR + ro) = w;
                    w.x = cvt_pk_bf16(gg[0], gg[1]); w.y = cvt_pk_bf16(gg[2], gg[3]); w.z = cvt_pk_bf16(gg[4], gg[5]); w.w = cvt_pk_bf16(gg[6], gg[7]);
                    *(v4u*)(GB + ro) = w; }
            return;
        }
        const int sec = pn >> 2, col0 = (pn & 3) * 256 + wc * 32 + 8 * fq;
        if (sec == 1) {
#pragma unroll
            for (int bj = 0; bj < 2; ++bj) {
                const f32x4 l0 = *(const f32x4*)(lb + col0 + bj * HALF), l1 = *(const f32x4*)(lb + col0 + bj * HALF + 4);
#pragma unroll
                for (int ai = 0; ai < 2; ++ai)
#pragma unroll
                    for (int m = 0; m < 4; ++m) { const size_t ro = (size_t)(row0 + ai * HALF + m * 16) * 1024 + col0 + bj * HALF;
                        float lf[8], kk[8];
#pragma unroll
                        for (int n = 0; n < 2; ++n)
#pragma unroll
                            for (int x = 0; x < 4; ++x) { const float z = fminf(fmaxf(acc[ai][bj][m][n][x], -30.f), 30.f); const float lbv = n ? l1[x] : l0[x];
                                const float e = fexp(-z), s = frcp(1.f + e); const float f = lbv + (1.f - lbv) * s;
                                lf[n * 4 + x] = flog(f); kk[n * 4 + x] = (1.f - lbv) * (e * s); }
                        *(f32x4*)(LOGF + ro) = (f32x4){lf[0], lf[1], lf[2], lf[3]}; *(f32x4*)(LOGF + ro + 4) = (f32x4){lf[4], lf[5], lf[6], lf[7]};
                        v4u w; w.x = cvt_pk_bf16(kk[0], kk[1]); w.y = cvt_pk_bf16(kk[2], kk[3]); w.z = cvt_pk_bf16(kk[4], kk[5]); w.w = cvt_pk_bf16(kk[6], kk[7]);
                        *(v4u*)(KK + ro) = w; }
            }
            return;
        }
        bf16_t* dst = sec == 0 ? Q : (sec == 2 ? V : (sec == 3 ? SG : UB));
        const bool sig = (sec == 3);
#pragma unroll
        for (int ai = 0; ai < 2; ++ai)
#pragma unroll
            for (int m = 0; m < 4; ++m) { bf16_t* rowp = dst + (size_t)(row0 + ai * HALF + m * 16) * 1024 + col0;
#pragma unroll
                for (int bj = 0; bj < 2; ++bj) { f32x4 v0 = acc[ai][bj][m][0], v1 = acc[ai][bj][m][1];
                    if (sig) {
#pragma unroll
                        for (int x = 0; x < 4; ++x) { v0[x] = frcp(1.f + fexp(-fminf(fmaxf(v0[x], -30.f), 30.f))); v1[x] = frcp(1.f + fexp(-fminf(fmaxf(v1[x], -30.f), 30.f))); } }
                    v4u w; w.x = cvt_pk_bf16(v0[0], v0[1]); w.y = cvt_pk_bf16(v0[2], v0[3]); w.z = cvt_pk_bf16(v1[0], v1[1]); w.w = cvt_pk_bf16(v1[2], v1[3]);
                    *(v4u*)(rowp + bj * HALF) = w; } }
    }
};
struct EpiGlu {
    static constexpr bool PERM = true, HAS_MID = false;
    bf16_t* O; int ldc;
    __device__ __forceinline__ void operator()(const Acc& acc, const Unit& u, int wr, int wc, int fr, int fq) const {
        vlaunder(fr, fq);
        const int row0 = u.pm * BM + wr * 64 + fr, col0 = u.pn * 128 + wc * 32 + 8 * fq;
#pragma unroll
        for (int ai = 0; ai < 2; ++ai)
#pragma unroll
            for (int m = 0; m < 4; ++m) { float o[8];
#pragma unroll
                for (int n = 0; n < 2; ++n)
#pragma unroll
                    for (int x = 0; x < 4; ++x) { const float h2 = fminf(fmaxf(acc[ai][1][m][n][x], -30.f), 30.f); o[n * 4 + x] = acc[ai][0][m][n][x] * frcp(1.f + fexp(-h2)); }
                v4u w; w.x = cvt_pk_bf16(o[0], o[1]); w.y = cvt_pk_bf16(o[2], o[3]); w.z = cvt_pk_bf16(o[4], o[5]); w.w = cvt_pk_bf16(o[6], o[7]);
                *(v4u*)(O + (size_t)(row0 + ai * HALF + m * 16) * ldc + col0) = w; }
    }
};
struct EpiUp {
    static constexpr bool PERM = true, HAS_MID = true;
    bf16_t* O; const bf16_t *GR, *GB;
    __device__ __forceinline__ void scale(Acc& acc, const bf16_t* G, const Unit& u, int wr, int wc, int fr, int fq) const {
        vlaunder(fr, fq);
        const int row0 = u.pm * BM + wr * 64 + fr, col0 = u.pn * BM + wc * 32 + 8 * fq;
#pragma unroll
        for (int ai = 0; ai < 2; ++ai) {
            v4u gw[4][2];
#pragma unroll
            for (int m = 0; m < 4; ++m)
#pragma unroll
                for (int bj = 0; bj < 2; ++bj) gw[m][bj] = *(const v4u*)(G + (size_t)(row0 + ai * HALF + m * 16) * 2048 + col0 + bj * HALF);
            __builtin_amdgcn_sched_barrier(0);
#pragma unroll
            for (int m = 0; m < 4; ++m) {
#pragma unroll
                for (int bj = 0; bj < 2; ++bj) { const v4u w = gw[m][bj];
                    acc[ai][bj][m][0] *= (f32x4){bf_lo(w.x), bf_hi(w.x), bf_lo(w.y), bf_hi(w.y)};
                    acc[ai][bj][m][1] *= (f32x4){bf_lo(w.z), bf_hi(w.z), bf_lo(w.w), bf_hi(w.w)}; } }
            __builtin_amdgcn_sched_barrier(0); }
    }
    __device__ __forceinline__ void mid(Acc& acc, const Unit& u, int wr, int wc, int fr, int fq) const { scale(acc, GR, u, wr, wc, fr, fq); }
    __device__ __forceinline__ void operator()(Acc& acc, const Unit& u, int wr, int wc, int fr, int fq) const {
        scale(acc, GB, u, wr, wc, fr, fq);
        const int row0 = u.pm * BM + wr * 64 + fr, col0 = u.pn * BM + wc * 32 + 8 * fq;
#pragma unroll
        for (int ai = 0; ai < 2; ++ai)
#pragma unroll
            for (int m = 0; m < 4; ++m) { bf16_t* rowp = O + (size_t)(row0 + ai * HALF + m * 16) * 2048 + col0;
#pragma unroll
                for (int bj = 0; bj < 2; ++bj) { const f32x4 v0 = acc[ai][bj][m][0], v1 = acc[ai][bj][m][1];
                    v4u w; w.x = cvt_pk_bf16(v0[0], v0[1]); w.y = cvt_pk_bf16(v0[2], v0[3]); w.z = cvt_pk_bf16(v1[0], v1[1]); w.w = cvt_pk_bf16(v1[2], v1[3]);
                    *(v4u*)(rowp + bj * HALF) = w; } }
    }
};
}

#define XB_TMO      128
#define XB_XCNT(j)  (256  + 64 * (j))
#define XB_XSUB(j)  (1280 + 64 * (j))
#define XB_XGEN(j)  (2304 + 64 * (j))
#define XB_TOP      3328
#define XB_TOPGEN   3392
#define XCD_BAR_WORDS 3456
#define XB_SPIN_CAP (1u << 20)

__device__ __forceinline__ unsigned xb_ld(unsigned* p)              { return __hip_atomic_load(p, __ATOMIC_RELAXED, __HIP_MEMORY_SCOPE_AGENT); }
__device__ __forceinline__ unsigned xb_add(unsigned* p, unsigned v) { return __hip_atomic_fetch_add(p, v, __ATOMIC_RELAXED, __HIP_MEMORY_SCOPE_AGENT); }
__device__ __forceinline__ unsigned xb_xcc_id() { return (unsigned)__builtin_amdgcn_s_getreg((3 << 11) | 20) & 0xFu; }
#define XB_SPIN(cond, bar) do { unsigned _sp = 0; while (cond) { __builtin_amdgcn_s_sleep(1); \
    if ((++_sp & 255u) == 0u) { if (xb_ld(&(bar)[XB_TMO])) break; if (_sp > XB_SPIN_CAP) { atomicAdd(&(bar)[XB_TMO], 1u); break; } } } } while (0)

struct XcdBarrier { unsigned* bar; unsigned x; volatile LAS unsigned* st; };

__device__ __forceinline__ XcdBarrier xcd_barrier_post(unsigned* bar, volatile LAS unsigned* st, bool leader) {
    XcdBarrier b; b.bar = bar; b.x = xb_xcc_id(); b.st = st;
    if (leader) (void)xb_add(&bar[XB_XCNT(b.x)], 1u);
    return b;
}
__device__ __forceinline__ void xcd_barrier_complete(unsigned* bar, unsigned x, unsigned& nloc, unsigned& nx) {
    const unsigned G = gridDim.x * gridDim.y * gridDim.z;
    unsigned sum, cnt, mine, sp = 0u;
    for (;;) {
        sum = 0u; cnt = 0u; mine = 0u;
#pragma unroll
        for (unsigned j = 0; j < 16; ++j) { const unsigned c = xb_ld(&bar[XB_XCNT(j)]); sum += c; cnt += (c > 0u) ? 1u : 0u; mine = (j == x) ? c : mine; }
        if (sum == G) break;
        __builtin_amdgcn_s_sleep(1);
        if ((++sp & 255u) == 0u) { if (xb_ld(&bar[XB_TMO])) break; if (sp > XB_SPIN_CAP) { atomicAdd(&bar[XB_TMO], 1u); break; } }
    }
    nloc = mine > 0u ? mine : 1u; nx = cnt > 0u ? cnt : 1u;
}
__device__ __forceinline__ void xcd_barrier(const XcdBarrier& b, int wv) {
    asm volatile("s_waitcnt vmcnt(0)" ::: "memory");
    __syncthreads();
    if (wv == 0 && lane_id() == 0) {
        unsigned* bar = b.bar;
        __builtin_amdgcn_s_waitcnt(0);
        unsigned nloc = b.st[0], nx = b.st[1];
        if (nloc == 0u) { xcd_barrier_complete(bar, b.x, nloc, nx); b.st[0] = nloc; b.st[1] = nx; }
        const unsigned old = xb_add(&bar[XB_XSUB(b.x)], 1u);
        const unsigned gen = old / nloc;
        if (old + 1u == (gen + 1u) * nloc) {
            __builtin_amdgcn_fence(__ATOMIC_RELEASE, "agent");
            asm volatile("s_waitcnt vmcnt(0)" ::: "memory");
            const unsigned og = xb_add(&bar[XB_TOP], 1u);
            const unsigned tg = og / nx;
            if (og + 1u == (tg + 1u) * nx) xb_add(&bar[XB_TOPGEN], 1u);
            else XB_SPIN(xb_ld(&bar[XB_TOPGEN]) == tg, bar);
            __builtin_amdgcn_fence(__ATOMIC_ACQUIRE, "agent");
            xb_add(&bar[XB_XGEN(b.x)], 1u);
            asm volatile("s_waitcnt vmcnt(0)" ::: "memory");
        } else {
            XB_SPIN(xb_ld(&bar[XB_XGEN(b.x)]) == gen, bar);
            __builtin_amdgcn_fence(__ATOMIC_ACQUIRE, "agent");
            asm volatile("s_waitcnt vmcnt(0)" ::: "memory");
        }
    }
    __syncthreads();
}

struct Args { const float* in[24]; float* out; unsigned char* ws; int ph_lo, ph_hi; };
struct Frame {
    LAS unsigned char* lds;
    int tid, lane, wave, vcu, G;
    unsigned char* ws;
    const __attribute__((address_space(4))) Args* ka;
};
enum { I_X = 0, I_WIN, I_LBL, I_NG, I_LRE, I_LIM, I_LSTEP, I_BRE, I_BIM, I_CRE, I_CIM, I_SD, I_WGLU, I_WUPA, I_WUPB, I_WO, I_LN1G, I_LN1B, I_PWQ, I_PKEYS, I_PU, I_PV, I_LN2G, I_LN2B };

__device__ __forceinline__ void p0_transpose_item(const float* W, int N, bf16* WT, int dpitch, int dst_koff, int dst_row0, LAS float* scr, int k0, int n0, int lane, bool h = false) {
    { const int kr = lane >> 3, c4 = (lane & 7) * 4; f32x4 v[8];
#pragma unroll
      for (int i = 0; i < 8; ++i) v[i] = __builtin_nontemporal_load((const f32x4*)(W + (size_t)(k0 + kr + 8 * i) * N + n0 + c4));
#pragma unroll
      for (int i = 0; i < 8; ++i) { LAS float* d = scr + (kr + 8 * i) * 33 + c4; d[0] = v[i][0]; d[1] = v[i][1]; d[2] = v[i][2]; d[3] = v[i][3]; } }
    LDS_WAIT(); asm volatile("" ::: "memory");
    const int c = lane & 7;
#pragma unroll
    for (int j = 0; j < 4; ++j) { const int n = (lane >> 3) + 8 * j; const LAS float* s = scr + (8 * c) * 33 + n;
        v4u o;
        if (h) { o.x = cvt_pk_f16(s[0 * 33], s[1 * 33]); o.y = cvt_pk_f16(s[2 * 33], s[3 * 33]); o.z = cvt_pk_f16(s[4 * 33], s[5 * 33]); o.w = cvt_pk_f16(s[6 * 33], s[7 * 33]); }
        else { o.x = cvt_pk_bf16(s[0 * 33], s[1 * 33]); o.y = cvt_pk_bf16(s[2 * 33], s[3 * 33]); o.z = cvt_pk_bf16(s[4 * 33], s[5 * 33]); o.w = cvt_pk_bf16(s[6 * 33], s[7 * 33]); }
        *(v4u*)(WT + (size_t)(dst_row0 + n) * dpitch + dst_koff + k0 + 8 * c) = o; }
    LDS_WAIT(); asm volatile("" ::: "memory");
}
__device__ __forceinline__ void sincos_d(double a, double& s, double& c) {
    const double k = __builtin_rint(a * 0.63661977236758134308);
    double r = __builtin_fma(-k, 1.57079632679489655800e+00, a); r = __builtin_fma(-k, 6.12323399573676603587e-17, r);
    const double r2 = r * r;
    double sp = 1.0 / 1307674368000.0; sp = sp * r2 - 1.0 / 6227020800.0; sp = sp * r2 + 1.0 / 39916800.0; sp = sp * r2 - 1.0 / 362880.0; sp = sp * r2 + 1.0 / 5040.0; sp = sp * r2 - 1.0 / 120.0; sp = sp * r2 + 1.0 / 6.0;
    const double sr = r - r * r2 * sp;
    double cp = 1.0 / 20922789888000.0; cp = cp * r2 - 1.0 / 87178291200.0; cp = cp * r2 + 1.0 / 479001600.0; cp = cp * r2 - 1.0 / 3628800.0; cp = cp * r2 + 1.0 / 40320.0; cp = cp * r2 - 1.0 / 720.0; cp = cp * r2 + 1.0 / 24.0;
    const double cr = 1.0 - 0.5 * r2 + r2 * r2 * cp;
    const int q = ((int)k) & 3;
    s = (q == 0) ? sr : (q == 1) ? cr : (q == 2) ? -sr : -cr;
    c = (q == 0) ? cr : (q == 1) ? -sr : (q == 2) ? -cr : sr;
}
__device__ __forceinline__ double exp_d(double x) {
    const double k = __builtin_rint(x * 1.44269504088896340736);
    const double r = __builtin_fma(-k, 6.93147180369123816490e-01, x) - k * 1.90821492927058770002e-10;
    double p = 1.0 / 6227020800.0;
    p = p * r + 1.0 / 479001600.0; p = p * r + 1.0 / 39916800.0; p = p * r + 1.0 / 3628800.0; p = p * r + 1.0 / 362880.0; p = p * r + 1.0 / 40320.0; p = p * r + 1.0 / 5040.0;
    p = p * r + 1.0 / 720.0; p = p * r + 1.0 / 120.0; p = p * r + 1.0 / 24.0; p = p * r + 1.0 / 6.0; p = p * r + 0.5; p = p * r + 1.0; p = p * r + 1.0;
    const long long e = (long long)k + 1023; double sc = __builtin_bit_cast(double, (unsigned long long)(e << 52));
    return p * sc;
}

__device__ __forceinline__ void phase_prologue_a(const Frame& F0) {
    Frame F = F0; F.tid = F.wave * 64 + lane_id(); asm volatile("" : "+v"(F.tid)); F.lane = F.tid & 63;
    unsigned char* ws = opqg(F.ws); const __attribute__((address_space(4))) Args* a = opq(F.ka);
    LAS float* scr = (LAS float*)(F.lds + F.wave * 16384);
    const int gw = F.vcu * 8 + F.wave, NGW = F.G * 8;
    constexpr int I_IN = 32 * 288, I_GLU = 16 * 64, I_UP = 16 * 64, I_O = 32 * 64, I_L = I_IN + I_GLU + 2 * I_UP + I_O;
    for (int it = gw; it < DEPTH * I_L; it += NGW) {
        const int l = it / I_L; int r = it % I_L;
        if (r < I_IN) { const int kb = r / 288, nb = r % 288, n0 = nb * 32; int dr;
            if (n0 < 5120) dr = n0; else if (n0 < 7168) { const int j = n0 - 5120; dr = 5120 + (j >> 7) * 256 + (j & 127); } else { const int j = n0 - 7168; dr = 5120 + (j >> 7) * 256 + 128 + (j & 127); }
            p0_transpose_item(GP(const float, a->in[I_WIN]) + (size_t)l * D * NIN, NIN, (bf16*)(ws + WS_WIN) + (size_t)l * NIN * D, D, 0, dr, scr, kb * 64, n0, F.lane, true); continue; }
        r -= I_IN;
        if (r < I_GLU) { const int kb = r / 64, nb = r % 64, n0 = nb * 32; int dr;
            if (n0 < 1024) dr = (n0 >> 7) * 256 + (n0 & 127); else { const int j = n0 - 1024; dr = (j >> 7) * 256 + 128 + (j & 127); }
            p0_transpose_item(GP(const float, a->in[I_WGLU]) + (size_t)l * 1024 * 2048, 2048, (bf16*)(ws + WS_WGLU) + (size_t)l * 2048 * 1024, 1024, 0, dr, scr, kb * 64, n0, F.lane); continue; }
        r -= I_GLU;
        if (r < I_UP) { const int kb = r / 64, nb = r % 64;
            p0_transpose_item(GP(const float, a->in[I_WUPA]) + (size_t)l * 1024 * 2048, 2048, (bf16*)(ws + WS_WUP) + (size_t)l * 2048 * 2048, 2048, 0, nb * 32, scr, kb * 64, nb * 32, F.lane); continue; }
        r -= I_UP;
        if (r < I_UP) { const int kb = r / 64, nb = r % 64;
            p0_transpose_item(GP(const float, a->in[I_WUPB]) + (size_t)l * 1024 * 2048, 2048, (bf16*)(ws + WS_WUP) + (size_t)l * 2048 * 2048, 2048, 1024, nb * 32, scr, kb * 64, nb * 32, F.lane); continue; }
        r -= I_UP;
        { const int kb = r / 64, nb = r % 64;
            p0_transpose_item(GP(const float, a->in[I_WO]) + (size_t)l * 2048 * 2048, 2048, (bf16*)(ws + WS_WO) + (size_t)l * 2048 * 2048, 2048, 0, nb * 32, scr, kb * 64, nb * 32, F.lane); }
    }
    const size_t gt = (size_t)F.vcu * 512 + F.tid, NT = (size_t)F.G * 512;
    { const float* src = GP(const float, a->in[I_PWQ]); bf16* dst = (bf16*)(ws + WS_WQB);
      const size_t N_ = (size_t)DEPTH * D * D / 8; size_t i = gt;
      for (; i + 3 * NT < N_; i += 4 * NT) { f32x4 va[4], vb[4];
#pragma unroll
          for (int k = 0; k < 4; ++k) { va[k] = *(const f32x4*)(src + (i + k * NT) * 8); vb[k] = *(const f32x4*)(src + (i + k * NT) * 8 + 4); }
#pragma unroll
          for (int k = 0; k < 4; ++k) { v4u w; w.x = cvt_pk_bf16(va[k][0], va[k][1]); w.y = cvt_pk_bf16(va[k][2], va[k][3]); w.z = cvt_pk_bf16(vb[k][0], vb[k][1]); w.w = cvt_pk_bf16(vb[k][2], vb[k][3]); *(v4u*)(dst + (i + k * NT) * 8) = w; } }
      for (; i < N_; i += NT) { const f32x4 v0 = *(const f32x4*)(src + i * 8), v1 = *(const f32x4*)(src + i * 8 + 4);
          v4u w; w.x = cvt_pk_bf16(v0[0], v0[1]); w.y = cvt_pk_bf16(v0[2], v0[3]); w.z = cvt_pk_bf16(v1[0], v1[1]); w.w = cvt_pk_bf16(v1[2], v1[3]); *(v4u*)(dst + i * 8) = w; } }
    { const float* src = GP(const float, a->in[I_X]); bf16* dst = (bf16*)(ws + WS_XH);
      const size_t N_ = (size_t)T * D / 8; size_t i = gt;
#define XSRC(ii) (src + (size_t)(int)(((ii) >> 2) & (T - 1)) * D + (int)((ii) >> 15) * 32 + (int)((ii) & 3) * 8)
      for (; i + 3 * NT < N_; i += 4 * NT) { f32x4 va[4], vb[4];
#pragma unroll
          for (int k = 0; k < 4; ++k) { const float* sp = XSRC(i + k * NT); va[k] = *(const f32x4*)sp; vb[k] = *(const f32x4*)(sp + 4); }
#pragma unroll
          for (int k = 0; k < 4; ++k) { v4u w; w.x = cvt_pk_f16(va[k][0], va[k][1]); w.y = cvt_pk_f16(va[k][2], va[k][3]); w.z = cvt_pk_f16(vb[k][0], vb[k][1]); w.w = cvt_pk_f16(vb[k][2], vb[k][3]); *(v4u*)(dst + (i + k * NT) * 8) = w; } }
      for (; i < N_; i += NT) { const float* sp = XSRC(i); const f32x4 v0 = *(const f32x4*)sp, v1 = *(const f32x4*)(sp + 4);
          v4u w; w.x = cvt_pk_f16(v0[0], v0[1]); w.y = cvt_pk_f16(v0[2], v0[3]); w.z = cvt_pk_f16(v1[0], v1[1]); w.w = cvt_pk_f16(v1[2], v1[3]); *(v4u*)(dst + i * 8) = w; }
#undef XSRC
    }
    { const float* keys = GP(const float, a->in[I_PKEYS]); bf16* dst = (bf16*)(ws + WS_BK);
      for (size_t i = gt; i < (size_t)DEPTH * 8 * 256 * 256 / 8; i += NT) { const int jj = (int)(i & 31) * 8; const int row = (int)((i >> 5) & 255); const size_t lh = i >> 13; const int half = row >> 7, n = row & 127;
          v4u w = (v4u){0u, 0u, 0u, 0u};
          if ((jj >> 7) == half) { const float* s = keys + ((lh * 2 + half) * 128 + n) * 128 + (jj & 127); const f32x4 v0 = *(const f32x4*)s, v1 = *(const f32x4*)(s + 4);
              w.x = cvt_pk_bf16(v0[0], v0[1]); w.y = cvt_pk_bf16(v0[2], v0[3]); w.z = cvt_pk_bf16(v1[0], v1[1]); w.w = cvt_pk_bf16(v1[2], v1[3]); }
          *(v4u*)(dst + i * 8) = w; } }
    if (gt < 1024) { const float* lg = GP(const float, a->in[I_LBL]); float* lbo = (float*)(ws + WS_LB); const int d = (int)gt;
        const float z0 = lg[d], z1 = lg[1024 + d], z2 = lg[2048 + d], z3 = lg[3072 + d]; const float mx = fmaxf(fmaxf(z0, z1), fmaxf(z2, z3));
        const float e0 = expf(z0 - mx), e1 = expf(z1 - mx), e2 = expf(z2 - mx), e3 = expf(z3 - mx); const float inv = 1.f / (e0 + e1 + e2 + e3);
        lbo[d] = 0.f; lbo[1024 + d] = e1 * inv; lbo[2048 + d] = (e1 + e2) * inv; lbo[3072 + d] = (e1 + e2 + e3) * inv; }
    for (size_t i = gt; i < (size_t)DEPTH * 64 * 64; i += NT) {
        const size_t lg_ = i >> 6;
        const double lr = fmin((double)GP(const float, a->in[I_LRE])[i], -1e-4), li = (double)GP(const float, a->in[I_LIM])[i], dt = exp_d((double)GP(const float, a->in[I_LSTEP])[lg_]);
        const double mag = exp_d(lr * dt); double sn, cs; sincos_d(li * dt, sn, cs);
        const double ar = mag * cs, ai = mag * sn, den = lr * lr + li * li, nr = ar - 1.0;
        const double zr = (nr * lr + ai * li) / den, zi = (ai * lr - nr * li) / den;
        const float* br = GP(const float, a->in[I_BRE]) + i * 16; const float* bi = GP(const float, a->in[I_BIM]) + i * 16; float* bb = (float*)(ws + WS_BB) + i * 32;
        f32x4 brv[4], biv[4];
#pragma unroll
        for (int m4 = 0; m4 < 4; ++m4) { brv[m4] = ((const f32x4*)br)[m4]; biv[m4] = ((const f32x4*)bi)[m4]; }
#pragma unroll
        for (int m4 = 0; m4 < 4; ++m4) { float o8[8];
#pragma unroll
            for (int x = 0; x < 4; ++x) { const double b_r = brv[m4][x], b_i = biv[m4][x]; o8[2 * x] = (float)(zr * b_r - zi * b_i); o8[2 * x + 1] = (float)(zr * b_i + zi * b_r); }
            ((f32x4*)bb)[2 * m4] = (f32x4){o8[0], o8[1], o8[2], o8[3]}; ((f32x4*)bb)[2 * m4 + 1] = (f32x4){o8[4], o8[5], o8[6], o8[7]}; }
        float* ap = (float*)(ws + WS_APOW) + (lg_ * 65 * 64 + (i & 63)) * 2; double pr = 1.0, pi = 0.0;
        for (int dl = 0; dl < 65; ++dl) { ap[dl * 128] = (float)pr; ap[dl * 128 + 1] = (float)pi; const double t = pr * ar - pi * ai; pi = pr * ai + pi * ar; pr = t; }
    }
    for (int it = gw; it < DEPTH * 1024; it += NGW) {
        const int l = it >> 10, eb = it & 1023;
        const int pe = eb * 16 + (F.lane >> 2), i1 = (pe & 1023) >> 3, i2 = (pe & 7) * 16 + (((pe >> 10) - i1) & 15);
        const float* src = GP(const float, a->in[I_PV]) + ((size_t)l * NEXP + i1 * 128 + i2) * D + (F.lane & 3) * 8;
        bf16* dst = (bf16*)(ws + WS_TBV) + (size_t)l * 64 * NEXP * 32 + ((size_t)(eb * 16 + (F.lane >> 2)) * 4 + ((F.lane & 3) ^ ((F.lane >> 4) & 3))) * 8;
#pragma unroll 1
        for (int k8 = 0; k8 < 64; k8 += 8) { f32x4 va[8], vb[8];
#pragma unroll
            for (int k = 0; k < 8; ++k) { va[k] = __builtin_nontemporal_load((const f32x4*)(src + (k8 + k) * 32)); vb[k] = __builtin_nontemporal_load((const f32x4*)(src + (k8 + k) * 32 + 4)); }
#pragma unroll
            for (int k = 0; k < 8; ++k) { v4u w; w.x = cvt_pk_f16(va[k][0], va[k][1]); w.y = cvt_pk_f16(va[k][2], va[k][3]); w.z = cvt_pk_f16(vb[k][0], vb[k][1]); w.w = cvt_pk_f16(vb[k][2], vb[k][3]);
                *(v4u*)(dst + (size_t)(k8 + k) * NEXP * 32) = w; } }
    }
    for (int it = gw; it < DEPTH * 4096; it += NGW) {
        const int l = it >> 12, q4 = it & 4095, c = F.lane & 15;
        const int pe = q4 * 4 + (F.lane >> 4), i1 = (pe & 1023) >> 3, i2 = (pe & 7) * 16 + (((pe >> 10) - i1) & 15);
        const float* src = GP(const float, a->in[I_PU]) + ((size_t)l * NEXP + i1 * 128 + i2) * D + c * 4;
        unsigned hv[64]; float m = 0.f;
#pragma unroll
        for (int i = 0; i < 32; ++i) { const f32x4 v = __builtin_nontemporal_load((const f32x4*)(src + i * 64));
            m = fmaxf(fmaxf(m, fmaxf(fabsf(v[0]), fabsf(v[1]))), fmaxf(fabsf(v[2]), fabsf(v[3])));
            hv[2 * i] = cvt_pk_f16(v[0], v[1]); hv[2 * i + 1] = cvt_pk_f16(v[2], v[3]); }
        m = fmaxf(m, __shfl_xor(m, 1)); m = fmaxf(m, __shfl_xor(m, 2)); m = fmaxf(m, __shfl_xor(m, 4)); m = fmaxf(m, __shfl_xor(m, 8));
        const float sc = (m > 0.f) ? m * (1.f / 127.f) : 1.f, inv = (m > 0.f) ? 127.f / m : 0.f;
        if (c == 0) ((float*)(ws + WS_SU))[(size_t)l * NEXP + pe] = sc;
        unsigned char* dst = ws + WS_TBU + (size_t)l * 32 * NEXP * 64 + (size_t)pe * 64 + (((c >> 2) ^ ((pe >> 2) & 3)) * 16 + (c & 3) * 4);
#pragma unroll
        for (int i = 0; i < 32; ++i) { const h2_t p0 = __builtin_bit_cast(h2_t, hv[2 * i]), p1 = __builtin_bit_cast(h2_t, hv[2 * i + 1]);
            const int q0 = (int)__builtin_rintf((float)p0.x * inv), q1 = (int)__builtin_rintf((float)p0.y * inv), q2 = (int)__builtin_rintf((float)p1.x * inv), q3 = (int)__builtin_rintf((float)p1.y * inv);
            *(unsigned*)(dst + (size_t)i * NEXP * 64) = (unsigned)(q0 & 255) | ((unsigned)(q1 & 255) << 8) | ((unsigned)(q2 & 255) << 16) | ((unsigned)q3 << 24); }
    }
}
__device__ __forceinline__ double dummy_unused_(double x) { return x; }

__device__ __forceinline__ void phase_prologue_b(const Frame& F0) {
    Frame F = F0; F.tid = F.wave * 64 + lane_id(); asm volatile("" : "+v"(F.tid)); F.lane = F.tid & 63;
    unsigned char* ws = opqg(F.ws); const __attribute__((address_space(4))) Args* a = opq(F.ka);
    const float* APOW = (const float*)(ws + WS_APOW); const float* BB = (const float*)(ws + WS_BB);
    LAS float* AP = (LAS float*)(F.lds); LAS float* BL = (LAS float*)(F.lds + 33280); LAS float* CR = (LAS float*)(F.lds + 41472); LAS float* CI = (LAS float*)(F.lds + 45568); LAS float* SDL = (LAS float*)(F.lds + 49664);
    bf16* KM = (bf16*)(ws + WS_KMAT); bf16* PM = (bf16*)(ws + WS_PM); bf16* E = (bf16*)(ws + WS_E);
    for (int lg = F.vcu; lg < DEPTH * 64; lg += F.G) {
        for (int i = F.tid; i < 65 * 64 * 2 / 4; i += 512) ((LAS f32x4*)AP)[i] = ((const f32x4*)(APOW + (size_t)lg * 65 * 128))[i];
        ((LAS f32x4*)BL)[F.tid] = ((const f32x4*)(BB + (size_t)lg * 2048))[F.tid];
        if (F.tid < 256) ((LAS f32x4*)CR)[F.tid] = ((const f32x4*)(GP(const float, a->in[I_CRE]) + (size_t)lg * 1024))[F.tid];
        else ((LAS f32x4*)CI)[F.tid - 256] = ((const f32x4*)(GP(const float, a->in[I_CIM]) + (size_t)lg * 1024))[F.tid - 256];
        if (F.tid < 16) SDL[F.tid] = GP(const float, a->in[I_SD])[lg * 16 + F.tid];
        __syncthreads();
        for (int task = F.tid; task < 65 * 16; task += 512) {
            const int n = task & 15, idx = task >> 4;
            float sm[16];
#pragma unroll
            for (int m = 0; m < 16; ++m) sm[m] = 0.f;
            if (idx > 0) { const int dl = idx - 1;
#pragma unroll 4
                for (int p = 0; p < 64; ++p) { const f32x2 av = *(const LAS f32x2*)(AP + (dl * 64 + p) * 2); const float c_r = CR[n * 64 + p], c_i = CI[n * 64 + p];
                    const float car = c_r * av[0] - c_i * av[1], cai = c_r * av[1] + c_i * av[0];
#pragma unroll
                    for (int q = 0; q < 8; ++q) { const f32x4 b4 = *(const LAS f32x4*)(BL + p * 32 + q * 4); sm[2 * q] += car * b4[0] - cai * b4[1]; sm[2 * q + 1] += car * b4[2] - cai * b4[3]; } }
                if (dl == 0) { const float dv = SDL[n];
#pragma unroll
                    for (int m = 0; m < 16; ++m) sm[m] += (m == n) ? dv : 0.f; } }
            v4u w0, w1; w0.x = cvt_pk_bf16(sm[0], sm[1]); w0.y = cvt_pk_bf16(sm[2], sm[3]); w0.z = cvt_pk_bf16(sm[4], sm[5]); w0.w = cvt_pk_bf16(sm[6], sm[7]);
            w1.x = cvt_pk_bf16(sm[8], sm[9]); w1.y = cvt_pk_bf16(sm[10], sm[11]); w1.z = cvt_pk_bf16(sm[12], sm[13]); w1.w = cvt_pk_bf16(sm[14], sm[15]);
            bf16* kp = KM + ((size_t)lg * 65 * 16 + task) * 16; *(v4u*)kp = w0; *(v4u*)(kp + 8) = w1; }
        for (int it = F.tid; it < 128 * 64 * 2; it += 512) {
            const int m0 = (it & 1) * 8, sidx = (it >> 1) & 63, pp = it >> 7, p = pp & 63;
            const f32x2 av = *(const LAS f32x2*)(AP + ((63 - sidx) * 64 + p) * 2); const float pr = av[0], pi = av[1];
            float o[8];
#pragma unroll
            for (int j = 0; j < 4; ++j) { const f32x4 b4 = *(const LAS f32x4*)(BL + p * 32 + m0 * 2 + j * 4);
                o[2 * j] = (pp < 64) ? (pr * b4[0] - pi * b4[1]) : (pr * b4[1] + pi * b4[0]); o[2 * j + 1] = (pp < 64) ? (pr * b4[2] - pi * b4[3]) : (pr * b4[3] + pi * b4[2]); }
            v4u w; w.x = cvt_pk_bf16(o[0], o[1]); w.y = cvt_pk_bf16(o[2], o[3]); w.z = cvt_pk_bf16(o[4], o[5]); w.w = cvt_pk_bf16(o[6], o[7]); *(v4u*)(PM + ((size_t)lg * 16384 + it) * 8) = w; }
        for (int it = F.tid; it < 1024 * 16; it += 512) {
            const int pp0 = (it & 15) * 8, n = (it >> 4) & 15, tau = it >> 8, p0 = pp0 & 63;
            float o[8];
#pragma unroll
            for (int j = 0; j < 8; ++j) { const f32x2 av = *(const LAS f32x2*)(AP + ((tau + 1) * 64 + p0 + j) * 2); const float c_r = CR[n * 64 + p0 + j], c_i = CI[n * 64 + p0 + j];
                o[j] = (pp0 < 64) ? (c_r * av[0] - c_i * av[1]) : -(c_r * av[1] + c_i * av[0]); }
            v4u w; w.x = cvt_pk_bf16(o[0], o[1]); w.y = cvt_pk_bf16(o[2], o[3]); w.z = cvt_pk_bf16(o[4], o[5]); w.w = cvt_pk_bf16(o[6], o[7]); *(v4u*)(E + ((size_t)lg * 16384 + it) * 8) = w; }
        __syncthreads();
    }
}
__device__ __forceinline__ void phase_quant_wpq(const Frame& F0) {
    Frame F = F0; F.tid = F.wave * 64 + lane_id(); asm volatile("" : "+v"(F.tid)); F.lane = F.tid & 63;
    unsigned char* ws = opqg(F.ws);
    const bf16* WPQ = (const bf16*)(ws + WS_WPQ); unsigned char* W8 = ws + WS_WP8; float* SW = (float*)(ws + WS_SW);
    for (int row = F.vcu * 8 + F.wave; row < DEPTH * 2048; row += F.G * 8) {
        v4u w[4]; float vf[32]; float m = 0.f;
#pragma unroll
        for (int k = 0; k < 4; ++k) w[k] = *(const v4u*)(WPQ + (size_t)row * 2048 + (k * 64 + F.lane) * 8);
#pragma unroll
        for (int k = 0; k < 4; ++k) { const unsigned ww[4] = {w[k].x, w[k].y, w[k].z, w[k].w};
#pragma unroll
            for (int x = 0; x < 4; ++x) { const h2_t hv = __builtin_bit_cast(h2_t, ww[x]); vf[8 * k + 2 * x] = (float)hv.x; vf[8 * k + 2 * x + 1] = (float)hv.y; m = fmaxf(m, fmaxf(fabsf((float)hv.x), fabsf((float)hv.y))); } }
#pragma unroll
        for (int o = 1; o < 64; o <<= 1) m = fmaxf(m, __shfl_xor(m, o));
        const float inv = (m > 0.f) ? 127.f / m : 0.f;
        if (F.lane == 0) SW[row] = (m > 0.f) ? m * (1.f / 127.f) : 1.f;
#pragma unroll
        for (int k = 0; k < 4; ++k) { int q[8];
#pragma unroll
            for (int x = 0; x < 8; ++x) q[x] = (int)__builtin_rintf(vf[8 * k + x] * inv);
            v2u o; o.x = (unsigned)(q[0] & 255) | ((unsigned)(q[1] & 255) << 8) | ((unsigned)(q[2] & 255) << 16) | ((unsigned)q[3] << 24);
            o.y = (unsigned)(q[4] & 255) | ((unsigned)(q[5] & 255) << 8) | ((unsigned)(q[6] & 255) << 16) | ((unsigned)q[7] << 24);
            *(v2u*)(W8 + (size_t)row * 2048 + (k * 64 + F.lane) * 8) = o; }
    }
}
constexpr int HG_BL = 0, HG_TOT = 33792, HG_VT = 35840, HG_KT = 54272, HG_RED = 72704;
constexpr int KSP = 136, HG_KS = 73728, HG_QT = HG_KS + 64 * KSP * 2, HG_QH = HG_QT + 64 * KSP * 2;
static_assert(HG_QH + 64 * KSP * 2 <= RING_BYTES, "hgrn_out LDS map");
constexpr int BLP = 132, VTP = 72;
__device__ __forceinline__ void hg_cumsum(const Frame& F, const float* LOGF, int c, int h) {
    LAS float* bL = (LAS float*)(F.lds + HG_BL); LAS float* tot = (LAS float*)(F.lds + HG_TOT);
    const int d = F.tid & 127, seg = F.tid >> 7;
    const float* src = LOGF + (size_t)(c * 64 + seg * 16) * AW + h * 128 + d;
    float lf[16];
#pragma unroll
    for (int i = 0; i < 16; ++i) lf[i] = src[(size_t)i * AW];
#pragma unroll
    for (int i = 1; i < 16; ++i) lf[i] += lf[i - 1];
    tot[seg * 128 + d] = lf[15];
    __syncthreads();
    float off = 0.f;
#pragma unroll
    for (int s2 = 0; s2 < 3; ++s2) off += (s2 < seg) ? tot[s2 * 128 + d] : 0.f;
#pragma unroll
    for (int i = 0; i < 16; ++i) bL[(seg * 16 + i) * BLP + d] = lf[i] + off;
}
__device__ __forceinline__ void hg_load_vt(const Frame& F, const bf16* V, int c, int h) {
    LAS bf16* VT = (LAS bf16*)(F.lds + HG_VT);
    const int s = F.lane, vb = F.wave * 16;
    const v4u* src = (const v4u*)(V + (size_t)(c * 64 + s) * AW + h * 128 + vb);
    const v4u w0 = src[0], w1 = src[1];
    const unsigned ww[8] = {w0.x, w0.y, w0.z, w0.w, w1.x, w1.y, w1.z, w1.w};
#pragma unroll
    for (int j = 0; j < 8; ++j) { VT[(vb + 2 * j) * VTP + s] = (bf16)(ww[j] & 0xffffu); VT[(vb + 2 * j + 1) * VTP + s] = (bf16)(ww[j] >> 16); }
}
__device__ __forceinline__ void phase_hgrn_local(const Frame& F0, int l) {
    Frame F = F0; F.tid = F.wave * 64 + lane_id(); asm volatile("" : "+v"(F.tid)); F.lane = F.tid & 63;
    unsigned char* ws = opqg(F.ws);
    const float* LOGF = (const float*)(ws + WS_LOGF); const bf16* KK = (const bf16*)(ws + WS_KK); const bf16* V = (const bf16*)(ws + WS_V);
    _Float16* U = (_Float16*)(ws + WS_U); float* BLo = (float*)(ws + WS_BL);
    LAS float* bL = (LAS float*)(F.lds + HG_BL); LAS bf16* VT = (LAS bf16*)(F.lds + HG_VT); LAS bf16* KT = (LAS bf16*)(F.lds + HG_KT);
    const int fr = F.lane & 15, fq = F.lane >> 4;
    for (int unit = F.vcu; unit < NCH * 8; unit += F.G) {
        const int c = unit >> 3, h = unit & 7;
        hg_cumsum(F, LOGF, c, h);
        hg_load_vt(F, V, c, h);
        __syncthreads();
        { const int s = F.lane, db = F.wave * 16;
          const v4u* src = (const v4u*)(KK + (size_t)(c * 64 + s) * AW + h * 128 + db);
          const v4u w0 = src[0], w1 = src[1];
          const unsigned ww[8] = {w0.x, w0.y, w0.z, w0.w, w1.x, w1.y, w1.z, w1.w};
#pragma unroll
          for (int j = 0; j < 8; ++j) {
              const float b0 = bL[s * BLP + db + 2 * j], b1 = bL[s * BLP + db + 2 * j + 1], l0 = bL[63 * BLP + db + 2 * j], l1 = bL[63 * BLP + db + 2 * j + 1];
              const unsigned pk = cvt_pk_bf16(bf_lo(ww[j]) * fexp(l0 - b0), bf_hi(ww[j]) * fexp(l1 - b1));
              KT[(db + 2 * j) * VTP + s] = (bf16)(pk & 0xffffu); KT[(db + 2 * j + 1) * VTP + s] = (bf16)(pk >> 16); } }
        if (F.tid < 128) BLo[(size_t)c * AW + h * 128 + F.tid] = bL[63 * BLP + F.tid];
        __syncthreads();
        f32x4 acc[8];
#pragma unroll
        for (int i = 0; i < 8; ++i) acc[i] = (f32x4){0.f, 0.f, 0.f, 0.f};
#pragma unroll
        for (int ks = 0; ks < 2; ++ks) {
            const bf16x8 A = *(const LAS bf16x8*)(VT + (F.wave * 16 + fr) * VTP + ks * 32 + fq * 8);
#pragma unroll
            for (int dt = 0; dt < 8; ++dt) { const bf16x8 B = *(const LAS bf16x8*)(KT + (dt * 16 + fr) * VTP + ks * 32 + fq * 8);
                acc[dt] = __builtin_amdgcn_mfma_f32_16x16x32_bf16(B, A, acc[dt], 0, 0, 0); }
        }
        _Float16* up = U + ((size_t)(c * 8 + h) * 128 + F.wave * 16 + fr) * 128 + fq * 4;
#pragma unroll
        for (int dt = 0; dt < 8; ++dt) { v2u w; w.x = cvt_pk_f16(acc[dt][0], acc[dt][1]); w.y = cvt_pk_f16(acc[dt][2], acc[dt][3]); *(v2u*)(up + dt * 16) = w; }
        __syncthreads();
    }
}
__device__ __forceinline__ void phase_scan(const Frame& F0, int l) {
    Frame F = F0; F.tid = F.wave * 64 + lane_id(); asm volatile("" : "+v"(F.tid)); F.lane = F.tid & 63;
    unsigned char* ws = opqg(F.ws);
    const _Float16* U = (const _Float16*)(ws + WS_U); const float* BLo = (const float*)(ws + WS_BL); bf16* SP = (bf16*)(ws + WS_SP);
    for (int e = F.vcu * 512 + F.tid; e < 8 * 128 * 128; e += F.G * 512) {
        const int hd = (e >> 14) * 128 + (e & 127);
        float s = 0.f;
        for (int c0 = 0; c0 < NCH; c0 += 32) {
            float u[32], bl[32];
#pragma unroll
            for (int i = 0; i < 32; ++i) { u[i] = (float)U[(size_t)(c0 + i) * 131072 + e]; bl[i] = BLo[(size_t)(c0 + i) * AW + hd]; }
#pragma unroll
            for (int i = 0; i < 32; ++i) { SP[(size_t)(c0 + i) * 131072 + e] = f2bf(s); s = s * fexp(bl[i]) + u[i]; }
        }
    }
    const float* XLOC = (const float*)(ws + WS_XLOC); float* XS = (float*)(ws + WS_XS); const float* APOW = (const float*)(ws + WS_APOW);
    for (int e = F.vcu * 512 + F.tid; e < 64 * 64; e += F.G * 512) {
        const int g = e >> 6, p = e & 63;
        const float* ap = APOW + (((size_t)(l * 64 + g) * 65 + 64) * 64 + p) * 2; const float ar = ap[0], ai = ap[1];
        float xr = 0.f, xi = 0.f;
        for (int c0 = 0; c0 < NCH; c0 += 32) {
            float lr_[32], li_[32];
#pragma unroll
            for (int i = 0; i < 32; ++i) { lr_[i] = XLOC[((size_t)(c0 + i) * 64 + g) * 128 + p]; li_[i] = XLOC[((size_t)(c0 + i) * 64 + g) * 128 + 64 + p]; }
#pragma unroll
            for (int i = 0; i < 32; ++i) { XS[((size_t)(c0 + i) * 64 + g) * 128 + p] = xr; XS[((size_t)(c0 + i) * 64 + g) * 128 + 64 + p] = xi;
                const float t = ar * xr - ai * xi + lr_[i]; xi = ar * xi + ai * xr + li_[i]; xr = t; }
        }
    }
}
__device__ __forceinline__ void phase_hgrn_out(const Frame& F0, int l) {
    Frame F = F0; F.tid = F.wave * 64 + lane_id(); asm volatile("" : "+v"(F.tid)); F.lane = F.tid & 63;
    unsigned char* ws = opqg(F.ws); const __attribute__((address_space(4))) Args* a = opq(F.ka);
    const float* LOGF = (const float*)(ws + WS_LOGF); const bf16* KK = (const bf16*)(ws + WS_KK); const bf16* V = (const bf16*)(ws + WS_V);
    const bf16* Q = (const bf16*)(ws + WS_Q); const bf16* SG = (const bf16*)(ws + WS_SG); const bf16* SP = (const bf16*)(ws + WS_SP);
    bf16* OAB = (bf16*)(ws + WS_OAB); const float* NG = GP(const float, a->in[I_NG]) + (size_t)l * AW;
    LAS float* bL = (LAS float*)(F.lds + HG_BL); LAS bf16* VT = (LAS bf16*)(F.lds + HG_VT); LAS float* red = (LAS float*)(F.lds + HG_RED);
    const int fr = F.lane & 15, fq = F.lane >> 4, tt = F.wave & 3, vh = F.wave >> 2;
    LAS float* tot = (LAS float*)(F.lds + HG_TOT);
    float lf[16]; v4u vw0, vw1, kg0, kg1, qg0, qg1;
#define HGO_PREF(u_) { const int c_ = (u_) >> 3, h_ = (u_) & 7; \
        const float* src_ = LOGF + (size_t)(c_ * 64 + (F.tid >> 7) * 16) * AW + h_ * 128 + (F.tid & 127); \
        _Pragma("unroll") for (int i = 0; i < 16; ++i) lf[i] = src_[(size_t)i * AW]; \
        const v4u* vp_ = (const v4u*)(V + (size_t)(c_ * 64 + F.lane) * AW + h_ * 128 + F.wave * 16); vw0 = vp_[0]; vw1 = vp_[1]; \
        const size_t ro_ = ((size_t)c_ * 64 + (F.tid >> 3)) * AW + h_ * 128 + (F.tid & 7) * 16; \
        const v4u* kp_ = (const v4u*)(KK + ro_); const v4u* qp_ = (const v4u*)(Q + ro_); kg0 = kp_[0]; kg1 = kp_[1]; qg0 = qp_[0]; qg1 = qp_[1]; }
    if (F.vcu < NCH * 8) HGO_PREF(F.vcu)
    for (int unit = F.vcu; unit < NCH * 8; unit += F.G) {
        const int c = unit >> 3, h = unit & 7;
        { const int d = F.tid & 127, seg = F.tid >> 7;
#pragma unroll
          for (int i = 1; i < 16; ++i) lf[i] += lf[i - 1];
          tot[seg * 128 + d] = lf[15];
          { const int s = F.lane, vb = F.wave * 16; const unsigned ww[8] = {vw0.x, vw0.y, vw0.z, vw0.w, vw1.x, vw1.y, vw1.z, vw1.w};
#pragma unroll
            for (int j = 0; j < 8; ++j) { VT[(vb + 2 * j) * VTP + s] = (bf16)(ww[j] & 0xffffu); VT[(vb + 2 * j + 1) * VTP + s] = (bf16)(ww[j] >> 16); } }
          __syncthreads();
          float off = 0.f;
#pragma unroll
          for (int s2 = 0; s2 < 3; ++s2) off += (s2 < seg) ? tot[s2 * 128 + d] : 0.f;
#pragma unroll
          for (int i = 0; i < 16; ++i) bL[(seg * 16 + i) * BLP + d] = lf[i] + off; }
        __syncthreads();
        const int t = tt * 16 + fr; const size_t tok = (size_t)c * 64 + t;
        bf16x8 sg_[2][4];
#define HG_LOAD(buf, kd_) { const int d0_ = (kd_) * 32 + fq * 8; \
            _Pragma("unroll") for (int vt = 0; vt < 4; ++vt) sg_[buf][vt] = *(const bf16x8*)(SP + ((size_t)(c * 8 + h) * 128 + (vh * 4 + vt) * 16 + fr) * 128 + d0_); }
        HG_LOAD(0, 0) HG_LOAD(1, 1)
        v2u sgw[4];
#pragma unroll
        for (int vt = 0; vt < 4; ++vt) sgw[vt] = *(const v2u*)(SG + tok * AW + h * 128 + (vh * 4 + vt) * 16 + fq * 4);
        f32x4 ngw[4];
#pragma unroll
        for (int vt = 0; vt < 4; ++vt) ngw[vt] = *(const f32x4*)(NG + h * 128 + (vh * 4 + vt) * 16 + fq * 4);
        { const int s = F.tid >> 3, dc = (F.tid & 7) * 16;
          const unsigned kq[8] = {kg0.x, kg0.y, kg0.z, kg0.w, kg1.x, kg1.y, kg1.z, kg1.w}, qq[8] = {qg0.x, qg0.y, qg0.z, qg0.w, qg1.x, qg1.y, qg1.z, qg1.w};
          unsigned ko[8], qto[8], qho[8];
#pragma unroll
          for (int j4 = 0; j4 < 4; ++j4) { const f32x4 bs = *(const LAS f32x4*)(bL + s * BLP + dc + 4 * j4), br = *(const LAS f32x4*)(bL + 31 * BLP + dc + 4 * j4);
#pragma unroll
              for (int hx = 0; hx < 2; ++hx) { const int w = 2 * j4 + hx; const float b0 = bs[2 * hx], b1 = bs[2 * hx + 1], r0 = br[2 * hx], r1 = br[2 * hx + 1];
                  const float k0 = bf_lo(kq[w]), k1 = bf_hi(kq[w]), q0 = bf_lo(qq[w]), q1 = bf_hi(qq[w]);
                  ko[w] = cvt_pk_bf16(k0 * fexp(fminf(r0 - b0, 80.f)), k1 * fexp(fminf(r1 - b1, 80.f)));
                  qto[w] = cvt_pk_bf16(q0 * fexp(fminf(b0 - r0, 80.f)), q1 * fexp(fminf(b1 - r1, 80.f)));
                  qho[w] = cvt_pk_bf16(q0 * fexp(b0), q1 * fexp(b1)); } }
          LAS v4u* kd_ = (LAS v4u*)(F.lds + HG_KS + (s * KSP + dc) * 2); kd_[0] = (v4u){ko[0], ko[1], ko[2], ko[3]}; kd_[1] = (v4u){ko[4], ko[5], ko[6], ko[7]};
          LAS v4u* qt_ = (LAS v4u*)(F.lds + HG_QT + (s * KSP + dc) * 2); qt_[0] = (v4u){qto[0], qto[1], qto[2], qto[3]}; qt_[1] = (v4u){qto[4], qto[5], qto[6], qto[7]};
          LAS v4u* qh_ = (LAS v4u*)(F.lds + HG_QH + (s * KSP + dc) * 2); qh_[0] = (v4u){qho[0], qho[1], qho[2], qho[3]}; qh_[1] = (v4u){qho[4], qho[5], qho[6], qho[7]}; }
        __syncthreads();
        f32x4 att[4], o[4];
#pragma unroll
        for (int i = 0; i < 4; ++i) { att[i] = (f32x4){0.f, 0.f, 0.f, 0.f}; o[i] = (f32x4){0.f, 0.f, 0.f, 0.f}; }
#pragma unroll
        for (int kd = 0; kd < 4; ++kd) {
            const int cb = kd & 1;
            const int fo = (kd * 32 + fq * 8) * 2;
            const bf16x8 Bqt = *(const LAS bf16x8*)(F.lds + HG_QT + (t * KSP) * 2 + fo), Bqh = *(const LAS bf16x8*)(F.lds + HG_QH + (t * KSP) * 2 + fo);
#pragma unroll
            for (int st = 0; st < 4; ++st) { const bf16x8 kt = *(const LAS bf16x8*)(F.lds + HG_KS + ((st * 16 + fr) * KSP) * 2 + fo);
                att[st] = __builtin_amdgcn_mfma_f32_16x16x32_bf16(kt, Bqt, att[st], 0, 0, 0); }
#pragma unroll
            for (int vt = 0; vt < 4; ++vt) o[vt] = __builtin_amdgcn_mfma_f32_16x16x32_bf16(sg_[cb][vt], Bqh, o[vt], 0, 0, 0);
            if (kd < 2) HG_LOAD(cb, kd + 2)
            if (kd == 1) { const int nu = unit + F.G; if (nu < NCH * 8) HGO_PREF(nu) }
        }
#undef HG_LOAD
#pragma unroll
        for (int ks = 0; ks < 2; ++ks) {
            float m8[8];
#pragma unroll
            for (int jj = 0; jj < 8; ++jj) { const int st = 2 * ks + (jj >> 2), r = jj & 3, s = st * 16 + fq * 4 + r; m8[jj] = (s <= t) ? att[st][r] : 0.f; }
            v4u pb; pb.x = cvt_pk_bf16(m8[0], m8[1]); pb.y = cvt_pk_bf16(m8[2], m8[3]); pb.z = cvt_pk_bf16(m8[4], m8[5]); pb.w = cvt_pk_bf16(m8[6], m8[7]);
            const bf16x8 B = __builtin_bit_cast(bf16x8, pb);
#pragma unroll
            for (int vt = 0; vt < 4; ++vt) { const int v = (vh * 4 + vt) * 16 + fr;
                const v2u a0 = *(const LAS v2u*)(VT + v * VTP + ks * 32 + fq * 4), a1 = *(const LAS v2u*)(VT + v * VTP + ks * 32 + 16 + fq * 4);
                const v4u pa = (v4u){a0.x, a0.y, a1.x, a1.y};
                o[vt] = __builtin_amdgcn_mfma_f32_16x16x32_bf16(__builtin_bit_cast(bf16x8, pa), B, o[vt], 0, 0, 0); }
        }
        float ss = 0.f;
#pragma unroll
        for (int vt = 0; vt < 4; ++vt)
#pragma unroll
            for (int r = 0; r < 4; ++r) ss += o[vt][r] * o[vt][r];
        ss += __shfl_xor(ss, 16); ss += __shfl_xor(ss, 32);
        if (fq == 0) red[F.wave * 16 + fr] = ss;
        LDS_WAIT(); __builtin_amdgcn_s_barrier(); asm volatile("" ::: "memory");
        const float tot = red[F.wave * 16 + fr] + red[(F.wave ^ 4) * 16 + fr];
        const float rstd = __builtin_amdgcn_rsqf(tot * (1.f / 128.f) + RMS_EPS);
#pragma unroll
        for (int vt = 0; vt < 4; ++vt) { const int v0 = (vh * 4 + vt) * 16 + fq * 4;
            const f32x4 g4 = ngw[vt]; const v2u sg = sgw[vt];
            v2u w; w.x = cvt_pk_bf16(o[vt][0] * rstd * g4[0] * bf_lo(sg.x), o[vt][1] * rstd * g4[1] * bf_hi(sg.x));
            w.y = cvt_pk_bf16(o[vt][2] * rstd * g4[2] * bf_lo(sg.y), o[vt][3] * rstd * g4[3] * bf_hi(sg.y));
            *(v2u*)(OAB + tok * 2048 + h * 128 + v0) = w; }
        LDS_WAIT(); __builtin_amdgcn_s_barrier(); asm volatile("" ::: "memory");
    }
#undef HGO_PREF
}

constexpr int S5_UT = 0, S5_UTP = 2064, S5_XST = 33024, S5_XSP = 272, S5_KM = 37376;
__device__ __forceinline__ void s5_load_ut(const Frame& F, const bf16* UB, int g, int jb) {
    v4u w0[2], w1[2];
#pragma unroll
    for (int i = 0; i < 2; ++i) { const int tl = F.tid + 512 * i; const v4u* src = (const v4u*)(UB + ((size_t)jb * 1024 + tl) * AW + g * 16); w0[i] = src[0]; w1[i] = src[1]; }
#pragma unroll
    for (int i = 0; i < 2; ++i) { const int tl = F.tid + 512 * i; LAS v4u* dst = (LAS v4u*)(F.lds + S5_UT + (tl >> 6) * S5_UTP + (tl & 63) * 32); dst[0] = w0[i]; dst[1] = w1[i]; }
}
__device__ __forceinline__ void phase_s5_local(const Frame& F0, int l) {
    Frame F = F0; F.tid = F.wave * 64 + lane_id(); asm volatile("" : "+v"(F.tid)); F.lane = F.tid & 63;
    unsigned char* ws = opqg(F.ws);
    const bf16* UB = (const bf16*)(ws + WS_UB); const bf16* PM = (const bf16*)(ws + WS_PM) + (size_t)l * 64 * 128 * 1024; float* XLOC = (float*)(ws + WS_XLOC);
    const int fr = F.lane & 15, fq = F.lane >> 4;
    for (int unit = F.vcu; unit < 64 * 8; unit += F.G) {
        const int g = unit >> 3, jb = unit & 7;
        const bf16* ap = PM + ((size_t)g * 128 + F.wave * 16 + fr) * 1024 + fq * 8;
        bf16x8 Af[32];
#pragma unroll
        for (int ks = 0; ks < 32; ++ks) Af[ks] = *(const bf16x8*)(ap + ks * 32);
        s5_load_ut(F, UB, g, jb);
        __syncthreads();
        f32x4 acc = (f32x4){0.f, 0.f, 0.f, 0.f};
        const LAS unsigned char* bp = F.lds + S5_UT + fr * S5_UTP + (fq >> 1) * 32 + (fq & 1) * 16;
#pragma unroll
        for (int ks = 0; ks < 32; ++ks) { const bf16x8 B = *(const LAS bf16x8*)(bp + ks * 64);
            acc = __builtin_amdgcn_mfma_f32_16x16x32_bf16(Af[ks], B, acc, 0, 0, 0); }
        *(f32x4*)(XLOC + ((size_t)(jb * 16 + fr) * 64 + g) * 128 + F.wave * 16 + fq * 4) = acc;
        __syncthreads();
    }
}
__device__ __forceinline__ void phase_s5_out(const Frame& F0, int l) {
    Frame F = F0; F.tid = F.wave * 64 + lane_id(); asm volatile("" : "+v"(F.tid)); F.lane = F.tid & 63;
    unsigned char* ws = opqg(F.ws);
    const bf16* UB = (const bf16*)(ws + WS_UB); const bf16* E = (const bf16*)(ws + WS_E) + (size_t)l * 64 * 1024 * 128; const bf16* KMAT = (const bf16*)(ws + WS_KMAT) + (size_t)l * 64 * 65 * 256;
    const float* XS = (const float*)(ws + WS_XS); bf16* YB = (bf16*)(ws + WS_YB);
    const int fr = F.lane & 15, fq = F.lane >> 4;
    for (int unit = F.vcu; unit < 64 * 8; unit += F.G) {
        const int g = unit >> 3, jb = unit & 7;
        { const int cc = F.tid >> 5, p0 = (F.tid & 31) * 4;
          const f32x4 xv = *(const f32x4*)(XS + ((size_t)(jb * 16 + cc) * 64 + g) * 128 + p0);
          v4u km[5];
#pragma unroll
          for (int k = 0; k < 5; ++k) { const int pc = F.tid + 512 * k; km[k] = (pc < 65 * 32) ? *(const v4u*)(KMAT + (size_t)g * 65 * 256 + (size_t)pc * 8) : (v4u){0u, 0u, 0u, 0u}; }
          s5_load_ut(F, UB, g, jb);
          v2u w; w.x = cvt_pk_bf16(xv[0], xv[1]); w.y = cvt_pk_bf16(xv[2], xv[3]); *(LAS v2u*)(F.lds + S5_XST + cc * S5_XSP + p0 * 2) = w;
#pragma unroll
          for (int k = 0; k < 5; ++k) { const int pc = F.tid + 512 * k; const int idx = pc >> 5, n = (pc >> 1) & 15, half = pc & 1;
              if (pc < 65 * 32) *(LAS v4u*)(F.lds + S5_KM + idx * 512 + n * 32 + ((half ^ (n >> 3)) * 16)) = km[k]; } }
        __syncthreads();
        for (int ti = 0; ti < 8; ++ti) {
            const int tau = ti * 8 + F.wave;
            const bf16* ep = E + ((size_t)g * 1024 + tau * 16 + fr) * 128 + fq * 8;
            bf16x8 Ae[4];
#pragma unroll
            for (int ke = 0; ke < 4; ++ke) Ae[ke] = *(const bf16x8*)(ep + ke * 32);
            f32x4 acc = (f32x4){0.f, 0.f, 0.f, 0.f}, acc1 = (f32x4){0.f, 0.f, 0.f, 0.f};
            const LAS unsigned char* bp = F.lds + S5_UT + fr * S5_UTP + (fq >> 1) * 32 + (fq & 1) * 16;
            const LAS unsigned char* kp = F.lds + S5_KM + (tau - (fq >> 1) + 1) * 512 + fr * 32 + (((fq & 1) ^ (fr >> 3)) * 16);
            const int nks = (tau >> 1) + 1;
            int ks = 0;
            for (; ks + 4 <= nks; ks += 4) {
                const bf16x8 A0 = *(const LAS bf16x8*)(kp - ks * 1024), A1 = *(const LAS bf16x8*)(kp - (ks + 1) * 1024), A2 = *(const LAS bf16x8*)(kp - (ks + 2) * 1024), A3 = *(const LAS bf16x8*)(kp - (ks + 3) * 1024);
                const bf16x8 B0 = *(const LAS bf16x8*)(bp + ks * 64), B1 = *(const LAS bf16x8*)(bp + (ks + 1) * 64), B2 = *(const LAS bf16x8*)(bp + (ks + 2) * 64), B3 = *(const LAS bf16x8*)(bp + (ks + 3) * 64);
                acc = __builtin_amdgcn_mfma_f32_16x16x32_bf16(A0, B0, acc, 0, 0, 0); acc1 = __builtin_amdgcn_mfma_f32_16x16x32_bf16(A1, B1, acc1, 0, 0, 0);
                acc = __builtin_amdgcn_mfma_f32_16x16x32_bf16(A2, B2, acc, 0, 0, 0); acc1 = __builtin_amdgcn_mfma_f32_16x16x32_bf16(A3, B3, acc1, 0, 0, 0); }
            for (; ks < nks; ++ks) { const bf16x8 A = *(const LAS bf16x8*)(kp - ks * 1024); const bf16x8 B = *(const LAS bf16x8*)(bp + ks * 64);
                acc = __builtin_amdgcn_mfma_f32_16x16x32_bf16(A, B, acc, 0, 0, 0); }
            const LAS unsigned char* xp = F.lds + S5_XST + fr * S5_XSP + fq * 16;
#pragma unroll
            for (int ke = 0; ke < 4; ke += 2) { const bf16x8 B0 = *(const LAS bf16x8*)(xp + ke * 64), B1 = *(const LAS bf16x8*)(xp + (ke + 1) * 64);
                acc = __builtin_amdgcn_mfma_f32_16x16x32_bf16(Ae[ke], B0, acc, 0, 0, 0); acc1 = __builtin_amdgcn_mfma_f32_16x16x32_bf16(Ae[ke + 1], B1, acc1, 0, 0, 0); }
            acc += acc1;
            v2u w; w.x = cvt_pk_bf16(gelu_tanh(acc[0]), gelu_tanh(acc[1])); w.y = cvt_pk_bf16(gelu_tanh(acc[2]), gelu_tanh(acc[3]));
            *(v2u*)(YB + ((size_t)(jb * 16 + fr) * 64 + tau) * AW + g * 16 + fq * 4) = w;
        }
        __syncthreads();
    }
}

__device__ __forceinline__ void phase_ln(const Frame& F0, int l, int which) {
    Frame F = F0; F.tid = F.wave * 64 + lane_id(); asm volatile("" : "+v"(F.tid)); F.lane = F.tid & 63;
    unsigned char* ws = opqg(F.ws); const __attribute__((address_space(4))) Args* a = opq(F.ka);
    const bf16* RS = (const bf16*)(ws + WS_RH); bf16* XS = (bf16*)(ws + WS_XH);
    const bool last = (which == 1 && l == DEPTH - 1); float* OUT = GP(float, a->out);
    const float* gam = GP(const float, a->in[which == 0 ? I_LN1G : I_LN2G]) + (size_t)l * D; const float* bet = GP(const float, a->in[which == 0 ? I_LN1B : I_LN2B]) + (size_t)l * D;
    const int gw = F.vcu * 8 + F.wave, NGW = F.G * 8;
    const int j = F.lane & 3, rr = (F.lane >> 2) & 1, sl = F.lane >> 3;
    LAS float* gamL = (LAS float*)(F.lds); LAS float* betL = gamL + D;
    ((LAS f32x4*)gamL)[F.tid] = ((const f32x4*)gam)[F.tid]; ((LAS f32x4*)betL)[F.tid] = ((const f32x4*)bet)[F.tid];
    __syncthreads();
    for (int rp = gw; rp < T / 2; rp += NGW) {
        const int row = 2 * rp + rr;
        const size_t eo = ((size_t)sl * T + row) * 32 + j * 8;
        v4u w[8];
#pragma unroll
        for (int i = 0; i < 8; ++i) w[i] = *(const v4u*)(RS + eo + (size_t)i * 8 * T * 32);
        float v[64]; float s = 0.f;
#pragma unroll
        for (int i = 0; i < 8; ++i) { const unsigned ww[4] = {w[i].x, w[i].y, w[i].z, w[i].w};
#pragma unroll
            for (int k = 0; k < 4; ++k) { const h2_t hv = __builtin_bit_cast(h2_t, ww[k]); v[8 * i + 2 * k] = (float)hv.x; v[8 * i + 2 * k + 1] = (float)hv.y; s += (float)hv.x + (float)hv.y; } }
        s += __shfl_xor(s, 1); s += __shfl_xor(s, 2); s += __shfl_xor(s, 8); s += __shfl_xor(s, 16); s += __shfl_xor(s, 32);
        const float mean = s * (1.f / D); float s2 = 0.f;
#pragma unroll
        for (int i = 0; i < 64; ++i) { v[i] -= mean; s2 += v[i] * v[i]; }
        s2 += __shfl_xor(s2, 1); s2 += __shfl_xor(s2, 2); s2 += __shfl_xor(s2, 8); s2 += __shfl_xor(s2, 16); s2 += __shfl_xor(s2, 32);
        const float rstd = __builtin_amdgcn_rsqf(s2 * (1.f / D) + LN_EPS);
        float amax = 0.f; int slv = sl; asm volatile("" : "+v"(slv));
#pragma unroll
        for (int i = 0; i < 8; ++i) { const int e0 = (8 * i + slv) * 32 + j * 8;
            const f32x4 g0 = *(const LAS f32x4*)(gamL + e0), g1 = *(const LAS f32x4*)(gamL + e0 + 4), b0 = *(const LAS f32x4*)(betL + e0), b1 = *(const LAS f32x4*)(betL + e0 + 4);
            const f32x4 y0 = (f32x4){v[8 * i], v[8 * i + 1], v[8 * i + 2], v[8 * i + 3]} * rstd * g0 + b0, y1 = (f32x4){v[8 * i + 4], v[8 * i + 5], v[8 * i + 6], v[8 * i + 7]} * rstd * g1 + b1;
            if (last) { *(f32x4*)(OUT + (size_t)row * D + e0) = y0; *(f32x4*)(OUT + (size_t)row * D + e0 + 4) = y1; }
            else { v4u o; o.x = cvt_pk_f16(y0[0], y0[1]); o.y = cvt_pk_f16(y0[2], y0[3]); o.z = cvt_pk_f16(y1[0], y1[1]); o.w = cvt_pk_f16(y1[2], y1[3]); *(v4u*)(XS + eo + (size_t)i * 8 * T * 32) = o; }
            if (which == 0) {
#pragma unroll
                for (int k = 0; k < 4; ++k) { v[8 * i + k] = y0[k]; v[8 * i + 4 + k] = y1[k]; amax = fmaxf(amax, fmaxf(fabsf(y0[k]), fabsf(y1[k]))); } } }
        if (which == 0) {
            amax = fmaxf(amax, __shfl_xor(amax, 1)); amax = fmaxf(amax, __shfl_xor(amax, 2)); amax = fmaxf(amax, __shfl_xor(amax, 8)); amax = fmaxf(amax, __shfl_xor(amax, 16)); amax = fmaxf(amax, __shfl_xor(amax, 32));
            const float inv = (amax > 0.f) ? 127.f / amax : 0.f;
            if (j == 0 && sl == 0) ((float*)(ws + WS_SX))[row] = (amax > 0.f) ? amax * (1.f / 127.f) : 1.f;
            unsigned char* xq = ws + WS_XQ + (size_t)row * 64 + (sl & 1) * 32 + j * 8;
#pragma unroll
            for (int i = 0; i < 8; ++i) { int q[8];
#pragma unroll
                for (int k = 0; k < 8; ++k) q[k] = (int)__builtin_rintf(v[8 * i + k] * inv);
                v2u o; o.x = (unsigned)(q[0] & 255) | ((unsigned)(q[1] & 255) << 8) | ((unsigned)(q[2] & 255) << 16) | ((unsigned)q[3] << 24);
                o.y = (unsigned)(q[4] & 255) | ((unsigned)(q[5] & 255) << 8) | ((unsigned)(q[6] & 255) << 16) | ((unsigned)q[7] << 24);
                *(v2u*)(xq + (size_t)(4 * i + (sl >> 1)) * T * 64) = o; } }
    }
    __syncthreads();
}

constexpr int PK_TV = 0, PK_EID = 65536, PK_GATE = 81920;
__device__ __forceinline__ int f2key(float x) { const int b = __float_as_int(x); return b ^ ((b >> 31) & 0x7fffffff); }
__device__ __forceinline__ float key2f(int k) { return __int_as_float(k ^ ((k >> 31) & 0x7fffffff)); }
__device__ __forceinline__ int imed3(int a, int b, int c) { int r; asm("v_med3_i32 %0, %1, %2, %3" : "=v"(r) : "v"(a), "v"(b), "v"(c)); return r; }
#define INSK(kx) do { const int _x = (kx); _Pragma("unroll") for (int _k = 15; _k > 0; --_k) tk[_k] = imed3(tk[_k - 1], tk[_k], _x); tk[0] = max(tk[0], _x); } while (0)
__device__ __forceinline__ void phase_topk(const Frame& F0, int l) {
    Frame F = F0; F.tid = F.wave * 64 + lane_id(); asm volatile("" : "+v"(F.tid)); F.lane = F.tid & 63;
    unsigned char* ws = opqg(F.ws);
    const float* SC = (const float*)(ws + WS_SC); int* SEID = (int*)(ws + WS_SEID); float* SGATE = (float*)(ws + WS_SGATE); unsigned char* START = ws + WS_START;
    LAS int* TK = (LAS int*)(F.lds + PK_TV); LAS int* EIDL = (LAS int*)(F.lds + PK_EID); LAS float* GATEL = (LAS float*)(F.lds + PK_GATE);
    for (int tb = F.vcu; tb < T / 32; tb += F.G) {
        const int t0 = tb * 32;
        { const int tok = F.tid >> 4, hh = F.tid & 15;
          const v4u* sp = (const v4u*)((const bf16*)SC + (size_t)(t0 + tok) * 2048 + hh * 128);
          int tk[16];
#pragma unroll
          for (int k = 0; k < 16; ++k) tk[k] = (int)0x80000000;
#pragma unroll 1
          for (int i4 = 0; i4 < 16; i4 += 4) { v4u sa[4];
#pragma unroll
              for (int i = 0; i < 4; ++i) sa[i] = sp[i4 + i];
#pragma unroll
              for (int i = 0; i < 4; ++i) { const v4u s0 = sa[i]; const unsigned sw[4] = {s0.x, s0.y, s0.z, s0.w}; const int ib = 127 - 8 * (i4 + i);
#pragma unroll
                  for (int x = 0; x < 4; ++x) { INSK((f2key(bf_lo(sw[x])) & ~127) | (ib - 2 * x)); INSK((f2key(bf_hi(sw[x])) & ~127) | (ib - 2 * x - 1)); } } }
#pragma unroll
          for (int k = 0; k < 16; ++k) TK[F.tid * 16 + k] = tk[k]; }
        __syncthreads();
        if ((F.tid & 1) == 0) {
            float v1[16], v2[16];
#pragma unroll
            for (int k = 0; k < 16; ++k) { v1[k] = key2f(TK[F.tid * 16 + k] & ~127); v2[k] = key2f(TK[(F.tid + 1) * 16 + k] & ~127); }
            int tk[16];
#pragma unroll
            for (int k = 0; k < 16; ++k) tk[k] = (int)0x80000000;
#pragma unroll
            for (int aa = 0; aa < 16; ++aa)
#pragma unroll
                for (int bb = 0; bb < 16; ++bb) if ((aa + 1) * (bb + 1) <= 16) { INSK((f2key(v1[aa] + v2[bb]) & ~255) | (255 - (aa * 16 + bb))); }
            float ex[16], sum = 0.f; const float v0 = key2f(tk[0] & ~255);
#pragma unroll
            for (int k = 0; k < 16; ++k) { ex[k] = expf(key2f(tk[k] & ~255) - v0); sum += ex[k]; }
            const float inv = 1.f / sum;
            const int tok = F.tid >> 4, hd = (F.tid >> 1) & 7;
#pragma unroll
            for (int k = 0; k < 16; ++k) { const int code = 255 - (tk[k] & 255);
                const int i1 = 127 - (TK[F.tid * 16 + (code >> 4)] & 127), i2 = 127 - (TK[(F.tid + 1) * 16 + (code & 15)] & 127);
                EIDL[tok * 128 + hd * 16 + k] = (((i1 + i2) & 15) << 10) + i1 * 8 + (i2 >> 4); GATEL[tok * 128 + hd * 16 + k] = ex[k] * inv; }
        }
        __syncthreads();
        for (int ti = 0; ti < 4; ++ti) {
            const int tok = F.wave * 4 + ti;
            int k0 = (EIDL[tok * 128 + F.lane] << 7) | F.lane, k1 = (EIDL[tok * 128 + 64 + F.lane] << 7) | (64 + F.lane);
#pragma unroll
            for (int k = 2; k <= 128; k <<= 1)
#pragma unroll
                for (int j = k >> 1; j > 0; j >>= 1) {
                    if (j == 64) { const int mn = min(k0, k1), mx = max(k0, k1); k0 = mn; k1 = mx; }
                    else { const int o0 = __shfl_xor(k0, j), o1 = __shfl_xor(k1, j); const bool lower = (F.lane & j) == 0;
                        const bool up0 = (F.lane & k) == 0, up1 = ((64 + F.lane) & k) == 0;
                        k0 = (up0 == lower) ? min(k0, o0) : max(k0, o0); k1 = (up1 == lower) ? min(k1, o1) : max(k1, o1); }
                }
            const size_t t = (size_t)(t0 + tok);
            { const int r0 = k0 >> 17, r1 = k1 >> 17; int mine = 0;
#pragma unroll
              for (int r = 1; r < 16; ++r) { const int c = __builtin_popcountll(__ballot(r0 < r)) + __builtin_popcountll(__ballot(r1 < r)); mine = (F.lane == r) ? c : mine; }
              if (F.lane < 16) START[t * 16 + F.lane] = (unsigned char)mine; }
            SEID[t * LP + F.lane] = k0 >> 7; SEID[t * LP + 64 + F.lane] = k1 >> 7;
            SGATE[t * 128 + F.lane] = GATEL[tok * 128 + (k0 & 127)]; SGATE[t * 128 + 64 + F.lane] = GATEL[tok * 128 + (k1 & 127)];
        }
        __syncthreads();
    }
}
typedef __bf16 bf2_t __attribute__((ext_vector_type(2)));
__device__ __forceinline__ float dot2bf(unsigned a, unsigned b, float c) { return __builtin_amdgcn_fdot2_f32_bf16(__builtin_bit_cast(bf2_t, a), __builtin_bit_cast(bf2_t, b), c, false); }
__device__ __forceinline__ void peer_stage(const Frame& F, const bf16* gsrc, int bo) {
#pragma unroll
    for (int i = 0; i < 8; ++i) { const int p = i * 8 + F.wave;
        __builtin_amdgcn_global_load_lds((const unsigned*)((const char*)gsrc + p * 1024 + F.lane * 16), (LAS unsigned*)(F.lds + bo + p * 1024), 16, 0, 0); }
}
__device__ __forceinline__ void peer_dma(const Frame& F, const void* gsrc, int bo) {
    const unsigned ldsbase = (unsigned)(size_t)(F.lds + bo) + (unsigned)F.wave * 1024u;
#pragma unroll
    for (int i = 0; i < 8; ++i) { const char* g = (const char*)gsrc + (i * 8 + F.wave) * 1024 + F.lane * 16; const unsigned m = ldsbase + i * 8192u;
        asm volatile("s_mov_b32 m0, %0\n\ts_nop 0\n\tglobal_load_lds_dwordx4 %1, off" :: "s"(m), "v"((GAS const char*)g) : "memory"); }
}
__device__ __forceinline__ int wave_max_i(int v) {
#pragma unroll
    for (int o = 1; o < 64; o <<= 1) v = max(v, __shfl_xor(v, o));
    return __builtin_amdgcn_readfirstlane(v);
}
template <int K> __device__ __forceinline__ unsigned dppq(unsigned v) { return (unsigned)__builtin_amdgcn_mov_dpp((int)v, K * 0x55, 0xf, 0xf, true); }
__device__ __forceinline__ int sdot4(unsigned a, unsigned b, int c) { return __builtin_amdgcn_sdot4((int)a, (int)b, c, false); }
__device__ __forceinline__ int quad_sum_i(int v) {
    v += __builtin_amdgcn_mov_dpp(v, 0xB1, 0xf, 0xf, true);
    v += __builtin_amdgcn_mov_dpp(v, 0x4E, 0xf, 0xf, true);
    return v;
}
__device__ __forceinline__ float quad_sum(float v) {
    v += __int_as_float(__builtin_amdgcn_mov_dpp(__float_as_int(v), 0xB1, 0xf, 0xf, true));
    v += __int_as_float(__builtin_amdgcn_mov_dpp(__float_as_int(v), 0x4E, 0xf, 0xf, true));
    return v;
}
constexpr int UCAP0 = 24, UCAP1 = 12, UCAP2 = 12, UCAP3 = 8;
__device__ __forceinline__ void phase_peer_u(const Frame& F0, int l) {
    Frame F = F0; F.tid = F.wave * 64 + lane_id(); asm volatile("" : "+v"(F.tid)); F.lane = F.tid & 63;
    unsigned char* ws = opqg(F.ws);
    const bf16* TU = (const bf16*)(ws + WS_TBU) + (size_t)l * 32 * NEXP * 32;
    const int* SEID = (const int*)(ws + WS_SEID); const float* SGATE = (const float*)(ws + WS_SGATE); unsigned* PACK = (unsigned*)(ws + WS_PACK); unsigned char* START = ws + WS_START;
    const bf16* XBS = (const bf16*)(ws + WS_XQ); unsigned* PACK2 = (unsigned*)(ws + WS_PACK2);
    const float* SX = (const float*)(ws + WS_SX); const float* SU = (const float*)(ws + WS_SU) + (size_t)l * NEXP;
    const int qd = F.lane >> 2, jc = F.lane & 3;
    for (int unit = F.vcu; unit < 256; unit += F.G) {
        const int tt = unit & 15, er = unit >> 4; const size_t t = (size_t)tt * 512 + F.tid;
        const int lo = START[t * 16 + er], hi = (er < 15) ? (int)START[t * 16 + er + 1] : 128;
        const int cnt = hi - lo;
        int key = (cnt << 6) | (63 - F.lane);
#pragma unroll
        for (int k = 2; k <= 64; k <<= 1)
#pragma unroll
            for (int j = k >> 1; j > 0; j >>= 1) { const int o = __shfl_xor(key, j); const bool lower = (F.lane & j) == 0, up = (F.lane & k) == 0;
                key = (up == lower) ? max(key, o) : min(key, o); }
        int tl[4], glo[4], gcnt[4], gmax[4];
#pragma unroll
        for (int a = 0; a < 4; ++a) { const int kk = __shfl(key, a * 16 + qd); tl[a] = 63 - (kk & 63); gcnt[a] = kk >> 6; glo[a] = __shfl(lo, tl[a]);
            gmax[a] = __builtin_amdgcn_readfirstlane(__shfl(key, a * 16)) >> 6; }
        const size_t tbase = (size_t)tt * 512 + F.wave * 64;
        unsigned ro0[UCAP0 / 4], ro1[UCAP1 / 4], ro2[UCAP2 / 4], ro3[UCAP3 / 4];
#define LOADRO(arr, a, CAP) _Pragma("unroll") for (int i = 0; i < CAP / 4; ++i) { const int s = 4 * i + jc; const int e = SEID[(tbase + tl[a]) * LP + glo[a] + s]; \
            const int row = (s < gcnt[a]) ? (e & 1023) : 0; arr[i] = (unsigned)((row << 6) + (((row >> 2) & 3) << 4)); }
        LOADRO(ro0, 0, UCAP0) LOADRO(ro1, 1, UCAP1) LOADRO(ro2, 2, UCAP2) LOADRO(ro3, 3, UCAP3)
#undef LOADRO
        int ac0[UCAP0], ac1[UCAP1], ac2[UCAP2], ac3[UCAP3];
#pragma unroll
        for (int s = 0; s < UCAP0; ++s) ac0[s] = 0;
#pragma unroll
        for (int s = 0; s < UCAP1; ++s) ac1[s] = 0;
#pragma unroll
        for (int s = 0; s < UCAP2; ++s) ac2[s] = 0;
#pragma unroll
        for (int s = 0; s < UCAP3; ++s) ac3[s] = 0;
        const bf16* gsl0 = TU + (size_t)er * 1024 * 32;
#define XA(a) ((const v4u*)(XBS + (tbase + tl[a]) * 32) + jc)
        v4u xs[4];
#pragma unroll
        for (int a = 0; a < 4; ++a) xs[a] = XA(a)[0];
        peer_dma(F, gsl0, 0);
        VM_WAIT(); __syncthreads();
#pragma unroll 1
        for (int ks = 0; ks < 32; ++ks) {
            const int bo = (ks & 1) * 65536, jx = jc << 4;
            v4u xn[4];
            const int kn = (ks + 1 < 32) ? ks + 1 : ks;
#pragma unroll
            for (int a = 0; a < 4; ++a) xn[a] = XA(a)[(size_t)kn * T * 4];
            if (ks + 1 < 32) peer_dma(F, gsl0 + (size_t)kn * NEXP * 32, bo ^ 65536);
#define URD(B, arr, g) { asm volatile("" : "+v"(arr[g])); B[0] = *(const LAS v4u*)(F.lds + bo + (dppq<0>(arr[g]) ^ jx)); B[1] = *(const LAS v4u*)(F.lds + bo + (dppq<1>(arr[g]) ^ jx)); \
                B[2] = *(const LAS v4u*)(F.lds + bo + (dppq<2>(arr[g]) ^ jx)); B[3] = *(const LAS v4u*)(F.lds + bo + (dppq<3>(arr[g]) ^ jx)); }
#define UCP(B, acc, a, g) { _Pragma("unroll") for (int q = 0; q < 4; ++q) { int p0 = acc[4 * (g) + q]; \
                p0 = sdot4(B[q].x, xs[a].x, p0); p0 = sdot4(B[q].y, xs[a].y, p0); p0 = sdot4(B[q].z, xs[a].z, p0); p0 = sdot4(B[q].w, xs[a].w, p0); acc[4 * (g) + q] = p0; } }
            { v4u BE[4], BO[4];
              URD(BE, ro0, 0) __builtin_amdgcn_sched_barrier(0);
              URD(BO, ro0, 1) UCP(BE, ac0, 0, 0)
              __builtin_amdgcn_sched_barrier(0);
              URD(BE, ro0, 2) UCP(BO, ac0, 0, 1)
              __builtin_amdgcn_sched_barrier(0);
              URD(BO, ro0, 3) UCP(BE, ac0, 0, 2)
              __builtin_amdgcn_sched_barrier(0);
              URD(BE, ro0, 4) UCP(BO, ac0, 0, 3)
              __builtin_amdgcn_sched_barrier(0);
              URD(BO, ro0, 5) UCP(BE, ac0, 0, 4)
              __builtin_amdgcn_sched_barrier(0);
              URD(BE, ro1, 0) UCP(BO, ac0, 0, 5)
              __builtin_amdgcn_sched_barrier(0);
              URD(BO, ro1, 1) UCP(BE, ac1, 1, 0)
              __builtin_amdgcn_sched_barrier(0);
              URD(BE, ro1, 2) UCP(BO, ac1, 1, 1)
              __builtin_amdgcn_sched_barrier(0);
              URD(BO, ro2, 0) UCP(BE, ac1, 1, 2)
              __builtin_amdgcn_sched_barrier(0);
              URD(BE, ro2, 1) UCP(BO, ac2, 2, 0)
              __builtin_amdgcn_sched_barrier(0);
              URD(BO, ro2, 2) UCP(BE, ac2, 2, 1)
              __builtin_amdgcn_sched_barrier(0);
              URD(BE, ro3, 0) UCP(BO, ac2, 2, 2)
              __builtin_amdgcn_sched_barrier(0);
              URD(BO, ro3, 1) UCP(BE, ac3, 3, 0)
              __builtin_amdgcn_sched_barrier(0);
              UCP(BO, ac3, 3, 1) }
#undef URD
#undef UCP
#pragma unroll
            for (int a = 0; a < 4; ++a) xs[a] = xn[a];
            VM_WAIT(); __syncthreads();
        }
        float gt0[UCAP0 / 4], gt1[UCAP1 / 4], gt2[UCAP2 / 4], gt3[UCAP3 / 4];
        float sq0[UCAP0 / 4], sq1[UCAP1 / 4], sq2[UCAP2 / 4], sq3[UCAP3 / 4];
#define UGT(gt, sq, arr, a, CAP) { const float* gp_ = SGATE + (tbase + tl[a]) * 128; const float sx_ = SX[tbase + tl[a]]; _Pragma("unroll") for (int i = 0; i < CAP / 4; ++i) { gt[i] = gp_[min(glo[a] + 4 * i + jc, 127)]; sq[i] = sx_ * SU[er * 1024 + (int)(arr[i] >> 6)]; } }
        UGT(gt0, sq0, ro0, 0, UCAP0) UGT(gt1, sq1, ro1, 1, UCAP1) UGT(gt2, sq2, ro2, 2, UCAP2) UGT(gt3, sq3, ro3, 3, UCAP3)
#undef UGT
#define UOUT(arr, acc, gt, sq, a, CAP) { const size_t tk = tbase + tl[a]; _Pragma("unroll") for (int s = 0; s < CAP; ++s) { const int toti = quad_sum_i(acc[s]); \
            if ((s & 3) == jc && s < NSLOT) { unsigned wv = 0u; if (s < gcnt[a]) { const float av = gelu_tanh((float)toti * sq[s >> 2]) * gt[s >> 2]; wv = (arr[s >> 2] << 16) | (cvt_pk_f16(av, 0.f) & 0xffffu); } \
                PACK2[(tk * 16 + er) * NSLOT + s] = wv; } } \
            _Pragma("unroll") for (int s = CAP; s < NSLOT; ++s) if ((s & 3) == jc && s >= gcnt[a]) PACK2[(tk * 16 + er) * NSLOT + s] = 0u; }
        UOUT(ro0, ac0, gt0, sq0, 0, UCAP0) UOUT(ro1, ac1, gt1, sq1, 1, UCAP1) UOUT(ro2, ac2, gt2, sq2, 2, UCAP2) UOUT(ro3, ac3, gt3, sq3, 3, UCAP3)
#undef UOUT
#undef XA
        { int myrank = 0; const int mykey = (cnt << 6) | (63 - F.lane);
          for (int p = 0; p < 64; ++p) myrank += (__shfl(key, p) > mykey) ? 1 : 0;
          const int cap = myrank < 16 ? UCAP0 : (myrank < 32 ? UCAP1 : (myrank < 48 ? UCAP2 : UCAP3));
          const v4u* xsp = (const v4u*)(XBS + t * 32);
          for (int s = cap; s < cnt; ++s) {
              const int pos = lo + s, e = SEID[t * LP + pos]; const int f = (e >> 2) & 3; int di = 0;
              for (int ks = 0; ks < 32; ++ks)
#pragma unroll
                  for (int j = 0; j < 4; ++j) { const v4u u4 = *(const v4u*)(TU + (((size_t)ks * NEXP + e) * 4 + (j ^ f)) * 8); const v4u x4 = xsp[(size_t)ks * T * 4 + j];
                      di = sdot4(u4.x, x4.x, di); di = sdot4(u4.y, x4.y, di); di = sdot4(u4.z, x4.z, di); di = sdot4(u4.w, x4.w, di); }
              const float d = (float)di * SX[t] * SU[e];
              const int row = e & 1023;
              const unsigned wv = ((unsigned)((row << 6) + (((row >> 2) & 3) << 4)) << 16) | (cvt_pk_f16(gelu_tanh(d) * SGATE[t * 128 + pos], 0.f) & 0xffffu);
              if (s < NSLOT) PACK2[(t * 16 + er) * NSLOT + s] = wv; else PACK[t * LP + pos] = wv; }
        }
    }
}
#ifndef VBLK
#define VBLK 2
#endif
#if VBLK == 4
#define VTT(x, j) (4 * ((x) & 3) + ((j) & 3))
#define VDS(x, j, it) (32 * ((x) >> 2) + 8 * (it) + ((j) >> 2))
#elif VBLK == 8
#define VTT(x, j) (8 * ((x) & 1) + ((j) & 7))
#define VDS(x, j, it) (16 * ((x) >> 1) + 4 * (it) + ((j) >> 3))
#elif VBLK == 2
#define VTT(x, j) (2 * (x) + ((j) & 1))
#define VDS(x, j, it) (16 * (it) + ((j) >> 1))
#else
#define VTT(x, j) ((j) & 15)
#define VDS(x, j, it) (((x) * 32 + (j) + 256 * (it)) >> 4)
#endif
__device__ __forceinline__ void phase_peer_v(const Frame& F0, int l) {
    Frame F = F0; F.tid = F.wave * 64 + lane_id(); asm volatile("" : "+v"(F.tid)); F.lane = F.tid & 63;
    unsigned char* ws = opqg(F.ws);
    const bf16* TV = (const bf16*)(ws + WS_TBV) + (size_t)l * 64 * NEXP * 32; const bf16* XS = (const bf16*)(ws + WS_XH); bf16* RS = (bf16*)(ws + WS_RH);
    const unsigned* PACK = (const unsigned*)(ws + WS_PACK); const unsigned char* START = ws + WS_START; const unsigned* PACK2 = (const unsigned*)(ws + WS_PACK2);
    for (int it = 0; it * F.G + F.vcu < 1024; ++it) {
        int tt, ds;
        if (F.G == 256) { const int x = F.vcu >> 5, j = F.vcu & 31; tt = VTT(x, j); ds = VDS(x, j, it); }
        else { const int unit = it * F.G + F.vcu; tt = unit & 15; ds = unit >> 4; }
        const size_t t = (size_t)tt * 512 + F.tid;
        const v4u st4 = *(const v4u*)(START + t * 16);
        const unsigned stw[4] = {st4.x, st4.y, st4.z, st4.w};
        unsigned acc[16];
#pragma unroll
        for (int i = 0; i < 16; ++i) acc[i] = 0u;
        const bf16* gsl0 = TV + (size_t)ds * NEXP * 32;
        unsigned Lc[NSLOT];
        { const v4u* lp = (const v4u*)(PACK2 + t * 16 * NSLOT);
#pragma unroll
          for (int s = 0; s < NSLOT / 4; ++s) { const v4u q = lp[s]; Lc[4 * s] = q.x; Lc[4 * s + 1] = q.y; Lc[4 * s + 2] = q.z; Lc[4 * s + 3] = q.w; } }
        peer_dma(F, gsl0, 0);
        VM_WAIT(); __syncthreads();
#pragma unroll 1
        for (int c = 0; c < 16; ++c) {
            const int bo = (c & 1) * 65536;
            const int q0 = c >> 2, q1 = (c + 1) >> 2;
            const unsigned w0 = q0 == 0 ? stw[0] : (q0 == 1 ? stw[1] : (q0 == 2 ? stw[2] : stw[3])), w1 = q1 == 0 ? stw[0] : (q1 == 1 ? stw[1] : (q1 == 2 ? stw[2] : stw[3]));
            const int s_c = (int)((w0 >> ((c & 3) * 8)) & 255u);
            const int s_n = (c < 15) ? (int)((w1 >> (((c + 1) & 3) * 8)) & 255u) : 128;
            const int n_c = s_n - s_c;
            unsigned Ln[NSLOT];
            const int cn = (c < 15) ? c + 1 : c;
            { const v4u* lp = (const v4u*)(PACK2 + (t * 16 + cn) * NSLOT);
#pragma unroll
              for (int s = 0; s < NSLOT / 4; ++s) { const v4u q = lp[s]; Ln[4 * s] = q.x; Ln[4 * s + 1] = q.y; Ln[4 * s + 2] = q.z; Ln[4 * s + 3] = q.w; } }
            if (c < 15) peer_dma(F, gsl0 + (size_t)cn * 1024 * 32, bo ^ 65536);
            const int wmax = wave_max_i(min(n_c, NSLOT));
#pragma unroll
            for (int g = 0; g < NSLOT / 2; ++g) {
                if (2 * g < wmax) {
                    v4u v4[2][4]; unsigned a2[2];
#pragma unroll
                    for (int q = 0; q < 2; ++q) { const int s = 2 * g + q; const unsigned w = Lc[s];
                        a2[q] = __builtin_amdgcn_perm(w, w, 0x01000100u);
                        const int a0 = bo + (int)((w >> 16) & 0xfff0u);
#pragma unroll
                        for (int j = 0; j < 4; ++j) v4[q][j] = *(const LAS v4u*)(F.lds + (a0 ^ (j << 4))); }
#pragma unroll
                    for (int q = 0; q < 2; ++q)
#pragma unroll
                        for (int j = 0; j < 4; ++j) {
                            acc[4 * j + 0] = pkfmah(v4[q][j].x, a2[q], acc[4 * j + 0]); acc[4 * j + 1] = pkfmah(v4[q][j].y, a2[q], acc[4 * j + 1]);
                            acc[4 * j + 2] = pkfmah(v4[q][j].z, a2[q], acc[4 * j + 2]); acc[4 * j + 3] = pkfmah(v4[q][j].w, a2[q], acc[4 * j + 3]); }
                }
            }
            for (int s = NSLOT; s < n_c; ++s) {
                const unsigned w = PACK[t * LP + s_c + s]; const unsigned a2 = (w & 0xffffu) | (w << 16);
                const int a0 = bo + (int)((w >> 16) & 0xfff0u);
#pragma unroll
                for (int j = 0; j < 4; ++j) { const v4u v4 = *(const LAS v4u*)(F.lds + (a0 ^ (j << 4)));
                    acc[4 * j + 0] = pkfmah(v4.x, a2, acc[4 * j + 0]); acc[4 * j + 1] = pkfmah(v4.y, a2, acc[4 * j + 1]);
                    acc[4 * j + 2] = pkfmah(v4.z, a2, acc[4 * j + 2]); acc[4 * j + 3] = pkfmah(v4.w, a2, acc[4 * j + 3]); }
            }
            VM_WAIT(); __syncthreads();
#pragma unroll
            for (int s = 0; s < NSLOT; ++s) Lc[s] = Ln[s];
        }
        const v4u* xp = (const v4u*)(XS + ((size_t)ds * T + t) * 32); v4u* rp = (v4u*)(RS + ((size_t)ds * T + t) * 32);
        v4u xw4[4];
#pragma unroll
        for (int j = 0; j < 4; ++j) xw4[j] = xp[j];
#pragma unroll
        for (int j = 0; j < 4; ++j) { const v4u xw = xw4[j]; const unsigned xx[4] = {xw.x, xw.y, xw.z, xw.w}; unsigned o[4];
#pragma unroll
            for (int k = 0; k < 4; ++k) { const h2_t xv = __builtin_bit_cast(h2_t, xx[k]), yv = __builtin_bit_cast(h2_t, acc[4 * j + k]);
                o[k] = cvt_pk_f16((float)xv.x * ALPHA + (float)yv.x, (float)xv.y * ALPHA + (float)yv.y); }
            rp[j] = (v4u){o[0], o[1], o[2], o[3]}; }
    }
}

constexpr int PH_PER_LAYER = 13, N_PHASES = 2 + DEPTH * PH_PER_LAYER;
__global__ void __launch_bounds__(512, 2) fwd_kernel(Args args) {
    extern __shared__ __attribute__((aligned(16))) unsigned char lds[];
    Frame F;
    F.lds = (LAS unsigned char*)lds;
    F.wave = __builtin_amdgcn_readfirstlane((int)threadIdx.x >> 6); F.tid = 0; F.lane = 0;
    F.G = gridDim.x; { const int bx = blockIdx.x; F.vcu = (F.G % 8 == 0) ? (bx % 8) * (F.G / 8) + bx / 8 : bx; }
    F.ws = args.ws; F.ka = (const __attribute__((address_space(4))) Args*)__builtin_amdgcn_kernarg_segment_ptr();
    unsigned char* ws = args.ws;
    for (int u = F.wave * 64 + lane_id(); u < (LDS_BYTES - LDSCTL_OFF) / 4; u += 512) ((LAS unsigned*)(F.lds + LDSCTL_OFF))[u] = 0u;
    __syncthreads();
    XcdBarrier bar; bar.bar = (unsigned*)(ws + WS_CTL) + CW_BAR; bar.x = 0; bar.st = nullptr;
    const int lo = args.ph_lo, hi = args.ph_hi;
    if (hi - lo > 1) bar = xcd_barrier_post((unsigned*)(ws + WS_CTL) + CW_BAR, (volatile LAS unsigned*)(F.lds + MISC_OFF) + 8, F.wave == 0 && lane_id() == 0);
#ifndef PHMASK
#define PHMASK 0xFFF
#endif
#define EN(i) ((PHMASK >> (i)) & 1)
#ifndef RPT
#define RPT 0
#endif
#define REP(i) for (int _r = 0; _r <= ((RPT >> (i)) & 1); ++_r)
#define IN(k) (lo <= (k) && (k) < hi)
#define SEAM(k) do { if (IN((k) + 1)) xcd_barrier(bar, F.wave); } while (0)

    if (EN(10) && IN(0)) { REP(13) { phase_prologue_a(F); } SEAM(0); }
    if (EN(11) && IN(1)) REP(14) {
        phase_prologue_b(F);
        unsigned char* ws = opqg(args.ws);
        int kc = 256; asm volatile("" : "+s"(kc));
        pg8::Gemm g{(const bf16*)(ws + WS_BK), (const bf16*)(ws + WS_WQB), DEPTH * 2048, 2048, kc, 256, 2048, 256, (long)2048 * 2048};
        pg8::StaticOrder S; S.init(DEPTH * 2048, 2048, F.G, (int)blockIdx.x);
        pg8::EpiF16 E{(bf16*)(ws + WS_WPQ), 2048};
        pg8::gemm_phase<pg8::EpiF16, pg8::StaticOrder, true>(F.lds, g, S, E, F.wave);
        if (_r == ((RPT >> 14) & 1)) SEAM(1);
    }
    for (int l = 0; l < DEPTH; ++l) {
        const int pb = 2 + l * PH_PER_LAYER;
        if (EN(0) && IN(pb + 0)) REP(0) {
            unsigned char* ws = opqg(args.ws);
            pg8::Gemm g{(const bf16*)(ws + WS_XH), (const bf16*)(ws + WS_WIN) + (size_t)l * NIN * D, T, NIN, D, T, D, 0, 0};
            pg8::StaticOrder S; S.init(T, (F.G == 256) ? 32 * 256 : NIN, F.G, (int)blockIdx.x);
            pg8::EpiIn E{(bf16*)(ws + WS_Q), (bf16*)(ws + WS_KK), (bf16*)(ws + WS_V), (bf16*)(ws + WS_SG), (bf16*)(ws + WS_UB), (bf16*)(ws + WS_GR), (bf16*)(ws + WS_GB),
                         (float*)(ws + WS_LOGF), (const float*)(ws + WS_LB) + l * AW};
            pg8::gemm_phase<pg8::EpiIn, pg8::StaticOrder, true, true, true>(F.lds, g, S, E, F.wave);
            if (_r == ((RPT >> 0) & 1)) SEAM(pb + 0);
        }
        if (EN(1) && IN(pb + 1)) { REP(1) { REP(17) { phase_hgrn_local(F, l); } REP(18) { phase_s5_local(F, l); } } if (l == 0) phase_quant_wpq(F); SEAM(pb + 1); }
        if (EN(2) && IN(pb + 2)) { REP(2) { phase_scan(F, l); } SEAM(pb + 2); }
        if (EN(3) && IN(pb + 3)) { REP(3) { REP(15) { phase_hgrn_out(F, l); } REP(16) { phase_s5_out(F, l); } } SEAM(pb + 3); }
        if (EN(4) && IN(pb + 4)) REP(4) {
            unsigned char* ws = opqg(args.ws);
            if (F.G == 256 && blockIdx.x < 128) {
                pg8::Gemm g{(const bf16*)(ws + WS_XH), (const bf16*)(ws + WS_WIN) + (size_t)l * NIN * D, T, NIN, D, T, D, 0, 0};
                pg8::OffOrder S; S.init(T, 4 * 256, F.G, (int)blockIdx.x, 32);
                pg8::EpiIn E{(bf16*)(ws + WS_Q), (bf16*)(ws + WS_KK), (bf16*)(ws + WS_V), (bf16*)(ws + WS_SG), (bf16*)(ws + WS_UB), (bf16*)(ws + WS_GR), (bf16*)(ws + WS_GB),
                             (float*)(ws + WS_LOGF), (const float*)(ws + WS_LB) + l * AW};
                pg8::gemm_phase<pg8::EpiIn, pg8::OffOrder, true, true, true>(F.lds, g, S, E, F.wave);
            } else {
                pg8::Gemm g{(const bf16*)(ws + WS_YB), (const bf16*)(ws + WS_WGLU) + (size_t)l * 2048 * 1024, T, 2048, 1024, 1024, 1024, 0, 0};
                pg8::EpiGlu E{(bf16*)(ws + WS_OAB) + 1024, 2048};
                if (F.G == 256) { pg8::PairOrder S{(int)blockIdx.x, 128, 8, 256}; pg8::gemm_phase<pg8::EpiGlu, pg8::PairOrder, true>(F.lds, g, S, E, F.wave); }
                else { pg8::StaticOrder S; S.init(T, 2048, F.G, (int)blockIdx.x); pg8::gemm_phase<pg8::EpiGlu, pg8::StaticOrder, true>(F.lds, g, S, E, F.wave); }
            }
            if (_r == ((RPT >> 4) & 1)) SEAM(pb + 4);
        }
        if (EN(5) && IN(pb + 5)) REP(5) {
            unsigned char* ws = opqg(args.ws);
            pg8::Gemm g{(const bf16*)(ws + WS_OAB), (const bf16*)(ws + WS_WUP) + (size_t)l * 2048 * 2048, T, 2048, 2048, 2048, 2048, 0, 0};
            pg8::StaticOrder S; S.init(T, 2048, F.G, (int)blockIdx.x);
            pg8::EpiUp E{(bf16*)(ws + WS_MG), (const bf16*)(ws + WS_GR), (const bf16*)(ws + WS_GB)};
            pg8::gemm_phase<pg8::EpiUp, pg8::StaticOrder, true>(F.lds, g, S, E, F.wave);
            if (_r == ((RPT >> 5) & 1)) SEAM(pb + 5);
        }
        if (EN(6) && IN(pb + 6)) REP(6) {
            unsigned char* ws = opqg(args.ws);
            pg8::Gemm g{(const bf16*)(ws + WS_MG), (const bf16*)(ws + WS_WO) + (size_t)l * 2048 * 2048, T, 2048, 2048, 2048, 2048, 0, 0};
            pg8::StaticOrder S; S.init(T, 2048, F.G, (int)blockIdx.x);
            pg8::EpiResH E{(bf16*)(ws + WS_RH), (const bf16*)(ws + WS_XH)};
            pg8::gemm_phase<pg8::EpiResH, pg8::StaticOrder, true>(F.lds, g, S, E, F.wave);
            if (_r == ((RPT >> 6) & 1)) SEAM(pb + 6);
        }
        if (EN(7) && IN(pb + 7)) { REP(7) { phase_ln(F, l, 0); } SEAM(pb + 7); }
        if (EN(8) && IN(pb + 8)) REP(8) {
            unsigned char* ws = opqg(args.ws);
            pg8::Gemm g{(const bf16*)(ws + WS_XQ), (const bf16*)(ws + WS_WP8) + (size_t)l * 2048 * 1024, T, 2048, 1024, T, 1024, 0, 0};
            pg8::StaticOrder S; S.init(T, 2048, F.G, (int)blockIdx.x);
            pg8::EpiSc8 E{(bf16*)(ws + WS_SC), (const float*)(ws + WS_SX), (const float*)(ws + WS_SW) + l * 2048};
            pg8::gemm_phase<pg8::EpiSc8, pg8::StaticOrder, true, false, true, true>(F.lds, g, S, E, F.wave);
            if (_r == ((RPT >> 8) & 1)) SEAM(pb + 8);
        }
        if (EN(9) && IN(pb + 9)) { REP(9) { phase_topk(F, l); } SEAM(pb + 9); }
        if (EN(9) && IN(pb + 10)) { REP(10) { phase_peer_u(F, l); } SEAM(pb + 10); }
        if (EN(9) && IN(pb + 11)) { REP(11) { phase_peer_v(F, l); } SEAM(pb + 11); }
        if (EN(9) && IN(pb + 12)) { REP(12) { phase_ln(F, l, 1); } SEAM(pb + 12); }
    }
#undef IN
#undef SEAM
}

extern "C" void kernel_launch(void* const* d_in, const int* in_sizes, int n_in, void* d_out, int out_size, void* d_ws, size_t ws_size, hipStream_t stream) {
    static int grid = 0;
    if (grid == 0) {
        if (n_in != 24 || out_size != T * D || ws_size < WS_END) { fprintf(stderr, "kernel_launch: unexpected sizes (n_in %d out %d ws %zu need %zu)\n", n_in, out_size, ws_size, (size_t)WS_END); grid = -1; return; }
        int dev = 0, cus = 0, per_cu = 0;
        if (hipGetDevice(&dev) != hipSuccess || hipDeviceGetAttribute(&cus, hipDeviceAttributeMultiprocessorCount, dev) != hipSuccess) { grid = -1; return; }
        if (hipFuncSetAttribute((const void*)fwd_kernel, hipFuncAttributeMaxDynamicSharedMemorySize, LDS_BYTES) != hipSuccess) { fprintf(stderr, "kernel_launch: hipFuncSetAttribute failed\n"); grid = -1; return; }
        if (hipOccupancyMaxActiveBlocksPerMultiprocessor(&per_cu, (const void*)fwd_kernel, 512, LDS_BYTES) != hipSuccess || per_cu < 1)
            fprintf(stderr, "kernel_launch: occupancy query reports %d\n", per_cu);
        (void)hipGetLastError();
        grid = cus;
    }
    if (grid < 0) return;
    if (hipMemsetAsync((char*)d_ws + WS_CTL, 0, CTL_ZERO_BYTES, stream) != hipSuccess) return;
    Args a{};
    for (int i = 0; i < 24; ++i) a.in[i] = (const float*)d_in[i];
    a.out = (float*)d_out; a.ws = (unsigned char*)d_ws;
#if ONE_LAUNCH
    a.ph_lo = 0; a.ph_hi = N_PHASES;
    hipLaunchKernelGGL(fwd_kernel, dim3(grid), dim3(512), LDS_BYTES, stream, a);
#else
    for (int p = 0; p < N_PHASES; ++p) { a.ph_lo = p; a.ph_hi = p + 1; hipLaunchKernelGGL(fwd_kernel, dim3(grid), dim3(512), LDS_BYTES, stream, a); }
#endif
}
```

```cpp
#include <hip/hip_runtime.h>
#include <cstdio>
#include <cstdint>

#define LAS __attribute__((address_space(3)))
#define GAS __attribute__((address_space(1)))
typedef unsigned short bf16;
typedef unsigned v4u __attribute__((ext_vector_type(4)));
typedef unsigned v2u __attribute__((ext_vector_type(2)));
typedef float f32x4 __attribute__((ext_vector_type(4)));
typedef float f32x2 __attribute__((ext_vector_type(2)));
typedef short bf16x8 __attribute__((ext_vector_type(8)));
typedef short s16x4 __attribute__((ext_vector_type(4)));

#ifndef ONE_LAUNCH
#define ONE_LAUNCH 1
#endif

constexpr int T = 8192, D = 2048, DEPTH = 4, NIN = 9216;
constexpr int AW = 1024;
constexpr int NCH = 128;
constexpr float ALPHA = 1.6817928305074290f;
constexpr float LN_EPS = 1e-5f, RMS_EPS = 1e-6f;
constexpr int NEXP = 16384;
constexpr int LP = 160;
constexpr int NSLOT = 24;

constexpr size_t MiB = 1u << 20;
constexpr size_t WS_CTL = 0, CTL_ZERO_BYTES = 32768;
constexpr size_t WS_WIN  = 1 * MiB;
constexpr size_t WS_WGLU = WS_WIN + 144 * MiB;
constexpr size_t WS_WUP  = WS_WGLU + 16 * MiB;
constexpr size_t WS_WO   = WS_WUP + 32 * MiB;
constexpr size_t WS_WQB  = WS_WO + 32 * MiB;
constexpr size_t WS_BK   = WS_WQB + 32 * MiB;
constexpr size_t WS_WPQ  = WS_BK + 4 * MiB;
constexpr size_t WS_LB   = WS_WPQ + 32 * MiB;
constexpr size_t WS_APOW = WS_LB + 1 * MiB;
constexpr size_t WS_BB   = WS_APOW + 9 * MiB;
constexpr size_t WS_KMAT = WS_BB + 2 * MiB;
constexpr size_t WS_PM   = WS_KMAT + 9 * MiB;
constexpr size_t WS_E    = WS_PM + 64 * MiB;
constexpr size_t WS_X32  = WS_E + 64 * MiB;
constexpr size_t WS_X1   = WS_X32 + 64 * MiB;
constexpr size_t WS_XB   = WS_X1 + 64 * MiB;
constexpr size_t WS_Q    = WS_XB + 32 * MiB;
constexpr size_t WS_KK   = WS_Q + 16 * MiB;
constexpr size_t WS_V    = WS_KK + 16 * MiB;
constexpr size_t WS_SG   = WS_V + 16 * MiB;
constexpr size_t WS_UB   = WS_SG + 16 * MiB;
constexpr size_t WS_LOGF = WS_UB + 16 * MiB;
constexpr size_t WS_GR   = WS_LOGF + 32 * MiB;
constexpr size_t WS_GB   = WS_GR + 32 * MiB;
constexpr size_t WS_U    = WS_GB + 32 * MiB;
constexpr size_t WS_SP   = WS_U + 64 * MiB;
constexpr size_t WS_BL   = WS_SP + 32 * MiB;
constexpr size_t WS_XLOC = WS_BL + 1 * MiB;
constexpr size_t WS_XS   = WS_XLOC + 4 * MiB;
constexpr size_t WS_OAB  = WS_XS + 4 * MiB;
constexpr size_t WS_YB   = WS_OAB + 32 * MiB;
constexpr size_t WS_MG   = WS_YB + 16 * MiB;
constexpr size_t WS_R    = WS_MG + 32 * MiB;
constexpr size_t WS_SC   = WS_R + 64 * MiB;
constexpr size_t WS_TBU  = WS_SC + 64 * MiB;
constexpr size_t WS_TBV  = WS_TBU + 256 * MiB;
constexpr size_t WS_SEID = WS_TBV + 256 * MiB;
constexpr size_t WS_SGATE= WS_SEID + 6 * MiB;
constexpr size_t WS_PACK = WS_SGATE + 4 * MiB;
constexpr size_t WS_START= WS_PACK + 6 * MiB;
constexpr size_t WS_PACK2= WS_START + 1 * MiB;
constexpr size_t WS_XBS  = WS_PACK2 + 13 * MiB;
constexpr size_t WS_END  = WS_XBS + 32 * MiB;
constexpr size_t WS_XH = WS_XBS;
constexpr size_t WS_XQ = WS_X1;
constexpr size_t WS_SX = WS_X1 + 16 * MiB;
constexpr size_t WS_SU = WS_X1 + 17 * MiB;
constexpr size_t WS_SW = WS_X1 + 18 * MiB;
constexpr size_t WS_WP8 = WS_WQB;
constexpr size_t WS_WG8 = WS_X32;
constexpr size_t WS_SWG = WS_X1 + 19 * MiB;
constexpr size_t WS_RH = WS_R;

constexpr int CW_TMO = 0, CW_CODE = 1;
constexpr int CW_BAR = 4096;

constexpr int RING_BYTES = 131072;
constexpr int LDSCTL_OFF = RING_BYTES, MISC_OFF = LDSCTL_OFF + 320;
constexpr int LDS_BYTES = 147456;

#define LDS_WAIT() asm volatile("s_waitcnt lgkmcnt(0)" ::: "memory")
#define VM_WAIT() asm volatile("s_waitcnt vmcnt(0)" ::: "memory")
__device__ __forceinline__ unsigned cvt_pk_bf16(float lo, float hi) { unsigned r; asm volatile("v_cvt_pk_bf16_f32 %0, %1, %2" : "=v"(r) : "v"(lo), "v"(hi)); return r; }
typedef _Float16 h2_t __attribute__((ext_vector_type(2)));
__device__ __forceinline__ unsigned cvt_pk_f16a(float lo, float hi) { unsigned r; asm volatile("v_cvt_pk_f16_f32 %0, %1, %2" : "=v"(r) : "v"(lo), "v"(hi)); return r; }
__device__ __forceinline__ unsigned cvt_pk_f16(float lo, float hi) { h2_t p; p.x = (_Float16)lo; p.y = (_Float16)hi; return __builtin_bit_cast(unsigned, p); }
__device__ __forceinline__ float dot2h(unsigned a, unsigned b, float c) { return __builtin_amdgcn_fdot2(__builtin_bit_cast(h2_t, a), __builtin_bit_cast(h2_t, b), c, false); }
__device__ __forceinline__ unsigned pkfmah(unsigned a, unsigned b, unsigned c) { return __builtin_bit_cast(unsigned, __builtin_elementwise_fma(__builtin_bit_cast(h2_t, a), __builtin_bit_cast(h2_t, b), __builtin_bit_cast(h2_t, c))); }
__device__ __forceinline__ float bf_lo(unsigned u) { return __uint_as_float(u << 16); }
__device__ __forceinline__ float bf_hi(unsigned u) { return __uint_as_float(u & 0xffff0000u); }
__device__ __forceinline__ float bf2f(bf16 b) { return __uint_as_float(((unsigned)b) << 16); }
__device__ __forceinline__ bf16 f2bf(float f) { return (bf16)(cvt_pk_bf16(f, 0.f) & 0xffffu); }
__device__ __forceinline__ float fexp(float x) { return __builtin_amdgcn_exp2f(x * 1.4426950408889634f); }
__device__ __forceinline__ float flog(float x) { return __builtin_amdgcn_logf(x) * 0.6931471805599453f; }
__device__ __forceinline__ float frcp(float x) { return __builtin_amdgcn_rcpf(x); }
__device__ __forceinline__ float gelu_tanh(float x) {
    const float u = 1.5957691216057308f * (x + 0.044715f * x * x * x);
    const float uc = fminf(fmaxf(u, -60.f), 60.f);
    return x * frcp(1.f + fexp(-uc));
}
__device__ __forceinline__ int lane_id() { int r; asm volatile("v_mbcnt_lo_u32_b32 %0, -1, 0\n\tv_mbcnt_hi_u32_b32 %0, -1, %0" : "=v"(r)); return r; }
__device__ __forceinline__ float wave_sum(float v) {
#pragma unroll
    for (int o = 1; o < 64; o <<= 1) v += __shfl_xor(v, o);
    return v;
}

__device__ __forceinline__ void vlaunder(int& a, int& b) { asm volatile("" : "+v"(a), "+v"(b)); }
template <class P> __device__ __forceinline__ P* opq(P* p) { asm volatile("" : "+s"(p)); return p; }
__device__ __forceinline__ unsigned char* opqg(unsigned char* p) { GAS unsigned char* g = (GAS unsigned char*)p; asm volatile("" : "+s"(g)); return (unsigned char*)g; }
#define GP(T, p) ((T*)(GAS T*)(p))

namespace pg8 {
#define PG8_LAS __attribute__((address_space(3)))
typedef unsigned short bf16_t;
constexpr int BM = 256, BK = 64, HALF = 128, HTB = HALF * BK * 2, STAGE_BYTES = 8 * HTB, NXCD = 8, WGM = 8;

__host__ __device__ __forceinline__ int lds_byte(int r, int c) { const int st = (r >> 4) * 2 + (c >> 5), rr = r & 15, cc = c & 31, ob = rr * 64 + cc * 2; return st * 1024 + (ob ^ (((ob >> 9) & 1) << 5)); }
__host__ __device__ __forceinline__ void stage_rc(int b, int& R, int& C) { const int st = b / 1024, sb = b % 1024, swz = sb ^ (((sb >> 9) & 1) << 5); R = (st >> 1) * 16 + swz / 64; C = (st & 1) * 32 + (swz % 64) / 2; }
__host__ __device__ __forceinline__ int perm32(int rho) { const int n = rho >> 4, i = rho & 15; return 8 * (i >> 2) + 4 * n + (i & 3); }

struct Unit { int pm, pn; };
struct Gemm { const bf16_t* A; const bf16_t* Bt; int M, N, K, lda, ldb, bkoff; long blstride; };

struct StaticOrder {
    int nM, nN, nwg, G, c;
    __host__ __device__ void init(int M, int N, int G_, int c_) { nM = M / BM; nN = N / BM; nwg = nM * nN; G = G_; c = c_; }
    __host__ __device__ bool next(int i, Unit& u) const {
        const long L = (long)i * G + c; if (L >= nwg) return false;
        int wgid = (int)L; { const int q = nwg / NXCD, r = nwg % NXCD, xcd = wgid % NXCD, off = wgid / NXCD; wgid = (xcd < r ? xcd * (q + 1) : r * (q + 1) + (xcd - r) * q) + off; }
        const int nig = WGM * nN, gid = wgid / nig, fm = gid * WGM, gsz = (nM - fm) < WGM ? (nM - fm) : WGM;
        u.pm = fm + ((wgid % nig) % gsz); u.pn = (wgid % nig) / gsz; return true;
    }
    __device__ __forceinline__ void a_ready(const Unit&) const {}
    __device__ __forceinline__ void done(const Unit&) const {}
};

struct OffOrder {
    StaticOrder b; int pn0;
    __device__ void init(int M, int N, int G_, int c_, int pn0_) { b.init(M, N, G_, c_); pn0 = pn0_; }
    __device__ bool next(int i, Unit& u) const { if (!b.next(i, u)) return false; u.pn += pn0; return true; }
    __device__ __forceinline__ void a_ready(const Unit&) const {}
    __device__ __forceinline__ void done(const Unit&) const {}
};
struct ListOrder {
    int base, cnt, x, pn0;
    __device__ bool next(int i, Unit& u) const { if (i >= cnt) return false; const int id = base + i; u.pm = 4 * x + (id & 3); u.pn = pn0 + (id >> 2); return true; }
    __device__ __forceinline__ void a_ready(const Unit&) const {}
    __device__ __forceinline__ void done(const Unit&) const {}
};
struct PairOrder {
    int c, c0, nN, nwg;
    __device__ bool next(int i, Unit& u) const { if (c < c0 || i >= 2) return false; const int id = (c - c0) * 2 + i; if (id >= nwg) return false; u.pm = id / nN; u.pn = id % nN; return true; }
    __device__ __forceinline__ void a_ready(const Unit&) const {}
    __device__ __forceinline__ void done(const Unit&) const {}
};
typedef f32x4 Acc[2][2][4][2];

typedef _Float16 f16x8 __attribute__((ext_vector_type(8)));
typedef int i32x4 __attribute__((ext_vector_type(4)));
template <class Epi, class Sched, bool ALIGN_EPI = false, bool F16 = false, bool ASL = false, bool I8 = false>
__device__ __forceinline__ void gemm_phase(PG8_LAS unsigned char* lds, const Gemm g, const Sched& S, const Epi& E, int wv) {
    int tid_ = wv * 64 + lane_id(); asm volatile("" : "+v"(tid_));
    const int tid = tid_, wid = __builtin_amdgcn_readfirstlane(tid >> 6), lane = tid & 63, wr = wid >> 2, wc = wid & 3, fr = lane & 15, fq = lane >> 4;
    const int K = g.K, nt = K / BK;
    unsigned voffA[2], voffB[2];
#pragma unroll
    for (int i = 0; i < 2; ++i) { int R, C; stage_rc(tid * 16 + i * 8192, R, C); const int Rb = Epi::PERM ? ((R & ~31) + perm32(R & 31)) : R;
        voffA[i] = ASL ? (unsigned)(((C >> 5) * g.lda + R) * 64 + (C & 31) * 2) : (unsigned)(R * g.lda + C) * 2u; voffB[i] = (unsigned)(Rb * g.ldb + C) * 2u; }
    const size_t kstep = (size_t)(BK * 2), kstepA = ASL ? (size_t)g.lda * 128 : (size_t)(BK * 2);
    const size_t hstepA = ASL ? (size_t)HALF * 64 : (size_t)HALF * g.lda * 2, hstepB = (size_t)HALF * g.ldb * 2;
    const size_t tstepA = 2 * hstepA, tstepB = 2 * hstepB;
    const unsigned ldsw = (unsigned)wid * 1024u;
    const int aoff = lds_byte(wr * 64 + fr, fq * 8), boff = lds_byte(wc * 32 + fr, fq * 8);
#define PG8_SA(b, h) (((b) * 2 + (h)) * HTB)
#define PG8_SB(b, h) ((4 + (b) * 2 + (h)) * HTB)
#define PG8_STAGE(bufoff, gbase, voff) do { _Pragma("unroll") for (int _i = 0; _i < 2; ++_i) \
        __builtin_amdgcn_global_load_lds((const unsigned*)((const char*)(gbase) + (voff)[_i]), (PG8_LAS unsigned*)(lds + (bufoff) + ldsw + _i * 8192), 16, 0, 0); } while (0)
#define PG8_LDA(dst, b, h) do { _Pragma("unroll") for (int m = 0; m < 4; ++m) _Pragma("unroll") for (int k = 0; k < 2; ++k) dst[m][k] = *(const PG8_LAS bf16x8*)(lds + PG8_SA(b, h) + aoff + m * 2048 + k * 1024); } while (0)
#define PG8_LDB(dst, b, h) do { _Pragma("unroll") for (int n = 0; n < 2; ++n) _Pragma("unroll") for (int k = 0; k < 2; ++k) dst[n][k] = *(const PG8_LAS bf16x8*)(lds + PG8_SB(b, h) + boff + n * 2048 + k * 1024); } while (0)
#define PG8_MMA(ai, bj, At, Bt) do { __builtin_amdgcn_s_setprio(1); _Pragma("unroll") for (int m = 0; m < 4; ++m) _Pragma("unroll") for (int n = 0; n < 2; ++n) _Pragma("unroll") for (int k = 0; k < 2; ++k) \
        { if constexpr (I8) acc[ai][bj][m][n] = __builtin_bit_cast(f32x4, __builtin_amdgcn_mfma_i32_16x16x64_i8(__builtin_bit_cast(i32x4, Bt[n][k]), __builtin_bit_cast(i32x4, At[m][k]), __builtin_bit_cast(i32x4, acc[ai][bj][m][n]), 0, 0, 0)); \
          else if constexpr (F16) acc[ai][bj][m][n] = __builtin_amdgcn_mfma_f32_16x16x32_f16(__builtin_bit_cast(f16x8, Bt[n][k]), __builtin_bit_cast(f16x8, At[m][k]), acc[ai][bj][m][n], 0, 0, 0); \
          else acc[ai][bj][m][n] = __builtin_amdgcn_mfma_f32_16x16x32_bf16(Bt[n][k], At[m][k], acc[ai][bj][m][n], 0, 0, 0); } __builtin_amdgcn_s_setprio(0); } while (0)
#define PG8_WAIT_V(n) asm volatile("s_waitcnt vmcnt(" #n ")" ::: "memory")
#define PG8_WAIT_L(n) asm volatile("s_waitcnt lgkmcnt(" #n ")" ::: "memory")
#define PG8_BAR __builtin_amdgcn_s_barrier()
#define PG8_SCHED __builtin_amdgcn_sched_barrier(0)
    Unit cur, nxt; int ui = 0;
    if (!S.next(0, cur)) return;
    Acc acc;
#pragma unroll
    for (int a = 0; a < 2; ++a)
#pragma unroll
        for (int b = 0; b < 2; ++b)
#pragma unroll
            for (int m = 0; m < 4; ++m)
#pragma unroll
                for (int n = 0; n < 2; ++n) acc[a][b][m][n] = (f32x4){0.f, 0.f, 0.f, 0.f};
    bf16x8 At[4][2], B0[2][2], B1[2][2];
    const char* cA = (const char*)g.A + (size_t)cur.pm * tstepA;
    const char* cB = (const char*)g.Bt + (size_t)cur.pn * tstepB + ((size_t)(cur.pm & 7) * g.bkoff + (size_t)(cur.pm >> 3) * g.blstride) * 2;
    S.a_ready(cur);
    PG8_STAGE(PG8_SB(0, 0), cB, voffB); PG8_STAGE(PG8_SB(0, 1), cB + hstepB, voffB); PG8_STAGE(PG8_SA(0, 0), cA, voffA); PG8_STAGE(PG8_SA(0, 1), cA + hstepA, voffA);
    if (wr == 1) PG8_BAR;
    PG8_WAIT_V(2); PG8_BAR;
    PG8_STAGE(PG8_SB(1, 0), cB + kstep, voffB); PG8_STAGE(PG8_SA(1, 0), cA + kstepA, voffA); PG8_STAGE(PG8_SB(1, 1), cB + hstepB + kstep, voffB);
    PG8_WAIT_V(6); PG8_BAR;
    for (;;) {
        const bool has_next = S.next(ui + 1, nxt);
        const char* nA = has_next ? (const char*)g.A + (size_t)nxt.pm * tstepA : cA;
        const char* nB = has_next ? (const char*)g.Bt + (size_t)nxt.pn * tstepB + ((size_t)(nxt.pm & 7) * g.bkoff + (size_t)(nxt.pm >> 3) * g.blstride) * 2 : cB;
        for (int t = 0; t < nt; t += 2) {
            const bool last = (t == nt - 2);
            const char* a1 = cA + (size_t)(t + 1) * kstepA;
            const char* a2 = last ? nA : cA + (size_t)(t + 2) * kstepA; const char* b2 = last ? nB : cB + (size_t)(t + 2) * kstep;
            const char* a3 = a2 + kstepA; const char* b3 = b2 + kstep;
            if (last && has_next) S.a_ready(nxt);
            PG8_LDB(B0, 0, 0); PG8_LDB(B1, 0, 1); PG8_SCHED; PG8_LDA(At, 0, 0); PG8_STAGE(PG8_SA(1, 1), a1 + hstepA, voffA);
            PG8_WAIT_V(8); PG8_WAIT_L(0); PG8_BAR; PG8_MMA(0, 0, At, B0); PG8_MMA(0, 1, At, B1); PG8_BAR; PG8_SCHED;
            PG8_LDA(At, 0, 1); PG8_STAGE(PG8_SB(0, 0), b2, voffB); PG8_STAGE(PG8_SB(0, 1), b2 + hstepB, voffB); PG8_STAGE(PG8_SA(0, 0), a2, voffA);
            PG8_WAIT_V(8); PG8_WAIT_L(0); PG8_BAR; PG8_MMA(1, 0, At, B0); PG8_MMA(1, 1, At, B1); PG8_BAR; PG8_SCHED;
            PG8_LDB(B0, 1, 0); PG8_LDB(B1, 1, 1); PG8_SCHED; PG8_LDA(At, 1, 0); PG8_STAGE(PG8_SA(0, 1), a2 + hstepA, voffA);
            PG8_WAIT_V(8); PG8_WAIT_L(0); PG8_BAR; PG8_MMA(0, 0, At, B0); PG8_MMA(0, 1, At, B1); PG8_BAR; PG8_SCHED;
            PG8_LDA(At, 1, 1); PG8_STAGE(PG8_SB(1, 0), b3, voffB); PG8_STAGE(PG8_SB(1, 1), b3 + hstepB, voffB); PG8_STAGE(PG8_SA(1, 0), a3, voffA);
            PG8_WAIT_V(8); PG8_WAIT_L(0); PG8_BAR; PG8_MMA(1, 0, At, B0); PG8_MMA(1, 1, At, B1); PG8_BAR; PG8_SCHED;
            if constexpr (Epi::HAS_MID) { if (t + 2 == (nt >> 1)) E.mid(acc, cur, wr, wc, fr, fq); }
        }
        if constexpr (ALIGN_EPI) { if (wr == 0) PG8_BAR; }
        E(acc, cur, wr, wc, fr, fq); S.done(cur);
        if (!has_next) break;
#pragma unroll
        for (int a = 0; a < 2; ++a)
#pragma unroll
            for (int b = 0; b < 2; ++b)
#pragma unroll
                for (int m = 0; m < 4; ++m)
#pragma unroll
                    for (int n = 0; n < 2; ++n) acc[a][b][m][n] = (f32x4){0.f, 0.f, 0.f, 0.f};
        cur = nxt; cA = nA; cB = nB; ++ui;
        if constexpr (ALIGN_EPI) { if (wr == 1) PG8_BAR; }
    }
    PG8_WAIT_V(0);
    if constexpr (!ALIGN_EPI) { if (wr == 0) PG8_BAR; }
    PG8_BAR;
#undef PG8_SA
#undef PG8_SB
#undef PG8_STAGE
#undef PG8_LDA
#undef PG8_LDB
#undef PG8_MMA
#undef PG8_WAIT_V
#undef PG8_WAIT_L
#undef PG8_BAR
#undef PG8_SCHED
}

struct EpiResH {
    static constexpr bool PERM = true, HAS_MID = false;
    bf16_t* RS; const bf16_t* XS;
    __device__ __forceinline__ void operator()(const Acc& acc, const Unit& u, int wr, int wc, int fr, int fq) const {
        vlaunder(fr, fq);
        const int row0 = u.pm * BM + wr * 64 + fr, sl0 = u.pn * 8 + wc;
#pragma unroll
        for (int ai = 0; ai < 2; ++ai) {
            v4u xw[4][2];
#pragma unroll
            for (int m = 0; m < 4; ++m)
#pragma unroll
                for (int bj = 0; bj < 2; ++bj) xw[m][bj] = *(const v4u*)(XS + ((size_t)(sl0 + bj * 4) * T + (row0 + ai * HALF + m * 16)) * 32 + 8 * fq);
#pragma unroll
            for (int m = 0; m < 4; ++m) {
#pragma unroll
                for (int bj = 0; bj < 2; ++bj) { const size_t eo = ((size_t)(sl0 + bj * 4) * T + (row0 + ai * HALF + m * 16)) * 32 + 8 * fq;
                    const f32x4 v0 = acc[ai][bj][m][0], v1 = acc[ai][bj][m][1];
                    const unsigned a0 = xw[m][bj].x, a1 = xw[m][bj].y, a2 = xw[m][bj].z, a3 = xw[m][bj].w;
                    const h2_t x0 = __builtin_bit_cast(h2_t, a0), x1 = __builtin_bit_cast(h2_t, a1), x2 = __builtin_bit_cast(h2_t, a2), x3 = __builtin_bit_cast(h2_t, a3);
                    v4u w; w.x = cvt_pk_f16a(v0[0] + ALPHA * (float)x0.x, v0[1] + ALPHA * (float)x0.y); w.y = cvt_pk_f16a(v0[2] + ALPHA * (float)x1.x, v0[3] + ALPHA * (float)x1.y);
                    w.z = cvt_pk_f16a(v1[0] + ALPHA * (float)x2.x, v1[1] + ALPHA * (float)x2.y); w.w = cvt_pk_f16a(v1[2] + ALPHA * (float)x3.x, v1[3] + ALPHA * (float)x3.y);
                    *(v4u*)(RS + eo) = w; } }
        }
    }
};
struct EpiF16 {
    static constexpr bool PERM = true, HAS_MID = false;
    bf16_t* O; int ldc;
    __device__ __forceinline__ void operator()(const Acc& acc, const Unit& u, int wr, int wc, int fr, int fq) const {
        vlaunder(fr, fq);
        const int row0 = u.pm * BM + wr * 64 + fr, col0 = u.pn * BM + wc * 32 + 8 * fq;
#pragma unroll
        for (int ai = 0; ai < 2; ++ai)
#pragma unroll
            for (int m = 0; m < 4; ++m) { bf16_t* rowp = O + (size_t)(row0 + ai * HALF + m * 16) * ldc + col0;
#pragma unroll
                for (int bj = 0; bj < 2; ++bj) { const f32x4 v0 = acc[ai][bj][m][0], v1 = acc[ai][bj][m][1];
                    v4u w; w.x = cvt_pk_f16a(v0[0], v0[1]); w.y = cvt_pk_f16a(v0[2], v0[3]); w.z = cvt_pk_f16a(v1[0], v1[1]); w.w = cvt_pk_f16a(v1[2], v1[3]);
                    *(v4u*)(rowp + bj * HALF) = w; } }
    }
};
struct EpiGate8 {
    static constexpr bool PERM = true, HAS_MID = false;
    bf16_t *GR, *GB; const float* SXp; const float* SWp;
    __device__ __forceinline__ void operator()(const Acc& acc, const Unit& u, int wr, int wc, int fr, int fq) const {
        vlaunder(fr, fq);
        const int row0 = u.pm * BM + wr * 64 + fr, tl = u.pn - 20;
        const int col0 = tl * 128 + wc * 32 + 8 * fq, w0 = tl * 256 + wc * 32 + 8 * fq;
        f32x4 sw[2][2]; float sx[2][4];
#pragma unroll
        for (int bj = 0; bj < 2; ++bj) { sw[bj][0] = *(const f32x4*)(SWp + w0 + bj * HALF); sw[bj][1] = *(const f32x4*)(SWp + w0 + bj * HALF + 4); }
#pragma unroll
        for (int ai = 0; ai < 2; ++ai)
#pragma unroll
            for (int m = 0; m < 4; ++m) sx[ai][m] = SXp[row0 + ai * HALF + m * 16];
#pragma unroll
        for (int ai = 0; ai < 2; ++ai)
#pragma unroll
            for (int m = 0; m < 4; ++m) { const size_t ro = (size_t)(row0 + ai * HALF + m * 16) * 2048 + col0;
                float rr[8], gg[8];
#pragma unroll
                for (int n = 0; n < 2; ++n) { const i32x4 ia = __builtin_bit_cast(i32x4, acc[ai][0][m][n]), ib = __builtin_bit_cast(i32x4, acc[ai][1][m][n]);
#pragma unroll
                    for (int x = 0; x < 4; ++x) { const float za = fminf(fmaxf((float)ia[x] * sx[ai][m] * sw[0][n][x], -30.f), 30.f), zb = fminf(fmaxf((float)ib[x] * sx[ai][m] * sw[1][n][x], -30.f), 30.f);
                        const float ea = fexp(-za), eb = fexp(-zb); gg[n * 4 + x] = frcp(1.f + eb); rr[n * 4 + x] = (1.f + eb) * frcp(1.f + ea); } }
                v4u w; w.x = cvt_pk_bf16(rr[0], rr[1]); w.y = cvt_pk_bf16(rr[2], rr[3]); w.z = cvt_pk_bf16(rr[4], rr[5]); w.w = cvt_pk_bf16(rr[6], rr[7]);
                *(v4u*)(GR + ro) = w;
                w.x = cvt_pk_bf16(gg[0], gg[1]); w.y = cvt_pk_bf16(gg[2], gg[3]); w.z = cvt_pk_bf16(gg[4], gg[5]); w.w = cvt_pk_bf16(gg[6], gg[7]);
                *(v4u*)(GB + ro) = w; }
    }
};
struct EpiSc8 {
    static constexpr bool PERM = true, HAS_MID = false;
    bf16_t* O; const float* SXp; const float* SWp;
    __device__ __forceinline__ void operator()(const Acc& acc, const Unit& u, int wr, int wc, int fr, int fq) const {
        vlaunder(fr, fq);
        const int row0 = u.pm * BM + wr * 64 + fr, col0 = u.pn * BM + wc * 32 + 8 * fq;
        f32x4 sw[2][2]; float sx[2][4];
#pragma unroll
        for (int bj = 0; bj < 2; ++bj) { sw[bj][0] = *(const f32x4*)(SWp + col0 + bj * HALF); sw[bj][1] = *(const f32x4*)(SWp + col0 + bj * HALF + 4); }
#pragma unroll
        for (int ai = 0; ai < 2; ++ai)
#pragma unroll
            for (int m = 0; m < 4; ++m) sx[ai][m] = SXp[row0 + ai * HALF + m * 16];
#pragma unroll
        for (int ai = 0; ai < 2; ++ai)
#pragma unroll
            for (int m = 0; m < 4; ++m) { bf16_t* rowp = O + (size_t)(row0 + ai * HALF + m * 16) * 2048 + col0;
#pragma unroll
                for (int bj = 0; bj < 2; ++bj) { const i32x4 i0 = __builtin_bit_cast(i32x4, acc[ai][bj][m][0]), i1 = __builtin_bit_cast(i32x4, acc[ai][bj][m][1]);
                    const f32x4 v0 = (f32x4){(float)i0[0], (float)i0[1], (float)i0[2], (float)i0[3]} * sx[ai][m] * sw[bj][0], v1 = (f32x4){(float)i1[0], (float)i1[1], (float)i1[2], (float)i1[3]} * sx[ai][m] * sw[bj][1];
                    v4u w; w.x = cvt_pk_bf16(v0[0], v0[1]); w.y = cvt_pk_bf16(v0[2], v0[3]); w.z = cvt_pk_bf16(v1[0], v1[1]); w.w = cvt_pk_bf16(v1[2], v1[3]);
                    *(v4u*)(rowp + bj * HALF) = w; } }
    }
};
struct EpiBf16 {
    static constexpr bool PERM = true, HAS_MID = false;
    bf16_t* O; int ldc;
    __device__ __forceinline__ void operator()(const Acc& acc, const Unit& u, int wr, int wc, int fr, int fq) const {
        vlaunder(fr, fq);
        const int row0 = u.pm * BM + wr * 64 + fr, col0 = u.pn * BM + wc * 32 + 8 * fq;
#pragma unroll
        for (int ai = 0; ai < 2; ++ai)
#pragma unroll
            for (int m = 0; m < 4; ++m) { bf16_t* rowp = O + (size_t)(row0 + ai * HALF + m * 16) * ldc + col0;
#pragma unroll
                for (int bj = 0; bj < 2; ++bj) { const f32x4 v0 = acc[ai][bj][m][0], v1 = acc[ai][bj][m][1];
                    v4u w; w.x = cvt_pk_bf16(v0[0], v0[1]); w.y = cvt_pk_bf16(v0[2], v0[3]); w.z = cvt_pk_bf16(v1[0], v1[1]); w.w = cvt_pk_bf16(v1[2], v1[3]);
                    *(v4u*)(rowp + bj * HALF) = w; } }
    }
};
struct EpiIn {
    static constexpr bool PERM = true, HAS_MID = false;
    bf16_t *Q, *KK, *V, *SG, *UB, *GR, *GB; float* LOGF; const float* lb;
    __device__ __forceinline__ void operator()(const Acc& acc, const Unit& u, int wr, int wc, int fr, int fq) const {
        vlaunder(fr, fq);
        const int row0 = u.pm * BM + wr * 64 + fr;
        const int pn = u.pn;
        if (pn >= 20) {
            const int col0 = (pn - 20) * 128 + wc * 32 + 8 * fq;
#pragma unroll
            for (int ai = 0; ai < 2; ++ai)
#pragma unroll
                for (int m = 0; m < 4; ++m) { const size_t ro = (size_t)(row0 + ai * HALF + m * 16) * 2048 + col0;
                    float rr[8], gg[8];
#pragma unroll
                    for (int n = 0; n < 2; ++n)
#pragma unroll
                        for (int x = 0; x < 4; ++x) { const float za = fminf(fmaxf(acc[ai][0][m][n][x], -30.f), 30.f), zb = fminf(fmaxf(acc[ai][1][m][n][x], -30.f), 30.f);
                            const float ea = fexp(-za), eb = fexp(-zb); gg[n * 4 + x] = frcp(1.f + eb); rr[n * 4 + x] = (1.f + eb) * frcp(1.f + ea); }
                    v4u w; w.x = cvt_pk_bf16(rr[0], rr[1]); w.y = cvt_pk_bf16(rr[2], rr[3]); w.z = cvt_pk_bf16(rr[4], rr[5]); w.w = cvt_pk_bf16(rr[6], rr[7]);
                    *(v4u*)(GR + ro) = w;
                    w.x = cvt_pk_bf16(gg[0], gg[1]); w.y = cvt_pk_bf16(gg[2], gg[3]); w.z = cvt_pk_bf16(gg[4], gg[5]); w.w = cvt_pk_bf16(gg[6], gg[7]);
                    *(v4u*)(GB + ro) = w; }
            return;
        }
        const int sec = pn >> 2, col0 = (pn & 3) * 256 + wc * 32 + 8 * fq;
        if (sec == 1) {
#pragma unroll
            for (int bj = 0; bj < 2; ++bj) {
                const f32x4 l0 = *(const f32x4*)(lb + col0 + bj * HALF), l1 = *(const f32x4*)(lb + col0 + bj * HALF + 4);
#pragma unroll
                for (int ai = 0; ai < 2; ++ai)
#pragma unroll
                    for (int m = 0; m < 4; ++m) { const size_t ro = (size_t)(row0 + ai * HALF + m * 16) * 1024 + col0 + bj * HALF;
                        float lf[8], kk[8];
#pragma unroll
                        for (int n = 0; n < 2; ++n)
#pragma unroll
                            for (int x = 0; x < 4; ++x) { const float z = fminf(fmaxf(acc[ai][bj][m][n][x], -30.f), 30.f); const float lbv = n ? l1[x] : l0[x];
                                const float e = fexp(-z), s = frcp(1.f + e); const float f = lbv + (1.f - lbv) * s;
                                lf[n * 4 + x] = flog(f); kk[n * 4 + x] = (1.f - lbv) * (e * s); }
                        *(f32x4*)(LOGF + ro) = (f32x4){lf[0], lf[1], lf[2], lf[3]}; *(f32x4*)(LOGF + ro + 4) = (f32x4){lf[4], lf[5], lf[6], lf[7]};
                        v4u w; w.x = cvt_pk_bf16(kk[0], kk[1]); w.y = cvt_pk_bf16(kk[2], kk[3]); w.z = cvt_pk_bf16(kk[4], kk[5]); w.w = cvt_pk_bf16(kk[6], kk[7]);
                        *(v4u*)(KK + ro) = w; }
            }
            return;
        }
        bf16_t* dst = sec == 0 ? Q : (sec == 2 ? V : (sec == 3 ? SG : UB));
        const bool sig = (sec == 3);
#pragma unroll
        for (int ai = 0; ai < 2; ++ai)
#pragma unroll
            for (int m = 0; m < 4; ++m) { bf16_t* rowp = dst + (size_t)(row0 + ai * HALF + m * 16) * 1024 + col0;
#pragma unroll
                for (int bj = 0; bj < 2; ++bj) { f32x4 v0 = acc[ai][bj][m][0], v1 = acc[ai][bj][m][1];
                    if (sig) {
#pragma unroll
                        for (int x = 0; x < 4; ++x) { v0[x] = frcp(1.f + fexp(-fminf(fmaxf(v0[x], -30.f), 30.f))); v1[x] = frcp(1.f + fexp(-fminf(fmaxf(v1[x], -30.f), 30.f))); } }
                    v4u w; w.x = cvt_pk_bf16(v0[0], v0[1]); w.y = cvt_pk_bf16(v0[2], v0[3]); w.z = cvt_pk_bf16(v1[0], v1[1]); w.w = cvt_pk_bf16(v1[2], v1[3]);
                    *(v4u*)(rowp + bj * HALF) = w; } }
    }
};
struct EpiGlu {
    static constexpr bool PERM = true, HAS_MID = false;
    bf16_t* O; int ldc;
    __device__ __forceinline__ void operator()(const Acc& acc, const Unit& u, int wr, int wc, int fr, int fq) const {
        vlaunder(fr, fq);
        const int row0 = u.pm * BM + wr * 64 + fr, col0 = u.pn * 128 + wc * 32 + 8 * fq;
#pragma unroll
        for (int ai = 0; ai < 2; ++ai)
#pragma unroll
            for (int m = 0; m < 4; ++m) { float o[8];
#pragma unroll
                for (int n = 0; n < 2; ++n)
#pragma unroll
                    for (int x = 0; x < 4; ++x) { const float h2 = fminf(fmaxf(acc[ai][1][m][n][x], -30.f), 30.f); o[n * 4 + x] = acc[ai][0][m][n][x] * frcp(1.f + fexp(-h2)); }
                v4u w; w.x = cvt_pk_bf16(o[0], o[1]); w.y = cvt_pk_bf16(o[2], o[3]); w.z = cvt_pk_bf16(o[4], o[5]); w.w = cvt_pk_bf16(o[6], o[7]);
                *(v4u*)(O + (size_t)(row0 + ai * HALF + m * 16) * ldc + col0) = w; }
    }
};
struct EpiUp {
    static constexpr bool PERM = true, HAS_MID = true;
    bf16_t* O; const bf16_t *GR, *GB;
    __device__ __forceinline__ void scale(Acc& acc, const bf16_t* G, const Unit& u, int wr, int wc, int fr, int fq) const {
        vlaunder(fr, fq);
        const int row0 = u.pm * BM + wr * 64 + fr, col0 = u.pn * BM + wc * 32 + 8 * fq;
#pragma unroll
        for (int ai = 0; ai < 2; ++ai) {
            v4u gw[4][2];
#pragma unroll
            for (int m = 0; m < 4; ++m)
#pragma unroll
                for (int bj = 0; bj < 2; ++bj) gw[m][bj] = *(const v4u*)(G + (size_t)(row0 + ai * HALF + m * 16) * 2048 + col0 + bj * HALF);
            __builtin_amdgcn_sched_barrier(0);
#pragma unroll
            for (int m = 0; m < 4; ++m) {
#pragma unroll
                for (int bj = 0; bj < 2; ++bj) { const v4u w = gw[m][bj];
                    acc[ai][bj][m][0] *= (f32x4){bf_lo(w.x), bf_hi(w.x), bf_lo(w.y), bf_hi(w.y)};
                    acc[ai][bj][m][1] *= (f32x4){bf_lo(w.z), bf_hi(w.z), bf_lo(w.w), bf_hi(w.w)}; } }
            __builtin_amdgcn_sched_barrier(0); }
    }
    __device__ __forceinline__ void mid(Acc& acc, const Unit& u, int wr, int wc, int fr, int fq) const { scale(acc, GR, u, wr, wc, fr, fq); }
    __device__ __forceinline__ void operator()(Acc& acc, const Unit& u, int wr, int wc, int fr, int fq) const {
        scale(acc, GB, u, wr, wc, fr, fq);
        const int row0 = u.pm * BM + wr * 64 + fr, col0 = u.pn * BM + wc * 32 + 8 * fq;
#pragma unroll
        for (int ai = 0; ai < 2; ++ai)
#pragma unroll
            for (int m = 0; m < 4; ++m) { bf16_t* rowp = O + (size_t)(row0 + ai * HALF + m * 16) * 2048 + col0;
#pragma unroll
                for (int bj = 0; bj < 2; ++bj) { const f32x4 v0 = acc[ai][bj][m][0], v1 = acc[ai][bj][m][1];
                    v4u w; w.x = cvt_pk_bf16(v0[0], v0[1]); w.y = cvt_pk_bf16(v0[2], v0[3]); w.z = cvt_pk_bf16(v1[0], v1[1]); w.w = cvt_pk_bf16(v1[2], v1[3]);
                    *(v4u*)(rowp + bj * HALF) = w; } }
    }
};
}

#define XB_TMO      128
#define XB_XCNT(j)  (256  + 64 * (j))
#define XB_XSUB(j)  (1280 + 64 * (j))
#define XB_XGEN(j)  (2304 + 64 * (j))
#define XB_TOP      3328
#define XB_TOPGEN   3392
#define XCD_BAR_WORDS 3456
#define XB_SPIN_CAP (1u << 20)

__device__ __forceinline__ unsigned xb_ld(unsigned* p)              { return __hip_atomic_load(p, __ATOMIC_RELAXED, __HIP_MEMORY_SCOPE_AGENT); }
__device__ __forceinline__ unsigned xb_add(unsigned* p, unsigned v) { return __hip_atomic_fetch_add(p, v, __ATOMIC_RELAXED, __HIP_MEMORY_SCOPE_AGENT); }
__device__ __forceinline__ unsigned xb_xcc_id() { return (unsigned)__builtin_amdgcn_s_getreg((3 << 11) | 20) & 0xFu; }
#define XB_SPIN(cond, bar) do { unsigned _sp = 0; while (cond) { __builtin_amdgcn_s_sleep(1); \
    if ((++_sp & 255u) == 0u) { if (xb_ld(&(bar)[XB_TMO])) break; if (_sp > XB_SPIN_CAP) { atomicAdd(&(bar)[XB_TMO], 1u); break; } } } } while (0)

struct XcdBarrier { unsigned* bar; unsigned x; volatile LAS unsigned* st; };

__device__ __forceinline__ XcdBarrier xcd_barrier_post(unsigned* bar, volatile LAS unsigned* st, bool leader) {
    XcdBarrier b; b.bar = bar; b.x = xb_xcc_id(); b.st = st;
    if (leader) (void)xb_add(&bar[XB_XCNT(b.x)], 1u);
    return b;
}
__device__ __forceinline__ void xcd_barrier_complete(unsigned* bar, unsigned x, unsigned& nloc, unsigned& nx) {
    const unsigned G = gridDim.x * gridDim.y * gridDim.z;
    unsigned sum, cnt, mine, sp = 0u;
    for (;;) {
        sum = 0u; cnt = 0u; mine = 0u;
#pragma unroll
        for (unsigned j = 0; j < 16; ++j) { const unsigned c = xb_ld(&bar[XB_XCNT(j)]); sum += c; cnt += (c > 0u) ? 1u : 0u; mine = (j == x) ? c : mine; }
        if (sum == G) break;
        __builtin_amdgcn_s_sleep(1);
        if ((++sp & 255u) == 0u) { if (xb_ld(&bar[XB_TMO])) break; if (sp > XB_SPIN_CAP) { atomicAdd(&bar[XB_TMO], 1u); break; } }
    }
    nloc = mine > 0u ? mine : 1u; nx = cnt > 0u ? cnt : 1u;
}
__device__ __forceinline__ void xcd_barrier(const XcdBarrier& b, int wv) {
    asm volatile("s_waitcnt vmcnt(0)" ::: "memory");
    __syncthreads();
    if (wv == 0 && lane_id() == 0) {
        unsigned* bar = b.bar;
        __builtin_amdgcn_s_waitcnt(0);
        unsigned nloc = b.st[0], nx = b.st[1];
        if (nloc == 0u) { xcd_barrier_complete(bar, b.x, nloc, nx); b.st[0] = nloc; b.st[1] = nx; }
        const unsigned old = xb_add(&bar[XB_XSUB(b.x)], 1u);
        const unsigned gen = old / nloc;
        if (old + 1u == (gen + 1u) * nloc) {
            __builtin_amdgcn_fence(__ATOMIC_RELEASE, "agent");
            asm volatile("s_waitcnt vmcnt(0)" ::: "memory");
            const unsigned og = xb_add(&bar[XB_TOP], 1u);
            const unsigned tg = og / nx;
            if (og + 1u == (tg + 1u) * nx) xb_add(&bar[XB_TOPGEN], 1u);
            else XB_SPIN(xb_ld(&bar[XB_TOPGEN]) == tg, bar);
            __builtin_amdgcn_fence(__ATOMIC_ACQUIRE, "agent");
            xb_add(&bar[XB_XGEN(b.x)], 1u);
            asm volatile("s_waitcnt vmcnt(0)" ::: "memory");
        } else {
            XB_SPIN(xb_ld(&bar[XB_XGEN(b.x)]) == gen, bar);
            __builtin_amdgcn_fence(__ATOMIC_ACQUIRE, "agent");
            asm volatile("s_waitcnt vmcnt(0)" ::: "memory");
        }
    }
    __syncthreads();
}

struct Args { const float* in[24]; float* out; unsigned char* ws; int ph_lo, ph_hi; };
struct Frame {
    LAS unsigned char* lds;
    int tid, lane, wave, vcu, G;
    unsigned char* ws;
    const __attribute__((address_space(4))) Args* ka;
};
enum { I_X = 0, I_WIN, I_LBL, I_NG, I_LRE, I_LIM, I_LSTEP, I_BRE, I_BIM, I_CRE, I_CIM, I_SD, I_WGLU, I_WUPA, I_WUPB, I_WO, I_LN1G, I_LN1B, I_PWQ, I_PKEYS, I_PU, I_PV, I_LN2G, I_LN2B };

__device__ __forceinline__ void p0_transpose_item(const float* W, int N, bf16* WT, int dpitch, int dst_koff, int dst_row0, LAS float* scr, int k0, int n0, int lane, bool h = false) {
    { const int kr = lane >> 3, c4 = (lane & 7) * 4; f32x4 v[8];
#pragma unroll
      for (int i = 0; i < 8; ++i) v[i] = __builtin_nontemporal_load((const f32x4*)(W + (size_t)(k0 + kr + 8 * i) * N + n0 + c4));
#pragma unroll
      for (int i = 0; i < 8; ++i) { LAS float* d = scr + (kr + 8 * i) * 33 + c4; d[0] = v[i][0]; d[1] = v[i][1]; d[2] = v[i][2]; d[3] = v[i][3]; } }
    LDS_WAIT(); asm volatile("" ::: "memory");
    const int c = lane & 7;
#pragma unroll
    for (int j = 0; j < 4; ++j) { const int n = (lane >> 3) + 8 * j; const LAS float* s = scr + (8 * c) * 33 + n;
        v4u o;
        if (h) { o.x = cvt_pk_f16(s[0 * 33], s[1 * 33]); o.y = cvt_pk_f16(s[2 * 33], s[3 * 33]); o.z = cvt_pk_f16(s[4 * 33], s[5 * 33]); o.w = cvt_pk_f16(s[6 * 33], s[7 * 33]); }
        else { o.x = cvt_pk_bf16(s[0 * 33], s[1 * 33]); o.y = cvt_pk_bf16(s[2 * 33], s[3 * 33]); o.z = cvt_pk_bf16(s[4 * 33], s[5 * 33]); o.w = cvt_pk_bf16(s[6 * 33], s[7 * 33]); }
        *(v4u*)(WT + (size_t)(dst_row0 + n) * dpitch + dst_koff + k0 + 8 * c) = o; }
    LDS_WAIT(); asm volatile("" ::: "memory");
}
__device__ __forceinline__ void sincos_d(double a, double& s, double& c) {
    const double k = __builtin_rint(a * 0.63661977236758134308);
    double r = __builtin_fma(-k, 1.57079632679489655800e+00, a); r = __builtin_fma(-k, 6.12323399573676603587e-17, r);
    const double r2 = r * r;
    double sp = 1.0 / 1307674368000.0; sp = sp * r2 - 1.0 / 6227020800.0; sp = sp * r2 + 1.0 / 39916800.0; sp = sp * r2 - 1.0 / 362880.0; sp = sp * r2 + 1.0 / 5040.0; sp = sp * r2 - 1.0 / 120.0; sp = sp * r2 + 1.0 / 6.0;
    const double sr = r - r * r2 * sp;
    double cp = 1.0 / 20922789888000.0; cp = cp * r2 - 1.0 / 87178291200.0; cp = cp * r2 + 1.0 / 479001600.0; cp = cp * r2 - 1.0 / 3628800.0; cp = cp * r2 + 1.0 / 40320.0; cp = cp * r2 - 1.0 / 720.0; cp = cp * r2 + 1.0 / 24.0;
    const double cr = 1.0 - 0.5 * r2 + r2 * r2 * cp;
    const int q = ((int)k) & 3;
    s = (q == 0) ? sr : (q == 1) ? cr : (q == 2) ? -sr : -cr;
    c = (q == 0) ? cr : (q == 1) ? -sr : (q == 2) ? -cr : sr;
}
__device__ __forceinline__ double exp_d(double x) {
    const double k = __builtin_rint(x * 1.44269504088896340736);
    const double r = __builtin_fma(-k, 6.93147180369123816490e-01, x) - k * 1.90821492927058770002e-10;
    double p = 1.0 / 6227020800.0;
    p = p * r + 1.0 / 479001600.0; p = p * r + 1.0 / 39916800.0; p = p * r + 1.0 / 3628800.0; p = p * r + 1.0 / 362880.0; p = p * r + 1.0 / 40320.0; p = p * r + 1.0 / 5040.0;
    p = p * r + 1.0 / 720.0; p = p * r + 1.0 / 120.0; p = p * r + 1.0 / 24.0; p = p * r + 1.0 / 6.0; p = p * r + 0.5; p = p * r + 1.0; p = p * r + 1.0;
    const long long e = (long long)k + 1023; double sc = __builtin_bit_cast(double, (unsigned long long)(e << 52));
    return p * sc;
}

__device__ __forceinline__ void phase_prologue_a(const Frame& F0) {
    Frame F = F0; F.tid = F.wave * 64 + lane_id(); asm volatile("" : "+v"(F.tid)); F.lane = F.tid & 63;
    unsigned char* ws = opqg(F.ws); const __attribute__((address_space(4))) Args* a = opq(F.ka);
    LAS float* scr = (LAS float*)(F.lds + F.wave * 16384);
    const int gw = F.vcu * 8 + F.wave, NGW = F.G * 8;
    constexpr int I_IN = 32 * 288, I_GLU = 16 * 64, I_UP = 16 * 64, I_O = 32 * 64, I_L = I_IN + I_GLU + 2 * I_UP + I_O;
    for (int it = gw; it < DEPTH * I_L; it += NGW) {
        const int l = it / I_L; int r = it % I_L;
        if (r < I_IN) { const int kb = r / 288, nb = r % 288, n0 = nb * 32; int dr;
            if (n0 < 5120) dr = n0; else if (n0 < 7168) { const int j = n0 - 5120; dr = 5120 + (j >> 7) * 256 + (j & 127); } else { const int j = n0 - 7168; dr = 5120 + (j >> 7) * 256 + 128 + (j & 127); }
            p0_transpose_item(GP(const float, a->in[I_WIN]) + (size_t)l * D * NIN, NIN, (bf16*)(ws + WS_WIN) + (size_t)l * NIN * D, D, 0, dr, scr, kb * 64, n0, F.lane, true); continue; }
        r -= I_IN;
        if (r < I_GLU) { const int kb = r / 64, nb = r % 64, n0 = nb * 32; int dr;
            if (n0 < 1024) dr = (n0 >> 7) * 256 + (n0 & 127); else { const int j = n0 - 1024; dr = (j >> 7) * 256 + 128 + (j & 127); }
            p0_transpose_item(GP(const float, a->in[I_WGLU]) + (size_t)l * 1024 * 2048, 2048, (bf16*)(ws + WS_WGLU) + (size_t)l * 2048 * 1024, 1024, 0, dr, scr, kb * 64, n0, F.lane); continue; }
        r -= I_GLU;
        if (r < I_UP) { const int kb = r / 64, nb = r % 64;
            p0_transpose_item(GP(const float, a->in[I_WUPA]) + (size_t)l * 1024 * 2048, 2048, (bf16*)(ws + WS_WUP) + (size_t)l * 2048 * 2048, 2048, 0, nb * 32, scr, kb * 64, nb * 32, F.lane); continue; }
        r -= I_UP;
        if (r < I_UP) { const int kb = r / 64, nb = r % 64;
            p0_transpose_item(GP(const float, a->in[I_WUPB]) + (size_t)l * 1024 * 2048, 2048, (bf16*)(ws + WS_WUP) + (size_t)l * 2048 * 2048, 2048, 1024, nb * 32, scr, kb * 64, nb * 32, F.lane); continue; }
        r -= I_UP;
        { const int kb = r / 64, nb = r % 64;
            p0_transpose_item(GP(const float, a->in[I_WO]) + (size_t)l * 2048 * 2048, 2048, (bf16*)(ws + WS_WO) + (size_t)l * 2048 * 2048, 2048, 0, nb * 32, scr, kb * 64, nb * 32, F.lane); }
    }
    const size_t gt = (size_t)F.vcu * 512 + F.tid, NT = (size_t)F.G * 512;
    { const float* src = GP(const float, a->in[I_PWQ]); bf16* dst = (bf16*)(ws + WS_WQB);
      const size_t N_ = (size_t)DEPTH * D * D / 8; size_t i = gt;
      for (; i + 3 * NT < N_; i += 4 * NT) { f32x4 va[4], vb[4];
#pragma unroll
          for (int k = 0; k < 4; ++k) { va[k] = *(const f32x4*)(src + (i + k * NT) * 8); vb[k] = *(const f32x4*)(src + (i + k * NT) * 8 + 4); }
#pragma unroll
          for (int k = 0; k < 4; ++k) { v4u w; w.x = cvt_pk_bf16(va[k][0], va[k][1]); w.y = cvt_pk_bf16(va[k][2], va[k][3]); w.z = cvt_pk_bf16(vb[k][0], vb[k][1]); w.w = cvt_pk_bf16(vb[k][2], vb[k][3]); *(v4u*)(dst + (i + k * NT) * 8) = w; } }
      for (; i < N_; i += NT) { const f32x4 v0 = *(const f32x4*)(src + i * 8), v1 = *(const f32x4*)(src + i * 8 + 4);
          v4u w; w.x = cvt_pk_bf16(v0[0], v0[1]); w.y = cvt_pk_bf16(v0[2], v0[3]); w.z = cvt_pk_bf16(v1[0], v1[1]); w.w = cvt_pk_bf16(v1[2], v1[3]); *(v4u*)(dst + i * 8) = w; } }
    { const float* src = GP(const float, a->in[I_X]); bf16* XS = (bf16*)(ws + WS_XH);
      const int j = F.lane & 3, rr = (F.lane >> 2) & 1, sl = F.lane >> 3;
      for (int rp = gw; rp < T / 2; rp += NGW) { const int row = 2 * rp + rr;
          f32x4 a0[8], a1[8]; float amax = 0.f;
#pragma unroll
          for (int i = 0; i < 8; ++i) { const float* sp = src + (size_t)row * D + (8 * i + sl) * 32 + j * 8; a0[i] = *(const f32x4*)sp; a1[i] = *(const f32x4*)(sp + 4); }
#pragma unroll
          for (int i = 0; i < 8; ++i) { v4u o; o.x = cvt_pk_f16(a0[i][0], a0[i][1]); o.y = cvt_pk_f16(a0[i][2], a0[i][3]); o.z = cvt_pk_f16(a1[i][0], a1[i][1]); o.w = cvt_pk_f16(a1[i][2], a1[i][3]);
              *(v4u*)(XS + ((size_t)(8 * i + sl) * T + row) * 32 + j * 8) = o;
#pragma unroll
              for (int k = 0; k < 4; ++k) amax = fmaxf(amax, fmaxf(fabsf(a0[i][k]), fabsf(a1[i][k]))); }
          amax = fmaxf(amax, __shfl_xor(amax, 1)); amax = fmaxf(amax, __shfl_xor(amax, 2)); amax = fmaxf(amax, __shfl_xor(amax, 8)); amax = fmaxf(amax, __shfl_xor(amax, 16)); amax = fmaxf(amax, __shfl_xor(amax, 32));
          const float inv = (amax > 0.f) ? 127.f / amax : 0.f;
          if (j == 0 && sl == 0) ((float*)(ws + WS_SX))[row] = (amax > 0.f) ? amax * (1.f / 127.f) : 1.f;
          unsigned char* xq = ws + WS_XQ + (size_t)row * 64 + (sl & 1) * 32 + j * 8;
#pragma unroll
          for (int i = 0; i < 8; ++i) { int q[8];
#pragma unroll
              for (int k = 0; k < 4; ++k) { q[k] = (int)__builtin_rintf(a0[i][k] * inv); q[4 + k] = (int)__builtin_rintf(a1[i][k] * inv); }
              v2u o; o.x = (unsigned)(q[0] & 255) | ((unsigned)(q[1] & 255) << 8) | ((unsigned)(q[2] & 255) << 16) | ((unsigned)q[3] << 24);
              o.y = (unsigned)(q[4] & 255) | ((unsigned)(q[5] & 255) << 8) | ((unsigned)(q[6] & 255) << 16) | ((unsigned)q[7] << 24);
              *(v2u*)(xq + (size_t)(4 * i + (sl >> 1)) * T * 64) = o; } } }
    { const float* keys = GP(const float, a->in[I_PKEYS]); bf16* dst = (bf16*)(ws + WS_BK);
      for (size_t i = gt; i < (size_t)DEPTH * 8 * 256 * 256 / 8; i += NT) { const int jj = (int)(i & 31) * 8; const int row = (int)((i >> 5) & 255); const size_t lh = i >> 13; const int half = row >> 7, n = row & 127;
          v4u w = (v4u){0u, 0u, 0u, 0u};
          if ((jj >> 7) == half) { const float* s = keys + ((lh * 2 + half) * 128 + n) * 128 + (jj & 127); const f32x4 v0 = *(const f32x4*)s, v1 = *(const f32x4*)(s + 4);
              w.x = cvt_pk_bf16(v0[0], v0[1]); w.y = cvt_pk_bf16(v0[2], v0[3]); w.z = cvt_pk_bf16(v1[0], v1[1]); w.w = cvt_pk_bf16(v1[2], v1[3]); }
          *(v4u*)(dst + i * 8) = w; } }
    if (gt < 1024) { const float* lg = GP(const float, a->in[I_LBL]); float* lbo = (float*)(ws + WS_LB); const int d = (int)gt;
        const float z0 = lg[d], z1 = lg[1024 + d], z2 = lg[2048 + d], z3 = lg[3072 + d]; const float mx = fmaxf(fmaxf(z0, z1), fmaxf(z2, z3));
        const float e0 = expf(z0 - mx), e1 = expf(z1 - mx), e2 = expf(z2 - mx), e3 = expf(z3 - mx); const float inv = 1.f / (e0 + e1 + e2 + e3);
        lbo[d] = 0.f; lbo[1024 + d] = e1 * inv; lbo[2048 + d] = (e1 + e2) * inv; lbo[3072 + d] = (e1 + e2 + e3) * inv; }
    for (size_t i = gt; i < (size_t)DEPTH * 64 * 64; i += NT) {
        const size_t lg_ = i >> 6;
        const double lr = fmin((double)GP(const float, a->in[I_LRE])[i], -1e-4), li = (double)GP(const float, a->in[I_LIM])[i], dt = exp_d((double)GP(const float, a->in[I_LSTEP])[lg_]);
        const double mag = exp_d(lr * dt); double sn, cs; sincos_d(li * dt, sn, cs);
        const double ar = mag * cs, ai = mag * sn, den = lr * lr + li * li, nr = ar - 1.0;
        const double zr = (nr * lr + ai * li) / den, zi = (ai * lr - nr * li) / den;
        const float* br = GP(const float, a->in[I_BRE]) + i * 16; const float* bi = GP(const float, a->in[I_BIM]) + i * 16; float* bb = (float*)(ws + WS_BB) + i * 32;
        f32x4 brv[4], biv[4];
#pragma unroll
        for (int m4 = 0; m4 < 4; ++m4) { brv[m4] = ((const f32x4*)br)[m4]; biv[m4] = ((const f32x4*)bi)[m4]; }
#pragma unroll
        for (int m4 = 0; m4 < 4; ++m4) { float o8[8];
#pragma unroll
            for (int x = 0; x < 4; ++x) { const double b_r = brv[m4][x], b_i = biv[m4][x]; o8[2 * x] = (float)(zr * b_r - zi * b_i); o8[2 * x + 1] = (float)(zr * b_i + zi * b_r); }
            ((f32x4*)bb)[2 * m4] = (f32x4){o8[0], o8[1], o8[2], o8[3]}; ((f32x4*)bb)[2 * m4 + 1] = (f32x4){o8[4], o8[5], o8[6], o8[7]}; }
        float* ap = (float*)(ws + WS_APOW) + (lg_ * 65 * 64 + (i & 63)) * 2; double pr = 1.0, pi = 0.0;
        for (int dl = 0; dl < 65; ++dl) { ap[dl * 128] = (float)pr; ap[dl * 128 + 1] = (float)pi; const double t = pr * ar - pi * ai; pi = pr * ai + pi * ar; pr = t; }
    }
    for (int it = gw; it < DEPTH * 1024; it += NGW) {
        const int l = it >> 10, eb = it & 1023;
        const int pe = eb * 16 + (F.lane >> 2), i1 = (pe & 1023) >> 3, i2 = (pe & 7) * 16 + (((pe >> 10) - i1) & 15);
        const float* src = GP(const float, a->in[I_PV]) + ((size_t)l * NEXP + i1 * 128 + i2) * D + (F.lane & 3) * 8;
        bf16* dst = (bf16*)(ws + WS_TBV) + (size_t)l * 64 * NEXP * 32 + ((size_t)(eb * 16 + (F.lane >> 2)) * 4 + ((F.lane & 3) ^ ((F.lane >> 4) & 3))) * 8;
#pragma unroll 1
        for (int k8 = 0; k8 < 64; k8 += 8) { f32x4 va[8], vb[8];
#pragma unroll
            for (int k = 0; k < 8; ++k) { va[k] = __builtin_nontemporal_load((const f32x4*)(src + (k8 + k) * 32)); vb[k] = __builtin_nontemporal_load((const f32x4*)(src + (k8 + k) * 32 + 4)); }
#pragma unroll
            for (int k = 0; k < 8; ++k) { v4u w; w.x = cvt_pk_f16(va[k][0], va[k][1]); w.y = cvt_pk_f16(va[k][2], va[k][3]); w.z = cvt_pk_f16(vb[k][0], vb[k][1]); w.w = cvt_pk_f16(vb[k][2], vb[k][3]);
                *(v4u*)(dst + (size_t)(k8 + k) * NEXP * 32) = w; } }
    }
    for (int it = gw; it < DEPTH * 4096; it += NGW) {
        const int l = it >> 12, q4 = it & 4095, c = F.lane & 15;
        const int pe = q4 * 4 + (F.lane >> 4), i1 = (pe & 1023) >> 3, i2 = (pe & 7) * 16 + (((pe >> 10) - i1) & 15);
        const float* src = GP(const float, a->in[I_PU]) + ((size_t)l * NEXP + i1 * 128 + i2) * D + c * 4;
        unsigned hv[64]; float m = 0.f;
#pragma unroll
        for (int i = 0; i < 32; ++i) { const f32x4 v = __builtin_nontemporal_load((const f32x4*)(src + i * 64));
            m = fmaxf(fmaxf(m, fmaxf(fabsf(v[0]), fabsf(v[1]))), fmaxf(fabsf(v[2]), fabsf(v[3])));
            hv[2 * i] = cvt_pk_f16(v[0], v[1]); hv[2 * i + 1] = cvt_pk_f16(v[2], v[3]); }
        m = fmaxf(m, __shfl_xor(m, 1)); m = fmaxf(m, __shfl_xor(m, 2)); m = fmaxf(m, __shfl_xor(m, 4)); m = fmaxf(m, __shfl_xor(m, 8));
        const float sc = (m > 0.f) ? m * (1.f / 127.f) : 1.f, inv = (m > 0.f) ? 127.f / m : 0.f;
        if (c == 0) ((float*)(ws + WS_SU))[(size_t)l * NEXP + pe] = sc;
        unsigned char* dst = ws + WS_TBU + (size_t)l * 32 * NEXP * 64 + (size_t)pe * 64 + (((c >> 2) ^ ((pe >> 2) & 3)) * 16 + (c & 3) * 4);
#pragma unroll
        for (int i = 0; i < 32; ++i) { const h2_t p0 = __builtin_bit_cast(h2_t, hv[2 * i]), p1 = __builtin_bit_cast(h2_t, hv[2 * i + 1]);
            const int q0 = (int)__builtin_rintf((float)p0.x * inv), q1 = (int)__builtin_rintf((float)p0.y * inv), q2 = (int)__builtin_rintf((float)p1.x * inv), q3 = (int)__builtin_rintf((float)p1.y * inv);
            *(unsigned*)(dst + (size_t)i * NEXP * 64) = (unsigned)(q0 & 255) | ((unsigned)(q1 & 255) << 8) | ((unsigned)(q2 & 255) << 16) | ((unsigned)q3 << 24); }
    }
}
__device__ __forceinline__ double dummy_unused_(double x) { return x; }

__device__ __forceinline__ void phase_prologue_b(const Frame& F0) {
    Frame F = F0; F.tid = F.wave * 64 + lane_id(); asm volatile("" : "+v"(F.tid)); F.lane = F.tid & 63;
    unsigned char* ws = opqg(F.ws); const __attribute__((address_space(4))) Args* a = opq(F.ka);
    const float* APOW = (const float*)(ws + WS_APOW); const float* BB = (const float*)(ws + WS_BB);
    LAS float* AP = (LAS float*)(F.lds); LAS float* BL = (LAS float*)(F.lds + 33280); LAS float* CR = (LAS float*)(F.lds + 41472); LAS float* CI = (LAS float*)(F.lds + 45568); LAS float* SDL = (LAS float*)(F.lds + 49664);
    bf16* KM = (bf16*)(ws + WS_KMAT); bf16* PM = (bf16*)(ws + WS_PM); bf16* E = (bf16*)(ws + WS_E);
    for (int lg = F.vcu; lg < DEPTH * 64; lg += F.G) {
        for (int i = F.tid; i < 65 * 64 * 2 / 4; i += 512) ((LAS f32x4*)AP)[i] = ((const f32x4*)(APOW + (size_t)lg * 65 * 128))[i];
        ((LAS f32x4*)BL)[F.tid] = ((const f32x4*)(BB + (size_t)lg * 2048))[F.tid];
        if (F.tid < 256) ((LAS f32x4*)CR)[F.tid] = ((const f32x4*)(GP(const float, a->in[I_CRE]) + (size_t)lg * 1024))[F.tid];
        else ((LAS f32x4*)CI)[F.tid - 256] = ((const f32x4*)(GP(const float, a->in[I_CIM]) + (size_t)lg * 1024))[F.tid - 256];
        if (F.tid < 16) SDL[F.tid] = GP(const float, a->in[I_SD])[lg * 16 + F.tid];
        __syncthreads();
        for (int task = F.tid; task < 65 * 16; task += 512) {
            const int n = task & 15, idx = task >> 4;
            float sm[16];
#pragma unroll
            for (int m = 0; m < 16; ++m) sm[m] = 0.f;
            if (idx > 0) { const int dl = idx - 1;
#pragma unroll 4
                for (int p = 0; p < 64; ++p) { const f32x2 av = *(const LAS f32x2*)(AP + (dl * 64 + p) * 2); const float c_r = CR[n * 64 + p], c_i = CI[n * 64 + p];
                    const float car = c_r * av[0] - c_i * av[1], cai = c_r * av[1] + c_i * av[0];
#pragma unroll
                    for (int q = 0; q < 8; ++q) { const f32x4 b4 = *(const LAS f32x4*)(BL + p * 32 + q * 4); sm[2 * q] += car * b4[0] - cai * b4[1]; sm[2 * q + 1] += car * b4[2] - cai * b4[3]; } }
                if (dl == 0) { const float dv = SDL[n];
#pragma unroll
                    for (int m = 0; m < 16; ++m) sm[m] += (m == n) ? dv : 0.f; } }
            v4u w0, w1; w0.x = cvt_pk_bf16(sm[0], sm[1]); w0.y = cvt_pk_bf16(sm[2], sm[3]); w0.z = cvt_pk_bf16(sm[4], sm[5]); w0.w = cvt_pk_bf16(sm[6], sm[7]);
            w1.x = cvt_pk_bf16(sm[8], sm[9]); w1.y = cvt_pk_bf16(sm[10], sm[11]); w1.z = cvt_pk_bf16(sm[12], sm[13]); w1.w = cvt_pk_bf16(sm[14], sm[15]);
            bf16* kp = KM + ((size_t)lg * 65 * 16 + task) * 16; *(v4u*)kp = w0; *(v4u*)(kp + 8) = w1; }
        for (int it = F.tid; it < 128 * 64 * 2; it += 512) {
            const int m0 = (it & 1) * 8, sidx = (it >> 1) & 63, pp = it >> 7, p = pp & 63;
            const f32x2 av = *(const LAS f32x2*)(AP + ((63 - sidx) * 64 + p) * 2); const float pr = av[0], pi = av[1];
            float o[8];
#pragma unroll
            for (int j = 0; j < 4; ++j) { const f32x4 b4 = *(const LAS f32x4*)(BL + p * 32 + m0 * 2 + j * 4);
                o[2 * j] = (pp < 64) ? (pr * b4[0] - pi * b4[1]) : (pr * b4[1] + pi * b4[0]); o[2 * j + 1] = (pp < 64) ? (pr * b4[2] - pi * b4[3]) : (pr * b4[3] + pi * b4[2]); }
            v4u w; w.x = cvt_pk_bf16(o[0], o[1]); w.y = cvt_pk_bf16(o[2], o[3]); w.z = cvt_pk_bf16(o[4], o[5]); w.w = cvt_pk_bf16(o[6], o[7]); *(v4u*)(PM + ((size_t)lg * 16384 + it) * 8) = w; }
        for (int it = F.tid; it < 1024 * 16; it += 512) {
            const int pp0 = (it & 15) * 8, n = (it >> 4) & 15, tau = it >> 8, p0 = pp0 & 63;
            float o[8];
#pragma unroll
            for (int j = 0; j < 8; ++j) { const f32x2 av = *(const LAS f32x2*)(AP + ((tau + 1) * 64 + p0 + j) * 2); const float c_r = CR[n * 64 + p0 + j], c_i = CI[n * 64 + p0 + j];
                o[j] = (pp0 < 64) ? (c_r * av[0] - c_i * av[1]) : -(c_r * av[1] + c_i * av[0]); }
            v4u w; w.x = cvt_pk_bf16(o[0], o[1]); w.y = cvt_pk_bf16(o[2], o[3]); w.z = cvt_pk_bf16(o[4], o[5]); w.w = cvt_pk_bf16(o[6], o[7]); *(v4u*)(E + ((size_t)lg * 16384 + it) * 8) = w; }
        __syncthreads();
    }
}
__device__ __forceinline__ void quant_rows(const Frame& F0, const bf16* SRC, int rpl, int lrows, int row0, unsigned char* W8, float* SW) {
    Frame F = F0; F.tid = F.wave * 64 + lane_id(); asm volatile("" : "+v"(F.tid)); F.lane = F.tid & 63;
    for (int row = F.vcu * 8 + F.wave; row < DEPTH * rpl; row += F.G * 8) {
        const int l = row / rpl, r = row - l * rpl; const bf16* sp = SRC + ((size_t)l * lrows + row0 + r) * 2048;
        v4u w[4]; float vf[32]; float m = 0.f;
#pragma unroll
        for (int k = 0; k < 4; ++k) w[k] = *(const v4u*)(sp + (k * 64 + F.lane) * 8);
#pragma unroll
        for (int k = 0; k < 4; ++k) { const unsigned ww[4] = {w[k].x, w[k].y, w[k].z, w[k].w};
#pragma unroll
            for (int x = 0; x < 4; ++x) { const h2_t hv = __builtin_bit_cast(h2_t, ww[x]); vf[8 * k + 2 * x] = (float)hv.x; vf[8 * k + 2 * x + 1] = (float)hv.y; m = fmaxf(m, fmaxf(fabsf((float)hv.x), fabsf((float)hv.y))); } }
#pragma unroll
        for (int o = 1; o < 64; o <<= 1) m = fmaxf(m, __shfl_xor(m, o));
        const float inv = (m > 0.f) ? 127.f / m : 0.f;
        if (F.lane == 0) SW[row] = (m > 0.f) ? m * (1.f / 127.f) : 1.f;
#pragma unroll
        for (int k = 0; k < 4; ++k) { int q[8];
#pragma unroll
            for (int x = 0; x < 8; ++x) q[x] = (int)__builtin_rintf(vf[8 * k + x] * inv);
            v2u o; o.x = (unsigned)(q[0] & 255) | ((unsigned)(q[1] & 255) << 8) | ((unsigned)(q[2] & 255) << 16) | ((unsigned)q[3] << 24);
            o.y = (unsigned)(q[4] & 255) | ((unsigned)(q[5] & 255) << 8) | ((unsigned)(q[6] & 255) << 16) | ((unsigned)q[7] << 24);
            *(v2u*)(W8 + (size_t)row * 2048 + (k * 64 + F.lane) * 8) = o; }
    }
}
constexpr int HG_BL = 0, HG_TOT = 33792, HG_VT = 35840, HG_KT = 54272, HG_RED = 72704;
constexpr int KSP = 136, HG_KS = 73728, HG_QT = HG_KS + 64 * KSP * 2, HG_QH = HG_QT + 64 * KSP * 2;
static_assert(HG_QH + 64 * KSP * 2 <= RING_BYTES, "hgrn_out LDS map");
constexpr int BLP = 132, VTP = 72;
__device__ __forceinline__ void hg_cumsum(const Frame& F, const float* LOGF, int c, int h) {
    LAS float* bL = (LAS float*)(F.lds + HG_BL); LAS float* tot = (LAS float*)(F.lds + HG_TOT);
    const int d = F.tid & 127, seg = F.tid >> 7;
    const float* src = LOGF + (size_t)(c * 64 + seg * 16) * AW + h * 128 + d;
    float lf[16];
#pragma unroll
    for (int i = 0; i < 16; ++i) lf[i] = src[(size_t)i * AW];
#pragma unroll
    for (int i = 1; i < 16; ++i) lf[i] += lf[i - 1];
    tot[seg * 128 + d] = lf[15];
    __syncthreads();
    float off = 0.f;
#pragma unroll
    for (int s2 = 0; s2 < 3; ++s2) off += (s2 < seg) ? tot[s2 * 128 + d] : 0.f;
#pragma unroll
    for (int i = 0; i < 16; ++i) bL[(seg * 16 + i) * BLP + d] = lf[i] + off;
}
__device__ __forceinline__ void hg_load_vt(const Frame& F, const bf16* V, int c, int h) {
    LAS bf16* VT = (LAS bf16*)(F.lds + HG_VT);
    const int s = F.lane, vb = F.wave * 16;
    const v4u* src = (const v4u*)(V + (size_t)(c * 64 + s) * AW + h * 128 + vb);
    const v4u w0 = src[0], w1 = src[1];
    const unsigned ww[8] = {w0.x, w0.y, w0.z, w0.w, w1.x, w1.y, w1.z, w1.w};
#pragma unroll
    for (int j = 0; j < 8; ++j) { VT[(vb + 2 * j) * VTP + s] = (bf16)(ww[j] & 0xffffu); VT[(vb + 2 * j + 1) * VTP + s] = (bf16)(ww[j] >> 16); }
}
__device__ __forceinline__ void phase_hgrn_local(const Frame& F0, int l) {
    Frame F = F0; F.tid = F.wave * 64 + lane_id(); asm volatile("" : "+v"(F.tid)); F.lane = F.tid & 63;
    unsigned char* ws = opqg(F.ws);
    const float* LOGF = (const float*)(ws + WS_LOGF); const bf16* KK = (const bf16*)(ws + WS_KK); const bf16* V = (const bf16*)(ws + WS_V);
    _Float16* U = (_Float16*)(ws + WS_U); float* BLo = (float*)(ws + WS_BL);
    LAS float* bL = (LAS float*)(F.lds + HG_BL); LAS bf16* VT = (LAS bf16*)(F.lds + HG_VT); LAS bf16* KT = (LAS bf16*)(F.lds + HG_KT);
    const int fr = F.lane & 15, fq = F.lane >> 4;
    for (int unit = F.vcu; unit < NCH * 8; unit += F.G) {
        const int c = unit >> 3, h = unit & 7;
        hg_cumsum(F, LOGF, c, h);
        hg_load_vt(F, V, c, h);
        __syncthreads();
        { const int s = F.lane, db = F.wave * 16;
          const v4u* src = (const v4u*)(KK + (size_t)(c * 64 + s) * AW + h * 128 + db);
          const v4u w0 = src[0], w1 = src[1];
          const unsigned ww[8] = {w0.x, w0.y, w0.z, w0.w, w1.x, w1.y, w1.z, w1.w};
#pragma unroll
          for (int j = 0; j < 8; ++j) {
              const float b0 = bL[s * BLP + db + 2 * j], b1 = bL[s * BLP + db + 2 * j + 1], l0 = bL[63 * BLP + db + 2 * j], l1 = bL[63 * BLP + db + 2 * j + 1];
              const unsigned pk = cvt_pk_bf16(bf_lo(ww[j]) * fexp(l0 - b0), bf_hi(ww[j]) * fexp(l1 - b1));
              KT[(db + 2 * j) * VTP + s] = (bf16)(pk & 0xffffu); KT[(db + 2 * j + 1) * VTP + s] = (bf16)(pk >> 16); } }
        if (F.tid < 128) BLo[(size_t)c * AW + h * 128 + F.tid] = bL[63 * BLP + F.tid];
        __syncthreads();
        f32x4 acc[8];
#pragma unroll
        for (int i = 0; i < 8; ++i) acc[i] = (f32x4){0.f, 0.f, 0.f, 0.f};
#pragma unroll
        for (int ks = 0; ks < 2; ++ks) {
            const bf16x8 A = *(const LAS bf16x8*)(VT + (F.wave * 16 + fr) * VTP + ks * 32 + fq * 8);
#pragma unroll
            for (int dt = 0; dt < 8; ++dt) { const bf16x8 B = *(const LAS bf16x8*)(KT + (dt * 16 + fr) * VTP + ks * 32 + fq * 8);
                acc[dt] = __builtin_amdgcn_mfma_f32_16x16x32_bf16(B, A, acc[dt], 0, 0, 0); }
        }
        _Float16* up = U + ((size_t)(c * 8 + h) * 128 + F.wave * 16 + fr) * 128 + fq * 4;
#pragma unroll
        for (int dt = 0; dt < 8; ++dt) { v2u w; w.x = cvt_pk_f16(acc[dt][0], acc[dt][1]); w.y = cvt_pk_f16(acc[dt][2], acc[dt][3]); *(v2u*)(up + dt * 16) = w; }
        __syncthreads();
    }
}
__device__ __forceinline__ void phase_scan(const Frame& F0, int l) {
    Frame F = F0; F.tid = F.wave * 64 + lane_id(); asm volatile("" : "+v"(F.tid)); F.lane = F.tid & 63;
    unsigned char* ws = opqg(F.ws);
    const _Float16* U = (const _Float16*)(ws + WS_U); const float* BLo = (const float*)(ws + WS_BL); bf16* SP = (bf16*)(ws + WS_SP);
    for (int e = F.vcu * 512 + F.tid; e < 8 * 128 * 128; e += F.G * 512) {
        const int hd = (e >> 14) * 128 + (e & 127);
        float s = 0.f;
        for (int c0 = 0; c0 < NCH; c0 += 32) {
            float u[32], bl[32];
#pragma unroll
            for (int i = 0; i < 32; ++i) { u[i] = (float)U[(size_t)(c0 + i) * 131072 + e]; bl[i] = BLo[(size_t)(c0 + i) * AW + hd]; }
#pragma unroll
            for (int i = 0; i < 32; ++i) { SP[(size_t)(c0 + i) * 131072 + e] = f2bf(s); s = s * fexp(bl[i]) + u[i]; }
        }
    }
    const float* XLOC = (const float*)(ws + WS_XLOC); float* XS = (float*)(ws + WS_XS); const float* APOW = (const float*)(ws + WS_APOW);
    for (int e = F.vcu * 512 + F.tid; e < 64 * 64; e += F.G * 512) {
        const int g = e >> 6, p = e & 63;
        const float* ap = APOW + (((size_t)(l * 64 + g) * 65 + 64) * 64 + p) * 2; const float ar = ap[0], ai = ap[1];
        float xr = 0.f, xi = 0.f;
        for (int c0 = 0; c0 < NCH; c0 += 32) {
            float lr_[32], li_[32];
#pragma unroll
            for (int i = 0; i < 32; ++i) { lr_[i] = XLOC[((size_t)(c0 + i) * 64 + g) * 128 + p]; li_[i] = XLOC[((size_t)(c0 + i) * 64 + g) * 128 + 64 + p]; }
#pragma unroll
            for (int i = 0; i < 32; ++i) { XS[((size_t)(c0 + i) * 64 + g) * 128 + p] = xr; XS[((size_t)(c0 + i) * 64 + g) * 128 + 64 + p] = xi;
                const float t = ar * xr - ai * xi + lr_[i]; xi = ar * xi + ai * xr + li_[i]; xr = t; }
        }
    }
}
__device__ __forceinline__ void phase_hgrn_out(const Frame& F0, int l) {
    Frame F = F0; F.tid = F.wave * 64 + lane_id(); asm volatile("" : "+v"(F.tid)); F.lane = F.tid & 63;
    unsigned char* ws = opqg(F.ws); const __attribute__((address_space(4))) Args* a = opq(F.ka);
    const float* LOGF = (const float*)(ws + WS_LOGF); const bf16* KK = (const bf16*)(ws + WS_KK); const bf16* V = (const bf16*)(ws + WS_V);
    const bf16* Q = (const bf16*)(ws + WS_Q); const bf16* SG = (const bf16*)(ws + WS_SG); const bf16* SP = (const bf16*)(ws + WS_SP);
    bf16* OAB = (bf16*)(ws + WS_OAB); const float* NG = GP(const float, a->in[I_NG]) + (size_t)l * AW;
    LAS float* bL = (LAS float*)(F.lds + HG_BL); LAS bf16* VT = (LAS bf16*)(F.lds + HG_VT); LAS float* red = (LAS float*)(F.lds + HG_RED);
    const int fr = F.lane & 15, fq = F.lane >> 4, tt = F.wave & 3, vh = F.wave >> 2;
    LAS float* tot = (LAS float*)(F.lds + HG_TOT);
    float lf[16]; v4u vw0, vw1, kg0, kg1, qg0, qg1;
#define HGO_PREF(u_) { const int c_ = (u_) >> 3, h_ = (u_) & 7; \
        const float* src_ = LOGF + (size_t)(c_ * 64 + (F.tid >> 7) * 16) * AW + h_ * 128 + (F.tid & 127); \
        _Pragma("unroll") for (int i = 0; i < 16; ++i) lf[i] = src_[(size_t)i * AW]; \
        const v4u* vp_ = (const v4u*)(V + (size_t)(c_ * 64 + F.lane) * AW + h_ * 128 + F.wave * 16); vw0 = vp_[0]; vw1 = vp_[1]; \
        const size_t ro_ = ((size_t)c_ * 64 + (F.tid >> 3)) * AW + h_ * 128 + (F.tid & 7) * 16; \
        const v4u* kp_ = (const v4u*)(KK + ro_); const v4u* qp_ = (const v4u*)(Q + ro_); kg0 = kp_[0]; kg1 = kp_[1]; qg0 = qp_[0]; qg1 = qp_[1]; }
    if (F.vcu < NCH * 8) HGO_PREF(F.vcu)
    for (int unit = F.vcu; unit < NCH * 8; unit += F.G) {
        const int c = unit >> 3, h = unit & 7;
        { const int d = F.tid & 127, seg = F.tid >> 7;
#pragma unroll
          for (int i = 1; i < 16; ++i) lf[i] += lf[i - 1];
          tot[seg * 128 + d] = lf[15];
          { const int s = F.lane, vb = F.wave * 16; const unsigned ww[8] = {vw0.x, vw0.y, vw0.z, vw0.w, vw1.x, vw1.y, vw1.z, vw1.w};
#pragma unroll
            for (int j = 0; j < 8; ++j) { VT[(vb + 2 * j) * VTP + s] = (bf16)(ww[j] & 0xffffu); VT[(vb + 2 * j + 1) * VTP + s] = (bf16)(ww[j] >> 16); } }
          __syncthreads();
          float off = 0.f;
#pragma unroll
          for (int s2 = 0; s2 < 3; ++s2) off += (s2 < seg) ? tot[s2 * 128 + d] : 0.f;
#pragma unroll
          for (int i = 0; i < 16; ++i) bL[(seg * 16 + i) * BLP + d] = lf[i] + off; }
        __syncthreads();
        const int t = tt * 16 + fr; const size_t tok = (size_t)c * 64 + t;
        bf16x8 sg_[2][4];
#define HG_LOAD(buf, kd_) { const int d0_ = (kd_) * 32 + fq * 8; \
            _Pragma("unroll") for (int vt = 0; vt < 4; ++vt) sg_[buf][vt] = *(const bf16x8*)(SP + ((size_t)(c * 8 + h) * 128 + (vh * 4 + vt) * 16 + fr) * 128 + d0_); }
        HG_LOAD(0, 0) HG_LOAD(1, 1)
        v2u sgw[4];
#pragma unroll
        for (int vt = 0; vt < 4; ++vt) sgw[vt] = *(const v2u*)(SG + tok * AW + h * 128 + (vh * 4 + vt) * 16 + fq * 4);
        f32x4 ngw[4];
#pragma unroll
        for (int vt = 0; vt < 4; ++vt) ngw[vt] = *(const f32x4*)(NG + h * 128 + (vh * 4 + vt) * 16 + fq * 4);
        { const int s = F.tid >> 3, dc = (F.tid & 7) * 16;
          const unsigned kq[8] = {kg0.x, kg0.y, kg0.z, kg0.w, kg1.x, kg1.y, kg1.z, kg1.w}, qq[8] = {qg0.x, qg0.y, qg0.z, qg0.w, qg1.x, qg1.y, qg1.z, qg1.w};
          unsigned ko[8], qto[8], qho[8];
#pragma unroll
          for (int j4 = 0; j4 < 4; ++j4) { const f32x4 bs = *(const LAS f32x4*)(bL + s * BLP + dc + 4 * j4), br = *(const LAS f32x4*)(bL + 31 * BLP + dc + 4 * j4);
#pragma unroll
              for (int hx = 0; hx < 2; ++hx) { const int w = 2 * j4 + hx; const float b0 = bs[2 * hx], b1 = bs[2 * hx + 1], r0 = br[2 * hx], r1 = br[2 * hx + 1];
                  const float k0 = bf_lo(kq[w]), k1 = bf_hi(kq[w]), q0 = bf_lo(qq[w]), q1 = bf_hi(qq[w]);
                  ko[w] = cvt_pk_bf16(k0 * fexp(fminf(r0 - b0, 80.f)), k1 * fexp(fminf(r1 - b1, 80.f)));
                  qto[w] = cvt_pk_bf16(q0 * fexp(fminf(b0 - r0, 80.f)), q1 * fexp(fminf(b1 - r1, 80.f)));
                  qho[w] = cvt_pk_bf16(q0 * fexp(b0), q1 * fexp(b1)); } }
          LAS v4u* kd_ = (LAS v4u*)(F.lds + HG_KS + (s * KSP + dc) * 2); kd_[0] = (v4u){ko[0], ko[1], ko[2], ko[3]}; kd_[1] = (v4u){ko[4], ko[5], ko[6], ko[7]};
          LAS v4u* qt_ = (LAS v4u*)(F.lds + HG_QT + (s * KSP + dc) * 2); qt_[0] = (v4u){qto[0], qto[1], qto[2], qto[3]}; qt_[1] = (v4u){qto[4], qto[5], qto[6], qto[7]};
          LAS v4u* qh_ = (LAS v4u*)(F.lds + HG_QH + (s * KSP + dc) * 2); qh_[0] = (v4u){qho[0], qho[1], qho[2], qho[3]}; qh_[1] = (v4u){qho[4], qho[5], qho[6], qho[7]}; }
        __syncthreads();
        f32x4 att[4], o[4];
#pragma unroll
        for (int i = 0; i < 4; ++i) { att[i] = (f32x4){0.f, 0.f, 0.f, 0.f}; o[i] = (f32x4){0.f, 0.f, 0.f, 0.f}; }
#pragma unroll
        for (int kd = 0; kd < 4; ++kd) {
            const int cb = kd & 1;
            const int fo = (kd * 32 + fq * 8) * 2;
            const bf16x8 Bqt = *(const LAS bf16x8*)(F.lds + HG_QT + (t * KSP) * 2 + fo), Bqh = *(const LAS bf16x8*)(F.lds + HG_QH + (t * KSP) * 2 + fo);
#pragma unroll
            for (int st = 0; st < 4; ++st) { const bf16x8 kt = *(const LAS bf16x8*)(F.lds + HG_KS + ((st * 16 + fr) * KSP) * 2 + fo);
                att[st] = __builtin_amdgcn_mfma_f32_16x16x32_bf16(kt, Bqt, att[st], 0, 0, 0); }
#pragma unroll
            for (int vt = 0; vt < 4; ++vt) o[vt] = __builtin_amdgcn_mfma_f32_16x16x32_bf16(sg_[cb][vt], Bqh, o[vt], 0, 0, 0);
            if (kd < 2) HG_LOAD(cb, kd + 2)
            if (kd == 1) { const int nu = unit + F.G; if (nu < NCH * 8) HGO_PREF(nu) }
        }
#undef HG_LOAD
#pragma unroll
        for (int ks = 0; ks < 2; ++ks) {
            float m8[8];
#pragma unroll
            for (int jj = 0; jj < 8; ++jj) { const int st = 2 * ks + (jj >> 2), r = jj & 3, s = st * 16 + fq * 4 + r; m8[jj] = (s <= t) ? att[st][r] : 0.f; }
            v4u pb; pb.x = cvt_pk_bf16(m8[0], m8[1]); pb.y = cvt_pk_bf16(m8[2], m8[3]); pb.z = cvt_pk_bf16(m8[4], m8[5]); pb.w = cvt_pk_bf16(m8[6], m8[7]);
            const bf16x8 B = __builtin_bit_cast(bf16x8, pb);
#pragma unroll
            for (int vt = 0; vt < 4; ++vt) { const int v = (vh * 4 + vt) * 16 + fr;
                const v2u a0 = *(const LAS v2u*)(VT + v * VTP + ks * 32 + fq * 4), a1 = *(const LAS v2u*)(VT + v * VTP + ks * 32 + 16 + fq * 4);
                const v4u pa = (v4u){a0.x, a0.y, a1.x, a1.y};
                o[vt] = __builtin_amdgcn_mfma_f32_16x16x32_bf16(__builtin_bit_cast(bf16x8, pa), B, o[vt], 0, 0, 0); }
        }
        float ss = 0.f;
#pragma unroll
        for (int vt = 0; vt < 4; ++vt)
#pragma unroll
            for (int r = 0; r < 4; ++r) ss += o[vt][r] * o[vt][r];
        ss += __shfl_xor(ss, 16); ss += __shfl_xor(ss, 32);
        if (fq == 0) red[F.wave * 16 + fr] = ss;
        LDS_WAIT(); __builtin_amdgcn_s_barrier(); asm volatile("" ::: "memory");
        const float tot = red[F.wave * 16 + fr] + red[(F.wave ^ 4) * 16 + fr];
        const float rstd = __builtin_amdgcn_rsqf(tot * (1.f / 128.f) + RMS_EPS);
#pragma unroll
        for (int vt = 0; vt < 4; ++vt) { const int v0 = (vh * 4 + vt) * 16 + fq * 4;
            const f32x4 g4 = ngw[vt]; const v2u sg = sgw[vt];
            v2u w; w.x = cvt_pk_bf16(o[vt][0] * rstd * g4[0] * bf_lo(sg.x), o[vt][1] * rstd * g4[1] * bf_hi(sg.x));
            w.y = cvt_pk_bf16(o[vt][2] * rstd * g4[2] * bf_lo(sg.y), o[vt][3] * rstd * g4[3] * bf_hi(sg.y));
            *(v2u*)(OAB + tok * 2048 + h * 128 + v0) = w; }
        LDS_WAIT(); __builtin_amdgcn_s_barrier(); asm volatile("" ::: "memory");
    }
#undef HGO_PREF
}

constexpr int S5_UT = 0, S5_UTP = 2064, S5_XST = 33024, S5_XSP = 272, S5_KM = 37376;
__device__ __forceinline__ void s5_load_ut(const Frame& F, const bf16* UB, int g, int jb) {
    v4u w0[2], w1[2];
#pragma unroll
    for (int i = 0; i < 2; ++i) { const int tl = F.tid + 512 * i; const v4u* src = (const v4u*)(UB + ((size_t)jb * 1024 + tl) * AW + g * 16); w0[i] = src[0]; w1[i] = src[1]; }
#pragma unroll
    for (int i = 0; i < 2; ++i) { const int tl = F.tid + 512 * i; LAS v4u* dst = (LAS v4u*)(F.lds + S5_UT + (tl >> 6) * S5_UTP + (tl & 63) * 32); dst[0] = w0[i]; dst[1] = w1[i]; }
}
__device__ __forceinline__ void phase_s5_local(const Frame& F0, int l) {
    Frame F = F0; F.tid = F.wave * 64 + lane_id(); asm volatile("" : "+v"(F.tid)); F.lane = F.tid & 63;
    unsigned char* ws = opqg(F.ws);
    const bf16* UB = (const bf16*)(ws + WS_UB); const bf16* PM = (const bf16*)(ws + WS_PM) + (size_t)l * 64 * 128 * 1024; float* XLOC = (float*)(ws + WS_XLOC);
    const int fr = F.lane & 15, fq = F.lane >> 4;
    for (int unit = F.vcu; unit < 64 * 8; unit += F.G) {
        const int g = unit >> 3, jb = unit & 7;
        const bf16* ap = PM + ((size_t)g * 128 + F.wave * 16 + fr) * 1024 + fq * 8;
        bf16x8 Af[32];
#pragma unroll
        for (int ks = 0; ks < 32; ++ks) Af[ks] = *(const bf16x8*)(ap + ks * 32);
        s5_load_ut(F, UB, g, jb);
        __syncthreads();
        f32x4 acc = (f32x4){0.f, 0.f, 0.f, 0.f};
        const LAS unsigned char* bp = F.lds + S5_UT + fr * S5_UTP + (fq >> 1) * 32 + (fq & 1) * 16;
#pragma unroll
        for (int ks = 0; ks < 32; ++ks) { const bf16x8 B = *(const LAS bf16x8*)(bp + ks * 64);
            acc = __builtin_amdgcn_mfma_f32_16x16x32_bf16(Af[ks], B, acc, 0, 0, 0); }
        *(f32x4*)(XLOC + ((size_t)(jb * 16 + fr) * 64 + g) * 128 + F.wave * 16 + fq * 4) = acc;
        __syncthreads();
    }
}
__device__ __forceinline__ void phase_s5_out(const Frame& F0, int l) {
    Frame F = F0; F.tid = F.wave * 64 + lane_id(); asm volatile("" : "+v"(F.tid)); F.lane = F.tid & 63;
    unsigned char* ws = opqg(F.ws);
    const bf16* UB = (const bf16*)(ws + WS_UB); const bf16* E = (const bf16*)(ws + WS_E) + (size_t)l * 64 * 1024 * 128; const bf16* KMAT = (const bf16*)(ws + WS_KMAT) + (size_t)l * 64 * 65 * 256;
    const float* XS = (const float*)(ws + WS_XS); bf16* YB = (bf16*)(ws + WS_YB);
    const int fr = F.lane & 15, fq = F.lane >> 4;
    for (int unit = F.vcu; unit < 64 * 8; unit += F.G) {
        const int g = unit >> 3, jb = unit & 7;
        { const int cc = F.tid >> 5, p0 = (F.tid & 31) * 4;
          const f32x4 xv = *(const f32x4*)(XS + ((size_t)(jb * 16 + cc) * 64 + g) * 128 + p0);
          v4u km[5];
#pragma unroll
          for (int k = 0; k < 5; ++k) { const int pc = F.tid + 512 * k; km[k] = (pc < 65 * 32) ? *(const v4u*)(KMAT + (size_t)g * 65 * 256 + (size_t)pc * 8) : (v4u){0u, 0u, 0u, 0u}; }
          s5_load_ut(F, UB, g, jb);
          v2u w; w.x = cvt_pk_bf16(xv[0], xv[1]); w.y = cvt_pk_bf16(xv[2], xv[3]); *(LAS v2u*)(F.lds + S5_XST + cc * S5_XSP + p0 * 2) = w;
#pragma unroll
          for (int k = 0; k < 5; ++k) { const int pc = F.tid + 512 * k; const int idx = pc >> 5, n = (pc >> 1) & 15, half = pc & 1;
              if (pc < 65 * 32) *(LAS v4u*)(F.lds + S5_KM + idx * 512 + n * 32 + ((half ^ (n >> 3)) * 16)) = km[k]; } }
        __syncthreads();
        for (int ti = 0; ti < 8; ++ti) {
            const int tau = ti * 8 + F.wave;
            const bf16* ep = E + ((size_t)g * 1024 + tau * 16 + fr) * 128 + fq * 8;
            bf16x8 Ae[4];
#pragma unroll
            for (int ke = 0; ke < 4; ++ke) Ae[ke] = *(const bf16x8*)(ep + ke * 32);
            f32x4 acc = (f32x4){0.f, 0.f, 0.f, 0.f}, acc1 = (f32x4){0.f, 0.f, 0.f, 0.f};
            const LAS unsigned char* bp = F.lds + S5_UT + fr * S5_UTP + (fq >> 1) * 32 + (fq & 1) * 16;
            const LAS unsigned char* kp = F.lds + S5_KM + (tau - (fq >> 1) + 1) * 512 + fr * 32 + (((fq & 1) ^ (fr >> 3)) * 16);
            const int nks = (tau >> 1) + 1;
            int ks = 0;
            for (; ks + 4 <= nks; ks += 4) {
                const bf16x8 A0 = *(const LAS bf16x8*)(kp - ks * 1024), A1 = *(const LAS bf16x8*)(kp - (ks + 1) * 1024), A2 = *(const LAS bf16x8*)(kp - (ks + 2) * 1024), A3 = *(const LAS bf16x8*)(kp - (ks + 3) * 1024);
                const bf16x8 B0 = *(const LAS bf16x8*)(bp + ks * 64), B1 = *(const LAS bf16x8*)(bp + (ks + 1) * 64), B2 = *(const LAS bf16x8*)(bp + (ks + 2) * 64), B3 = *(const LAS bf16x8*)(bp + (ks + 3) * 64);
                acc = __builtin_amdgcn_mfma_f32_16x16x32_bf16(A0, B0, acc, 0, 0, 0); acc1 = __builtin_amdgcn_mfma_f32_16x16x32_bf16(A1, B1, acc1, 0, 0, 0);
                acc = __builtin_amdgcn_mfma_f32_16x16x32_bf16(A2, B2, acc, 0, 0, 0); acc1 = __builtin_amdgcn_mfma_f32_16x16x32_bf16(A3, B3, acc1, 0, 0, 0); }
            for (; ks < nks; ++ks) { const bf16x8 A = *(const LAS bf16x8*)(kp - ks * 1024); const bf16x8 B = *(const LAS bf16x8*)(bp + ks * 64);
                acc = __builtin_amdgcn_mfma_f32_16x16x32_bf16(A, B, acc, 0, 0, 0); }
            const LAS unsigned char* xp = F.lds + S5_XST + fr * S5_XSP + fq * 16;
#pragma unroll
            for (int ke = 0; ke < 4; ke += 2) { const bf16x8 B0 = *(const LAS bf16x8*)(xp + ke * 64), B1 = *(const LAS bf16x8*)(xp + (ke + 1) * 64);
                acc = __builtin_amdgcn_mfma_f32_16x16x32_bf16(Ae[ke], B0, acc, 0, 0, 0); acc1 = __builtin_amdgcn_mfma_f32_16x16x32_bf16(Ae[ke + 1], B1, acc1, 0, 0, 0); }
            acc += acc1;
            v2u w; w.x = cvt_pk_bf16(gelu_tanh(acc[0]), gelu_tanh(acc[1])); w.y = cvt_pk_bf16(gelu_tanh(acc[2]), gelu_tanh(acc[3]));
            *(v2u*)(YB + ((size_t)(jb * 16 + fr) * 64 + tau) * AW + g * 16 + fq * 4) = w;
        }
        __syncthreads();
    }
}

__device__ __forceinline__ void phase_ln(const Frame& F0, int l, int which) {
    Frame F = F0; F.tid = F.wave * 64 + lane_id(); asm volatile("" : "+v"(F.tid)); F.lane = F.tid & 63;
    unsigned char* ws = opqg(F.ws); const __attribute__((address_space(4))) Args* a = opq(F.ka);
    const bf16* RS = (const bf16*)(ws + WS_RH); bf16* XS = (bf16*)(ws + WS_XH);
    const bool last = (which == 1 && l == DEPTH - 1); float* OUT = GP(float, a->out);
    const float* gam = GP(const float, a->in[which == 0 ? I_LN1G : I_LN2G]) + (size_t)l * D; const float* bet = GP(const float, a->in[which == 0 ? I_LN1B : I_LN2B]) + (size_t)l * D;
    const int gw = F.vcu * 8 + F.wave, NGW = F.G * 8;
    const int j = F.lane & 3, rr = (F.lane >> 2) & 1, sl = F.lane >> 3;
    LAS float* gamL = (LAS float*)(F.lds); LAS float* betL = gamL + D;
    ((LAS f32x4*)gamL)[F.tid] = ((const f32x4*)gam)[F.tid]; ((LAS f32x4*)betL)[F.tid] = ((const f32x4*)bet)[F.tid];
    __syncthreads();
    for (int rp = gw; rp < T / 2; rp += NGW) {
        const int row = 2 * rp + rr;
        const size_t eo = ((size_t)sl * T + row) * 32 + j * 8;
        v4u w[8];
#pragma unroll
        for (int i = 0; i < 8; ++i) w[i] = *(const v4u*)(RS + eo + (size_t)i * 8 * T * 32);
        float v[64]; float s = 0.f;
#pragma unroll
        for (int i = 0; i < 8; ++i) { const unsigned ww[4] = {w[i].x, w[i].y, w[i].z, w[i].w};
#pragma unroll
            for (int k = 0; k < 4; ++k) { const h2_t hv = __builtin_bit_cast(h2_t, ww[k]); v[8 * i + 2 * k] = (float)hv.x; v[8 * i + 2 * k + 1] = (float)hv.y; s += (float)hv.x + (float)hv.y; } }
        s += __shfl_xor(s, 1); s += __shfl_xor(s, 2); s += __shfl_xor(s, 8); s += __shfl_xor(s, 16); s += __shfl_xor(s, 32);
        const float mean = s * (1.f / D); float s2 = 0.f;
#pragma unroll
        for (int i = 0; i < 64; ++i) { v[i] -= mean; s2 += v[i] * v[i]; }
        s2 += __shfl_xor(s2, 1); s2 += __shfl_xor(s2, 2); s2 += __shfl_xor(s2, 8); s2 += __shfl_xor(s2, 16); s2 += __shfl_xor(s2, 32);
        const float rstd = __builtin_amdgcn_rsqf(s2 * (1.f / D) + LN_EPS);
        float amax = 0.f; int slv = sl; asm volatile("" : "+v"(slv));
#pragma unroll
        for (int i = 0; i < 8; ++i) { const int e0 = (8 * i + slv) * 32 + j * 8;
            const f32x4 g0 = *(const LAS f32x4*)(gamL + e0), g1 = *(const LAS f32x4*)(gamL + e0 + 4), b0 = *(const LAS f32x4*)(betL + e0), b1 = *(const LAS f32x4*)(betL + e0 + 4);
            const f32x4 y0 = (f32x4){v[8 * i], v[8 * i + 1], v[8 * i + 2], v[8 * i + 3]} * rstd * g0 + b0, y1 = (f32x4){v[8 * i + 4], v[8 * i + 5], v[8 * i + 6], v[8 * i + 7]} * rstd * g1 + b1;
            if (last) { *(f32x4*)(OUT + (size_t)row * D + e0) = y0; *(f32x4*)(OUT + (size_t)row * D + e0 + 4) = y1; }
            else { v4u o; o.x = cvt_pk_f16(y0[0], y0[1]); o.y = cvt_pk_f16(y0[2], y0[3]); o.z = cvt_pk_f16(y1[0], y1[1]); o.w = cvt_pk_f16(y1[2], y1[3]); *(v4u*)(XS + eo + (size_t)i * 8 * T * 32) = o; }
            if (!last) {
#pragma unroll
                for (int k = 0; k < 4; ++k) { v[8 * i + k] = y0[k]; v[8 * i + 4 + k] = y1[k]; amax = fmaxf(amax, fmaxf(fabsf(y0[k]), fabsf(y1[k]))); } } }
        if (!last) {
            amax = fmaxf(amax, __shfl_xor(amax, 1)); amax = fmaxf(amax, __shfl_xor(amax, 2)); amax = fmaxf(amax, __shfl_xor(amax, 8)); amax = fmaxf(amax, __shfl_xor(amax, 16)); amax = fmaxf(amax, __shfl_xor(amax, 32));
            const float inv = (amax > 0.f) ? 127.f / amax : 0.f;
            if (j == 0 && sl == 0) ((float*)(ws + WS_SX))[row] = (amax > 0.f) ? amax * (1.f / 127.f) : 1.f;
            unsigned char* xq = ws + WS_XQ + (size_t)row * 64 + (sl & 1) * 32 + j * 8;
#pragma unroll
            for (int i = 0; i < 8; ++i) { int q[8];
#pragma unroll
                for (int k = 0; k < 8; ++k) q[k] = (int)__builtin_rintf(v[8 * i + k] * inv);
                v2u o; o.x = (unsigned)(q[0] & 255) | ((unsigned)(q[1] & 255) << 8) | ((unsigned)(q[2] & 255) << 16) | ((unsigned)q[3] << 24);
                o.y = (unsigned)(q[4] & 255) | ((unsigned)(q[5] & 255) << 8) | ((unsigned)(q[6] & 255) << 16) | ((unsigned)q[7] << 24);
                *(v2u*)(xq + (size_t)(4 * i + (sl >> 1)) * T * 64) = o; } }
    }
    __syncthreads();
}

constexpr int PK_TV = 0, PK_EID = 65536, PK_GATE = 81920;
__device__ __forceinline__ int f2key(float x) { const int b = __float_as_int(x); return b ^ ((b >> 31) & 0x7fffffff); }
__device__ __forceinline__ float key2f(int k) { return __int_as_float(k ^ ((k >> 31) & 0x7fffffff)); }
__device__ __forceinline__ int imed3(int a, int b, int c) { int r; asm("v_med3_i32 %0, %1, %2, %3" : "=v"(r) : "v"(a), "v"(b), "v"(c)); return r; }
#define INSK(kx) do { const int _x = (kx); _Pragma("unroll") for (int _k = 15; _k > 0; --_k) tk[_k] = imed3(tk[_k - 1], tk[_k], _x); tk[0] = max(tk[0], _x); } while (0)
__device__ __forceinline__ void phase_topk(const Frame& F0, int l) {
    Frame F = F0; F.tid = F.wave * 64 + lane_id(); asm volatile("" : "+v"(F.tid)); F.lane = F.tid & 63;
    unsigned char* ws = opqg(F.ws);
    const float* SC = (const float*)(ws + WS_SC); int* SEID = (int*)(ws + WS_SEID); float* SGATE = (float*)(ws + WS_SGATE); unsigned char* START = ws + WS_START;
    LAS int* TK = (LAS int*)(F.lds + PK_TV); LAS int* EIDL = (LAS int*)(F.lds + PK_EID); LAS float* GATEL = (LAS float*)(F.lds + PK_GATE);
    for (int tb = F.vcu; tb < T / 32; tb += F.G) {
        const int t0 = tb * 32;
        { const int tok = F.tid >> 4, hh = F.tid & 15;
          const v4u* sp = (const v4u*)((const bf16*)SC + (size_t)(t0 + tok) * 2048 + hh * 128);
          int tk[16];
#pragma unroll
          for (int k = 0; k < 16; ++k) tk[k] = (int)0x80000000;
#pragma unroll 1
          for (int i4 = 0; i4 < 16; i4 += 4) { v4u sa[4];
#pragma unroll
              for (int i = 0; i < 4; ++i) sa[i] = sp[i4 + i];
#pragma unroll
              for (int i = 0; i < 4; ++i) { const v4u s0 = sa[i]; const unsigned sw[4] = {s0.x, s0.y, s0.z, s0.w}; const int ib = 127 - 8 * (i4 + i);
#pragma unroll
                  for (int x = 0; x < 4; ++x) { INSK((f2key(bf_lo(sw[x])) & ~127) | (ib - 2 * x)); INSK((f2key(bf_hi(sw[x])) & ~127) | (ib - 2 * x - 1)); } } }
#pragma unroll
          for (int k = 0; k < 16; ++k) TK[F.tid * 16 + k] = tk[k]; }
        __syncthreads();
        if ((F.tid & 1) == 0) {
            float v1[16], v2[16];
#pragma unroll
            for (int k = 0; k < 16; ++k) { v1[k] = key2f(TK[F.tid * 16 + k] & ~127); v2[k] = key2f(TK[(F.tid + 1) * 16 + k] & ~127); }
            int tk[16];
#pragma unroll
            for (int k = 0; k < 16; ++k) tk[k] = (int)0x80000000;
#pragma unroll
            for (int aa = 0; aa < 16; ++aa)
#pragma unroll
                for (int bb = 0; bb < 16; ++bb) if ((aa + 1) * (bb + 1) <= 16) { INSK((f2key(v1[aa] + v2[bb]) & ~255) | (255 - (aa * 16 + bb))); }
            float ex[16], sum = 0.f; const float v0 = key2f(tk[0] & ~255);
#pragma unroll
            for (int k = 0; k < 16; ++k) { ex[k] = expf(key2f(tk[k] & ~255) - v0); sum += ex[k]; }
            const float inv = 1.f / sum;
            const int tok = F.tid >> 4, hd = (F.tid >> 1) & 7;
#pragma unroll
            for (int k = 0; k < 16; ++k) { const int code = 255 - (tk[k] & 255);
                const int i1 = 127 - (TK[F.tid * 16 + (code >> 4)] & 127), i2 = 127 - (TK[(F.tid + 1) * 16 + (code & 15)] & 127);
                EIDL[tok * 128 + hd * 16 + k] = (((i1 + i2) & 15) << 10) + i1 * 8 + (i2 >> 4); GATEL[tok * 128 + hd * 16 + k] = ex[k] * inv; }
        }
        __syncthreads();
        for (int ti = 0; ti < 4; ++ti) {
            const int tok = F.wave * 4 + ti;
            int k0 = (EIDL[tok * 128 + F.lane] << 7) | F.lane, k1 = (EIDL[tok * 128 + 64 + F.lane] << 7) | (64 + F.lane);
#pragma unroll
            for (int k = 2; k <= 128; k <<= 1)
#pragma unroll
                for (int j = k >> 1; j > 0; j >>= 1) {
                    if (j == 64) { const int mn = min(k0, k1), mx = max(k0, k1); k0 = mn; k1 = mx; }
                    else { const int o0 = __shfl_xor(k0, j), o1 = __shfl_xor(k1, j); const bool lower = (F.lane & j) == 0;
                        const bool up0 = (F.lane & k) == 0, up1 = ((64 + F.lane) & k) == 0;
                        k0 = (up0 == lower) ? min(k0, o0) : max(k0, o0); k1 = (up1 == lower) ? min(k1, o1) : max(k1, o1); }
                }
            const size_t t = (size_t)(t0 + tok);
            { const int r0 = k0 >> 17, r1 = k1 >> 17; int mine = 0;
#pragma unroll
              for (int r = 1; r < 16; ++r) { const int c = __builtin_popcountll(__ballot(r0 < r)) + __builtin_popcountll(__ballot(r1 < r)); mine = (F.lane == r) ? c : mine; }
              if (F.lane < 16) START[t * 16 + F.lane] = (unsigned char)mine; }
            SEID[t * LP + F.lane] = k0 >> 7; SEID[t * LP + 64 + F.lane] = k1 >> 7;
            SGATE[t * 128 + F.lane] = GATEL[tok * 128 + (k0 & 127)]; SGATE[t * 128 + 64 + F.lane] = GATEL[tok * 128 + (k1 & 127)];
        }
        __syncthreads();
    }
}
typedef __bf16 bf2_t __attribute__((ext_vector_type(2)));
__device__ __forceinline__ float dot2bf(unsigned a, unsigned b, float c) { return __builtin_amdgcn_fdot2_f32_bf16(__builtin_bit_cast(bf2_t, a), __builtin_bit_cast(bf2_t, b), c, false); }
__device__ __forceinline__ void peer_stage(const Frame& F, const bf16* gsrc, int bo) {
#pragma unroll
    for (int i = 0; i < 8; ++i) { const int p = i * 8 + F.wave;
        __builtin_amdgcn_global_load_lds((const unsigned*)((const char*)gsrc + p * 1024 + F.lane * 16), (LAS unsigned*)(F.lds + bo + p * 1024), 16, 0, 0); }
}
__device__ __forceinline__ void peer_dma(const Frame& F, const void* gsrc, int bo) {
    const unsigned ldsbase = (unsigned)(size_t)(F.lds + bo) + (unsigned)F.wave * 1024u;
#pragma unroll
    for (int i = 0; i < 8; ++i) { const char* g = (const char*)gsrc + (i * 8 + F.wave) * 1024 + F.lane * 16; const unsigned m = ldsbase + i * 8192u;
        asm volatile("s_mov_b32 m0, %0\n\ts_nop 0\n\tglobal_load_lds_dwordx4 %1, off" :: "s"(m), "v"((GAS const char*)g) : "memory"); }
}
__device__ __forceinline__ int wave_max_i(int v) {
#pragma unroll
    for (int o = 1; o < 64; o <<= 1) v = max(v, __shfl_xor(v, o));
    return __builtin_amdgcn_readfirstlane(v);
}
template <int K> __device__ __forceinline__ unsigned dppq(unsigned v) { return (unsigned)__builtin_amdgcn_mov_dpp((int)v, K * 0x55, 0xf, 0xf, true); }
__device__ __forceinline__ int sdot4(unsigned a, unsigned b, int c) { return __builtin_amdgcn_sdot4((int)a, (int)b, c, false); }
__device__ __forceinline__ int quad_sum_i(int v) {
    v += __builtin_amdgcn_mov_dpp(v, 0xB1, 0xf, 0xf, true);
    v += __builtin_amdgcn_mov_dpp(v, 0x4E, 0xf, 0xf, true);
    return v;
}
__device__ __forceinline__ float quad_sum(float v) {
    v += __int_as_float(__builtin_amdgcn_mov_dpp(__float_as_int(v), 0xB1, 0xf, 0xf, true));
    v += __int_as_float(__builtin_amdgcn_mov_dpp(__float_as_int(v), 0x4E, 0xf, 0xf, true));
    return v;
}
constexpr int UCAP0 = 24, UCAP1 = 12, UCAP2 = 12, UCAP3 = 8;
__device__ __forceinline__ void phase_peer_u(const Frame& F0, int l) {
    Frame F = F0; F.tid = F.wave * 64 + lane_id(); asm volatile("" : "+v"(F.tid)); F.lane = F.tid & 63;
    unsigned char* ws = opqg(F.ws);
    const bf16* TU = (const bf16*)(ws + WS_TBU) + (size_t)l * 32 * NEXP * 32;
    const int* SEID = (const int*)(ws + WS_SEID); const float* SGATE = (const float*)(ws + WS_SGATE); unsigned* PACK = (unsigned*)(ws + WS_PACK); unsigned char* START = ws + WS_START;
    const bf16* XBS = (const bf16*)(ws + WS_XQ); unsigned* PACK2 = (unsigned*)(ws + WS_PACK2);
    const float* SX = (const float*)(ws + WS_SX); const float* SU = (const float*)(ws + WS_SU) + (size_t)l * NEXP;
    const int qd = F.lane >> 2, jc = F.lane & 3;
    for (int unit = F.vcu; unit < 256; unit += F.G) {
        const int tt = unit & 15, er = unit >> 4; const size_t t = (size_t)tt * 512 + F.tid;
        const int lo = START[t * 16 + er], hi = (er < 15) ? (int)START[t * 16 + er + 1] : 128;
        const int cnt = hi - lo;
        int key = (cnt << 6) | (63 - F.lane);
#pragma unroll
        for (int k = 2; k <= 64; k <<= 1)
#pragma unroll
            for (int j = k >> 1; j > 0; j >>= 1) { const int o = __shfl_xor(key, j); const bool lower = (F.lane & j) == 0, up = (F.lane & k) == 0;
                key = (up == lower) ? max(key, o) : min(key, o); }
        int tl[4], glo[4], gcnt[4], gmax[4];
#pragma unroll
        for (int a = 0; a < 4; ++a) { const int kk = __shfl(key, a * 16 + qd); tl[a] = 63 - (kk & 63); gcnt[a] = kk >> 6; glo[a] = __shfl(lo, tl[a]);
            gmax[a] = __builtin_amdgcn_readfirstlane(__shfl(key, a * 16)) >> 6; }
        const size_t tbase = (size_t)tt * 512 + F.wave * 64;
        unsigned ro0[UCAP0 / 4], ro1[UCAP1 / 4], ro2[UCAP2 / 4], ro3[UCAP3 / 4];
#define LOADRO(arr, a, CAP) _Pragma("unroll") for (int i = 0; i < CAP / 4; ++i) { const int s = 4 * i + jc; const int e = SEID[(tbase + tl[a]) * LP + glo[a] + s]; \
            const int row = (s < gcnt[a]) ? (e & 1023) : 0; arr[i] = (unsigned)((row << 6) + (((row >> 2) & 3) << 4)); }
        LOADRO(ro0, 0, UCAP0) LOADRO(ro1, 1, UCAP1) LOADRO(ro2, 2, UCAP2) LOADRO(ro3, 3, UCAP3)
#undef LOADRO
        int ac0[UCAP0], ac1[UCAP1], ac2[UCAP2], ac3[UCAP3];
#pragma unroll
        for (int s = 0; s < UCAP0; ++s) ac0[s] = 0;
#pragma unroll
        for (int s = 0; s < UCAP1; ++s) ac1[s] = 0;
#pragma unroll
        for (int s = 0; s < UCAP2; ++s) ac2[s] = 0;
#pragma unroll
        for (int s = 0; s < UCAP3; ++s) ac3[s] = 0;
        const bf16* gsl0 = TU + (size_t)er * 1024 * 32;
#define XA(a) ((const v4u*)(XBS + (tbase + tl[a]) * 32) + jc)
        v4u xs[4];
#pragma unroll
        for (int a = 0; a < 4; ++a) xs[a] = XA(a)[0];
        peer_dma(F, gsl0, 0);
        VM_WAIT(); __syncthreads();
#pragma unroll 1
        for (int ks = 0; ks < 32; ++ks) {
            const int bo = (ks & 1) * 65536, jx = jc << 4;
            v4u xn[4];
            const int kn = (ks + 1 < 32) ? ks + 1 : ks;
#pragma unroll
            for (int a = 0; a < 4; ++a) xn[a] = XA(a)[(size_t)kn * T * 4];
            if (ks + 1 < 32) peer_dma(F, gsl0 + (size_t)kn * NEXP * 32, bo ^ 65536);
#define URD(B, arr, g) { asm volatile("" : "+v"(arr[g])); B[0] = *(const LAS v4u*)(F.lds + bo + (dppq<0>(arr[g]) ^ jx)); B[1] = *(const LAS v4u*)(F.lds + bo + (dppq<1>(arr[g]) ^ jx)); \
                B[2] = *(const LAS v4u*)(F.lds + bo + (dppq<2>(arr[g]) ^ jx)); B[3] = *(const LAS v4u*)(F.lds + bo + (dppq<3>(arr[g]) ^ jx)); }
#define UCP(B, acc, a, g) { _Pragma("unroll") for (int q = 0; q < 4; ++q) { int p0 = acc[4 * (g) + q]; \
                p0 = sdot4(B[q].x, xs[a].x, p0); p0 = sdot4(B[q].y, xs[a].y, p0); p0 = sdot4(B[q].z, xs[a].z, p0); p0 = sdot4(B[q].w, xs[a].w, p0); acc[4 * (g) + q] = p0; } }
            { v4u BE[4], BO[4];
              URD(BE, ro0, 0) __builtin_amdgcn_sched_barrier(0);
              URD(BO, ro0, 1) UCP(BE, ac0, 0, 0)
              __builtin_amdgcn_sched_barrier(0);
              URD(BE, ro0, 2) UCP(BO, ac0, 0, 1)
              __builtin_amdgcn_sched_barrier(0);
              URD(BO, ro0, 3) UCP(BE, ac0, 0, 2)
              __builtin_amdgcn_sched_barrier(0);
              URD(BE, ro0, 4) UCP(BO, ac0, 0, 3)
              __builtin_amdgcn_sched_barrier(0);
              URD(BO, ro0, 5) UCP(BE, ac0, 0, 4)
              __builtin_amdgcn_sched_barrier(0);
              URD(BE, ro1, 0) UCP(BO, ac0, 0, 5)
              __builtin_amdgcn_sched_barrier(0);
              URD(BO, ro1, 1) UCP(BE, ac1, 1, 0)
              __builtin_amdgcn_sched_barrier(0);
              URD(BE, ro1, 2) UCP(BO, ac1, 1, 1)
              __builtin_amdgcn_sched_barrier(0);
              URD(BO, ro2, 0) UCP(BE, ac1, 1, 2)
              __builtin_amdgcn_sched_barrier(0);
              URD(BE, ro2, 1) UCP(BO, ac2, 2, 0)
              __builtin_amdgcn_sched_barrier(0);
              URD(BO, ro2, 2) UCP(BE, ac2, 2, 1)
              __builtin_amdgcn_sched_barrier(0);
              URD(BE, ro3, 0) UCP(BO, ac2, 2, 2)
              __builtin_amdgcn_sched_barrier(0);
              URD(BO, ro3, 1) UCP(BE, ac3, 3, 0)
              __builtin_amdgcn_sched_barrier(0);
              UCP(BO, ac3, 3, 1) }
#undef URD
#undef UCP
#pragma unroll
            for (int a = 0; a < 4; ++a) xs[a] = xn[a];
            VM_WAIT(); __syncthreads();
        }
        float gt0[UCAP0 / 4], gt1[UCAP1 / 4], gt2[UCAP2 / 4], gt3[UCAP3 / 4];
        float sq0[UCAP0 / 4], sq1[UCAP1 / 4], sq2[UCAP2 / 4], sq3[UCAP3 / 4];
#define UGT(gt, sq, arr, a, CAP) { const float* gp_ = SGATE + (tbase + tl[a]) * 128; const float sx_ = SX[tbase + tl[a]]; _Pragma("unroll") for (int i = 0; i < CAP / 4; ++i) { gt[i] = gp_[min(glo[a] + 4 * i + jc, 127)]; sq[i] = sx_ * SU[er * 1024 + (int)(arr[i] >> 6)]; } }
        UGT(gt0, sq0, ro0, 0, UCAP0) UGT(gt1, sq1, ro1, 1, UCAP1) UGT(gt2, sq2, ro2, 2, UCAP2) UGT(gt3, sq3, ro3, 3, UCAP3)
#undef UGT
#define UOUT(arr, acc, gt, sq, a, CAP) { const size_t tk = tbase + tl[a]; _Pragma("unroll") for (int s = 0; s < CAP; ++s) { const int toti = quad_sum_i(acc[s]); \
            if ((s & 3) == jc && s < NSLOT) { unsigned wv = 0u; if (s < gcnt[a]) { const float av = gelu_tanh((float)toti * sq[s >> 2]) * gt[s >> 2]; wv = (arr[s >> 2] << 16) | (cvt_pk_f16(av, 0.f) & 0xffffu); } \
                PACK2[(tk * 16 + er) * NSLOT + s] = wv; } } \
            _Pragma("unroll") for (int s = CAP; s < NSLOT; ++s) if ((s & 3) == jc && s >= gcnt[a]) PACK2[(tk * 16 + er) * NSLOT + s] = 0u; }
        UOUT(ro0, ac0, gt0, sq0, 0, UCAP0) UOUT(ro1, ac1, gt1, sq1, 1, UCAP1) UOUT(ro2, ac2, gt2, sq2, 2, UCAP2) UOUT(ro3, ac3, gt3, sq3, 3, UCAP3)
#undef UOUT
#undef XA
        { int myrank = 0; const int mykey = (cnt << 6) | (63 - F.lane);
          for (int p = 0; p < 64; ++p) myrank += (__shfl(key, p) > mykey) ? 1 : 0;
          const int cap = myrank < 16 ? UCAP0 : (myrank < 32 ? UCAP1 : (myrank < 48 ? UCAP2 : UCAP3));
          const v4u* xsp = (const v4u*)(XBS + t * 32);
          for (int s = cap; s < cnt; ++s) {
              const int pos = lo + s, e = SEID[t * LP + pos]; const int f = (e >> 2) & 3; int di = 0;
              for (int ks = 0; ks < 32; ++ks)
#pragma unroll
                  for (int j = 0; j < 4; ++j) { const v4u u4 = *(const v4u*)(TU + (((size_t)ks * NEXP + e) * 4 + (j ^ f)) * 8); const v4u x4 = xsp[(size_t)ks * T * 4 + j];
                      di = sdot4(u4.x, x4.x, di); di = sdot4(u4.y, x4.y, di); di = sdot4(u4.z, x4.z, di); di = sdot4(u4.w, x4.w, di); }
              const float d = (float)di * SX[t] * SU[e];
              const int row = e & 1023;
              const unsigned wv = ((unsigned)((row << 6) + (((row >> 2) & 3) << 4)) << 16) | (cvt_pk_f16(gelu_tanh(d) * SGATE[t * 128 + pos], 0.f) & 0xffffu);
              if (s < NSLOT) PACK2[(t * 16 + er) * NSLOT + s] = wv; else PACK[t * LP + pos] = wv; }
        }
    }
}
#ifndef VBLK
#define VBLK 2
#endif
#if VBLK == 4
#define VTT(x, j) (4 * ((x) & 3) + ((j) & 3))
#define VDS(x, j, it) (32 * ((x) >> 2) + 8 * (it) + ((j) >> 2))
#elif VBLK == 8
#define VTT(x, j) (8 * ((x) & 1) + ((j) & 7))
#define VDS(x, j, it) (16 * ((x) >> 1) + 4 * (it) + ((j) >> 3))
#elif VBLK == 2
#define VTT(x, j) (2 * (x) + ((j) & 1))
#define VDS(x, j, it) (16 * (it) + ((j) >> 1))
#else
#define VTT(x, j) ((j) & 15)
#define VDS(x, j, it) (((x) * 32 + (j) + 256 * (it)) >> 4)
#endif
__device__ __forceinline__ void phase_peer_v(const Frame& F0, int l) {
    Frame F = F0; F.tid = F.wave * 64 + lane_id(); asm volatile("" : "+v"(F.tid)); F.lane = F.tid & 63;
    unsigned char* ws = opqg(F.ws);
    const bf16* TV = (const bf16*)(ws + WS_TBV) + (size_t)l * 64 * NEXP * 32; const bf16* XS = (const bf16*)(ws + WS_XH); bf16* RS = (bf16*)(ws + WS_RH);
    const unsigned* PACK = (const unsigned*)(ws + WS_PACK); const unsigned char* START = ws + WS_START; const unsigned* PACK2 = (const unsigned*)(ws + WS_PACK2);
    for (int it = 0; it * F.G + F.vcu < 1024; ++it) {
        int tt, ds;
        if (F.G == 256) { const int x = F.vcu >> 5, j = F.vcu & 31; tt = VTT(x, j); ds = VDS(x, j, it); }
        else { const int unit = it * F.G + F.vcu; tt = unit & 15; ds = unit >> 4; }
        const size_t t = (size_t)tt * 512 + F.tid;
        const v4u st4 = *(const v4u*)(START + t * 16);
        const unsigned stw[4] = {st4.x, st4.y, st4.z, st4.w};
        unsigned acc[16];
#pragma unroll
        for (int i = 0; i < 16; ++i) acc[i] = 0u;
        const bf16* gsl0 = TV + (size_t)ds * NEXP * 32;
        unsigned Lc[NSLOT];
        { const v4u* lp = (const v4u*)(PACK2 + t * 16 * NSLOT);
#pragma unroll
          for (int s = 0; s < NSLOT / 4; ++s) { const v4u q = lp[s]; Lc[4 * s] = q.x; Lc[4 * s + 1] = q.y; Lc[4 * s + 2] = q.z; Lc[4 * s + 3] = q.w; } }
        peer_dma(F, gsl0, 0);
        VM_WAIT(); __syncthreads();
#pragma unroll 1
        for (int c = 0; c < 16; ++c) {
            const int bo = (c & 1) * 65536;
            const int q0 = c >> 2, q1 = (c + 1) >> 2;
            const unsigned w0 = q0 == 0 ? stw[0] : (q0 == 1 ? stw[1] : (q0 == 2 ? stw[2] : stw[3])), w1 = q1 == 0 ? stw[0] : (q1 == 1 ? stw[1] : (q1 == 2 ? stw[2] : stw[3]));
            const int s_c = (int)((w0 >> ((c & 3) * 8)) & 255u);
            const int s_n = (c < 15) ? (int)((w1 >> (((c + 1) & 3) * 8)) & 255u) : 128;
            const int n_c = s_n - s_c;
            unsigned Ln[NSLOT];
            const int cn = (c < 15) ? c + 1 : c;
            { const v4u* lp = (const v4u*)(PACK2 + (t * 16 + cn) * NSLOT);
#pragma unroll
              for (int s = 0; s < NSLOT / 4; ++s) { const v4u q = lp[s]; Ln[4 * s] = q.x; Ln[4 * s + 1] = q.y; Ln[4 * s + 2] = q.z; Ln[4 * s + 3] = q.w; } }
            if (c < 15) peer_dma(F, gsl0 + (size_t)cn * 1024 * 32, bo ^ 65536);
            const int wmax = wave_max_i(min(n_c, NSLOT));
#pragma unroll
            for (int g = 0; g < NSLOT / 2; ++g) {
                if (2 * g < wmax) {
                    v4u v4[2][4]; unsigned a2[2];
#pragma unroll
                    for (int q = 0; q < 2; ++q) { const int s = 2 * g + q; const unsigned w = Lc[s];
                        a2[q] = __builtin_amdgcn_perm(w, w, 0x01000100u);
                        const int a0 = bo + (int)((w >> 16) & 0xfff0u);
#pragma unroll
                        for (int j = 0; j < 4; ++j) v4[q][j] = *(const LAS v4u*)(F.lds + (a0 ^ (j << 4))); }
#pragma unroll
                    for (int q = 0; q < 2; ++q)
#pragma unroll
                        for (int j = 0; j < 4; ++j) {
                            acc[4 * j + 0] = pkfmah(v4[q][j].x, a2[q], acc[4 * j + 0]); acc[4 * j + 1] = pkfmah(v4[q][j].y, a2[q], acc[4 * j + 1]);
                            acc[4 * j + 2] = pkfmah(v4[q][j].z, a2[q], acc[4 * j + 2]); acc[4 * j + 3] = pkfmah(v4[q][j].w, a2[q], acc[4 * j + 3]); }
                }
            }
            for (int s = NSLOT; s < n_c; ++s) {
                const unsigned w = PACK[t * LP + s_c + s]; const unsigned a2 = (w & 0xffffu) | (w << 16);
                const int a0 = bo + (int)((w >> 16) & 0xfff0u);
#pragma unroll
                for (int j = 0; j < 4; ++j) { const v4u v4 = *(const LAS v4u*)(F.lds + (a0 ^ (j << 4)));
                    acc[4 * j + 0] = pkfmah(v4.x, a2, acc[4 * j + 0]); acc[4 * j + 1] = pkfmah(v4.y, a2, acc[4 * j + 1]);
                    acc[4 * j + 2] = pkfmah(v4.z, a2, acc[4 * j + 2]); acc[4 * j + 3] = pkfmah(v4.w, a2, acc[4 * j + 3]); }
            }
            VM_WAIT(); __syncthreads();
#pragma unroll
            for (int s = 0; s < NSLOT; ++s) Lc[s] = Ln[s];
        }
        const v4u* xp = (const v4u*)(XS + ((size_t)ds * T + t) * 32); v4u* rp = (v4u*)(RS + ((size_t)ds * T + t) * 32);
        v4u xw4[4];
#pragma unroll
        for (int j = 0; j < 4; ++j) xw4[j] = xp[j];
#pragma unroll
        for (int j = 0; j < 4; ++j) { const v4u xw = xw4[j]; const unsigned xx[4] = {xw.x, xw.y, xw.z, xw.w}; unsigned o[4];
#pragma unroll
            for (int k = 0; k < 4; ++k) { const h2_t xv = __builtin_bit_cast(h2_t, xx[k]), yv = __builtin_bit_cast(h2_t, acc[4 * j + k]);
                o[k] = cvt_pk_f16((float)xv.x * ALPHA + (float)yv.x, (float)xv.y * ALPHA + (float)yv.y); }
            rp[j] = (v4u){o[0], o[1], o[2], o[3]}; }
    }
}

constexpr int PH_PER_LAYER = 13, N_PHASES = 2 + DEPTH * PH_PER_LAYER;
__global__ void __launch_bounds__(512, 2) fwd_kernel(Args args) {
    extern __shared__ __attribute__((aligned(16))) unsigned char lds[];
    Frame F;
    F.lds = (LAS unsigned char*)lds;
    F.wave = __builtin_amdgcn_readfirstlane((int)threadIdx.x >> 6); F.tid = 0; F.lane = 0;
    F.G = gridDim.x; { const int bx = blockIdx.x; F.vcu = (F.G % 8 == 0) ? (bx % 8) * (F.G / 8) + bx / 8 : bx; }
    F.ws = args.ws; F.ka = (const __attribute__((address_space(4))) Args*)__builtin_amdgcn_kernarg_segment_ptr();
    unsigned char* ws = args.ws;
    for (int u = F.wave * 64 + lane_id(); u < (LDS_BYTES - LDSCTL_OFF) / 4; u += 512) ((LAS unsigned*)(F.lds + LDSCTL_OFF))[u] = 0u;
    __syncthreads();
    XcdBarrier bar; bar.bar = (unsigned*)(ws + WS_CTL) + CW_BAR; bar.x = 0; bar.st = nullptr;
    const int lo = args.ph_lo, hi = args.ph_hi;
    if (hi - lo > 1) bar = xcd_barrier_post((unsigned*)(ws + WS_CTL) + CW_BAR, (volatile LAS unsigned*)(F.lds + MISC_OFF) + 8, F.wave == 0 && lane_id() == 0);
#ifndef PHMASK
#define PHMASK 0xFFF
#endif
#define EN(i) ((PHMASK >> (i)) & 1)
#ifndef RPT
#define RPT 0
#endif
#define REP(i) for (int _r = 0; _r <= ((RPT >> (i)) & 1); ++_r)
#define IN(k) (lo <= (k) && (k) < hi)
#define SEAM(k) do { if (IN((k) + 1)) xcd_barrier(bar, F.wave); } while (0)

    if (EN(10) && IN(0)) { REP(13) { phase_prologue_a(F); } SEAM(0); }
    if (EN(11) && IN(1)) REP(14) {
        phase_prologue_b(F);
        unsigned char* ws = opqg(args.ws);
        quant_rows(F, (const bf16*)(ws + WS_WIN), 4096, NIN, 5120, ws + WS_WG8, (float*)(ws + WS_SWG));
        int kc = 256; asm volatile("" : "+s"(kc));
        pg8::Gemm g{(const bf16*)(ws + WS_BK), (const bf16*)(ws + WS_WQB), DEPTH * 2048, 2048, kc, 256, 2048, 256, (long)2048 * 2048};
        pg8::StaticOrder S; S.init(DEPTH * 2048, 2048, F.G, (int)blockIdx.x);
        pg8::EpiF16 E{(bf16*)(ws + WS_WPQ), 2048};
        pg8::gemm_phase<pg8::EpiF16, pg8::StaticOrder, true>(F.lds, g, S, E, F.wave);
        if (_r == ((RPT >> 14) & 1)) SEAM(1);
    }
    for (int l = 0; l < DEPTH; ++l) {
        const int pb = 2 + l * PH_PER_LAYER;
        if (EN(0) && IN(pb + 0)) REP(0) {
            unsigned char* ws = opqg(args.ws);
            pg8::Gemm g{(const bf16*)(ws + WS_XH), (const bf16*)(ws + WS_WIN) + (size_t)l * NIN * D, T, NIN, D, T, D, 0, 0};
            pg8::EpiIn E{(bf16*)(ws + WS_Q), (bf16*)(ws + WS_KK), (bf16*)(ws + WS_V), (bf16*)(ws + WS_SG), (bf16*)(ws + WS_UB), (bf16*)(ws + WS_GR), (bf16*)(ws + WS_GB),
                         (float*)(ws + WS_LOGF), (const float*)(ws + WS_LB) + l * AW};
            if (F.G == 256) {
                const int x = (int)blockIdx.x & 7, j = (int)blockIdx.x >> 3;
                pg8::ListOrder Sf{j < 16 ? 3 * j : 48 + 2 * (j - 16), j < 16 ? 3 : 2, x, 0};
                pg8::gemm_phase<pg8::EpiIn, pg8::ListOrder, true, true, true>(F.lds, g, Sf, E, F.wave);
                pg8::Gemm g8{(const bf16*)(ws + WS_XQ), (const bf16*)(ws + WS_WG8) + ((size_t)l * 4096 - 20 * 256) * 1024, T, NIN, 1024, T, 1024, 0, 0};
                pg8::ListOrder Si{j < 16 ? j : 16 + 3 * (j - 16), j < 16 ? 1 : 3, x, 20};
                pg8::EpiGate8 E8{(bf16*)(ws + WS_GR), (bf16*)(ws + WS_GB), (const float*)(ws + WS_SX), (const float*)(ws + WS_SWG) + l * 4096};
                pg8::gemm_phase<pg8::EpiGate8, pg8::ListOrder, true, false, true, true>(F.lds, g8, Si, E8, F.wave);
            } else {
                pg8::StaticOrder S; S.init(T, NIN, F.G, (int)blockIdx.x);
                pg8::gemm_phase<pg8::EpiIn, pg8::StaticOrder, true, true, true>(F.lds, g, S, E, F.wave);
            }
            if (_r == ((RPT >> 0) & 1)) SEAM(pb + 0);
        }
        if (EN(1) && IN(pb + 1)) { REP(1) { REP(17) { phase_hgrn_local(F, l); } REP(18) { phase_s5_local(F, l); } } if (l == 0) { unsigned char* ws = opqg(args.ws); quant_rows(F, (const bf16*)(ws + WS_WPQ), 2048, 2048, 0, ws + WS_WP8, (float*)(ws + WS_SW)); } SEAM(pb + 1); }
        if (EN(2) && IN(pb + 2)) { REP(2) { phase_scan(F, l); } SEAM(pb + 2); }
        if (EN(3) && IN(pb + 3)) { REP(3) { REP(15) { phase_hgrn_out(F, l); } REP(16) { phase_s5_out(F, l); } } SEAM(pb + 3); }
        if (EN(4) && IN(pb + 4)) REP(4) {
            unsigned char* ws = opqg(args.ws);
            pg8::Gemm g{(const bf16*)(ws + WS_YB), (const bf16*)(ws + WS_WGLU) + (size_t)l * 2048 * 1024, T, 2048, 1024, 1024, 1024, 0, 0};
            pg8::EpiGlu E{(bf16*)(ws + WS_OAB) + 1024, 2048};
            pg8::StaticOrder S; S.init(T, 2048, F.G, (int)blockIdx.x);
            pg8::gemm_phase<pg8::EpiGlu, pg8::StaticOrder, true>(F.lds, g, S, E, F.wave);
            if (_r == ((RPT >> 4) & 1)) SEAM(pb + 4);
        }
        if (EN(5) && IN(pb + 5)) REP(5) {
            unsigned char* ws = opqg(args.ws);
            pg8::Gemm g{(const bf16*)(ws + WS_OAB), (const bf16*)(ws + WS_WUP) + (size_t)l * 2048 * 2048, T, 2048, 2048, 2048, 2048, 0, 0};
            pg8::StaticOrder S; S.init(T, 2048, F.G, (int)blockIdx.x);
            pg8::EpiUp E{(bf16*)(ws + WS_MG), (const bf16*)(ws + WS_GR), (const bf16*)(ws + WS_GB)};
            pg8::gemm_phase<pg8::EpiUp, pg8::StaticOrder, true>(F.lds, g, S, E, F.wave);
            if (_r == ((RPT >> 5) & 1)) SEAM(pb + 5);
        }
        if (EN(6) && IN(pb + 6)) REP(6) {
            unsigned char* ws = opqg(args.ws);
            pg8::Gemm g{(const bf16*)(ws + WS_MG), (const bf16*)(ws + WS_WO) + (size_t)l * 2048 * 2048, T, 2048, 2048, 2048, 2048, 0, 0};
            pg8::StaticOrder S; S.init(T, 2048, F.G, (int)blockIdx.x);
            pg8::EpiResH E{(bf16*)(ws + WS_RH), (const bf16*)(ws + WS_XH)};
            pg8::gemm_phase<pg8::EpiResH, pg8::StaticOrder, true>(F.lds, g, S, E, F.wave);
            if (_r == ((RPT >> 6) & 1)) SEAM(pb + 6);
        }
        if (EN(7) && IN(pb + 7)) { REP(7) { phase_ln(F, l, 0); } SEAM(pb + 7); }
        if (EN(8) && IN(pb + 8)) REP(8) {
            unsigned char* ws = opqg(args.ws);
            pg8::Gemm g{(const bf16*)(ws + WS_XQ), (const bf16*)(ws + WS_WP8) + (size_t)l * 2048 * 1024, T, 2048, 1024, T, 1024, 0, 0};
            pg8::StaticOrder S; S.init(T, 2048, F.G, (int)blockIdx.x);
            pg8::EpiSc8 E{(bf16*)(ws + WS_SC), (const float*)(ws + WS_SX), (const float*)(ws + WS_SW) + l * 2048};
            pg8::gemm_phase<pg8::EpiSc8, pg8::StaticOrder, true, false, true, true>(F.lds, g, S, E, F.wave);
            if (_r == ((RPT >> 8) & 1)) SEAM(pb + 8);
        }
        if (EN(9) && IN(pb + 9)) { REP(9) { phase_topk(F, l); } SEAM(pb + 9); }
        if (EN(9) && IN(pb + 10)) { REP(10) { phase_peer_u(F, l); } SEAM(pb + 10); }
        if (EN(9) && IN(pb + 11)) { REP(11) { phase_peer_v(F, l); } SEAM(pb + 11); }
        if (EN(9) && IN(pb + 12)) { REP(12) { phase_ln(F, l, 1); } SEAM(pb + 12); }
    }
#undef IN
#undef SEAM
}

extern "C" void kernel_launch(void* const* d_in, const int* in_sizes, int n_in, void* d_out, int out_size, void* d_ws, size_t ws_size, hipStream_t stream) {
    static int grid = 0;
    if (grid == 0) {
        if (n_in != 24 || out_size != T * D || ws_size < WS_END) { fprintf(stderr, "kernel_launch: unexpected sizes (n_in %d out %d ws %zu need %zu)\n", n_in, out_size, ws_size, (size_t)WS_END); grid = -1; return; }
        int dev = 0, cus = 0, per_cu = 0;
        if (hipGetDevice(&dev) != hipSuccess || hipDeviceGetAttribute(&cus, hipDeviceAttributeMultiprocessorCount, dev) != hipSuccess) { grid = -1; return; }
        if (hipFuncSetAttribute((const void*)fwd_kernel, hipFuncAttributeMaxDynamicSharedMemorySize, LDS_BYTES) != hipSuccess) { fprintf(stderr, "kernel_launch: hipFuncSetAttribute failed\n"); grid = -1; return; }
        if (hipOccupancyMaxActiveBlocksPerMultiprocessor(&per_cu, (const void*)fwd_kernel, 512, LDS_BYTES) != hipSuccess || per_cu < 1)
            fprintf(stderr, "kernel_launch: occupancy query reports %d\n", per_cu);
        (void)hipGetLastError();
        grid = cus;
    }
    if (grid < 0) return;
    if (hipMemsetAsync((char*)d_ws + WS_CTL, 0, CTL_ZERO_BYTES, stream) != hipSuccess) return;
    Args a{};
    for (int i = 0; i < 24; ++i) a.in[i] = (const float*)d_in[i];
    a.out = (float*)d_out; a.ws = (unsigned char*)d_ws;
#if ONE_LAUNCH
    a.ph_lo = 0; a.ph_hi = N_PHASES;
    hipLaunchKernelGGL(fwd_kernel, dim3(grid), dim3(512), LDS_BYTES, stream, a);
#else
    for (int p = 0; p < N_PHASES; ++p) { a.ph_lo = p; a.ph_hi = p + 1; hipLaunchKernelGGL(fwd_kernel, dim3(grid), dim3(512), LDS_BYTES, stream, a); }
#endif
}
```

```cpp
#include <hip/hip_runtime.h>
#include <cstdio>
#include <cstdint>

#define LAS __attribute__((address_space(3)))
#define GAS __attribute__((address_space(1)))
typedef unsigned short bf16;
typedef unsigned v4u __attribute__((ext_vector_type(4)));
typedef unsigned v2u __attribute__((ext_vector_type(2)));
typedef float f32x4 __attribute__((ext_vector_type(4)));
typedef float f32x2 __attribute__((ext_vector_type(2)));
typedef short bf16x8 __attribute__((ext_vector_type(8)));
typedef short s16x4 __attribute__((ext_vector_type(4)));

#ifndef ONE_LAUNCH
#define ONE_LAUNCH 1
#endif

constexpr int T = 8192, D = 2048, DEPTH = 4, NIN = 9216;
constexpr int AW = 1024;
constexpr int NCH = 128;
constexpr float ALPHA = 1.6817928305074290f;
constexpr float LN_EPS = 1e-5f, RMS_EPS = 1e-6f;
constexpr int NEXP = 16384;
constexpr int LP = 160;
constexpr int NSLOT = 24;

constexpr size_t MiB = 1u << 20;
constexpr size_t WS_CTL = 0, CTL_ZERO_BYTES = 32768;
constexpr size_t WS_WIN  = 1 * MiB;
constexpr size_t WS_WGLU = WS_WIN + 144 * MiB;
constexpr size_t WS_WUP  = WS_WGLU + 16 * MiB;
constexpr size_t WS_WO   = WS_WUP + 32 * MiB;
constexpr size_t WS_WQB  = WS_WO + 32 * MiB;
constexpr size_t WS_BK   = WS_WQB + 32 * MiB;
constexpr size_t WS_WPQ  = WS_BK + 4 * MiB;
constexpr size_t WS_LB   = WS_WPQ + 32 * MiB;
constexpr size_t WS_APOW = WS_LB + 1 * MiB;
constexpr size_t WS_BB   = WS_APOW + 9 * MiB;
constexpr size_t WS_KMAT = WS_BB + 2 * MiB;
constexpr size_t WS_PM   = WS_KMAT + 9 * MiB;
constexpr size_t WS_E    = WS_PM + 64 * MiB;
constexpr size_t WS_X32  = WS_E + 64 * MiB;
constexpr size_t WS_X1   = WS_X32 + 64 * MiB;
constexpr size_t WS_XB   = WS_X1 + 64 * MiB;
constexpr size_t WS_Q    = WS_XB + 32 * MiB;
constexpr size_t WS_KK   = WS_Q + 16 * MiB;
constexpr size_t WS_V    = WS_KK + 16 * MiB;
constexpr size_t WS_SG   = WS_V + 16 * MiB;
constexpr size_t WS_UB   = WS_SG + 16 * MiB;
constexpr size_t WS_LOGF = WS_UB + 16 * MiB;
constexpr size_t WS_GR   = WS_LOGF + 32 * MiB;
constexpr size_t WS_GB   = WS_GR + 32 * MiB;
constexpr size_t WS_U    = WS_GB + 32 * MiB;
constexpr size_t WS_SP   = WS_U + 64 * MiB;
constexpr size_t WS_BL   = WS_SP + 32 * MiB;
constexpr size_t WS_XLOC = WS_BL + 1 * MiB;
constexpr size_t WS_XS   = WS_XLOC + 4 * MiB;
constexpr size_t WS_OAB  = WS_XS + 4 * MiB;
constexpr size_t WS_YB   = WS_OAB + 32 * MiB;
constexpr size_t WS_MG   = WS_YB + 16 * MiB;
constexpr size_t WS_R    = WS_MG + 32 * MiB;
constexpr size_t WS_SC   = WS_R + 64 * MiB;
constexpr size_t WS_TBU  = WS_SC + 64 * MiB;
constexpr size_t WS_TBV  = WS_TBU + 256 * MiB;
constexpr size_t WS_SEID = WS_TBV + 256 * MiB;
constexpr size_t WS_SGATE= WS_SEID + 6 * MiB;
constexpr size_t WS_PACK = WS_SGATE + 4 * MiB;
constexpr size_t WS_START= WS_PACK + 6 * MiB;
constexpr size_t WS_PACK2= WS_START + 1 * MiB;
constexpr size_t WS_XBS  = WS_PACK2 + 13 * MiB;
constexpr size_t WS_END  = WS_XBS + 32 * MiB;
constexpr size_t WS_XH = WS_XBS;
constexpr size_t WS_XQ = WS_X1;
constexpr size_t WS_SX = WS_X1 + 16 * MiB;
constexpr size_t WS_SU = WS_X1 + 17 * MiB;
constexpr size_t WS_SW = WS_X1 + 18 * MiB;
constexpr size_t WS_WP8 = WS_WQB;
constexpr size_t WS_WG8 = WS_X32;
constexpr size_t WS_SWG = WS_X1 + 19 * MiB;
constexpr size_t WS_RH = WS_R;

constexpr int CW_TMO = 0, CW_CODE = 1;
constexpr int CW_BAR = 4096;

constexpr int RING_BYTES = 131072;
constexpr int LDSCTL_OFF = RING_BYTES, MISC_OFF = LDSCTL_OFF + 320;
constexpr int LDS_BYTES = 147456;

#define LDS_WAIT() asm volatile("s_waitcnt lgkmcnt(0)" ::: "memory")
#define VM_WAIT() asm volatile("s_waitcnt vmcnt(0)" ::: "memory")
__device__ __forceinline__ unsigned cvt_pk_bf16(float lo, float hi) { unsigned r; asm volatile("v_cvt_pk_bf16_f32 %0, %1, %2" : "=v"(r) : "v"(lo), "v"(hi)); return r; }
typedef _Float16 h2_t __attribute__((ext_vector_type(2)));
__device__ __forceinline__ unsigned cvt_pk_f16a(float lo, float hi) { unsigned r; asm volatile("v_cvt_pk_f16_f32 %0, %1, %2" : "=v"(r) : "v"(lo), "v"(hi)); return r; }
__device__ __forceinline__ unsigned cvt_pk_f16(float lo, float hi) { h2_t p; p.x = (_Float16)lo; p.y = (_Float16)hi; return __builtin_bit_cast(unsigned, p); }
__device__ __forceinline__ float dot2h(unsigned a, unsigned b, float c) { return __builtin_amdgcn_fdot2(__builtin_bit_cast(h2_t, a), __builtin_bit_cast(h2_t, b), c, false); }
__device__ __forceinline__ unsigned pkfmah(unsigned a, unsigned b, unsigned c) { return __builtin_bit_cast(unsigned, __builtin_elementwise_fma(__builtin_bit_cast(h2_t, a), __builtin_bit_cast(h2_t, b), __builtin_bit_cast(h2_t, c))); }
__device__ __forceinline__ float bf_lo(unsigned u) { return __uint_as_float(u << 16); }
__device__ __forceinline__ float bf_hi(unsigned u) { return __uint_as_float(u & 0xffff0000u); }
__device__ __forceinline__ float bf2f(bf16 b) { return __uint_as_float(((unsigned)b) << 16); }
__device__ __forceinline__ bf16 f2bf(float f) { return (bf16)(cvt_pk_bf16(f, 0.f) & 0xffffu); }
__device__ __forceinline__ float fexp(float x) { return __builtin_amdgcn_exp2f(x * 1.4426950408889634f); }
__device__ __forceinline__ float flog(float x) { return __builtin_amdgcn_logf(x) * 0.6931471805599453f; }
__device__ __forceinline__ float frcp(float x) { return __builtin_amdgcn_rcpf(x); }
__device__ __forceinline__ float gelu_tanh(float x) {
    const float u = 1.5957691216057308f * (x + 0.044715f * x * x * x);
    const float uc = fminf(fmaxf(u, -60.f), 60.f);
    return x * frcp(1.f + fexp(-uc));
}
__device__ __forceinline__ int lane_id() { int r; asm volatile("v_mbcnt_lo_u32_b32 %0, -1, 0\n\tv_mbcnt_hi_u32_b32 %0, -1, %0" : "=v"(r)); return r; }
__device__ __forceinline__ float wave_sum(float v) {
#pragma unroll
    for (int o = 1; o < 64; o <<= 1) v += __shfl_xor(v, o);
    return v;
}

__device__ __forceinline__ void vlaunder(int& a, int& b) { asm volatile("" : "+v"(a), "+v"(b)); }
template <class P> __device__ __forceinline__ P* opq(P* p) { asm volatile("" : "+s"(p)); return p; }
__device__ __forceinline__ unsigned char* opqg(unsigned char* p) { GAS unsigned char* g = (GAS unsigned char*)p; asm volatile("" : "+s"(g)); return (unsigned char*)g; }
#define GP(T, p) ((T*)(GAS T*)(p))

namespace pg8 {
#define PG8_LAS __attribute__((address_space(3)))
typedef unsigned short bf16_t;
constexpr int BM = 256, BK = 64, HALF = 128, HTB = HALF * BK * 2, STAGE_BYTES = 8 * HTB, NXCD = 8, WGM = 8;

__host__ __device__ __forceinline__ int lds_byte(int r, int c) { const int st = (r >> 4) * 2 + (c >> 5), rr = r & 15, cc = c & 31, ob = rr * 64 + cc * 2; return st * 1024 + (ob ^ (((ob >> 9) & 1) << 5)); }
__host__ __device__ __forceinline__ void stage_rc(int b, int& R, int& C) { const int st = b / 1024, sb = b % 1024, swz = sb ^ (((sb >> 9) & 1) << 5); R = (st >> 1) * 16 + swz / 64; C = (st & 1) * 32 + (swz % 64) / 2; }
__host__ __device__ __forceinline__ int perm32(int rho) { const int n = rho >> 4, i = rho & 15; return 8 * (i >> 2) + 4 * n + (i & 3); }

struct Unit { int pm, pn; };
struct Gemm { const bf16_t* A; const bf16_t* Bt; int M, N, K, lda, ldb, bkoff; long blstride; };

struct StaticOrder {
    int nM, nN, nwg, G, c;
    __host__ __device__ void init(int M, int N, int G_, int c_) { nM = M / BM; nN = N / BM; nwg = nM * nN; G = G_; c = c_; }
    __host__ __device__ bool next(int i, Unit& u) const {
        const long L = (long)i * G + c; if (L >= nwg) return false;
        int wgid = (int)L; { const int q = nwg / NXCD, r = nwg % NXCD, xcd = wgid % NXCD, off = wgid / NXCD; wgid = (xcd < r ? xcd * (q + 1) : r * (q + 1) + (xcd - r) * q) + off; }
        const int nig = WGM * nN, gid = wgid / nig, fm = gid * WGM, gsz = (nM - fm) < WGM ? (nM - fm) : WGM;
        u.pm = fm + ((wgid % nig) % gsz); u.pn = (wgid % nig) / gsz; return true;
    }
    __device__ __forceinline__ void a_ready(const Unit&) const {}
    __device__ __forceinline__ void done(const Unit&) const {}
};

struct OffOrder {
    StaticOrder b; int pn0;
    __device__ void init(int M, int N, int G_, int c_, int pn0_) { b.init(M, N, G_, c_); pn0 = pn0_; }
    __device__ bool next(int i, Unit& u) const { if (!b.next(i, u)) return false; u.pn += pn0; return true; }
    __device__ __forceinline__ void a_ready(const Unit&) const {}
    __device__ __forceinline__ void done(const Unit&) const {}
};
struct ListOrder {
    int base, cnt, x, pn0;
    __device__ bool next(int i, Unit& u) const { if (i >= cnt) return false; const int id = base + i; u.pm = 4 * x + (id & 3); u.pn = pn0 + (id >> 2); return true; }
    __device__ __forceinline__ void a_ready(const Unit&) const {}
    __device__ __forceinline__ void done(const Unit&) const {}
};
struct PairOrder {
    int c, c0, nN, nwg;
    __device__ bool next(int i, Unit& u) const { if (c < c0 || i >= 2) return false; const int id = (c - c0) * 2 + i; if (id >= nwg) return false; u.pm = id / nN; u.pn = id % nN; return true; }
    __device__ __forceinline__ void a_ready(const Unit&) const {}
    __device__ __forceinline__ void done(const Unit&) const {}
};
typedef f32x4 Acc[2][2][4][2];

typedef _Float16 f16x8 __attribute__((ext_vector_type(8)));
typedef int i32x4 __attribute__((ext_vector_type(4)));
template <class Epi, class Sched, bool ALIGN_EPI = false, bool F16 = false, bool ASL = false, bool I8 = false>
__device__ __forceinline__ void gemm_phase(PG8_LAS unsigned char* lds, const Gemm g, const Sched& S, const Epi& E, int wv) {
    int tid_ = wv * 64 + lane_id(); asm volatile("" : "+v"(tid_));
    const int tid = tid_, wid = __builtin_amdgcn_readfirstlane(tid >> 6), lane = tid & 63, wr = wid >> 2, wc = wid & 3, fr = lane & 15, fq = lane >> 4;
    const int K = g.K, nt = K / BK;
    unsigned voffA[2], voffB[2];
#pragma unroll
    for (int i = 0; i < 2; ++i) { int R, C; stage_rc(tid * 16 + i * 8192, R, C); const int Rb = Epi::PERM ? ((R & ~31) + perm32(R & 31)) : R;
        voffA[i] = ASL ? (unsigned)(((C >> 5) * g.lda + R) * 64 + (C & 31) * 2) : (unsigned)(R * g.lda + C) * 2u; voffB[i] = (unsigned)(Rb * g.ldb + C) * 2u; }
    const size_t kstep = (size_t)(BK * 2), kstepA = ASL ? (size_t)g.lda * 128 : (size_t)(BK * 2);
    const size_t hstepA = ASL ? (size_t)HALF * 64 : (size_t)HALF * g.lda * 2, hstepB = (size_t)HALF * g.ldb * 2;
    const size_t tstepA = 2 * hstepA, tstepB = 2 * hstepB;
    const unsigned ldsw = (unsigned)wid * 1024u;
    const int aoff = lds_byte(wr * 64 + fr, fq * 8), boff = lds_byte(wc * 32 + fr, fq * 8);
#define PG8_SA(b, h) (((b) * 2 + (h)) * HTB)
#define PG8_SB(b, h) ((4 + (b) * 2 + (h)) * HTB)
#define PG8_STAGE(bufoff, gbase, voff) do { _Pragma("unroll") for (int _i = 0; _i < 2; ++_i) \
        __builtin_amdgcn_global_load_lds((const unsigned*)((const char*)(gbase) + (voff)[_i]), (PG8_LAS unsigned*)(lds + (bufoff) + ldsw + _i * 8192), 16, 0, 0); } while (0)
#define PG8_LDA(dst, b, h) do { _Pragma("unroll") for (int m = 0; m < 4; ++m) _Pragma("unroll") for (int k = 0; k < 2; ++k) dst[m][k] = *(const PG8_LAS bf16x8*)(lds + PG8_SA(b, h) + aoff + m * 2048 + k * 1024); } while (0)
#define PG8_LDB(dst, b, h) do { _Pragma("unroll") for (int n = 0; n < 2; ++n) _Pragma("unroll") for (int k = 0; k < 2; ++k) dst[n][k] = *(const PG8_LAS bf16x8*)(lds + PG8_SB(b, h) + boff + n * 2048 + k * 1024); } while (0)
#define PG8_MMA(ai, bj, At, Bt) do { __builtin_amdgcn_s_setprio(1); _Pragma("unroll") for (int m = 0; m < 4; ++m) _Pragma("unroll") for (int n = 0; n < 2; ++n) _Pragma("unroll") for (int k = 0; k < 2; ++k) \
        { if constexpr (I8) acc[ai][bj][m][n] = __builtin_bit_cast(f32x4, __builtin_amdgcn_mfma_i32_16x16x64_i8(__builtin_bit_cast(i32x4, Bt[n][k]), __builtin_bit_cast(i32x4, At[m][k]), __builtin_bit_cast(i32x4, acc[ai][bj][m][n]), 0, 0, 0)); \
          else if constexpr (F16) acc[ai][bj][m][n] = __builtin_amdgcn_mfma_f32_16x16x32_f16(__builtin_bit_cast(f16x8, Bt[n][k]), __builtin_bit_cast(f16x8, At[m][k]), acc[ai][bj][m][n], 0, 0, 0); \
          else acc[ai][bj][m][n] = __builtin_amdgcn_mfma_f32_16x16x32_bf16(Bt[n][k], At[m][k], acc[ai][bj][m][n], 0, 0, 0); } __builtin_amdgcn_s_setprio(0); } while (0)
#define PG8_WAIT_V(n) asm volatile("s_waitcnt vmcnt(" #n ")" ::: "memory")
#define PG8_WAIT_L(n) asm volatile("s_waitcnt lgkmcnt(" #n ")" ::: "memory")
#define PG8_BAR __builtin_amdgcn_s_barrier()
#define PG8_SCHED __builtin_amdgcn_sched_barrier(0)
    Unit cur, nxt; int ui = 0;
    if (!S.next(0, cur)) return;
    Acc acc;
#pragma unroll
    for (int a = 0; a < 2; ++a)
#pragma unroll
        for (int b = 0; b < 2; ++b)
#pragma unroll
            for (int m = 0; m < 4; ++m)
#pragma unroll
                for (int n = 0; n < 2; ++n) acc[a][b][m][n] = (f32x4){0.f, 0.f, 0.f, 0.f};
    bf16x8 At[4][2], B0[2][2], B1[2][2];
    const char* cA = (const char*)g.A + (size_t)cur.pm * tstepA;
    const char* cB = (const char*)g.Bt + (size_t)cur.pn * tstepB + ((size_t)(cur.pm & 7) * g.bkoff + (size_t)(cur.pm >> 3) * g.blstride) * 2;
    S.a_ready(cur);
    PG8_STAGE(PG8_SB(0, 0), cB, voffB); PG8_STAGE(PG8_SB(0, 1), cB + hstepB, voffB); PG8_STAGE(PG8_SA(0, 0), cA, voffA); PG8_STAGE(PG8_SA(0, 1), cA + hstepA, voffA);
    if (wr == 1) PG8_BAR;
    PG8_WAIT_V(2); PG8_BAR;
    PG8_STAGE(PG8_SB(1, 0), cB + kstep, voffB); PG8_STAGE(PG8_SA(1, 0), cA + kstepA, voffA); PG8_STAGE(PG8_SB(1, 1), cB + hstepB + kstep, voffB);
    PG8_WAIT_V(6); PG8_BAR;
    for (;;) {
        const bool has_next = S.next(ui + 1, nxt);
        const char* nA = has_next ? (const char*)g.A + (size_t)nxt.pm * tstepA : cA;
        const char* nB = has_next ? (const char*)g.Bt + (size_t)nxt.pn * tstepB + ((size_t)(nxt.pm & 7) * g.bkoff + (size_t)(nxt.pm >> 3) * g.blstride) * 2 : cB;
        for (int t = 0; t < nt; t += 2) {
            const bool last = (t == nt - 2);
            const char* a1 = cA + (size_t)(t + 1) * kstepA;
            const char* a2 = last ? nA : cA + (size_t)(t + 2) * kstepA; const char* b2 = last ? nB : cB + (size_t)(t + 2) * kstep;
            const char* a3 = a2 + kstepA; const char* b3 = b2 + kstep;
            if (last && has_next) S.a_ready(nxt);
            PG8_LDB(B0, 0, 0); PG8_LDB(B1, 0, 1); PG8_SCHED; PG8_LDA(At, 0, 0); PG8_STAGE(PG8_SA(1, 1), a1 + hstepA, voffA);
            PG8_WAIT_V(8); PG8_WAIT_L(0); PG8_BAR; PG8_MMA(0, 0, At, B0); PG8_MMA(0, 1, At, B1); PG8_BAR; PG8_SCHED;
            PG8_LDA(At, 0, 1); PG8_STAGE(PG8_SB(0, 0), b2, voffB); PG8_STAGE(PG8_SB(0, 1), b2 + hstepB, voffB); PG8_STAGE(PG8_SA(0, 0), a2, voffA);
            PG8_WAIT_V(8); PG8_WAIT_L(0); PG8_BAR; PG8_MMA(1, 0, At, B0); PG8_MMA(1, 1, At, B1); PG8_BAR; PG8_SCHED;
            PG8_LDB(B0, 1, 0); PG8_LDB(B1, 1, 1); PG8_SCHED; PG8_LDA(At, 1, 0); PG8_STAGE(PG8_SA(0, 1), a2 + hstepA, voffA);
            PG8_WAIT_V(8); PG8_WAIT_L(0); PG8_BAR; PG8_MMA(0, 0, At, B0); PG8_MMA(0, 1, At, B1); PG8_BAR; PG8_SCHED;
            PG8_LDA(At, 1, 1); PG8_STAGE(PG8_SB(1, 0), b3, voffB); PG8_STAGE(PG8_SB(1, 1), b3 + hstepB, voffB); PG8_STAGE(PG8_SA(1, 0), a3, voffA);
            PG8_WAIT_V(8); PG8_WAIT_L(0); PG8_BAR; PG8_MMA(1, 0, At, B0); PG8_MMA(1, 1, At, B1); PG8_BAR; PG8_SCHED;
            if constexpr (Epi::HAS_MID) { if (t + 2 == (nt >> 1)) E.mid(acc, cur, wr, wc, fr, fq); }
        }
        if constexpr (ALIGN_EPI) { if (wr == 0) PG8_BAR; }
        E(acc, cur, wr, wc, fr, fq); S.done(cur);
        if (!has_next) break;
#pragma unroll
        for (int a = 0; a < 2; ++a)
#pragma unroll
            for (int b = 0; b < 2; ++b)
#pragma unroll
                for (int m = 0; m < 4; ++m)
#pragma unroll
                    for (int n = 0; n < 2; ++n) acc[a][b][m][n] = (f32x4){0.f, 0.f, 0.f, 0.f};
        cur = nxt; cA = nA; cB = nB; ++ui;
        if constexpr (ALIGN_EPI) { if (wr == 1) PG8_BAR; }
    }
    PG8_WAIT_V(0);
    if constexpr (!ALIGN_EPI) { if (wr == 0) PG8_BAR; }
    PG8_BAR;
#undef PG8_SA
#undef PG8_SB
#undef PG8_STAGE
#undef PG8_LDA
#undef PG8_LDB
#undef PG8_MMA
#undef PG8_WAIT_V
#undef PG8_WAIT_L
#undef PG8_BAR
#undef PG8_SCHED
}

struct EpiResH {
    static constexpr bool PERM = true, HAS_MID = false;
    bf16_t* RS; const bf16_t* XS;
    __device__ __forceinline__ void operator()(const Acc& acc, const Unit& u, int wr, int wc, int fr, int fq) const {
        vlaunder(fr, fq);
        const int row0 = u.pm * BM + wr * 64 + fr, sl0 = u.pn * 8 + wc;
#pragma unroll
        for (int ai = 0; ai < 2; ++ai) {
            v4u xw[4][2];
#pragma unroll
            for (int m = 0; m < 4; ++m)
#pragma unroll
                for (int bj = 0; bj < 2; ++bj) xw[m][bj] = *(const v4u*)(XS + ((size_t)(sl0 + bj * 4) * T + (row0 + ai * HALF + m * 16)) * 32 + 8 * fq);
#pragma unroll
            for (int m = 0; m < 4; ++m) {
#pragma unroll
                for (int bj = 0; bj < 2; ++bj) { const size_t eo = ((size_t)(sl0 + bj * 4) * T + (row0 + ai * HALF + m * 16)) * 32 + 8 * fq;
                    const f32x4 v0 = acc[ai][bj][m][0], v1 = acc[ai][bj][m][1];
                    const unsigned a0 = xw[m][bj].x, a1 = xw[m][bj].y, a2 = xw[m][bj].z, a3 = xw[m][bj].w;
                    const h2_t x0 = __builtin_bit_cast(h2_t, a0), x1 = __builtin_bit_cast(h2_t, a1), x2 = __builtin_bit_cast(h2_t, a2), x3 = __builtin_bit_cast(h2_t, a3);
                    v4u w; w.x = cvt_pk_f16a(v0[0] + ALPHA * (float)x0.x, v0[1] + ALPHA * (float)x0.y); w.y = cvt_pk_f16a(v0[2] + ALPHA * (float)x1.x, v0[3] + ALPHA * (float)x1.y);
                    w.z = cvt_pk_f16a(v1[0] + ALPHA * (float)x2.x, v1[1] + ALPHA * (float)x2.y); w.w = cvt_pk_f16a(v1[2] + ALPHA * (float)x3.x, v1[3] + ALPHA * (float)x3.y);
                    *(v4u*)(RS + eo) = w; } }
        }
    }
};
struct EpiF16 {
    static constexpr bool PERM = true, HAS_MID = false;
    bf16_t* O; int ldc;
    __device__ __forceinline__ void operator()(const Acc& acc, const Unit& u, int wr, int wc, int fr, int fq) const {
        vlaunder(fr, fq);
        const int row0 = u.pm * BM + wr * 64 + fr, col0 = u.pn * BM + wc * 32 + 8 * fq;
#pragma unroll
        for (int ai = 0; ai < 2; ++ai)
#pragma unroll
            for (int m = 0; m < 4; ++m) { bf16_t* rowp = O + (size_t)(row0 + ai * HALF + m * 16) * ldc + col0;
#pragma unroll
                for (int bj = 0; bj < 2; ++bj) { const f32x4 v0 = acc[ai][bj][m][0], v1 = acc[ai][bj][m][1];
                    v4u w; w.x = cvt_pk_f16a(v0[0], v0[1]); w.y = cvt_pk_f16a(v0[2], v0[3]); w.z = cvt_pk_f16a(v1[0], v1[1]); w.w = cvt_pk_f16a(v1[2], v1[3]);
                    *(v4u*)(rowp + bj * HALF) = w; } }
    }
};
struct EpiGate8 {
    static constexpr bool PERM = true, HAS_MID = false;
    bf16_t *GR, *GB; const float* SXp; const float* SWp;
    __device__ __forceinline__ void operator()(const Acc& acc, const Unit& u, int wr, int wc, int fr, int fq) const {
        vlaunder(fr, fq);
        const int row0 = u.pm * BM + wr * 64 + fr, tl = u.pn - 20;
        const int col0 = tl * 128 + wc * 32 + 8 * fq, w0 = tl * 256 + wc * 32 + 8 * fq;
        f32x4 sw[2][2]; float sx[2][4];
#pragma unroll
        for (int bj = 0; bj < 2; ++bj) { sw[bj][0] = *(const f32x4*)(SWp + w0 + bj * HALF); sw[bj][1] = *(const f32x4*)(SWp + w0 + bj * HALF + 4); }
#pragma unroll
        for (int ai = 0; ai < 2; ++ai)
#pragma unroll
            for (int m = 0; m < 4; ++m) sx[ai][m] = SXp[row0 + ai * HALF + m * 16];
#pragma unroll
        for (int ai = 0; ai < 2; ++ai)
#pragma unroll
            for (int m = 0; m < 4; ++m) { const size_t ro = (size_t)(row0 + ai * HALF + m * 16) * 2048 + col0;
                float rr[8], gg[8];
#pragma unroll
                for (int n = 0; n < 2; ++n) { const i32x4 ia = __builtin_bit_cast(i32x4, acc[ai][0][m][n]), ib = __builtin_bit_cast(i32x4, acc[ai][1][m][n]);
#pragma unroll
                    for (int x = 0; x < 4; ++x) { const float za = fminf(fmaxf((float)ia[x] * sx[ai][m] * sw[0][n][x], -30.f), 30.f), zb = fminf(fmaxf((float)ib[x] * sx[ai][m] * sw[1][n][x], -30.f), 30.f);
                        const float ea = fexp(-za), eb = fexp(-zb); gg[n * 4 + x] = frcp(1.f + eb); rr[n * 4 + x] = (1.f + eb) * frcp(1.f + ea); } }
                v4u w; w.x = cvt_pk_bf16(rr[0], rr[1]); w.y = cvt_pk_bf16(rr[2], rr[3]); w.z = cvt_pk_bf16(rr[4], rr[5]); w.w = cvt_pk_bf16(rr[6], rr[7]);
                *(v4u*)(GR + ro) = w;
                w.x = cvt_pk_bf16(gg[0], gg[1]); w.y = cvt_pk_bf16(gg[2], gg[3]); w.z = cvt_pk_bf16(gg[4], gg[5]); w.w = cvt_pk_bf16(gg[6], gg[7]);
                *(v4u*)(GB + ro) = w; }
    }
};
struct EpiSc8 {
    static constexpr bool PERM = true, HAS_MID = false;
    bf16_t* O; const float* SXp; const float* SWp;
    __device__ __forceinline__ void operator()(const Acc& acc, const Unit& u, int wr, int wc, int fr, int fq) const {
        vlaunder(fr, fq);
        const int row0 = u.pm * BM + wr * 64 + fr, col0 = u.pn * BM + wc * 32 + 8 * fq;
        f32x4 sw[2][2]; float sx[2][4];
#pragma unroll
        for (int bj = 0; bj < 2; ++bj) { sw[bj][0] = *(const f32x4*)(SWp + col0 + bj * HALF); sw[bj][1] = *(const f32x4*)(SWp + col0 + bj * HALF + 4); }
#pragma unroll
        for (int ai = 0; ai < 2; ++ai)
#pragma unroll
            for (int m = 0; m < 4; ++m) sx[ai][m] = SXp[row0 + ai * HALF + m * 16];
#pragma unroll
        for (int ai = 0; ai < 2; ++ai)
#pragma unroll
            for (int m = 0; m < 4; ++m) { bf16_t* rowp = O + (size_t)(row0 + ai * HALF + m * 16) * 2048 + col0;
#pragma unroll
                for (int bj = 0; bj < 2; ++bj) { const i32x4 i0 = __builtin_bit_cast(i32x4, acc[ai][bj][m][0]), i1 = __builtin_bit_cast(i32x4, acc[ai][bj][m][1]);
                    const f32x4 v0 = (f32x4){(float)i0[0], (float)i0[1], (float)i0[2], (float)i0[3]} * sx[ai][m] * sw[bj][0], v1 = (f32x4){(float)i1[0], (float)i1[1], (float)i1[2], (float)i1[3]} * sx[ai][m] * sw[bj][1];
                    v4u w; w.x = cvt_pk_bf16(v0[0], v0[1]); w.y = cvt_pk_bf16(v0[2], v0[3]); w.z = cvt_pk_bf16(v1[0], v1[1]); w.w = cvt_pk_bf16(v1[2], v1[3]);
                    *(v4u*)(rowp + bj * HALF) = w; } }
    }
};
struct EpiBf16 {
    static constexpr bool PERM = true, HAS_MID = false;
    bf16_t* O; int ldc;
    __device__ __forceinline__ void operator()(const Acc& acc, const Unit& u, int wr, int wc, int fr, int fq) const {
        vlaunder(fr, fq);
        const int row0 = u.pm * BM + wr * 64 + fr, col0 = u.pn * BM + wc * 32 + 8 * fq;
#pragma unroll
        for (int ai = 0; ai < 2; ++ai)
#pragma unroll
            for (int m = 0; m < 4; ++m) { bf16_t* rowp = O + (size_t)(row0 + ai * HALF + m * 16) * ldc + col0;
#pragma unroll
                for (int bj = 0; bj < 2; ++bj) { const f32x4 v0 = acc[ai][bj][m][0], v1 = acc[ai][bj][m][1];
                    v4u w; w.x = cvt_pk_bf16(v0[0], v0[1]); w.y = cvt_pk_bf16(v0[2], v0[3]); w.z = cvt_pk_bf16(v1[0], v1[1]); w.w = cvt_pk_bf16(v1[2], v1[3]);
                    *(v4u*)(rowp + bj * HALF) = w; } }
    }
};
struct EpiIn {
    static constexpr bool PERM = true, HAS_MID = false;
    bf16_t *Q, *KK, *V, *SG, *UB, *GR, *GB; float* LOGF; const float* lb;
    __device__ __forceinline__ void operator()(const Acc& acc, const Unit& u, int wr, int wc, int fr, int fq) const {
        vlaunder(fr, fq);
        const int row0 = u.pm * BM + wr * 64 + fr;
        const int pn = u.pn;
        if (pn >= 20) {
            const int col0 = (pn - 20) * 128 + wc * 32 + 8 * fq;
#pragma unroll
            for (int ai = 0; ai < 2; ++ai)
#pragma unroll
                for (int m = 0; m < 4; ++m) { const size_t ro = (size_t)(row0 + ai * HALF + m * 16) * 2048 + col0;
                    float rr[8], gg[8];
#pragma unroll
                    for (int n = 0; n < 2; ++n)
#pragma unroll
                        for (int x = 0; x < 4; ++x) { const float za = fminf(fmaxf(acc[ai][0][m][n][x], -30.f), 30.f), zb = fminf(fmaxf(acc[ai][1][m][n][x], -30.f), 30.f);
                            const float ea = fexp(-za), eb = fexp(-zb); gg[n * 4 + x] = frcp(1.f + eb); rr[n * 4 + x] = (1.f + eb) * frcp(1.f + ea); }
                    v4u w; w.x = cvt_pk_bf16(rr[0], rr[1]); w.y = cvt_pk_bf16(rr[2], rr[3]); w.z = cvt_pk_bf16(rr[4], rr[5]); w.w = cvt_pk_bf16(rr[6], rr[7]);
                    *(v4u*)(GR + ro) = w;
                    w.x = cvt_pk_bf16(gg[0], gg[1]); w.y = cvt_pk_bf16(gg[2], gg[3]); w.z = cvt_pk_bf16(gg[4], gg[5]); w.w = cvt_pk_bf16(gg[6], gg[7]);
                    *(v4u*)(GB + ro) = w; }
            return;
        }
        const int sec = pn >> 2, col0 = (pn & 3) * 256 + wc * 32 + 8 * fq;
        if (sec == 1) {
#pragma unroll
            for (int bj = 0; bj < 2; ++bj) {
                const f32x4 l0 = *(const f32x4*)(lb + col0 + bj * HALF), l1 = *(const f32x4*)(lb + col0 + bj * HALF + 4);
#pragma unroll
                for (int ai = 0; ai < 2; ++ai)
#pragma unroll
                    for (int m = 0; m < 4; ++m) { const size_t ro = (size_t)(row0 + ai * HALF + m * 16) * 1024 + col0 + bj * HALF;
                        float lf[8], kk[8];
#pragma unroll
                        for (int n = 0; n < 2; ++n)
#pragma unroll
                            for (int x = 0; x < 4; ++x) { const float z = fminf(fmaxf(acc[ai][bj][m][n][x], -30.f), 30.f); const float lbv = n ? l1[x] : l0[x];
                                const float e = fexp(-z), s = frcp(1.f + e); const float f = lbv + (1.f - lbv) * s;
                                lf[n * 4 + x] = flog(f); kk[n * 4 + x] = (1.f - lbv) * (e * s); }
                        *(f32x4*)(LOGF + ro) = (f32x4){lf[0], lf[1], lf[2], lf[3]}; *(f32x4*)(LOGF + ro + 4) = (f32x4){lf[4], lf[5], lf[6], lf[7]};
                        v4u w; w.x = cvt_pk_bf16(kk[0], kk[1]); w.y = cvt_pk_bf16(kk[2], kk[3]); w.z = cvt_pk_bf16(kk[4], kk[5]); w.w = cvt_pk_bf16(kk[6], kk[7]);
                        *(v4u*)(KK + ro) = w; }
            }
            return;
        }
        bf16_t* dst = sec == 0 ? Q : (sec == 2 ? V : (sec == 3 ? SG : UB));
        const bool sig = (sec == 3);
#pragma unroll
        for (int ai = 0; ai < 2; ++ai)
#pragma unroll
            for (int m = 0; m < 4; ++m) { bf16_t* rowp = dst + (size_t)(row0 + ai * HALF + m * 16) * 1024 + col0;
#pragma unroll
                for (int bj = 0; bj < 2; ++bj) { f32x4 v0 = acc[ai][bj][m][0], v1 = acc[ai][bj][m][1];
                    if (sig) {
#pragma unroll
                        for (int x = 0; x < 4; ++x) { v0[x] = frcp(1.f + fexp(-fminf(fmaxf(v0[x], -30.f), 30.f))); v1[x] = frcp(1.f + fexp(-fminf(fmaxf(v1[x], -30.f), 30.f))); } }
                    v4u w; w.x = cvt_pk_bf16(v0[0], v0[1]); w.y = cvt_pk_bf16(v0[2], v0[3]); w.z = cvt_pk_bf16(v1[0], v1[1]); w.w = cvt_pk_bf16(v1[2], v1[3]);
                    *(v4u*)(rowp + bj * HALF) = w; } }
    }
};
struct EpiGlu {
    static constexpr bool PERM = true, HAS_MID = false;
    bf16_t* O; int ldc;
    __device__ __forceinline__ void operator()(const Acc& acc, const Unit& u, int wr, int wc, int fr, int fq) const {
        vlaunder(fr, fq);
        const int row0 = u.pm * BM + wr * 64 + fr, col0 = u.pn * 128 + wc * 32 + 8 * fq;
#pragma unroll
        for (int ai = 0; ai < 2; ++ai)
#pragma unroll
            for (int m = 0; m < 4; ++m) { float o[8];
#pragma unroll
                for (int n = 0; n < 2; ++n)
#pragma unroll
                    for (int x = 0; x < 4; ++x) { const float h2 = fminf(fmaxf(acc[ai][1][m][n][x], -30.f), 30.f); o[n * 4 + x] = acc[ai][0][m][n][x] * frcp(1.f + fexp(-h2)); }
                v4u w; w.x = cvt_pk_bf16(o[0], o[1]); w.y = cvt_pk_bf16(o[2], o[3]); w.z = cvt_pk_bf16(o[4], o[5]); w.w = cvt_pk_bf16(o[6], o[7]);
                *(v4u*)(O + (size_t)(row0 + ai * HALF + m * 16) * ldc + col0) = w; }
    }
};
struct EpiUp {
    static constexpr bool PERM = true, HAS_MID = true;
    bf16_t* O; const bf16_t *GR, *GB;
    __device__ __forceinline__ void scale(Acc& acc, const bf16_t* G, const Unit& u, int wr, int wc, int fr, int fq) const {
        vlaunder(fr, fq);
        const int row0 = u.pm * BM + wr * 64 + fr, col0 = u.pn * BM + wc * 32 + 8 * fq;
#pragma unroll
        for (int ai = 0; ai < 2; ++ai) {
            v4u gw[4][2];
#pragma unroll
            for (int m = 0; m < 4; ++m)
#pragma unroll
                for (int bj = 0; bj < 2; ++bj) gw[m][bj] = *(const v4u*)(G + (size_t)(row0 + ai * HALF + m * 16) * 2048 + col0 + bj * HALF);
            __builtin_amdgcn_sched_barrier(0);
#pragma unroll
            for (int m = 0; m < 4; ++m) {
#pragma unroll
                for (int bj = 0; bj < 2; ++bj) { const v4u w = gw[m][bj];
                    acc[ai][bj][m][0] *= (f32x4){bf_lo(w.x), bf_hi(w.x), bf_lo(w.y), bf_hi(w.y)};
                    acc[ai][bj][m][1] *= (f32x4){bf_lo(w.z), bf_hi(w.z), bf_lo(w.w), bf_hi(w.w)}; } }
            __builtin_amdgcn_sched_barrier(0); }
    }
    __device__ __forceinline__ void mid(Acc& acc, const Unit& u, int wr, int wc, int fr, int fq) const { scale(acc, GR, u, wr, wc, fr, fq); }
    __device__ __forceinline__ void operator()(Acc& acc, const Unit& u, int wr, int wc, int fr, int fq) const {
        scale(acc, GB, u, wr, wc, fr, fq);
        const int row0 = u.pm * BM + wr * 64 + fr, col0 = u.pn * BM + wc * 32 + 8 * fq;
#pragma unroll
        for (int ai = 0; ai < 2; ++ai)
#pragma unroll
            for (int m = 0; m < 4; ++m) { bf16_t* rowp = O + (size_t)(row0 + ai * HALF + m * 16) * 2048 + col0;
#pragma unroll
                for (int bj = 0; bj < 2; ++bj) { const f32x4 v0 = acc[ai][bj][m][0], v1 = acc[ai][bj][m][1];
                    v4u w; w.x = cvt_pk_bf16(v0[0], v0[1]); w.y = cvt_pk_bf16(v0[2], v0[3]); w.z = cvt_pk_bf16(v1[0], v1[1]); w.w = cvt_pk_bf16(v1[2], v1[3]);
                    *(v4u*)(rowp + bj * HALF) = w; } }
    }
};
}

#define XB_TMO      128
#define XB_XCNT(j)  (256  + 64 * (j))
#define XB_XSUB(j)  (1280 + 64 * (j))
#define XB_XGEN(j)  (2304 + 64 * (j))
#define XB_TOP      3328
#define XB_TOPGEN   3392
#define XCD_BAR_WORDS 3456
#define XB_SPIN_CAP (1u << 20)

__device__ __forceinline__ unsigned xb_ld(unsigned* p)              { return __hip_atomic_load(p, __ATOMIC_RELAXED, __HIP_MEMORY_SCOPE_AGENT); }
__device__ __forceinline__ unsigned xb_add(unsigned* p, unsigned v) { return __hip_atomic_fetch_add(p, v, __ATOMIC_RELAXED, __HIP_MEMORY_SCOPE_AGENT); }
__device__ __forceinline__ unsigned xb_xcc_id() { return (unsigned)__builtin_amdgcn_s_getreg((3 << 11) | 20) & 0xFu; }
#define XB_SPIN(cond, bar) do { unsigned _sp = 0; while (cond) { __builtin_amdgcn_s_sleep(1); \
    if ((++_sp & 255u) == 0u) { if (xb_ld(&(bar)[XB_TMO])) break; if (_sp > XB_SPIN_CAP) { atomicAdd(&(bar)[XB_TMO], 1u); break; } } } } while (0)

struct XcdBarrier { unsigned* bar; unsigned x; volatile LAS unsigned* st; };

__device__ __forceinline__ XcdBarrier xcd_barrier_post(unsigned* bar, volatile LAS unsigned* st, bool leader) {
    XcdBarrier b; b.bar = bar; b.x = xb_xcc_id(); b.st = st;
    if (leader) (void)xb_add(&bar[XB_XCNT(b.x)], 1u);
    return b;
}
__device__ __forceinline__ void xcd_barrier_complete(unsigned* bar, unsigned x, unsigned& nloc, unsigned& nx) {
    const unsigned G = gridDim.x * gridDim.y * gridDim.z;
    unsigned sum, cnt, mine, sp = 0u;
    for (;;) {
        sum = 0u; cnt = 0u; mine = 0u;
#pragma unroll
        for (unsigned j = 0; j < 16; ++j) { const unsigned c = xb_ld(&bar[XB_XCNT(j)]); sum += c; cnt += (c > 0u) ? 1u : 0u; mine = (j == x) ? c : mine; }
        if (sum == G) break;
        __builtin_amdgcn_s_sleep(1);
        if ((++sp & 255u) == 0u) { if (xb_ld(&bar[XB_TMO])) break; if (sp > XB_SPIN_CAP) { atomicAdd(&bar[XB_TMO], 1u); break; } }
    }
    nloc = mine > 0u ? mine : 1u; nx = cnt > 0u ? cnt : 1u;
}
__device__ __forceinline__ void xcd_barrier(const XcdBarrier& b, int wv) {
    asm volatile("s_waitcnt vmcnt(0)" ::: "memory");
    __syncthreads();
    if (wv == 0 && lane_id() == 0) {
        unsigned* bar = b.bar;
        __builtin_amdgcn_s_waitcnt(0);
        unsigned nloc = b.st[0], nx = b.st[1];
        if (nloc == 0u) { xcd_barrier_complete(bar, b.x, nloc, nx); b.st[0] = nloc; b.st[1] = nx; }
        const unsigned old = xb_add(&bar[XB_XSUB(b.x)], 1u);
        const unsigned gen = old / nloc;
        if (old + 1u == (gen + 1u) * nloc) {
            __builtin_amdgcn_fence(__ATOMIC_RELEASE, "agent");
            asm volatile("s_waitcnt vmcnt(0)" ::: "memory");
            const unsigned og = xb_add(&bar[XB_TOP], 1u);
            const unsigned tg = og / nx;
            if (og + 1u == (tg + 1u) * nx) xb_add(&bar[XB_TOPGEN], 1u);
            else XB_SPIN(xb_ld(&bar[XB_TOPGEN]) == tg, bar);
            __builtin_amdgcn_fence(__ATOMIC_ACQUIRE, "agent");
            xb_add(&bar[XB_XGEN(b.x)], 1u);
            asm volatile("s_waitcnt vmcnt(0)" ::: "memory");
        } else {
            XB_SPIN(xb_ld(&bar[XB_XGEN(b.x)]) == gen, bar);
            __builtin_amdgcn_fence(__ATOMIC_ACQUIRE, "agent");
            asm volatile("s_waitcnt vmcnt(0)" ::: "memory");
        }
    }
    __syncthreads();
}

struct Args { const float* in[24]; float* out; unsigned char* ws; int ph_lo, ph_hi; };
struct Frame {
    LAS unsigned char* lds;
    int tid, lane, wave, vcu, G;
    unsigned char* ws;
    const __attribute__((address_space(4))) Args* ka;
};
enum { I_X = 0, I_WIN, I_LBL, I_NG, I_LRE, I_LIM, I_LSTEP, I_BRE, I_BIM, I_CRE, I_CIM, I_SD, I_WGLU, I_WUPA, I_WUPB, I_WO, I_LN1G, I_LN1B, I_PWQ, I_PKEYS, I_PU, I_PV, I_LN2G, I_LN2B };

__device__ __forceinline__ void p0_transpose_item(const float* W, int N, bf16* WT, int dpitch, int dst_koff, int dst_row0, LAS float* scr, int k0, int n0, int lane, bool h = false) {
    { const int kr = lane >> 3, c4 = (lane & 7) * 4; f32x4 v[8];
#pragma unroll
      for (int i = 0; i < 8; ++i) v[i] = __builtin_nontemporal_load((const f32x4*)(W + (size_t)(k0 + kr + 8 * i) * N + n0 + c4));
#pragma unroll
      for (int i = 0; i < 8; ++i) { LAS float* d = scr + (kr + 8 * i) * 33 + c4; d[0] = v[i][0]; d[1] = v[i][1]; d[2] = v[i][2]; d[3] = v[i][3]; } }
    LDS_WAIT(); asm volatile("" ::: "memory");
    const int c = lane & 7;
#pragma unroll
    for (int j = 0; j < 4; ++j) { const int n = (lane >> 3) + 8 * j; const LAS float* s = scr + (8 * c) * 33 + n;
        v4u o;
        if (h) { o.x = cvt_pk_f16(s[0 * 33], s[1 * 33]); o.y = cvt_pk_f16(s[2 * 33], s[3 * 33]); o.z = cvt_pk_f16(s[4 * 33], s[5 * 33]); o.w = cvt_pk_f16(s[6 * 33], s[7 * 33]); }
        else { o.x = cvt_pk_bf16(s[0 * 33], s[1 * 33]); o.y = cvt_pk_bf16(s[2 * 33], s[3 * 33]); o.z = cvt_pk_bf16(s[4 * 33], s[5 * 33]); o.w = cvt_pk_bf16(s[6 * 33], s[7 * 33]); }
        *(v4u*)(WT + (size_t)(dst_row0 + n) * dpitch + dst_koff + k0 + 8 * c) = o; }
    LDS_WAIT(); asm volatile("" ::: "memory");
}
__device__ __forceinline__ void sincos_d(double a, double& s, double& c) {
    const double k = __builtin_rint(a * 0.63661977236758134308);
    double r = __builtin_fma(-k, 1.57079632679489655800e+00, a); r = __builtin_fma(-k, 6.12323399573676603587e-17, r);
    const double r2 = r * r;
    double sp = 1.0 / 1307674368000.0; sp = sp * r2 - 1.0 / 6227020800.0; sp = sp * r2 + 1.0 / 39916800.0; sp = sp * r2 - 1.0 / 362880.0; sp = sp * r2 + 1.0 / 5040.0; sp = sp * r2 - 1.0 / 120.0; sp = sp * r2 + 1.0 / 6.0;
    const double sr = r - r * r2 * sp;
    double cp = 1.0 / 20922789888000.0; cp = cp * r2 - 1.0 / 87178291200.0; cp = cp * r2 + 1.0 / 479001600.0; cp = cp * r2 - 1.0 / 3628800.0; cp = cp * r2 + 1.0 / 40320.0; cp = cp * r2 - 1.0 / 720.0; cp = cp * r2 + 1.0 / 24.0;
    const double cr = 1.0 - 0.5 * r2 + r2 * r2 * cp;
    const int q = ((int)k) & 3;
    s = (q == 0) ? sr : (q == 1) ? cr : (q == 2) ? -sr : -cr;
    c = (q == 0) ? cr : (q == 1) ? -sr : (q == 2) ? -cr : sr;
}
__device__ __forceinline__ double exp_d(double x) {
    const double k = __builtin_rint(x * 1.44269504088896340736);
    const double r = __builtin_fma(-k, 6.93147180369123816490e-01, x) - k * 1.90821492927058770002e-10;
    double p = 1.0 / 6227020800.0;
    p = p * r + 1.0 / 479001600.0; p = p * r + 1.0 / 39916800.0; p = p * r + 1.0 / 3628800.0; p = p * r + 1.0 / 362880.0; p = p * r + 1.0 / 40320.0; p = p * r + 1.0 / 5040.0;
    p = p * r + 1.0 / 720.0; p = p * r + 1.0 / 120.0; p = p * r + 1.0 / 24.0; p = p * r + 1.0 / 6.0; p = p * r + 0.5; p = p * r + 1.0; p = p * r + 1.0;
    const long long e = (long long)k + 1023; double sc = __builtin_bit_cast(double, (unsigned long long)(e << 52));
    return p * sc;
}

__device__ __forceinline__ void phase_prologue_a(const Frame& F0) {
    Frame F = F0; F.tid = F.wave * 64 + lane_id(); asm volatile("" : "+v"(F.tid)); F.lane = F.tid & 63;
    unsigned char* ws = opqg(F.ws); const __attribute__((address_space(4))) Args* a = opq(F.ka);
    LAS float* scr = (LAS float*)(F.lds + F.wave * 16384);
    const int gw = F.vcu * 8 + F.wave, NGW = F.G * 8;
    constexpr int I_IN = 32 * 288, I_GLU = 16 * 64, I_UP = 16 * 64, I_O = 32 * 64, I_L = I_IN + I_GLU + 2 * I_UP + I_O;
    for (int it = gw; it < DEPTH * I_L; it += NGW) {
        const int l = it / I_L; int r = it % I_L;
        if (r < I_IN) { const int kb = r / 288, nb = r % 288, n0 = nb * 32; int dr;
            if (n0 < 5120) dr = n0; else if (n0 < 7168) { const int j = n0 - 5120; dr = 5120 + (j >> 7) * 256 + (j & 127); } else { const int j = n0 - 7168; dr = 5120 + (j >> 7) * 256 + 128 + (j & 127); }
            p0_transpose_item(GP(const float, a->in[I_WIN]) + (size_t)l * D * NIN, NIN, (bf16*)(ws + WS_WIN) + (size_t)l * NIN * D, D, 0, dr, scr, kb * 64, n0, F.lane, true); continue; }
        r -= I_IN;
        if (r < I_GLU) { const int kb = r / 64, nb = r % 64, n0 = nb * 32; int dr;
            if (n0 < 1024) dr = (n0 >> 7) * 256 + (n0 & 127); else { const int j = n0 - 1024; dr = (j >> 7) * 256 + 128 + (j & 127); }
            p0_transpose_item(GP(const float, a->in[I_WGLU]) + (size_t)l * 1024 * 2048, 2048, (bf16*)(ws + WS_WGLU) + (size_t)l * 2048 * 1024, 1024, 0, dr, scr, kb * 64, n0, F.lane); continue; }
        r -= I_GLU;
        if (r < I_UP) { const int kb = r / 64, nb = r % 64;
            p0_transpose_item(GP(const float, a->in[I_WUPA]) + (size_t)l * 1024 * 2048, 2048, (bf16*)(ws + WS_WUP) + (size_t)l * 2048 * 2048, 2048, 0, nb * 32, scr, kb * 64, nb * 32, F.lane); continue; }
        r -= I_UP;
        if (r < I_UP) { const int kb = r / 64, nb = r % 64;
            p0_transpose_item(GP(const float, a->in[I_WUPB]) + (size_t)l * 1024 * 2048, 2048, (bf16*)(ws + WS_WUP) + (size_t)l * 2048 * 2048, 2048, 1024, nb * 32, scr, kb * 64, nb * 32, F.lane); continue; }
        r -= I_UP;
        { const int kb = r / 64, nb = r % 64;
            p0_transpose_item(GP(const float, a->in[I_WO]) + (size_t)l * 2048 * 2048, 2048, (bf16*)(ws + WS_WO) + (size_t)l * 2048 * 2048, 2048, 0, nb * 32, scr, kb * 64, nb * 32, F.lane); }
    }
    const size_t gt = (size_t)F.vcu * 512 + F.tid, NT = (size_t)F.G * 512;
    { const float* src = GP(const float, a->in[I_PWQ]); bf16* dst = (bf16*)(ws + WS_WQB);
      const size_t N_ = (size_t)DEPTH * D * D / 8; size_t i = gt;
      for (; i + 3 * NT < N_; i += 4 * NT) { f32x4 va[4], vb[4];
#pragma unroll
          for (int k = 0; k < 4; ++k) { va[k] = *(const f32x4*)(src + (i + k * NT) * 8); vb[k] = *(const f32x4*)(src + (i + k * NT) * 8 + 4); }
#pragma unroll
          for (int k = 0; k < 4; ++k) { v4u w; w.x = cvt_pk_bf16(va[k][0], va[k][1]); w.y = cvt_pk_bf16(va[k][2], va[k][3]); w.z = cvt_pk_bf16(vb[k][0], vb[k][1]); w.w = cvt_pk_bf16(vb[k][2], vb[k][3]); *(v4u*)(dst + (i + k * NT) * 8) = w; } }
      for (; i < N_; i += NT) { const f32x4 v0 = *(const f32x4*)(src + i * 8), v1 = *(const f32x4*)(src + i * 8 + 4);
          v4u w; w.x = cvt_pk_bf16(v0[0], v0[1]); w.y = cvt_pk_bf16(v0[2], v0[3]); w.z = cvt_pk_bf16(v1[0], v1[1]); w.w = cvt_pk_bf16(v1[2], v1[3]); *(v4u*)(dst + i * 8) = w; } }
    { const float* src = GP(const float, a->in[I_X]); bf16* XS = (bf16*)(ws + WS_XH);
      const int j = F.lane & 3, rr = (F.lane >> 2) & 1, sl = F.lane >> 3;
      for (int rp = gw; rp < T / 2; rp += NGW) { const int row = 2 * rp + rr;
          f32x4 a0[8], a1[8]; float amax = 0.f;
#pragma unroll
          for (int i = 0; i < 8; ++i) { const float* sp = src + (size_t)row * D + (8 * i + sl) * 32 + j * 8; a0[i] = *(const f32x4*)sp; a1[i] = *(const f32x4*)(sp + 4); }
#pragma unroll
          for (int i = 0; i < 8; ++i) { v4u o; o.x = cvt_pk_f16(a0[i][0], a0[i][1]); o.y = cvt_pk_f16(a0[i][2], a0[i][3]); o.z = cvt_pk_f16(a1[i][0], a1[i][1]); o.w = cvt_pk_f16(a1[i][2], a1[i][3]);
              *(v4u*)(XS + ((size_t)(8 * i + sl) * T + row) * 32 + j * 8) = o;
#pragma unroll
              for (int k = 0; k < 4; ++k) amax = fmaxf(amax, fmaxf(fabsf(a0[i][k]), fabsf(a1[i][k]))); }
          amax = fmaxf(amax, __shfl_xor(amax, 1)); amax = fmaxf(amax, __shfl_xor(amax, 2)); amax = fmaxf(amax, __shfl_xor(amax, 8)); amax = fmaxf(amax, __shfl_xor(amax, 16)); amax = fmaxf(amax, __shfl_xor(amax, 32));
          const float inv = (amax > 0.f) ? 127.f / amax : 0.f;
          if (j == 0 && sl == 0) ((float*)(ws + WS_SX))[row] = (amax > 0.f) ? amax * (1.f / 127.f) : 1.f;
          unsigned char* xq = ws + WS_XQ + (size_t)row * 64 + (sl & 1) * 32 + j * 8;
#pragma unroll
          for (int i = 0; i < 8; ++i) { int q[8];
#pragma unroll
              for (int k = 0; k < 4; ++k) { q[k] = (int)__builtin_rintf(a0[i][k] * inv); q[4 + k] = (int)__builtin_rintf(a1[i][k] * inv); }
              v2u o; o.x = (unsigned)(q[0] & 255) | ((unsigned)(q[1] & 255) << 8) | ((unsigned)(q[2] & 255) << 16) | ((unsigned)q[3] << 24);
              o.y = (unsigned)(q[4] & 255) | ((unsigned)(q[5] & 255) << 8) | ((unsigned)(q[6] & 255) << 16) | ((unsigned)q[7] << 24);
              *(v2u*)(xq + (size_t)(4 * i + (sl >> 1)) * T * 64) = o; } } }
    { const float* keys = GP(const float, a->in[I_PKEYS]); bf16* dst = (bf16*)(ws + WS_BK);
      for (size_t i = gt; i < (size_t)DEPTH * 8 * 256 * 256 / 8; i += NT) { const int jj = (int)(i & 31) * 8; const int row = (int)((i >> 5) & 255); const size_t lh = i >> 13; const int half = row >> 7, n = row & 127;
          v4u w = (v4u){0u, 0u, 0u, 0u};
          if ((jj >> 7) == half) { const float* s = keys + ((lh * 2 + half) * 128 + n) * 128 + (jj & 127); const f32x4 v0 = *(const f32x4*)s, v1 = *(const f32x4*)(s + 4);
              w.x = cvt_pk_bf16(v0[0], v0[1]); w.y = cvt_pk_bf16(v0[2], v0[3]); w.z = cvt_pk_bf16(v1[0], v1[1]); w.w = cvt_pk_bf16(v1[2], v1[3]); }
          *(v4u*)(dst + i * 8) = w; } }
    if (gt < 1024) { const float* lg = GP(const float, a->in[I_LBL]); float* lbo = (float*)(ws + WS_LB); const int d = (int)gt;
        const float z0 = lg[d], z1 = lg[1024 + d], z2 = lg[2048 + d], z3 = lg[3072 + d]; const float mx = fmaxf(fmaxf(z0, z1), fmaxf(z2, z3));
        const float e0 = expf(z0 - mx), e1 = expf(z1 - mx), e2 = expf(z2 - mx), e3 = expf(z3 - mx); const float inv = 1.f / (e0 + e1 + e2 + e3);
        lbo[d] = 0.f; lbo[1024 + d] = e1 * inv; lbo[2048 + d] = (e1 + e2) * inv; lbo[3072 + d] = (e1 + e2 + e3) * inv; }
    for (size_t i = gt; i < (size_t)DEPTH * 64 * 64; i += NT) {
        const size_t lg_ = i >> 6;
        const double lr = fmin((double)GP(const float, a->in[I_LRE])[i], -1e-4), li = (double)GP(const float, a->in[I_LIM])[i], dt = exp_d((double)GP(const float, a->in[I_LSTEP])[lg_]);
        const double mag = exp_d(lr * dt); double sn, cs; sincos_d(li * dt, sn, cs);
        const double ar = mag * cs, ai = mag * sn, den = lr * lr + li * li, nr = ar - 1.0;
        const double zr = (nr * lr + ai * li) / den, zi = (ai * lr - nr * li) / den;
        const float* br = GP(const float, a->in[I_BRE]) + i * 16; const float* bi = GP(const float, a->in[I_BIM]) + i * 16; float* bb = (float*)(ws + WS_BB) + i * 32;
        f32x4 brv[4], biv[4];
#pragma unroll
        for (int m4 = 0; m4 < 4; ++m4) { brv[m4] = ((const f32x4*)br)[m4]; biv[m4] = ((const f32x4*)bi)[m4]; }
#pragma unroll
        for (int m4 = 0; m4 < 4; ++m4) { float o8[8];
#pragma unroll
            for (int x = 0; x < 4; ++x) { const double b_r = brv[m4][x], b_i = biv[m4][x]; o8[2 * x] = (float)(zr * b_r - zi * b_i); o8[2 * x + 1] = (float)(zr * b_i + zi * b_r); }
            ((f32x4*)bb)[2 * m4] = (f32x4){o8[0], o8[1], o8[2], o8[3]}; ((f32x4*)bb)[2 * m4 + 1] = (f32x4){o8[4], o8[5], o8[6], o8[7]}; }
        float* ap = (float*)(ws + WS_APOW) + (lg_ * 65 * 64 + (i & 63)) * 2; double pr = 1.0, pi = 0.0;
        for (int dl = 0; dl < 65; ++dl) { ap[dl * 128] = (float)pr; ap[dl * 128 + 1] = (float)pi; const double t = pr * ar - pi * ai; pi = pr * ai + pi * ar; pr = t; }
    }
    for (int it = gw; it < DEPTH * 1024; it += NGW) {
        const int l = it >> 10, eb = it & 1023;
        const int pe = eb * 16 + (F.lane >> 2), i1 = (pe & 1023) >> 3, i2 = (pe & 7) * 16 + (((pe >> 10) - i1) & 15);
        const float* src = GP(const float, a->in[I_PV]) + ((size_t)l * NEXP + i1 * 128 + i2) * D + (F.lane & 3) * 8;
        bf16* dst = (bf16*)(ws + WS_TBV) + (size_t)l * 64 * NEXP * 32 + ((size_t)(eb * 16 + (F.lane >> 2)) * 4 + ((F.lane & 3) ^ ((F.lane >> 4) & 3))) * 8;
#pragma unroll 1
        for (int k8 = 0; k8 < 64; k8 += 8) { f32x4 va[8], vb[8];
#pragma unroll
            for (int k = 0; k < 8; ++k) { va[k] = __builtin_nontemporal_load((const f32x4*)(src + (k8 + k) * 32)); vb[k] = __builtin_nontemporal_load((const f32x4*)(src + (k8 + k) * 32 + 4)); }
#pragma unroll
            for (int k = 0; k < 8; ++k) { v4u w; w.x = cvt_pk_f16(va[k][0], va[k][1]); w.y = cvt_pk_f16(va[k][2], va[k][3]); w.z = cvt_pk_f16(vb[k][0], vb[k][1]); w.w = cvt_pk_f16(vb[k][2], vb[k][3]);
                *(v4u*)(dst + (size_t)(k8 + k) * NEXP * 32) = w; } }
    }
    for (int it = gw; it < DEPTH * 4096; it += NGW) {
        const int l = it >> 12, q4 = it & 4095, c = F.lane & 15;
        const int pe = q4 * 4 + (F.lane >> 4), i1 = (pe & 1023) >> 3, i2 = (pe & 7) * 16 + (((pe >> 10) - i1) & 15);
        const float* src = GP(const float, a->in[I_PU]) + ((size_t)l * NEXP + i1 * 128 + i2) * D + c * 4;
        unsigned hv[64]; float m = 0.f;
#pragma unroll
        for (int i = 0; i < 32; ++i) { const f32x4 v = __builtin_nontemporal_load((const f32x4*)(src + i * 64));
            m = fmaxf(fmaxf(m, fmaxf(fabsf(v[0]), fabsf(v[1]))), fmaxf(fabsf(v[2]), fabsf(v[3])));
            hv[2 * i] = cvt_pk_f16(v[0], v[1]); hv[2 * i + 1] = cvt_pk_f16(v[2], v[3]); }
        m = fmaxf(m, __shfl_xor(m, 1)); m = fmaxf(m, __shfl_xor(m, 2)); m = fmaxf(m, __shfl_xor(m, 4)); m = fmaxf(m, __shfl_xor(m, 8));
        const float sc = (m > 0.f) ? m * (1.f / 127.f) : 1.f, inv = (m > 0.f) ? 127.f / m : 0.f;
        if (c == 0) ((float*)(ws + WS_SU))[(size_t)l * NEXP + pe] = sc;
        unsigned char* dst = ws + WS_TBU + (size_t)l * 32 * NEXP * 64 + (size_t)pe * 64 + (((c >> 2) ^ ((pe >> 2) & 3)) * 16 + (c & 3) * 4);
#pragma unroll
        for (int i = 0; i < 32; ++i) { const h2_t p0 = __builtin_bit_cast(h2_t, hv[2 * i]), p1 = __builtin_bit_cast(h2_t, hv[2 * i + 1]);
            const int q0 = (int)__builtin_rintf((float)p0.x * inv), q1 = (int)__builtin_rintf((float)p0.y * inv), q2 = (int)__builtin_rintf((float)p1.x * inv), q3 = (int)__builtin_rintf((float)p1.y * inv);
            *(unsigned*)(dst + (size_t)i * NEXP * 64) = (unsigned)(q0 & 255) | ((unsigned)(q1 & 255) << 8) | ((unsigned)(q2 & 255) << 16) | ((unsigned)q3 << 24); }
    }
}
__device__ __forceinline__ double dummy_unused_(double x) { return x; }

__device__ __forceinline__ void phase_prologue_b(const Frame& F0) {
    Frame F = F0; F.tid = F.wave * 64 + lane_id(); asm volatile("" : "+v"(F.tid)); F.lane = F.tid & 63;
    unsigned char* ws = opqg(F.ws); const __attribute__((address_space(4))) Args* a = opq(F.ka);
    const float* APOW = (const float*)(ws + WS_APOW); const float* BB = (const float*)(ws + WS_BB);
    LAS float* AP = (LAS float*)(F.lds); LAS float* BL = (LAS float*)(F.lds + 33280); LAS float* CR = (LAS float*)(F.lds + 41472); LAS float* CI = (LAS float*)(F.lds + 45568); LAS float* SDL = (LAS float*)(F.lds + 49664);
    bf16* KM = (bf16*)(ws + WS_KMAT); bf16* PM = (bf16*)(ws + WS_PM); bf16* E = (bf16*)(ws + WS_E);
    for (int lg = F.vcu; lg < DEPTH * 64; lg += F.G) {
        for (int i = F.tid; i < 65 * 64 * 2 / 4; i += 512) ((LAS f32x4*)AP)[i] = ((const f32x4*)(APOW + (size_t)lg * 65 * 128))[i];
        ((LAS f32x4*)BL)[F.tid] = ((const f32x4*)(BB + (size_t)lg * 2048))[F.tid];
        if (F.tid < 256) ((LAS f32x4*)CR)[F.tid] = ((const f32x4*)(GP(const float, a->in[I_CRE]) + (size_t)lg * 1024))[F.tid];
        else ((LAS f32x4*)CI)[F.tid - 256] = ((const f32x4*)(GP(const float, a->in[I_CIM]) + (size_t)lg * 1024))[F.tid - 256];
        if (F.tid < 16) SDL[F.tid] = GP(const float, a->in[I_SD])[lg * 16 + F.tid];
        __syncthreads();
        for (int task = F.tid; task < 65 * 16; task += 512) {
            const int n = task & 15, idx = task >> 4;
            float sm[16];
#pragma unroll
            for (int m = 0; m < 16; ++m) sm[m] = 0.f;
            if (idx > 0) { const int dl = idx - 1;
#pragma unroll 4
                for (int p = 0; p < 64; ++p) { const f32x2 av = *(const LAS f32x2*)(AP + (dl * 64 + p) * 2); const float c_r = CR[n * 64 + p], c_i = CI[n * 64 + p];
                    const float car = c_r * av[0] - c_i * av[1], cai = c_r * av[1] + c_i * av[0];
#pragma unroll
                    for (int q = 0; q < 8; ++q) { const f32x4 b4 = *(const LAS f32x4*)(BL + p * 32 + q * 4); sm[2 * q] += car * b4[0] - cai * b4[1]; sm[2 * q + 1] += car * b4[2] - cai * b4[3]; } }
                if (dl == 0) { const float dv = SDL[n];
#pragma unroll
                    for (int m = 0; m < 16; ++m) sm[m] += (m == n) ? dv : 0.f; } }
            v4u w0, w1; w0.x = cvt_pk_bf16(sm[0], sm[1]); w0.y = cvt_pk_bf16(sm[2], sm[3]); w0.z = cvt_pk_bf16(sm[4], sm[5]); w0.w = cvt_pk_bf16(sm[6], sm[7]);
            w1.x = cvt_pk_bf16(sm[8], sm[9]); w1.y = cvt_pk_bf16(sm[10], sm[11]); w1.z = cvt_pk_bf16(sm[12], sm[13]); w1.w = cvt_pk_bf16(sm[14], sm[15]);
            bf16* kp = KM + ((size_t)lg * 65 * 16 + task) * 16; *(v4u*)kp = w0; *(v4u*)(kp + 8) = w1; }
        for (int it = F.tid; it < 128 * 64 * 2; it += 512) {
            const int m0 = (it & 1) * 8, sidx = (it >> 1) & 63, pp = it >> 7, p = pp & 63;
            const f32x2 av = *(const LAS f32x2*)(AP + ((63 - sidx) * 64 + p) * 2); const float pr = av[0], pi = av[1];
            float o[8];
#pragma unroll
            for (int j = 0; j < 4; ++j) { const f32x4 b4 = *(const LAS f32x4*)(BL + p * 32 + m0 * 2 + j * 4);
                o[2 * j] = (pp < 64) ? (pr * b4[0] - pi * b4[1]) : (pr * b4[1] + pi * b4[0]); o[2 * j + 1] = (pp < 64) ? (pr * b4[2] - pi * b4[3]) : (pr * b4[3] + pi * b4[2]); }
            v4u w; w.x = cvt_pk_bf16(o[0], o[1]); w.y = cvt_pk_bf16(o[2], o[3]); w.z = cvt_pk_bf16(o[4], o[5]); w.w = cvt_pk_bf16(o[6], o[7]); *(v4u*)(PM + ((size_t)lg * 16384 + it) * 8) = w; }
        for (int it = F.tid; it < 1024 * 16; it += 512) {
            const int pp0 = (it & 15) * 8, n = (it >> 4) & 15, tau = it >> 8, p0 = pp0 & 63;
            float o[8];
#pragma unroll
            for (int j = 0; j < 8; ++j) { const f32x2 av = *(const LAS f32x2*)(AP + ((tau + 1) * 64 + p0 + j) * 2); const float c_r = CR[n * 64 + p0 + j], c_i = CI[n * 64 + p0 + j];
                o[j] = (pp0 < 64) ? (c_r * av[0] - c_i * av[1]) : -(c_r * av[1] + c_i * av[0]); }
            v4u w; w.x = cvt_pk_bf16(o[0], o[1]); w.y = cvt_pk_bf16(o[2], o[3]); w.z = cvt_pk_bf16(o[4], o[5]); w.w = cvt_pk_bf16(o[6], o[7]); *(v4u*)(E + ((size_t)lg * 16384 + it) * 8) = w; }
        __syncthreads();
    }
}
__device__ __forceinline__ void quant_rows(const Frame& F0, const bf16* SRC, int rpl, int lrows, int row0, unsigned char* W8, float* SW) {
    Frame F = F0; F.tid = F.wave * 64 + lane_id(); asm volatile("" : "+v"(F.tid)); F.lane = F.tid & 63;
    for (int row = F.vcu * 8 + F.wave; row < DEPTH * rpl; row += F.G * 8) {
        const int l = row / rpl, r = row - l * rpl; const bf16* sp = SRC + ((size_t)l * lrows + row0 + r) * 2048;
        v4u w[4]; float vf[32]; float m = 0.f;
#pragma unroll
        for (int k = 0; k < 4; ++k) w[k] = *(const v4u*)(sp + (k * 64 + F.lane) * 8);
#pragma unroll
        for (int k = 0; k < 4; ++k) { const unsigned ww[4] = {w[k].x, w[k].y, w[k].z, w[k].w};
#pragma unroll
            for (int x = 0; x < 4; ++x) { const h2_t hv = __builtin_bit_cast(h2_t, ww[x]); vf[8 * k + 2 * x] = (float)hv.x; vf[8 * k + 2 * x + 1] = (float)hv.y; m = fmaxf(m, fmaxf(fabsf((float)hv.x), fabsf((float)hv.y))); } }
#pragma unroll
        for (int o = 1; o < 64; o <<= 1) m = fmaxf(m, __shfl_xor(m, o));
        const float inv = (m > 0.f) ? 127.f / m : 0.f;
        if (F.lane == 0) SW[row] = (m > 0.f) ? m * (1.f / 127.f) : 1.f;
#pragma unroll
        for (int k = 0; k < 4; ++k) { int q[8];
#pragma unroll
            for (int x = 0; x < 8; ++x) q[x] = (int)__builtin_rintf(vf[8 * k + x] * inv);
            v2u o; o.x = (unsigned)(q[0] & 255) | ((unsigned)(q[1] & 255) << 8) | ((unsigned)(q[2] & 255) << 16) | ((unsigned)q[3] << 24);
            o.y = (unsigned)(q[4] & 255) | ((unsigned)(q[5] & 255) << 8) | ((unsigned)(q[6] & 255) << 16) | ((unsigned)q[7] << 24);
            *(v2u*)(W8 + (size_t)row * 2048 + (k * 64 + F.lane) * 8) = o; }
    }
}
constexpr int HG_BL = 0, HG_TOT = 33792, HG_VT = 35840, HG_KT = 54272, HG_RED = 72704;
constexpr int KSP = 136, HG_KS = 73728, HG_QT = HG_KS + 64 * KSP * 2, HG_QH = HG_QT + 64 * KSP * 2;
static_assert(HG_QH + 64 * KSP * 2 <= RING_BYTES, "hgrn_out LDS map");
constexpr int BLP = 132, VTP = 72;
__device__ __forceinline__ void hg_cumsum(const Frame& F, const float* LOGF, int c, int h) {
    LAS float* bL = (LAS float*)(F.lds + HG_BL); LAS float* tot = (LAS float*)(F.lds + HG_TOT);
    const int d = F.tid & 127, seg = F.tid >> 7;
    const float* src = LOGF + (size_t)(c * 64 + seg * 16) * AW + h * 128 + d;
    float lf[16];
#pragma unroll
    for (int i = 0; i < 16; ++i) lf[i] = src[(size_t)i * AW];
#pragma unroll
    for (int i = 1; i < 16; ++i) lf[i] += lf[i - 1];
    tot[seg * 128 + d] = lf[15];
    __syncthreads();
    float off = 0.f;
#pragma unroll
    for (int s2 = 0; s2 < 3; ++s2) off += (s2 < seg) ? tot[s2 * 128 + d] : 0.f;
#pragma unroll
    for (int i = 0; i < 16; ++i) bL[(seg * 16 + i) * BLP + d] = lf[i] + off;
}
__device__ __forceinline__ void hg_load_vt(const Frame& F, const bf16* V, int c, int h) {
    LAS bf16* VT = (LAS bf16*)(F.lds + HG_VT);
    const int s = F.lane, vb = F.wave * 16;
    const v4u* src = (const v4u*)(V + (size_t)(c * 64 + s) * AW + h * 128 + vb);
    const v4u w0 = src[0], w1 = src[1];
    const unsigned ww[8] = {w0.x, w0.y, w0.z, w0.w, w1.x, w1.y, w1.z, w1.w};
#pragma unroll
    for (int j = 0; j < 8; ++j) { VT[(vb + 2 * j) * VTP + s] = (bf16)(ww[j] & 0xffffu); VT[(vb + 2 * j + 1) * VTP + s] = (bf16)(ww[j] >> 16); }
}
__device__ __forceinline__ void phase_hgrn_local(const Frame& F0, int l) {
    Frame F = F0; F.tid = F.wave * 64 + lane_id(); asm volatile("" : "+v"(F.tid)); F.lane = F.tid & 63;
    unsigned char* ws = opqg(F.ws);
    const float* LOGF = (const float*)(ws + WS_LOGF); const bf16* KK = (const bf16*)(ws + WS_KK); const bf16* V = (const bf16*)(ws + WS_V);
    _Float16* U = (_Float16*)(ws + WS_U); float* BLo = (float*)(ws + WS_BL);
    LAS float* bL = (LAS float*)(F.lds + HG_BL); LAS bf16* VT = (LAS bf16*)(F.lds + HG_VT); LAS bf16* KT = (LAS bf16*)(F.lds + HG_KT);
    const int fr = F.lane & 15, fq = F.lane >> 4;
    for (int unit = F.vcu; unit < NCH * 8; unit += F.G) {
        const int c = unit >> 3, h = unit & 7;
        hg_cumsum(F, LOGF, c, h);
        hg_load_vt(F, V, c, h);
        __syncthreads();
        { const int s = F.lane, db = F.wave * 16;
          const v4u* src = (const v4u*)(KK + (size_t)(c * 64 + s) * AW + h * 128 + db);
          const v4u w0 = src[0], w1 = src[1];
          const unsigned ww[8] = {w0.x, w0.y, w0.z, w0.w, w1.x, w1.y, w1.z, w1.w};
#pragma unroll
          for (int j = 0; j < 8; ++j) {
              const float b0 = bL[s * BLP + db + 2 * j], b1 = bL[s * BLP + db + 2 * j + 1], l0 = bL[63 * BLP + db + 2 * j], l1 = bL[63 * BLP + db + 2 * j + 1];
              const unsigned pk = cvt_pk_bf16(bf_lo(ww[j]) * fexp(l0 - b0), bf_hi(ww[j]) * fexp(l1 - b1));
              KT[(db + 2 * j) * VTP + s] = (bf16)(pk & 0xffffu); KT[(db + 2 * j + 1) * VTP + s] = (bf16)(pk >> 16); } }
        if (F.tid < 128) BLo[(size_t)c * AW + h * 128 + F.tid] = bL[63 * BLP + F.tid];
        __syncthreads();
        f32x4 acc[8];
#pragma unroll
        for (int i = 0; i < 8; ++i) acc[i] = (f32x4){0.f, 0.f, 0.f, 0.f};
#pragma unroll
        for (int ks = 0; ks < 2; ++ks) {
            const bf16x8 A = *(const LAS bf16x8*)(VT + (F.wave * 16 + fr) * VTP + ks * 32 + fq * 8);
#pragma unroll
            for (int dt = 0; dt < 8; ++dt) { const bf16x8 B = *(const LAS bf16x8*)(KT + (dt * 16 + fr) * VTP + ks * 32 + fq * 8);
                acc[dt] = __builtin_amdgcn_mfma_f32_16x16x32_bf16(B, A, acc[dt], 0, 0, 0); }
        }
        _Float16* up = U + ((size_t)(c * 8 + h) * 128 + F.wave * 16 + fr) * 128 + fq * 4;
#pragma unroll
        for (int dt = 0; dt < 8; ++dt) { v2u w; w.x = cvt_pk_f16(acc[dt][0], acc[dt][1]); w.y = cvt_pk_f16(acc[dt][2], acc[dt][3]); *(v2u*)(up + dt * 16) = w; }
        __syncthreads();
    }
}
__device__ __forceinline__ void phase_scan(const Frame& F0, int l) {
    Frame F = F0; F.tid = F.wave * 64 + lane_id(); asm volatile("" : "+v"(F.tid)); F.lane = F.tid & 63;
    unsigned char* ws = opqg(F.ws);
    const _Float16* U = (const _Float16*)(ws + WS_U); const float* BLo = (const float*)(ws + WS_BL); bf16* SP = (bf16*)(ws + WS_SP);
    for (int e = F.vcu * 512 + F.tid; e < 8 * 128 * 128; e += F.G * 512) {
        const int hd = (e >> 14) * 128 + (e & 127);
        float s = 0.f;
        float u[32], bl[32], bln[32]; _Float16 unh[32];
#pragma unroll
        for (int i = 0; i < 32; ++i) { u[i] = (float)U[(size_t)i * 131072 + e]; bl[i] = BLo[(size_t)i * AW + hd]; }
#pragma unroll 1
        for (int c0 = 0; c0 < NCH; c0 += 32) {
            const int cn = (c0 + 32 < NCH) ? c0 + 32 : c0;
#pragma unroll
            for (int i = 0; i < 32; ++i) { unh[i] = U[(size_t)(cn + i) * 131072 + e]; bln[i] = BLo[(size_t)(cn + i) * AW + hd]; }
#pragma unroll
            for (int i = 0; i < 32; ++i) { SP[(size_t)(c0 + i) * 131072 + e] = f2bf(s); s = s * fexp(bl[i]) + u[i]; }
#pragma unroll
            for (int i = 0; i < 32; ++i) { u[i] = (float)unh[i]; bl[i] = bln[i]; }
        }
    }
    const float* XLOC = (const float*)(ws + WS_XLOC); float* XS = (float*)(ws + WS_XS); const float* APOW = (const float*)(ws + WS_APOW);
    for (int e = F.vcu * 512 + F.tid; e < 64 * 64; e += F.G * 512) {
        const int g = e >> 6, p = e & 63;
        const float* ap = APOW + (((size_t)(l * 64 + g) * 65 + 64) * 64 + p) * 2; const float ar = ap[0], ai = ap[1];
        float xr = 0.f, xi = 0.f;
        for (int c0 = 0; c0 < NCH; c0 += 32) {
            float lr_[32], li_[32];
#pragma unroll
            for (int i = 0; i < 32; ++i) { lr_[i] = XLOC[((size_t)(c0 + i) * 64 + g) * 128 + p]; li_[i] = XLOC[((size_t)(c0 + i) * 64 + g) * 128 + 64 + p]; }
#pragma unroll
            for (int i = 0; i < 32; ++i) { XS[((size_t)(c0 + i) * 64 + g) * 128 + p] = xr; XS[((size_t)(c0 + i) * 64 + g) * 128 + 64 + p] = xi;
                const float t = ar * xr - ai * xi + lr_[i]; xi = ar * xi + ai * xr + li_[i]; xr = t; }
        }
    }
}
__device__ __forceinline__ void phase_hgrn_out(const Frame& F0, int l) {
    Frame F = F0; F.tid = F.wave * 64 + lane_id(); asm volatile("" : "+v"(F.tid)); F.lane = F.tid & 63;
    unsigned char* ws = opqg(F.ws); const __attribute__((address_space(4))) Args* a = opq(F.ka);
    const float* LOGF = (const float*)(ws + WS_LOGF); const bf16* KK = (const bf16*)(ws + WS_KK); const bf16* V = (const bf16*)(ws + WS_V);
    const bf16* Q = (const bf16*)(ws + WS_Q); const bf16* SG = (const bf16*)(ws + WS_SG); const bf16* SP = (const bf16*)(ws + WS_SP);
    bf16* OAB = (bf16*)(ws + WS_OAB); const float* NG = GP(const float, a->in[I_NG]) + (size_t)l * AW;
    LAS float* bL = (LAS float*)(F.lds + HG_BL); LAS bf16* VT = (LAS bf16*)(F.lds + HG_VT); LAS float* red = (LAS float*)(F.lds + HG_RED);
    const int fr = F.lane & 15, fq = F.lane >> 4, tt = F.wave & 3, vh = F.wave >> 2;
    LAS float* tot = (LAS float*)(F.lds + HG_TOT);
    float lf[16]; v4u vw0, vw1, kg0, kg1, qg0, qg1;
#define HGO_PREF(u_) { const int c_ = (u_) >> 3, h_ = (u_) & 7; \
        const float* src_ = LOGF + (size_t)(c_ * 64 + (F.tid >> 7) * 16) * AW + h_ * 128 + (F.tid & 127); \
        _Pragma("unroll") for (int i = 0; i < 16; ++i) lf[i] = src_[(size_t)i * AW]; \
        const v4u* vp_ = (const v4u*)(V + (size_t)(c_ * 64 + F.lane) * AW + h_ * 128 + F.wave * 16); vw0 = vp_[0]; vw1 = vp_[1]; \
        const size_t ro_ = ((size_t)c_ * 64 + (F.tid >> 3)) * AW + h_ * 128 + (F.tid & 7) * 16; \
        const v4u* kp_ = (const v4u*)(KK + ro_); const v4u* qp_ = (const v4u*)(Q + ro_); kg0 = kp_[0]; kg1 = kp_[1]; qg0 = qp_[0]; qg1 = qp_[1]; }
    if (F.vcu < NCH * 8) HGO_PREF(F.vcu)
    for (int unit = F.vcu; unit < NCH * 8; unit += F.G) {
        const int c = unit >> 3, h = unit & 7;
        { const int d = F.tid & 127, seg = F.tid >> 7;
#pragma unroll
          for (int i = 1; i < 16; ++i) lf[i] += lf[i - 1];
          tot[seg * 128 + d] = lf[15];
          { const int s = F.lane, vb = F.wave * 16; const unsigned ww[8] = {vw0.x, vw0.y, vw0.z, vw0.w, vw1.x, vw1.y, vw1.z, vw1.w};
#pragma unroll
            for (int j = 0; j < 8; ++j) { VT[(vb + 2 * j) * VTP + s] = (bf16)(ww[j] & 0xffffu); VT[(vb + 2 * j + 1) * VTP + s] = (bf16)(ww[j] >> 16); } }
          __syncthreads();
          float off = 0.f;
#pragma unroll
          for (int s2 = 0; s2 < 3; ++s2) off += (s2 < seg) ? tot[s2 * 128 + d] : 0.f;
#pragma unroll
          for (int i = 0; i < 16; ++i) bL[(seg * 16 + i) * BLP + d] = lf[i] + off; }
        __syncthreads();
        const int t = tt * 16 + fr; const size_t tok = (size_t)c * 64 + t;
        bf16x8 sg_[2][4];
#define HG_LOAD(buf, kd_) { const int d0_ = (kd_) * 32 + fq * 8; \
            _Pragma("unroll") for (int vt = 0; vt < 4; ++vt) sg_[buf][vt] = *(const bf16x8*)(SP + ((size_t)(c * 8 + h) * 128 + (vh * 4 + vt) * 16 + fr) * 128 + d0_); }
        HG_LOAD(0, 0) HG_LOAD(1, 1)
        v2u sgw[4];
#pragma unroll
        for (int vt = 0; vt < 4; ++vt) sgw[vt] = *(const v2u*)(SG + tok * AW + h * 128 + (vh * 4 + vt) * 16 + fq * 4);
        f32x4 ngw[4];
#pragma unroll
        for (int vt = 0; vt < 4; ++vt) ngw[vt] = *(const f32x4*)(NG + h * 128 + (vh * 4 + vt) * 16 + fq * 4);
        { const int s = F.tid >> 3, dc = (F.tid & 7) * 16;
          const unsigned kq[8] = {kg0.x, kg0.y, kg0.z, kg0.w, kg1.x, kg1.y, kg1.z, kg1.w}, qq[8] = {qg0.x, qg0.y, qg0.z, qg0.w, qg1.x, qg1.y, qg1.z, qg1.w};
          unsigned ko[8], qto[8], qho[8];
#pragma unroll
          for (int j4 = 0; j4 < 4; ++j4) { const f32x4 bs = *(const LAS f32x4*)(bL + s * BLP + dc + 4 * j4), br = *(const LAS f32x4*)(bL + 31 * BLP + dc + 4 * j4);
#pragma unroll
              for (int hx = 0; hx < 2; ++hx) { const int w = 2 * j4 + hx; const float b0 = bs[2 * hx], b1 = bs[2 * hx + 1], r0 = br[2 * hx], r1 = br[2 * hx + 1];
                  const float k0 = bf_lo(kq[w]), k1 = bf_hi(kq[w]), q0 = bf_lo(qq[w]), q1 = bf_hi(qq[w]);
                  ko[w] = cvt_pk_bf16(k0 * fexp(fminf(r0 - b0, 80.f)), k1 * fexp(fminf(r1 - b1, 80.f)));
                  qto[w] = cvt_pk_bf16(q0 * fexp(fminf(b0 - r0, 80.f)), q1 * fexp(fminf(b1 - r1, 80.f)));
                  qho[w] = cvt_pk_bf16(q0 * fexp(b0), q1 * fexp(b1)); } }
          LAS v4u* kd_ = (LAS v4u*)(F.lds + HG_KS + (s * KSP + dc) * 2); kd_[0] = (v4u){ko[0], ko[1], ko[2], ko[3]}; kd_[1] = (v4u){ko[4], ko[5], ko[6], ko[7]};
          LAS v4u* qt_ = (LAS v4u*)(F.lds + HG_QT + (s * KSP + dc) * 2); qt_[0] = (v4u){qto[0], qto[1], qto[2], qto[3]}; qt_[1] = (v4u){qto[4], qto[5], qto[6], qto[7]};
          LAS v4u* qh_ = (LAS v4u*)(F.lds + HG_QH + (s * KSP + dc) * 2); qh_[0] = (v4u){qho[0], qho[1], qho[2], qho[3]}; qh_[1] = (v4u){qho[4], qho[5], qho[6], qho[7]}; }
        __syncthreads();
        f32x4 att[4], o[4];
#pragma unroll
        for (int i = 0; i < 4; ++i) { att[i] = (f32x4){0.f, 0.f, 0.f, 0.f}; o[i] = (f32x4){0.f, 0.f, 0.f, 0.f}; }
#pragma unroll
        for (int kd = 0; kd < 4; ++kd) {
            const int cb = kd & 1;
            const int fo = (kd * 32 + fq * 8) * 2;
            const bf16x8 Bqt = *(const LAS bf16x8*)(F.lds + HG_QT + (t * KSP) * 2 + fo), Bqh = *(const LAS bf16x8*)(F.lds + HG_QH + (t * KSP) * 2 + fo);
#pragma unroll
            for (int st = 0; st < 4; ++st) { const bf16x8 kt = *(const LAS bf16x8*)(F.lds + HG_KS + ((st * 16 + fr) * KSP) * 2 + fo);
                att[st] = __builtin_amdgcn_mfma_f32_16x16x32_bf16(kt, Bqt, att[st], 0, 0, 0); }
#pragma unroll
            for (int vt = 0; vt < 4; ++vt) o[vt] = __builtin_amdgcn_mfma_f32_16x16x32_bf16(sg_[cb][vt], Bqh, o[vt], 0, 0, 0);
            if (kd < 2) HG_LOAD(cb, kd + 2)
            if (kd == 1) { const int nu = unit + F.G; if (nu < NCH * 8) HGO_PREF(nu) }
        }
#undef HG_LOAD
#pragma unroll
        for (int ks = 0; ks < 2; ++ks) {
            float m8[8];
#pragma unroll
            for (int jj = 0; jj < 8; ++jj) { const int st = 2 * ks + (jj >> 2), r = jj & 3, s = st * 16 + fq * 4 + r; m8[jj] = (s <= t) ? att[st][r] : 0.f; }
            v4u pb; pb.x = cvt_pk_bf16(m8[0], m8[1]); pb.y = cvt_pk_bf16(m8[2], m8[3]); pb.z = cvt_pk_bf16(m8[4], m8[5]); pb.w = cvt_pk_bf16(m8[6], m8[7]);
            const bf16x8 B = __builtin_bit_cast(bf16x8, pb);
#pragma unroll
            for (int vt = 0; vt < 4; ++vt) { const int v = (vh * 4 + vt) * 16 + fr;
                const v2u a0 = *(const LAS v2u*)(VT + v * VTP + ks * 32 + fq * 4), a1 = *(const LAS v2u*)(VT + v * VTP + ks * 32 + 16 + fq * 4);
                const v4u pa = (v4u){a0.x, a0.y, a1.x, a1.y};
                o[vt] = __builtin_amdgcn_mfma_f32_16x16x32_bf16(__builtin_bit_cast(bf16x8, pa), B, o[vt], 0, 0, 0); }
        }
        float ss = 0.f;
#pragma unroll
        for (int vt = 0; vt < 4; ++vt)
#pragma unroll
            for (int r = 0; r < 4; ++r) ss += o[vt][r] * o[vt][r];
        ss += __shfl_xor(ss, 16); ss += __shfl_xor(ss, 32);
        if (fq == 0) red[F.wave * 16 + fr] = ss;
        LDS_WAIT(); __builtin_amdgcn_s_barrier(); asm volatile("" ::: "memory");
        const float tot = red[F.wave * 16 + fr] + red[(F.wave ^ 4) * 16 + fr];
        const float rstd = __builtin_amdgcn_rsqf(tot * (1.f / 128.f) + RMS_EPS);
#pragma unroll
        for (int vt = 0; vt < 4; ++vt) { const int v0 = (vh * 4 + vt) * 16 + fq * 4;
            const f32x4 g4 = ngw[vt]; const v2u sg = sgw[vt];
            v2u w; w.x = cvt_pk_bf16(o[vt][0] * rstd * g4[0] * bf_lo(sg.x), o[vt][1] * rstd * g4[1] * bf_hi(sg.x));
            w.y = cvt_pk_bf16(o[vt][2] * rstd * g4[2] * bf_lo(sg.y), o[vt][3] * rstd * g4[3] * bf_hi(sg.y));
            *(v2u*)(OAB + tok * 2048 + h * 128 + v0) = w; }
        LDS_WAIT(); __builtin_amdgcn_s_barrier(); asm volatile("" ::: "memory");
    }
#undef HGO_PREF
}

constexpr int S5_UT = 0, S5_UTP = 2064, S5_XST = 33024, S5_XSP = 272, S5_KM = 37376;
__device__ __forceinline__ void s5_load_ut(const Frame& F, const bf16* UB, int g, int jb) {
    v4u w0[2], w1[2];
#pragma unroll
    for (int i = 0; i < 2; ++i) { const int tl = F.tid + 512 * i; const v4u* src = (const v4u*)(UB + ((size_t)jb * 1024 + tl) * AW + g * 16); w0[i] = src[0]; w1[i] = src[1]; }
#pragma unroll
    for (int i = 0; i < 2; ++i) { const int tl = F.tid + 512 * i; LAS v4u* dst = (LAS v4u*)(F.lds + S5_UT + (tl >> 6) * S5_UTP + (tl & 63) * 32); dst[0] = w0[i]; dst[1] = w1[i]; }
}
__device__ __forceinline__ void phase_s5_local(const Frame& F0, int l) {
    Frame F = F0; F.tid = F.wave * 64 + lane_id(); asm volatile("" : "+v"(F.tid)); F.lane = F.tid & 63;
    unsigned char* ws = opqg(F.ws);
    const bf16* UB = (const bf16*)(ws + WS_UB); const bf16* PM = (const bf16*)(ws + WS_PM) + (size_t)l * 64 * 128 * 1024; float* XLOC = (float*)(ws + WS_XLOC);
    const int fr = F.lane & 15, fq = F.lane >> 4;
    for (int unit = F.vcu; unit < 64 * 8; unit += F.G) {
        const int g = unit >> 3, jb = unit & 7;
        const bf16* ap = PM + ((size_t)g * 128 + F.wave * 16 + fr) * 1024 + fq * 8;
        bf16x8 Af[32];
#pragma unroll
        for (int ks = 0; ks < 32; ++ks) Af[ks] = *(const bf16x8*)(ap + ks * 32);
        s5_load_ut(F, UB, g, jb);
        __syncthreads();
        f32x4 acc = (f32x4){0.f, 0.f, 0.f, 0.f};
        const LAS unsigned char* bp = F.lds + S5_UT + fr * S5_UTP + (fq >> 1) * 32 + (fq & 1) * 16;
#pragma unroll
        for (int ks = 0; ks < 32; ++ks) { const bf16x8 B = *(const LAS bf16x8*)(bp + ks * 64);
            acc = __builtin_amdgcn_mfma_f32_16x16x32_bf16(Af[ks], B, acc, 0, 0, 0); }
        *(f32x4*)(XLOC + ((size_t)(jb * 16 + fr) * 64 + g) * 128 + F.wave * 16 + fq * 4) = acc;
        __syncthreads();
    }
}
__device__ __forceinline__ void phase_s5_out(const Frame& F0, int l) {
    Frame F = F0; F.tid = F.wave * 64 + lane_id(); asm volatile("" : "+v"(F.tid)); F.lane = F.tid & 63;
    unsigned char* ws = opqg(F.ws);
    const bf16* UB = (const bf16*)(ws + WS_UB); const bf16* E = (const bf16*)(ws + WS_E) + (size_t)l * 64 * 1024 * 128; const bf16* KMAT = (const bf16*)(ws + WS_KMAT) + (size_t)l * 64 * 65 * 256;
    const float* XS = (const float*)(ws + WS_XS); bf16* YB = (bf16*)(ws + WS_YB);
    const int fr = F.lane & 15, fq = F.lane >> 4;
    for (int unit = F.vcu; unit < 64 * 8; unit += F.G) {
        const int g = unit >> 3, jb = unit & 7;
        { const int cc = F.tid >> 5, p0 = (F.tid & 31) * 4;
          const f32x4 xv = *(const f32x4*)(XS + ((size_t)(jb * 16 + cc) * 64 + g) * 128 + p0);
          v4u km[5];
#pragma unroll
          for (int k = 0; k < 5; ++k) { const int pc = F.tid + 512 * k; km[k] = (pc < 65 * 32) ? *(const v4u*)(KMAT + (size_t)g * 65 * 256 + (size_t)pc * 8) : (v4u){0u, 0u, 0u, 0u}; }
          s5_load_ut(F, UB, g, jb);
          v2u w; w.x = cvt_pk_bf16(xv[0], xv[1]); w.y = cvt_pk_bf16(xv[2], xv[3]); *(LAS v2u*)(F.lds + S5_XST + cc * S5_XSP + p0 * 2) = w;
#pragma unroll
          for (int k = 0; k < 5; ++k) { const int pc = F.tid + 512 * k; const int idx = pc >> 5, n = (pc >> 1) & 15, half = pc & 1;
              if (pc < 65 * 32) *(LAS v4u*)(F.lds + S5_KM + idx * 512 + n * 32 + ((half ^ (n >> 3)) * 16)) = km[k]; } }
        __syncthreads();
        for (int ti = 0; ti < 8; ++ti) {
            const int tau = ti * 8 + F.wave;
            const bf16* ep = E + ((size_t)g * 1024 + tau * 16 + fr) * 128 + fq * 8;
            bf16x8 Ae[4];
#pragma unroll
            for (int ke = 0; ke < 4; ++ke) Ae[ke] = *(const bf16x8*)(ep + ke * 32);
            f32x4 acc = (f32x4){0.f, 0.f, 0.f, 0.f}, acc1 = (f32x4){0.f, 0.f, 0.f, 0.f};
            const LAS unsigned char* bp = F.lds + S5_UT + fr * S5_UTP + (fq >> 1) * 32 + (fq & 1) * 16;
            const LAS unsigned char* kp = F.lds + S5_KM + (tau - (fq >> 1) + 1) * 512 + fr * 32 + (((fq & 1) ^ (fr >> 3)) * 16);
            const int nks = (tau >> 1) + 1;
            int ks = 0;
            for (; ks + 4 <= nks; ks += 4) {
                const bf16x8 A0 = *(const LAS bf16x8*)(kp - ks * 1024), A1 = *(const LAS bf16x8*)(kp - (ks + 1) * 1024), A2 = *(const LAS bf16x8*)(kp - (ks + 2) * 1024), A3 = *(const LAS bf16x8*)(kp - (ks + 3) * 1024);
                const bf16x8 B0 = *(const LAS bf16x8*)(bp + ks * 64), B1 = *(const LAS bf16x8*)(bp + (ks + 1) * 64), B2 = *(const LAS bf16x8*)(bp + (ks + 2) * 64), B3 = *(const LAS bf16x8*)(bp + (ks + 3) * 64);
                acc = __builtin_amdgcn_mfma_f32_16x16x32_bf16(A0, B0, acc, 0, 0, 0); acc1 = __builtin_amdgcn_mfma_f32_16x16x32_bf16(A1, B1, acc1, 0, 0, 0);
                acc = __builtin_amdgcn_mfma_f32_16x16x32_bf16(A2, B2, acc, 0, 0, 0); acc1 = __builtin_amdgcn_mfma_f32_16x16x32_bf16(A3, B3, acc1, 0, 0, 0); }
            for (; ks < nks; ++ks) { const bf16x8 A = *(const LAS bf16x8*)(kp - ks * 1024); const bf16x8 B = *(const LAS bf16x8*)(bp + ks * 64);
                acc = __builtin_amdgcn_mfma_f32_16x16x32_bf16(A, B, acc, 0, 0, 0); }
            const LAS unsigned char* xp = F.lds + S5_XST + fr * S5_XSP + fq * 16;
#pragma unroll
            for (int ke = 0; ke < 4; ke += 2) { const bf16x8 B0 = *(const LAS bf16x8*)(xp + ke * 64), B1 = *(const LAS bf16x8*)(xp + (ke + 1) * 64);
                acc = __builtin_amdgcn_mfma_f32_16x16x32_bf16(Ae[ke], B0, acc, 0, 0, 0); acc1 = __builtin_amdgcn_mfma_f32_16x16x32_bf16(Ae[ke + 1], B1, acc1, 0, 0, 0); }
            acc += acc1;
            v2u w; w.x = cvt_pk_bf16(gelu_tanh(acc[0]), gelu_tanh(acc[1])); w.y = cvt_pk_bf16(gelu_tanh(acc[2]), gelu_tanh(acc[3]));
            *(v2u*)(YB + ((size_t)(jb * 16 + fr) * 64 + tau) * AW + g * 16 + fq * 4) = w;
        }
        __syncthreads();
    }
}

__device__ __forceinline__ void phase_ln(const Frame& F0, int l, int which) {
    Frame F = F0; F.tid = F.wave * 64 + lane_id(); asm volatile("" : "+v"(F.tid)); F.lane = F.tid & 63;
    unsigned char* ws = opqg(F.ws); const __attribute__((address_space(4))) Args* a = opq(F.ka);
    const bf16* RS = (const bf16*)(ws + WS_RH); bf16* XS = (bf16*)(ws + WS_XH);
    const bool last = (which == 1 && l == DEPTH - 1); float* OUT = GP(float, a->out);
    const float* gam = GP(const float, a->in[which == 0 ? I_LN1G : I_LN2G]) + (size_t)l * D; const float* bet = GP(const float, a->in[which == 0 ? I_LN1B : I_LN2B]) + (size_t)l * D;
    const int gw = F.vcu * 8 + F.wave, NGW = F.G * 8;
    const int j = F.lane & 3, rr = (F.lane >> 2) & 1, sl = F.lane >> 3;
    LAS float* gamL = (LAS float*)(F.lds); LAS float* betL = gamL + D;
    ((LAS f32x4*)gamL)[F.tid] = ((const f32x4*)gam)[F.tid]; ((LAS f32x4*)betL)[F.tid] = ((const f32x4*)bet)[F.tid];
    __syncthreads();
    for (int rp = gw; rp < T / 2; rp += NGW) {
        const int row = 2 * rp + rr;
        const size_t eo = ((size_t)sl * T + row) * 32 + j * 8;
        v4u w[8];
#pragma unroll
        for (int i = 0; i < 8; ++i) w[i] = *(const v4u*)(RS + eo + (size_t)i * 8 * T * 32);
        float v[64]; float s = 0.f;
#pragma unroll
        for (int i = 0; i < 8; ++i) { const unsigned ww[4] = {w[i].x, w[i].y, w[i].z, w[i].w};
#pragma unroll
            for (int k = 0; k < 4; ++k) { const h2_t hv = __builtin_bit_cast(h2_t, ww[k]); v[8 * i + 2 * k] = (float)hv.x; v[8 * i + 2 * k + 1] = (float)hv.y; s += (float)hv.x + (float)hv.y; } }
        s += __shfl_xor(s, 1); s += __shfl_xor(s, 2); s += __shfl_xor(s, 8); s += __shfl_xor(s, 16); s += __shfl_xor(s, 32);
        const float mean = s * (1.f / D); float s2 = 0.f;
#pragma unroll
        for (int i = 0; i < 64; ++i) { v[i] -= mean; s2 += v[i] * v[i]; }
        s2 += __shfl_xor(s2, 1); s2 += __shfl_xor(s2, 2); s2 += __shfl_xor(s2, 8); s2 += __shfl_xor(s2, 16); s2 += __shfl_xor(s2, 32);
        const float rstd = __builtin_amdgcn_rsqf(s2 * (1.f / D) + LN_EPS);
        float amax = 0.f; int slv = sl; asm volatile("" : "+v"(slv));
#pragma unroll
        for (int i = 0; i < 8; ++i) { const int e0 = (8 * i + slv) * 32 + j * 8;
            const f32x4 g0 = *(const LAS f32x4*)(gamL + e0), g1 = *(const LAS f32x4*)(gamL + e0 + 4), b0 = *(const LAS f32x4*)(betL + e0), b1 = *(const LAS f32x4*)(betL + e0 + 4);
            const f32x4 y0 = (f32x4){v[8 * i], v[8 * i + 1], v[8 * i + 2], v[8 * i + 3]} * rstd * g0 + b0, y1 = (f32x4){v[8 * i + 4], v[8 * i + 5], v[8 * i + 6], v[8 * i + 7]} * rstd * g1 + b1;
            if (last) { *(f32x4*)(OUT + (size_t)row * D + e0) = y0; *(f32x4*)(OUT + (size_t)row * D + e0 + 4) = y1; }
            else { v4u o; o.x = cvt_pk_f16(y0[0], y0[1]); o.y = cvt_pk_f16(y0[2], y0[3]); o.z = cvt_pk_f16(y1[0], y1[1]); o.w = cvt_pk_f16(y1[2], y1[3]); *(v4u*)(XS + eo + (size_t)i * 8 * T * 32) = o; }
            if (!last) {
#pragma unroll
                for (int k = 0; k < 4; ++k) { v[8 * i + k] = y0[k]; v[8 * i + 4 + k] = y1[k]; amax = fmaxf(amax, fmaxf(fabsf(y0[k]), fabsf(y1[k]))); } } }
        if (!last) {
            amax = fmaxf(amax, __shfl_xor(amax, 1)); amax = fmaxf(amax, __shfl_xor(amax, 2)); amax = fmaxf(amax, __shfl_xor(amax, 8)); amax = fmaxf(amax, __shfl_xor(amax, 16)); amax = fmaxf(amax, __shfl_xor(amax, 32));
            const float inv = (amax > 0.f) ? 127.f / amax : 0.f;
            if (j == 0 && sl == 0) ((float*)(ws + WS_SX))[row] = (amax > 0.f) ? amax * (1.f / 127.f) : 1.f;
            unsigned char* xq = ws + WS_XQ + (size_t)row * 64 + (sl & 1) * 32 + j * 8;
#pragma unroll
            for (int i = 0; i < 8; ++i) { int q[8];
#pragma unroll
                for (int k = 0; k < 8; ++k) q[k] = (int)__builtin_rintf(v[8 * i + k] * inv);
                v2u o; o.x = (unsigned)(q[0] & 255) | ((unsigned)(q[1] & 255) << 8) | ((unsigned)(q[2] & 255) << 16) | ((unsigned)q[3] << 24);
                o.y = (unsigned)(q[4] & 255) | ((unsigned)(q[5] & 255) << 8) | ((unsigned)(q[6] & 255) << 16) | ((unsigned)q[7] << 24);
                *(v2u*)(xq + (size_t)(4 * i + (sl >> 1)) * T * 64) = o; } }
    }
    __syncthreads();
}

constexpr int PK_TV = 0, PK_EID = 65536, PK_GATE = 81920;
__device__ __forceinline__ int f2key(float x) { const int b = __float_as_int(x); return b ^ ((b >> 31) & 0x7fffffff); }
__device__ __forceinline__ float key2f(int k) { return __int_as_float(k ^ ((k >> 31) & 0x7fffffff)); }
__device__ __forceinline__ int imed3(int a, int b, int c) { int r; asm("v_med3_i32 %0, %1, %2, %3" : "=v"(r) : "v"(a), "v"(b), "v"(c)); return r; }
#define INSK(kx) do { const int _x = (kx); _Pragma("unroll") for (int _k = 15; _k > 0; --_k) tk[_k] = imed3(tk[_k - 1], tk[_k], _x); tk[0] = max(tk[0], _x); } while (0)
__device__ __forceinline__ void phase_topk(const Frame& F0, int l) {
    Frame F = F0; F.tid = F.wave * 64 + lane_id(); asm volatile("" : "+v"(F.tid)); F.lane = F.tid & 63;
    unsigned char* ws = opqg(F.ws);
    const float* SC = (const float*)(ws + WS_SC); int* SEID = (int*)(ws + WS_SEID); float* SGATE = (float*)(ws + WS_SGATE); unsigned char* START = ws + WS_START;
    LAS int* TK = (LAS int*)(F.lds + PK_TV); LAS int* EIDL = (LAS int*)(F.lds + PK_EID); LAS float* GATEL = (LAS float*)(F.lds + PK_GATE);
    for (int tb = F.vcu; tb < T / 32; tb += F.G) {
        const int t0 = tb * 32;
        { const int tok = F.tid >> 4, hh = F.tid & 15;
          const v4u* sp = (const v4u*)((const bf16*)SC + (size_t)(t0 + tok) * 2048 + hh * 128);
          int tk[16];
#pragma unroll
          for (int k = 0; k < 16; ++k) tk[k] = (int)0x80000000;
#pragma unroll 1
          for (int i4 = 0; i4 < 16; i4 += 4) { v4u sa[4];
#pragma unroll
              for (int i = 0; i < 4; ++i) sa[i] = sp[i4 + i];
#pragma unroll
              for (int i = 0; i < 4; ++i) { const v4u s0 = sa[i]; const unsigned sw[4] = {s0.x, s0.y, s0.z, s0.w}; const int ib = 127 - 8 * (i4 + i);
#pragma unroll
                  for (int x = 0; x < 4; ++x) { INSK((f2key(bf_lo(sw[x])) & ~127) | (ib - 2 * x)); INSK((f2key(bf_hi(sw[x])) & ~127) | (ib - 2 * x - 1)); } } }
#pragma unroll
          for (int k = 0; k < 16; ++k) TK[F.tid * 16 + k] = tk[k]; }
        __syncthreads();
        if ((F.tid & 1) == 0) {
            float v1[16], v2[16];
#pragma unroll
            for (int k = 0; k < 16; ++k) { v1[k] = key2f(TK[F.tid * 16 + k] & ~127); v2[k] = key2f(TK[(F.tid + 1) * 16 + k] & ~127); }
            int tk[16];
#pragma unroll
            for (int k = 0; k < 16; ++k) tk[k] = (int)0x80000000;
#pragma unroll
            for (int aa = 0; aa < 16; ++aa)
#pragma unroll
                for (int bb = 0; bb < 16; ++bb) if ((aa + 1) * (bb + 1) <= 16) { INSK((f2key(v1[aa] + v2[bb]) & ~255) | (255 - (aa * 16 + bb))); }
            float ex[16], sum = 0.f; const float v0 = key2f(tk[0] & ~255);
#pragma unroll
            for (int k = 0; k < 16; ++k) { ex[k] = expf(key2f(tk[k] & ~255) - v0); sum += ex[k]; }
            const float inv = 1.f / sum;
            const int tok = F.tid >> 4, hd = (F.tid >> 1) & 7;
#pragma unroll
            for (int k = 0; k < 16; ++k) { const int code = 255 - (tk[k] & 255);
                const int i1 = 127 - (TK[F.tid * 16 + (code >> 4)] & 127), i2 = 127 - (TK[(F.tid + 1) * 16 + (code & 15)] & 127);
                EIDL[tok * 128 + hd * 16 + k] = (((i1 + i2) & 15) << 10) + i1 * 8 + (i2 >> 4); GATEL[tok * 128 + hd * 16 + k] = ex[k] * inv; }
        }
        __syncthreads();
        for (int ti = 0; ti < 4; ++ti) {
            const int tok = F.wave * 4 + ti;
            int k0 = (EIDL[tok * 128 + F.lane] << 7) | F.lane, k1 = (EIDL[tok * 128 + 64 + F.lane] << 7) | (64 + F.lane);
#pragma unroll
            for (int k = 2; k <= 128; k <<= 1)
#pragma unroll
                for (int j = k >> 1; j > 0; j >>= 1) {
                    if (j == 64) { const int mn = min(k0, k1), mx = max(k0, k1); k0 = mn; k1 = mx; }
                    else { const int o0 = __shfl_xor(k0, j), o1 = __shfl_xor(k1, j); const bool lower = (F.lane & j) == 0;
                        const bool up0 = (F.lane & k) == 0, up1 = ((64 + F.lane) & k) == 0;
                        k0 = (up0 == lower) ? min(k0, o0) : max(k0, o0); k1 = (up1 == lower) ? min(k1, o1) : max(k1, o1); }
                }
            const size_t t = (size_t)(t0 + tok);
            { const int r0 = k0 >> 17, r1 = k1 >> 17; int mine = 0;
#pragma unroll
              for (int r = 1; r < 16; ++r) { const int c = __builtin_popcountll(__ballot(r0 < r)) + __builtin_popcountll(__ballot(r1 < r)); mine = (F.lane == r) ? c : mine; }
              if (F.lane < 16) START[t * 16 + F.lane] = (unsigned char)mine; }
            SEID[t * LP + F.lane] = k0 >> 7; SEID[t * LP + 64 + F.lane] = k1 >> 7;
            SGATE[t * 128 + F.lane] = GATEL[tok * 128 + (k0 & 127)]; SGATE[t * 128 + 64 + F.lane] = GATEL[tok * 128 + (k1 & 127)];
        }
        __syncthreads();
    }
}
typedef __bf16 bf2_t __attribute__((ext_vector_type(2)));
__device__ __forceinline__ float dot2bf(unsigned a, unsigned b, float c) { return __builtin_amdgcn_fdot2_f32_bf16(__builtin_bit_cast(bf2_t, a), __builtin_bit_cast(bf2_t, b), c, false); }
__device__ __forceinline__ void peer_stage(const Frame& F, const bf16* gsrc, int bo) {
#pragma unroll
    for (int i = 0; i < 8; ++i) { const int p = i * 8 + F.wave;
        __builtin_amdgcn_global_load_lds((const unsigned*)((const char*)gsrc + p * 1024 + F.lane * 16), (LAS unsigned*)(F.lds + bo + p * 1024), 16, 0, 0); }
}
__device__ __forceinline__ void peer_dma(const Frame& F, const void* gsrc, int bo) {
    const unsigned ldsbase = (unsigned)(size_t)(F.lds + bo) + (unsigned)F.wave * 1024u;
#pragma unroll
    for (int i = 0; i < 8; ++i) { const char* g = (const char*)gsrc + (i * 8 + F.wave) * 1024 + F.lane * 16; const unsigned m = ldsbase + i * 8192u;
        asm volatile("s_mov_b32 m0, %0\n\ts_nop 0\n\tglobal_load_lds_dwordx4 %1, off" :: "s"(m), "v"((GAS const char*)g) : "memory"); }
}
__device__ __forceinline__ int wave_max_i(int v) {
#pragma unroll
    for (int o = 1; o < 64; o <<= 1) v = max(v, __shfl_xor(v, o));
    return __builtin_amdgcn_readfirstlane(v);
}
template <int K> __device__ __forceinline__ unsigned dppq(unsigned v) { return (unsigned)__builtin_amdgcn_mov_dpp((int)v, K * 0x55, 0xf, 0xf, true); }
__device__ __forceinline__ int sdot4(unsigned a, unsigned b, int c) { return __builtin_amdgcn_sdot4((int)a, (int)b, c, false); }
__device__ __forceinline__ int quad_sum_i(int v) {
    v += __builtin_amdgcn_mov_dpp(v, 0xB1, 0xf, 0xf, true);
    v += __builtin_amdgcn_mov_dpp(v, 0x4E, 0xf, 0xf, true);
    return v;
}
__device__ __forceinline__ float quad_sum(float v) {
    v += __int_as_float(__builtin_amdgcn_mov_dpp(__float_as_int(v), 0xB1, 0xf, 0xf, true));
    v += __int_as_float(__builtin_amdgcn_mov_dpp(__float_as_int(v), 0x4E, 0xf, 0xf, true));
    return v;
}
constexpr int UCAP0 = 24, UCAP1 = 12, UCAP2 = 12, UCAP3 = 8;
__device__ __forceinline__ void phase_peer_u(const Frame& F0, int l) {
    Frame F = F0; F.tid = F.wave * 64 + lane_id(); asm volatile("" : "+v"(F.tid)); F.lane = F.tid & 63;
    unsigned char* ws = opqg(F.ws);
    const bf16* TU = (const bf16*)(ws + WS_TBU) + (size_t)l * 32 * NEXP * 32;
    const int* SEID = (const int*)(ws + WS_SEID); const float* SGATE = (const float*)(ws + WS_SGATE); unsigned* PACK = (unsigned*)(ws + WS_PACK); unsigned char* START = ws + WS_START;
    const bf16* XBS = (const bf16*)(ws + WS_XQ); unsigned* PACK2 = (unsigned*)(ws + WS_PACK2);
    const float* SX = (const float*)(ws + WS_SX); const float* SU = (const float*)(ws + WS_SU) + (size_t)l * NEXP;
    const int qd = F.lane >> 2, jc = F.lane & 3;
    for (int unit = F.vcu; unit < 256; unit += F.G) {
        const int tt = unit & 15, er = unit >> 4; const size_t t = (size_t)tt * 512 + F.tid;
        const int lo = START[t * 16 + er], hi = (er < 15) ? (int)START[t * 16 + er + 1] : 128;
        const int cnt = hi - lo;
        int key = (cnt << 6) | (63 - F.lane);
#pragma unroll
        for (int k = 2; k <= 64; k <<= 1)
#pragma unroll
            for (int j = k >> 1; j > 0; j >>= 1) { const int o = __shfl_xor(key, j); const bool lower = (F.lane & j) == 0, up = (F.lane & k) == 0;
                key = (up == lower) ? max(key, o) : min(key, o); }
        int tl[4], glo[4], gcnt[4], gmax[4];
#pragma unroll
        for (int a = 0; a < 4; ++a) { const int kk = __shfl(key, a * 16 + qd); tl[a] = 63 - (kk & 63); gcnt[a] = kk >> 6; glo[a] = __shfl(lo, tl[a]);
            gmax[a] = __builtin_amdgcn_readfirstlane(__shfl(key, a * 16)) >> 6; }
        const size_t tbase = (size_t)tt * 512 + F.wave * 64;
        unsigned ro0[UCAP0 / 4], ro1[UCAP1 / 4], ro2[UCAP2 / 4], ro3[UCAP3 / 4];
#define LOADRO(arr, a, CAP) _Pragma("unroll") for (int i = 0; i < CAP / 4; ++i) { const int s = 4 * i + jc; const int e = SEID[(tbase + tl[a]) * LP + glo[a] + s]; \
            const int row = (s < gcnt[a]) ? (e & 1023) : 0; arr[i] = (unsigned)((row << 6) + (((row >> 2) & 3) << 4)); }
        LOADRO(ro0, 0, UCAP0) LOADRO(ro1, 1, UCAP1) LOADRO(ro2, 2, UCAP2) LOADRO(ro3, 3, UCAP3)
#undef LOADRO
        int ac0[UCAP0], ac1[UCAP1], ac2[UCAP2], ac3[UCAP3];
#pragma unroll
        for (int s = 0; s < UCAP0; ++s) ac0[s] = 0;
#pragma unroll
        for (int s = 0; s < UCAP1; ++s) ac1[s] = 0;
#pragma unroll
        for (int s = 0; s < UCAP2; ++s) ac2[s] = 0;
#pragma unroll
        for (int s = 0; s < UCAP3; ++s) ac3[s] = 0;
        const bf16* gsl0 = TU + (size_t)er * 1024 * 32;
#define XA(a) ((const v4u*)(XBS + (tbase + tl[a]) * 32) + jc)
        v4u xs[4];
#pragma unroll
        for (int a = 0; a < 4; ++a) xs[a] = XA(a)[0];
        peer_dma(F, gsl0, 0);
        VM_WAIT(); __syncthreads();
#pragma unroll 1
        for (int ks = 0; ks < 32; ++ks) {
            const int bo = (ks & 1) * 65536, jx = jc << 4;
            v4u xn[4];
            const int kn = (ks + 1 < 32) ? ks + 1 : ks;
#pragma unroll
            for (int a = 0; a < 4; ++a) xn[a] = XA(a)[(size_t)kn * T * 4];
            if (ks + 1 < 32) peer_dma(F, gsl0 + (size_t)kn * NEXP * 32, bo ^ 65536);
#define URD(B, arr, g) { asm volatile("" : "+v"(arr[g])); B[0] = *(const LAS v4u*)(F.lds + bo + (dppq<0>(arr[g]) ^ jx)); B[1] = *(const LAS v4u*)(F.lds + bo + (dppq<1>(arr[g]) ^ jx)); \
                B[2] = *(const LAS v4u*)(F.lds + bo + (dppq<2>(arr[g]) ^ jx)); B[3] = *(const LAS v4u*)(F.lds + bo + (dppq<3>(arr[g]) ^ jx)); }
#define UCP(B, acc, a, g) { _Pragma("unroll") for (int q = 0; q < 4; ++q) { int p0 = acc[4 * (g) + q]; \
                p0 = sdot4(B[q].x, xs[a].x, p0); p0 = sdot4(B[q].y, xs[a].y, p0); p0 = sdot4(B[q].z, xs[a].z, p0); p0 = sdot4(B[q].w, xs[a].w, p0); acc[4 * (g) + q] = p0; } }
            { v4u BE[4], BO[4];
              URD(BE, ro0, 0) __builtin_amdgcn_sched_barrier(0);
              URD(BO, ro0, 1) UCP(BE, ac0, 0, 0)
              __builtin_amdgcn_sched_barrier(0);
              URD(BE, ro0, 2) UCP(BO, ac0, 0, 1)
              __builtin_amdgcn_sched_barrier(0);
              URD(BO, ro0, 3) UCP(BE, ac0, 0, 2)
              __builtin_amdgcn_sched_barrier(0);
              URD(BE, ro0, 4) UCP(BO, ac0, 0, 3)
              __builtin_amdgcn_sched_barrier(0);
              URD(BO, ro0, 5) UCP(BE, ac0, 0, 4)
              __builtin_amdgcn_sched_barrier(0);
              URD(BE, ro1, 0) UCP(BO, ac0, 0, 5)
              __builtin_amdgcn_sched_barrier(0);
              URD(BO, ro1, 1) UCP(BE, ac1, 1, 0)
              __builtin_amdgcn_sched_barrier(0);
              URD(BE, ro1, 2) UCP(BO, ac1, 1, 1)
              __builtin_amdgcn_sched_barrier(0);
              URD(BO, ro2, 0) UCP(BE, ac1, 1, 2)
              __builtin_amdgcn_sched_barrier(0);
              URD(BE, ro2, 1) UCP(BO, ac2, 2, 0)
              __builtin_amdgcn_sched_barrier(0);
              URD(BO, ro2, 2) UCP(BE, ac2, 2, 1)
              __builtin_amdgcn_sched_barrier(0);
              URD(BE, ro3, 0) UCP(BO, ac2, 2, 2)
              __builtin_amdgcn_sched_barrier(0);
              URD(BO, ro3, 1) UCP(BE, ac3, 3, 0)
              __builtin_amdgcn_sched_barrier(0);
              UCP(BO, ac3, 3, 1) }
#undef URD
#undef UCP
#pragma unroll
            for (int a = 0; a < 4; ++a) xs[a] = xn[a];
            VM_WAIT(); __syncthreads();
        }
        float gt0[UCAP0 / 4], gt1[UCAP1 / 4], gt2[UCAP2 / 4], gt3[UCAP3 / 4];
        float sq0[UCAP0 / 4], sq1[UCAP1 / 4], sq2[UCAP2 / 4], sq3[UCAP3 / 4];
#define UGT(gt, sq, arr, a, CAP) { const float* gp_ = SGATE + (tbase + tl[a]) * 128; const float sx_ = SX[tbase + tl[a]]; _Pragma("unroll") for (int i = 0; i < CAP / 4; ++i) { gt[i] = gp_[min(glo[a] + 4 * i + jc, 127)]; sq[i] = sx_ * SU[er * 1024 + (int)(arr[i] >> 6)]; } }
        UGT(gt0, sq0, ro0, 0, UCAP0) UGT(gt1, sq1, ro1, 1, UCAP1) UGT(gt2, sq2, ro2, 2, UCAP2) UGT(gt3, sq3, ro3, 3, UCAP3)
#undef UGT
#define UOUT(arr, acc, gt, sq, a, CAP) { const size_t tk = tbase + tl[a]; _Pragma("unroll") for (int s = 0; s < CAP; ++s) { const int toti = quad_sum_i(acc[s]); \
            if ((s & 3) == jc && s < NSLOT) { unsigned wv = 0u; if (s < gcnt[a]) { const float av = gelu_tanh((float)toti * sq[s >> 2]) * gt[s >> 2]; wv = (arr[s >> 2] << 16) | (cvt_pk_f16(av, 0.f) & 0xffffu); } \
                PACK2[(tk * 16 + er) * NSLOT + s] = wv; } } \
            _Pragma("unroll") for (int s = CAP; s < NSLOT; ++s) if ((s & 3) == jc && s >= gcnt[a]) PACK2[(tk * 16 + er) * NSLOT + s] = 0u; }
        UOUT(ro0, ac0, gt0, sq0, 0, UCAP0) UOUT(ro1, ac1, gt1, sq1, 1, UCAP1) UOUT(ro2, ac2, gt2, sq2, 2, UCAP2) UOUT(ro3, ac3, gt3, sq3, 3, UCAP3)
#undef UOUT
#undef XA
        { int myrank = 0; const int mykey = (cnt << 6) | (63 - F.lane);
          for (int p = 0; p < 64; ++p) myrank += (__shfl(key, p) > mykey) ? 1 : 0;
          const int cap = myrank < 16 ? UCAP0 : (myrank < 32 ? UCAP1 : (myrank < 48 ? UCAP2 : UCAP3));
          const v4u* xsp = (const v4u*)(XBS + t * 32);
          for (int s = cap; s < cnt; ++s) {
              const int pos = lo + s, e = SEID[t * LP + pos]; const int f = (e >> 2) & 3; int di = 0;
              for (int ks = 0; ks < 32; ++ks)
#pragma unroll
                  for (int j = 0; j < 4; ++j) { const v4u u4 = *(const v4u*)(TU + (((size_t)ks * NEXP + e) * 4 + (j ^ f)) * 8); const v4u x4 = xsp[(size_t)ks * T * 4 + j];
                      di = sdot4(u4.x, x4.x, di); di = sdot4(u4.y, x4.y, di); di = sdot4(u4.z, x4.z, di); di = sdot4(u4.w, x4.w, di); }
              const float d = (float)di * SX[t] * SU[e];
              const int row = e & 1023;
              const unsigned wv = ((unsigned)((row << 6) + (((row >> 2) & 3) << 4)) << 16) | (cvt_pk_f16(gelu_tanh(d) * SGATE[t * 128 + pos], 0.f) & 0xffffu);
              if (s < NSLOT) PACK2[(t * 16 + er) * NSLOT + s] = wv; else PACK[t * LP + pos] = wv; }
        }
    }
}
#ifndef VBLK
#define VBLK 2
#endif
#if VBLK == 4
#define VTT(x, j) (4 * ((x) & 3) + ((j) & 3))
#define VDS(x, j, it) (32 * ((x) >> 2) + 8 * (it) + ((j) >> 2))
#elif VBLK == 8
#define VTT(x, j) (8 * ((x) & 1) + ((j) & 7))
#define VDS(x, j, it) (16 * ((x) >> 1) + 4 * (it) + ((j) >> 3))
#elif VBLK == 2
#define VTT(x, j) (2 * (x) + ((j) & 1))
#define VDS(x, j, it) (16 * (it) + ((j) >> 1))
#else
#define VTT(x, j) ((j) & 15)
#define VDS(x, j, it) (((x) * 32 + (j) + 256 * (it)) >> 4)
#endif
__device__ __forceinline__ void phase_peer_v(const Frame& F0, int l) {
    Frame F = F0; F.tid = F.wave * 64 + lane_id(); asm volatile("" : "+v"(F.tid)); F.lane = F.tid & 63;
    unsigned char* ws = opqg(F.ws);
    const bf16* TV = (const bf16*)(ws + WS_TBV) + (size_t)l * 64 * NEXP * 32; const bf16* XS = (const bf16*)(ws + WS_XH); bf16* RS = (bf16*)(ws + WS_RH);
    const unsigned* PACK = (const unsigned*)(ws + WS_PACK); const unsigned char* START = ws + WS_START; const unsigned* PACK2 = (const unsigned*)(ws + WS_PACK2);
    for (int it = 0; it * F.G + F.vcu < 1024; ++it) {
        int tt, ds;
        if (F.G == 256) { const int x = F.vcu >> 5, j = F.vcu & 31; tt = VTT(x, j); ds = VDS(x, j, it); }
        else { const int unit = it * F.G + F.vcu; tt = unit & 15; ds = unit >> 4; }
        const size_t t = (size_t)tt * 512 + F.tid;
        const v4u st4 = *(const v4u*)(START + t * 16);
        const unsigned stw[4] = {st4.x, st4.y, st4.z, st4.w};
        unsigned acc[16];
#pragma unroll
        for (int i = 0; i < 16; ++i) acc[i] = 0u;
        const bf16* gsl0 = TV + (size_t)ds * NEXP * 32;
        unsigned Lc[NSLOT];
        { const v4u* lp = (const v4u*)(PACK2 + t * 16 * NSLOT);
#pragma unroll
          for (int s = 0; s < NSLOT / 4; ++s) { const v4u q = lp[s]; Lc[4 * s] = q.x; Lc[4 * s + 1] = q.y; Lc[4 * s + 2] = q.z; Lc[4 * s + 3] = q.w; } }
        peer_dma(F, gsl0, 0);
        VM_WAIT(); __syncthreads();
#pragma unroll 1
        for (int c = 0; c < 16; ++c) {
            const int bo = (c & 1) * 65536;
            const int q0 = c >> 2, q1 = (c + 1) >> 2;
            const unsigned w0 = q0 == 0 ? stw[0] : (q0 == 1 ? stw[1] : (q0 == 2 ? stw[2] : stw[3])), w1 = q1 == 0 ? stw[0] : (q1 == 1 ? stw[1] : (q1 == 2 ? stw[2] : stw[3]));
            const int s_c = (int)((w0 >> ((c & 3) * 8)) & 255u);
            const int s_n = (c < 15) ? (int)((w1 >> (((c + 1) & 3) * 8)) & 255u) : 128;
            const int n_c = s_n - s_c;
            unsigned Ln[NSLOT];
            const int cn = (c < 15) ? c + 1 : c;
            { const v4u* lp = (const v4u*)(PACK2 + (t * 16 + cn) * NSLOT);
#pragma unroll
              for (int s = 0; s < NSLOT / 4; ++s) { const v4u q = lp[s]; Ln[4 * s] = q.x; Ln[4 * s + 1] = q.y; Ln[4 * s + 2] = q.z; Ln[4 * s + 3] = q.w; } }
            if (c < 15) peer_dma(F, gsl0 + (size_t)cn * 1024 * 32, bo ^ 65536);
            const int wmax = wave_max_i(min(n_c, NSLOT));
#pragma unroll
            for (int g = 0; g < NSLOT / 2; ++g) {
                if (2 * g < wmax) {
                    v4u v4[2][4]; unsigned a2[2];
#pragma unroll
                    for (int q = 0; q < 2; ++q) { const int s = 2 * g + q; const unsigned w = Lc[s];
                        a2[q] = __builtin_amdgcn_perm(w, w, 0x01000100u);
                        const int a0 = bo + (int)((w >> 16) & 0xfff0u);
#pragma unroll
                        for (int j = 0; j < 4; ++j) v4[q][j] = *(const LAS v4u*)(F.lds + (a0 ^ (j << 4))); }
#pragma unroll
                    for (int q = 0; q < 2; ++q)
#pragma unroll
                        for (int j = 0; j < 4; ++j) {
                            acc[4 * j + 0] = pkfmah(v4[q][j].x, a2[q], acc[4 * j + 0]); acc[4 * j + 1] = pkfmah(v4[q][j].y, a2[q], acc[4 * j + 1]);
                            acc[4 * j + 2] = pkfmah(v4[q][j].z, a2[q], acc[4 * j + 2]); acc[4 * j + 3] = pkfmah(v4[q][j].w, a2[q], acc[4 * j + 3]); }
                }
            }
            for (int s = NSLOT; s < n_c; ++s) {
                const unsigned w = PACK[t * LP + s_c + s]; const unsigned a2 = (w & 0xffffu) | (w << 16);
                const int a0 = bo + (int)((w >> 16) & 0xfff0u);
#pragma unroll
                for (int j = 0; j < 4; ++j) { const v4u v4 = *(const LAS v4u*)(F.lds + (a0 ^ (j << 4)));
                    acc[4 * j + 0] = pkfmah(v4.x, a2, acc[4 * j + 0]); acc[4 * j + 1] = pkfmah(v4.y, a2, acc[4 * j + 1]);
                    acc[4 * j + 2] = pkfmah(v4.z, a2, acc[4 * j + 2]); acc[4 * j + 3] = pkfmah(v4.w, a2, acc[4 * j + 3]); }
            }
            VM_WAIT(); __syncthreads();
#pragma unroll
            for (int s = 0; s < NSLOT; ++s) Lc[s] = Ln[s];
        }
        const v4u* xp = (const v4u*)(XS + ((size_t)ds * T + t) * 32); v4u* rp = (v4u*)(RS + ((size_t)ds * T + t) * 32);
        v4u xw4[4];
#pragma unroll
        for (int j = 0; j < 4; ++j) xw4[j] = xp[j];
#pragma unroll
        for (int j = 0; j < 4; ++j) { const v4u xw = xw4[j]; const unsigned xx[4] = {xw.x, xw.y, xw.z, xw.w}; unsigned o[4];
#pragma unroll
            for (int k = 0; k < 4; ++k) { const h2_t xv = __builtin_bit_cast(h2_t, xx[k]), yv = __builtin_bit_cast(h2_t, acc[4 * j + k]);
                o[k] = cvt_pk_f16((float)xv.x * ALPHA + (float)yv.x, (float)xv.y * ALPHA + (float)yv.y); }
            rp[j] = (v4u){o[0], o[1], o[2], o[3]}; }
    }
}

constexpr int PH_PER_LAYER = 13, N_PHASES = 2 + DEPTH * PH_PER_LAYER;
__global__ void __launch_bounds__(512, 2) fwd_kernel(Args args) {
    extern __shared__ __attribute__((aligned(16))) unsigned char lds[];
    Frame F;
    F.lds = (LAS unsigned char*)lds;
    F.wave = __builtin_amdgcn_readfirstlane((int)threadIdx.x >> 6); F.tid = 0; F.lane = 0;
    F.G = gridDim.x; { const int bx = blockIdx.x; F.vcu = (F.G % 8 == 0) ? (bx % 8) * (F.G / 8) + bx / 8 : bx; }
    F.ws = args.ws; F.ka = (const __attribute__((address_space(4))) Args*)__builtin_amdgcn_kernarg_segment_ptr();
    unsigned char* ws = args.ws;
    for (int u = F.wave * 64 + lane_id(); u < (LDS_BYTES - LDSCTL_OFF) / 4; u += 512) ((LAS unsigned*)(F.lds + LDSCTL_OFF))[u] = 0u;
    __syncthreads();
    XcdBarrier bar; bar.bar = (unsigned*)(ws + WS_CTL) + CW_BAR; bar.x = 0; bar.st = nullptr;
    const int lo = args.ph_lo, hi = args.ph_hi;
    if (hi - lo > 1) bar = xcd_barrier_post((unsigned*)(ws + WS_CTL) + CW_BAR, (volatile LAS unsigned*)(F.lds + MISC_OFF) + 8, F.wave == 0 && lane_id() == 0);
#ifndef PHMASK
#define PHMASK 0xFFF
#endif
#define EN(i) ((PHMASK >> (i)) & 1)
#ifndef RPT
#define RPT 0
#endif
#define REP(i) for (int _r = 0; _r <= ((RPT >> (i)) & 1); ++_r)
#define IN(k) (lo <= (k) && (k) < hi)
#define SEAM(k) do { if (IN((k) + 1)) xcd_barrier(bar, F.wave); } while (0)

    if (EN(10) && IN(0)) { REP(13) { phase_prologue_a(F); } SEAM(0); }
    if (EN(11) && IN(1)) REP(14) {
        phase_prologue_b(F);
        unsigned char* ws = opqg(args.ws);
        quant_rows(F, (const bf16*)(ws + WS_WIN), 4096, NIN, 5120, ws + WS_WG8, (float*)(ws + WS_SWG));
        int kc = 256; asm volatile("" : "+s"(kc));
        pg8::Gemm g{(const bf16*)(ws + WS_BK), (const bf16*)(ws + WS_WQB), DEPTH * 2048, 2048, kc, 256, 2048, 256, (long)2048 * 2048};
        pg8::StaticOrder S; S.init(DEPTH * 2048, 2048, F.G, (int)blockIdx.x);
        pg8::EpiF16 E{(bf16*)(ws + WS_WPQ), 2048};
        pg8::gemm_phase<pg8::EpiF16, pg8::StaticOrder, true>(F.lds, g, S, E, F.wave);
        if (_r == ((RPT >> 14) & 1)) SEAM(1);
    }
    for (int l = 0; l < DEPTH; ++l) {
        const int pb = 2 + l * PH_PER_LAYER;
        if (EN(0) && IN(pb + 0)) REP(0) {
            unsigned char* ws = opqg(args.ws);
            pg8::Gemm g{(const bf16*)(ws + WS_XH), (const bf16*)(ws + WS_WIN) + (size_t)l * NIN * D, T, NIN, D, T, D, 0, 0};
            pg8::EpiIn E{(bf16*)(ws + WS_Q), (bf16*)(ws + WS_KK), (bf16*)(ws + WS_V), (bf16*)(ws + WS_SG), (bf16*)(ws + WS_UB), (bf16*)(ws + WS_GR), (bf16*)(ws + WS_GB),
                         (float*)(ws + WS_LOGF), (const float*)(ws + WS_LB) + l * AW};
            if (F.G == 256) {
                const int x = (int)blockIdx.x & 7, j = (int)blockIdx.x >> 3;
                pg8::ListOrder Sf{j < 16 ? 3 * j : 48 + 2 * (j - 16), j < 16 ? 3 : 2, x, 0};
                pg8::gemm_phase<pg8::EpiIn, pg8::ListOrder, true, true, true>(F.lds, g, Sf, E, F.wave);
                pg8::Gemm g8{(const bf16*)(ws + WS_XQ), (const bf16*)(ws + WS_WG8) + ((size_t)l * 4096 - 20 * 256) * 1024, T, NIN, 1024, T, 1024, 0, 0};
                pg8::ListOrder Si{j < 16 ? j : 16 + 3 * (j - 16), j < 16 ? 1 : 3, x, 20};
                pg8::EpiGate8 E8{(bf16*)(ws + WS_GR), (bf16*)(ws + WS_GB), (const float*)(ws + WS_SX), (const float*)(ws + WS_SWG) + l * 4096};
                pg8::gemm_phase<pg8::EpiGate8, pg8::ListOrder, true, false, true, true>(F.lds, g8, Si, E8, F.wave);
            } else {
                pg8::StaticOrder S; S.init(T, NIN, F.G, (int)blockIdx.x);
                pg8::gemm_phase<pg8::EpiIn, pg8::StaticOrder, true, true, true>(F.lds, g, S, E, F.wave);
            }
            if (_r == ((RPT >> 0) & 1)) SEAM(pb + 0);
        }
        if (EN(1) && IN(pb + 1)) { REP(1) { REP(17) { phase_hgrn_local(F, l); } REP(18) { phase_s5_local(F, l); } } if (l == 0) { unsigned char* ws = opqg(args.ws); quant_rows(F, (const bf16*)(ws + WS_WPQ), 2048, 2048, 0, ws + WS_WP8, (float*)(ws + WS_SW)); } SEAM(pb + 1); }
        if (EN(2) && IN(pb + 2)) { REP(2) { phase_scan(F, l); } SEAM(pb + 2); }
        if (EN(3) && IN(pb + 3)) { REP(3) { REP(15) { phase_hgrn_out(F, l); } REP(16) { phase_s5_out(F, l); } } SEAM(pb + 3); }
        if (EN(4) && IN(pb + 4)) REP(4) {
            unsigned char* ws = opqg(args.ws);
            pg8::Gemm g{(const bf16*)(ws + WS_YB), (const bf16*)(ws + WS_WGLU) + (size_t)l * 2048 * 1024, T, 2048, 1024, 1024, 1024, 0, 0};
            pg8::EpiGlu E{(bf16*)(ws + WS_OAB) + 1024, 2048};
            pg8::StaticOrder S; S.init(T, 2048, F.G, (int)blockIdx.x);
            pg8::gemm_phase<pg8::EpiGlu, pg8::StaticOrder, true>(F.lds, g, S, E, F.wave);
            if (_r == ((RPT >> 4) & 1)) SEAM(pb + 4);
        }
        if (EN(5) && IN(pb + 5)) REP(5) {
            unsigned char* ws = opqg(args.ws);
            pg8::Gemm g{(const bf16*)(ws + WS_OAB), (const bf16*)(ws + WS_WUP) + (size_t)l * 2048 * 2048, T, 2048, 2048, 2048, 2048, 0, 0};
            pg8::StaticOrder S; S.init(T, 2048, F.G, (int)blockIdx.x);
            pg8::EpiUp E{(bf16*)(ws + WS_MG), (const bf16*)(ws + WS_GR), (const bf16*)(ws + WS_GB)};
            pg8::gemm_phase<pg8::EpiUp, pg8::StaticOrder, true>(F.lds, g, S, E, F.wave);
            if (_r == ((RPT >> 5) & 1)) SEAM(pb + 5);
        }
        if (EN(6) && IN(pb + 6)) REP(6) {
            unsigned char* ws = opqg(args.ws);
            pg8::Gemm g{(const bf16*)(ws + WS_MG), (const bf16*)(ws + WS_WO) + (size_t)l * 2048 * 2048, T, 2048, 2048, 2048, 2048, 0, 0};
            pg8::StaticOrder S; S.init(T, 2048, F.G, (int)blockIdx.x);
            pg8::EpiResH E{(bf16*)(ws + WS_RH), (const bf16*)(ws + WS_XH)};
            pg8::gemm_phase<pg8::EpiResH, pg8::StaticOrder, true>(F.lds, g, S, E, F.wave);
            if (_r == ((RPT >> 6) & 1)) SEAM(pb + 6);
        }
        if (EN(7) && IN(pb + 7)) { REP(7) { phase_ln(F, l, 0); } SEAM(pb + 7); }
        if (EN(8) && IN(pb + 8)) REP(8) {
            unsigned char* ws = opqg(args.ws);
            pg8::Gemm g{(const bf16*)(ws + WS_XQ), (const bf16*)(ws + WS_WP8) + (size_t)l * 2048 * 1024, T, 2048, 1024, T, 1024, 0, 0};
            pg8::StaticOrder S; S.init(T, 2048, F.G, (int)blockIdx.x);
            pg8::EpiSc8 E{(bf16*)(ws + WS_SC), (const float*)(ws + WS_SX), (const float*)(ws + WS_SW) + l * 2048};
            pg8::gemm_phase<pg8::EpiSc8, pg8::StaticOrder, true, false, true, true>(F.lds, g, S, E, F.wave);
            if (_r == ((RPT >> 8) & 1)) SEAM(pb + 8);
        }
        if (EN(9) && IN(pb + 9)) { REP(9) { phase_topk(F, l); } SEAM(pb + 9); }
        if (EN(9) && IN(pb + 10)) { REP(10) { phase_peer_u(F, l); } SEAM(pb + 10); }
        if (EN(9) && IN(pb + 11)) { REP(11) { phase_peer_v(F, l); } SEAM(pb + 11); }
        if (EN(9) && IN(pb + 12)) { REP(12) { phase_ln(F, l, 1); } SEAM(pb + 12); }
    }
#undef IN
#undef SEAM
}

extern "C" void kernel_launch(void* const* d_in, const int* in_sizes, int n_in, void* d_out, int out_size, void* d_ws, size_t ws_size, hipStream_t stream) {
    static int grid = 0;
    if (grid == 0) {
        if (n_in != 24 || out_size != T * D || ws_size < WS_END) { fprintf(stderr, "kernel_launch: unexpected sizes (n_in %d out %d ws %zu need %zu)\n", n_in, out_size, ws_size, (size_t)WS_END); grid = -1; return; }
        int dev = 0, cus = 0, per_cu = 0;
        if (hipGetDevice(&dev) != hipSuccess || hipDeviceGetAttribute(&cus, hipDeviceAttributeMultiprocessorCount, dev) != hipSuccess) { grid = -1; return; }
        if (hipFuncSetAttribute((const void*)fwd_kernel, hipFuncAttributeMaxDynamicSharedMemorySize, LDS_BYTES) != hipSuccess) { fprintf(stderr, "kernel_launch: hipFuncSetAttribute failed\n"); grid = -1; return; }
        if (hipOccupancyMaxActiveBlocksPerMultiprocessor(&per_cu, (const void*)fwd_kernel, 512, LDS_BYTES) != hipSuccess || per_cu < 1)
            fprintf(stderr, "kernel_launch: occupancy query reports %d\n", per_cu);
        (void)hipGetLastError();
        grid = cus;
    }
    if (grid < 0) return;
    if (hipMemsetAsync((char*)d_ws + WS_CTL, 0, CTL_ZERO_BYTES, stream) != hipSuccess) return;
    Args a{};
    for (int i = 0; i < 24; ++i) a.in[i] = (const float*)d_in[i];
    a.out = (float*)d_out; a.ws = (unsigned char*)d_ws;
#if ONE_LAUNCH
    a.ph_lo = 0; a.ph_hi = N_PHASES;
    hipLaunchKernelGGL(fwd_kernel, dim3(grid), dim3(512), LDS_BYTES, stream, a);
#else
    for (int p = 0; p < N_PHASES; ++p) { a.ph_lo = p; a.ph_hi = p + 1; hipLaunchKernelGGL(fwd_kernel, dim3(grid), dim3(512), LDS_BYTES, stream, a); }
#endif
}
```

```cpp
#include <hip/hip_runtime.h>
#include <cstdio>
#include <cstdint>

#define LAS __attribute__((address_space(3)))
#define GAS __attribute__((address_space(1)))
typedef unsigned short bf16;
typedef unsigned v4u __attribute__((ext_vector_type(4)));
typedef unsigned v2u __attribute__((ext_vector_type(2)));
typedef float f32x4 __attribute__((ext_vector_type(4)));
typedef float f32x2 __attribute__((ext_vector_type(2)));
typedef short bf16x8 __attribute__((ext_vector_type(8)));
typedef short s16x4 __attribute__((ext_vector_type(4)));

#ifndef ONE_LAUNCH
#define ONE_LAUNCH 1
#endif

constexpr int T = 8192, D = 2048, DEPTH = 4, NIN = 9216;
constexpr int AW = 1024;
constexpr int NCH = 128;
constexpr float ALPHA = 1.6817928305074290f;
constexpr float LN_EPS = 1e-5f, RMS_EPS = 1e-6f;
constexpr int NEXP = 16384;
constexpr int LP = 160;
constexpr int NSLOT = 24;

constexpr size_t MiB = 1u << 20;
constexpr size_t WS_CTL = 0, CTL_ZERO_BYTES = 32768;
constexpr size_t WS_WIN  = 1 * MiB;
constexpr size_t WS_WGLU = WS_WIN + 144 * MiB;
constexpr size_t WS_WUP  = WS_WGLU + 16 * MiB;
constexpr size_t WS_WO   = WS_WUP + 32 * MiB;
constexpr size_t WS_WQB  = WS_WO + 32 * MiB;
constexpr size_t WS_BK   = WS_WQB + 32 * MiB;
constexpr size_t WS_WPQ  = WS_BK + 4 * MiB;
constexpr size_t WS_LB   = WS_WPQ + 32 * MiB;
constexpr size_t WS_APOW = WS_LB + 1 * MiB;
constexpr size_t WS_BB   = WS_APOW + 9 * MiB;
constexpr size_t WS_KMAT = WS_BB + 2 * MiB;
constexpr size_t WS_PM   = WS_KMAT + 9 * MiB;
constexpr size_t WS_E    = WS_PM + 64 * MiB;
constexpr size_t WS_X32  = WS_E + 64 * MiB;
constexpr size_t WS_X1   = WS_X32 + 64 * MiB;
constexpr size_t WS_XB   = WS_X1 + 64 * MiB;
constexpr size_t WS_Q    = WS_XB + 32 * MiB;
constexpr size_t WS_KK   = WS_Q + 16 * MiB;
constexpr size_t WS_V    = WS_KK + 16 * MiB;
constexpr size_t WS_SG   = WS_V + 16 * MiB;
constexpr size_t WS_UB   = WS_SG + 16 * MiB;
constexpr size_t WS_LOGF = WS_UB + 16 * MiB;
constexpr size_t WS_GR   = WS_LOGF + 32 * MiB;
constexpr size_t WS_GB   = WS_GR + 32 * MiB;
constexpr size_t WS_U    = WS_GB + 32 * MiB;
constexpr size_t WS_SP   = WS_U + 64 * MiB;
constexpr size_t WS_BL   = WS_SP + 32 * MiB;
constexpr size_t WS_XLOC = WS_BL + 1 * MiB;
constexpr size_t WS_XS   = WS_XLOC + 4 * MiB;
constexpr size_t WS_OAB  = WS_XS + 4 * MiB;
constexpr size_t WS_YB   = WS_OAB + 32 * MiB;
constexpr size_t WS_MG   = WS_YB + 16 * MiB;
constexpr size_t WS_R    = WS_MG + 32 * MiB;
constexpr size_t WS_SC   = WS_R + 64 * MiB;
constexpr size_t WS_TBU  = WS_SC + 64 * MiB;
constexpr size_t WS_TBV  = WS_TBU + 256 * MiB;
constexpr size_t WS_SEID = WS_TBV + 256 * MiB;
constexpr size_t WS_SGATE= WS_SEID + 6 * MiB;
constexpr size_t WS_PACK = WS_SGATE + 4 * MiB;
constexpr size_t WS_START= WS_PACK + 6 * MiB;
constexpr size_t WS_PACK2= WS_START + 1 * MiB;
constexpr size_t WS_XBS  = WS_PACK2 + 13 * MiB;
constexpr size_t WS_END  = WS_XBS + 32 * MiB;
constexpr size_t WS_XH = WS_XBS;
constexpr size_t WS_XQ = WS_X1;
constexpr size_t WS_SX = WS_X1 + 16 * MiB;
constexpr size_t WS_SU = WS_X1 + 17 * MiB;
constexpr size_t WS_SW = WS_X1 + 18 * MiB;
constexpr size_t WS_WP8 = WS_WQB;
constexpr size_t WS_WG8 = WS_X32;
constexpr size_t WS_SWG = WS_X1 + 19 * MiB;
constexpr size_t WS_RH = WS_R;

constexpr int CW_TMO = 0, CW_CODE = 1;
constexpr int CW_BAR = 4096;

constexpr int RING_BYTES = 131072;
constexpr int LDSCTL_OFF = RING_BYTES, MISC_OFF = LDSCTL_OFF + 320;
constexpr int LDS_BYTES = 147456;

#define LDS_WAIT() asm volatile("s_waitcnt lgkmcnt(0)" ::: "memory")
#define VM_WAIT() asm volatile("s_waitcnt vmcnt(0)" ::: "memory")
__device__ __forceinline__ unsigned cvt_pk_bf16(float lo, float hi) { unsigned r; asm volatile("v_cvt_pk_bf16_f32 %0, %1, %2" : "=v"(r) : "v"(lo), "v"(hi)); return r; }
typedef _Float16 h2_t __attribute__((ext_vector_type(2)));
__device__ __forceinline__ unsigned cvt_pk_f16a(float lo, float hi) { unsigned r; asm volatile("v_cvt_pk_f16_f32 %0, %1, %2" : "=v"(r) : "v"(lo), "v"(hi)); return r; }
__device__ __forceinline__ unsigned cvt_pk_f16(float lo, float hi) { h2_t p; p.x = (_Float16)lo; p.y = (_Float16)hi; return __builtin_bit_cast(unsigned, p); }
__device__ __forceinline__ float dot2h(unsigned a, unsigned b, float c) { return __builtin_amdgcn_fdot2(__builtin_bit_cast(h2_t, a), __builtin_bit_cast(h2_t, b), c, false); }
__device__ __forceinline__ unsigned pkfmab(unsigned a, unsigned w, unsigned c) { const h2_t wv = __builtin_bit_cast(h2_t, w); const h2_t b = {wv.x, wv.x};
    return __builtin_bit_cast(unsigned, __builtin_elementwise_fma(__builtin_bit_cast(h2_t, a), b, __builtin_bit_cast(h2_t, c))); }
__device__ __forceinline__ unsigned pkfmah(unsigned a, unsigned b, unsigned c) { return __builtin_bit_cast(unsigned, __builtin_elementwise_fma(__builtin_bit_cast(h2_t, a), __builtin_bit_cast(h2_t, b), __builtin_bit_cast(h2_t, c))); }
__device__ __forceinline__ float bf_lo(unsigned u) { return __uint_as_float(u << 16); }
__device__ __forceinline__ float bf_hi(unsigned u) { return __uint_as_float(u & 0xffff0000u); }
__device__ __forceinline__ float bf2f(bf16 b) { return __uint_as_float(((unsigned)b) << 16); }
__device__ __forceinline__ bf16 f2bf(float f) { return (bf16)(cvt_pk_bf16(f, 0.f) & 0xffffu); }
__device__ __forceinline__ float fexp(float x) { return __builtin_amdgcn_exp2f(x * 1.4426950408889634f); }
__device__ __forceinline__ float flog(float x) { return __builtin_amdgcn_logf(x) * 0.6931471805599453f; }
__device__ __forceinline__ float frcp(float x) { return __builtin_amdgcn_rcpf(x); }
__device__ __forceinline__ float gelu_tanh(float x) {
    const float u = 1.5957691216057308f * (x + 0.044715f * x * x * x);
    const float uc = fminf(fmaxf(u, -60.f), 60.f);
    return x * frcp(1.f + fexp(-uc));
}
__device__ __forceinline__ int lane_id() { int r; asm volatile("v_mbcnt_lo_u32_b32 %0, -1, 0\n\tv_mbcnt_hi_u32_b32 %0, -1, %0" : "=v"(r)); return r; }
__device__ __forceinline__ float wave_sum(float v) {
#pragma unroll
    for (int o = 1; o < 64; o <<= 1) v += __shfl_xor(v, o);
    return v;
}

__device__ __forceinline__ void vlaunder(int& a, int& b) { asm volatile("" : "+v"(a), "+v"(b)); }
template <class P> __device__ __forceinline__ P* opq(P* p) { asm volatile("" : "+s"(p)); return p; }
__device__ __forceinline__ unsigned char* opqg(unsigned char* p) { GAS unsigned char* g = (GAS unsigned char*)p; asm volatile("" : "+s"(g)); return (unsigned char*)g; }
#define GP(T, p) ((T*)(GAS T*)(p))

namespace pg8 {
#define PG8_LAS __attribute__((address_space(3)))
typedef unsigned short bf16_t;
constexpr int BM = 256, BK = 64, HALF = 128, HTB = HALF * BK * 2, STAGE_BYTES = 8 * HTB, NXCD = 8, WGM = 8;

__host__ __device__ __forceinline__ int lds_byte(int r, int c) { const int st = (r >> 4) * 2 + (c >> 5), rr = r & 15, cc = c & 31, ob = rr * 64 + cc * 2; return st * 1024 + (ob ^ (((ob >> 9) & 1) << 5)); }
__host__ __device__ __forceinline__ void stage_rc(int b, int& R, int& C) { const int st = b / 1024, sb = b % 1024, swz = sb ^ (((sb >> 9) & 1) << 5); R = (st >> 1) * 16 + swz / 64; C = (st & 1) * 32 + (swz % 64) / 2; }
__host__ __device__ __forceinline__ int perm32(int rho) { const int n = rho >> 4, i = rho & 15; return 8 * (i >> 2) + 4 * n + (i & 3); }

struct Unit { int pm, pn; };
struct Gemm { const bf16_t* A; const bf16_t* Bt; int M, N, K, lda, ldb, bkoff; long blstride; };

struct StaticOrder {
    int nM, nN, nwg, G, c;
    __host__ __device__ void init(int M, int N, int G_, int c_) { nM = M / BM; nN = N / BM; nwg = nM * nN; G = G_; c = c_; }
    __host__ __device__ bool next(int i, Unit& u) const {
        const long L = (long)i * G + c; if (L >= nwg) return false;
        int wgid = (int)L; { const int q = nwg / NXCD, r = nwg % NXCD, xcd = wgid % NXCD, off = wgid / NXCD; wgid = (xcd < r ? xcd * (q + 1) : r * (q + 1) + (xcd - r) * q) + off; }
        const int nig = WGM * nN, gid = wgid / nig, fm = gid * WGM, gsz = (nM - fm) < WGM ? (nM - fm) : WGM;
        u.pm = fm + ((wgid % nig) % gsz); u.pn = (wgid % nig) / gsz; return true;
    }
    __device__ __forceinline__ void a_ready(const Unit&) const {}
    __device__ __forceinline__ void done(const Unit&) const {}
};

struct OffOrder {
    StaticOrder b; int pn0;
    __device__ void init(int M, int N, int G_, int c_, int pn0_) { b.init(M, N, G_, c_); pn0 = pn0_; }
    __device__ bool next(int i, Unit& u) const { if (!b.next(i, u)) return false; u.pn += pn0; return true; }
    __device__ __forceinline__ void a_ready(const Unit&) const {}
    __device__ __forceinline__ void done(const Unit&) const {}
};
struct ListOrder {
    int base, cnt, x, pn0;
    __device__ bool next(int i, Unit& u) const { if (i >= cnt) return false; const int id = base + i; u.pm = 4 * x + (id & 3); u.pn = pn0 + (id >> 2); return true; }
    __device__ __forceinline__ void a_ready(const Unit&) const {}
    __device__ __forceinline__ void done(const Unit&) const {}
};
struct PairOrder {
    int c, c0, nN, nwg;
    __device__ bool next(int i, Unit& u) const { if (c < c0 || i >= 2) return false; const int id = (c - c0) * 2 + i; if (id >= nwg) return false; u.pm = id / nN; u.pn = id % nN; return true; }
    __device__ __forceinline__ void a_ready(const Unit&) const {}
    __device__ __forceinline__ void done(const Unit&) const {}
};
typedef f32x4 Acc[2][2][4][2];

typedef _Float16 f16x8 __attribute__((ext_vector_type(8)));
typedef int i32x4 __attribute__((ext_vector_type(4)));
template <class Epi, class Sched, bool ALIGN_EPI = false, bool F16 = false, bool ASL = false, bool I8 = false>
__device__ __forceinline__ void gemm_phase(PG8_LAS unsigned char* lds, const Gemm g, const Sched& S, const Epi& E, int wv) {
    int tid_ = wv * 64 + lane_id(); asm volatile("" : "+v"(tid_));
    const int tid = tid_, wid = __builtin_amdgcn_readfirstlane(tid >> 6), lane = tid & 63, wr = wid >> 2, wc = wid & 3, fr = lane & 15, fq = lane >> 4;
    const int K = g.K, nt = K / BK;
    unsigned voffA[2], voffB[2];
#pragma unroll
    for (int i = 0; i < 2; ++i) { int R, C; stage_rc(tid * 16 + i * 8192, R, C); const int Rb = Epi::PERM ? ((R & ~31) + perm32(R & 31)) : R;
        voffA[i] = ASL ? (unsigned)(((C >> 5) * g.lda + R) * 64 + (C & 31) * 2) : (unsigned)(R * g.lda + C) * 2u; voffB[i] = (unsigned)(Rb * g.ldb + C) * 2u; }
    const size_t kstep = (size_t)(BK * 2), kstepA = ASL ? (size_t)g.lda * 128 : (size_t)(BK * 2);
    const size_t hstepA = ASL ? (size_t)HALF * 64 : (size_t)HALF * g.lda * 2, hstepB = (size_t)HALF * g.ldb * 2;
    const size_t tstepA = 2 * hstepA, tstepB = 2 * hstepB;
    const unsigned ldsw = (unsigned)wid * 1024u;
    const int aoff = lds_byte(wr * 64 + fr, fq * 8), boff = lds_byte(wc * 32 + fr, fq * 8);
#define PG8_SA(b, h) (((b) * 2 + (h)) * HTB)
#define PG8_SB(b, h) ((4 + (b) * 2 + (h)) * HTB)
#define PG8_STAGE(bufoff, gbase, voff) do { _Pragma("unroll") for (int _i = 0; _i < 2; ++_i) \
        __builtin_amdgcn_global_load_lds((const unsigned*)((const char*)(gbase) + (voff)[_i]), (PG8_LAS unsigned*)(lds + (bufoff) + ldsw + _i * 8192), 16, 0, 0); } while (0)
#define PG8_LDA(dst, b, h) do { _Pragma("unroll") for (int m = 0; m < 4; ++m) _Pragma("unroll") for (int k = 0; k < 2; ++k) dst[m][k] = *(const PG8_LAS bf16x8*)(lds + PG8_SA(b, h) + aoff + m * 2048 + k * 1024); } while (0)
#define PG8_LDB(dst, b, h) do { _Pragma("unroll") for (int n = 0; n < 2; ++n) _Pragma("unroll") for (int k = 0; k < 2; ++k) dst[n][k] = *(const PG8_LAS bf16x8*)(lds + PG8_SB(b, h) + boff + n * 2048 + k * 1024); } while (0)
#define PG8_MMA(ai, bj, At, Bt) do { __builtin_amdgcn_s_setprio(1); _Pragma("unroll") for (int m = 0; m < 4; ++m) _Pragma("unroll") for (int n = 0; n < 2; ++n) _Pragma("unroll") for (int k = 0; k < 2; ++k) \
        { if constexpr (I8) acc[ai][bj][m][n] = __builtin_bit_cast(f32x4, __builtin_amdgcn_mfma_i32_16x16x64_i8(__builtin_bit_cast(i32x4, Bt[n][k]), __builtin_bit_cast(i32x4, At[m][k]), __builtin_bit_cast(i32x4, acc[ai][bj][m][n]), 0, 0, 0)); \
          else if constexpr (F16) acc[ai][bj][m][n] = __builtin_amdgcn_mfma_f32_16x16x32_f16(__builtin_bit_cast(f16x8, Bt[n][k]), __builtin_bit_cast(f16x8, At[m][k]), acc[ai][bj][m][n], 0, 0, 0); \
          else acc[ai][bj][m][n] = __builtin_amdgcn_mfma_f32_16x16x32_bf16(Bt[n][k], At[m][k], acc[ai][bj][m][n], 0, 0, 0); } __builtin_amdgcn_s_setprio(0); } while (0)
#define PG8_WAIT_V(n) asm volatile("s_waitcnt vmcnt(" #n ")" ::: "memory")
#define PG8_WAIT_L(n) asm volatile("s_waitcnt lgkmcnt(" #n ")" ::: "memory")
#define PG8_BAR __builtin_amdgcn_s_barrier()
#define PG8_SCHED __builtin_amdgcn_sched_barrier(0)
    Unit cur, nxt; int ui = 0;
    if (!S.next(0, cur)) return;
    Acc acc;
#pragma unroll
    for (int a = 0; a < 2; ++a)
#pragma unroll
        for (int b = 0; b < 2; ++b)
#pragma unroll
            for (int m = 0; m < 4; ++m)
#pragma unroll
                for (int n = 0; n < 2; ++n) acc[a][b][m][n] = (f32x4){0.f, 0.f, 0.f, 0.f};
    bf16x8 At[4][2], B0[2][2], B1[2][2];
    const char* cA = (const char*)g.A + (size_t)cur.pm * tstepA;
    const char* cB = (const char*)g.Bt + (size_t)cur.pn * tstepB + ((size_t)(cur.pm & 7) * g.bkoff + (size_t)(cur.pm >> 3) * g.blstride) * 2;
    S.a_ready(cur);
    PG8_STAGE(PG8_SB(0, 0), cB, voffB); PG8_STAGE(PG8_SB(0, 1), cB + hstepB, voffB); PG8_STAGE(PG8_SA(0, 0), cA, voffA); PG8_STAGE(PG8_SA(0, 1), cA + hstepA, voffA);
    if (wr == 1) PG8_BAR;
    PG8_WAIT_V(2); PG8_BAR;
    PG8_STAGE(PG8_SB(1, 0), cB + kstep, voffB); PG8_STAGE(PG8_SA(1, 0), cA + kstepA, voffA); PG8_STAGE(PG8_SB(1, 1), cB + hstepB + kstep, voffB);
    PG8_WAIT_V(6); PG8_BAR;
    for (;;) {
        const bool has_next = S.next(ui + 1, nxt);
        const char* nA = has_next ? (const char*)g.A + (size_t)nxt.pm * tstepA : cA;
        const char* nB = has_next ? (const char*)g.Bt + (size_t)nxt.pn * tstepB + ((size_t)(nxt.pm & 7) * g.bkoff + (size_t)(nxt.pm >> 3) * g.blstride) * 2 : cB;
        for (int t = 0; t < nt; t += 2) {
            const bool last = (t == nt - 2);
            const char* a1 = cA + (size_t)(t + 1) * kstepA;
            const char* a2 = last ? nA : cA + (size_t)(t + 2) * kstepA; const char* b2 = last ? nB : cB + (size_t)(t + 2) * kstep;
            const char* a3 = a2 + kstepA; const char* b3 = b2 + kstep;
            if (last && has_next) S.a_ready(nxt);
            PG8_LDB(B0, 0, 0); PG8_LDB(B1, 0, 1); PG8_SCHED; PG8_LDA(At, 0, 0); PG8_STAGE(PG8_SA(1, 1), a1 + hstepA, voffA);
            PG8_WAIT_V(8); PG8_WAIT_L(0); PG8_BAR; PG8_MMA(0, 0, At, B0); PG8_MMA(0, 1, At, B1); PG8_BAR; PG8_SCHED;
            PG8_LDA(At, 0, 1); PG8_STAGE(PG8_SB(0, 0), b2, voffB); PG8_STAGE(PG8_SB(0, 1), b2 + hstepB, voffB); PG8_STAGE(PG8_SA(0, 0), a2, voffA);
            PG8_WAIT_V(8); PG8_WAIT_L(0); PG8_BAR; PG8_MMA(1, 0, At, B0); PG8_MMA(1, 1, At, B1); PG8_BAR; PG8_SCHED;
            PG8_LDB(B0, 1, 0); PG8_LDB(B1, 1, 1); PG8_SCHED; PG8_LDA(At, 1, 0); PG8_STAGE(PG8_SA(0, 1), a2 + hstepA, voffA);
            PG8_WAIT_V(8); PG8_WAIT_L(0); PG8_BAR; PG8_MMA(0, 0, At, B0); PG8_MMA(0, 1, At, B1); PG8_BAR; PG8_SCHED;
            PG8_LDA(At, 1, 1); PG8_STAGE(PG8_SB(1, 0), b3, voffB); PG8_STAGE(PG8_SB(1, 1), b3 + hstepB, voffB); PG8_STAGE(PG8_SA(1, 0), a3, voffA);
            PG8_WAIT_V(8); PG8_WAIT_L(0); PG8_BAR; PG8_MMA(1, 0, At, B0); PG8_MMA(1, 1, At, B1); PG8_BAR; PG8_SCHED;
            if constexpr (Epi::HAS_MID) { if (t + 2 == (nt >> 1)) E.mid(acc, cur, wr, wc, fr, fq); }
        }
        if constexpr (ALIGN_EPI) { if (wr == 0) PG8_BAR; }
        E(acc, cur, wr, wc, fr, fq); S.done(cur);
        if (!has_next) break;
#pragma unroll
        for (int a = 0; a < 2; ++a)
#pragma unroll
            for (int b = 0; b < 2; ++b)
#pragma unroll
                for (int m = 0; m < 4; ++m)
#pragma unroll
                    for (int n = 0; n < 2; ++n) acc[a][b][m][n] = (f32x4){0.f, 0.f, 0.f, 0.f};
        cur = nxt; cA = nA; cB = nB; ++ui;
        if constexpr (ALIGN_EPI) { if (wr == 1) PG8_BAR; }
    }
    PG8_WAIT_V(0);
    if constexpr (!ALIGN_EPI) { if (wr == 0) PG8_BAR; }
    PG8_BAR;
#undef PG8_SA
#undef PG8_SB
#undef PG8_STAGE
#undef PG8_LDA
#undef PG8_LDB
#undef PG8_MMA
#undef PG8_WAIT_V
#undef PG8_WAIT_L
#undef PG8_BAR
#undef PG8_SCHED
}

struct EpiResH {
    static constexpr bool PERM = true, HAS_MID = false;
    bf16_t* RS; const bf16_t* XS;
    __device__ __forceinline__ void operator()(const Acc& acc, const Unit& u, int wr, int wc, int fr, int fq) const {
        vlaunder(fr, fq);
        const int row0 = u.pm * BM + wr * 64 + fr, sl0 = u.pn * 8 + wc;
#pragma unroll
        for (int ai = 0; ai < 2; ++ai) {
            v4u xw[4][2];
#pragma unroll
            for (int m = 0; m < 4; ++m)
#pragma unroll
                for (int bj = 0; bj < 2; ++bj) xw[m][bj] = *(const v4u*)(XS + ((size_t)(sl0 + bj * 4) * T + (row0 + ai * HALF + m * 16)) * 32 + 8 * fq);
#pragma unroll
            for (int m = 0; m < 4; ++m) {
#pragma unroll
                for (int bj = 0; bj < 2; ++bj) { const size_t eo = ((size_t)(sl0 + bj * 4) * T + (row0 + ai * HALF + m * 16)) * 32 + 8 * fq;
                    const f32x4 v0 = acc[ai][bj][m][0], v1 = acc[ai][bj][m][1];
                    const unsigned a0 = xw[m][bj].x, a1 = xw[m][bj].y, a2 = xw[m][bj].z, a3 = xw[m][bj].w;
                    const h2_t x0 = __builtin_bit_cast(h2_t, a0), x1 = __builtin_bit_cast(h2_t, a1), x2 = __builtin_bit_cast(h2_t, a2), x3 = __builtin_bit_cast(h2_t, a3);
                    v4u w; w.x = cvt_pk_f16a(v0[0] + ALPHA * (float)x0.x, v0[1] + ALPHA * (float)x0.y); w.y = cvt_pk_f16a(v0[2] + ALPHA * (float)x1.x, v0[3] + ALPHA * (float)x1.y);
                    w.z = cvt_pk_f16a(v1[0] + ALPHA * (float)x2.x, v1[1] + ALPHA * (float)x2.y); w.w = cvt_pk_f16a(v1[2] + ALPHA * (float)x3.x, v1[3] + ALPHA * (float)x3.y);
                    *(v4u*)(RS + eo) = w; } }
        }
    }
};
struct EpiF16 {
    static constexpr bool PERM = true, HAS_MID = false;
    bf16_t* O; int ldc;
    __device__ __forceinline__ void operator()(const Acc& acc, const Unit& u, int wr, int wc, int fr, int fq) const {
        vlaunder(fr, fq);
        const int row0 = u.pm * BM + wr * 64 + fr, col0 = u.pn * BM + wc * 32 + 8 * fq;
#pragma unroll
        for (int ai = 0; ai < 2; ++ai)
#pragma unroll
            for (int m = 0; m < 4; ++m) { bf16_t* rowp = O + (size_t)(row0 + ai * HALF + m * 16) * ldc + col0;
#pragma unroll
                for (int bj = 0; bj < 2; ++bj) { const f32x4 v0 = acc[ai][bj][m][0], v1 = acc[ai][bj][m][1];
                    v4u w; w.x = cvt_pk_f16a(v0[0], v0[1]); w.y = cvt_pk_f16a(v0[2], v0[3]); w.z = cvt_pk_f16a(v1[0], v1[1]); w.w = cvt_pk_f16a(v1[2], v1[3]);
                    *(v4u*)(rowp + bj * HALF) = w; } }
    }
};
struct EpiGate8 {
    static constexpr bool PERM = true, HAS_MID = false;
    bf16_t *GR, *GB; const float* SXp; const float* SWp;
    __device__ __forceinline__ void operator()(const Acc& acc, const Unit& u, int wr, int wc, int fr, int fq) const {
        vlaunder(fr, fq);
        const int row0 = u.pm * BM + wr * 64 + fr, tl = u.pn - 20;
        const int col0 = tl * 128 + wc * 32 + 8 * fq, w0 = tl * 256 + wc * 32 + 8 * fq;
        f32x4 sw[2][2]; float sx[2][4];
#pragma unroll
        for (int bj = 0; bj < 2; ++bj) { sw[bj][0] = *(const f32x4*)(SWp + w0 + bj * HALF); sw[bj][1] = *(const f32x4*)(SWp + w0 + bj * HALF + 4); }
#pragma unroll
        for (int ai = 0; ai < 2; ++ai)
#pragma unroll
            for (int m = 0; m < 4; ++m) sx[ai][m] = SXp[row0 + ai * HALF + m * 16];
#pragma unroll
        for (int ai = 0; ai < 2; ++ai)
#pragma unroll
            for (int m = 0; m < 4; ++m) { const size_t ro = (size_t)(row0 + ai * HALF + m * 16) * 2048 + col0;
                float rr[8], gg[8];
#pragma unroll
                for (int n = 0; n < 2; ++n) { const i32x4 ia = __builtin_bit_cast(i32x4, acc[ai][0][m][n]), ib = __builtin_bit_cast(i32x4, acc[ai][1][m][n]);
#pragma unroll
                    for (int x = 0; x < 4; ++x) { const float za = fminf(fmaxf((float)ia[x] * sx[ai][m] * sw[0][n][x], -30.f), 30.f), zb = fminf(fmaxf((float)ib[x] * sx[ai][m] * sw[1][n][x], -30.f), 30.f);
                        const float ea = fexp(-za), eb = fexp(-zb); gg[n * 4 + x] = frcp(1.f + eb); rr[n * 4 + x] = (1.f + eb) * frcp(1.f + ea); } }
                v4u w; w.x = cvt_pk_bf16(rr[0], rr[1]); w.y = cvt_pk_bf16(rr[2], rr[3]); w.z = cvt_pk_bf16(rr[4], rr[5]); w.w = cvt_pk_bf16(rr[6], rr[7]);
                *(v4u*)(GR + ro) = w;
                w.x = cvt_pk_bf16(gg[0], gg[1]); w.y = cvt_pk_bf16(gg[2], gg[3]); w.z = cvt_pk_bf16(gg[4], gg[5]); w.w = cvt_pk_bf16(gg[6], gg[7]);
                *(v4u*)(GB + ro) = w; }
    }
};
struct EpiSc8 {
    static constexpr bool PERM = true, HAS_MID = false;
    bf16_t* O; const float* SXp; const float* SWp;
    __device__ __forceinline__ void operator()(const Acc& acc, const Unit& u, int wr, int wc, int fr, int fq) const {
        vlaunder(fr, fq);
        const int row0 = u.pm * BM + wr * 64 + fr, col0 = u.pn * BM + wc * 32 + 8 * fq;
        f32x4 sw[2][2]; float sx[2][4];
#pragma unroll
        for (int bj = 0; bj < 2; ++bj) { sw[bj][0] = *(const f32x4*)(SWp + col0 + bj * HALF); sw[bj][1] = *(const f32x4*)(SWp + col0 + bj * HALF + 4); }
#pragma unroll
        for (int ai = 0; ai < 2; ++ai)
#pragma unroll
            for (int m = 0; m < 4; ++m) sx[ai][m] = SXp[row0 + ai * HALF + m * 16];
#pragma unroll
        for (int ai = 0; ai < 2; ++ai)
#pragma unroll
            for (int m = 0; m < 4; ++m) { bf16_t* rowp = O + (size_t)(row0 + ai * HALF + m * 16) * 2048 + col0;
#pragma unroll
                for (int bj = 0; bj < 2; ++bj) { const i32x4 i0 = __builtin_bit_cast(i32x4, acc[ai][bj][m][0]), i1 = __builtin_bit_cast(i32x4, acc[ai][bj][m][1]);
                    const f32x4 v0 = (f32x4){(float)i0[0], (float)i0[1], (float)i0[2], (float)i0[3]} * sx[ai][m] * sw[bj][0], v1 = (f32x4){(float)i1[0], (float)i1[1], (float)i1[2], (float)i1[3]} * sx[ai][m] * sw[bj][1];
                    v4u w; w.x = cvt_pk_bf16(v0[0], v0[1]); w.y = cvt_pk_bf16(v0[2], v0[3]); w.z = cvt_pk_bf16(v1[0], v1[1]); w.w = cvt_pk_bf16(v1[2], v1[3]);
                    *(v4u*)(rowp + bj * HALF) = w; } }
    }
};
struct EpiBf16 {
    static constexpr bool PERM = true, HAS_MID = false;
    bf16_t* O; int ldc;
    __device__ __forceinline__ void operator()(const Acc& acc, const Unit& u, int wr, int wc, int fr, int fq) const {
        vlaunder(fr, fq);
        const int row0 = u.pm * BM + wr * 64 + fr, col0 = u.pn * BM + wc * 32 + 8 * fq;
#pragma unroll
        for (int ai = 0; ai < 2; ++ai)
#pragma unroll
            for (int m = 0; m < 4; ++m) { bf16_t* rowp = O + (size_t)(row0 + ai * HALF + m * 16) * ldc + col0;
#pragma unroll
                for (int bj = 0; bj < 2; ++bj) { const f32x4 v0 = acc[ai][bj][m][0], v1 = acc[ai][bj][m][1];
                    v4u w; w.x = cvt_pk_bf16(v0[0], v0[1]); w.y = cvt_pk_bf16(v0[2], v0[3]); w.z = cvt_pk_bf16(v1[0], v1[1]); w.w = cvt_pk_bf16(v1[2], v1[3]);
                    *(v4u*)(rowp + bj * HALF) = w; } }
    }
};
struct EpiIn {
    static constexpr bool PERM = true, HAS_MID = false;
    bf16_t *Q, *KK, *V, *SG, *UB, *GR, *GB; float* LOGF; const float* lb;
    __device__ __forceinline__ void operator()(const Acc& acc, const Unit& u, int wr, int wc, int fr, int fq) const {
        vlaunder(fr, fq);
        const int row0 = u.pm * BM + wr * 64 + fr;
        const int pn = u.pn;
        if (pn >= 20) {
            const int col0 = (pn - 20) * 128 + wc * 32 + 8 * fq;
#pragma unroll
            for (int ai = 0; ai < 2; ++ai)
#pragma unroll
                for (int m = 0; m < 4; ++m) { const size_t ro = (size_t)(row0 + ai * HALF + m * 16) * 2048 + col0;
                    float rr[8], gg[8];
#pragma unroll
                    for (int n = 0; n < 2; ++n)
#pragma unroll
                        for (int x = 0; x < 4; ++x) { const float za = fminf(fmaxf(acc[ai][0][m][n][x], -30.f), 30.f), zb = fminf(fmaxf(acc[ai][1][m][n][x], -30.f), 30.f);
                            const float ea = fexp(-za), eb = fexp(-zb); gg[n * 4 + x] = frcp(1.f + eb); rr[n * 4 + x] = (1.f + eb) * frcp(1.f + ea); }
                    v4u w; w.x = cvt_pk_bf16(rr[0], rr[1]); w.y = cvt_pk_bf16(rr[2], rr[3]); w.z = cvt_pk_bf16(rr[4], rr[5]); w.w = cvt_pk_bf16(rr[6], rr[7]);
                    *(v4u*)(GR + ro) = w;
                    w.x = cvt_pk_bf16(gg[0], gg[1]); w.y = cvt_pk_bf16(gg[2], gg[3]); w.z = cvt_pk_bf16(gg[4], gg[5]); w.w = cvt_pk_bf16(gg[6], gg[7]);
                    *(v4u*)(GB + ro) = w; }
            return;
        }
        const int sec = pn >> 2, col0 = (pn & 3) * 256 + wc * 32 + 8 * fq;
        if (sec == 1) {
#pragma unroll
            for (int bj = 0; bj < 2; ++bj) {
                const f32x4 l0 = *(const f32x4*)(lb + col0 + bj * HALF), l1 = *(const f32x4*)(lb + col0 + bj * HALF + 4);
#pragma unroll
                for (int ai = 0; ai < 2; ++ai)
#pragma unroll
                    for (int m = 0; m < 4; ++m) { const size_t ro = (size_t)(row0 + ai * HALF + m * 16) * 1024 + col0 + bj * HALF;
                        float lf[8], kk[8];
#pragma unroll
                        for (int n = 0; n < 2; ++n)
#pragma unroll
                            for (int x = 0; x < 4; ++x) { const float z = fminf(fmaxf(acc[ai][bj][m][n][x], -30.f), 30.f); const float lbv = n ? l1[x] : l0[x];
                                const float e = fexp(-z), s = frcp(1.f + e); const float f = lbv + (1.f - lbv) * s;
                                lf[n * 4 + x] = flog(f); kk[n * 4 + x] = (1.f - lbv) * (e * s); }
                        *(f32x4*)(LOGF + ro) = (f32x4){lf[0], lf[1], lf[2], lf[3]}; *(f32x4*)(LOGF + ro + 4) = (f32x4){lf[4], lf[5], lf[6], lf[7]};
                        v4u w; w.x = cvt_pk_bf16(kk[0], kk[1]); w.y = cvt_pk_bf16(kk[2], kk[3]); w.z = cvt_pk_bf16(kk[4], kk[5]); w.w = cvt_pk_bf16(kk[6], kk[7]);
                        *(v4u*)(KK + ro) = w; }
            }
            return;
        }
        bf16_t* dst = sec == 0 ? Q : (sec == 2 ? V : (sec == 3 ? SG : UB));
        const bool sig = (sec == 3);
#pragma unroll
        for (int ai = 0; ai < 2; ++ai)
#pragma unroll
            for (int m = 0; m < 4; ++m) { bf16_t* rowp = dst + (size_t)(row0 + ai * HALF + m * 16) * 1024 + col0;
#pragma unroll
                for (int bj = 0; bj < 2; ++bj) { f32x4 v0 = acc[ai][bj][m][0], v1 = acc[ai][bj][m][1];
                    if (sig) {
#pragma unroll
                        for (int x = 0; x < 4; ++x) { v0[x] = frcp(1.f + fexp(-fminf(fmaxf(v0[x], -30.f), 30.f))); v1[x] = frcp(1.f + fexp(-fminf(fmaxf(v1[x], -30.f), 30.f))); } }
                    v4u w; w.x = cvt_pk_bf16(v0[0], v0[1]); w.y = cvt_pk_bf16(v0[2], v0[3]); w.z = cvt_pk_bf16(v1[0], v1[1]); w.w = cvt_pk_bf16(v1[2], v1[3]);
                    *(v4u*)(rowp + bj * HALF) = w; } }
    }
};
struct EpiGlu {
    static constexpr bool PERM = true, HAS_MID = false;
    bf16_t* O; int ldc;
    __device__ __forceinline__ void operator()(const Acc& acc, const Unit& u, int wr, int wc, int fr, int fq) const {
        vlaunder(fr, fq);
        const int row0 = u.pm * BM + wr * 64 + fr, col0 = u.pn * 128 + wc * 32 + 8 * fq;
#pragma unroll
        for (int ai = 0; ai < 2; ++ai)
#pragma unroll
            for (int m = 0; m < 4; ++m) { float o[8];
#pragma unroll
                for (int n = 0; n < 2; ++n)
#pragma unroll
                    for (int x = 0; x < 4; ++x) { const float h2 = fminf(fmaxf(acc[ai][1][m][n][x], -30.f), 30.f); o[n * 4 + x] = acc[ai][0][m][n][x] * frcp(1.f + fexp(-h2)); }
                v4u w; w.x = cvt_pk_bf16(o[0], o[1]); w.y = cvt_pk_bf16(o[2], o[3]); w.z = cvt_pk_bf16(o[4], o[5]); w.w = cvt_pk_bf16(o[6], o[7]);
                *(v4u*)(O + (size_t)(row0 + ai * HALF + m * 16) * ldc + col0) = w; }
    }
};
struct EpiUp {
    static constexpr bool PERM = true, HAS_MID = true;
    bf16_t* O; const bf16_t *GR, *GB;
    __device__ __forceinline__ void scale(Acc& acc, const bf16_t* G, const Unit& u, int wr, int wc, int fr, int fq) const {
        vlaunder(fr, fq);
        const int row0 = u.pm * BM + wr * 64 + fr, col0 = u.pn * BM + wc * 32 + 8 * fq;
#pragma unroll
        for (int ai = 0; ai < 2; ++ai) {
            v4u gw[4][2];
#pragma unroll
            for (int m = 0; m < 4; ++m)
#pragma unroll
                for (int bj = 0; bj < 2; ++bj) gw[m][bj] = *(const v4u*)(G + (size_t)(row0 + ai * HALF + m * 16) * 2048 + col0 + bj * HALF);
            __builtin_amdgcn_sched_barrier(0);
#pragma unroll
            for (int m = 0; m < 4; ++m) {
#pragma unroll
                for (int bj = 0; bj < 2; ++bj) { const v4u w = gw[m][bj];
                    acc[ai][bj][m][0] *= (f32x4){bf_lo(w.x), bf_hi(w.x), bf_lo(w.y), bf_hi(w.y)};
                    acc[ai][bj][m][1] *= (f32x4){bf_lo(w.z), bf_hi(w.z), bf_lo(w.w), bf_hi(w.w)}; } }
            __builtin_amdgcn_sched_barrier(0); }
    }
    __device__ __forceinline__ void mid(Acc& acc, const Unit& u, int wr, int wc, int fr, int fq) const { scale(acc, GR, u, wr, wc, fr, fq); }
    __device__ __forceinline__ void operator()(Acc& acc, const Unit& u, int wr, int wc, int fr, int fq) const {
        scale(acc, GB, u, wr, wc, fr, fq);
        const int row0 = u.pm * BM + wr * 64 + fr, col0 = u.pn * BM + wc * 32 + 8 * fq;
#pragma unroll
        for (int ai = 0; ai < 2; ++ai)
#pragma unroll
            for (int m = 0; m < 4; ++m) { bf16_t* rowp = O + (size_t)(row0 + ai * HALF + m * 16) * 2048 + col0;
#pragma unroll
                for (int bj = 0; bj < 2; ++bj) { const f32x4 v0 = acc[ai][bj][m][0], v1 = acc[ai][bj][m][1];
                    v4u w; w.x = cvt_pk_bf16(v0[0], v0[1]); w.y = cvt_pk_bf16(v0[2], v0[3]); w.z = cvt_pk_bf16(v1[0], v1[1]); w.w = cvt_pk_bf16(v1[2], v1[3]);
                    *(v4u*)(rowp + bj * HALF) = w; } }
    }
};
}

#define XB_TMO      128
#define XB_XCNT(j)  (256  + 64 * (j))
#define XB_XSUB(j)  (1280 + 64 * (j))
#define XB_XGEN(j)  (2304 + 64 * (j))
#define XB_TOP      3328
#define XB_TOPGEN   3392
#define XCD_BAR_WORDS 3456
#define XB_SPIN_CAP (1u << 20)

__device__ __forceinline__ unsigned xb_ld(unsigned* p)              { return __hip_atomic_load(p, __ATOMIC_RELAXED, __HIP_MEMORY_SCOPE_AGENT); }
__device__ __forceinline__ unsigned xb_add(unsigned* p, unsigned v) { return __hip_atomic_fetch_add(p, v, __ATOMIC_RELAXED, __HIP_MEMORY_SCOPE_AGENT); }
__device__ __forceinline__ unsigned xb_xcc_id() { return (unsigned)__builtin_amdgcn_s_getreg((3 << 11) | 20) & 0xFu; }
#define XB_SPIN(cond, bar) do { unsigned _sp = 0; while (cond) { __builtin_amdgcn_s_sleep(1); \
    if ((++_sp & 255u) == 0u) { if (xb_ld(&(bar)[XB_TMO])) break; if (_sp > XB_SPIN_CAP) { atomicAdd(&(bar)[XB_TMO], 1u); break; } } } } while (0)

struct XcdBarrier { unsigned* bar; unsigned x; volatile LAS unsigned* st; };

__device__ __forceinline__ XcdBarrier xcd_barrier_post(unsigned* bar, volatile LAS unsigned* st, bool leader) {
    XcdBarrier b; b.bar = bar; b.x = xb_xcc_id(); b.st = st;
    if (leader) (void)xb_add(&bar[XB_XCNT(b.x)], 1u);
    return b;
}
__device__ __forceinline__ void xcd_barrier_complete(unsigned* bar, unsigned x, unsigned& nloc, unsigned& nx) {
    const unsigned G = gridDim.x * gridDim.y * gridDim.z;
    unsigned sum, cnt, mine, sp = 0u;
    for (;;) {
        sum = 0u; cnt = 0u; mine = 0u;
#pragma unroll
        for (unsigned j = 0; j < 16; ++j) { const unsigned c = xb_ld(&bar[XB_XCNT(j)]); sum += c; cnt += (c > 0u) ? 1u : 0u; mine = (j == x) ? c : mine; }
        if (sum == G) break;
        __builtin_amdgcn_s_sleep(1);
        if ((++sp & 255u) == 0u) { if (xb_ld(&bar[XB_TMO])) break; if (sp > XB_SPIN_CAP) { atomicAdd(&bar[XB_TMO], 1u); break; } }
    }
    nloc = mine > 0u ? mine : 1u; nx = cnt > 0u ? cnt : 1u;
}
__device__ __forceinline__ void xcd_barrier(const XcdBarrier& b, int wv) {
    asm volatile("s_waitcnt vmcnt(0)" ::: "memory");
    __syncthreads();
    if (wv == 0 && lane_id() == 0) {
        unsigned* bar = b.bar;
        __builtin_amdgcn_s_waitcnt(0);
        unsigned nloc = b.st[0], nx = b.st[1];
        if (nloc == 0u) { xcd_barrier_complete(bar, b.x, nloc, nx); b.st[0] = nloc; b.st[1] = nx; }
        const unsigned old = xb_add(&bar[XB_XSUB(b.x)], 1u);
        const unsigned gen = old / nloc;
        if (old + 1u == (gen + 1u) * nloc) {
            __builtin_amdgcn_fence(__ATOMIC_RELEASE, "agent");
            asm volatile("s_waitcnt vmcnt(0)" ::: "memory");
            const unsigned og = xb_add(&bar[XB_TOP], 1u);
            const unsigned tg = og / nx;
            if (og + 1u == (tg + 1u) * nx) xb_add(&bar[XB_TOPGEN], 1u);
            else XB_SPIN(xb_ld(&bar[XB_TOPGEN]) == tg, bar);
            __builtin_amdgcn_fence(__ATOMIC_ACQUIRE, "agent");
            xb_add(&bar[XB_XGEN(b.x)], 1u);
            asm volatile("s_waitcnt vmcnt(0)" ::: "memory");
        } else {
            XB_SPIN(xb_ld(&bar[XB_XGEN(b.x)]) == gen, bar);
            __builtin_amdgcn_fence(__ATOMIC_ACQUIRE, "agent");
            asm volatile("s_waitcnt vmcnt(0)" ::: "memory");
        }
    }
    __syncthreads();
}

struct Args { const float* in[24]; float* out; unsigned char* ws; int ph_lo, ph_hi; };
struct Frame {
    LAS unsigned char* lds;
    int tid, lane, wave, vcu, G;
    unsigned char* ws;
    const __attribute__((address_space(4))) Args* ka;
};
enum { I_X = 0, I_WIN, I_LBL, I_NG, I_LRE, I_LIM, I_LSTEP, I_BRE, I_BIM, I_CRE, I_CIM, I_SD, I_WGLU, I_WUPA, I_WUPB, I_WO, I_LN1G, I_LN1B, I_PWQ, I_PKEYS, I_PU, I_PV, I_LN2G, I_LN2B };

__device__ __forceinline__ void p0_transpose_item(const float* W, int N, bf16* WT, int dpitch, int dst_koff, int dst_row0, LAS float* scr, int k0, int n0, int lane, bool h = false) {
    { const int kr = lane >> 3, c4 = (lane & 7) * 4; f32x4 v[8];
#pragma unroll
      for (int i = 0; i < 8; ++i) v[i] = __builtin_nontemporal_load((const f32x4*)(W + (size_t)(k0 + kr + 8 * i) * N + n0 + c4));
#pragma unroll
      for (int i = 0; i < 8; ++i) { LAS float* d = scr + (kr + 8 * i) * 33 + c4; d[0] = v[i][0]; d[1] = v[i][1]; d[2] = v[i][2]; d[3] = v[i][3]; } }
    LDS_WAIT(); asm volatile("" ::: "memory");
    const int c = lane & 7;
#pragma unroll
    for (int j = 0; j < 4; ++j) { const int n = (lane >> 3) + 8 * j; const LAS float* s = scr + (8 * c) * 33 + n;
        v4u o;
        if (h) { o.x = cvt_pk_f16(s[0 * 33], s[1 * 33]); o.y = cvt_pk_f16(s[2 * 33], s[3 * 33]); o.z = cvt_pk_f16(s[4 * 33], s[5 * 33]); o.w = cvt_pk_f16(s[6 * 33], s[7 * 33]); }
        else { o.x = cvt_pk_bf16(s[0 * 33], s[1 * 33]); o.y = cvt_pk_bf16(s[2 * 33], s[3 * 33]); o.z = cvt_pk_bf16(s[4 * 33], s[5 * 33]); o.w = cvt_pk_bf16(s[6 * 33], s[7 * 33]); }
        *(v4u*)(WT + (size_t)(dst_row0 + n) * dpitch + dst_koff + k0 + 8 * c) = o; }
    LDS_WAIT(); asm volatile("" ::: "memory");
}
__device__ __forceinline__ void sincos_d(double a, double& s, double& c) {
    const double k = __builtin_rint(a * 0.63661977236758134308);
    double r = __builtin_fma(-k, 1.57079632679489655800e+00, a); r = __builtin_fma(-k, 6.12323399573676603587e-17, r);
    const double r2 = r * r;
    double sp = 1.0 / 1307674368000.0; sp = sp * r2 - 1.0 / 6227020800.0; sp = sp * r2 + 1.0 / 39916800.0; sp = sp * r2 - 1.0 / 362880.0; sp = sp * r2 + 1.0 / 5040.0; sp = sp * r2 - 1.0 / 120.0; sp = sp * r2 + 1.0 / 6.0;
    const double sr = r - r * r2 * sp;
    double cp = 1.0 / 20922789888000.0; cp = cp * r2 - 1.0 / 87178291200.0; cp = cp * r2 + 1.0 / 479001600.0; cp = cp * r2 - 1.0 / 3628800.0; cp = cp * r2 + 1.0 / 40320.0; cp = cp * r2 - 1.0 / 720.0; cp = cp * r2 + 1.0 / 24.0;
    const double cr = 1.0 - 0.5 * r2 + r2 * r2 * cp;
    const int q = ((int)k) & 3;
    s = (q == 0) ? sr : (q == 1) ? cr : (q == 2) ? -sr : -cr;
    c = (q == 0) ? cr : (q == 1) ? -sr : (q == 2) ? -cr : sr;
}
__device__ __forceinline__ double exp_d(double x) {
    const double k = __builtin_rint(x * 1.44269504088896340736);
    const double r = __builtin_fma(-k, 6.93147180369123816490e-01, x) - k * 1.90821492927058770002e-10;
    double p = 1.0 / 6227020800.0;
    p = p * r + 1.0 / 479001600.0; p = p * r + 1.0 / 39916800.0; p = p * r + 1.0 / 3628800.0; p = p * r + 1.0 / 362880.0; p = p * r + 1.0 / 40320.0; p = p * r + 1.0 / 5040.0;
    p = p * r + 1.0 / 720.0; p = p * r + 1.0 / 120.0; p = p * r + 1.0 / 24.0; p = p * r + 1.0 / 6.0; p = p * r + 0.5; p = p * r + 1.0; p = p * r + 1.0;
    const long long e = (long long)k + 1023; double sc = __builtin_bit_cast(double, (unsigned long long)(e << 52));
    return p * sc;
}

__device__ __forceinline__ void phase_prologue_a(const Frame& F0) {
    Frame F = F0; F.tid = F.wave * 64 + lane_id(); asm volatile("" : "+v"(F.tid)); F.lane = F.tid & 63;
    unsigned char* ws = opqg(F.ws); const __attribute__((address_space(4))) Args* a = opq(F.ka);
    LAS float* scr = (LAS float*)(F.lds + F.wave * 16384);
    const int gw = F.vcu * 8 + F.wave, NGW = F.G * 8;
    constexpr int I_IN = 32 * 288, I_GLU = 16 * 64, I_UP = 16 * 64, I_O = 32 * 64, I_L = I_IN + I_GLU + 2 * I_UP + I_O;
    for (int it = gw; it < DEPTH * I_L; it += NGW) {
        const int l = it / I_L; int r = it % I_L;
        if (r < I_IN) { const int kb = r / 288, nb = r % 288, n0 = nb * 32; int dr;
            if (n0 < 5120) dr = n0; else if (n0 < 7168) { const int j = n0 - 5120; dr = 5120 + (j >> 7) * 256 + (j & 127); } else { const int j = n0 - 7168; dr = 5120 + (j >> 7) * 256 + 128 + (j & 127); }
            p0_transpose_item(GP(const float, a->in[I_WIN]) + (size_t)l * D * NIN, NIN, (bf16*)(ws + WS_WIN) + (size_t)l * NIN * D, D, 0, dr, scr, kb * 64, n0, F.lane, true); continue; }
        r -= I_IN;
        if (r < I_GLU) { const int kb = r / 64, nb = r % 64, n0 = nb * 32; int dr;
            if (n0 < 1024) dr = (n0 >> 7) * 256 + (n0 & 127); else { const int j = n0 - 1024; dr = (j >> 7) * 256 + 128 + (j & 127); }
            p0_transpose_item(GP(const float, a->in[I_WGLU]) + (size_t)l * 1024 * 2048, 2048, (bf16*)(ws + WS_WGLU) + (size_t)l * 2048 * 1024, 1024, 0, dr, scr, kb * 64, n0, F.lane); continue; }
        r -= I_GLU;
        if (r < I_UP) { const int kb = r / 64, nb = r % 64;
            p0_transpose_item(GP(const float, a->in[I_WUPA]) + (size_t)l * 1024 * 2048, 2048, (bf16*)(ws + WS_WUP) + (size_t)l * 2048 * 2048, 2048, 0, nb * 32, scr, kb * 64, nb * 32, F.lane); continue; }
        r -= I_UP;
        if (r < I_UP) { const int kb = r / 64, nb = r % 64;
            p0_transpose_item(GP(const float, a->in[I_WUPB]) + (size_t)l * 1024 * 2048, 2048, (bf16*)(ws + WS_WUP) + (size_t)l * 2048 * 2048, 2048, 1024, nb * 32, scr, kb * 64, nb * 32, F.lane); continue; }
        r -= I_UP;
        { const int kb = r / 64, nb = r % 64;
            p0_transpose_item(GP(const float, a->in[I_WO]) + (size_t)l * 2048 * 2048, 2048, (bf16*)(ws + WS_WO) + (size_t)l * 2048 * 2048, 2048, 0, nb * 32, scr, kb * 64, nb * 32, F.lane); }
    }
    const size_t gt = (size_t)F.vcu * 512 + F.tid, NT = (size_t)F.G * 512;
    { const float* src = GP(const float, a->in[I_PWQ]); bf16* dst = (bf16*)(ws + WS_WQB);
      const size_t N_ = (size_t)DEPTH * D * D / 8; size_t i = gt;
      for (; i + 3 * NT < N_; i += 4 * NT) { f32x4 va[4], vb[4];
#pragma unroll
          for (int k = 0; k < 4; ++k) { va[k] = *(const f32x4*)(src + (i + k * NT) * 8); vb[k] = *(const f32x4*)(src + (i + k * NT) * 8 + 4); }
#pragma unroll
          for (int k = 0; k < 4; ++k) { v4u w; w.x = cvt_pk_bf16(va[k][0], va[k][1]); w.y = cvt_pk_bf16(va[k][2], va[k][3]); w.z = cvt_pk_bf16(vb[k][0], vb[k][1]); w.w = cvt_pk_bf16(vb[k][2], vb[k][3]); *(v4u*)(dst + (i + k * NT) * 8) = w; } }
      for (; i < N_; i += NT) { const f32x4 v0 = *(const f32x4*)(src + i * 8), v1 = *(const f32x4*)(src + i * 8 + 4);
          v4u w; w.x = cvt_pk_bf16(v0[0], v0[1]); w.y = cvt_pk_bf16(v0[2], v0[3]); w.z = cvt_pk_bf16(v1[0], v1[1]); w.w = cvt_pk_bf16(v1[2], v1[3]); *(v4u*)(dst + i * 8) = w; } }
    { const float* src = GP(const float, a->in[I_X]); bf16* XS = (bf16*)(ws + WS_XH);
      const int j = F.lane & 3, rr = (F.lane >> 2) & 1, sl = F.lane >> 3;
      for (int rp = gw; rp < T / 2; rp += NGW) { const int row = 2 * rp + rr;
          f32x4 a0[8], a1[8]; float amax = 0.f;
#pragma unroll
          for (int i = 0; i < 8; ++i) { const float* sp = src + (size_t)row * D + (8 * i + sl) * 32 + j * 8; a0[i] = *(const f32x4*)sp; a1[i] = *(const f32x4*)(sp + 4); }
#pragma unroll
          for (int i = 0; i < 8; ++i) { v4u o; o.x = cvt_pk_f16(a0[i][0], a0[i][1]); o.y = cvt_pk_f16(a0[i][2], a0[i][3]); o.z = cvt_pk_f16(a1[i][0], a1[i][1]); o.w = cvt_pk_f16(a1[i][2], a1[i][3]);
              *(v4u*)(XS + ((size_t)(8 * i + sl) * T + row) * 32 + j * 8) = o;
#pragma unroll
              for (int k = 0; k < 4; ++k) amax = fmaxf(amax, fmaxf(fabsf(a0[i][k]), fabsf(a1[i][k]))); }
          amax = fmaxf(amax, __shfl_xor(amax, 1)); amax = fmaxf(amax, __shfl_xor(amax, 2)); amax = fmaxf(amax, __shfl_xor(amax, 8)); amax = fmaxf(amax, __shfl_xor(amax, 16)); amax = fmaxf(amax, __shfl_xor(amax, 32));
          const float inv = (amax > 0.f) ? 127.f / amax : 0.f;
          if (j == 0 && sl == 0) ((float*)(ws + WS_SX))[row] = (amax > 0.f) ? amax * (1.f / 127.f) : 1.f;
          unsigned char* xq = ws + WS_XQ + (size_t)row * 64 + (sl & 1) * 32 + j * 8;
#pragma unroll
          for (int i = 0; i < 8; ++i) { int q[8];
#pragma unroll
              for (int k = 0; k < 4; ++k) { q[k] = (int)__builtin_rintf(a0[i][k] * inv); q[4 + k] = (int)__builtin_rintf(a1[i][k] * inv); }
              v2u o; o.x = (unsigned)(q[0] & 255) | ((unsigned)(q[1] & 255) << 8) | ((unsigned)(q[2] & 255) << 16) | ((unsigned)q[3] << 24);
              o.y = (unsigned)(q[4] & 255) | ((unsigned)(q[5] & 255) << 8) | ((unsigned)(q[6] & 255) << 16) | ((unsigned)q[7] << 24);
              *(v2u*)(xq + (size_t)(4 * i + (sl >> 1)) * T * 64) = o; } } }
    { const float* keys = GP(const float, a->in[I_PKEYS]); bf16* dst = (bf16*)(ws + WS_BK);
      for (size_t i = gt; i < (size_t)DEPTH * 8 * 256 * 256 / 8; i += NT) { const int jj = (int)(i & 31) * 8; const int row = (int)((i >> 5) & 255); const size_t lh = i >> 13; const int half = row >> 7, n = row & 127;
          v4u w = (v4u){0u, 0u, 0u, 0u};
          if ((jj >> 7) == half) { const float* s = keys + ((lh * 2 + half) * 128 + n) * 128 + (jj & 127); const f32x4 v0 = *(const f32x4*)s, v1 = *(const f32x4*)(s + 4);
              w.x = cvt_pk_bf16(v0[0], v0[1]); w.y = cvt_pk_bf16(v0[2], v0[3]); w.z = cvt_pk_bf16(v1[0], v1[1]); w.w = cvt_pk_bf16(v1[2], v1[3]); }
          *(v4u*)(dst + i * 8) = w; } }
    if (gt < 1024) { const float* lg = GP(const float, a->in[I_LBL]); float* lbo = (float*)(ws + WS_LB); const int d = (int)gt;
        const float z0 = lg[d], z1 = lg[1024 + d], z2 = lg[2048 + d], z3 = lg[3072 + d]; const float mx = fmaxf(fmaxf(z0, z1), fmaxf(z2, z3));
        const float e0 = expf(z0 - mx), e1 = expf(z1 - mx), e2 = expf(z2 - mx), e3 = expf(z3 - mx); const float inv = 1.f / (e0 + e1 + e2 + e3);
        lbo[d] = 0.f; lbo[1024 + d] = e1 * inv; lbo[2048 + d] = (e1 + e2) * inv; lbo[3072 + d] = (e1 + e2 + e3) * inv; }
    for (size_t i = gt; i < (size_t)DEPTH * 64 * 64; i += NT) {
        const size_t lg_ = i >> 6;
        const double lr = fmin((double)GP(const float, a->in[I_LRE])[i], -1e-4), li = (double)GP(const float, a->in[I_LIM])[i], dt = exp_d((double)GP(const float, a->in[I_LSTEP])[lg_]);
        const double mag = exp_d(lr * dt); double sn, cs; sincos_d(li * dt, sn, cs);
        const double ar = mag * cs, ai = mag * sn, den = lr * lr + li * li, nr = ar - 1.0;
        const double zr = (nr * lr + ai * li) / den, zi = (ai * lr - nr * li) / den;
        const float* br = GP(const float, a->in[I_BRE]) + i * 16; const float* bi = GP(const float, a->in[I_BIM]) + i * 16; float* bb = (float*)(ws + WS_BB) + i * 32;
        f32x4 brv[4], biv[4];
#pragma unroll
        for (int m4 = 0; m4 < 4; ++m4) { brv[m4] = ((const f32x4*)br)[m4]; biv[m4] = ((const f32x4*)bi)[m4]; }
#pragma unroll
        for (int m4 = 0; m4 < 4; ++m4) { float o8[8];
#pragma unroll
            for (int x = 0; x < 4; ++x) { const double b_r = brv[m4][x], b_i = biv[m4][x]; o8[2 * x] = (float)(zr * b_r - zi * b_i); o8[2 * x + 1] = (float)(zr * b_i + zi * b_r); }
            ((f32x4*)bb)[2 * m4] = (f32x4){o8[0], o8[1], o8[2], o8[3]}; ((f32x4*)bb)[2 * m4 + 1] = (f32x4){o8[4], o8[5], o8[6], o8[7]}; }
        float* ap = (float*)(ws + WS_APOW) + (lg_ * 65 * 64 + (i & 63)) * 2; double pr = 1.0, pi = 0.0;
        for (int dl = 0; dl < 65; ++dl) { ap[dl * 128] = (float)pr; ap[dl * 128 + 1] = (float)pi; const double t = pr * ar - pi * ai; pi = pr * ai + pi * ar; pr = t; }
    }
    for (int it = gw; it < DEPTH * 1024; it += NGW) {
        const int l = it >> 10, eb = it & 1023;
        const int pe = eb * 16 + (F.lane >> 2), i1 = (pe & 1023) >> 3, i2 = (pe & 7) * 16 + (((pe >> 10) - i1) & 15);
        const float* src = GP(const float, a->in[I_PV]) + ((size_t)l * NEXP + i1 * 128 + i2) * D + (F.lane & 3) * 8;
        bf16* dst = (bf16*)(ws + WS_TBV) + (size_t)l * 64 * NEXP * 32 + ((size_t)((pe >> 10) * 4 + (F.lane & 3)) * 1024 + (pe & 1023)) * 8;
#pragma unroll 1
        for (int k8 = 0; k8 < 64; k8 += 8) { f32x4 va[8], vb[8];
#pragma unroll
            for (int k = 0; k < 8; ++k) { va[k] = __builtin_nontemporal_load((const f32x4*)(src + (k8 + k) * 32)); vb[k] = __builtin_nontemporal_load((const f32x4*)(src + (k8 + k) * 32 + 4)); }
#pragma unroll
            for (int k = 0; k < 8; ++k) { v4u w; w.x = cvt_pk_f16(va[k][0], va[k][1]); w.y = cvt_pk_f16(va[k][2], va[k][3]); w.z = cvt_pk_f16(vb[k][0], vb[k][1]); w.w = cvt_pk_f16(vb[k][2], vb[k][3]);
                *(v4u*)(dst + (size_t)(k8 + k) * NEXP * 32) = w; } }
    }
    for (int it = gw; it < DEPTH * 4096; it += NGW) {
        const int l = it >> 12, q4 = it & 4095, c = F.lane & 15;
        const int pe = q4 * 4 + (F.lane >> 4), i1 = (pe & 1023) >> 3, i2 = (pe & 7) * 16 + (((pe >> 10) - i1) & 15);
        const float* src = GP(const float, a->in[I_PU]) + ((size_t)l * NEXP + i1 * 128 + i2) * D + c * 4;
        unsigned hv[64]; float m = 0.f;
#pragma unroll
        for (int i = 0; i < 32; ++i) { const f32x4 v = __builtin_nontemporal_load((const f32x4*)(src + i * 64));
            m = fmaxf(fmaxf(m, fmaxf(fabsf(v[0]), fabsf(v[1]))), fmaxf(fabsf(v[2]), fabsf(v[3])));
            hv[2 * i] = cvt_pk_f16(v[0], v[1]); hv[2 * i + 1] = cvt_pk_f16(v[2], v[3]); }
        m = fmaxf(m, __shfl_xor(m, 1)); m = fmaxf(m, __shfl_xor(m, 2)); m = fmaxf(m, __shfl_xor(m, 4)); m = fmaxf(m, __shfl_xor(m, 8));
        const float sc = (m > 0.f) ? m * (1.f / 127.f) : 1.f, inv = (m > 0.f) ? 127.f / m : 0.f;
        if (c == 0) ((float*)(ws + WS_SU))[(size_t)l * NEXP + pe] = sc;
        unsigned char* dst = ws + WS_TBU + (size_t)l * 32 * NEXP * 64 + (size_t)pe * 64 + (((c >> 2) ^ ((pe >> 2) & 3)) * 16 + (c & 3) * 4);
#pragma unroll
        for (int i = 0; i < 32; ++i) { const h2_t p0 = __builtin_bit_cast(h2_t, hv[2 * i]), p1 = __builtin_bit_cast(h2_t, hv[2 * i + 1]);
            const int q0 = (int)__builtin_rintf((float)p0.x * inv), q1 = (int)__builtin_rintf((float)p0.y * inv), q2 = (int)__builtin_rintf((float)p1.x * inv), q3 = (int)__builtin_rintf((float)p1.y * inv);
            *(unsigned*)(dst + (size_t)i * NEXP * 64) = (unsigned)(q0 & 255) | ((unsigned)(q1 & 255) << 8) | ((unsigned)(q2 & 255) << 16) | ((unsigned)q3 << 24); }
    }
}
__device__ __forceinline__ double dummy_unused_(double x) { return x; }

__device__ __forceinline__ void phase_prologue_b(const Frame& F0) {
    Frame F = F0; F.tid = F.wave * 64 + lane_id(); asm volatile("" : "+v"(F.tid)); F.lane = F.tid & 63;
    unsigned char* ws = opqg(F.ws); const __attribute__((address_space(4))) Args* a = opq(F.ka);
    const float* APOW = (const float*)(ws + WS_APOW); const float* BB = (const float*)(ws + WS_BB);
    LAS float* AP = (LAS float*)(F.lds); LAS float* BL = (LAS float*)(F.lds + 33280); LAS float* CR = (LAS float*)(F.lds + 41472); LAS float* CI = (LAS float*)(F.lds + 45568); LAS float* SDL = (LAS float*)(F.lds + 49664);
    bf16* KM = (bf16*)(ws + WS_KMAT); bf16* PM = (bf16*)(ws + WS_PM); bf16* E = (bf16*)(ws + WS_E);
    for (int lg = F.vcu; lg < DEPTH * 64; lg += F.G) {
        for (int i = F.tid; i < 65 * 64 * 2 / 4; i += 512) ((LAS f32x4*)AP)[i] = ((const f32x4*)(APOW + (size_t)lg * 65 * 128))[i];
        ((LAS f32x4*)BL)[F.tid] = ((const f32x4*)(BB + (size_t)lg * 2048))[F.tid];
        if (F.tid < 256) ((LAS f32x4*)CR)[F.tid] = ((const f32x4*)(GP(const float, a->in[I_CRE]) + (size_t)lg * 1024))[F.tid];
        else ((LAS f32x4*)CI)[F.tid - 256] = ((const f32x4*)(GP(const float, a->in[I_CIM]) + (size_t)lg * 1024))[F.tid - 256];
        if (F.tid < 16) SDL[F.tid] = GP(const float, a->in[I_SD])[lg * 16 + F.tid];
        __syncthreads();
        for (int task = F.tid; task < 65 * 16; task += 512) {
            const int n = task & 15, idx = task >> 4;
            float sm[16];
#pragma unroll
            for (int m = 0; m < 16; ++m) sm[m] = 0.f;
            if (idx > 0) { const int dl = idx - 1;
#pragma unroll 4
                for (int p = 0; p < 64; ++p) { const f32x2 av = *(const LAS f32x2*)(AP + (dl * 64 + p) * 2); const float c_r = CR[n * 64 + p], c_i = CI[n * 64 + p];
                    const float car = c_r * av[0] - c_i * av[1], cai = c_r * av[1] + c_i * av[0];
#pragma unroll
                    for (int q = 0; q < 8; ++q) { const f32x4 b4 = *(const LAS f32x4*)(BL + p * 32 + q * 4); sm[2 * q] += car * b4[0] - cai * b4[1]; sm[2 * q + 1] += car * b4[2] - cai * b4[3]; } }
                if (dl == 0) { const float dv = SDL[n];
#pragma unroll
                    for (int m = 0; m < 16; ++m) sm[m] += (m == n) ? dv : 0.f; } }
            v4u w0, w1; w0.x = cvt_pk_bf16(sm[0], sm[1]); w0.y = cvt_pk_bf16(sm[2], sm[3]); w0.z = cvt_pk_bf16(sm[4], sm[5]); w0.w = cvt_pk_bf16(sm[6], sm[7]);
            w1.x = cvt_pk_bf16(sm[8], sm[9]); w1.y = cvt_pk_bf16(sm[10], sm[11]); w1.z = cvt_pk_bf16(sm[12], sm[13]); w1.w = cvt_pk_bf16(sm[14], sm[15]);
            bf16* kp = KM + ((size_t)lg * 65 * 16 + task) * 16; *(v4u*)kp = w0; *(v4u*)(kp + 8) = w1; }
        for (int it = F.tid; it < 128 * 64 * 2; it += 512) {
            const int m0 = (it & 1) * 8, sidx = (it >> 1) & 63, pp = it >> 7, p = pp & 63;
            const f32x2 av = *(const LAS f32x2*)(AP + ((63 - sidx) * 64 + p) * 2); const float pr = av[0], pi = av[1];
            float o[8];
#pragma unroll
            for (int j = 0; j < 4; ++j) { const f32x4 b4 = *(const LAS f32x4*)(BL + p * 32 + m0 * 2 + j * 4);
                o[2 * j] = (pp < 64) ? (pr * b4[0] - pi * b4[1]) : (pr * b4[1] + pi * b4[0]); o[2 * j + 1] = (pp < 64) ? (pr * b4[2] - pi * b4[3]) : (pr * b4[3] + pi * b4[2]); }
            v4u w; w.x = cvt_pk_bf16(o[0], o[1]); w.y = cvt_pk_bf16(o[2], o[3]); w.z = cvt_pk_bf16(o[4], o[5]); w.w = cvt_pk_bf16(o[6], o[7]); *(v4u*)(PM + ((size_t)lg * 16384 + it) * 8) = w; }
        for (int it = F.tid; it < 1024 * 16; it += 512) {
            const int pp0 = (it & 15) * 8, n = (it >> 4) & 15, tau = it >> 8, p0 = pp0 & 63;
            float o[8];
#pragma unroll
            for (int j = 0; j < 8; ++j) { const f32x2 av = *(const LAS f32x2*)(AP + ((tau + 1) * 64 + p0 + j) * 2); const float c_r = CR[n * 64 + p0 + j], c_i = CI[n * 64 + p0 + j];
                o[j] = (pp0 < 64) ? (c_r * av[0] - c_i * av[1]) : -(c_r * av[1] + c_i * av[0]); }
            v4u w; w.x = cvt_pk_bf16(o[0], o[1]); w.y = cvt_pk_bf16(o[2], o[3]); w.z = cvt_pk_bf16(o[4], o[5]); w.w = cvt_pk_bf16(o[6], o[7]); *(v4u*)(E + ((size_t)lg * 16384 + it) * 8) = w; }
        __syncthreads();
    }
}
__device__ __forceinline__ void quant_rows(const Frame& F0, const bf16* SRC, int rpl, int lrows, int row0, unsigned char* W8, float* SW) {
    Frame F = F0; F.tid = F.wave * 64 + lane_id(); asm volatile("" : "+v"(F.tid)); F.lane = F.tid & 63;
    for (int row = F.vcu * 8 + F.wave; row < DEPTH * rpl; row += F.G * 8) {
        const int l = row / rpl, r = row - l * rpl; const bf16* sp = SRC + ((size_t)l * lrows + row0 + r) * 2048;
        v4u w[4]; float vf[32]; float m = 0.f;
#pragma unroll
        for (int k = 0; k < 4; ++k) w[k] = *(const v4u*)(sp + (k * 64 + F.lane) * 8);
#pragma unroll
        for (int k = 0; k < 4; ++k) { const unsigned ww[4] = {w[k].x, w[k].y, w[k].z, w[k].w};
#pragma unroll
            for (int x = 0; x < 4; ++x) { const h2_t hv = __builtin_bit_cast(h2_t, ww[x]); vf[8 * k + 2 * x] = (float)hv.x; vf[8 * k + 2 * x + 1] = (float)hv.y; m = fmaxf(m, fmaxf(fabsf((float)hv.x), fabsf((float)hv.y))); } }
#pragma unroll
        for (int o = 1; o < 64; o <<= 1) m = fmaxf(m, __shfl_xor(m, o));
        const float inv = (m > 0.f) ? 127.f / m : 0.f;
        if (F.lane == 0) SW[row] = (m > 0.f) ? m * (1.f / 127.f) : 1.f;
#pragma unroll
        for (int k = 0; k < 4; ++k) { int q[8];
#pragma unroll
            for (int x = 0; x < 8; ++x) q[x] = (int)__builtin_rintf(vf[8 * k + x] * inv);
            v2u o; o.x = (unsigned)(q[0] & 255) | ((unsigned)(q[1] & 255) << 8) | ((unsigned)(q[2] & 255) << 16) | ((unsigned)q[3] << 24);
            o.y = (unsigned)(q[4] & 255) | ((unsigned)(q[5] & 255) << 8) | ((unsigned)(q[6] & 255) << 16) | ((unsigned)q[7] << 24);
            *(v2u*)(W8 + (size_t)row * 2048 + (k * 64 + F.lane) * 8) = o; }
    }
}
constexpr int HG_BL = 0, HG_TOT = 33792, HG_VT = 35840, HG_KT = 54272, HG_RED = 72704;
constexpr int KSP = 136, HG_KS = 73728, HG_QT = HG_KS + 64 * KSP * 2, HG_QH = HG_QT + 64 * KSP * 2;
static_assert(HG_QH + 64 * KSP * 2 <= RING_BYTES, "hgrn_out LDS map");
constexpr int BLP = 132, VTP = 72;
__device__ __forceinline__ void hg_cumsum(const Frame& F, const float* LOGF, int c, int h) {
    LAS float* bL = (LAS float*)(F.lds + HG_BL); LAS float* tot = (LAS float*)(F.lds + HG_TOT);
    const int d = F.tid & 127, seg = F.tid >> 7;
    const float* src = LOGF + (size_t)(c * 64 + seg * 16) * AW + h * 128 + d;
    float lf[16];
#pragma unroll
    for (int i = 0; i < 16; ++i) lf[i] = src[(size_t)i * AW];
#pragma unroll
    for (int i = 1; i < 16; ++i) lf[i] += lf[i - 1];
    tot[seg * 128 + d] = lf[15];
    __syncthreads();
    float off = 0.f;
#pragma unroll
    for (int s2 = 0; s2 < 3; ++s2) off += (s2 < seg) ? tot[s2 * 128 + d] : 0.f;
#pragma unroll
    for (int i = 0; i < 16; ++i) bL[(seg * 16 + i) * BLP + d] = lf[i] + off;
}
__device__ __forceinline__ void hg_load_vt(const Frame& F, const bf16* V, int c, int h) {
    LAS bf16* VT = (LAS bf16*)(F.lds + HG_VT);
    const int s = F.lane, vb = F.wave * 16;
    const v4u* src = (const v4u*)(V + (size_t)(c * 64 + s) * AW + h * 128 + vb);
    const v4u w0 = src[0], w1 = src[1];
    const unsigned ww[8] = {w0.x, w0.y, w0.z, w0.w, w1.x, w1.y, w1.z, w1.w};
#pragma unroll
    for (int j = 0; j < 8; ++j) { VT[(vb + 2 * j) * VTP + s] = (bf16)(ww[j] & 0xffffu); VT[(vb + 2 * j + 1) * VTP + s] = (bf16)(ww[j] >> 16); }
}
__device__ __forceinline__ void phase_hgrn_local(const Frame& F0, int l) {
    Frame F = F0; F.tid = F.wave * 64 + lane_id(); asm volatile("" : "+v"(F.tid)); F.lane = F.tid & 63;
    unsigned char* ws = opqg(F.ws);
    const float* LOGF = (const float*)(ws + WS_LOGF); const bf16* KK = (const bf16*)(ws + WS_KK); const bf16* V = (const bf16*)(ws + WS_V);
    _Float16* U = (_Float16*)(ws + WS_U); float* BLo = (float*)(ws + WS_BL);
    LAS float* bL = (LAS float*)(F.lds + HG_BL); LAS bf16* VT = (LAS bf16*)(F.lds + HG_VT); LAS bf16* KT = (LAS bf16*)(F.lds + HG_KT);
    const int fr = F.lane & 15, fq = F.lane >> 4;
    for (int unit = F.vcu; unit < NCH * 8; unit += F.G) {
        const int c = unit >> 3, h = unit & 7;
        hg_cumsum(F, LOGF, c, h);
        hg_load_vt(F, V, c, h);
        __syncthreads();
        { const int s = F.lane, db = F.wave * 16;
          const v4u* src = (const v4u*)(KK + (size_t)(c * 64 + s) * AW + h * 128 + db);
          const v4u w0 = src[0], w1 = src[1];
          const unsigned ww[8] = {w0.x, w0.y, w0.z, w0.w, w1.x, w1.y, w1.z, w1.w};
#pragma unroll
          for (int j = 0; j < 8; ++j) {
              const float b0 = bL[s * BLP + db + 2 * j], b1 = bL[s * BLP + db + 2 * j + 1], l0 = bL[63 * BLP + db + 2 * j], l1 = bL[63 * BLP + db + 2 * j + 1];
              const unsigned pk = cvt_pk_bf16(bf_lo(ww[j]) * fexp(l0 - b0), bf_hi(ww[j]) * fexp(l1 - b1));
              KT[(db + 2 * j) * VTP + s] = (bf16)(pk & 0xffffu); KT[(db + 2 * j + 1) * VTP + s] = (bf16)(pk >> 16); } }
        if (F.tid < 128) BLo[(size_t)c * AW + h * 128 + F.tid] = bL[63 * BLP + F.tid];
        __syncthreads();
        f32x4 acc[8];
#pragma unroll
        for (int i = 0; i < 8; ++i) acc[i] = (f32x4){0.f, 0.f, 0.f, 0.f};
#pragma unroll
        for (int ks = 0; ks < 2; ++ks) {
            const bf16x8 A = *(const LAS bf16x8*)(VT + (F.wave * 16 + fr) * VTP + ks * 32 + fq * 8);
#pragma unroll
            for (int dt = 0; dt < 8; ++dt) { const bf16x8 B = *(const LAS bf16x8*)(KT + (dt * 16 + fr) * VTP + ks * 32 + fq * 8);
                acc[dt] = __builtin_amdgcn_mfma_f32_16x16x32_bf16(B, A, acc[dt], 0, 0, 0); }
        }
        _Float16* up = U + ((size_t)(c * 8 + h) * 128 + F.wave * 16 + fr) * 128 + fq * 4;
#pragma unroll
        for (int dt = 0; dt < 8; ++dt) { v2u w; w.x = cvt_pk_f16(acc[dt][0], acc[dt][1]); w.y = cvt_pk_f16(acc[dt][2], acc[dt][3]); *(v2u*)(up + dt * 16) = w; }
        __syncthreads();
    }
}
__device__ __forceinline__ void phase_scan(const Frame& F0, int l) {
    Frame F = F0; F.tid = F.wave * 64 + lane_id(); asm volatile("" : "+v"(F.tid)); F.lane = F.tid & 63;
    unsigned char* ws = opqg(F.ws);
    const _Float16* U = (const _Float16*)(ws + WS_U); const float* BLo = (const float*)(ws + WS_BL); bf16* SP = (bf16*)(ws + WS_SP);
    for (int e = F.vcu * 512 + F.tid; e < 8 * 128 * 128; e += F.G * 512) {
        const int hd = (e >> 14) * 128 + (e & 127);
        float s = 0.f;
        float u[32], bl[32], bln[32]; _Float16 unh[32];
#pragma unroll
        for (int i = 0; i < 32; ++i) { u[i] = (float)U[(size_t)i * 131072 + e]; bl[i] = BLo[(size_t)i * AW + hd]; }
#pragma unroll 1
        for (int c0 = 0; c0 < NCH; c0 += 32) {
            const int cn = (c0 + 32 < NCH) ? c0 + 32 : c0;
#pragma unroll
            for (int i = 0; i < 32; ++i) { unh[i] = U[(size_t)(cn + i) * 131072 + e]; bln[i] = BLo[(size_t)(cn + i) * AW + hd]; }
#pragma unroll
            for (int i = 0; i < 32; ++i) { SP[(size_t)(c0 + i) * 131072 + e] = f2bf(s); s = s * fexp(bl[i]) + u[i]; }
#pragma unroll
            for (int i = 0; i < 32; ++i) { u[i] = (float)unh[i]; bl[i] = bln[i]; }
        }
    }
    const float* XLOC = (const float*)(ws + WS_XLOC); float* XS = (float*)(ws + WS_XS); const float* APOW = (const float*)(ws + WS_APOW);
    for (int e = F.vcu * 512 + F.tid; e < 64 * 64; e += F.G * 512) {
        const int g = e >> 6, p = e & 63;
        const float* ap = APOW + (((size_t)(l * 64 + g) * 65 + 64) * 64 + p) * 2; const float ar = ap[0], ai = ap[1];
        float xr = 0.f, xi = 0.f;
        for (int c0 = 0; c0 < NCH; c0 += 32) {
            float lr_[32], li_[32];
#pragma unroll
            for (int i = 0; i < 32; ++i) { lr_[i] = XLOC[((size_t)(c0 + i) * 64 + g) * 128 + p]; li_[i] = XLOC[((size_t)(c0 + i) * 64 + g) * 128 + 64 + p]; }
#pragma unroll
            for (int i = 0; i < 32; ++i) { XS[((size_t)(c0 + i) * 64 + g) * 128 + p] = xr; XS[((size_t)(c0 + i) * 64 + g) * 128 + 64 + p] = xi;
                const float t = ar * xr - ai * xi + lr_[i]; xi = ar * xi + ai * xr + li_[i]; xr = t; }
        }
    }
}
__device__ __forceinline__ void phase_hgrn_out(const Frame& F0, int l) {
    Frame F = F0; F.tid = F.wave * 64 + lane_id(); asm volatile("" : "+v"(F.tid)); F.lane = F.tid & 63;
    unsigned char* ws = opqg(F.ws); const __attribute__((address_space(4))) Args* a = opq(F.ka);
    const float* LOGF = (const float*)(ws + WS_LOGF); const bf16* KK = (const bf16*)(ws + WS_KK); const bf16* V = (const bf16*)(ws + WS_V);
    const bf16* Q = (const bf16*)(ws + WS_Q); const bf16* SG = (const bf16*)(ws + WS_SG); const bf16* SP = (const bf16*)(ws + WS_SP);
    bf16* OAB = (bf16*)(ws + WS_OAB); const float* NG = GP(const float, a->in[I_NG]) + (size_t)l * AW;
    LAS float* bL = (LAS float*)(F.lds + HG_BL); LAS bf16* VT = (LAS bf16*)(F.lds + HG_VT); LAS float* red = (LAS float*)(F.lds + HG_RED);
    const int fr = F.lane & 15, fq = F.lane >> 4, tt = F.wave & 3, vh = F.wave >> 2;
    LAS float* tot = (LAS float*)(F.lds + HG_TOT);
    float lf[16]; v4u vw0, vw1, kg0, kg1, qg0, qg1;
#define HGO_PREF(u_) { const int c_ = (u_) >> 3, h_ = (u_) & 7; \
        const float* src_ = LOGF + (size_t)(c_ * 64 + (F.tid >> 7) * 16) * AW + h_ * 128 + (F.tid & 127); \
        _Pragma("unroll") for (int i = 0; i < 16; ++i) lf[i] = src_[(size_t)i * AW]; \
        const v4u* vp_ = (const v4u*)(V + (size_t)(c_ * 64 + F.lane) * AW + h_ * 128 + F.wave * 16); vw0 = vp_[0]; vw1 = vp_[1]; \
        const size_t ro_ = ((size_t)c_ * 64 + (F.tid >> 3)) * AW + h_ * 128 + (F.tid & 7) * 16; \
        const v4u* kp_ = (const v4u*)(KK + ro_); const v4u* qp_ = (const v4u*)(Q + ro_); kg0 = kp_[0]; kg1 = kp_[1]; qg0 = qp_[0]; qg1 = qp_[1]; }
    if (F.vcu < NCH * 8) HGO_PREF(F.vcu)
    for (int unit = F.vcu; unit < NCH * 8; unit += F.G) {
        const int c = unit >> 3, h = unit & 7;
        { const int d = F.tid & 127, seg = F.tid >> 7;
#pragma unroll
          for (int i = 1; i < 16; ++i) lf[i] += lf[i - 1];
          tot[seg * 128 + d] = lf[15];
          { const int s = F.lane, vb = F.wave * 16; const unsigned ww[8] = {vw0.x, vw0.y, vw0.z, vw0.w, vw1.x, vw1.y, vw1.z, vw1.w};
#pragma unroll
            for (int j = 0; j < 8; ++j) { VT[(vb + 2 * j) * VTP + s] = (bf16)(ww[j] & 0xffffu); VT[(vb + 2 * j + 1) * VTP + s] = (bf16)(ww[j] >> 16); } }
          __syncthreads();
          float off = 0.f;
#pragma unroll
          for (int s2 = 0; s2 < 3; ++s2) off += (s2 < seg) ? tot[s2 * 128 + d] : 0.f;
#pragma unroll
          for (int i = 0; i < 16; ++i) bL[(seg * 16 + i) * BLP + d] = lf[i] + off; }
        __syncthreads();
        const int t = tt * 16 + fr; const size_t tok = (size_t)c * 64 + t;
        bf16x8 sg_[2][4];
#define HG_LOAD(buf, kd_) { const int d0_ = (kd_) * 32 + fq * 8; \
            _Pragma("unroll") for (int vt = 0; vt < 4; ++vt) sg_[buf][vt] = *(const bf16x8*)(SP + ((size_t)(c * 8 + h) * 128 + (vh * 4 + vt) * 16 + fr) * 128 + d0_); }
        HG_LOAD(0, 0) HG_LOAD(1, 1)
        v2u sgw[4];
#pragma unroll
        for (int vt = 0; vt < 4; ++vt) sgw[vt] = *(const v2u*)(SG + tok * AW + h * 128 + (vh * 4 + vt) * 16 + fq * 4);
        f32x4 ngw[4];
#pragma unroll
        for (int vt = 0; vt < 4; ++vt) ngw[vt] = *(const f32x4*)(NG + h * 128 + (vh * 4 + vt) * 16 + fq * 4);
        { const int s = F.tid >> 3, dc = (F.tid & 7) * 16;
          const unsigned kq[8] = {kg0.x, kg0.y, kg0.z, kg0.w, kg1.x, kg1.y, kg1.z, kg1.w}, qq[8] = {qg0.x, qg0.y, qg0.z, qg0.w, qg1.x, qg1.y, qg1.z, qg1.w};
          unsigned ko[8], qto[8], qho[8];
#pragma unroll
          for (int j4 = 0; j4 < 4; ++j4) { const f32x4 bs = *(const LAS f32x4*)(bL + s * BLP + dc + 4 * j4), br = *(const LAS f32x4*)(bL + 31 * BLP + dc + 4 * j4);
#pragma unroll
              for (int hx = 0; hx < 2; ++hx) { const int w = 2 * j4 + hx; const float b0 = bs[2 * hx], b1 = bs[2 * hx + 1], r0 = br[2 * hx], r1 = br[2 * hx + 1];
                  const float k0 = bf_lo(kq[w]), k1 = bf_hi(kq[w]), q0 = bf_lo(qq[w]), q1 = bf_hi(qq[w]);
                  ko[w] = cvt_pk_bf16(k0 * fexp(fminf(r0 - b0, 80.f)), k1 * fexp(fminf(r1 - b1, 80.f)));
                  qto[w] = cvt_pk_bf16(q0 * fexp(fminf(b0 - r0, 80.f)), q1 * fexp(fminf(b1 - r1, 80.f)));
                  qho[w] = cvt_pk_bf16(q0 * fexp(b0), q1 * fexp(b1)); } }
          LAS v4u* kd_ = (LAS v4u*)(F.lds + HG_KS + (s * KSP + dc) * 2); kd_[0] = (v4u){ko[0], ko[1], ko[2], ko[3]}; kd_[1] = (v4u){ko[4], ko[5], ko[6], ko[7]};
          LAS v4u* qt_ = (LAS v4u*)(F.lds + HG_QT + (s * KSP + dc) * 2); qt_[0] = (v4u){qto[0], qto[1], qto[2], qto[3]}; qt_[1] = (v4u){qto[4], qto[5], qto[6], qto[7]};
          LAS v4u* qh_ = (LAS v4u*)(F.lds + HG_QH + (s * KSP + dc) * 2); qh_[0] = (v4u){qho[0], qho[1], qho[2], qho[3]}; qh_[1] = (v4u){qho[4], qho[5], qho[6], qho[7]}; }
        __syncthreads();
        f32x4 att[4], o[4];
#pragma unroll
        for (int i = 0; i < 4; ++i) { att[i] = (f32x4){0.f, 0.f, 0.f, 0.f}; o[i] = (f32x4){0.f, 0.f, 0.f, 0.f}; }
#pragma unroll
        for (int kd = 0; kd < 4; ++kd) {
            const int cb = kd & 1;
            const int fo = (kd * 32 + fq * 8) * 2;
            const bf16x8 Bqt = *(const LAS bf16x8*)(F.lds + HG_QT + (t * KSP) * 2 + fo), Bqh = *(const LAS bf16x8*)(F.lds + HG_QH + (t * KSP) * 2 + fo);
#pragma unroll
            for (int st = 0; st < 4; ++st) { const bf16x8 kt = *(const LAS bf16x8*)(F.lds + HG_KS + ((st * 16 + fr) * KSP) * 2 + fo);
                att[st] = __builtin_amdgcn_mfma_f32_16x16x32_bf16(kt, Bqt, att[st], 0, 0, 0); }
#pragma unroll
            for (int vt = 0; vt < 4; ++vt) o[vt] = __builtin_amdgcn_mfma_f32_16x16x32_bf16(sg_[cb][vt], Bqh, o[vt], 0, 0, 0);
            if (kd < 2) HG_LOAD(cb, kd + 2)
            if (kd == 1) { const int nu = unit + F.G; if (nu < NCH * 8) HGO_PREF(nu) }
        }
#undef HG_LOAD
#pragma unroll
        for (int ks = 0; ks < 2; ++ks) {
            float m8[8];
#pragma unroll
            for (int jj = 0; jj < 8; ++jj) { const int st = 2 * ks + (jj >> 2), r = jj & 3, s = st * 16 + fq * 4 + r; m8[jj] = (s <= t) ? att[st][r] : 0.f; }
            v4u pb; pb.x = cvt_pk_bf16(m8[0], m8[1]); pb.y = cvt_pk_bf16(m8[2], m8[3]); pb.z = cvt_pk_bf16(m8[4], m8[5]); pb.w = cvt_pk_bf16(m8[6], m8[7]);
            const bf16x8 B = __builtin_bit_cast(bf16x8, pb);
#pragma unroll
            for (int vt = 0; vt < 4; ++vt) { const int v = (vh * 4 + vt) * 16 + fr;
                const v2u a0 = *(const LAS v2u*)(VT + v * VTP + ks * 32 + fq * 4), a1 = *(const LAS v2u*)(VT + v * VTP + ks * 32 + 16 + fq * 4);
                const v4u pa = (v4u){a0.x, a0.y, a1.x, a1.y};
                o[vt] = __builtin_amdgcn_mfma_f32_16x16x32_bf16(__builtin_bit_cast(bf16x8, pa), B, o[vt], 0, 0, 0); }
        }
        float ss = 0.f;
#pragma unroll
        for (int vt = 0; vt < 4; ++vt)
#pragma unroll
            for (int r = 0; r < 4; ++r) ss += o[vt][r] * o[vt][r];
        ss += __shfl_xor(ss, 16); ss += __shfl_xor(ss, 32);
        if (fq == 0) red[F.wave * 16 + fr] = ss;
        LDS_WAIT(); __builtin_amdgcn_s_barrier(); asm volatile("" ::: "memory");
        const float tot = red[F.wave * 16 + fr] + red[(F.wave ^ 4) * 16 + fr];
        const float rstd = __builtin_amdgcn_rsqf(tot * (1.f / 128.f) + RMS_EPS);
#pragma unroll
        for (int vt = 0; vt < 4; ++vt) { const int v0 = (vh * 4 + vt) * 16 + fq * 4;
            const f32x4 g4 = ngw[vt]; const v2u sg = sgw[vt];
            v2u w; w.x = cvt_pk_bf16(o[vt][0] * rstd * g4[0] * bf_lo(sg.x), o[vt][1] * rstd * g4[1] * bf_hi(sg.x));
            w.y = cvt_pk_bf16(o[vt][2] * rstd * g4[2] * bf_lo(sg.y), o[vt][3] * rstd * g4[3] * bf_hi(sg.y));
            *(v2u*)(OAB + tok * 2048 + h * 128 + v0) = w; }
        LDS_WAIT(); __builtin_amdgcn_s_barrier(); asm volatile("" ::: "memory");
    }
#undef HGO_PREF
}

constexpr int S5_UT = 0, S5_UTP = 2064, S5_XST = 33024, S5_XSP = 272, S5_KM = 37376;
__device__ __forceinline__ void s5_load_ut(const Frame& F, const bf16* UB, int g, int jb) {
    v4u w0[2], w1[2];
#pragma unroll
    for (int i = 0; i < 2; ++i) { const int tl = F.tid + 512 * i; const v4u* src = (const v4u*)(UB + ((size_t)jb * 1024 + tl) * AW + g * 16); w0[i] = src[0]; w1[i] = src[1]; }
#pragma unroll
    for (int i = 0; i < 2; ++i) { const int tl = F.tid + 512 * i; LAS v4u* dst = (LAS v4u*)(F.lds + S5_UT + (tl >> 6) * S5_UTP + (tl & 63) * 32); dst[0] = w0[i]; dst[1] = w1[i]; }
}
__device__ __forceinline__ void phase_s5_local(const Frame& F0, int l) {
    Frame F = F0; F.tid = F.wave * 64 + lane_id(); asm volatile("" : "+v"(F.tid)); F.lane = F.tid & 63;
    unsigned char* ws = opqg(F.ws);
    const bf16* UB = (const bf16*)(ws + WS_UB); const bf16* PM = (const bf16*)(ws + WS_PM) + (size_t)l * 64 * 128 * 1024; float* XLOC = (float*)(ws + WS_XLOC);
    const int fr = F.lane & 15, fq = F.lane >> 4;
    for (int unit = F.vcu; unit < 64 * 8; unit += F.G) {
        const int g = unit >> 3, jb = unit & 7;
        const bf16* ap = PM + ((size_t)g * 128 + F.wave * 16 + fr) * 1024 + fq * 8;
        bf16x8 Af[32];
#pragma unroll
        for (int ks = 0; ks < 32; ++ks) Af[ks] = *(const bf16x8*)(ap + ks * 32);
        s5_load_ut(F, UB, g, jb);
        __syncthreads();
        f32x4 acc = (f32x4){0.f, 0.f, 0.f, 0.f};
        const LAS unsigned char* bp = F.lds + S5_UT + fr * S5_UTP + (fq >> 1) * 32 + (fq & 1) * 16;
#pragma unroll
        for (int ks = 0; ks < 32; ++ks) { const bf16x8 B = *(const LAS bf16x8*)(bp + ks * 64);
            acc = __builtin_amdgcn_mfma_f32_16x16x32_bf16(Af[ks], B, acc, 0, 0, 0); }
        *(f32x4*)(XLOC + ((size_t)(jb * 16 + fr) * 64 + g) * 128 + F.wave * 16 + fq * 4) = acc;
        __syncthreads();
    }
}
__device__ __forceinline__ void phase_s5_out(const Frame& F0, int l) {
    Frame F = F0; F.tid = F.wave * 64 + lane_id(); asm volatile("" : "+v"(F.tid)); F.lane = F.tid & 63;
    unsigned char* ws = opqg(F.ws);
    const bf16* UB = (const bf16*)(ws + WS_UB); const bf16* E = (const bf16*)(ws + WS_E) + (size_t)l * 64 * 1024 * 128; const bf16* KMAT = (const bf16*)(ws + WS_KMAT) + (size_t)l * 64 * 65 * 256;
    const float* XS = (const float*)(ws + WS_XS); bf16* YB = (bf16*)(ws + WS_YB);
    const int fr = F.lane & 15, fq = F.lane >> 4;
    for (int unit = F.vcu; unit < 64 * 8; unit += F.G) {
        const int g = unit >> 3, jb = unit & 7;
        { const int cc = F.tid >> 5, p0 = (F.tid & 31) * 4;
          const f32x4 xv = *(const f32x4*)(XS + ((size_t)(jb * 16 + cc) * 64 + g) * 128 + p0);
          v4u km[5];
#pragma unroll
          for (int k = 0; k < 5; ++k) { const int pc = F.tid + 512 * k; km[k] = (pc < 65 * 32) ? *(const v4u*)(KMAT + (size_t)g * 65 * 256 + (size_t)pc * 8) : (v4u){0u, 0u, 0u, 0u}; }
          s5_load_ut(F, UB, g, jb);
          v2u w; w.x = cvt_pk_bf16(xv[0], xv[1]); w.y = cvt_pk_bf16(xv[2], xv[3]); *(LAS v2u*)(F.lds + S5_XST + cc * S5_XSP + p0 * 2) = w;
#pragma unroll
          for (int k = 0; k < 5; ++k) { const int pc = F.tid + 512 * k; const int idx = pc >> 5, n = (pc >> 1) & 15, half = pc & 1;
              if (pc < 65 * 32) *(LAS v4u*)(F.lds + S5_KM + idx * 512 + n * 32 + ((half ^ (n >> 3)) * 16)) = km[k]; } }
        __syncthreads();
        for (int ti = 0; ti < 8; ++ti) {
            const int tau = ti * 8 + F.wave;
            const bf16* ep = E + ((size_t)g * 1024 + tau * 16 + fr) * 128 + fq * 8;
            bf16x8 Ae[4];
#pragma unroll
            for (int ke = 0; ke < 4; ++ke) Ae[ke] = *(const bf16x8*)(ep + ke * 32);
            f32x4 acc = (f32x4){0.f, 0.f, 0.f, 0.f}, acc1 = (f32x4){0.f, 0.f, 0.f, 0.f};
            const LAS unsigned char* bp = F.lds + S5_UT + fr * S5_UTP + (fq >> 1) * 32 + (fq & 1) * 16;
            const LAS unsigned char* kp = F.lds + S5_KM + (tau - (fq >> 1) + 1) * 512 + fr * 32 + (((fq & 1) ^ (fr >> 3)) * 16);
            const int nks = (tau >> 1) + 1;
            int ks = 0;
            for (; ks + 4 <= nks; ks += 4) {
                const bf16x8 A0 = *(const LAS bf16x8*)(kp - ks * 1024), A1 = *(const LAS bf16x8*)(kp - (ks + 1) * 1024), A2 = *(const LAS bf16x8*)(kp - (ks + 2) * 1024), A3 = *(const LAS bf16x8*)(kp - (ks + 3) * 1024);
                const bf16x8 B0 = *(const LAS bf16x8*)(bp + ks * 64), B1 = *(const LAS bf16x8*)(bp + (ks + 1) * 64), B2 = *(const LAS bf16x8*)(bp + (ks + 2) * 64), B3 = *(const LAS bf16x8*)(bp + (ks + 3) * 64);
                acc = __builtin_amdgcn_mfma_f32_16x16x32_bf16(A0, B0, acc, 0, 0, 0); acc1 = __builtin_amdgcn_mfma_f32_16x16x32_bf16(A1, B1, acc1, 0, 0, 0);
                acc = __builtin_amdgcn_mfma_f32_16x16x32_bf16(A2, B2, acc, 0, 0, 0); acc1 = __builtin_amdgcn_mfma_f32_16x16x32_bf16(A3, B3, acc1, 0, 0, 0); }
            for (; ks < nks; ++ks) { const bf16x8 A = *(const LAS bf16x8*)(kp - ks * 1024); const bf16x8 B = *(const LAS bf16x8*)(bp + ks * 64);
                acc = __builtin_amdgcn_mfma_f32_16x16x32_bf16(A, B, acc, 0, 0, 0); }
            const LAS unsigned char* xp = F.lds + S5_XST + fr * S5_XSP + fq * 16;
#pragma unroll
            for (int ke = 0; ke < 4; ke += 2) { const bf16x8 B0 = *(const LAS bf16x8*)(xp + ke * 64), B1 = *(const LAS bf16x8*)(xp + (ke + 1) * 64);
                acc = __builtin_amdgcn_mfma_f32_16x16x32_bf16(Ae[ke], B0, acc, 0, 0, 0); acc1 = __builtin_amdgcn_mfma_f32_16x16x32_bf16(Ae[ke + 1], B1, acc1, 0, 0, 0); }
            acc += acc1;
            v2u w; w.x = cvt_pk_bf16(gelu_tanh(acc[0]), gelu_tanh(acc[1])); w.y = cvt_pk_bf16(gelu_tanh(acc[2]), gelu_tanh(acc[3]));
            *(v2u*)(YB + ((size_t)(jb * 16 + fr) * 64 + tau) * AW + g * 16 + fq * 4) = w;
        }
        __syncthreads();
    }
}

__device__ __forceinline__ void phase_ln(const Frame& F0, int l, int which) {
    Frame F = F0; F.tid = F.wave * 64 + lane_id(); asm volatile("" : "+v"(F.tid)); F.lane = F.tid & 63;
    unsigned char* ws = opqg(F.ws); const __attribute__((address_space(4))) Args* a = opq(F.ka);
    const bf16* RS = (const bf16*)(ws + WS_RH); bf16* XS = (bf16*)(ws + WS_XH);
    const bool last = (which == 1 && l == DEPTH - 1); float* OUT = GP(float, a->out);
    const float* gam = GP(const float, a->in[which == 0 ? I_LN1G : I_LN2G]) + (size_t)l * D; const float* bet = GP(const float, a->in[which == 0 ? I_LN1B : I_LN2B]) + (size_t)l * D;
    const int gw = F.vcu * 8 + F.wave, NGW = F.G * 8;
    const int j = F.lane & 3, rr = (F.lane >> 2) & 1, sl = F.lane >> 3;
    LAS float* gamL = (LAS float*)(F.lds); LAS float* betL = gamL + D;
    ((LAS f32x4*)gamL)[F.tid] = ((const f32x4*)gam)[F.tid]; ((LAS f32x4*)betL)[F.tid] = ((const f32x4*)bet)[F.tid];
    __syncthreads();
    for (int rp = gw; rp < T / 2; rp += NGW) {
        const int row = 2 * rp + rr;
        const size_t eo = ((size_t)sl * T + row) * 32 + j * 8;
        v4u w[8];
#pragma unroll
        for (int i = 0; i < 8; ++i) w[i] = *(const v4u*)(RS + eo + (size_t)i * 8 * T * 32);
        float v[64]; float s = 0.f;
#pragma unroll
        for (int i = 0; i < 8; ++i) { const unsigned ww[4] = {w[i].x, w[i].y, w[i].z, w[i].w};
#pragma unroll
            for (int k = 0; k < 4; ++k) { const h2_t hv = __builtin_bit_cast(h2_t, ww[k]); v[8 * i + 2 * k] = (float)hv.x; v[8 * i + 2 * k + 1] = (float)hv.y; s += (float)hv.x + (float)hv.y; } }
        s += __shfl_xor(s, 1); s += __shfl_xor(s, 2); s += __shfl_xor(s, 8); s += __shfl_xor(s, 16); s += __shfl_xor(s, 32);
        const float mean = s * (1.f / D); float s2 = 0.f;
#pragma unroll
        for (int i = 0; i < 64; ++i) { v[i] -= mean; s2 += v[i] * v[i]; }
        s2 += __shfl_xor(s2, 1); s2 += __shfl_xor(s2, 2); s2 += __shfl_xor(s2, 8); s2 += __shfl_xor(s2, 16); s2 += __shfl_xor(s2, 32);
        const float rstd = __builtin_amdgcn_rsqf(s2 * (1.f / D) + LN_EPS);
        float amax = 0.f; int slv = sl; asm volatile("" : "+v"(slv));
#pragma unroll
        for (int i = 0; i < 8; ++i) { const int e0 = (8 * i + slv) * 32 + j * 8;
            const f32x4 g0 = *(const LAS f32x4*)(gamL + e0), g1 = *(const LAS f32x4*)(gamL + e0 + 4), b0 = *(const LAS f32x4*)(betL + e0), b1 = *(const LAS f32x4*)(betL + e0 + 4);
            const f32x4 y0 = (f32x4){v[8 * i], v[8 * i + 1], v[8 * i + 2], v[8 * i + 3]} * rstd * g0 + b0, y1 = (f32x4){v[8 * i + 4], v[8 * i + 5], v[8 * i + 6], v[8 * i + 7]} * rstd * g1 + b1;
            if (last) { *(f32x4*)(OUT + (size_t)row * D + e0) = y0; *(f32x4*)(OUT + (size_t)row * D + e0 + 4) = y1; }
            else { v4u o; o.x = cvt_pk_f16(y0[0], y0[1]); o.y = cvt_pk_f16(y0[2], y0[3]); o.z = cvt_pk_f16(y1[0], y1[1]); o.w = cvt_pk_f16(y1[2], y1[3]); *(v4u*)(XS + eo + (size_t)i * 8 * T * 32) = o; }
            if (!last) {
#pragma unroll
                for (int k = 0; k < 4; ++k) { v[8 * i + k] = y0[k]; v[8 * i + 4 + k] = y1[k]; amax = fmaxf(amax, fmaxf(fabsf(y0[k]), fabsf(y1[k]))); } } }
        if (!last) {
            amax = fmaxf(amax, __shfl_xor(amax, 1)); amax = fmaxf(amax, __shfl_xor(amax, 2)); amax = fmaxf(amax, __shfl_xor(amax, 8)); amax = fmaxf(amax, __shfl_xor(amax, 16)); amax = fmaxf(amax, __shfl_xor(amax, 32));
            const float inv = (amax > 0.f) ? 127.f / amax : 0.f;
            if (j == 0 && sl == 0) ((float*)(ws + WS_SX))[row] = (amax > 0.f) ? amax * (1.f / 127.f) : 1.f;
            unsigned char* xq = ws + WS_XQ + (size_t)row * 64 + (sl & 1) * 32 + j * 8;
#pragma unroll
            for (int i = 0; i < 8; ++i) { int q[8];
#pragma unroll
                for (int k = 0; k < 8; ++k) q[k] = (int)__builtin_rintf(v[8 * i + k] * inv);
                v2u o; o.x = (unsigned)(q[0] & 255) | ((unsigned)(q[1] & 255) << 8) | ((unsigned)(q[2] & 255) << 16) | ((unsigned)q[3] << 24);
                o.y = (unsigned)(q[4] & 255) | ((unsigned)(q[5] & 255) << 8) | ((unsigned)(q[6] & 255) << 16) | ((unsigned)q[7] << 24);
                *(v2u*)(xq + (size_t)(4 * i + (sl >> 1)) * T * 64) = o; } }
    }
    __syncthreads();
}

constexpr int PK_TV = 0, PK_EID = 65536, PK_GATE = 81920;
__device__ __forceinline__ int f2key(float x) { const int b = __float_as_int(x); return b ^ ((b >> 31) & 0x7fffffff); }
__device__ __forceinline__ float key2f(int k) { return __int_as_float(k ^ ((k >> 31) & 0x7fffffff)); }
__device__ __forceinline__ int imed3(int a, int b, int c) { int r; asm("v_med3_i32 %0, %1, %2, %3" : "=v"(r) : "v"(a), "v"(b), "v"(c)); return r; }
#define INSK(kx) do { const int _x = (kx); _Pragma("unroll") for (int _k = 15; _k > 0; --_k) tk[_k] = imed3(tk[_k - 1], tk[_k], _x); tk[0] = max(tk[0], _x); } while (0)
__device__ __forceinline__ void phase_topk(const Frame& F0, int l) {
    Frame F = F0; F.tid = F.wave * 64 + lane_id(); asm volatile("" : "+v"(F.tid)); F.lane = F.tid & 63;
    unsigned char* ws = opqg(F.ws);
    const float* SC = (const float*)(ws + WS_SC); int* SEID = (int*)(ws + WS_SEID); float* SGATE = (float*)(ws + WS_SGATE); unsigned char* START = ws + WS_START;
    LAS int* TK = (LAS int*)(F.lds + PK_TV); LAS int* EIDL = (LAS int*)(F.lds + PK_EID); LAS float* GATEL = (LAS float*)(F.lds + PK_GATE);
    for (int tb = F.vcu; tb < T / 32; tb += F.G) {
        const int t0 = tb * 32;
        { const int tok = F.tid >> 4, hh = F.tid & 15;
          const v4u* sp = (const v4u*)((const bf16*)SC + (size_t)(t0 + tok) * 2048 + hh * 128);
          int tk[16];
#pragma unroll
          for (int k = 0; k < 16; ++k) tk[k] = (int)0x80000000;
#pragma unroll 1
          for (int i4 = 0; i4 < 16; i4 += 4) { v4u sa[4];
#pragma unroll
              for (int i = 0; i < 4; ++i) sa[i] = sp[i4 + i];
#pragma unroll
              for (int i = 0; i < 4; ++i) { const v4u s0 = sa[i]; const unsigned sw[4] = {s0.x, s0.y, s0.z, s0.w}; const int ib = 127 - 8 * (i4 + i);
#pragma unroll
                  for (int x = 0; x < 4; ++x) { INSK((f2key(bf_lo(sw[x])) & ~127) | (ib - 2 * x)); INSK((f2key(bf_hi(sw[x])) & ~127) | (ib - 2 * x - 1)); } } }
#pragma unroll
          for (int k = 0; k < 16; ++k) TK[F.tid * 16 + k] = tk[k]; }
        __syncthreads();
        if ((F.tid & 1) == 0) {
            float v1[16], v2[16];
#pragma unroll
            for (int k = 0; k < 16; ++k) { v1[k] = key2f(TK[F.tid * 16 + k] & ~127); v2[k] = key2f(TK[(F.tid + 1) * 16 + k] & ~127); }
            int tk[16];
#pragma unroll
            for (int k = 0; k < 16; ++k) tk[k] = (int)0x80000000;
#pragma unroll
            for (int aa = 0; aa < 16; ++aa)
#pragma unroll
                for (int bb = 0; bb < 16; ++bb) if ((aa + 1) * (bb + 1) <= 16) { INSK((f2key(v1[aa] + v2[bb]) & ~255) | (255 - (aa * 16 + bb))); }
            float ex[16], sum = 0.f; const float v0 = key2f(tk[0] & ~255);
#pragma unroll
            for (int k = 0; k < 16; ++k) { ex[k] = expf(key2f(tk[k] & ~255) - v0); sum += ex[k]; }
            const float inv = 1.f / sum;
            const int tok = F.tid >> 4, hd = (F.tid >> 1) & 7;
#pragma unroll
            for (int k = 0; k < 16; ++k) { const int code = 255 - (tk[k] & 255);
                const int i1 = 127 - (TK[F.tid * 16 + (code >> 4)] & 127), i2 = 127 - (TK[(F.tid + 1) * 16 + (code & 15)] & 127);
                EIDL[tok * 128 + hd * 16 + k] = (((i1 + i2) & 15) << 10) + i1 * 8 + (i2 >> 4); GATEL[tok * 128 + hd * 16 + k] = ex[k] * inv; }
        }
        __syncthreads();
        for (int ti = 0; ti < 4; ++ti) {
            const int tok = F.wave * 4 + ti;
            int k0 = (EIDL[tok * 128 + F.lane] << 7) | F.lane, k1 = (EIDL[tok * 128 + 64 + F.lane] << 7) | (64 + F.lane);
#pragma unroll
            for (int k = 2; k <= 128; k <<= 1)
#pragma unroll
                for (int j = k >> 1; j > 0; j >>= 1) {
                    if (j == 64) { const int mn = min(k0, k1), mx = max(k0, k1); k0 = mn; k1 = mx; }
                    else { const int o0 = __shfl_xor(k0, j), o1 = __shfl_xor(k1, j); const bool lower = (F.lane & j) == 0;
                        const bool up0 = (F.lane & k) == 0, up1 = ((64 + F.lane) & k) == 0;
                        k0 = (up0 == lower) ? min(k0, o0) : max(k0, o0); k1 = (up1 == lower) ? min(k1, o1) : max(k1, o1); }
                }
            const size_t t = (size_t)(t0 + tok);
            { const int r0 = k0 >> 17, r1 = k1 >> 17; int mine = 0;
#pragma unroll
              for (int r = 1; r < 16; ++r) { const int c = __builtin_popcountll(__ballot(r0 < r)) + __builtin_popcountll(__ballot(r1 < r)); mine = (F.lane == r) ? c : mine; }
              if (F.lane < 16) START[t * 16 + F.lane] = (unsigned char)mine; }
            SEID[t * LP + F.lane] = k0 >> 7; SEID[t * LP + 64 + F.lane] = k1 >> 7;
            SGATE[t * 128 + F.lane] = GATEL[tok * 128 + (k0 & 127)]; SGATE[t * 128 + 64 + F.lane] = GATEL[tok * 128 + (k1 & 127)];
        }
        __syncthreads();
    }
}
typedef __bf16 bf2_t __attribute__((ext_vector_type(2)));
__device__ __forceinline__ float dot2bf(unsigned a, unsigned b, float c) { return __builtin_amdgcn_fdot2_f32_bf16(__builtin_bit_cast(bf2_t, a), __builtin_bit_cast(bf2_t, b), c, false); }
__device__ __forceinline__ void peer_stage(const Frame& F, const bf16* gsrc, int bo) {
#pragma unroll
    for (int i = 0; i < 8; ++i) { const int p = i * 8 + F.wave;
        __builtin_amdgcn_global_load_lds((const unsigned*)((const char*)gsrc + p * 1024 + F.lane * 16), (LAS unsigned*)(F.lds + bo + p * 1024), 16, 0, 0); }
}
__device__ __forceinline__ void peer_dma(const Frame& F, const void* gsrc, int bo) {
    const unsigned ldsbase = (unsigned)(size_t)(F.lds + bo) + (unsigned)F.wave * 1024u;
#pragma unroll
    for (int i = 0; i < 8; ++i) { const char* g = (const char*)gsrc + (i * 8 + F.wave) * 1024 + F.lane * 16; const unsigned m = ldsbase + i * 8192u;
        asm volatile("s_mov_b32 m0, %0\n\ts_nop 0\n\tglobal_load_lds_dwordx4 %1, off" :: "s"(m), "v"((GAS const char*)g) : "memory"); }
}
__device__ __forceinline__ int wave_max_i(int v) {
#pragma unroll
    for (int o = 1; o < 64; o <<= 1) v = max(v, __shfl_xor(v, o));
    return __builtin_amdgcn_readfirstlane(v);
}
template <int K> __device__ __forceinline__ unsigned dppq(unsigned v) { return (unsigned)__builtin_amdgcn_mov_dpp((int)v, K * 0x55, 0xf, 0xf, true); }
__device__ __forceinline__ int sdot4(unsigned a, unsigned b, int c) { return __builtin_amdgcn_sdot4((int)a, (int)b, c, false); }
__device__ __forceinline__ int quad_sum_i(int v) {
    v += __builtin_amdgcn_mov_dpp(v, 0xB1, 0xf, 0xf, true);
    v += __builtin_amdgcn_mov_dpp(v, 0x4E, 0xf, 0xf, true);
    return v;
}
__device__ __forceinline__ float quad_sum(float v) {
    v += __int_as_float(__builtin_amdgcn_mov_dpp(__float_as_int(v), 0xB1, 0xf, 0xf, true));
    v += __int_as_float(__builtin_amdgcn_mov_dpp(__float_as_int(v), 0x4E, 0xf, 0xf, true));
    return v;
}
constexpr int UCAP0 = 24, UCAP1 = 12, UCAP2 = 12, UCAP3 = 8;
__device__ __forceinline__ void phase_peer_u(const Frame& F0, int l) {
    Frame F = F0; F.tid = F.wave * 64 + lane_id(); asm volatile("" : "+v"(F.tid)); F.lane = F.tid & 63;
    unsigned char* ws = opqg(F.ws);
    const bf16* TU = (const bf16*)(ws + WS_TBU) + (size_t)l * 32 * NEXP * 32;
    const int* SEID = (const int*)(ws + WS_SEID); const float* SGATE = (const float*)(ws + WS_SGATE); unsigned* PACK = (unsigned*)(ws + WS_PACK); unsigned char* START = ws + WS_START;
    const bf16* XBS = (const bf16*)(ws + WS_XQ); unsigned* PACK2 = (unsigned*)(ws + WS_PACK2);
    const float* SX = (const float*)(ws + WS_SX); const float* SU = (const float*)(ws + WS_SU) + (size_t)l * NEXP;
    const int qd = F.lane >> 2, jc = F.lane & 3;
    for (int unit = F.vcu; unit < 256; unit += F.G) {
        const int tt = unit & 15, er = unit >> 4; const size_t t = (size_t)tt * 512 + F.tid;
        const int lo = START[t * 16 + er], hi = (er < 15) ? (int)START[t * 16 + er + 1] : 128;
        const int cnt = hi - lo;
        int key = (cnt << 6) | (63 - F.lane);
#pragma unroll
        for (int k = 2; k <= 64; k <<= 1)
#pragma unroll
            for (int j = k >> 1; j > 0; j >>= 1) { const int o = __shfl_xor(key, j); const bool lower = (F.lane & j) == 0, up = (F.lane & k) == 0;
                key = (up == lower) ? max(key, o) : min(key, o); }
        int tl[4], glo[4], gcnt[4], gmax[4];
#pragma unroll
        for (int a = 0; a < 4; ++a) { const int kk = __shfl(key, a * 16 + qd); tl[a] = 63 - (kk & 63); gcnt[a] = kk >> 6; glo[a] = __shfl(lo, tl[a]);
            gmax[a] = __builtin_amdgcn_readfirstlane(__shfl(key, a * 16)) >> 6; }
        const size_t tbase = (size_t)tt * 512 + F.wave * 64;
        unsigned ro0[UCAP0 / 4], ro1[UCAP1 / 4], ro2[UCAP2 / 4], ro3[UCAP3 / 4];
#define LOADRO(arr, a, CAP) _Pragma("unroll") for (int i = 0; i < CAP / 4; ++i) { const int s = 4 * i + jc; const int e = SEID[(tbase + tl[a]) * LP + glo[a] + s]; \
            const int row = (s < gcnt[a]) ? (e & 1023) : 0; arr[i] = (unsigned)((row << 6) + (((row >> 2) & 3) << 4)); }
        LOADRO(ro0, 0, UCAP0) LOADRO(ro1, 1, UCAP1) LOADRO(ro2, 2, UCAP2) LOADRO(ro3, 3, UCAP3)
#undef LOADRO
        int ac0[UCAP0], ac1[UCAP1], ac2[UCAP2], ac3[UCAP3];
#pragma unroll
        for (int s = 0; s < UCAP0; ++s) ac0[s] = 0;
#pragma unroll
        for (int s = 0; s < UCAP1; ++s) ac1[s] = 0;
#pragma unroll
        for (int s = 0; s < UCAP2; ++s) ac2[s] = 0;
#pragma unroll
        for (int s = 0; s < UCAP3; ++s) ac3[s] = 0;
        const bf16* gsl0 = TU + (size_t)er * 1024 * 32;
#define XA(a) ((const v4u*)(XBS + (tbase + tl[a]) * 32) + jc)
        v4u xs[4];
#pragma unroll
        for (int a = 0; a < 4; ++a) xs[a] = XA(a)[0];
        peer_dma(F, gsl0, 0);
        VM_WAIT(); __syncthreads();
#pragma unroll 1
        for (int ks = 0; ks < 32; ++ks) {
            const int bo = (ks & 1) * 65536, jx = jc << 4;
            v4u xn[4];
            const int kn = (ks + 1 < 32) ? ks + 1 : ks;
#pragma unroll
            for (int a = 0; a < 4; ++a) xn[a] = XA(a)[(size_t)kn * T * 4];
            if (ks + 1 < 32) peer_dma(F, gsl0 + (size_t)kn * NEXP * 32, bo ^ 65536);
#define URD(B, arr, g) { asm volatile("" : "+v"(arr[g])); B[0] = *(const LAS v4u*)(F.lds + bo + (dppq<0>(arr[g]) ^ jx)); B[1] = *(const LAS v4u*)(F.lds + bo + (dppq<1>(arr[g]) ^ jx)); \
                B[2] = *(const LAS v4u*)(F.lds + bo + (dppq<2>(arr[g]) ^ jx)); B[3] = *(const LAS v4u*)(F.lds + bo + (dppq<3>(arr[g]) ^ jx)); }
#define UCP(B, acc, a, g) { _Pragma("unroll") for (int q = 0; q < 4; ++q) { int p0 = acc[4 * (g) + q]; \
                p0 = sdot4(B[q].x, xs[a].x, p0); p0 = sdot4(B[q].y, xs[a].y, p0); p0 = sdot4(B[q].z, xs[a].z, p0); p0 = sdot4(B[q].w, xs[a].w, p0); acc[4 * (g) + q] = p0; } }
            { v4u BE[4], BO[4];
              URD(BE, ro0, 0) __builtin_amdgcn_sched_barrier(0);
              URD(BO, ro0, 1) UCP(BE, ac0, 0, 0)
              __builtin_amdgcn_sched_barrier(0);
              URD(BE, ro0, 2) UCP(BO, ac0, 0, 1)
              __builtin_amdgcn_sched_barrier(0);
              URD(BO, ro0, 3) UCP(BE, ac0, 0, 2)
              __builtin_amdgcn_sched_barrier(0);
              URD(BE, ro0, 4) UCP(BO, ac0, 0, 3)
              __builtin_amdgcn_sched_barrier(0);
              URD(BO, ro0, 5) UCP(BE, ac0, 0, 4)
              __builtin_amdgcn_sched_barrier(0);
              URD(BE, ro1, 0) UCP(BO, ac0, 0, 5)
              __builtin_amdgcn_sched_barrier(0);
              URD(BO, ro1, 1) UCP(BE, ac1, 1, 0)
              __builtin_amdgcn_sched_barrier(0);
              URD(BE, ro1, 2) UCP(BO, ac1, 1, 1)
              __builtin_amdgcn_sched_barrier(0);
              URD(BO, ro2, 0) UCP(BE, ac1, 1, 2)
              __builtin_amdgcn_sched_barrier(0);
              URD(BE, ro2, 1) UCP(BO, ac2, 2, 0)
              __builtin_amdgcn_sched_barrier(0);
              URD(BO, ro2, 2) UCP(BE, ac2, 2, 1)
              __builtin_amdgcn_sched_barrier(0);
              URD(BE, ro3, 0) UCP(BO, ac2, 2, 2)
              __builtin_amdgcn_sched_barrier(0);
              URD(BO, ro3, 1) UCP(BE, ac3, 3, 0)
              __builtin_amdgcn_sched_barrier(0);
              UCP(BO, ac3, 3, 1) }
#undef URD
#undef UCP
#pragma unroll
            for (int a = 0; a < 4; ++a) xs[a] = xn[a];
            VM_WAIT(); __syncthreads();
        }
        float gt0[UCAP0 / 4], gt1[UCAP1 / 4], gt2[UCAP2 / 4], gt3[UCAP3 / 4];
        float sq0[UCAP0 / 4], sq1[UCAP1 / 4], sq2[UCAP2 / 4], sq3[UCAP3 / 4];
#define UGT(gt, sq, arr, a, CAP) { const float* gp_ = SGATE + (tbase + tl[a]) * 128; const float sx_ = SX[tbase + tl[a]]; _Pragma("unroll") for (int i = 0; i < CAP / 4; ++i) { gt[i] = gp_[min(glo[a] + 4 * i + jc, 127)]; sq[i] = sx_ * SU[er * 1024 + (int)(arr[i] >> 6)]; } }
        UGT(gt0, sq0, ro0, 0, UCAP0) UGT(gt1, sq1, ro1, 1, UCAP1) UGT(gt2, sq2, ro2, 2, UCAP2) UGT(gt3, sq3, ro3, 3, UCAP3)
#undef UGT
#define UOUT(arr, acc, gt, sq, a, CAP) { const size_t tk = tbase + tl[a]; _Pragma("unroll") for (int s = 0; s < CAP; ++s) { const int toti = quad_sum_i(acc[s]); \
            if ((s & 3) == jc && s < NSLOT) { unsigned wv = 0u; if (s < gcnt[a]) { const float av = gelu_tanh((float)toti * sq[s >> 2]) * gt[s >> 2]; wv = ((arr[s >> 2] >> 6) << 20) | (cvt_pk_f16(av, 0.f) & 0xffffu); } \
                PACK2[(tk * 16 + er) * NSLOT + s] = wv; } } \
            _Pragma("unroll") for (int s = CAP; s < NSLOT; ++s) if ((s & 3) == jc && s >= gcnt[a]) PACK2[(tk * 16 + er) * NSLOT + s] = 0u; }
        UOUT(ro0, ac0, gt0, sq0, 0, UCAP0) UOUT(ro1, ac1, gt1, sq1, 1, UCAP1) UOUT(ro2, ac2, gt2, sq2, 2, UCAP2) UOUT(ro3, ac3, gt3, sq3, 3, UCAP3)
#undef UOUT
#undef XA
        { int myrank = 0; const int mykey = (cnt << 6) | (63 - F.lane);
          for (int p = 0; p < 64; ++p) myrank += (__shfl(key, p) > mykey) ? 1 : 0;
          const int cap = myrank < 16 ? UCAP0 : (myrank < 32 ? UCAP1 : (myrank < 48 ? UCAP2 : UCAP3));
          const v4u* xsp = (const v4u*)(XBS + t * 32);
          for (int s = cap; s < cnt; ++s) {
              const int pos = lo + s, e = SEID[t * LP + pos]; const int f = (e >> 2) & 3; int di = 0;
              for (int ks = 0; ks < 32; ++ks)
#pragma unroll
                  for (int j = 0; j < 4; ++j) { const v4u u4 = *(const v4u*)(TU + (((size_t)ks * NEXP + e) * 4 + (j ^ f)) * 8); const v4u x4 = xsp[(size_t)ks * T * 4 + j];
                      di = sdot4(u4.x, x4.x, di); di = sdot4(u4.y, x4.y, di); di = sdot4(u4.z, x4.z, di); di = sdot4(u4.w, x4.w, di); }
              const float d = (float)di * SX[t] * SU[e];
              const int row = e & 1023;
              const unsigned wv = ((unsigned)row << 20) | (cvt_pk_f16(gelu_tanh(d) * SGATE[t * 128 + pos], 0.f) & 0xffffu);
              if (s < NSLOT) PACK2[(t * 16 + er) * NSLOT + s] = wv; else PACK[t * LP + pos] = wv; }
        }
    }
}
#ifndef VBLK
#define VBLK 2
#endif
#if VBLK == 4
#define VTT(x, j) (4 * ((x) & 3) + ((j) & 3))
#define VDS(x, j, it) (32 * ((x) >> 2) + 8 * (it) + ((j) >> 2))
#elif VBLK == 8
#define VTT(x, j) (8 * ((x) & 1) + ((j) & 7))
#define VDS(x, j, it) (16 * ((x) >> 1) + 4 * (it) + ((j) >> 3))
#elif VBLK == 2
#define VTT(x, j) (2 * (x) + ((j) & 1))
#define VDS(x, j, it) (16 * (it) + ((j) >> 1))
#else
#define VTT(x, j) ((j) & 15)
#define VDS(x, j, it) (((x) * 32 + (j) + 256 * (it)) >> 4)
#endif
__device__ __forceinline__ void phase_peer_v(const Frame& F0, int l) {
    Frame F = F0; F.tid = F.wave * 64 + lane_id(); asm volatile("" : "+v"(F.tid)); F.lane = F.tid & 63;
    unsigned char* ws = opqg(F.ws);
    const bf16* TV = (const bf16*)(ws + WS_TBV) + (size_t)l * 64 * NEXP * 32; const bf16* XS = (const bf16*)(ws + WS_XH); bf16* RS = (bf16*)(ws + WS_RH);
    const unsigned* PACK = (const unsigned*)(ws + WS_PACK); const unsigned char* START = ws + WS_START; const unsigned* PACK2 = (const unsigned*)(ws + WS_PACK2);
    for (int it = 0; it * F.G + F.vcu < 1024; ++it) {
        int tt, ds;
        if (F.G == 256) { const int x = F.vcu >> 5, j = F.vcu & 31; tt = VTT(x, j); ds = VDS(x, j, it); }
        else { const int unit = it * F.G + F.vcu; tt = unit & 15; ds = unit >> 4; }
        const size_t t = (size_t)tt * 512 + F.tid;
        const v4u st4 = *(const v4u*)(START + t * 16);
        const unsigned stw[4] = {st4.x, st4.y, st4.z, st4.w};
        unsigned acc[16];
#pragma unroll
        for (int i = 0; i < 16; ++i) acc[i] = 0u;
        const bf16* gsl0 = TV + (size_t)ds * NEXP * 32;
        unsigned Lc[NSLOT];
        { const v4u* lp = (const v4u*)(PACK2 + t * 16 * NSLOT);
#pragma unroll
          for (int s = 0; s < NSLOT / 4; ++s) { const v4u q = lp[s]; Lc[4 * s] = q.x; Lc[4 * s + 1] = q.y; Lc[4 * s + 2] = q.z; Lc[4 * s + 3] = q.w; } }
        peer_dma(F, gsl0, 0);
        VM_WAIT(); __syncthreads();
#pragma unroll 1
        for (int c = 0; c < 16; ++c) {
            const int bo = (c & 1) * 65536;
            const int q0 = c >> 2, q1 = (c + 1) >> 2;
            const unsigned w0 = q0 == 0 ? stw[0] : (q0 == 1 ? stw[1] : (q0 == 2 ? stw[2] : stw[3])), w1 = q1 == 0 ? stw[0] : (q1 == 1 ? stw[1] : (q1 == 2 ? stw[2] : stw[3]));
            const int s_c = (int)((w0 >> ((c & 3) * 8)) & 255u);
            const int s_n = (c < 15) ? (int)((w1 >> (((c + 1) & 3) * 8)) & 255u) : 128;
            const int n_c = s_n - s_c;
            unsigned Ln[NSLOT];
            const int cn = (c < 15) ? c + 1 : c;
            { const v4u* lp = (const v4u*)(PACK2 + (t * 16 + cn) * NSLOT);
#pragma unroll
              for (int s = 0; s < NSLOT / 4; ++s) { const v4u q = lp[s]; Ln[4 * s] = q.x; Ln[4 * s + 1] = q.y; Ln[4 * s + 2] = q.z; Ln[4 * s + 3] = q.w; } }
            if (c < 15) peer_dma(F, gsl0 + (size_t)cn * 1024 * 32, bo ^ 65536);
            const int wmax = wave_max_i(min(n_c, NSLOT));
#pragma unroll
            for (int g = 0; g < NSLOT / 2; ++g) {
                if (2 * g < wmax) {
                    v4u v4[2][4]; unsigned a2[2];
#pragma unroll
                    for (int q = 0; q < 2; ++q) { const int s = 2 * g + q; const unsigned w = Lc[s];
                        a2[q] = w;
                        const int a0 = bo + (int)(w >> 16);
#pragma unroll
                        for (int j = 0; j < 4; ++j) v4[q][j] = *(const LAS v4u*)(F.lds + a0 + j * 16384); }
#pragma unroll
                    for (int q = 0; q < 2; ++q)
#pragma unroll
                        for (int j = 0; j < 4; ++j) {
                            acc[4 * j + 0] = pkfmab(v4[q][j].x, a2[q], acc[4 * j + 0]); acc[4 * j + 1] = pkfmab(v4[q][j].y, a2[q], acc[4 * j + 1]);
                            acc[4 * j + 2] = pkfmab(v4[q][j].z, a2[q], acc[4 * j + 2]); acc[4 * j + 3] = pkfmab(v4[q][j].w, a2[q], acc[4 * j + 3]); }
                }
            }
            for (int s = NSLOT; s < n_c; ++s) {
                const unsigned w = PACK[t * LP + s_c + s]; const unsigned a2 = w;
                const int a0 = bo + (int)(w >> 16);
#pragma unroll
                for (int j = 0; j < 4; ++j) { const v4u v4 = *(const LAS v4u*)(F.lds + a0 + j * 16384);
                    acc[4 * j + 0] = pkfmab(v4.x, a2, acc[4 * j + 0]); acc[4 * j + 1] = pkfmab(v4.y, a2, acc[4 * j + 1]);
                    acc[4 * j + 2] = pkfmab(v4.z, a2, acc[4 * j + 2]); acc[4 * j + 3] = pkfmab(v4.w, a2, acc[4 * j + 3]); }
            }
            VM_WAIT(); __syncthreads();
#pragma unroll
            for (int s = 0; s < NSLOT; ++s) Lc[s] = Ln[s];
        }
        const v4u* xp = (const v4u*)(XS + ((size_t)ds * T + t) * 32); v4u* rp = (v4u*)(RS + ((size_t)ds * T + t) * 32);
        v4u xw4[4];
#pragma unroll
        for (int j = 0; j < 4; ++j) xw4[j] = xp[j];
#pragma unroll
        for (int j = 0; j < 4; ++j) { const v4u xw = xw4[j]; const unsigned xx[4] = {xw.x, xw.y, xw.z, xw.w}; unsigned o[4];
#pragma unroll
            for (int k = 0; k < 4; ++k) { const h2_t xv = __builtin_bit_cast(h2_t, xx[k]), yv = __builtin_bit_cast(h2_t, acc[4 * j + k]);
                o[k] = cvt_pk_f16((float)xv.x * ALPHA + (float)yv.x, (float)xv.y * ALPHA + (float)yv.y); }
            rp[j] = (v4u){o[0], o[1], o[2], o[3]}; }
    }
}

constexpr int PH_PER_LAYER = 13, N_PHASES = 2 + DEPTH * PH_PER_LAYER;
__global__ void __launch_bounds__(512, 2) fwd_kernel(Args args) {
    extern __shared__ __attribute__((aligned(16))) unsigned char lds[];
    Frame F;
    F.lds = (LAS unsigned char*)lds;
    F.wave = __builtin_amdgcn_readfirstlane((int)threadIdx.x >> 6); F.tid = 0; F.lane = 0;
    F.G = gridDim.x; { const int bx = blockIdx.x; F.vcu = (F.G % 8 == 0) ? (bx % 8) * (F.G / 8) + bx / 8 : bx; }
    F.ws = args.ws; F.ka = (const __attribute__((address_space(4))) Args*)__builtin_amdgcn_kernarg_segment_ptr();
    unsigned char* ws = args.ws;
    for (int u = F.wave * 64 + lane_id(); u < (LDS_BYTES - LDSCTL_OFF) / 4; u += 512) ((LAS unsigned*)(F.lds + LDSCTL_OFF))[u] = 0u;
    __syncthreads();
    XcdBarrier bar; bar.bar = (unsigned*)(ws + WS_CTL) + CW_BAR; bar.x = 0; bar.st = nullptr;
    const int lo = args.ph_lo, hi = args.ph_hi;
    if (hi - lo > 1) bar = xcd_barrier_post((unsigned*)(ws + WS_CTL) + CW_BAR, (volatile LAS unsigned*)(F.lds + MISC_OFF) + 8, F.wave == 0 && lane_id() == 0);
#ifndef PHMASK
#define PHMASK 0xFFF
#endif
#define EN(i) ((PHMASK >> (i)) & 1)
#ifndef RPT
#define RPT 0
#endif
#define REP(i) for (int _r = 0; _r <= ((RPT >> (i)) & 1); ++_r)
#define IN(k) (lo <= (k) && (k) < hi)
#define SEAM(k) do { if (IN((k) + 1)) xcd_barrier(bar, F.wave); } while (0)

    if (EN(10) && IN(0)) { REP(13) { phase_prologue_a(F); } SEAM(0); }
    if (EN(11) && IN(1)) REP(14) {
        phase_prologue_b(F);
        unsigned char* ws = opqg(args.ws);
        quant_rows(F, (const bf16*)(ws + WS_WIN), 4096, NIN, 5120, ws + WS_WG8, (float*)(ws + WS_SWG));
        int kc = 256; asm volatile("" : "+s"(kc));
        pg8::Gemm g{(const bf16*)(ws + WS_BK), (const bf16*)(ws + WS_WQB), DEPTH * 2048, 2048, kc, 256, 2048, 256, (long)2048 * 2048};
        pg8::StaticOrder S; S.init(DEPTH * 2048, 2048, F.G, (int)blockIdx.x);
        pg8::EpiF16 E{(bf16*)(ws + WS_WPQ), 2048};
        pg8::gemm_phase<pg8::EpiF16, pg8::StaticOrder, true>(F.lds, g, S, E, F.wave);
        if (_r == ((RPT >> 14) & 1)) SEAM(1);
    }
    for (int l = 0; l < DEPTH; ++l) {
        const int pb = 2 + l * PH_PER_LAYER;
        if (EN(0) && IN(pb + 0)) REP(0) {
            unsigned char* ws = opqg(args.ws);
            pg8::Gemm g{(const bf16*)(ws + WS_XH), (const bf16*)(ws + WS_WIN) + (size_t)l * NIN * D, T, NIN, D, T, D, 0, 0};
            pg8::EpiIn E{(bf16*)(ws + WS_Q), (bf16*)(ws + WS_KK), (bf16*)(ws + WS_V), (bf16*)(ws + WS_SG), (bf16*)(ws + WS_UB), (bf16*)(ws + WS_GR), (bf16*)(ws + WS_GB),
                         (float*)(ws + WS_LOGF), (const float*)(ws + WS_LB) + l * AW};
            if (F.G == 256) {
                const int x = (int)blockIdx.x & 7, j = (int)blockIdx.x >> 3;
                pg8::ListOrder Sf{j < 16 ? 3 * j : 48 + 2 * (j - 16), j < 16 ? 3 : 2, x, 0};
                pg8::gemm_phase<pg8::EpiIn, pg8::ListOrder, true, true, true>(F.lds, g, Sf, E, F.wave);
                pg8::Gemm g8{(const bf16*)(ws + WS_XQ), (const bf16*)(ws + WS_WG8) + ((size_t)l * 4096 - 20 * 256) * 1024, T, NIN, 1024, T, 1024, 0, 0};
                pg8::ListOrder Si{j < 16 ? j : 16 + 3 * (j - 16), j < 16 ? 1 : 3, x, 20};
                pg8::EpiGate8 E8{(bf16*)(ws + WS_GR), (bf16*)(ws + WS_GB), (const float*)(ws + WS_SX), (const float*)(ws + WS_SWG) + l * 4096};
                pg8::gemm_phase<pg8::EpiGate8, pg8::ListOrder, true, false, true, true>(F.lds, g8, Si, E8, F.wave);
            } else {
                pg8::StaticOrder S; S.init(T, NIN, F.G, (int)blockIdx.x);
                pg8::gemm_phase<pg8::EpiIn, pg8::StaticOrder, true, true, true>(F.lds, g, S, E, F.wave);
            }
            if (_r == ((RPT >> 0) & 1)) SEAM(pb + 0);
        }
        if (EN(1) && IN(pb + 1)) { REP(1) { REP(17) { phase_hgrn_local(F, l); } REP(18) { phase_s5_local(F, l); } } if (l == 0) { unsigned char* ws = opqg(args.ws); quant_rows(F, (const bf16*)(ws + WS_WPQ), 2048, 2048, 0, ws + WS_WP8, (float*)(ws + WS_SW)); } SEAM(pb + 1); }
        if (EN(2) && IN(pb + 2)) { REP(2) { phase_scan(F, l); } SEAM(pb + 2); }
        if (EN(3) && IN(pb + 3)) { REP(3) { REP(15) { phase_hgrn_out(F, l); } REP(16) { phase_s5_out(F, l); } } SEAM(pb + 3); }
        if (EN(4) && IN(pb + 4)) REP(4) {
            unsigned char* ws = opqg(args.ws);
            pg8::Gemm g{(const bf16*)(ws + WS_YB), (const bf16*)(ws + WS_WGLU) + (size_t)l * 2048 * 1024, T, 2048, 1024, 1024, 1024, 0, 0};
            pg8::EpiGlu E{(bf16*)(ws + WS_OAB) + 1024, 2048};
            pg8::StaticOrder S; S.init(T, 2048, F.G, (int)blockIdx.x);
            pg8::gemm_phase<pg8::EpiGlu, pg8::StaticOrder, true>(F.lds, g, S, E, F.wave);
            if (_r == ((RPT >> 4) & 1)) SEAM(pb + 4);
        }
        if (EN(5) && IN(pb + 5)) REP(5) {
            unsigned char* ws = opqg(args.ws);
            pg8::Gemm g{(const bf16*)(ws + WS_OAB), (const bf16*)(ws + WS_WUP) + (size_t)l * 2048 * 2048, T, 2048, 2048, 2048, 2048, 0, 0};
            pg8::StaticOrder S; S.init(T, 2048, F.G, (int)blockIdx.x);
            pg8::EpiUp E{(bf16*)(ws + WS_MG), (const bf16*)(ws + WS_GR), (const bf16*)(ws + WS_GB)};
            pg8::gemm_phase<pg8::EpiUp, pg8::StaticOrder, true>(F.lds, g, S, E, F.wave);
            if (_r == ((RPT >> 5) & 1)) SEAM(pb + 5);
        }
        if (EN(6) && IN(pb + 6)) REP(6) {
            unsigned char* ws = opqg(args.ws);
            pg8::Gemm g{(const bf16*)(ws + WS_MG), (const bf16*)(ws + WS_WO) + (size_t)l * 2048 * 2048, T, 2048, 2048, 2048, 2048, 0, 0};
            pg8::StaticOrder S; S.init(T, 2048, F.G, (int)blockIdx.x);
            pg8::EpiResH E{(bf16*)(ws + WS_RH), (const bf16*)(ws + WS_XH)};
            pg8::gemm_phase<pg8::EpiResH, pg8::StaticOrder, true>(F.lds, g, S, E, F.wave);
            if (_r == ((RPT >> 6) & 1)) SEAM(pb + 6);
        }
        if (EN(7) && IN(pb + 7)) { REP(7) { phase_ln(F, l, 0); } SEAM(pb + 7); }
        if (EN(8) && IN(pb + 8)) REP(8) {
            unsigned char* ws = opqg(args.ws);
            pg8::Gemm g{(const bf16*)(ws + WS_XQ), (const bf16*)(ws + WS_WP8) + (size_t)l * 2048 * 1024, T, 2048, 1024, T, 1024, 0, 0};
            pg8::StaticOrder S; S.init(T, 2048, F.G, (int)blockIdx.x);
            pg8::EpiSc8 E{(bf16*)(ws + WS_SC), (const float*)(ws + WS_SX), (const float*)(ws + WS_SW) + l * 2048};
            pg8::gemm_phase<pg8::EpiSc8, pg8::StaticOrder, true, false, true, true>(F.lds, g, S, E, F.wave);
            if (_r == ((RPT >> 8) & 1)) SEAM(pb + 8);
        }
        if (EN(9) && IN(pb + 9)) { REP(9) { phase_topk(F, l); } SEAM(pb + 9); }
        if (EN(9) && IN(pb + 10)) { REP(10) { phase_peer_u(F, l); } SEAM(pb + 10); }
        if (EN(9) && IN(pb + 11)) { REP(11) { phase_peer_v(F, l); } SEAM(pb + 11); }
        if (EN(9) && IN(pb + 12)) { REP(12) { phase_ln(F, l, 1); } SEAM(pb + 12); }
    }
#undef IN
#undef SEAM
}

extern "C" void kernel_launch(void* const* d_in, const int* in_sizes, int n_in, void* d_out, int out_size, void* d_ws, size_t ws_size, hipStream_t stream) {
    static int grid = 0;
    if (grid == 0) {
        if (n_in != 24 || out_size != T * D || ws_size < WS_END) { fprintf(stderr, "kernel_launch: unexpected sizes (n_in %d out %d ws %zu need %zu)\n", n_in, out_size, ws_size, (size_t)WS_END); grid = -1; return; }
        int dev = 0, cus = 0, per_cu = 0;
        if (hipGetDevice(&dev) != hipSuccess || hipDeviceGetAttribute(&cus, hipDeviceAttributeMultiprocessorCount, dev) != hipSuccess) { grid = -1; return; }
        if (hipFuncSetAttribute((const void*)fwd_kernel, hipFuncAttributeMaxDynamicSharedMemorySize, LDS_BYTES) != hipSuccess) { fprintf(stderr, "kernel_launch: hipFuncSetAttribute failed\n"); grid = -1; return; }
        if (hipOccupancyMaxActiveBlocksPerMultiprocessor(&per_cu, (const void*)fwd_kernel, 512, LDS_BYTES) != hipSuccess || per_cu < 1)
            fprintf(stderr, "kernel_launch: occupancy query reports %d\n", per_cu);
        (void)hipGetLastError();
        grid = cus;
    }
    if (grid < 0) return;
    if (hipMemsetAsync((char*)d_ws + WS_CTL, 0, CTL_ZERO_BYTES, stream) != hipSuccess) return;
    Args a{};
    for (int i = 0; i < 24; ++i) a.in[i] = (const float*)d_in[i];
    a.out = (float*)d_out; a.ws = (unsigned char*)d_ws;
#if ONE_LAUNCH
    a.ph_lo = 0; a.ph_hi = N_PHASES;
    hipLaunchKernelGGL(fwd_kernel, dim3(grid), dim3(512), LDS_BYTES, stream, a);
#else
    for (int p = 0; p < N_PHASES; ++p) { a.ph_lo = p; a.ph_hi = p + 1; hipLaunchKernelGGL(fwd_kernel, dim3(grid), dim3(512), LDS_BYTES, stream, a); }
#endif
}
```

```cpp
#include <hip/hip_runtime.h>
#include <cstdio>
#include <cstdint>

#define LAS __attribute__((address_space(3)))
#define GAS __attribute__((address_space(1)))
typedef unsigned short bf16;
typedef unsigned v4u __attribute__((ext_vector_type(4)));
typedef unsigned v2u __attribute__((ext_vector_type(2)));
typedef float f32x4 __attribute__((ext_vector_type(4)));
typedef float f32x2 __attribute__((ext_vector_type(2)));
typedef short bf16x8 __attribute__((ext_vector_type(8)));
typedef short s16x4 __attribute__((ext_vector_type(4)));

#ifndef ONE_LAUNCH
#define ONE_LAUNCH 1
#endif

constexpr int T = 8192, D = 2048, DEPTH = 4, NIN = 9216;
constexpr int AW = 1024;
constexpr int NCH = 128;
constexpr float ALPHA = 1.6817928305074290f;
constexpr float LN_EPS = 1e-5f, RMS_EPS = 1e-6f;
constexpr int NEXP = 16384;
constexpr int LP = 160;
constexpr int NSLOT = 24;

constexpr size_t MiB = 1u << 20;
constexpr size_t WS_CTL = 0, CTL_ZERO_BYTES = 32768;
constexpr size_t WS_WIN  = 1 * MiB;
constexpr size_t WS_WGLU = WS_WIN + 144 * MiB;
constexpr size_t WS_WUP  = WS_WGLU + 16 * MiB;
constexpr size_t WS_WO   = WS_WUP + 32 * MiB;
constexpr size_t WS_WQB  = WS_WO + 32 * MiB;
constexpr size_t WS_BK   = WS_WQB + 32 * MiB;
constexpr size_t WS_WPQ  = WS_BK + 4 * MiB;
constexpr size_t WS_LB   = WS_WPQ + 32 * MiB;
constexpr size_t WS_APOW = WS_LB + 1 * MiB;
constexpr size_t WS_BB   = WS_APOW + 9 * MiB;
constexpr size_t WS_KMAT = WS_BB + 2 * MiB;
constexpr size_t WS_PM   = WS_KMAT + 9 * MiB;
constexpr size_t WS_E    = WS_PM + 64 * MiB;
constexpr size_t WS_X32  = WS_E + 64 * MiB;
constexpr size_t WS_X1   = WS_X32 + 64 * MiB;
constexpr size_t WS_XB   = WS_X1 + 64 * MiB;
constexpr size_t WS_Q    = WS_XB + 32 * MiB;
constexpr size_t WS_KK   = WS_Q + 16 * MiB;
constexpr size_t WS_V    = WS_KK + 16 * MiB;
constexpr size_t WS_SG   = WS_V + 16 * MiB;
constexpr size_t WS_UB   = WS_SG + 16 * MiB;
constexpr size_t WS_LOGF = WS_UB + 16 * MiB;
constexpr size_t WS_GR   = WS_LOGF + 32 * MiB;
constexpr size_t WS_GB   = WS_GR + 32 * MiB;
constexpr size_t WS_U    = WS_GB + 32 * MiB;
constexpr size_t WS_SP   = WS_U + 64 * MiB;
constexpr size_t WS_BL   = WS_SP + 32 * MiB;
constexpr size_t WS_XLOC = WS_BL + 1 * MiB;
constexpr size_t WS_XS   = WS_XLOC + 4 * MiB;
constexpr size_t WS_OAB  = WS_XS + 4 * MiB;
constexpr size_t WS_YB   = WS_OAB + 32 * MiB;
constexpr size_t WS_MG   = WS_YB + 16 * MiB;
constexpr size_t WS_R    = WS_MG + 32 * MiB;
constexpr size_t WS_SC   = WS_R + 64 * MiB;
constexpr size_t WS_TBU  = WS_SC + 64 * MiB;
constexpr size_t WS_TBV  = WS_TBU + 256 * MiB;
constexpr size_t WS_SEID = WS_TBV + 256 * MiB;
constexpr size_t WS_SGATE= WS_SEID + 6 * MiB;
constexpr size_t WS_PACK = WS_SGATE + 4 * MiB;
constexpr size_t WS_START= WS_PACK + 6 * MiB;
constexpr size_t WS_PACK2= WS_START + 1 * MiB;
constexpr size_t WS_XBS  = WS_PACK2 + 13 * MiB;
constexpr size_t WS_END  = WS_XBS + 32 * MiB;
constexpr size_t WS_XH = WS_XBS;
constexpr size_t WS_XQ = WS_X1;
constexpr size_t WS_SX = WS_X1 + 16 * MiB;
constexpr size_t WS_SU = WS_X1 + 17 * MiB;
constexpr size_t WS_SW = WS_X1 + 18 * MiB;
constexpr size_t WS_WP8 = WS_WQB;
constexpr size_t WS_WG8 = WS_TBU + 128 * MiB;
constexpr size_t WS_SWG = WS_X1 + 19 * MiB;
constexpr size_t WS_RH = WS_R;

constexpr int CW_TMO = 0, CW_CODE = 1;
constexpr int CW_BAR = 4096;

constexpr int RING_BYTES = 131072;
constexpr int LDSCTL_OFF = RING_BYTES, MISC_OFF = LDSCTL_OFF + 320;
constexpr int LDS_BYTES = 147456;

#define LDS_WAIT() asm volatile("s_waitcnt lgkmcnt(0)" ::: "memory")
#define VM_WAIT() asm volatile("s_waitcnt vmcnt(0)" ::: "memory")
__device__ __forceinline__ unsigned cvt_pk_bf16(float lo, float hi) { unsigned r; asm volatile("v_cvt_pk_bf16_f32 %0, %1, %2" : "=v"(r) : "v"(lo), "v"(hi)); return r; }
typedef _Float16 h2_t __attribute__((ext_vector_type(2)));
__device__ __forceinline__ unsigned cvt_pk_f16a(float lo, float hi) { unsigned r; asm volatile("v_cvt_pk_f16_f32 %0, %1, %2" : "=v"(r) : "v"(lo), "v"(hi)); return r; }
__device__ __forceinline__ unsigned cvt_pk_f16(float lo, float hi) { h2_t p; p.x = (_Float16)lo; p.y = (_Float16)hi; return __builtin_bit_cast(unsigned, p); }
__device__ __forceinline__ float dot2h(unsigned a, unsigned b, float c) { return __builtin_amdgcn_fdot2(__builtin_bit_cast(h2_t, a), __builtin_bit_cast(h2_t, b), c, false); }
__device__ __forceinline__ unsigned pkfmab(unsigned a, unsigned w, unsigned c) { const h2_t wv = __builtin_bit_cast(h2_t, w); const h2_t b = {wv.x, wv.x};
    return __builtin_bit_cast(unsigned, __builtin_elementwise_fma(__builtin_bit_cast(h2_t, a), b, __builtin_bit_cast(h2_t, c))); }
__device__ __forceinline__ unsigned pkfmah(unsigned a, unsigned b, unsigned c) { return __builtin_bit_cast(unsigned, __builtin_elementwise_fma(__builtin_bit_cast(h2_t, a), __builtin_bit_cast(h2_t, b), __builtin_bit_cast(h2_t, c))); }
__device__ __forceinline__ float bf_lo(unsigned u) { return __uint_as_float(u << 16); }
__device__ __forceinline__ float bf_hi(unsigned u) { return __uint_as_float(u & 0xffff0000u); }
__device__ __forceinline__ float bf2f(bf16 b) { return __uint_as_float(((unsigned)b) << 16); }
__device__ __forceinline__ bf16 f2bf(float f) { return (bf16)(cvt_pk_bf16(f, 0.f) & 0xffffu); }
__device__ __forceinline__ float fexp(float x) { return __builtin_amdgcn_exp2f(x * 1.4426950408889634f); }
__device__ __forceinline__ float flog(float x) { return __builtin_amdgcn_logf(x) * 0.6931471805599453f; }
__device__ __forceinline__ float frcp(float x) { return __builtin_amdgcn_rcpf(x); }
__device__ __forceinline__ float gelu_tanh(float x) {
    const float u = 1.5957691216057308f * (x + 0.044715f * x * x * x);
    const float uc = fminf(fmaxf(u, -60.f), 60.f);
    return x * frcp(1.f + fexp(-uc));
}
__device__ __forceinline__ int lane_id() { int r; asm volatile("v_mbcnt_lo_u32_b32 %0, -1, 0\n\tv_mbcnt_hi_u32_b32 %0, -1, %0" : "=v"(r)); return r; }
__device__ __forceinline__ float wave_sum(float v) {
#pragma unroll
    for (int o = 1; o < 64; o <<= 1) v += __shfl_xor(v, o);
    return v;
}

__device__ __forceinline__ void vlaunder(int& a, int& b) { asm volatile("" : "+v"(a), "+v"(b)); }
template <class P> __device__ __forceinline__ P* opq(P* p) { asm volatile("" : "+s"(p)); return p; }
__device__ __forceinline__ unsigned char* opqg(unsigned char* p) { GAS unsigned char* g = (GAS unsigned char*)p; asm volatile("" : "+s"(g)); return (unsigned char*)g; }
#define GP(T, p) ((T*)(GAS T*)(p))

namespace pg8 {
#define PG8_LAS __attribute__((address_space(3)))
typedef unsigned short bf16_t;
constexpr int BM = 256, BK = 64, HALF = 128, HTB = HALF * BK * 2, STAGE_BYTES = 8 * HTB, NXCD = 8, WGM = 8;

__host__ __device__ __forceinline__ int lds_byte(int r, int c) { const int st = (r >> 4) * 2 + (c >> 5), rr = r & 15, cc = c & 31, ob = rr * 64 + cc * 2; return st * 1024 + (ob ^ (((ob >> 9) & 1) << 5)); }
__host__ __device__ __forceinline__ void stage_rc(int b, int& R, int& C) { const int st = b / 1024, sb = b % 1024, swz = sb ^ (((sb >> 9) & 1) << 5); R = (st >> 1) * 16 + swz / 64; C = (st & 1) * 32 + (swz % 64) / 2; }
__host__ __device__ __forceinline__ int perm32(int rho) { const int n = rho >> 4, i = rho & 15; return 8 * (i >> 2) + 4 * n + (i & 3); }

struct Unit { int pm, pn; };
struct Gemm { const bf16_t* A; const bf16_t* Bt; int M, N, K, lda, ldb, bkoff; long blstride; };

struct StaticOrder {
    int nM, nN, nwg, G, c;
    __host__ __device__ void init(int M, int N, int G_, int c_) { nM = M / BM; nN = N / BM; nwg = nM * nN; G = G_; c = c_; }
    __host__ __device__ bool next(int i, Unit& u) const {
        const long L = (long)i * G + c; if (L >= nwg) return false;
        int wgid = (int)L; { const int q = nwg / NXCD, r = nwg % NXCD, xcd = wgid % NXCD, off = wgid / NXCD; wgid = (xcd < r ? xcd * (q + 1) : r * (q + 1) + (xcd - r) * q) + off; }
        const int nig = WGM * nN, gid = wgid / nig, fm = gid * WGM, gsz = (nM - fm) < WGM ? (nM - fm) : WGM;
        u.pm = fm + ((wgid % nig) % gsz); u.pn = (wgid % nig) / gsz; return true;
    }
    __device__ __forceinline__ void a_ready(const Unit&) const {}
    __device__ __forceinline__ void done(const Unit&) const {}
};

struct OffOrder {
    StaticOrder b; int pn0;
    __device__ void init(int M, int N, int G_, int c_, int pn0_) { b.init(M, N, G_, c_); pn0 = pn0_; }
    __device__ bool next(int i, Unit& u) const { if (!b.next(i, u)) return false; u.pn += pn0; return true; }
    __device__ __forceinline__ void a_ready(const Unit&) const {}
    __device__ __forceinline__ void done(const Unit&) const {}
};
struct ListOrder {
    int base, cnt, x, pn0, hole;
    __device__ bool next(int i, Unit& u) const { if (i >= cnt) return false; const int id = base + i; u.pm = 4 * x + (id & 3); int t = pn0 + (id >> 2); if (hole && t >= 4) t += 4; u.pn = t; return true; }
    __device__ __forceinline__ void a_ready(const Unit&) const {}
    __device__ __forceinline__ void done(const Unit&) const {}
};
struct PairOrder {
    int c, c0, nN, nwg;
    __device__ bool next(int i, Unit& u) const { if (c < c0 || i >= 2) return false; const int id = (c - c0) * 2 + i; if (id >= nwg) return false; u.pm = id / nN; u.pn = id % nN; return true; }
    __device__ __forceinline__ void a_ready(const Unit&) const {}
    __device__ __forceinline__ void done(const Unit&) const {}
};
typedef f32x4 Acc[2][2][4][2];

typedef _Float16 f16x8 __attribute__((ext_vector_type(8)));
typedef int i32x4 __attribute__((ext_vector_type(4)));
template <class Epi, class Sched, bool ALIGN_EPI = false, bool F16 = false, bool ASL = false, bool I8 = false>
__device__ __forceinline__ void gemm_phase(PG8_LAS unsigned char* lds, const Gemm g, const Sched& S, const Epi& E, int wv) {
    int tid_ = wv * 64 + lane_id(); asm volatile("" : "+v"(tid_));
    const int tid = tid_, wid = __builtin_amdgcn_readfirstlane(tid >> 6), lane = tid & 63, wr = wid >> 2, wc = wid & 3, fr = lane & 15, fq = lane >> 4;
    const int K = g.K, nt = K / BK;
    unsigned voffA[2], voffB[2];
#pragma unroll
    for (int i = 0; i < 2; ++i) { int R, C; stage_rc(tid * 16 + i * 8192, R, C); const int Rb = Epi::PERM ? ((R & ~31) + perm32(R & 31)) : R;
        voffA[i] = ASL ? (unsigned)(((C >> 5) * g.lda + R) * 64 + (C & 31) * 2) : (unsigned)(R * g.lda + C) * 2u; voffB[i] = (unsigned)(Rb * g.ldb + C) * 2u; }
    const size_t kstep = (size_t)(BK * 2), kstepA = ASL ? (size_t)g.lda * 128 : (size_t)(BK * 2);
    const size_t hstepA = ASL ? (size_t)HALF * 64 : (size_t)HALF * g.lda * 2, hstepB = (size_t)HALF * g.ldb * 2;
    const size_t tstepA = 2 * hstepA, tstepB = 2 * hstepB;
    const unsigned ldsw = (unsigned)wid * 1024u;
    const int aoff = lds_byte(wr * 64 + fr, fq * 8), boff = lds_byte(wc * 32 + fr, fq * 8);
#define PG8_SA(b, h) (((b) * 2 + (h)) * HTB)
#define PG8_SB(b, h) ((4 + (b) * 2 + (h)) * HTB)
#define PG8_STAGE(bufoff, gbase, voff) do { _Pragma("unroll") for (int _i = 0; _i < 2; ++_i) \
        __builtin_amdgcn_global_load_lds((const unsigned*)((const char*)(gbase) + (voff)[_i]), (PG8_LAS unsigned*)(lds + (bufoff) + ldsw + _i * 8192), 16, 0, 0); } while (0)
#define PG8_LDA(dst, b, h) do { _Pragma("unroll") for (int m = 0; m < 4; ++m) _Pragma("unroll") for (int k = 0; k < 2; ++k) dst[m][k] = *(const PG8_LAS bf16x8*)(lds + PG8_SA(b, h) + aoff + m * 2048 + k * 1024); } while (0)
#define PG8_LDB(dst, b, h) do { _Pragma("unroll") for (int n = 0; n < 2; ++n) _Pragma("unroll") for (int k = 0; k < 2; ++k) dst[n][k] = *(const PG8_LAS bf16x8*)(lds + PG8_SB(b, h) + boff + n * 2048 + k * 1024); } while (0)
#define PG8_MMA(ai, bj, At, Bt) do { __builtin_amdgcn_s_setprio(1); _Pragma("unroll") for (int m = 0; m < 4; ++m) _Pragma("unroll") for (int n = 0; n < 2; ++n) _Pragma("unroll") for (int k = 0; k < 2; ++k) \
        { if constexpr (I8) acc[ai][bj][m][n] = __builtin_bit_cast(f32x4, __builtin_amdgcn_mfma_i32_16x16x64_i8(__builtin_bit_cast(i32x4, Bt[n][k]), __builtin_bit_cast(i32x4, At[m][k]), __builtin_bit_cast(i32x4, acc[ai][bj][m][n]), 0, 0, 0)); \
          else if constexpr (F16) acc[ai][bj][m][n] = __builtin_amdgcn_mfma_f32_16x16x32_f16(__builtin_bit_cast(f16x8, Bt[n][k]), __builtin_bit_cast(f16x8, At[m][k]), acc[ai][bj][m][n], 0, 0, 0); \
          else acc[ai][bj][m][n] = __builtin_amdgcn_mfma_f32_16x16x32_bf16(Bt[n][k], At[m][k], acc[ai][bj][m][n], 0, 0, 0); } __builtin_amdgcn_s_setprio(0); } while (0)
#define PG8_WAIT_V(n) asm volatile("s_waitcnt vmcnt(" #n ")" ::: "memory")
#define PG8_WAIT_L(n) asm volatile("s_waitcnt lgkmcnt(" #n ")" ::: "memory")
#define PG8_BAR __builtin_amdgcn_s_barrier()
#define PG8_SCHED __builtin_amdgcn_sched_barrier(0)
    Unit cur, nxt; int ui = 0;
    if (!S.next(0, cur)) return;
    Acc acc;
#pragma unroll
    for (int a = 0; a < 2; ++a)
#pragma unroll
        for (int b = 0; b < 2; ++b)
#pragma unroll
            for (int m = 0; m < 4; ++m)
#pragma unroll
                for (int n = 0; n < 2; ++n) acc[a][b][m][n] = (f32x4){0.f, 0.f, 0.f, 0.f};
    bf16x8 At[4][2], B0[2][2], B1[2][2];
    const char* cA = (const char*)g.A + (size_t)cur.pm * tstepA;
    const char* cB = (const char*)g.Bt + (size_t)cur.pn * tstepB + ((size_t)(cur.pm & 7) * g.bkoff + (size_t)(cur.pm >> 3) * g.blstride) * 2;
    S.a_ready(cur);
    PG8_STAGE(PG8_SB(0, 0), cB, voffB); PG8_STAGE(PG8_SB(0, 1), cB + hstepB, voffB); PG8_STAGE(PG8_SA(0, 0), cA, voffA); PG8_STAGE(PG8_SA(0, 1), cA + hstepA, voffA);
    if (wr == 1) PG8_BAR;
    PG8_WAIT_V(2); PG8_BAR;
    PG8_STAGE(PG8_SB(1, 0), cB + kstep, voffB); PG8_STAGE(PG8_SA(1, 0), cA + kstepA, voffA); PG8_STAGE(PG8_SB(1, 1), cB + hstepB + kstep, voffB);
    PG8_WAIT_V(6); PG8_BAR;
    for (;;) {
        const bool has_next = S.next(ui + 1, nxt);
        const char* nA = has_next ? (const char*)g.A + (size_t)nxt.pm * tstepA : cA;
        const char* nB = has_next ? (const char*)g.Bt + (size_t)nxt.pn * tstepB + ((size_t)(nxt.pm & 7) * g.bkoff + (size_t)(nxt.pm >> 3) * g.blstride) * 2 : cB;
        for (int t = 0; t < nt; t += 2) {
            const bool last = (t == nt - 2);
            const char* a1 = cA + (size_t)(t + 1) * kstepA;
            const char* a2 = last ? nA : cA + (size_t)(t + 2) * kstepA; const char* b2 = last ? nB : cB + (size_t)(t + 2) * kstep;
            const char* a3 = a2 + kstepA; const char* b3 = b2 + kstep;
            if (last && has_next) S.a_ready(nxt);
            PG8_LDB(B0, 0, 0); PG8_LDB(B1, 0, 1); PG8_SCHED; PG8_LDA(At, 0, 0); PG8_STAGE(PG8_SA(1, 1), a1 + hstepA, voffA);
            PG8_WAIT_V(8); PG8_WAIT_L(0); PG8_BAR; PG8_MMA(0, 0, At, B0); PG8_MMA(0, 1, At, B1); PG8_BAR; PG8_SCHED;
            PG8_LDA(At, 0, 1); PG8_STAGE(PG8_SB(0, 0), b2, voffB); PG8_STAGE(PG8_SB(0, 1), b2 + hstepB, voffB); PG8_STAGE(PG8_SA(0, 0), a2, voffA);
            PG8_WAIT_V(8); PG8_WAIT_L(0); PG8_BAR; PG8_MMA(1, 0, At, B0); PG8_MMA(1, 1, At, B1); PG8_BAR; PG8_SCHED;
            PG8_LDB(B0, 1, 0); PG8_LDB(B1, 1, 1); PG8_SCHED; PG8_LDA(At, 1, 0); PG8_STAGE(PG8_SA(0, 1), a2 + hstepA, voffA);
            PG8_WAIT_V(8); PG8_WAIT_L(0); PG8_BAR; PG8_MMA(0, 0, At, B0); PG8_MMA(0, 1, At, B1); PG8_BAR; PG8_SCHED;
            PG8_LDA(At, 1, 1); PG8_STAGE(PG8_SB(1, 0), b3, voffB); PG8_STAGE(PG8_SB(1, 1), b3 + hstepB, voffB); PG8_STAGE(PG8_SA(1, 0), a3, voffA);
            PG8_WAIT_V(8); PG8_WAIT_L(0); PG8_BAR; PG8_MMA(1, 0, At, B0); PG8_MMA(1, 1, At, B1); PG8_BAR; PG8_SCHED;
            if constexpr (Epi::HAS_MID) { if (t + 2 == (nt >> 1)) E.mid(acc, cur, wr, wc, fr, fq); }
        }
        if constexpr (ALIGN_EPI) { if (wr == 0) PG8_BAR; }
        E(acc, cur, wr, wc, fr, fq); S.done(cur);
        if (!has_next) break;
#pragma unroll
        for (int a = 0; a < 2; ++a)
#pragma unroll
            for (int b = 0; b < 2; ++b)
#pragma unroll
                for (int m = 0; m < 4; ++m)
#pragma unroll
                    for (int n = 0; n < 2; ++n) acc[a][b][m][n] = (f32x4){0.f, 0.f, 0.f, 0.f};
        cur = nxt; cA = nA; cB = nB; ++ui;
        if constexpr (ALIGN_EPI) { if (wr == 1) PG8_BAR; }
    }
    PG8_WAIT_V(0);
    if constexpr (!ALIGN_EPI) { if (wr == 0) PG8_BAR; }
    PG8_BAR;
#undef PG8_SA
#undef PG8_SB
#undef PG8_STAGE
#undef PG8_LDA
#undef PG8_LDB
#undef PG8_MMA
#undef PG8_WAIT_V
#undef PG8_WAIT_L
#undef PG8_BAR
#undef PG8_SCHED
}

struct EpiResH {
    static constexpr bool PERM = true, HAS_MID = false;
    bf16_t* RS; const bf16_t* XS;
    __device__ __forceinline__ void operator()(const Acc& acc, const Unit& u, int wr, int wc, int fr, int fq) const {
        vlaunder(fr, fq);
        const int row0 = u.pm * BM + wr * 64 + fr, sl0 = u.pn * 8 + wc;
#pragma unroll
        for (int ai = 0; ai < 2; ++ai) {
            v4u xw[4][2];
#pragma unroll
            for (int m = 0; m < 4; ++m)
#pragma unroll
                for (int bj = 0; bj < 2; ++bj) xw[m][bj] = *(const v4u*)(XS + ((size_t)(sl0 + bj * 4) * T + (row0 + ai * HALF + m * 16)) * 32 + 8 * fq);
#pragma unroll
            for (int m = 0; m < 4; ++m) {
#pragma unroll
                for (int bj = 0; bj < 2; ++bj) { const size_t eo = ((size_t)(sl0 + bj * 4) * T + (row0 + ai * HALF + m * 16)) * 32 + 8 * fq;
                    const f32x4 v0 = acc[ai][bj][m][0], v1 = acc[ai][bj][m][1];
                    const unsigned a0 = xw[m][bj].x, a1 = xw[m][bj].y, a2 = xw[m][bj].z, a3 = xw[m][bj].w;
                    const h2_t x0 = __builtin_bit_cast(h2_t, a0), x1 = __builtin_bit_cast(h2_t, a1), x2 = __builtin_bit_cast(h2_t, a2), x3 = __builtin_bit_cast(h2_t, a3);
                    v4u w; w.x = cvt_pk_f16a(v0[0] + ALPHA * (float)x0.x, v0[1] + ALPHA * (float)x0.y); w.y = cvt_pk_f16a(v0[2] + ALPHA * (float)x1.x, v0[3] + ALPHA * (float)x1.y);
                    w.z = cvt_pk_f16a(v1[0] + ALPHA * (float)x2.x, v1[1] + ALPHA * (float)x2.y); w.w = cvt_pk_f16a(v1[2] + ALPHA * (float)x3.x, v1[3] + ALPHA * (float)x3.y);
                    *(v4u*)(RS + eo) = w; } }
        }
    }
};
struct EpiF16 {
    static constexpr bool PERM = true, HAS_MID = false;
    bf16_t* O; int ldc;
    __device__ __forceinline__ void operator()(const Acc& acc, const Unit& u, int wr, int wc, int fr, int fq) const {
        vlaunder(fr, fq);
        const int row0 = u.pm * BM + wr * 64 + fr, col0 = u.pn * BM + wc * 32 + 8 * fq;
#pragma unroll
        for (int ai = 0; ai < 2; ++ai)
#pragma unroll
            for (int m = 0; m < 4; ++m) { bf16_t* rowp = O + (size_t)(row0 + ai * HALF + m * 16) * ldc + col0;
#pragma unroll
                for (int bj = 0; bj < 2; ++bj) { const f32x4 v0 = acc[ai][bj][m][0], v1 = acc[ai][bj][m][1];
                    v4u w; w.x = cvt_pk_f16a(v0[0], v0[1]); w.y = cvt_pk_f16a(v0[2], v0[3]); w.z = cvt_pk_f16a(v1[0], v1[1]); w.w = cvt_pk_f16a(v1[2], v1[3]);
                    *(v4u*)(rowp + bj * HALF) = w; } }
    }
};
struct EpiGate8 {
    static constexpr bool PERM = true, HAS_MID = false;
    bf16_t *GR, *GB; const float* SXp; const float* SWp;
    __device__ __forceinline__ void operator()(const Acc& acc, const Unit& u, int wr, int wc, int fr, int fq) const {
        vlaunder(fr, fq);
        const int row0 = u.pm * BM + wr * 64 + fr, tl = u.pn - 20;
        const int col0 = tl * 128 + wc * 32 + 8 * fq, w0 = tl * 256 + wc * 32 + 8 * fq;
        f32x4 sw[2][2]; float sx[2][4];
#pragma unroll
        for (int bj = 0; bj < 2; ++bj) { sw[bj][0] = *(const f32x4*)(SWp + w0 + bj * HALF); sw[bj][1] = *(const f32x4*)(SWp + w0 + bj * HALF + 4); }
#pragma unroll
        for (int ai = 0; ai < 2; ++ai)
#pragma unroll
            for (int m = 0; m < 4; ++m) sx[ai][m] = SXp[row0 + ai * HALF + m * 16];
#pragma unroll
        for (int ai = 0; ai < 2; ++ai)
#pragma unroll
            for (int m = 0; m < 4; ++m) { const size_t ro = (size_t)(row0 + ai * HALF + m * 16) * 2048 + col0;
                float rr[8], gg[8];
#pragma unroll
                for (int n = 0; n < 2; ++n) { const i32x4 ia = __builtin_bit_cast(i32x4, acc[ai][0][m][n]), ib = __builtin_bit_cast(i32x4, acc[ai][1][m][n]);
#pragma unroll
                    for (int x = 0; x < 4; ++x) { const float za = fminf(fmaxf((float)ia[x] * sx[ai][m] * sw[0][n][x], -30.f), 30.f), zb = fminf(fmaxf((float)ib[x] * sx[ai][m] * sw[1][n][x], -30.f), 30.f);
                        const float ea = fexp(-za), eb = fexp(-zb); gg[n * 4 + x] = frcp(1.f + eb); rr[n * 4 + x] = (1.f + eb) * frcp(1.f + ea); } }
                v4u w; w.x = cvt_pk_bf16(rr[0], rr[1]); w.y = cvt_pk_bf16(rr[2], rr[3]); w.z = cvt_pk_bf16(rr[4], rr[5]); w.w = cvt_pk_bf16(rr[6], rr[7]);
                *(v4u*)(GR + ro) = w;
                w.x = cvt_pk_bf16(gg[0], gg[1]); w.y = cvt_pk_bf16(gg[2], gg[3]); w.z = cvt_pk_bf16(gg[4], gg[5]); w.w = cvt_pk_bf16(gg[6], gg[7]);
                *(v4u*)(GB + ro) = w; }
    }
};
struct EpiSc8 {
    static constexpr bool PERM = true, HAS_MID = false;
    bf16_t* O; const float* SXp; const float* SWp;
    __device__ __forceinline__ void operator()(const Acc& acc, const Unit& u, int wr, int wc, int fr, int fq) const {
        vlaunder(fr, fq);
        const int row0 = u.pm * BM + wr * 64 + fr, col0 = u.pn * BM + wc * 32 + 8 * fq;
        f32x4 sw[2][2]; float sx[2][4];
#pragma unroll
        for (int bj = 0; bj < 2; ++bj) { sw[bj][0] = *(const f32x4*)(SWp + col0 + bj * HALF); sw[bj][1] = *(const f32x4*)(SWp + col0 + bj * HALF + 4); }
#pragma unroll
        for (int ai = 0; ai < 2; ++ai)
#pragma unroll
            for (int m = 0; m < 4; ++m) sx[ai][m] = SXp[row0 + ai * HALF + m * 16];
#pragma unroll
        for (int ai = 0; ai < 2; ++ai)
#pragma unroll
            for (int m = 0; m < 4; ++m) { bf16_t* rowp = O + (size_t)(row0 + ai * HALF + m * 16) * 2048 + col0;
#pragma unroll
                for (int bj = 0; bj < 2; ++bj) { const i32x4 i0 = __builtin_bit_cast(i32x4, acc[ai][bj][m][0]), i1 = __builtin_bit_cast(i32x4, acc[ai][bj][m][1]);
                    const f32x4 v0 = (f32x4){(float)i0[0], (float)i0[1], (float)i0[2], (float)i0[3]} * sx[ai][m] * sw[bj][0], v1 = (f32x4){(float)i1[0], (float)i1[1], (float)i1[2], (float)i1[3]} * sx[ai][m] * sw[bj][1];
                    v4u w; w.x = cvt_pk_bf16(v0[0], v0[1]); w.y = cvt_pk_bf16(v0[2], v0[3]); w.z = cvt_pk_bf16(v1[0], v1[1]); w.w = cvt_pk_bf16(v1[2], v1[3]);
                    *(v4u*)(rowp + bj * HALF) = w; } }
    }
};
struct EpiBf16 {
    static constexpr bool PERM = true, HAS_MID = false;
    bf16_t* O; int ldc;
    __device__ __forceinline__ void operator()(const Acc& acc, const Unit& u, int wr, int wc, int fr, int fq) const {
        vlaunder(fr, fq);
        const int row0 = u.pm * BM + wr * 64 + fr, col0 = u.pn * BM + wc * 32 + 8 * fq;
#pragma unroll
        for (int ai = 0; ai < 2; ++ai)
#pragma unroll
            for (int m = 0; m < 4; ++m) { bf16_t* rowp = O + (size_t)(row0 + ai * HALF + m * 16) * ldc + col0;
#pragma unroll
                for (int bj = 0; bj < 2; ++bj) { const f32x4 v0 = acc[ai][bj][m][0], v1 = acc[ai][bj][m][1];
                    v4u w; w.x = cvt_pk_bf16(v0[0], v0[1]); w.y = cvt_pk_bf16(v0[2], v0[3]); w.z = cvt_pk_bf16(v1[0], v1[1]); w.w = cvt_pk_bf16(v1[2], v1[3]);
                    *(v4u*)(rowp + bj * HALF) = w; } }
    }
};
struct EpiIn {
    static constexpr bool PERM = true, HAS_MID = false;
    bf16_t *Q, *KK, *V, *SG, *UB, *GR, *GB; float* LOGF; const float* lb;
    __device__ __forceinline__ void operator()(const Acc& acc, const Unit& u, int wr, int wc, int fr, int fq) const {
        vlaunder(fr, fq);
        const int row0 = u.pm * BM + wr * 64 + fr;
        const int pn = u.pn;
        if (pn >= 20) {
            const int col0 = (pn - 20) * 128 + wc * 32 + 8 * fq;
#pragma unroll
            for (int ai = 0; ai < 2; ++ai)
#pragma unroll
                for (int m = 0; m < 4; ++m) { const size_t ro = (size_t)(row0 + ai * HALF + m * 16) * 2048 + col0;
                    float rr[8], gg[8];
#pragma unroll
                    for (int n = 0; n < 2; ++n)
#pragma unroll
                        for (int x = 0; x < 4; ++x) { const float za = fminf(fmaxf(acc[ai][0][m][n][x], -30.f), 30.f), zb = fminf(fmaxf(acc[ai][1][m][n][x], -30.f), 30.f);
                            const float ea = fexp(-za), eb = fexp(-zb); gg[n * 4 + x] = frcp(1.f + eb); rr[n * 4 + x] = (1.f + eb) * frcp(1.f + ea); }
                    v4u w; w.x = cvt_pk_bf16(rr[0], rr[1]); w.y = cvt_pk_bf16(rr[2], rr[3]); w.z = cvt_pk_bf16(rr[4], rr[5]); w.w = cvt_pk_bf16(rr[6], rr[7]);
                    *(v4u*)(GR + ro) = w;
                    w.x = cvt_pk_bf16(gg[0], gg[1]); w.y = cvt_pk_bf16(gg[2], gg[3]); w.z = cvt_pk_bf16(gg[4], gg[5]); w.w = cvt_pk_bf16(gg[6], gg[7]);
                    *(v4u*)(GB + ro) = w; }
            return;
        }
        const int sec = pn >> 2, col0 = (pn & 3) * 256 + wc * 32 + 8 * fq;
        if (sec == 1) {
#pragma unroll
            for (int bj = 0; bj < 2; ++bj) {
                const f32x4 l0 = *(const f32x4*)(lb + col0 + bj * HALF), l1 = *(const f32x4*)(lb + col0 + bj * HALF + 4);
#pragma unroll
                for (int ai = 0; ai < 2; ++ai)
#pragma unroll
                    for (int m = 0; m < 4; ++m) { const size_t ro = (size_t)(row0 + ai * HALF + m * 16) * 1024 + col0 + bj * HALF;
                        float lf[8], kk[8];
#pragma unroll
                        for (int n = 0; n < 2; ++n)
#pragma unroll
                            for (int x = 0; x < 4; ++x) { const float z = fminf(fmaxf(acc[ai][bj][m][n][x], -30.f), 30.f); const float lbv = n ? l1[x] : l0[x];
                                const float e = fexp(-z), s = frcp(1.f + e); const float f = lbv + (1.f - lbv) * s;
                                lf[n * 4 + x] = flog(f); kk[n * 4 + x] = (1.f - lbv) * (e * s); }
                        *(f32x4*)(LOGF + ro) = (f32x4){lf[0], lf[1], lf[2], lf[3]}; *(f32x4*)(LOGF + ro + 4) = (f32x4){lf[4], lf[5], lf[6], lf[7]};
                        v4u w; w.x = cvt_pk_bf16(kk[0], kk[1]); w.y = cvt_pk_bf16(kk[2], kk[3]); w.z = cvt_pk_bf16(kk[4], kk[5]); w.w = cvt_pk_bf16(kk[6], kk[7]);
                        *(v4u*)(KK + ro) = w; }
            }
            return;
        }
        bf16_t* dst = sec == 0 ? Q : (sec == 2 ? V : (sec == 3 ? SG : UB));
        const bool sig = (sec == 3);
#pragma unroll
        for (int ai = 0; ai < 2; ++ai)
#pragma unroll
            for (int m = 0; m < 4; ++m) { bf16_t* rowp = dst + (size_t)(row0 + ai * HALF + m * 16) * 1024 + col0;
#pragma unroll
                for (int bj = 0; bj < 2; ++bj) { f32x4 v0 = acc[ai][bj][m][0], v1 = acc[ai][bj][m][1];
                    if (sig) {
#pragma unroll
                        for (int x = 0; x < 4; ++x) { v0[x] = frcp(1.f + fexp(-fminf(fmaxf(v0[x], -30.f), 30.f))); v1[x] = frcp(1.f + fexp(-fminf(fmaxf(v1[x], -30.f), 30.f))); } }
                    v4u w; w.x = cvt_pk_bf16(v0[0], v0[1]); w.y = cvt_pk_bf16(v0[2], v0[3]); w.z = cvt_pk_bf16(v1[0], v1[1]); w.w = cvt_pk_bf16(v1[2], v1[3]);
                    *(v4u*)(rowp + bj * HALF) = w; } }
    }
};
struct EpiIn8 {
    static constexpr bool PERM = true, HAS_MID = false;
    EpiIn base; const float* SXp; const float* SWp;
    __device__ __forceinline__ void operator()(Acc& acc, const Unit& u, int wr, int wc, int fr, int fq) const {
        { int fr_ = fr, fq_ = fq; vlaunder(fr_, fq_);
          const int row0 = u.pm * BM + wr * 64 + fr_, w0 = u.pn * BM + wc * 32 + 8 * fq_;
          f32x4 sw[2][2]; float sx[2][4];
#pragma unroll
          for (int bj = 0; bj < 2; ++bj) { sw[bj][0] = *(const f32x4*)(SWp + w0 + bj * HALF); sw[bj][1] = *(const f32x4*)(SWp + w0 + bj * HALF + 4); }
#pragma unroll
          for (int ai = 0; ai < 2; ++ai)
#pragma unroll
              for (int m = 0; m < 4; ++m) sx[ai][m] = SXp[row0 + ai * HALF + m * 16];
#pragma unroll
          for (int ai = 0; ai < 2; ++ai)
#pragma unroll
              for (int bj = 0; bj < 2; ++bj)
#pragma unroll
                  for (int m = 0; m < 4; ++m)
#pragma unroll
                      for (int n = 0; n < 2; ++n) { const i32x4 iv = __builtin_bit_cast(i32x4, acc[ai][bj][m][n]);
                          acc[ai][bj][m][n] = (f32x4){(float)iv[0], (float)iv[1], (float)iv[2], (float)iv[3]} * sx[ai][m] * sw[bj][n]; } }
        base(acc, u, wr, wc, fr, fq);
    }
};
struct EpiGlu {
    static constexpr bool PERM = true, HAS_MID = false;
    bf16_t* O; int ldc;
    __device__ __forceinline__ void operator()(const Acc& acc, const Unit& u, int wr, int wc, int fr, int fq) const {
        vlaunder(fr, fq);
        const int row0 = u.pm * BM + wr * 64 + fr, col0 = u.pn * 128 + wc * 32 + 8 * fq;
#pragma unroll
        for (int ai = 0; ai < 2; ++ai)
#pragma unroll
            for (int m = 0; m < 4; ++m) { float o[8];
#pragma unroll
                for (int n = 0; n < 2; ++n)
#pragma unroll
                    for (int x = 0; x < 4; ++x) { const float h2 = fminf(fmaxf(acc[ai][1][m][n][x], -30.f), 30.f); o[n * 4 + x] = acc[ai][0][m][n][x] * frcp(1.f + fexp(-h2)); }
                v4u w; w.x = cvt_pk_bf16(o[0], o[1]); w.y = cvt_pk_bf16(o[2], o[3]); w.z = cvt_pk_bf16(o[4], o[5]); w.w = cvt_pk_bf16(o[6], o[7]);
                *(v4u*)(O + (size_t)(row0 + ai * HALF + m * 16) * ldc + col0) = w; }
    }
};
struct EpiUp {
    static constexpr bool PERM = true, HAS_MID = true;
    bf16_t* O; const bf16_t *GR, *GB;
    __device__ __forceinline__ void scale(Acc& acc, const bf16_t* G, const Unit& u, int wr, int wc, int fr, int fq) const {
        vlaunder(fr, fq);
        const int row0 = u.pm * BM + wr * 64 + fr, col0 = u.pn * BM + wc * 32 + 8 * fq;
#pragma unroll
        for (int ai = 0; ai < 2; ++ai) {
            v4u gw[4][2];
#pragma unroll
            for (int m = 0; m < 4; ++m)
#pragma unroll
                for (int bj = 0; bj < 2; ++bj) gw[m][bj] = *(const v4u*)(G + (size_t)(row0 + ai * HALF + m * 16) * 2048 + col0 + bj * HALF);
            __builtin_amdgcn_sched_barrier(0);
#pragma unroll
            for (int m = 0; m < 4; ++m) {
#pragma unroll
                for (int bj = 0; bj < 2; ++bj) { const v4u w = gw[m][bj];
                    acc[ai][bj][m][0] *= (f32x4){bf_lo(w.x), bf_hi(w.x), bf_lo(w.y), bf_hi(w.y)};
                    acc[ai][bj][m][1] *= (f32x4){bf_lo(w.z), bf_hi(w.z), bf_lo(w.w), bf_hi(w.w)}; } }
            __builtin_amdgcn_sched_barrier(0); }
    }
    __device__ __forceinline__ void mid(Acc& acc, const Unit& u, int wr, int wc, int fr, int fq) const { scale(acc, GR, u, wr, wc, fr, fq); }
    __device__ __forceinline__ void operator()(Acc& acc, const Unit& u, int wr, int wc, int fr, int fq) const {
        scale(acc, GB, u, wr, wc, fr, fq);
        const int row0 = u.pm * BM + wr * 64 + fr, col0 = u.pn * BM + wc * 32 + 8 * fq;
#pragma unroll
        for (int ai = 0; ai < 2; ++ai)
#pragma unroll
            for (int m = 0; m < 4; ++m) { bf16_t* rowp = O + (size_t)(row0 + ai * HALF + m * 16) * 2048 + col0;
#pragma unroll
                for (int bj = 0; bj < 2; ++bj) { const f32x4 v0 = acc[ai][bj][m][0], v1 = acc[ai][bj][m][1];
                    v4u w; w.x = cvt_pk_bf16(v0[0], v0[1]); w.y = cvt_pk_bf16(v0[2], v0[3]); w.z = cvt_pk_bf16(v1[0], v1[1]); w.w = cvt_pk_bf16(v1[2], v1[3]);
                    *(v4u*)(rowp + bj * HALF) = w; } }
    }
};
}

#define XB_TMO      128
#define XB_XCNT(j)  (256  + 64 * (j))
#define XB_XSUB(j)  (1280 + 64 * (j))
#define XB_XGEN(j)  (2304 + 64 * (j))
#define XB_TOP      3328
#define XB_TOPGEN   3392
#define XCD_BAR_WORDS 3456
#define XB_SPIN_CAP (1u << 20)

__device__ __forceinline__ unsigned xb_ld(unsigned* p)              { return __hip_atomic_load(p, __ATOMIC_RELAXED, __HIP_MEMORY_SCOPE_AGENT); }
__device__ __forceinline__ unsigned xb_add(unsigned* p, unsigned v) { return __hip_atomic_fetch_add(p, v, __ATOMIC_RELAXED, __HIP_MEMORY_SCOPE_AGENT); }
__device__ __forceinline__ unsigned xb_xcc_id() { return (unsigned)__builtin_amdgcn_s_getreg((3 << 11) | 20) & 0xFu; }
#define XB_SPIN(cond, bar) do { unsigned _sp = 0; while (cond) { __builtin_amdgcn_s_sleep(1); \
    if ((++_sp & 255u) == 0u) { if (xb_ld(&(bar)[XB_TMO])) break; if (_sp > XB_SPIN_CAP) { atomicAdd(&(bar)[XB_TMO], 1u); break; } } } } while (0)

struct XcdBarrier { unsigned* bar; unsigned x; volatile LAS unsigned* st; };

__device__ __forceinline__ XcdBarrier xcd_barrier_post(unsigned* bar, volatile LAS unsigned* st, bool leader) {
    XcdBarrier b; b.bar = bar; b.x = xb_xcc_id(); b.st = st;
    if (leader) (void)xb_add(&bar[XB_XCNT(b.x)], 1u);
    return b;
}
__device__ __forceinline__ void xcd_barrier_complete(unsigned* bar, unsigned x, unsigned& nloc, unsigned& nx) {
    const unsigned G = gridDim.x * gridDim.y * gridDim.z;
    unsigned sum, cnt, mine, sp = 0u;
    for (;;) {
        sum = 0u; cnt = 0u; mine = 0u;
#pragma unroll
        for (unsigned j = 0; j < 16; ++j) { const unsigned c = xb_ld(&bar[XB_XCNT(j)]); sum += c; cnt += (c > 0u) ? 1u : 0u; mine = (j == x) ? c : mine; }
        if (sum == G) break;
        __builtin_amdgcn_s_sleep(1);
        if ((++sp & 255u) == 0u) { if (xb_ld(&bar[XB_TMO])) break; if (sp > XB_SPIN_CAP) { atomicAdd(&bar[XB_TMO], 1u); break; } }
    }
    nloc = mine > 0u ? mine : 1u; nx = cnt > 0u ? cnt : 1u;
}
__device__ __forceinline__ void xcd_barrier(const XcdBarrier& b, int wv) {
    asm volatile("s_waitcnt vmcnt(0)" ::: "memory");
    __syncthreads();
    if (wv == 0 && lane_id() == 0) {
        unsigned* bar = b.bar;
        __builtin_amdgcn_s_waitcnt(0);
        unsigned nloc = b.st[0], nx = b.st[1];
        if (nloc == 0u) { xcd_barrier_complete(bar, b.x, nloc, nx); b.st[0] = nloc; b.st[1] = nx; }
        const unsigned old = xb_add(&bar[XB_XSUB(b.x)], 1u);
        const unsigned gen = old / nloc;
        if (old + 1u == (gen + 1u) * nloc) {
            __builtin_amdgcn_fence(__ATOMIC_RELEASE, "agent");
            asm volatile("s_waitcnt vmcnt(0)" ::: "memory");
            const unsigned og = xb_add(&bar[XB_TOP], 1u);
            const unsigned tg = og / nx;
            if (og + 1u == (tg + 1u) * nx) xb_add(&bar[XB_TOPGEN], 1u);
            else XB_SPIN(xb_ld(&bar[XB_TOPGEN]) == tg, bar);
            __builtin_amdgcn_fence(__ATOMIC_ACQUIRE, "agent");
            xb_add(&bar[XB_XGEN(b.x)], 1u);
            asm volatile("s_waitcnt vmcnt(0)" ::: "memory");
        } else {
            XB_SPIN(xb_ld(&bar[XB_XGEN(b.x)]) == gen, bar);
            __builtin_amdgcn_fence(__ATOMIC_ACQUIRE, "agent");
            asm volatile("s_waitcnt vmcnt(0)" ::: "memory");
        }
    }
    __syncthreads();
}

struct Args { const float* in[24]; float* out; unsigned char* ws; int ph_lo, ph_hi; };
struct Frame {
    LAS unsigned char* lds;
    int tid, lane, wave, vcu, G;
    unsigned char* ws;
    const __attribute__((address_space(4))) Args* ka;
};
enum { I_X = 0, I_WIN, I_LBL, I_NG, I_LRE, I_LIM, I_LSTEP, I_BRE, I_BIM, I_CRE, I_CIM, I_SD, I_WGLU, I_WUPA, I_WUPB, I_WO, I_LN1G, I_LN1B, I_PWQ, I_PKEYS, I_PU, I_PV, I_LN2G, I_LN2B };

__device__ __forceinline__ void p0_transpose_item(const float* W, int N, bf16* WT, int dpitch, int dst_koff, int dst_row0, LAS float* scr, int k0, int n0, int lane, bool h = false) {
    { const int kr = lane >> 3, c4 = (lane & 7) * 4; f32x4 v[8];
#pragma unroll
      for (int i = 0; i < 8; ++i) v[i] = __builtin_nontemporal_load((const f32x4*)(W + (size_t)(k0 + kr + 8 * i) * N + n0 + c4));
#pragma unroll
      for (int i = 0; i < 8; ++i) { LAS float* d = scr + (kr + 8 * i) * 33 + c4; d[0] = v[i][0]; d[1] = v[i][1]; d[2] = v[i][2]; d[3] = v[i][3]; } }
    LDS_WAIT(); asm volatile("" ::: "memory");
    const int c = lane & 7;
#pragma unroll
    for (int j = 0; j < 4; ++j) { const int n = (lane >> 3) + 8 * j; const LAS float* s = scr + (8 * c) * 33 + n;
        v4u o;
        if (h) { o.x = cvt_pk_f16(s[0 * 33], s[1 * 33]); o.y = cvt_pk_f16(s[2 * 33], s[3 * 33]); o.z = cvt_pk_f16(s[4 * 33], s[5 * 33]); o.w = cvt_pk_f16(s[6 * 33], s[7 * 33]); }
        else { o.x = cvt_pk_bf16(s[0 * 33], s[1 * 33]); o.y = cvt_pk_bf16(s[2 * 33], s[3 * 33]); o.z = cvt_pk_bf16(s[4 * 33], s[5 * 33]); o.w = cvt_pk_bf16(s[6 * 33], s[7 * 33]); }
        *(v4u*)(WT + (size_t)(dst_row0 + n) * dpitch + dst_koff + k0 + 8 * c) = o; }
    LDS_WAIT(); asm volatile("" ::: "memory");
}
__device__ __forceinline__ void sincos_d(double a, double& s, double& c) {
    const double k = __builtin_rint(a * 0.63661977236758134308);
    double r = __builtin_fma(-k, 1.57079632679489655800e+00, a); r = __builtin_fma(-k, 6.12323399573676603587e-17, r);
    const double r2 = r * r;
    double sp = 1.0 / 1307674368000.0; sp = sp * r2 - 1.0 / 6227020800.0; sp = sp * r2 + 1.0 / 39916800.0; sp = sp * r2 - 1.0 / 362880.0; sp = sp * r2 + 1.0 / 5040.0; sp = sp * r2 - 1.0 / 120.0; sp = sp * r2 + 1.0 / 6.0;
    const double sr = r - r * r2 * sp;
    double cp = 1.0 / 20922789888000.0; cp = cp * r2 - 1.0 / 87178291200.0; cp = cp * r2 + 1.0 / 479001600.0; cp = cp * r2 - 1.0 / 3628800.0; cp = cp * r2 + 1.0 / 40320.0; cp = cp * r2 - 1.0 / 720.0; cp = cp * r2 + 1.0 / 24.0;
    const double cr = 1.0 - 0.5 * r2 + r2 * r2 * cp;
    const int q = ((int)k) & 3;
    s = (q == 0) ? sr : (q == 1) ? cr : (q == 2) ? -sr : -cr;
    c = (q == 0) ? cr : (q == 1) ? -sr : (q == 2) ? -cr : sr;
}
__device__ __forceinline__ double exp_d(double x) {
    const double k = __builtin_rint(x * 1.44269504088896340736);
    const double r = __builtin_fma(-k, 6.93147180369123816490e-01, x) - k * 1.90821492927058770002e-10;
    double p = 1.0 / 6227020800.0;
    p = p * r + 1.0 / 479001600.0; p = p * r + 1.0 / 39916800.0; p = p * r + 1.0 / 3628800.0; p = p * r + 1.0 / 362880.0; p = p * r + 1.0 / 40320.0; p = p * r + 1.0 / 5040.0;
    p = p * r + 1.0 / 720.0; p = p * r + 1.0 / 120.0; p = p * r + 1.0 / 24.0; p = p * r + 1.0 / 6.0; p = p * r + 0.5; p = p * r + 1.0; p = p * r + 1.0;
    const long long e = (long long)k + 1023; double sc = __builtin_bit_cast(double, (unsigned long long)(e << 52));
    return p * sc;
}

__device__ __forceinline__ void phase_prologue_a(const Frame& F0) {
    Frame F = F0; F.tid = F.wave * 64 + lane_id(); asm volatile("" : "+v"(F.tid)); F.lane = F.tid & 63;
    unsigned char* ws = opqg(F.ws); const __attribute__((address_space(4))) Args* a = opq(F.ka);
    LAS float* scr = (LAS float*)(F.lds + F.wave * 16384);
    const int gw = F.vcu * 8 + F.wave, NGW = F.G * 8;
    constexpr int I_IN = 32 * 288, I_GLU = 16 * 64, I_UP = 16 * 64, I_O = 32 * 64, I_L = I_IN + I_GLU + 2 * I_UP + I_O;
    for (int it = gw; it < DEPTH * I_L; it += NGW) {
        const int l = it / I_L; int r = it % I_L;
        if (r < I_IN) { const int kb = r / 288, nb = r % 288, n0 = nb * 32; int dr;
            if (n0 < 5120) dr = n0; else if (n0 < 7168) { const int j = n0 - 5120; dr = 5120 + (j >> 7) * 256 + (j & 127); } else { const int j = n0 - 7168; dr = 5120 + (j >> 7) * 256 + 128 + (j & 127); }
            p0_transpose_item(GP(const float, a->in[I_WIN]) + (size_t)l * D * NIN, NIN, (bf16*)(ws + WS_WIN) + (size_t)l * NIN * D, D, 0, dr, scr, kb * 64, n0, F.lane, true); continue; }
        r -= I_IN;
        if (r < I_GLU) { const int kb = r / 64, nb = r % 64, n0 = nb * 32; int dr;
            if (n0 < 1024) dr = (n0 >> 7) * 256 + (n0 & 127); else { const int j = n0 - 1024; dr = (j >> 7) * 256 + 128 + (j & 127); }
            p0_transpose_item(GP(const float, a->in[I_WGLU]) + (size_t)l * 1024 * 2048, 2048, (bf16*)(ws + WS_WGLU) + (size_t)l * 2048 * 1024, 1024, 0, dr, scr, kb * 64, n0, F.lane); continue; }
        r -= I_GLU;
        if (r < I_UP) { const int kb = r / 64, nb = r % 64;
            p0_transpose_item(GP(const float, a->in[I_WUPA]) + (size_t)l * 1024 * 2048, 2048, (bf16*)(ws + WS_WUP) + (size_t)l * 2048 * 2048, 2048, 0, nb * 32, scr, kb * 64, nb * 32, F.lane); continue; }
        r -= I_UP;
        if (r < I_UP) { const int kb = r / 64, nb = r % 64;
            p0_transpose_item(GP(const float, a->in[I_WUPB]) + (size_t)l * 1024 * 2048, 2048, (bf16*)(ws + WS_WUP) + (size_t)l * 2048 * 2048, 2048, 1024, nb * 32, scr, kb * 64, nb * 32, F.lane); continue; }
        r -= I_UP;
        { const int kb = r / 64, nb = r % 64;
            p0_transpose_item(GP(const float, a->in[I_WO]) + (size_t)l * 2048 * 2048, 2048, (bf16*)(ws + WS_WO) + (size_t)l * 2048 * 2048, 2048, 0, nb * 32, scr, kb * 64, nb * 32, F.lane); }
    }
    const size_t gt = (size_t)F.vcu * 512 + F.tid, NT = (size_t)F.G * 512;
    { const float* src = GP(const float, a->in[I_PWQ]); bf16* dst = (bf16*)(ws + WS_WQB);
      const size_t N_ = (size_t)DEPTH * D * D / 8; size_t i = gt;
      for (; i + 3 * NT < N_; i += 4 * NT) { f32x4 va[4], vb[4];
#pragma unroll
          for (int k = 0; k < 4; ++k) { va[k] = *(const f32x4*)(src + (i + k * NT) * 8); vb[k] = *(const f32x4*)(src + (i + k * NT) * 8 + 4); }
#pragma unroll
          for (int k = 0; k < 4; ++k) { v4u w; w.x = cvt_pk_bf16(va[k][0], va[k][1]); w.y = cvt_pk_bf16(va[k][2], va[k][3]); w.z = cvt_pk_bf16(vb[k][0], vb[k][1]); w.w = cvt_pk_bf16(vb[k][2], vb[k][3]); *(v4u*)(dst + (i + k * NT) * 8) = w; } }
      for (; i < N_; i += NT) { const f32x4 v0 = *(const f32x4*)(src + i * 8), v1 = *(const f32x4*)(src + i * 8 + 4);
          v4u w; w.x = cvt_pk_bf16(v0[0], v0[1]); w.y = cvt_pk_bf16(v0[2], v0[3]); w.z = cvt_pk_bf16(v1[0], v1[1]); w.w = cvt_pk_bf16(v1[2], v1[3]); *(v4u*)(dst + i * 8) = w; } }
    { const float* src = GP(const float, a->in[I_X]); bf16* XS = (bf16*)(ws + WS_XH);
      const int j = F.lane & 3, rr = (F.lane >> 2) & 1, sl = F.lane >> 3;
      for (int rp = gw; rp < T / 2; rp += NGW) { const int row = 2 * rp + rr;
          f32x4 a0[8], a1[8]; float amax = 0.f;
#pragma unroll
          for (int i = 0; i < 8; ++i) { const float* sp = src + (size_t)row * D + (8 * i + sl) * 32 + j * 8; a0[i] = *(const f32x4*)sp; a1[i] = *(const f32x4*)(sp + 4); }
#pragma unroll
          for (int i = 0; i < 8; ++i) { v4u o; o.x = cvt_pk_f16(a0[i][0], a0[i][1]); o.y = cvt_pk_f16(a0[i][2], a0[i][3]); o.z = cvt_pk_f16(a1[i][0], a1[i][1]); o.w = cvt_pk_f16(a1[i][2], a1[i][3]);
              *(v4u*)(XS + ((size_t)(8 * i + sl) * T + row) * 32 + j * 8) = o;
#pragma unroll
              for (int k = 0; k < 4; ++k) amax = fmaxf(amax, fmaxf(fabsf(a0[i][k]), fabsf(a1[i][k]))); }
          amax = fmaxf(amax, __shfl_xor(amax, 1)); amax = fmaxf(amax, __shfl_xor(amax, 2)); amax = fmaxf(amax, __shfl_xor(amax, 8)); amax = fmaxf(amax, __shfl_xor(amax, 16)); amax = fmaxf(amax, __shfl_xor(amax, 32));
          const float inv = (amax > 0.f) ? 127.f / amax : 0.f;
          if (j == 0 && sl == 0) ((float*)(ws + WS_SX))[row] = (amax > 0.f) ? amax * (1.f / 127.f) : 1.f;
          unsigned char* xq = ws + WS_XQ + (size_t)row * 64 + (sl & 1) * 32 + j * 8;
#pragma unroll
          for (int i = 0; i < 8; ++i) { int q[8];
#pragma unroll
              for (int k = 0; k < 4; ++k) { q[k] = (int)__builtin_rintf(a0[i][k] * inv); q[4 + k] = (int)__builtin_rintf(a1[i][k] * inv); }
              v2u o; o.x = (unsigned)(q[0] & 255) | ((unsigned)(q[1] & 255) << 8) | ((unsigned)(q[2] & 255) << 16) | ((unsigned)q[3] << 24);
              o.y = (unsigned)(q[4] & 255) | ((unsigned)(q[5] & 255) << 8) | ((unsigned)(q[6] & 255) << 16) | ((unsigned)q[7] << 24);
              *(v2u*)(xq + (size_t)(4 * i + (sl >> 1)) * T * 64) = o; } } }
    { const float* keys = GP(const float, a->in[I_PKEYS]); bf16* dst = (bf16*)(ws + WS_BK);
      for (size_t i = gt; i < (size_t)DEPTH * 8 * 256 * 256 / 8; i += NT) { const int jj = (int)(i & 31) * 8; const int row = (int)((i >> 5) & 255); const size_t lh = i >> 13; const int half = row >> 7, n = row & 127;
          v4u w = (v4u){0u, 0u, 0u, 0u};
          if ((jj >> 7) == half) { const float* s = keys + ((lh * 2 + half) * 128 + n) * 128 + (jj & 127); const f32x4 v0 = *(const f32x4*)s, v1 = *(const f32x4*)(s + 4);
              w.x = cvt_pk_bf16(v0[0], v0[1]); w.y = cvt_pk_bf16(v0[2], v0[3]); w.z = cvt_pk_bf16(v1[0], v1[1]); w.w = cvt_pk_bf16(v1[2], v1[3]); }
          *(v4u*)(dst + i * 8) = w; } }
    if (gt < 1024) { const float* lg = GP(const float, a->in[I_LBL]); float* lbo = (float*)(ws + WS_LB); const int d = (int)gt;
        const float z0 = lg[d], z1 = lg[1024 + d], z2 = lg[2048 + d], z3 = lg[3072 + d]; const float mx = fmaxf(fmaxf(z0, z1), fmaxf(z2, z3));
        const float e0 = expf(z0 - mx), e1 = expf(z1 - mx), e2 = expf(z2 - mx), e3 = expf(z3 - mx); const float inv = 1.f / (e0 + e1 + e2 + e3);
        lbo[d] = 0.f; lbo[1024 + d] = e1 * inv; lbo[2048 + d] = (e1 + e2) * inv; lbo[3072 + d] = (e1 + e2 + e3) * inv; }
    for (size_t i = gt; i < (size_t)DEPTH * 64 * 64; i += NT) {
        const size_t lg_ = i >> 6;
        const double lr = fmin((double)GP(const float, a->in[I_LRE])[i], -1e-4), li = (double)GP(const float, a->in[I_LIM])[i], dt = exp_d((double)GP(const float, a->in[I_LSTEP])[lg_]);
        const double mag = exp_d(lr * dt); double sn, cs; sincos_d(li * dt, sn, cs);
        const double ar = mag * cs, ai = mag * sn, den = lr * lr + li * li, nr = ar - 1.0;
        const double zr = (nr * lr + ai * li) / den, zi = (ai * lr - nr * li) / den;
        const float* br = GP(const float, a->in[I_BRE]) + i * 16; const float* bi = GP(const float, a->in[I_BIM]) + i * 16; float* bb = (float*)(ws + WS_BB) + i * 32;
        f32x4 brv[4], biv[4];
#pragma unroll
        for (int m4 = 0; m4 < 4; ++m4) { brv[m4] = ((const f32x4*)br)[m4]; biv[m4] = ((const f32x4*)bi)[m4]; }
#pragma unroll
        for (int m4 = 0; m4 < 4; ++m4) { float o8[8];
#pragma unroll
            for (int x = 0; x < 4; ++x) { const double b_r = brv[m4][x], b_i = biv[m4][x]; o8[2 * x] = (float)(zr * b_r - zi * b_i); o8[2 * x + 1] = (float)(zr * b_i + zi * b_r); }
            ((f32x4*)bb)[2 * m4] = (f32x4){o8[0], o8[1], o8[2], o8[3]}; ((f32x4*)bb)[2 * m4 + 1] = (f32x4){o8[4], o8[5], o8[6], o8[7]}; }
        float* ap = (float*)(ws + WS_APOW) + (lg_ * 65 * 64 + (i & 63)) * 2; double pr = 1.0, pi = 0.0;
        for (int dl = 0; dl < 65; ++dl) { ap[dl * 128] = (float)pr; ap[dl * 128 + 1] = (float)pi; const double t = pr * ar - pi * ai; pi = pr * ai + pi * ar; pr = t; }
    }
    for (int it = gw; it < DEPTH * 1024; it += NGW) {
        const int l = it >> 10, eb = it & 1023;
        const int pe = eb * 16 + (F.lane >> 2), i1 = (pe & 1023) >> 3, i2 = (pe & 7) * 16 + (((pe >> 10) - i1) & 15);
        const float* src = GP(const float, a->in[I_PV]) + ((size_t)l * NEXP + i1 * 128 + i2) * D + (F.lane & 3) * 8;
        bf16* dst = (bf16*)(ws + WS_TBV) + (size_t)l * 64 * NEXP * 32 + ((size_t)((pe >> 10) * 4 + (F.lane & 3)) * 1024 + (pe & 1023)) * 8;
#pragma unroll 1
        for (int k8 = 0; k8 < 64; k8 += 8) { f32x4 va[8], vb[8];
#pragma unroll
            for (int k = 0; k < 8; ++k) { va[k] = __builtin_nontemporal_load((const f32x4*)(src + (k8 + k) * 32)); vb[k] = __builtin_nontemporal_load((const f32x4*)(src + (k8 + k) * 32 + 4)); }
#pragma unroll
            for (int k = 0; k < 8; ++k) { v4u w; w.x = cvt_pk_f16(va[k][0], va[k][1]); w.y = cvt_pk_f16(va[k][2], va[k][3]); w.z = cvt_pk_f16(vb[k][0], vb[k][1]); w.w = cvt_pk_f16(vb[k][2], vb[k][3]);
                *(v4u*)(dst + (size_t)(k8 + k) * NEXP * 32) = w; } }
    }
    for (int it = gw; it < DEPTH * 4096; it += NGW) {
        const int l = it >> 12, q4 = it & 4095, c = F.lane & 15;
        const int pe = q4 * 4 + (F.lane >> 4), i1 = (pe & 1023) >> 3, i2 = (pe & 7) * 16 + (((pe >> 10) - i1) & 15);
        const float* src = GP(const float, a->in[I_PU]) + ((size_t)l * NEXP + i1 * 128 + i2) * D + c * 4;
        unsigned hv[64]; float m = 0.f;
#pragma unroll
        for (int i = 0; i < 32; ++i) { const f32x4 v = __builtin_nontemporal_load((const f32x4*)(src + i * 64));
            m = fmaxf(fmaxf(m, fmaxf(fabsf(v[0]), fabsf(v[1]))), fmaxf(fabsf(v[2]), fabsf(v[3])));
            hv[2 * i] = cvt_pk_f16(v[0], v[1]); hv[2 * i + 1] = cvt_pk_f16(v[2], v[3]); }
        m = fmaxf(m, __shfl_xor(m, 1)); m = fmaxf(m, __shfl_xor(m, 2)); m = fmaxf(m, __shfl_xor(m, 4)); m = fmaxf(m, __shfl_xor(m, 8));
        const float sc = (m > 0.f) ? m * (1.f / 127.f) : 1.f, inv = (m > 0.f) ? 127.f / m : 0.f;
        if (c == 0) ((float*)(ws + WS_SU))[(size_t)l * NEXP + pe] = sc;
        unsigned char* dst = ws + WS_TBU + (size_t)l * 32 * NEXP * 64 + (size_t)pe * 64 + (((c >> 2) ^ ((pe >> 2) & 3)) * 16 + (c & 3) * 4);
#pragma unroll
        for (int i = 0; i < 32; ++i) { const h2_t p0 = __builtin_bit_cast(h2_t, hv[2 * i]), p1 = __builtin_bit_cast(h2_t, hv[2 * i + 1]);
            const int q0 = (int)__builtin_rintf((float)p0.x * inv), q1 = (int)__builtin_rintf((float)p0.y * inv), q2 = (int)__builtin_rintf((float)p1.x * inv), q3 = (int)__builtin_rintf((float)p1.y * inv);
            *(unsigned*)(dst + (size_t)i * NEXP * 64) = (unsigned)(q0 & 255) | ((unsigned)(q1 & 255) << 8) | ((unsigned)(q2 & 255) << 16) | ((unsigned)q3 << 24); }
    }
}
__device__ __forceinline__ double dummy_unused_(double x) { return x; }

__device__ __forceinline__ void phase_prologue_b(const Frame& F0) {
    Frame F = F0; F.tid = F.wave * 64 + lane_id(); asm volatile("" : "+v"(F.tid)); F.lane = F.tid & 63;
    unsigned char* ws = opqg(F.ws); const __attribute__((address_space(4))) Args* a = opq(F.ka);
    const float* APOW = (const float*)(ws + WS_APOW); const float* BB = (const float*)(ws + WS_BB);
    LAS float* AP = (LAS float*)(F.lds); LAS float* BL = (LAS float*)(F.lds + 33280); LAS float* CR = (LAS float*)(F.lds + 41472); LAS float* CI = (LAS float*)(F.lds + 45568); LAS float* SDL = (LAS float*)(F.lds + 49664);
    bf16* KM = (bf16*)(ws + WS_KMAT); bf16* PM = (bf16*)(ws + WS_PM); bf16* E = (bf16*)(ws + WS_E);
    for (int lg = F.vcu; lg < DEPTH * 64; lg += F.G) {
        for (int i = F.tid; i < 65 * 64 * 2 / 4; i += 512) ((LAS f32x4*)AP)[i] = ((const f32x4*)(APOW + (size_t)lg * 65 * 128))[i];
        ((LAS f32x4*)BL)[F.tid] = ((const f32x4*)(BB + (size_t)lg * 2048))[F.tid];
        if (F.tid < 256) ((LAS f32x4*)CR)[F.tid] = ((const f32x4*)(GP(const float, a->in[I_CRE]) + (size_t)lg * 1024))[F.tid];
        else ((LAS f32x4*)CI)[F.tid - 256] = ((const f32x4*)(GP(const float, a->in[I_CIM]) + (size_t)lg * 1024))[F.tid - 256];
        if (F.tid < 16) SDL[F.tid] = GP(const float, a->in[I_SD])[lg * 16 + F.tid];
        __syncthreads();
        for (int task = F.tid; task < 65 * 16; task += 512) {
            const int n = task & 15, idx = task >> 4;
            float sm[16];
#pragma unroll
            for (int m = 0; m < 16; ++m) sm[m] = 0.f;
            if (idx > 0) { const int dl = idx - 1;
#pragma unroll 4
                for (int p = 0; p < 64; ++p) { const f32x2 av = *(const LAS f32x2*)(AP + (dl * 64 + p) * 2); const float c_r = CR[n * 64 + p], c_i = CI[n * 64 + p];
                    const float car = c_r * av[0] - c_i * av[1], cai = c_r * av[1] + c_i * av[0];
#pragma unroll
                    for (int q = 0; q < 8; ++q) { const f32x4 b4 = *(const LAS f32x4*)(BL + p * 32 + q * 4); sm[2 * q] += car * b4[0] - cai * b4[1]; sm[2 * q + 1] += car * b4[2] - cai * b4[3]; } }
                if (dl == 0) { const float dv = SDL[n];
#pragma unroll
                    for (int m = 0; m < 16; ++m) sm[m] += (m == n) ? dv : 0.f; } }
            v4u w0, w1; w0.x = cvt_pk_bf16(sm[0], sm[1]); w0.y = cvt_pk_bf16(sm[2], sm[3]); w0.z = cvt_pk_bf16(sm[4], sm[5]); w0.w = cvt_pk_bf16(sm[6], sm[7]);
            w1.x = cvt_pk_bf16(sm[8], sm[9]); w1.y = cvt_pk_bf16(sm[10], sm[11]); w1.z = cvt_pk_bf16(sm[12], sm[13]); w1.w = cvt_pk_bf16(sm[14], sm[15]);
            bf16* kp = KM + ((size_t)lg * 65 * 16 + task) * 16; *(v4u*)kp = w0; *(v4u*)(kp + 8) = w1; }
        for (int it = F.tid; it < 128 * 64 * 2; it += 512) {
            const int m0 = (it & 1) * 8, sidx = (it >> 1) & 63, pp = it >> 7, p = pp & 63;
            const f32x2 av = *(const LAS f32x2*)(AP + ((63 - sidx) * 64 + p) * 2); const float pr = av[0], pi = av[1];
            float o[8];
#pragma unroll
            for (int j = 0; j < 4; ++j) { const f32x4 b4 = *(const LAS f32x4*)(BL + p * 32 + m0 * 2 + j * 4);
                o[2 * j] = (pp < 64) ? (pr * b4[0] - pi * b4[1]) : (pr * b4[1] + pi * b4[0]); o[2 * j + 1] = (pp < 64) ? (pr * b4[2] - pi * b4[3]) : (pr * b4[3] + pi * b4[2]); }
            v4u w; w.x = cvt_pk_bf16(o[0], o[1]); w.y = cvt_pk_bf16(o[2], o[3]); w.z = cvt_pk_bf16(o[4], o[5]); w.w = cvt_pk_bf16(o[6], o[7]); *(v4u*)(PM + ((size_t)lg * 16384 + it) * 8) = w; }
        for (int it = F.tid; it < 1024 * 16; it += 512) {
            const int pp0 = (it & 15) * 8, n = (it >> 4) & 15, tau = it >> 8, p0 = pp0 & 63;
            float o[8];
#pragma unroll
            for (int j = 0; j < 8; ++j) { const f32x2 av = *(const LAS f32x2*)(AP + ((tau + 1) * 64 + p0 + j) * 2); const float c_r = CR[n * 64 + p0 + j], c_i = CI[n * 64 + p0 + j];
                o[j] = (pp0 < 64) ? (c_r * av[0] - c_i * av[1]) : -(c_r * av[1] + c_i * av[0]); }
            v4u w; w.x = cvt_pk_bf16(o[0], o[1]); w.y = cvt_pk_bf16(o[2], o[3]); w.z = cvt_pk_bf16(o[4], o[5]); w.w = cvt_pk_bf16(o[6], o[7]); *(v4u*)(E + ((size_t)lg * 16384 + it) * 8) = w; }
        __syncthreads();
    }
}
__device__ __forceinline__ void quant_rows(const Frame& F0, const bf16* SRC, int rpl, int lrows, int row0, unsigned char* W8, float* SW) {
    Frame F = F0; F.tid = F.wave * 64 + lane_id(); asm volatile("" : "+v"(F.tid)); F.lane = F.tid & 63;
    for (int row = F.vcu * 8 + F.wave; row < DEPTH * rpl; row += F.G * 8) {
        const int l = row / rpl, r = row - l * rpl; const bf16* sp = SRC + ((size_t)l * lrows + row0 + r) * 2048;
        v4u w[4]; float vf[32]; float m = 0.f;
#pragma unroll
        for (int k = 0; k < 4; ++k) w[k] = *(const v4u*)(sp + (k * 64 + F.lane) * 8);
#pragma unroll
        for (int k = 0; k < 4; ++k) { const unsigned ww[4] = {w[k].x, w[k].y, w[k].z, w[k].w};
#pragma unroll
            for (int x = 0; x < 4; ++x) { const h2_t hv = __builtin_bit_cast(h2_t, ww[x]); vf[8 * k + 2 * x] = (float)hv.x; vf[8 * k + 2 * x + 1] = (float)hv.y; m = fmaxf(m, fmaxf(fabsf((float)hv.x), fabsf((float)hv.y))); } }
#pragma unroll
        for (int o = 1; o < 64; o <<= 1) m = fmaxf(m, __shfl_xor(m, o));
        const float inv = (m > 0.f) ? 127.f / m : 0.f;
        if (F.lane == 0) SW[row] = (m > 0.f) ? m * (1.f / 127.f) : 1.f;
#pragma unroll
        for (int k = 0; k < 4; ++k) { int q[8];
#pragma unroll
            for (int x = 0; x < 8; ++x) q[x] = (int)__builtin_rintf(vf[8 * k + x] * inv);
            v2u o; o.x = (unsigned)(q[0] & 255) | ((unsigned)(q[1] & 255) << 8) | ((unsigned)(q[2] & 255) << 16) | ((unsigned)q[3] << 24);
            o.y = (unsigned)(q[4] & 255) | ((unsigned)(q[5] & 255) << 8) | ((unsigned)(q[6] & 255) << 16) | ((unsigned)q[7] << 24);
            *(v2u*)(W8 + (size_t)row * 2048 + (k * 64 + F.lane) * 8) = o; }
    }
}
constexpr int HG_BL = 0, HG_TOT = 33792, HG_VT = 35840, HG_KT = 54272, HG_RED = 72704;
constexpr int KSP = 136, HG_KS = 73728, HG_QT = HG_KS + 64 * KSP * 2, HG_QH = HG_QT + 64 * KSP * 2;
static_assert(HG_QH + 64 * KSP * 2 <= RING_BYTES, "hgrn_out LDS map");
constexpr int BLP = 132, VTP = 72;
__device__ __forceinline__ void hg_cumsum(const Frame& F, const float* LOGF, int c, int h) {
    LAS float* bL = (LAS float*)(F.lds + HG_BL); LAS float* tot = (LAS float*)(F.lds + HG_TOT);
    const int d = F.tid & 127, seg = F.tid >> 7;
    const float* src = LOGF + (size_t)(c * 64 + seg * 16) * AW + h * 128 + d;
    float lf[16];
#pragma unroll
    for (int i = 0; i < 16; ++i) lf[i] = src[(size_t)i * AW];
#pragma unroll
    for (int i = 1; i < 16; ++i) lf[i] += lf[i - 1];
    tot[seg * 128 + d] = lf[15];
    __syncthreads();
    float off = 0.f;
#pragma unroll
    for (int s2 = 0; s2 < 3; ++s2) off += (s2 < seg) ? tot[s2 * 128 + d] : 0.f;
#pragma unroll
    for (int i = 0; i < 16; ++i) bL[(seg * 16 + i) * BLP + d] = lf[i] + off;
}
__device__ __forceinline__ void hg_load_vt(const Frame& F, const bf16* V, int c, int h) {
    LAS bf16* VT = (LAS bf16*)(F.lds + HG_VT);
    const int s = F.lane, vb = F.wave * 16;
    const v4u* src = (const v4u*)(V + (size_t)(c * 64 + s) * AW + h * 128 + vb);
    const v4u w0 = src[0], w1 = src[1];
    const unsigned ww[8] = {w0.x, w0.y, w0.z, w0.w, w1.x, w1.y, w1.z, w1.w};
#pragma unroll
    for (int j = 0; j < 8; ++j) { VT[(vb + 2 * j) * VTP + s] = (bf16)(ww[j] & 0xffffu); VT[(vb + 2 * j + 1) * VTP + s] = (bf16)(ww[j] >> 16); }
}
__device__ __forceinline__ void phase_hgrn_local(const Frame& F0, int l) {
    Frame F = F0; F.tid = F.wave * 64 + lane_id(); asm volatile("" : "+v"(F.tid)); F.lane = F.tid & 63;
    unsigned char* ws = opqg(F.ws);
    const float* LOGF = (const float*)(ws + WS_LOGF); const bf16* KK = (const bf16*)(ws + WS_KK); const bf16* V = (const bf16*)(ws + WS_V);
    _Float16* U = (_Float16*)(ws + WS_U); float* BLo = (float*)(ws + WS_BL);
    LAS float* bL = (LAS float*)(F.lds + HG_BL); LAS bf16* VT = (LAS bf16*)(F.lds + HG_VT); LAS bf16* KT = (LAS bf16*)(F.lds + HG_KT);
    const int fr = F.lane & 15, fq = F.lane >> 4;
    for (int unit = F.vcu; unit < NCH * 8; unit += F.G) {
        const int c = unit >> 3, h = unit & 7;
        hg_cumsum(F, LOGF, c, h);
        hg_load_vt(F, V, c, h);
        __syncthreads();
        { const int s = F.lane, db = F.wave * 16;
          const v4u* src = (const v4u*)(KK + (size_t)(c * 64 + s) * AW + h * 128 + db);
          const v4u w0 = src[0], w1 = src[1];
          const unsigned ww[8] = {w0.x, w0.y, w0.z, w0.w, w1.x, w1.y, w1.z, w1.w};
#pragma unroll
          for (int j = 0; j < 8; ++j) {
              const float b0 = bL[s * BLP + db + 2 * j], b1 = bL[s * BLP + db + 2 * j + 1], l0 = bL[63 * BLP + db + 2 * j], l1 = bL[63 * BLP + db + 2 * j + 1];
              const unsigned pk = cvt_pk_bf16(bf_lo(ww[j]) * fexp(l0 - b0), bf_hi(ww[j]) * fexp(l1 - b1));
              KT[(db + 2 * j) * VTP + s] = (bf16)(pk & 0xffffu); KT[(db + 2 * j + 1) * VTP + s] = (bf16)(pk >> 16); } }
        if (F.tid < 128) BLo[(size_t)c * AW + h * 128 + F.tid] = bL[63 * BLP + F.tid];
        __syncthreads();
        f32x4 acc[8];
#pragma unroll
        for (int i = 0; i < 8; ++i) acc[i] = (f32x4){0.f, 0.f, 0.f, 0.f};
#pragma unroll
        for (int ks = 0; ks < 2; ++ks) {
            const bf16x8 A = *(const LAS bf16x8*)(VT + (F.wave * 16 + fr) * VTP + ks * 32 + fq * 8);
#pragma unroll
            for (int dt = 0; dt < 8; ++dt) { const bf16x8 B = *(const LAS bf16x8*)(KT + (dt * 16 + fr) * VTP + ks * 32 + fq * 8);
                acc[dt] = __builtin_amdgcn_mfma_f32_16x16x32_bf16(B, A, acc[dt], 0, 0, 0); }
        }
        _Float16* up = U + ((size_t)(c * 8 + h) * 128 + F.wave * 16 + fr) * 128 + fq * 4;
#pragma unroll
        for (int dt = 0; dt < 8; ++dt) { v2u w; w.x = cvt_pk_f16(acc[dt][0], acc[dt][1]); w.y = cvt_pk_f16(acc[dt][2], acc[dt][3]); *(v2u*)(up + dt * 16) = w; }
        __syncthreads();
    }
}
__device__ __forceinline__ void phase_scan(const Frame& F0, int l) {
    Frame F = F0; F.tid = F.wave * 64 + lane_id(); asm volatile("" : "+v"(F.tid)); F.lane = F.tid & 63;
    unsigned char* ws = opqg(F.ws);
    const _Float16* U = (const _Float16*)(ws + WS_U); const float* BLo = (const float*)(ws + WS_BL); bf16* SP = (bf16*)(ws + WS_SP);
    for (int e = F.vcu * 512 + F.tid; e < 8 * 128 * 128; e += F.G * 512) {
        const int hd = (e >> 14) * 128 + (e & 127);
        float s = 0.f;
        float u[32], bl[32], bln[32]; _Float16 unh[32];
#pragma unroll
        for (int i = 0; i < 32; ++i) { u[i] = (float)U[(size_t)i * 131072 + e]; bl[i] = BLo[(size_t)i * AW + hd]; }
#pragma unroll 1
        for (int c0 = 0; c0 < NCH; c0 += 32) {
            const int cn = (c0 + 32 < NCH) ? c0 + 32 : c0;
#pragma unroll
            for (int i = 0; i < 32; ++i) { unh[i] = U[(size_t)(cn + i) * 131072 + e]; bln[i] = BLo[(size_t)(cn + i) * AW + hd]; }
#pragma unroll
            for (int i = 0; i < 32; ++i) { SP[(size_t)(c0 + i) * 131072 + e] = f2bf(s); s = s * fexp(bl[i]) + u[i]; }
#pragma unroll
            for (int i = 0; i < 32; ++i) { u[i] = (float)unh[i]; bl[i] = bln[i]; }
        }
    }
    const float* XLOC = (const float*)(ws + WS_XLOC); float* XS = (float*)(ws + WS_XS); const float* APOW = (const float*)(ws + WS_APOW);
    for (int e = F.vcu * 512 + F.tid; e < 64 * 64; e += F.G * 512) {
        const int g = e >> 6, p = e & 63;
        const float* ap = APOW + (((size_t)(l * 64 + g) * 65 + 64) * 64 + p) * 2; const float ar = ap[0], ai = ap[1];
        float xr = 0.f, xi = 0.f;
        for (int c0 = 0; c0 < NCH; c0 += 32) {
            float lr_[32], li_[32];
#pragma unroll
            for (int i = 0; i < 32; ++i) { lr_[i] = XLOC[((size_t)(c0 + i) * 64 + g) * 128 + p]; li_[i] = XLOC[((size_t)(c0 + i) * 64 + g) * 128 + 64 + p]; }
#pragma unroll
            for (int i = 0; i < 32; ++i) { XS[((size_t)(c0 + i) * 64 + g) * 128 + p] = xr; XS[((size_t)(c0 + i) * 64 + g) * 128 + 64 + p] = xi;
                const float t = ar * xr - ai * xi + lr_[i]; xi = ar * xi + ai * xr + li_[i]; xr = t; }
        }
    }
}
__device__ __forceinline__ void phase_hgrn_out(const Frame& F0, int l) {
    Frame F = F0; F.tid = F.wave * 64 + lane_id(); asm volatile("" : "+v"(F.tid)); F.lane = F.tid & 63;
    unsigned char* ws = opqg(F.ws); const __attribute__((address_space(4))) Args* a = opq(F.ka);
    const float* LOGF = (const float*)(ws + WS_LOGF); const bf16* KK = (const bf16*)(ws + WS_KK); const bf16* V = (const bf16*)(ws + WS_V);
    const bf16* Q = (const bf16*)(ws + WS_Q); const bf16* SG = (const bf16*)(ws + WS_SG); const bf16* SP = (const bf16*)(ws + WS_SP);
    bf16* OAB = (bf16*)(ws + WS_OAB); const float* NG = GP(const float, a->in[I_NG]) + (size_t)l * AW;
    LAS float* bL = (LAS float*)(F.lds + HG_BL); LAS bf16* VT = (LAS bf16*)(F.lds + HG_VT); LAS float* red = (LAS float*)(F.lds + HG_RED);
    const int fr = F.lane & 15, fq = F.lane >> 4, tt = F.wave & 3, vh = F.wave >> 2;
    LAS float* tot = (LAS float*)(F.lds + HG_TOT);
    float lf[16]; v4u vw0, vw1, kg0, kg1, qg0, qg1;
#define HGO_PREF(u_) { const int c_ = (u_) >> 3, h_ = (u_) & 7; \
        const float* src_ = LOGF + (size_t)(c_ * 64 + (F.tid >> 7) * 16) * AW + h_ * 128 + (F.tid & 127); \
        _Pragma("unroll") for (int i = 0; i < 16; ++i) lf[i] = src_[(size_t)i * AW]; \
        const v4u* vp_ = (const v4u*)(V + (size_t)(c_ * 64 + F.lane) * AW + h_ * 128 + F.wave * 16); vw0 = vp_[0]; vw1 = vp_[1]; \
        const size_t ro_ = ((size_t)c_ * 64 + (F.tid >> 3)) * AW + h_ * 128 + (F.tid & 7) * 16; \
        const v4u* kp_ = (const v4u*)(KK + ro_); const v4u* qp_ = (const v4u*)(Q + ro_); kg0 = kp_[0]; kg1 = kp_[1]; qg0 = qp_[0]; qg1 = qp_[1]; }
    if (F.vcu < NCH * 8) HGO_PREF(F.vcu)
    for (int unit = F.vcu; unit < NCH * 8; unit += F.G) {
        const int c = unit >> 3, h = unit & 7;
        { const int d = F.tid & 127, seg = F.tid >> 7;
#pragma unroll
          for (int i = 1; i < 16; ++i) lf[i] += lf[i - 1];
          tot[seg * 128 + d] = lf[15];
          { const int s = F.lane, vb = F.wave * 16; const unsigned ww[8] = {vw0.x, vw0.y, vw0.z, vw0.w, vw1.x, vw1.y, vw1.z, vw1.w};
#pragma unroll
            for (int j = 0; j < 8; ++j) { VT[(vb + 2 * j) * VTP + s] = (bf16)(ww[j] & 0xffffu); VT[(vb + 2 * j + 1) * VTP + s] = (bf16)(ww[j] >> 16); } }
          __syncthreads();
          float off = 0.f;
#pragma unroll
          for (int s2 = 0; s2 < 3; ++s2) off += (s2 < seg) ? tot[s2 * 128 + d] : 0.f;
#pragma unroll
          for (int i = 0; i < 16; ++i) bL[(seg * 16 + i) * BLP + d] = lf[i] + off; }
        __syncthreads();
        const int t = tt * 16 + fr; const size_t tok = (size_t)c * 64 + t;
        bf16x8 sg_[2][4];
#define HG_LOAD(buf, kd_) { const int d0_ = (kd_) * 32 + fq * 8; \
            _Pragma("unroll") for (int vt = 0; vt < 4; ++vt) sg_[buf][vt] = *(const bf16x8*)(SP + ((size_t)(c * 8 + h) * 128 + (vh * 4 + vt) * 16 + fr) * 128 + d0_); }
        HG_LOAD(0, 0) HG_LOAD(1, 1)
        v2u sgw[4];
#pragma unroll
        for (int vt = 0; vt < 4; ++vt) sgw[vt] = *(const v2u*)(SG + tok * AW + h * 128 + (vh * 4 + vt) * 16 + fq * 4);
        f32x4 ngw[4];
#pragma unroll
        for (int vt = 0; vt < 4; ++vt) ngw[vt] = *(const f32x4*)(NG + h * 128 + (vh * 4 + vt) * 16 + fq * 4);
        { const int s = F.tid >> 3, dc = (F.tid & 7) * 16;
          const unsigned kq[8] = {kg0.x, kg0.y, kg0.z, kg0.w, kg1.x, kg1.y, kg1.z, kg1.w}, qq[8] = {qg0.x, qg0.y, qg0.z, qg0.w, qg1.x, qg1.y, qg1.z, qg1.w};
          unsigned ko[8], qto[8], qho[8];
#pragma unroll
          for (int j4 = 0; j4 < 4; ++j4) { const f32x4 bs = *(const LAS f32x4*)(bL + s * BLP + dc + 4 * j4), br = *(const LAS f32x4*)(bL + 31 * BLP + dc + 4 * j4);
#pragma unroll
              for (int hx = 0; hx < 2; ++hx) { const int w = 2 * j4 + hx; const float b0 = bs[2 * hx], b1 = bs[2 * hx + 1], r0 = br[2 * hx], r1 = br[2 * hx + 1];
                  const float k0 = bf_lo(kq[w]), k1 = bf_hi(kq[w]), q0 = bf_lo(qq[w]), q1 = bf_hi(qq[w]);
                  ko[w] = cvt_pk_bf16(k0 * fexp(fminf(r0 - b0, 80.f)), k1 * fexp(fminf(r1 - b1, 80.f)));
                  qto[w] = cvt_pk_bf16(q0 * fexp(fminf(b0 - r0, 80.f)), q1 * fexp(fminf(b1 - r1, 80.f)));
                  qho[w] = cvt_pk_bf16(q0 * fexp(b0), q1 * fexp(b1)); } }
          LAS v4u* kd_ = (LAS v4u*)(F.lds + HG_KS + (s * KSP + dc) * 2); kd_[0] = (v4u){ko[0], ko[1], ko[2], ko[3]}; kd_[1] = (v4u){ko[4], ko[5], ko[6], ko[7]};
          LAS v4u* qt_ = (LAS v4u*)(F.lds + HG_QT + (s * KSP + dc) * 2); qt_[0] = (v4u){qto[0], qto[1], qto[2], qto[3]}; qt_[1] = (v4u){qto[4], qto[5], qto[6], qto[7]};
          LAS v4u* qh_ = (LAS v4u*)(F.lds + HG_QH + (s * KSP + dc) * 2); qh_[0] = (v4u){qho[0], qho[1], qho[2], qho[3]}; qh_[1] = (v4u){qho[4], qho[5], qho[6], qho[7]}; }
        __syncthreads();
        f32x4 att[4], o[4];
#pragma unroll
        for (int i = 0; i < 4; ++i) { att[i] = (f32x4){0.f, 0.f, 0.f, 0.f}; o[i] = (f32x4){0.f, 0.f, 0.f, 0.f}; }
#pragma unroll
        for (int kd = 0; kd < 4; ++kd) {
            const int cb = kd & 1;
            const int fo = (kd * 32 + fq * 8) * 2;
            const bf16x8 Bqt = *(const LAS bf16x8*)(F.lds + HG_QT + (t * KSP) * 2 + fo), Bqh = *(const LAS bf16x8*)(F.lds + HG_QH + (t * KSP) * 2 + fo);
#pragma unroll
            for (int st = 0; st < 4; ++st) { const bf16x8 kt = *(const LAS bf16x8*)(F.lds + HG_KS + ((st * 16 + fr) * KSP) * 2 + fo);
                att[st] = __builtin_amdgcn_mfma_f32_16x16x32_bf16(kt, Bqt, att[st], 0, 0, 0); }
#pragma unroll
            for (int vt = 0; vt < 4; ++vt) o[vt] = __builtin_amdgcn_mfma_f32_16x16x32_bf16(sg_[cb][vt], Bqh, o[vt], 0, 0, 0);
            if (kd < 2) HG_LOAD(cb, kd + 2)
            if (kd == 1) { const int nu = unit + F.G; if (nu < NCH * 8) HGO_PREF(nu) }
        }
#undef HG_LOAD
#pragma unroll
        for (int ks = 0; ks < 2; ++ks) {
            float m8[8];
#pragma unroll
            for (int jj = 0; jj < 8; ++jj) { const int st = 2 * ks + (jj >> 2), r = jj & 3, s = st * 16 + fq * 4 + r; m8[jj] = (s <= t) ? att[st][r] : 0.f; }
            v4u pb; pb.x = cvt_pk_bf16(m8[0], m8[1]); pb.y = cvt_pk_bf16(m8[2], m8[3]); pb.z = cvt_pk_bf16(m8[4], m8[5]); pb.w = cvt_pk_bf16(m8[6], m8[7]);
            const bf16x8 B = __builtin_bit_cast(bf16x8, pb);
#pragma unroll
            for (int vt = 0; vt < 4; ++vt) { const int v = (vh * 4 + vt) * 16 + fr;
                const v2u a0 = *(const LAS v2u*)(VT + v * VTP + ks * 32 + fq * 4), a1 = *(const LAS v2u*)(VT + v * VTP + ks * 32 + 16 + fq * 4);
                const v4u pa = (v4u){a0.x, a0.y, a1.x, a1.y};
                o[vt] = __builtin_amdgcn_mfma_f32_16x16x32_bf16(__builtin_bit_cast(bf16x8, pa), B, o[vt], 0, 0, 0); }
        }
        float ss = 0.f;
#pragma unroll
        for (int vt = 0; vt < 4; ++vt)
#pragma unroll
            for (int r = 0; r < 4; ++r) ss += o[vt][r] * o[vt][r];
        ss += __shfl_xor(ss, 16); ss += __shfl_xor(ss, 32);
        if (fq == 0) red[F.wave * 16 + fr] = ss;
        LDS_WAIT(); __builtin_amdgcn_s_barrier(); asm volatile("" ::: "memory");
        const float tot = red[F.wave * 16 + fr] + red[(F.wave ^ 4) * 16 + fr];
        const float rstd = __builtin_amdgcn_rsqf(tot * (1.f / 128.f) + RMS_EPS);
#pragma unroll
        for (int vt = 0; vt < 4; ++vt) { const int v0 = (vh * 4 + vt) * 16 + fq * 4;
            const f32x4 g4 = ngw[vt]; const v2u sg = sgw[vt];
            v2u w; w.x = cvt_pk_bf16(o[vt][0] * rstd * g4[0] * bf_lo(sg.x), o[vt][1] * rstd * g4[1] * bf_hi(sg.x));
            w.y = cvt_pk_bf16(o[vt][2] * rstd * g4[2] * bf_lo(sg.y), o[vt][3] * rstd * g4[3] * bf_hi(sg.y));
            *(v2u*)(OAB + tok * 2048 + h * 128 + v0) = w; }
        LDS_WAIT(); __builtin_amdgcn_s_barrier(); asm volatile("" ::: "memory");
    }
#undef HGO_PREF
}

constexpr int S5_UT = 0, S5_UTP = 2064, S5_XST = 33024, S5_XSP = 272, S5_KM = 37376;
__device__ __forceinline__ void s5_load_ut(const Frame& F, const bf16* UB, int g, int jb) {
    v4u w0[2], w1[2];
#pragma unroll
    for (int i = 0; i < 2; ++i) { const int tl = F.tid + 512 * i; const v4u* src = (const v4u*)(UB + ((size_t)jb * 1024 + tl) * AW + g * 16); w0[i] = src[0]; w1[i] = src[1]; }
#pragma unroll
    for (int i = 0; i < 2; ++i) { const int tl = F.tid + 512 * i; LAS v4u* dst = (LAS v4u*)(F.lds + S5_UT + (tl >> 6) * S5_UTP + (tl & 63) * 32); dst[0] = w0[i]; dst[1] = w1[i]; }
}
__device__ __forceinline__ void phase_s5_local(const Frame& F0, int l) {
    Frame F = F0; F.tid = F.wave * 64 + lane_id(); asm volatile("" : "+v"(F.tid)); F.lane = F.tid & 63;
    unsigned char* ws = opqg(F.ws);
    const bf16* UB = (const bf16*)(ws + WS_UB); const bf16* PM = (const bf16*)(ws + WS_PM) + (size_t)l * 64 * 128 * 1024; float* XLOC = (float*)(ws + WS_XLOC);
    const int fr = F.lane & 15, fq = F.lane >> 4;
    for (int unit = F.vcu; unit < 64 * 8; unit += F.G) {
        const int g = unit >> 3, jb = unit & 7;
        const bf16* ap = PM + ((size_t)g * 128 + F.wave * 16 + fr) * 1024 + fq * 8;
        bf16x8 Af[32];
#pragma unroll
        for (int ks = 0; ks < 32; ++ks) Af[ks] = *(const bf16x8*)(ap + ks * 32);
        s5_load_ut(F, UB, g, jb);
        __syncthreads();
        f32x4 acc = (f32x4){0.f, 0.f, 0.f, 0.f};
        const LAS unsigned char* bp = F.lds + S5_UT + fr * S5_UTP + (fq >> 1) * 32 + (fq & 1) * 16;
#pragma unroll
        for (int ks = 0; ks < 32; ++ks) { const bf16x8 B = *(const LAS bf16x8*)(bp + ks * 64);
            acc = __builtin_amdgcn_mfma_f32_16x16x32_bf16(Af[ks], B, acc, 0, 0, 0); }
        *(f32x4*)(XLOC + ((size_t)(jb * 16 + fr) * 64 + g) * 128 + F.wave * 16 + fq * 4) = acc;
        __syncthreads();
    }
}
__device__ __forceinline__ void phase_s5_out(const Frame& F0, int l) {
    Frame F = F0; F.tid = F.wave * 64 + lane_id(); asm volatile("" : "+v"(F.tid)); F.lane = F.tid & 63;
    unsigned char* ws = opqg(F.ws);
    const bf16* UB = (const bf16*)(ws + WS_UB); const bf16* E = (const bf16*)(ws + WS_E) + (size_t)l * 64 * 1024 * 128; const bf16* KMAT = (const bf16*)(ws + WS_KMAT) + (size_t)l * 64 * 65 * 256;
    const float* XS = (const float*)(ws + WS_XS); bf16* YB = (bf16*)(ws + WS_YB);
    const int fr = F.lane & 15, fq = F.lane >> 4;
    for (int unit = F.vcu; unit < 64 * 8; unit += F.G) {
        const int g = unit >> 3, jb = unit & 7;
        { const int cc = F.tid >> 5, p0 = (F.tid & 31) * 4;
          const f32x4 xv = *(const f32x4*)(XS + ((size_t)(jb * 16 + cc) * 64 + g) * 128 + p0);
          v4u km[5];
#pragma unroll
          for (int k = 0; k < 5; ++k) { const int pc = F.tid + 512 * k; km[k] = (pc < 65 * 32) ? *(const v4u*)(KMAT + (size_t)g * 65 * 256 + (size_t)pc * 8) : (v4u){0u, 0u, 0u, 0u}; }
          s5_load_ut(F, UB, g, jb);
          v2u w; w.x = cvt_pk_bf16(xv[0], xv[1]); w.y = cvt_pk_bf16(xv[2], xv[3]); *(LAS v2u*)(F.lds + S5_XST + cc * S5_XSP + p0 * 2) = w;
#pragma unroll
          for (int k = 0; k < 5; ++k) { const int pc = F.tid + 512 * k; const int idx = pc >> 5, n = (pc >> 1) & 15, half = pc & 1;
              if (pc < 65 * 32) *(LAS v4u*)(F.lds + S5_KM + idx * 512 + n * 32 + ((half ^ (n >> 3)) * 16)) = km[k]; } }
        __syncthreads();
        for (int ti = 0; ti < 8; ++ti) {
            const int tau = ti * 8 + F.wave;
            const bf16* ep = E + ((size_t)g * 1024 + tau * 16 + fr) * 128 + fq * 8;
            bf16x8 Ae[4];
#pragma unroll
            for (int ke = 0; ke < 4; ++ke) Ae[ke] = *(const bf16x8*)(ep + ke * 32);
            f32x4 acc = (f32x4){0.f, 0.f, 0.f, 0.f}, acc1 = (f32x4){0.f, 0.f, 0.f, 0.f};
            const LAS unsigned char* bp = F.lds + S5_UT + fr * S5_UTP + (fq >> 1) * 32 + (fq & 1) * 16;
            const LAS unsigned char* kp = F.lds + S5_KM + (tau - (fq >> 1) + 1) * 512 + fr * 32 + (((fq & 1) ^ (fr >> 3)) * 16);
            const int nks = (tau >> 1) + 1;
            int ks = 0;
            for (; ks + 4 <= nks; ks += 4) {
                const bf16x8 A0 = *(const LAS bf16x8*)(kp - ks * 1024), A1 = *(const LAS bf16x8*)(kp - (ks + 1) * 1024), A2 = *(const LAS bf16x8*)(kp - (ks + 2) * 1024), A3 = *(const LAS bf16x8*)(kp - (ks + 3) * 1024);
                const bf16x8 B0 = *(const LAS bf16x8*)(bp + ks * 64), B1 = *(const LAS bf16x8*)(bp + (ks + 1) * 64), B2 = *(const LAS bf16x8*)(bp + (ks + 2) * 64), B3 = *(const LAS bf16x8*)(bp + (ks + 3) * 64);
                acc = __builtin_amdgcn_mfma_f32_16x16x32_bf16(A0, B0, acc, 0, 0, 0); acc1 = __builtin_amdgcn_mfma_f32_16x16x32_bf16(A1, B1, acc1, 0, 0, 0);
                acc = __builtin_amdgcn_mfma_f32_16x16x32_bf16(A2, B2, acc, 0, 0, 0); acc1 = __builtin_amdgcn_mfma_f32_16x16x32_bf16(A3, B3, acc1, 0, 0, 0); }
            for (; ks < nks; ++ks) { const bf16x8 A = *(const LAS bf16x8*)(kp - ks * 1024); const bf16x8 B = *(const LAS bf16x8*)(bp + ks * 64);
                acc = __builtin_amdgcn_mfma_f32_16x16x32_bf16(A, B, acc, 0, 0, 0); }
            const LAS unsigned char* xp = F.lds + S5_XST + fr * S5_XSP + fq * 16;
#pragma unroll
            for (int ke = 0; ke < 4; ke += 2) { const bf16x8 B0 = *(const LAS bf16x8*)(xp + ke * 64), B1 = *(const LAS bf16x8*)(xp + (ke + 1) * 64);
                acc = __builtin_amdgcn_mfma_f32_16x16x32_bf16(Ae[ke], B0, acc, 0, 0, 0); acc1 = __builtin_amdgcn_mfma_f32_16x16x32_bf16(Ae[ke + 1], B1, acc1, 0, 0, 0); }
            acc += acc1;
            v2u w; w.x = cvt_pk_bf16(gelu_tanh(acc[0]), gelu_tanh(acc[1])); w.y = cvt_pk_bf16(gelu_tanh(acc[2]), gelu_tanh(acc[3]));
            *(v2u*)(YB + ((size_t)(jb * 16 + fr) * 64 + tau) * AW + g * 16 + fq * 4) = w;
        }
        __syncthreads();
    }
}

__device__ __forceinline__ void phase_ln(const Frame& F0, int l, int which) {
    Frame F = F0; F.tid = F.wave * 64 + lane_id(); asm volatile("" : "+v"(F.tid)); F.lane = F.tid & 63;
    unsigned char* ws = opqg(F.ws); const __attribute__((address_space(4))) Args* a = opq(F.ka);
    const bf16* RS = (const bf16*)(ws + WS_RH); bf16* XS = (bf16*)(ws + WS_XH);
    const bool last = (which == 1 && l == DEPTH - 1); float* OUT = GP(float, a->out);
    const float* gam = GP(const float, a->in[which == 0 ? I_LN1G : I_LN2G]) + (size_t)l * D; const float* bet = GP(const float, a->in[which == 0 ? I_LN1B : I_LN2B]) + (size_t)l * D;
    const int gw = F.vcu * 8 + F.wave, NGW = F.G * 8;
    const int j = F.lane & 3, rr = (F.lane >> 2) & 1, sl = F.lane >> 3;
    LAS float* gamL = (LAS float*)(F.lds); LAS float* betL = gamL + D;
    ((LAS f32x4*)gamL)[F.tid] = ((const f32x4*)gam)[F.tid]; ((LAS f32x4*)betL)[F.tid] = ((const f32x4*)bet)[F.tid];
    __syncthreads();
    for (int rp = gw; rp < T / 2; rp += NGW) {
        const int row = 2 * rp + rr;
        const size_t eo = ((size_t)sl * T + row) * 32 + j * 8;
        v4u w[8];
#pragma unroll
        for (int i = 0; i < 8; ++i) w[i] = *(const v4u*)(RS + eo + (size_t)i * 8 * T * 32);
        float v[64]; float s = 0.f;
#pragma unroll
        for (int i = 0; i < 8; ++i) { const unsigned ww[4] = {w[i].x, w[i].y, w[i].z, w[i].w};
#pragma unroll
            for (int k = 0; k < 4; ++k) { const h2_t hv = __builtin_bit_cast(h2_t, ww[k]); v[8 * i + 2 * k] = (float)hv.x; v[8 * i + 2 * k + 1] = (float)hv.y; s += (float)hv.x + (float)hv.y; } }
        s += __shfl_xor(s, 1); s += __shfl_xor(s, 2); s += __shfl_xor(s, 8); s += __shfl_xor(s, 16); s += __shfl_xor(s, 32);
        const float mean = s * (1.f / D); float s2 = 0.f;
#pragma unroll
        for (int i = 0; i < 64; ++i) { v[i] -= mean; s2 += v[i] * v[i]; }
        s2 += __shfl_xor(s2, 1); s2 += __shfl_xor(s2, 2); s2 += __shfl_xor(s2, 8); s2 += __shfl_xor(s2, 16); s2 += __shfl_xor(s2, 32);
        const float rstd = __builtin_amdgcn_rsqf(s2 * (1.f / D) + LN_EPS);
        float amax = 0.f; int slv = sl; asm volatile("" : "+v"(slv));
#pragma unroll
        for (int i = 0; i < 8; ++i) { const int e0 = (8 * i + slv) * 32 + j * 8;
            const f32x4 g0 = *(const LAS f32x4*)(gamL + e0), g1 = *(const LAS f32x4*)(gamL + e0 + 4), b0 = *(const LAS f32x4*)(betL + e0), b1 = *(const LAS f32x4*)(betL + e0 + 4);
            const f32x4 y0 = (f32x4){v[8 * i], v[8 * i + 1], v[8 * i + 2], v[8 * i + 3]} * rstd * g0 + b0, y1 = (f32x4){v[8 * i + 4], v[8 * i + 5], v[8 * i + 6], v[8 * i + 7]} * rstd * g1 + b1;
            if (last) { *(f32x4*)(OUT + (size_t)row * D + e0) = y0; *(f32x4*)(OUT + (size_t)row * D + e0 + 4) = y1; }
            else { v4u o; o.x = cvt_pk_f16(y0[0], y0[1]); o.y = cvt_pk_f16(y0[2], y0[3]); o.z = cvt_pk_f16(y1[0], y1[1]); o.w = cvt_pk_f16(y1[2], y1[3]); *(v4u*)(XS + eo + (size_t)i * 8 * T * 32) = o; }
            if (!last) {
#pragma unroll
                for (int k = 0; k < 4; ++k) { v[8 * i + k] = y0[k]; v[8 * i + 4 + k] = y1[k]; amax = fmaxf(amax, fmaxf(fabsf(y0[k]), fabsf(y1[k]))); } } }
        if (!last) {
            amax = fmaxf(amax, __shfl_xor(amax, 1)); amax = fmaxf(amax, __shfl_xor(amax, 2)); amax = fmaxf(amax, __shfl_xor(amax, 8)); amax = fmaxf(amax, __shfl_xor(amax, 16)); amax = fmaxf(amax, __shfl_xor(amax, 32));
            const float inv = (amax > 0.f) ? 127.f / amax : 0.f;
            if (j == 0 && sl == 0) ((float*)(ws + WS_SX))[row] = (amax > 0.f) ? amax * (1.f / 127.f) : 1.f;
            unsigned char* xq = ws + WS_XQ + (size_t)row * 64 + (sl & 1) * 32 + j * 8;
#pragma unroll
            for (int i = 0; i < 8; ++i) { int q[8];
#pragma unroll
                for (int k = 0; k < 8; ++k) q[k] = (int)__builtin_rintf(v[8 * i + k] * inv);
                v2u o; o.x = (unsigned)(q[0] & 255) | ((unsigned)(q[1] & 255) << 8) | ((unsigned)(q[2] & 255) << 16) | ((unsigned)q[3] << 24);
                o.y = (unsigned)(q[4] & 255) | ((unsigned)(q[5] & 255) << 8) | ((unsigned)(q[6] & 255) << 16) | ((unsigned)q[7] << 24);
                *(v2u*)(xq + (size_t)(4 * i + (sl >> 1)) * T * 64) = o; } }
    }
    __syncthreads();
}

constexpr int PK_TV = 0, PK_EID = 65536, PK_GATE = 81920;
__device__ __forceinline__ int f2key(float x) { const int b = __float_as_int(x); return b ^ ((b >> 31) & 0x7fffffff); }
__device__ __forceinline__ float key2f(int k) { return __int_as_float(k ^ ((k >> 31) & 0x7fffffff)); }
__device__ __forceinline__ int imed3(int a, int b, int c) { int r; asm("v_med3_i32 %0, %1, %2, %3" : "=v"(r) : "v"(a), "v"(b), "v"(c)); return r; }
#define INSK(kx) do { const int _x = (kx); _Pragma("unroll") for (int _k = 15; _k > 0; --_k) tk[_k] = imed3(tk[_k - 1], tk[_k], _x); tk[0] = max(tk[0], _x); } while (0)
__device__ __forceinline__ void phase_topk(const Frame& F0, int l) {
    Frame F = F0; F.tid = F.wave * 64 + lane_id(); asm volatile("" : "+v"(F.tid)); F.lane = F.tid & 63;
    unsigned char* ws = opqg(F.ws);
    const float* SC = (const float*)(ws + WS_SC); int* SEID = (int*)(ws + WS_SEID); float* SGATE = (float*)(ws + WS_SGATE); unsigned char* START = ws + WS_START;
    LAS int* TK = (LAS int*)(F.lds + PK_TV); LAS int* EIDL = (LAS int*)(F.lds + PK_EID); LAS float* GATEL = (LAS float*)(F.lds + PK_GATE);
    for (int tb = F.vcu; tb < T / 32; tb += F.G) {
        const int t0 = tb * 32;
        { const int tok = F.tid >> 4, hh = F.tid & 15;
          const v4u* sp = (const v4u*)((const bf16*)SC + (size_t)(t0 + tok) * 2048 + hh * 128);
          int tk[16];
#pragma unroll
          for (int k = 0; k < 16; ++k) tk[k] = (int)0x80000000;
#pragma unroll 1
          for (int i4 = 0; i4 < 16; i4 += 4) { v4u sa[4];
#pragma unroll
              for (int i = 0; i < 4; ++i) sa[i] = sp[i4 + i];
#pragma unroll
              for (int i = 0; i < 4; ++i) { const v4u s0 = sa[i]; const unsigned sw[4] = {s0.x, s0.y, s0.z, s0.w}; const int ib = 127 - 8 * (i4 + i);
#pragma unroll
                  for (int x = 0; x < 4; ++x) { INSK((f2key(bf_lo(sw[x])) & ~127) | (ib - 2 * x)); INSK((f2key(bf_hi(sw[x])) & ~127) | (ib - 2 * x - 1)); } } }
#pragma unroll
          for (int k = 0; k < 16; ++k) TK[F.tid * 16 + k] = tk[k]; }
        __syncthreads();
        if ((F.tid & 1) == 0) {
            float v1[16], v2[16];
#pragma unroll
            for (int k = 0; k < 16; ++k) { v1[k] = key2f(TK[F.tid * 16 + k] & ~127); v2[k] = key2f(TK[(F.tid + 1) * 16 + k] & ~127); }
            int tk[16];
#pragma unroll
            for (int k = 0; k < 16; ++k) tk[k] = (int)0x80000000;
#pragma unroll
            for (int aa = 0; aa < 16; ++aa)
#pragma unroll
                for (int bb = 0; bb < 16; ++bb) if ((aa + 1) * (bb + 1) <= 16) { INSK((f2key(v1[aa] + v2[bb]) & ~255) | (255 - (aa * 16 + bb))); }
            float ex[16], sum = 0.f; const float v0 = key2f(tk[0] & ~255);
#pragma unroll
            for (int k = 0; k < 16; ++k) { ex[k] = expf(key2f(tk[k] & ~255) - v0); sum += ex[k]; }
            const float inv = 1.f / sum;
            const int tok = F.tid >> 4, hd = (F.tid >> 1) & 7;
#pragma unroll
            for (int k = 0; k < 16; ++k) { const int code = 255 - (tk[k] & 255);
                const int i1 = 127 - (TK[F.tid * 16 + (code >> 4)] & 127), i2 = 127 - (TK[(F.tid + 1) * 16 + (code & 15)] & 127);
                EIDL[tok * 128 + hd * 16 + k] = (((i1 + i2) & 15) << 10) + i1 * 8 + (i2 >> 4); GATEL[tok * 128 + hd * 16 + k] = ex[k] * inv; }
        }
        __syncthreads();
        for (int ti = 0; ti < 4; ++ti) {
            const int tok = F.wave * 4 + ti;
            int k0 = (EIDL[tok * 128 + F.lane] << 7) | F.lane, k1 = (EIDL[tok * 128 + 64 + F.lane] << 7) | (64 + F.lane);
#pragma unroll
            for (int k = 2; k <= 128; k <<= 1)
#pragma unroll
                for (int j = k >> 1; j > 0; j >>= 1) {
                    if (j == 64) { const int mn = min(k0, k1), mx = max(k0, k1); k0 = mn; k1 = mx; }
                    else { const int o0 = __shfl_xor(k0, j), o1 = __shfl_xor(k1, j); const bool lower = (F.lane & j) == 0;
                        const bool up0 = (F.lane & k) == 0, up1 = ((64 + F.lane) & k) == 0;
                        k0 = (up0 == lower) ? min(k0, o0) : max(k0, o0); k1 = (up1 == lower) ? min(k1, o1) : max(k1, o1); }
                }
            const size_t t = (size_t)(t0 + tok);
            { const int r0 = k0 >> 17, r1 = k1 >> 17; int mine = 0;
#pragma unroll
              for (int r = 1; r < 16; ++r) { const int c = __builtin_popcountll(__ballot(r0 < r)) + __builtin_popcountll(__ballot(r1 < r)); mine = (F.lane == r) ? c : mine; }
              if (F.lane < 16) START[t * 16 + F.lane] = (unsigned char)mine; }
            SEID[t * LP + F.lane] = k0 >> 7; SEID[t * LP + 64 + F.lane] = k1 >> 7;
            SGATE[t * 128 + F.lane] = GATEL[tok * 128 + (k0 & 127)]; SGATE[t * 128 + 64 + F.lane] = GATEL[tok * 128 + (k1 & 127)];
        }
        __syncthreads();
    }
}
typedef __bf16 bf2_t __attribute__((ext_vector_type(2)));
__device__ __forceinline__ float dot2bf(unsigned a, unsigned b, float c) { return __builtin_amdgcn_fdot2_f32_bf16(__builtin_bit_cast(bf2_t, a), __builtin_bit_cast(bf2_t, b), c, false); }
__device__ __forceinline__ void peer_stage(const Frame& F, const bf16* gsrc, int bo) {
#pragma unroll
    for (int i = 0; i < 8; ++i) { const int p = i * 8 + F.wave;
        __builtin_amdgcn_global_load_lds((const unsigned*)((const char*)gsrc + p * 1024 + F.lane * 16), (LAS unsigned*)(F.lds + bo + p * 1024), 16, 0, 0); }
}
__device__ __forceinline__ void peer_dma(const Frame& F, const void* gsrc, int bo) {
    const unsigned ldsbase = (unsigned)(size_t)(F.lds + bo) + (unsigned)F.wave * 1024u;
#pragma unroll
    for (int i = 0; i < 8; ++i) { const char* g = (const char*)gsrc + (i * 8 + F.wave) * 1024 + F.lane * 16; const unsigned m = ldsbase + i * 8192u;
        asm volatile("s_mov_b32 m0, %0\n\ts_nop 0\n\tglobal_load_lds_dwordx4 %1, off" :: "s"(m), "v"((GAS const char*)g) : "memory"); }
}
__device__ __forceinline__ int wave_max_i(int v) {
#pragma unroll
    for (int o = 1; o < 64; o <<= 1) v = max(v, __shfl_xor(v, o));
    return __builtin_amdgcn_readfirstlane(v);
}
template <int K> __device__ __forceinline__ unsigned dppq(unsigned v) { return (unsigned)__builtin_amdgcn_mov_dpp((int)v, K * 0x55, 0xf, 0xf, true); }
__device__ __forceinline__ int sdot4(unsigned a, unsigned b, int c) { return __builtin_amdgcn_sdot4((int)a, (int)b, c, false); }
__device__ __forceinline__ int quad_sum_i(int v) {
    v += __builtin_amdgcn_mov_dpp(v, 0xB1, 0xf, 0xf, true);
    v += __builtin_amdgcn_mov_dpp(v, 0x4E, 0xf, 0xf, true);
    return v;
}
__device__ __forceinline__ float quad_sum(float v) {
    v += __int_as_float(__builtin_amdgcn_mov_dpp(__float_as_int(v), 0xB1, 0xf, 0xf, true));
    v += __int_as_float(__builtin_amdgcn_mov_dpp(__float_as_int(v), 0x4E, 0xf, 0xf, true));
    return v;
}
constexpr int UCAP0 = 24, UCAP1 = 12, UCAP2 = 12, UCAP3 = 8;
__device__ __forceinline__ void phase_peer_u(const Frame& F0, int l) {
    Frame F = F0; F.tid = F.wave * 64 + lane_id(); asm volatile("" : "+v"(F.tid)); F.lane = F.tid & 63;
    unsigned char* ws = opqg(F.ws);
    const bf16* TU = (const bf16*)(ws + WS_TBU) + (size_t)l * 32 * NEXP * 32;
    const int* SEID = (const int*)(ws + WS_SEID); const float* SGATE = (const float*)(ws + WS_SGATE); unsigned* PACK = (unsigned*)(ws + WS_PACK); unsigned char* START = ws + WS_START;
    const bf16* XBS = (const bf16*)(ws + WS_XQ); unsigned* PACK2 = (unsigned*)(ws + WS_PACK2);
    const float* SX = (const float*)(ws + WS_SX); const float* SU = (const float*)(ws + WS_SU) + (size_t)l * NEXP;
    const int qd = F.lane >> 2, jc = F.lane & 3;
    for (int unit = F.vcu; unit < 256; unit += F.G) {
        const int tt = unit & 15, er = unit >> 4; const size_t t = (size_t)tt * 512 + F.tid;
        const int lo = START[t * 16 + er], hi = (er < 15) ? (int)START[t * 16 + er + 1] : 128;
        const int cnt = hi - lo;
        int key = (cnt << 6) | (63 - F.lane);
#pragma unroll
        for (int k = 2; k <= 64; k <<= 1)
#pragma unroll
            for (int j = k >> 1; j > 0; j >>= 1) { const int o = __shfl_xor(key, j); const bool lower = (F.lane & j) == 0, up = (F.lane & k) == 0;
                key = (up == lower) ? max(key, o) : min(key, o); }
        int tl[4], glo[4], gcnt[4], gmax[4];
#pragma unroll
        for (int a = 0; a < 4; ++a) { const int kk = __shfl(key, a * 16 + qd); tl[a] = 63 - (kk & 63); gcnt[a] = kk >> 6; glo[a] = __shfl(lo, tl[a]);
            gmax[a] = __builtin_amdgcn_readfirstlane(__shfl(key, a * 16)) >> 6; }
        const size_t tbase = (size_t)tt * 512 + F.wave * 64;
        unsigned ro0[UCAP0 / 4], ro1[UCAP1 / 4], ro2[UCAP2 / 4], ro3[UCAP3 / 4];
#define LOADRO(arr, a, CAP) _Pragma("unroll") for (int i = 0; i < CAP / 4; ++i) { const int s = 4 * i + jc; const int e = SEID[(tbase + tl[a]) * LP + glo[a] + s]; \
            const int row = (s < gcnt[a]) ? (e & 1023) : 0; arr[i] = (unsigned)((row << 6) + (((row >> 2) & 3) << 4)); }
        LOADRO(ro0, 0, UCAP0) LOADRO(ro1, 1, UCAP1) LOADRO(ro2, 2, UCAP2) LOADRO(ro3, 3, UCAP3)
#undef LOADRO
        int ac0[UCAP0], ac1[UCAP1], ac2[UCAP2], ac3[UCAP3];
#pragma unroll
        for (int s = 0; s < UCAP0; ++s) ac0[s] = 0;
#pragma unroll
        for (int s = 0; s < UCAP1; ++s) ac1[s] = 0;
#pragma unroll
        for (int s = 0; s < UCAP2; ++s) ac2[s] = 0;
#pragma unroll
        for (int s = 0; s < UCAP3; ++s) ac3[s] = 0;
        const bf16* gsl0 = TU + (size_t)er * 1024 * 32;
#define XA(a) ((const v4u*)(XBS + (tbase + tl[a]) * 32) + jc)
        v4u xs[4];
#pragma unroll
        for (int a = 0; a < 4; ++a) xs[a] = XA(a)[0];
        peer_dma(F, gsl0, 0);
        VM_WAIT(); __syncthreads();
#pragma unroll 1
        for (int ks = 0; ks < 32; ++ks) {
            const int bo = (ks & 1) * 65536, jx = jc << 4;
            v4u xn[4];
            const int kn = (ks + 1 < 32) ? ks + 1 : ks;
#pragma unroll
            for (int a = 0; a < 4; ++a) xn[a] = XA(a)[(size_t)kn * T * 4];
            if (ks + 1 < 32) peer_dma(F, gsl0 + (size_t)kn * NEXP * 32, bo ^ 65536);
#define URD(B, arr, g) { asm volatile("" : "+v"(arr[g])); B[0] = *(const LAS v4u*)(F.lds + bo + (dppq<0>(arr[g]) ^ jx)); B[1] = *(const LAS v4u*)(F.lds + bo + (dppq<1>(arr[g]) ^ jx)); \
                B[2] = *(const LAS v4u*)(F.lds + bo + (dppq<2>(arr[g]) ^ jx)); B[3] = *(const LAS v4u*)(F.lds + bo + (dppq<3>(arr[g]) ^ jx)); }
#define UCP(B, acc, a, g) { _Pragma("unroll") for (int q = 0; q < 4; ++q) { int p0 = acc[4 * (g) + q]; \
                p0 = sdot4(B[q].x, xs[a].x, p0); p0 = sdot4(B[q].y, xs[a].y, p0); p0 = sdot4(B[q].z, xs[a].z, p0); p0 = sdot4(B[q].w, xs[a].w, p0); acc[4 * (g) + q] = p0; } }
            { v4u BE[4], BO[4];
              URD(BE, ro0, 0) __builtin_amdgcn_sched_barrier(0);
              URD(BO, ro0, 1) UCP(BE, ac0, 0, 0)
              __builtin_amdgcn_sched_barrier(0);
              URD(BE, ro0, 2) UCP(BO, ac0, 0, 1)
              __builtin_amdgcn_sched_barrier(0);
              URD(BO, ro0, 3) UCP(BE, ac0, 0, 2)
              __builtin_amdgcn_sched_barrier(0);
              URD(BE, ro0, 4) UCP(BO, ac0, 0, 3)
              __builtin_amdgcn_sched_barrier(0);
              URD(BO, ro0, 5) UCP(BE, ac0, 0, 4)
              __builtin_amdgcn_sched_barrier(0);
              URD(BE, ro1, 0) UCP(BO, ac0, 0, 5)
              __builtin_amdgcn_sched_barrier(0);
              URD(BO, ro1, 1) UCP(BE, ac1, 1, 0)
              __builtin_amdgcn_sched_barrier(0);
              URD(BE, ro1, 2) UCP(BO, ac1, 1, 1)
              __builtin_amdgcn_sched_barrier(0);
              URD(BO, ro2, 0) UCP(BE, ac1, 1, 2)
              __builtin_amdgcn_sched_barrier(0);
              URD(BE, ro2, 1) UCP(BO, ac2, 2, 0)
              __builtin_amdgcn_sched_barrier(0);
              URD(BO, ro2, 2) UCP(BE, ac2, 2, 1)
              __builtin_amdgcn_sched_barrier(0);
              URD(BE, ro3, 0) UCP(BO, ac2, 2, 2)
              __builtin_amdgcn_sched_barrier(0);
              URD(BO, ro3, 1) UCP(BE, ac3, 3, 0)
              __builtin_amdgcn_sched_barrier(0);
              UCP(BO, ac3, 3, 1) }
#undef URD
#undef UCP
#pragma unroll
            for (int a = 0; a < 4; ++a) xs[a] = xn[a];
            VM_WAIT(); __syncthreads();
        }
        float gt0[UCAP0 / 4], gt1[UCAP1 / 4], gt2[UCAP2 / 4], gt3[UCAP3 / 4];
        float sq0[UCAP0 / 4], sq1[UCAP1 / 4], sq2[UCAP2 / 4], sq3[UCAP3 / 4];
#define UGT(gt, sq, arr, a, CAP) { const float* gp_ = SGATE + (tbase + tl[a]) * 128; const float sx_ = SX[tbase + tl[a]]; _Pragma("unroll") for (int i = 0; i < CAP / 4; ++i) { gt[i] = gp_[min(glo[a] + 4 * i + jc, 127)]; sq[i] = sx_ * SU[er * 1024 + (int)(arr[i] >> 6)]; } }
        UGT(gt0, sq0, ro0, 0, UCAP0) UGT(gt1, sq1, ro1, 1, UCAP1) UGT(gt2, sq2, ro2, 2, UCAP2) UGT(gt3, sq3, ro3, 3, UCAP3)
#undef UGT
#define UOUT(arr, acc, gt, sq, a, CAP) { const size_t tk = tbase + tl[a]; _Pragma("unroll") for (int s = 0; s < CAP; ++s) { const int toti = quad_sum_i(acc[s]); \
            if ((s & 3) == jc && s < NSLOT) { unsigned wv = 0u; if (s < gcnt[a]) { const float av = gelu_tanh((float)toti * sq[s >> 2]) * gt[s >> 2]; wv = ((arr[s >> 2] >> 6) << 20) | (cvt_pk_f16(av, 0.f) & 0xffffu); } \
                PACK2[(tk * 16 + er) * NSLOT + s] = wv; } } \
            _Pragma("unroll") for (int s = CAP; s < NSLOT; ++s) if ((s & 3) == jc && s >= gcnt[a]) PACK2[(tk * 16 + er) * NSLOT + s] = 0u; }
        UOUT(ro0, ac0, gt0, sq0, 0, UCAP0) UOUT(ro1, ac1, gt1, sq1, 1, UCAP1) UOUT(ro2, ac2, gt2, sq2, 2, UCAP2) UOUT(ro3, ac3, gt3, sq3, 3, UCAP3)
#undef UOUT
#undef XA
        { int myrank = 0; const int mykey = (cnt << 6) | (63 - F.lane);
          for (int p = 0; p < 64; ++p) myrank += (__shfl(key, p) > mykey) ? 1 : 0;
          const int cap = myrank < 16 ? UCAP0 : (myrank < 32 ? UCAP1 : (myrank < 48 ? UCAP2 : UCAP3));
          const v4u* xsp = (const v4u*)(XBS + t * 32);
          for (int s = cap; s < cnt; ++s) {
              const int pos = lo + s, e = SEID[t * LP + pos]; const int f = (e >> 2) & 3; int di = 0;
              for (int ks = 0; ks < 32; ++ks)
#pragma unroll
                  for (int j = 0; j < 4; ++j) { const v4u u4 = *(const v4u*)(TU + (((size_t)ks * NEXP + e) * 4 + (j ^ f)) * 8); const v4u x4 = xsp[(size_t)ks * T * 4 + j];
                      di = sdot4(u4.x, x4.x, di); di = sdot4(u4.y, x4.y, di); di = sdot4(u4.z, x4.z, di); di = sdot4(u4.w, x4.w, di); }
              const float d = (float)di * SX[t] * SU[e];
              const int row = e & 1023;
              const unsigned wv = ((unsigned)row << 20) | (cvt_pk_f16(gelu_tanh(d) * SGATE[t * 128 + pos], 0.f) & 0xffffu);
              if (s < NSLOT) PACK2[(t * 16 + er) * NSLOT + s] = wv; else PACK[t * LP + pos] = wv; }
        }
    }
}
#ifndef VBLK
#define VBLK 2
#endif
#if VBLK == 4
#define VTT(x, j) (4 * ((x) & 3) + ((j) & 3))
#define VDS(x, j, it) (32 * ((x) >> 2) + 8 * (it) + ((j) >> 2))
#elif VBLK == 8
#define VTT(x, j) (8 * ((x) & 1) + ((j) & 7))
#define VDS(x, j, it) (16 * ((x) >> 1) + 4 * (it) + ((j) >> 3))
#elif VBLK == 2
#define VTT(x, j) (2 * (x) + ((j) & 1))
#define VDS(x, j, it) (16 * (it) + ((j) >> 1))
#else
#define VTT(x, j) ((j) & 15)
#define VDS(x, j, it) (((x) * 32 + (j) + 256 * (it)) >> 4)
#endif
__device__ __forceinline__ void phase_peer_v(const Frame& F0, int l) {
    Frame F = F0; F.tid = F.wave * 64 + lane_id(); asm volatile("" : "+v"(F.tid)); F.lane = F.tid & 63;
    unsigned char* ws = opqg(F.ws);
    const bf16* TV = (const bf16*)(ws + WS_TBV) + (size_t)l * 64 * NEXP * 32; const bf16* XS = (const bf16*)(ws + WS_XH); bf16* RS = (bf16*)(ws + WS_RH);
    const unsigned* PACK = (const unsigned*)(ws + WS_PACK); const unsigned char* START = ws + WS_START; const unsigned* PACK2 = (const unsigned*)(ws + WS_PACK2);
    for (int it = 0; it * F.G + F.vcu < 1024; ++it) {
        int tt, ds;
        if (F.G == 256) { const int x = F.vcu >> 5, j = F.vcu & 31; tt = VTT(x, j); ds = VDS(x, j, it); }
        else { const int unit = it * F.G + F.vcu; tt = unit & 15; ds = unit >> 4; }
        const size_t t = (size_t)tt * 512 + F.tid;
        const v4u st4 = *(const v4u*)(START + t * 16);
        const unsigned stw[4] = {st4.x, st4.y, st4.z, st4.w};
        unsigned acc[16];
#pragma unroll
        for (int i = 0; i < 16; ++i) acc[i] = 0u;
        const bf16* gsl0 = TV + (size_t)ds * NEXP * 32;
        unsigned Lc[NSLOT];
        { const v4u* lp = (const v4u*)(PACK2 + t * 16 * NSLOT);
#pragma unroll
          for (int s = 0; s < NSLOT / 4; ++s) { const v4u q = lp[s]; Lc[4 * s] = q.x; Lc[4 * s + 1] = q.y; Lc[4 * s + 2] = q.z; Lc[4 * s + 3] = q.w; } }
        peer_dma(F, gsl0, 0);
        VM_WAIT(); __syncthreads();
#pragma unroll 1
        for (int c = 0; c < 16; ++c) {
            const int bo = (c & 1) * 65536;
            const int q0 = c >> 2, q1 = (c + 1) >> 2;
            const unsigned w0 = q0 == 0 ? stw[0] : (q0 == 1 ? stw[1] : (q0 == 2 ? stw[2] : stw[3])), w1 = q1 == 0 ? stw[0] : (q1 == 1 ? stw[1] : (q1 == 2 ? stw[2] : stw[3]));
            const int s_c = (int)((w0 >> ((c & 3) * 8)) & 255u);
            const int s_n = (c < 15) ? (int)((w1 >> (((c + 1) & 3) * 8)) & 255u) : 128;
            const int n_c = s_n - s_c;
            unsigned Ln[NSLOT];
            const int cn = (c < 15) ? c + 1 : c;
            { const v4u* lp = (const v4u*)(PACK2 + (t * 16 + cn) * NSLOT);
#pragma unroll
              for (int s = 0; s < NSLOT / 4; ++s) { const v4u q = lp[s]; Ln[4 * s] = q.x; Ln[4 * s + 1] = q.y; Ln[4 * s + 2] = q.z; Ln[4 * s + 3] = q.w; } }
            if (c < 15) peer_dma(F, gsl0 + (size_t)cn * 1024 * 32, bo ^ 65536);
            const int wmax = wave_max_i(min(n_c, NSLOT));
#pragma unroll
            for (int g = 0; g < NSLOT / 2; ++g) {
                if (2 * g < wmax) {
                    v4u v4[2][4]; unsigned a2[2];
#pragma unroll
                    for (int q = 0; q < 2; ++q) { const int s = 2 * g + q; const unsigned w = Lc[s];
                        a2[q] = w;
                        const int a0 = bo + (int)(w >> 16);
#pragma unroll
                        for (int j = 0; j < 4; ++j) v4[q][j] = *(const LAS v4u*)(F.lds + a0 + j * 16384); }
#pragma unroll
                    for (int q = 0; q < 2; ++q)
#pragma unroll
                        for (int j = 0; j < 4; ++j) {
                            acc[4 * j + 0] = pkfmab(v4[q][j].x, a2[q], acc[4 * j + 0]); acc[4 * j + 1] = pkfmab(v4[q][j].y, a2[q], acc[4 * j + 1]);
                            acc[4 * j + 2] = pkfmab(v4[q][j].z, a2[q], acc[4 * j + 2]); acc[4 * j + 3] = pkfmab(v4[q][j].w, a2[q], acc[4 * j + 3]); }
                }
            }
            for (int s = NSLOT; s < n_c; ++s) {
                const unsigned w = PACK[t * LP + s_c + s]; const unsigned a2 = w;
                const int a0 = bo + (int)(w >> 16);
#pragma unroll
                for (int j = 0; j < 4; ++j) { const v4u v4 = *(const LAS v4u*)(F.lds + a0 + j * 16384);
                    acc[4 * j + 0] = pkfmab(v4.x, a2, acc[4 * j + 0]); acc[4 * j + 1] = pkfmab(v4.y, a2, acc[4 * j + 1]);
                    acc[4 * j + 2] = pkfmab(v4.z, a2, acc[4 * j + 2]); acc[4 * j + 3] = pkfmab(v4.w, a2, acc[4 * j + 3]); }
            }
            VM_WAIT(); __syncthreads();
#pragma unroll
            for (int s = 0; s < NSLOT; ++s) Lc[s] = Ln[s];
        }
        const v4u* xp = (const v4u*)(XS + ((size_t)ds * T + t) * 32); v4u* rp = (v4u*)(RS + ((size_t)ds * T + t) * 32);
        v4u xw4[4];
#pragma unroll
        for (int j = 0; j < 4; ++j) xw4[j] = xp[j];
#pragma unroll
        for (int j = 0; j < 4; ++j) { const v4u xw = xw4[j]; const unsigned xx[4] = {xw.x, xw.y, xw.z, xw.w}; unsigned o[4];
#pragma unroll
            for (int k = 0; k < 4; ++k) { const h2_t xv = __builtin_bit_cast(h2_t, xx[k]), yv = __builtin_bit_cast(h2_t, acc[4 * j + k]);
                o[k] = cvt_pk_f16((float)xv.x * ALPHA + (float)yv.x, (float)xv.y * ALPHA + (float)yv.y); }
            rp[j] = (v4u){o[0], o[1], o[2], o[3]}; }
    }
}

constexpr int PH_PER_LAYER = 13, N_PHASES = 2 + DEPTH * PH_PER_LAYER;
__global__ void __launch_bounds__(512, 2) fwd_kernel(Args args) {
    extern __shared__ __attribute__((aligned(16))) unsigned char lds[];
    Frame F;
    F.lds = (LAS unsigned char*)lds;
    F.wave = __builtin_amdgcn_readfirstlane((int)threadIdx.x >> 6); F.tid = 0; F.lane = 0;
    F.G = gridDim.x; { const int bx = blockIdx.x; F.vcu = (F.G % 8 == 0) ? (bx % 8) * (F.G / 8) + bx / 8 : bx; }
    F.ws = args.ws; F.ka = (const __attribute__((address_space(4))) Args*)__builtin_amdgcn_kernarg_segment_ptr();
    unsigned char* ws = args.ws;
    for (int u = F.wave * 64 + lane_id(); u < (LDS_BYTES - LDSCTL_OFF) / 4; u += 512) ((LAS unsigned*)(F.lds + LDSCTL_OFF))[u] = 0u;
    __syncthreads();
    XcdBarrier bar; bar.bar = (unsigned*)(ws + WS_CTL) + CW_BAR; bar.x = 0; bar.st = nullptr;
    const int lo = args.ph_lo, hi = args.ph_hi;
    if (hi - lo > 1) bar = xcd_barrier_post((unsigned*)(ws + WS_CTL) + CW_BAR, (volatile LAS unsigned*)(F.lds + MISC_OFF) + 8, F.wave == 0 && lane_id() == 0);
#ifndef PHMASK
#define PHMASK 0xFFF
#endif
#define EN(i) ((PHMASK >> (i)) & 1)
#ifndef RPT
#define RPT 0
#endif
#define REP(i) for (int _r = 0; _r <= ((RPT >> (i)) & 1); ++_r)
#define IN(k) (lo <= (k) && (k) < hi)
#define SEAM(k) do { if (IN((k) + 1)) xcd_barrier(bar, F.wave); } while (0)

    if (EN(10) && IN(0)) { REP(13) { phase_prologue_a(F); } SEAM(0); }
    if (EN(11) && IN(1)) REP(14) {
        phase_prologue_b(F);
        unsigned char* ws = opqg(args.ws);
        quant_rows(F, (const bf16*)(ws + WS_WIN), NIN, NIN, 0, ws + WS_WG8, (float*)(ws + WS_SWG));
        int kc = 256; asm volatile("" : "+s"(kc));
        pg8::Gemm g{(const bf16*)(ws + WS_BK), (const bf16*)(ws + WS_WQB), DEPTH * 2048, 2048, kc, 256, 2048, 256, (long)2048 * 2048};
        pg8::StaticOrder S; S.init(DEPTH * 2048, 2048, F.G, (int)blockIdx.x);
        pg8::EpiF16 E{(bf16*)(ws + WS_WPQ), 2048};
        pg8::gemm_phase<pg8::EpiF16, pg8::StaticOrder, true>(F.lds, g, S, E, F.wave);
        if (_r == ((RPT >> 14) & 1)) SEAM(1);
    }
    for (int l = 0; l < DEPTH; ++l) {
        const int pb = 2 + l * PH_PER_LAYER;
        if (EN(0) && IN(pb + 0)) REP(0) {
            unsigned char* ws = opqg(args.ws);
            pg8::Gemm g{(const bf16*)(ws + WS_XH), (const bf16*)(ws + WS_WIN) + (size_t)l * NIN * D, T, NIN, D, T, D, 0, 0};
            pg8::EpiIn E{(bf16*)(ws + WS_Q), (bf16*)(ws + WS_KK), (bf16*)(ws + WS_V), (bf16*)(ws + WS_SG), (bf16*)(ws + WS_UB), (bf16*)(ws + WS_GR), (bf16*)(ws + WS_GB),
                         (float*)(ws + WS_LOGF), (const float*)(ws + WS_LB) + l * AW};
            if (F.G == 256) {
                const int x = (int)blockIdx.x & 7, j = (int)blockIdx.x >> 3;
                pg8::ListOrder Sf{j, j < 16 ? 1 : 0, x, 4, 0};
                pg8::gemm_phase<pg8::EpiIn, pg8::ListOrder, true, true, true>(F.lds, g, Sf, E, F.wave);
                pg8::Gemm g8{(const bf16*)(ws + WS_XQ), (const bf16*)(ws + WS_WG8) + (size_t)l * NIN * 1024, T, NIN, 1024, T, 1024, 0, 0};
                pg8::ListOrder Si{j < 16 ? 3 * j : 48 + 5 * (j - 16), j < 16 ? 3 : 5, x, 0, 1};
                pg8::EpiIn8 E8{E, (const float*)(ws + WS_SX), (const float*)(ws + WS_SWG) + l * NIN};
                pg8::gemm_phase<pg8::EpiIn8, pg8::ListOrder, true, false, true, true>(F.lds, g8, Si, E8, F.wave);
            } else {
                pg8::StaticOrder S; S.init(T, NIN, F.G, (int)blockIdx.x);
                pg8::gemm_phase<pg8::EpiIn, pg8::StaticOrder, true, true, true>(F.lds, g, S, E, F.wave);
            }
            if (_r == ((RPT >> 0) & 1)) SEAM(pb + 0);
        }
        if (EN(1) && IN(pb + 1)) { REP(1) { REP(17) { phase_hgrn_local(F, l); } REP(18) { phase_s5_local(F, l); } } if (l == 0) { unsigned char* ws = opqg(args.ws); quant_rows(F, (const bf16*)(ws + WS_WPQ), 2048, 2048, 0, ws + WS_WP8, (float*)(ws + WS_SW)); } SEAM(pb + 1); }
        if (EN(2) && IN(pb + 2)) { REP(2) { phase_scan(F, l); } SEAM(pb + 2); }
        if (EN(3) && IN(pb + 3)) { REP(3) { REP(15) { phase_hgrn_out(F, l); } REP(16) { phase_s5_out(F, l); } } SEAM(pb + 3); }
        if (EN(4) && IN(pb + 4)) REP(4) {
            unsigned char* ws = opqg(args.ws);
            pg8::Gemm g{(const bf16*)(ws + WS_YB), (const bf16*)(ws + WS_WGLU) + (size_t)l * 2048 * 1024, T, 2048, 1024, 1024, 1024, 0, 0};
            pg8::EpiGlu E{(bf16*)(ws + WS_OAB) + 1024, 2048};
            pg8::StaticOrder S; S.init(T, 2048, F.G, (int)blockIdx.x);
            pg8::gemm_phase<pg8::EpiGlu, pg8::StaticOrder, true>(F.lds, g, S, E, F.wave);
            if (_r == ((RPT >> 4) & 1)) SEAM(pb + 4);
        }
        if (EN(5) && IN(pb + 5)) REP(5) {
            unsigned char* ws = opqg(args.ws);
            pg8::Gemm g{(const bf16*)(ws + WS_OAB), (const bf16*)(ws + WS_WUP) + (size_t)l * 2048 * 2048, T, 2048, 2048, 2048, 2048, 0, 0};
            pg8::StaticOrder S; S.init(T, 2048, F.G, (int)blockIdx.x);
            pg8::EpiUp E{(bf16*)(ws + WS_MG), (const bf16*)(ws + WS_GR), (const bf16*)(ws + WS_GB)};
            pg8::gemm_phase<pg8::EpiUp, pg8::StaticOrder, true>(F.lds, g, S, E, F.wave);
            if (_r == ((RPT >> 5) & 1)) SEAM(pb + 5);
        }
        if (EN(6) && IN(pb + 6)) REP(6) {
            unsigned char* ws = opqg(args.ws);
            pg8::Gemm g{(const bf16*)(ws + WS_MG), (const bf16*)(ws + WS_WO) + (size_t)l * 2048 * 2048, T, 2048, 2048, 2048, 2048, 0, 0};
            pg8::StaticOrder S; S.init(T, 2048, F.G, (int)blockIdx.x);
            pg8::EpiResH E{(bf16*)(ws + WS_RH), (const bf16*)(ws + WS_XH)};
            pg8::gemm_phase<pg8::EpiResH, pg8::StaticOrder, true>(F.lds, g, S, E, F.wave);
            if (_r == ((RPT >> 6) & 1)) SEAM(pb + 6);
        }
        if (EN(7) && IN(pb + 7)) { REP(7) { phase_ln(F, l, 0); } SEAM(pb + 7); }
        if (EN(8) && IN(pb + 8)) REP(8) {
            unsigned char* ws = opqg(args.ws);
            pg8::Gemm g{(const bf16*)(ws + WS_XQ), (const bf16*)(ws + WS_WP8) + (size_t)l * 2048 * 1024, T, 2048, 1024, T, 1024, 0, 0};
            pg8::StaticOrder S; S.init(T, 2048, F.G, (int)blockIdx.x);
            pg8::EpiSc8 E{(bf16*)(ws + WS_SC), (const float*)(ws + WS_SX), (const float*)(ws + WS_SW) + l * 2048};
            pg8::gemm_phase<pg8::EpiSc8, pg8::StaticOrder, true, false, true, true>(F.lds, g, S, E, F.wave);
            if (_r == ((RPT >> 8) & 1)) SEAM(pb + 8);
        }
        if (EN(9) && IN(pb + 9)) { REP(9) { phase_topk(F, l); } SEAM(pb + 9); }
        if (EN(9) && IN(pb + 10)) { REP(10) { phase_peer_u(F, l); } SEAM(pb + 10); }
        if (EN(9) && IN(pb + 11)) { REP(11) { phase_peer_v(F, l); } SEAM(pb + 11); }
        if (EN(9) && IN(pb + 12)) { REP(12) { phase_ln(F, l, 1); } SEAM(pb + 12); }
    }
#undef IN
#undef SEAM
}

extern "C" void kernel_launch(void* const* d_in, const int* in_sizes, int n_in, void* d_out, int out_size, void* d_ws, size_t ws_size, hipStream_t stream) {
    static int grid = 0;
    if (grid == 0) {
        if (n_in != 24 || out_size != T * D || ws_size < WS_END) { fprintf(stderr, "kernel_launch: unexpected sizes (n_in %d out %d ws %zu need %zu)\n", n_in, out_size, ws_size, (size_t)WS_END); grid = -1; return; }
        int dev = 0, cus = 0, per_cu = 0;
        if (hipGetDevice(&dev) != hipSuccess || hipDeviceGetAttribute(&cus, hipDeviceAttributeMultiprocessorCount, dev) != hipSuccess) { grid = -1; return; }
        if (hipFuncSetAttribute((const void*)fwd_kernel, hipFuncAttributeMaxDynamicSharedMemorySize, LDS_BYTES) != hipSuccess) { fprintf(stderr, "kernel_launch: hipFuncSetAttribute failed\n"); grid = -1; return; }
        if (hipOccupancyMaxActiveBlocksPerMultiprocessor(&per_cu, (const void*)fwd_kernel, 512, LDS_BYTES) != hipSuccess || per_cu < 1)
            fprintf(stderr, "kernel_launch: occupancy query reports %d\n", per_cu);
        (void)hipGetLastError();
        grid = cus;
    }
    if (grid < 0) return;
    if (hipMemsetAsync((char*)d_ws + WS_CTL, 0, CTL_ZERO_BYTES, stream) != hipSuccess) return;
    Args a{};
    for (int i = 0; i < 24; ++i) a.in[i] = (const float*)d_in[i];
    a.out = (float*)d_out; a.ws = (unsigned char*)d_ws;
#if ONE_LAUNCH
    a.ph_lo = 0; a.ph_hi = N_PHASES;
    hipLaunchKernelGGL(fwd_kernel, dim3(grid), dim3(512), LDS_BYTES, stream, a);
#else
    for (int p = 0; p < N_PHASES; ++p) { a.ph_lo = p; a.ph_hi = p + 1; hipLaunchKernelGGL(fwd_kernel, dim3(grid), dim3(512), LDS_BYTES, stream, a); }
#endif
}
```
